# Optimizing an MI355X kernel written in HIP

```python
import math
import jax, jax.numpy as jnp
from jax import lax
import numpy as np

D_MODEL = 2048
BATCH = 2
SEQ = 8192
DEPTH = 1

SSM_GROUP = 16
SSM_WIDTH = 1024
SSM_GROUPS = SSM_WIDTH // SSM_GROUP
SSM_STATE = 64
DT_MIN = 1e-3
DT_MAX = 1e-1
SB_HEADS = 8
SB_HEAD_DIM = 128
SB_WIDTH = SB_HEADS * SB_HEAD_DIM
Q_BLOCK = 128
IN_COLS = SSM_WIDTH + 3 * SB_WIDTH + 2 * D_MODEL
SPLITS = (SSM_WIDTH, SSM_WIDTH + SB_WIDTH, SSM_WIDTH + 2 * SB_WIDTH,
          SSM_WIDTH + 3 * SB_WIDTH, SSM_WIDTH + 3 * SB_WIDTH + D_MODEL)
PEER_HEADS = 8
PEER_N_KEYS = 128
PEER_N_EXPERTS = PEER_N_KEYS * PEER_N_KEYS
PEER_TOPK = 16
PEER_QUERY_DIM = 256
PEER_HALF = PEER_QUERY_DIM // 2
PEER_CHUNK = 128
N_ADA = 6
EPS = 1e-6

kernel_name = "hybrid_s5_stickbreak_peer_adaln"


def _rms(x, g):
    xf = x.astype(jnp.float32)
    y = xf * lax.rsqrt(jnp.mean(xf * xf, axis=-1, keepdims=True) + EPS)
    return (y * g.astype(jnp.float32)).astype(x.dtype)


def _ada_norm(x, g, shift, scale):
    return _rms(x, g) * (1 + scale) + shift


def _s5(u, lam_re, lam_im, log_dt, b_re, b_im, c_re, c_im, d_skip):
    f32 = jnp.float32
    uf = u.astype(f32)
    lam = lax.complex(lam_re.astype(f32), lam_im.astype(f32))
    dt = jnp.exp(log_dt.astype(f32))[:, None]
    lam_bar = jnp.exp(lam * dt)
    b = lax.complex(b_re.astype(f32), b_im.astype(f32))
    b_bar = ((lam_bar - 1) / lam)[..., None] * b
    cmat = lax.complex(c_re.astype(f32), c_im.astype(f32))
    bu = jnp.einsum('bsgi,gpi->bsgp', uf.astype(jnp.complex64), b_bar)
    a = jnp.broadcast_to(lam_bar, (1, uf.shape[1]) + lam_bar.shape)

    def combine(left, right):
        a_l, b_l = left
        a_r, b_r = right
        return a_r * a_l, a_r * b_l + b_r

    _, states = lax.associative_scan(combine, (a, bu), axis=1)
    y = jnp.real(jnp.einsum('bsgp,gip->bsgi', states, cmat)) + d_skip.astype(f32) * uf
    return y.astype(u.dtype)


def _stick_breaking(q, k, v):
    f32 = jnp.float32
    seq = q.shape[2]
    scale = SB_HEAD_DIM ** -0.5
    outs = []
    for blk in range(seq // Q_BLOCK):
        t0 = blk * Q_BLOCK
        length = t0 + Q_BLOCK
        qb = q[:, :, t0:length].astype(f32)
        kb = k[:, :, :length].astype(f32)
        vb = v[:, :, :length].astype(f32)
        z = jnp.einsum('bhqd,bhkd->bhqk', qb, kb) * scale
        t_idx = t0 + jnp.arange(Q_BLOCK)[:, None]
        s_idx = jnp.arange(length)[None, :]
        causal = s_idx < t_idx
        log_fail = jnp.where(causal, jax.nn.log_sigmoid(-z), 0.0)
        suffix = lax.cumsum(log_fail, axis=3, reverse=True) - log_fail
        log_w = jnp.where(causal, jax.nn.log_sigmoid(z) + suffix, -jnp.inf)
        outs.append(jnp.einsum('bhqk,bhkd->bhqd', jnp.exp(log_w), vb))
    return jnp.concatenate(outs, axis=2).astype(v.dtype)


def _peer(h, wq, k1, k2, u_tab, v_tab):
    f32 = jnp.float32
    bsz, seq, d = h.shape
    t = bsz * seq
    hf = h.reshape(t, d)
    q = (hf @ wq).reshape(t, PEER_HEADS, 2, PEER_HALF).astype(f32)
    s1 = jnp.einsum('thd,nd->thn', q[:, :, 0], k1.astype(f32))
    s2 = jnp.einsum('thd,nd->thn', q[:, :, 1], k2.astype(f32))
    v1, i1 = lax.top_k(s1, PEER_TOPK)
    v2, i2 = lax.top_k(s2, PEER_TOPK)
    cand = (v1[..., :, None] + v2[..., None, :]).reshape(t, PEER_HEADS, PEER_TOPK * PEER_TOPK)
    cidx = (i1[..., :, None] * PEER_N_KEYS + i2[..., None, :]).reshape(t, PEER_HEADS, PEER_TOPK * PEER_TOPK)
    best, pos = lax.top_k(cand, PEER_TOPK)
    idx = jnp.take_along_axis(cidx, pos, axis=-1)
    gate = jax.nn.softmax(best, axis=-1).astype(h.dtype)
    n_chunks = t // PEER_CHUNK

    def chunk(args):
        xc, ic, gc = args
        ue = jnp.take(u_tab, ic, axis=0)
        act = gc * jax.nn.gelu(jnp.einsum('cd,chkd->chk', xc, ue))
        ve = jnp.take(v_tab, ic, axis=0)
        return jnp.einsum('chk,chkd->cd', act, ve)

    out = lax.map(chunk, (hf.reshape(n_chunks, PEER_CHUNK, d),
                          idx.reshape(n_chunks, PEER_CHUNK, PEER_HEADS, PEER_TOPK),
                          gate.reshape(n_chunks, PEER_CHUNK, PEER_HEADS, PEER_TOPK)))
    return out.reshape(bsz, seq, d)


def setup_inputs(seed: int = 0) -> dict:
    key = jax.random.key(seed)
    ks = jax.random.split(key, 26)
    nrm = jax.random.normal
    D = D_MODEL
    L = DEPTH
    x = nrm(ks[0], (BATCH, SEQ, D), jnp.float32)
    c = nrm(ks[1], (BATCH, D), jnp.float32)
    w_ada = nrm(ks[2], (L, D, N_ADA * D), jnp.float32) * (0.5 * D ** -0.5)
    b_ada = nrm(ks[3], (L, N_ADA * D), jnp.float32) * 0.01
    norm1_g = 1.0 + 0.02 * nrm(ks[4], (L, D), jnp.float32)
    w_in = nrm(ks[5], (L, D, IN_COLS), jnp.float32) * D ** -0.5
    lam_re = -0.5 * jnp.exp(0.01 * nrm(ks[6], (L, SSM_GROUPS, SSM_STATE), jnp.float32))
    lam_im = (jnp.pi * jnp.arange(SSM_STATE, dtype=jnp.float32))[None, None, :] \
        + 0.01 * nrm(ks[7], (L, SSM_GROUPS, SSM_STATE), jnp.float32)
    log_dt = jax.random.uniform(ks[8], (L, SSM_GROUPS), jnp.float32,
                                math.log(DT_MIN), math.log(DT_MAX))
    ssm_b_re = nrm(ks[9], (L, SSM_GROUPS, SSM_STATE, SSM_GROUP), jnp.float32) * (2 * SSM_GROUP) ** -0.5
    ssm_b_im = nrm(ks[10], (L, SSM_GROUPS, SSM_STATE, SSM_GROUP), jnp.float32) * (2 * SSM_GROUP) ** -0.5
    ssm_c_re = nrm(ks[11], (L, SSM_GROUPS, SSM_GROUP, SSM_STATE), jnp.float32) * 0.5
    ssm_c_im = nrm(ks[12], (L, SSM_GROUPS, SSM_GROUP, SSM_STATE), jnp.float32) * 0.5
    ssm_d = nrm(ks[13], (L, SSM_GROUPS, SSM_GROUP), jnp.float32) * 0.5
    w_glu = nrm(ks[14], (L, SSM_WIDTH, 2 * D), jnp.float32) * SSM_WIDTH ** -0.5
    q_norm_g = 1.0 + 0.02 * nrm(ks[15], (L, SB_HEAD_DIM), jnp.float32)
    k_norm_g = 1.0 + 0.02 * nrm(ks[16], (L, SB_HEAD_DIM), jnp.float32)
    w_att_up = nrm(ks[17], (L, SB_WIDTH, D), jnp.float32) * SB_WIDTH ** -0.5
    w_out = nrm(ks[18], (L, D, D), jnp.float32) * D ** -0.5
    norm2_g = 1.0 + 0.02 * nrm(ks[19], (L, D), jnp.float32)
    peer_wq = nrm(ks[20], (L, D, PEER_HEADS * PEER_QUERY_DIM), jnp.float32) * D ** -0.5
    peer_k1 = nrm(ks[21], (L, PEER_N_KEYS, PEER_HALF), jnp.float32) * PEER_HALF ** -0.5
    peer_k2 = nrm(ks[22], (L, PEER_N_KEYS, PEER_HALF), jnp.float32) * PEER_HALF ** -0.5
    peer_u = nrm(ks[23], (L, PEER_N_EXPERTS, D), jnp.float32) * D ** -0.5
    peer_v = nrm(ks[24], (L, PEER_N_EXPERTS, D), jnp.float32)
    return {"x": x, "c": c, "w_ada": w_ada, "b_ada": b_ada, "norm1_g": norm1_g, "w_in": w_in,
            "lam_re": lam_re, "lam_im": lam_im, "log_dt": log_dt,
            "ssm_b_re": ssm_b_re, "ssm_b_im": ssm_b_im, "ssm_c_re": ssm_c_re, "ssm_c_im": ssm_c_im,
            "ssm_d": ssm_d, "w_glu": w_glu, "q_norm_g": q_norm_g, "k_norm_g": k_norm_g,
            "w_att_up": w_att_up, "w_out": w_out, "norm2_g": norm2_g, "peer_wq": peer_wq,
            "peer_k1": peer_k1, "peer_k2": peer_k2, "peer_u": peer_u, "peer_v": peer_v}


def reference(x, c, w_ada, b_ada, norm1_g, w_in, lam_re, lam_im, log_dt,
              ssm_b_re, ssm_b_im, ssm_c_re, ssm_c_im, ssm_d, w_glu, q_norm_g, k_norm_g,
              w_att_up, w_out, norm2_g, peer_wq, peer_k1, peer_k2, peer_u, peer_v):
    bsz, seq, _ = x.shape
    c_act = jax.nn.silu(c)
    for l in range(DEPTH):
        mod = c_act @ w_ada[l] + b_ada[l]
        sh1, sc1, gt1, sh2, sc2, gt2 = [m[:, None, :] for m in jnp.split(mod, N_ADA, axis=-1)]

        h = _ada_norm(x, norm1_g[l], sh1, sc1)
        proj = h @ w_in[l]
        u_ssm, q, k, v, g_ssm, g_att = jnp.split(proj, SPLITS, axis=-1)

        y = _s5(u_ssm.reshape(bsz, seq, SSM_GROUPS, SSM_GROUP), lam_re[l], lam_im[l], log_dt[l],
                ssm_b_re[l], ssm_b_im[l], ssm_c_re[l], ssm_c_im[l], ssm_d[l])
        y = jax.nn.gelu(y.reshape(bsz, seq, SSM_WIDTH))
        y_val, y_gate = jnp.split(y @ w_glu[l], 2, axis=-1)
        ssm_out = y_val * jax.nn.sigmoid(y_gate)

        qh = _rms(q.reshape(bsz, seq, SB_HEADS, SB_HEAD_DIM), q_norm_g[l]).transpose(0, 2, 1, 3)
        kh = _rms(k.reshape(bsz, seq, SB_HEADS, SB_HEAD_DIM), k_norm_g[l]).transpose(0, 2, 1, 3)
        vh = v.reshape(bsz, seq, SB_HEADS, SB_HEAD_DIM).transpose(0, 2, 1, 3)
        att = _stick_breaking(qh, kh, vh).transpose(0, 2, 1, 3).reshape(bsz, seq, SB_WIDTH)
        att_out = att @ w_att_up[l]

        merged = jax.nn.sigmoid(g_ssm) * ssm_out + jax.nn.sigmoid(g_att) * att_out
        x = x + gt1 * (merged @ w_out[l])

        h2 = _ada_norm(x, norm2_g[l], sh2, sc2)
        x = x + gt2 * _peer(h2, peer_wq[l], peer_k1[l], peer_k2[l], peer_u[l], peer_v[l])
    return x
```

```cpp
#include <hip/hip_runtime.h>
#include <cstdio>
#include <cstdint>

#ifndef MK_PER_PHASE
#define MK_PER_PHASE 1
#endif

#define LAS __attribute__((address_space(3)))
typedef unsigned short bf16_t;
typedef short bf16x8 __attribute__((ext_vector_type(8)));
typedef float f32x4 __attribute__((ext_vector_type(4)));
typedef float f32x2 __attribute__((ext_vector_type(2)));
typedef unsigned u32x4 __attribute__((ext_vector_type(4)));
typedef unsigned u32x2 __attribute__((ext_vector_type(2)));

constexpr int T_TOK = 16384, DM = 2048, SEQ = 8192;
constexpr int NPHASE = 11;
constexpr float EPS = 1e-6f;

constexpr size_t WS_CTL   = 0;
constexpr size_t WS_MODP  = 65536;
constexpr size_t WS_MOD   = WS_MODP + (size_t)32 * 2 * 12288 * 4;
constexpr size_t WS_WIN   = WS_MOD + (size_t)2 * 12288 * 4;
constexpr size_t WS_WGLU  = WS_WIN + (size_t)8192 * 2048 * 2;
constexpr size_t WS_WATT  = WS_WGLU + (size_t)4096 * 1024 * 2;
constexpr size_t WS_WOUT  = WS_WATT + (size_t)2048 * 1024 * 2;
constexpr size_t WS_WSC   = WS_WOUT + (size_t)2048 * 2048 * 2;
constexpr size_t WS_H     = WS_WSC + (size_t)2048 * 2048 * 2;
constexpr size_t WS_PA    = WS_H + (size_t)T_TOK * 2048 * 2;
constexpr size_t WS_PG    = WS_PA + (size_t)T_TOK * 4096 * 2;
constexpr size_t WS_E     = WS_PG + (size_t)T_TOK * 4096 * 2;
constexpr size_t WS_YA    = WS_E + (size_t)2 * 64 * 128 * 64 * 8;
constexpr size_t WS_ATT   = WS_YA + (size_t)T_TOK * 1024 * 2;
constexpr size_t WS_END   = WS_ATT + (size_t)T_TOK * 1024 * 2;
constexpr size_t WS_SC    = WS_PA;
constexpr size_t WS_UT    = WS_PG;
constexpr size_t WS_VT    = WS_PG + (size_t)16384 * 2048 * 2;

constexpr int LDS_MAIN = 131072, LDS_BYTES = LDS_MAIN + 256;

__device__ __forceinline__ unsigned cvt_pk_bf16(float lo, float hi) { unsigned r; asm volatile("v_cvt_pk_bf16_f32 %0, %1, %2" : "=v"(r) : "v"(lo), "v"(hi)); return r; }
__device__ __forceinline__ float bf_lo(unsigned w) { return __uint_as_float(w << 16); }
__device__ __forceinline__ float bf_hi(unsigned w) { return __uint_as_float(w & 0xffff0000u); }
__device__ __forceinline__ float wave_sum(float v) {
#pragma unroll
    for (int o = 1; o < 64; o <<= 1) v += __shfl_xor(v, o);
    return v;
}
__device__ __forceinline__ float sigmoidf_(float x) { return 1.0f / (1.0f + __expf(-x)); }
__device__ __forceinline__ float gelu_tanh(float x) {
    const float a = 0.7978845608028654f * (x + 0.044715f * x * x * x);
    const float t = 1.0f - 2.0f / (__expf(2.0f * a) + 1.0f);
    return 0.5f * x * (1.0f + t);
}
#define LDS_WAIT() asm volatile("s_waitcnt lgkmcnt(0)" ::: "memory")

#define XB_TMO      128
#define XB_XCNT(j)  (256  + 64 * (j))
#define XB_XSUB(j)  (1280 + 64 * (j))
#define XB_XGEN(j)  (2304 + 64 * (j))
#define XB_TOP      3328
#define XB_TOPGEN   3392
#define XCD_BAR_WORDS 3456
#define XB_SPIN_CAP (1u << 22)
__device__ __forceinline__ unsigned xb_ld(unsigned* p)              { return __hip_atomic_load(p, __ATOMIC_RELAXED, __HIP_MEMORY_SCOPE_AGENT); }
__device__ __forceinline__ unsigned xb_add(unsigned* p, unsigned v) { return __hip_atomic_fetch_add(p, v, __ATOMIC_RELAXED, __HIP_MEMORY_SCOPE_AGENT); }
__device__ __forceinline__ unsigned xb_xcc_id() { return (unsigned)__builtin_amdgcn_s_getreg((3 << 11) | 20) & 0xFu; }
#define XB_SPIN(cond, bar) do { unsigned _sp = 0; while (cond) { __builtin_amdgcn_s_sleep(1); \
    if ((++_sp & 255u) == 0u) { if (xb_ld(&(bar)[XB_TMO])) break; if (_sp > XB_SPIN_CAP) { atomicAdd(&(bar)[XB_TMO], 1u); break; } } } } while (0)
struct XcdBarrier { unsigned* bar; unsigned x; volatile LAS unsigned* st; };
__device__ __forceinline__ XcdBarrier xcd_barrier_post(unsigned* bar, volatile LAS unsigned* st) {
    XcdBarrier b; b.bar = bar; b.x = xb_xcc_id(); b.st = st;
    if (threadIdx.x == 0) (void)xb_add(&bar[XB_XCNT(b.x)], 1u);
    return b;
}
__device__ __forceinline__ void xcd_barrier_complete(unsigned* bar, unsigned x, unsigned& nloc, unsigned& nx) {
    const unsigned G = gridDim.x * gridDim.y * gridDim.z;
    unsigned sum, cnt, mine, sp = 0u;
    for (;;) {
        sum = 0u; cnt = 0u; mine = 0u;
#pragma unroll
        for (unsigned j = 0; j < 16; ++j) { const unsigned c = xb_ld(&bar[XB_XCNT(j)]); sum += c; cnt += (c > 0u) ? 1u : 0u; mine = (j == x) ? c : mine; }
        if (sum == G) break;
        __builtin_amdgcn_s_sleep(1);
        if ((++sp & 255u) == 0u) { if (xb_ld(&bar[XB_TMO])) break; if (sp > XB_SPIN_CAP) { atomicAdd(&bar[XB_TMO], 1u); break; } }
    }
    nloc = mine > 0u ? mine : 1u; nx = cnt > 0u ? cnt : 1u;
}
__device__ __forceinline__ void xcd_barrier(const XcdBarrier& b) {
    asm volatile("s_waitcnt vmcnt(0)" ::: "memory");
    __syncthreads();
    if (threadIdx.x == 0) {
        unsigned* bar = b.bar;
        __builtin_amdgcn_s_waitcnt(0);
        unsigned nloc = b.st[0], nx = b.st[1];
        if (nloc == 0u) { xcd_barrier_complete(bar, b.x, nloc, nx); b.st[0] = nloc; b.st[1] = nx; }
        const unsigned old = xb_add(&bar[XB_XSUB(b.x)], 1u);
        const unsigned gen = old / nloc;
        if (old + 1u == (gen + 1u) * nloc) {
            __builtin_amdgcn_fence(__ATOMIC_RELEASE, "agent");
            asm volatile("s_waitcnt vmcnt(0)" ::: "memory");
            const unsigned og = xb_add(&bar[XB_TOP], 1u);
            const unsigned tg = og / nx;
            if (og + 1u == (tg + 1u) * nx) xb_add(&bar[XB_TOPGEN], 1u);
            else XB_SPIN(xb_ld(&bar[XB_TOPGEN]) == tg, bar);
            __builtin_amdgcn_fence(__ATOMIC_ACQUIRE, "agent");
            xb_add(&bar[XB_XGEN(b.x)], 1u);
            asm volatile("s_waitcnt vmcnt(0)" ::: "memory");
        } else {
            XB_SPIN(xb_ld(&bar[XB_XGEN(b.x)]) == gen, bar);
            __builtin_amdgcn_fence(__ATOMIC_ACQUIRE, "agent");
            asm volatile("s_waitcnt vmcnt(0)" ::: "memory");
        }
    }
    __syncthreads();
}

namespace pg8 {
constexpr int BM = 256, BK = 64, HALF = 128, HTB = HALF * BK * 2, STAGE_BYTES = 8 * HTB, NXCD = 8, WGM = 8;
__host__ __device__ __forceinline__ int lds_byte(int r, int c) { const int st = (r >> 4) * 2 + (c >> 5), rr = r & 15, cc = c & 31, ob = rr * 64 + cc * 2; return st * 1024 + (ob ^ (((ob >> 9) & 1) << 5)); }
__host__ __device__ __forceinline__ void stage_rc(int b, int& R, int& C) { const int st = b / 1024, sb = b % 1024, swz = sb ^ (((sb >> 9) & 1) << 5); R = (st >> 1) * 16 + swz / 64; C = (st & 1) * 32 + (swz % 64) / 2; }
__host__ __device__ __forceinline__ int perm32(int rho) { const int n = rho >> 4, i = rho & 15; return 8 * (i >> 2) + 4 * n + (i & 3); }
struct Unit { int pm, pn; };
struct Gemm { const bf16_t* A; const bf16_t* Bt; int M, N, K; };
struct StaticOrder {
    int nM, nN, nwg, G, c;
    __host__ __device__ void init(int M, int N, int G_, int c_) { nM = M / BM; nN = N / BM; nwg = nM * nN; G = G_; c = c_; }
    __host__ __device__ bool next(int i, Unit& u) const {
        const long L = (long)i * G + c; if (L >= nwg) return false;
        int wgid = (int)L; { const int q = nwg / NXCD, r = nwg % NXCD, xcd = wgid % NXCD, off = wgid / NXCD; wgid = (xcd < r ? xcd * (q + 1) : r * (q + 1) + (xcd - r) * q) + off; }
        const int nig = WGM * nN, gid = wgid / nig, fm = gid * WGM, gsz = (nM - fm) < WGM ? (nM - fm) : WGM;
        u.pm = fm + ((wgid % nig) % gsz); u.pn = (wgid % nig) / gsz; return true;
    }
    __device__ __forceinline__ void a_ready(const Unit&) const {}
    __device__ __forceinline__ void done(const Unit&) const {}
};
template <class Epi, class Sched, bool ALIGN_EPI = false, bool SP2 = false>
__device__ __forceinline__ void gemm_phase(LAS unsigned char* lds, const Gemm g, const Sched& S, const Epi& E) {
    const int tid = threadIdx.x, wid = __builtin_amdgcn_readfirstlane(tid >> 6), lane = tid & 63, wr = wid >> 2, wc = wid & 3, fr = lane & 15, fq = lane >> 4;
    const int K = g.K, nt = K / BK;
    unsigned voffA[2], voffB[2];
#pragma unroll
    for (int i = 0; i < 2; ++i) { int R, C; stage_rc(tid * 16 + i * 8192, R, C); const int Rb = Epi::PERM ? ((R & ~31) + perm32(R & 31)) : R;
        voffA[i] = (unsigned)(R * K + C) * 2u; voffB[i] = (unsigned)(Rb * K + C) * 2u; }
    const size_t kstep = (size_t)(BK * 2);
    const size_t hstep = (size_t)HALF * K * 2;
    const size_t tstep = 2 * hstep;
    const unsigned ldsw = (unsigned)wid * 1024u;
    const int aoff = lds_byte(wr * 64 + fr, fq * 8), boff = lds_byte(wc * 32 + fr, fq * 8);
#define PG8_SA(b, h) (((b) * 2 + (h)) * HTB)
#define PG8_SB(b, h) ((4 + (b) * 2 + (h)) * HTB)
#define PG8_STAGE(bufoff, gbase, voff) do { _Pragma("unroll") for (int _i = 0; _i < 2; ++_i) \
        __builtin_amdgcn_global_load_lds((const unsigned*)((const char*)(gbase) + (voff)[_i]), (LAS unsigned*)(lds + (bufoff) + ldsw + _i * 8192), 16, 0, 0); } while (0)
#define PG8_LDA(dst, b, h) do { _Pragma("unroll") for (int m = 0; m < 4; ++m) _Pragma("unroll") for (int k = 0; k < 2; ++k) dst[m][k] = *(const LAS bf16x8*)(lds + PG8_SA(b, h) + aoff + m * 2048 + k * 1024); } while (0)
#define PG8_LDB(dst, b, h) do { _Pragma("unroll") for (int n = 0; n < 2; ++n) _Pragma("unroll") for (int k = 0; k < 2; ++k) dst[n][k] = *(const LAS bf16x8*)(lds + PG8_SB(b, h) + boff + n * 2048 + k * 1024); } while (0)
#define PG8_MMA(ai, bj, At, Bt) do { __builtin_amdgcn_s_setprio(1); _Pragma("unroll") for (int m = 0; m < 4; ++m) _Pragma("unroll") for (int n = 0; n < 2; ++n) _Pragma("unroll") for (int k = 0; k < 2; ++k) \
        acc[ai][bj][m][n] = __builtin_amdgcn_mfma_f32_16x16x32_bf16(Bt[n][k], At[m][k], acc[ai][bj][m][n], 0, 0, 0); __builtin_amdgcn_s_setprio(0); } while (0)
#define PG8_WAIT_V(n) asm volatile("s_waitcnt vmcnt(" #n ")" ::: "memory")
#define PG8_WAIT_L(n) asm volatile("s_waitcnt lgkmcnt(" #n ")" ::: "memory")
#define PG8_BAR __builtin_amdgcn_s_barrier()
#define PG8_SCHED __builtin_amdgcn_sched_barrier(0)
    Unit cur, nxt; int ui = 0;
    if (!S.next(0, cur)) return;
    f32x4 acc[2][2][4][2];
#pragma unroll
    for (int a = 0; a < 2; ++a)
#pragma unroll
        for (int b = 0; b < 2; ++b)
#pragma unroll
            for (int m = 0; m < 4; ++m)
#pragma unroll
                for (int n = 0; n < 2; ++n) acc[a][b][m][n] = (f32x4){0.f, 0.f, 0.f, 0.f};
    bf16x8 At[4][2], B0[2][2], B1[2][2];
    const char* cA = (const char*)g.A + (size_t)cur.pm * tstep; const char* cB = (const char*)g.Bt + (size_t)cur.pn * tstep;
    S.a_ready(cur);
    if constexpr (SP2) {
        PG8_STAGE(PG8_SB(0, 0), cB, voffB); PG8_STAGE(PG8_SB(0, 1), cB + hstep, voffB); PG8_STAGE(PG8_SA(0, 0), cA, voffA); PG8_STAGE(PG8_SA(0, 1), cA + hstep, voffA);
        if (wr == 1) PG8_BAR;
        PG8_WAIT_V(2); PG8_BAR;
        PG8_STAGE(PG8_SB(1, 0), cB + kstep, voffB); PG8_STAGE(PG8_SA(1, 0), cA + kstep, voffA); PG8_STAGE(PG8_SB(1, 1), cB + hstep + kstep, voffB);
        PG8_WAIT_V(6); PG8_BAR;
    } else {
        PG8_STAGE(PG8_SB(0, 0), cB, voffB); PG8_STAGE(PG8_SA(0, 0), cA, voffA); PG8_STAGE(PG8_SB(0, 1), cB + hstep, voffB); PG8_STAGE(PG8_SA(0, 1), cA + hstep, voffA);
        if (wr == 1) PG8_BAR;
        PG8_WAIT_V(4); PG8_BAR;
        PG8_STAGE(PG8_SB(1, 0), cB + kstep, voffB); PG8_STAGE(PG8_SA(1, 0), cA + kstep, voffA); PG8_STAGE(PG8_SB(1, 1), cB + hstep + kstep, voffB);
        PG8_WAIT_V(6); PG8_BAR;
    }
    for (;;) {
        const bool has_next = S.next(ui + 1, nxt);
        const char* nA = has_next ? (const char*)g.A + (size_t)nxt.pm * tstep : cA; const char* nB = has_next ? (const char*)g.Bt + (size_t)nxt.pn * tstep : cB;
        for (int t = 0; t < nt; t += 2) {
            const bool last = (t == nt - 2);
            const char* a1 = cA + (size_t)(t + 1) * kstep;
            const char* a2 = last ? nA : cA + (size_t)(t + 2) * kstep; const char* b2 = last ? nB : cB + (size_t)(t + 2) * kstep;
            const char* a3 = a2 + kstep; const char* b3 = b2 + kstep;
            if (last && has_next) S.a_ready(nxt);
            if constexpr (SP2) {
            PG8_LDB(B0, 0, 0); PG8_LDB(B1, 0, 1); PG8_SCHED; PG8_LDA(At, 0, 0); PG8_STAGE(PG8_SA(1, 1), a1 + hstep, voffA);
            PG8_WAIT_V(8); PG8_WAIT_L(0); PG8_BAR; PG8_MMA(0, 0, At, B0); PG8_MMA(0, 1, At, B1); PG8_BAR; PG8_SCHED;
            PG8_LDA(At, 0, 1); PG8_STAGE(PG8_SB(0, 0), b2, voffB); PG8_STAGE(PG8_SB(0, 1), b2 + hstep, voffB); PG8_STAGE(PG8_SA(0, 0), a2, voffA);
            PG8_WAIT_V(8); PG8_WAIT_L(0); PG8_BAR; PG8_MMA(1, 0, At, B0); PG8_MMA(1, 1, At, B1); PG8_BAR; PG8_SCHED;
            PG8_LDB(B0, 1, 0); PG8_LDB(B1, 1, 1); PG8_SCHED; PG8_LDA(At, 1, 0); PG8_STAGE(PG8_SA(0, 1), a2 + hstep, voffA);
            PG8_WAIT_V(8); PG8_WAIT_L(0); PG8_BAR; PG8_MMA(0, 0, At, B0); PG8_MMA(0, 1, At, B1); PG8_BAR; PG8_SCHED;
            PG8_LDA(At, 1, 1); PG8_STAGE(PG8_SB(1, 0), b3, voffB); PG8_STAGE(PG8_SB(1, 1), b3 + hstep, voffB); PG8_STAGE(PG8_SA(1, 0), a3, voffA);
            PG8_WAIT_V(8); PG8_WAIT_L(0); PG8_BAR; PG8_MMA(1, 0, At, B0); PG8_MMA(1, 1, At, B1); PG8_BAR; PG8_SCHED;
            } else {
            PG8_LDB(B0, 0, 0); PG8_SCHED; PG8_LDA(At, 0, 0); PG8_STAGE(PG8_SA(1, 1), a1 + hstep, voffA);
            PG8_WAIT_L(8); PG8_BAR; PG8_WAIT_L(0); PG8_MMA(0, 0, At, B0); PG8_BAR; PG8_SCHED;
            PG8_LDB(B1, 0, 1); PG8_STAGE(PG8_SB(0, 0), b2, voffB);
            PG8_BAR; PG8_WAIT_L(0); PG8_MMA(0, 1, At, B1); PG8_BAR;
            PG8_LDA(At, 0, 1); PG8_STAGE(PG8_SA(0, 0), a2, voffA);
            PG8_BAR; PG8_WAIT_L(0); PG8_MMA(1, 0, At, B0); PG8_BAR; PG8_SCHED;
            PG8_STAGE(PG8_SB(0, 1), b2 + hstep, voffB);
            PG8_WAIT_V(6); PG8_BAR; PG8_MMA(1, 1, At, B1); PG8_BAR;
            PG8_LDB(B0, 1, 0); PG8_SCHED; PG8_LDA(At, 1, 0); PG8_STAGE(PG8_SA(0, 1), a2 + hstep, voffA);
            PG8_WAIT_L(8); PG8_BAR; PG8_WAIT_L(0); PG8_MMA(0, 0, At, B0); PG8_BAR; PG8_SCHED;
            PG8_LDB(B1, 1, 1); PG8_STAGE(PG8_SB(1, 0), b3, voffB);
            PG8_BAR; PG8_WAIT_L(0); PG8_MMA(0, 1, At, B1); PG8_BAR;
            PG8_LDA(At, 1, 1); PG8_STAGE(PG8_SA(1, 0), a3, voffA);
            PG8_BAR; PG8_WAIT_L(0); PG8_MMA(1, 0, At, B0); PG8_BAR; PG8_SCHED;
            PG8_STAGE(PG8_SB(1, 1), b3 + hstep, voffB);
            PG8_WAIT_V(6); PG8_BAR; PG8_MMA(1, 1, At, B1); PG8_BAR;
            }
        }
        if constexpr (ALIGN_EPI) { if (wr == 0) PG8_BAR; }
        E(acc, cur, wr, wc, fr, fq); S.done(cur);
        if (!has_next) break;
#pragma unroll
        for (int a = 0; a < 2; ++a)
#pragma unroll
            for (int b = 0; b < 2; ++b)
#pragma unroll
                for (int m = 0; m < 4; ++m)
#pragma unroll
                    for (int n = 0; n < 2; ++n) acc[a][b][m][n] = (f32x4){0.f, 0.f, 0.f, 0.f};
        cur = nxt; cA = nA; cB = nB; ++ui;
        if constexpr (ALIGN_EPI) { if (wr == 1) PG8_BAR; }
    }
    PG8_WAIT_V(0);
    if constexpr (!ALIGN_EPI) { if (wr == 0) PG8_BAR; }
    PG8_BAR;
#undef PG8_SA
#undef PG8_SB
#undef PG8_STAGE
#undef PG8_LDA
#undef PG8_LDB
#undef PG8_MMA
#undef PG8_WAIT_V
#undef PG8_WAIT_L
#undef PG8_BAR
#undef PG8_SCHED
}

struct EpiProj {
    static constexpr bool PERM = true;
    bf16_t* PA; bf16_t* PG;
    __device__ __forceinline__ void operator()(const f32x4 (&acc)[2][2][4][2], const Unit& u, int wr, int wc, int fr, int fq) const {
        const int row0 = u.pm * BM + wr * 64 + fr; int colt = u.pn * BM; bf16_t* base = colt < 4096 ? PA : PG; colt &= 4095;
        const int col0 = colt + wc * 32 + 8 * fq;
#pragma unroll
        for (int ai = 0; ai < 2; ++ai)
#pragma unroll
            for (int m = 0; m < 4; ++m) { bf16_t* rowp = base + (size_t)(row0 + ai * HALF + m * 16) * 4096 + col0;
#pragma unroll
                for (int bj = 0; bj < 2; ++bj) { const f32x4 v0 = acc[ai][bj][m][0], v1 = acc[ai][bj][m][1];
                    u32x4 w; w.x = cvt_pk_bf16(v0[0], v0[1]); w.y = cvt_pk_bf16(v0[2], v0[3]); w.z = cvt_pk_bf16(v1[0], v1[1]); w.w = cvt_pk_bf16(v1[2], v1[3]);
                    *(u32x4*)(rowp + bj * HALF) = w; } }
    }
};
struct EpiAttUp {
    static constexpr bool PERM = true;
    const bf16_t* PG; bf16_t* HB;
    __device__ __forceinline__ void operator()(const f32x4 (&acc)[2][2][4][2], const Unit& u, int wr, int wc, int fr, int fq) const {
        const int row0 = u.pm * BM + wr * 64 + fr; const int col0 = u.pn * BM + wc * 32 + 8 * fq;
#pragma unroll
        for (int ai = 0; ai < 2; ++ai)
#pragma unroll
            for (int m = 0; m < 4; ++m) { const size_t row = (size_t)(row0 + ai * HALF + m * 16);
#pragma unroll
                for (int bj = 0; bj < 2; ++bj) { const int col = col0 + bj * HALF;
                    const u32x4 gw = *(const u32x4*)(PG + row * 4096 + 2048 + col);
                    const f32x4 v0 = acc[ai][bj][m][0], v1 = acc[ai][bj][m][1];
                    u32x4 w;
                    w.x = cvt_pk_bf16(v0[0] * sigmoidf_(bf_lo(gw.x)), v0[1] * sigmoidf_(bf_hi(gw.x)));
                    w.y = cvt_pk_bf16(v0[2] * sigmoidf_(bf_lo(gw.y)), v0[3] * sigmoidf_(bf_hi(gw.y)));
                    w.z = cvt_pk_bf16(v1[0] * sigmoidf_(bf_lo(gw.z)), v1[1] * sigmoidf_(bf_hi(gw.z)));
                    w.w = cvt_pk_bf16(v1[2] * sigmoidf_(bf_lo(gw.w)), v1[3] * sigmoidf_(bf_hi(gw.w)));
                    *(u32x4*)(HB + row * 2048 + col) = w; } }
    }
};
struct EpiGlu {
    static constexpr bool PERM = true;
    const bf16_t* PG; bf16_t* HB;
    __device__ __forceinline__ void operator()(const f32x4 (&acc)[2][2][4][2], const Unit& u, int wr, int wc, int fr, int fq) const {
        const int row0 = u.pm * BM + wr * 64 + fr; const int col = u.pn * HALF + wc * 32 + 8 * fq;
#pragma unroll
        for (int ai = 0; ai < 2; ++ai)
#pragma unroll
            for (int m = 0; m < 4; ++m) { const size_t row = (size_t)(row0 + ai * HALF + m * 16);
                const u32x4 gw = *(const u32x4*)(PG + row * 4096 + col);
                const u32x4 aw = *(const u32x4*)(HB + row * 2048 + col);
                const f32x4 a0 = acc[ai][0][m][0], a1 = acc[ai][0][m][1], g0 = acc[ai][1][m][0], g1 = acc[ai][1][m][1];
                u32x4 w;
                w.x = cvt_pk_bf16(sigmoidf_(bf_lo(gw.x)) * a0[0] * sigmoidf_(g0[0]) + bf_lo(aw.x), sigmoidf_(bf_hi(gw.x)) * a0[1] * sigmoidf_(g0[1]) + bf_hi(aw.x));
                w.y = cvt_pk_bf16(sigmoidf_(bf_lo(gw.y)) * a0[2] * sigmoidf_(g0[2]) + bf_lo(aw.y), sigmoidf_(bf_hi(gw.y)) * a0[3] * sigmoidf_(g0[3]) + bf_hi(aw.y));
                w.z = cvt_pk_bf16(sigmoidf_(bf_lo(gw.z)) * a1[0] * sigmoidf_(g1[0]) + bf_lo(aw.z), sigmoidf_(bf_hi(gw.z)) * a1[1] * sigmoidf_(g1[1]) + bf_hi(aw.z));
                w.w = cvt_pk_bf16(sigmoidf_(bf_lo(gw.w)) * a1[2] * sigmoidf_(g1[2]) + bf_lo(aw.w), sigmoidf_(bf_hi(gw.w)) * a1[3] * sigmoidf_(g1[3]) + bf_hi(aw.w));
                *(u32x4*)(HB + row * 2048 + col) = w; }
    }
};
struct EpiOut {
    static constexpr bool PERM = true;
    const float* X; float* O; const float* mod;
    __device__ __forceinline__ void operator()(const f32x4 (&acc)[2][2][4][2], const Unit& u, int wr, int wc, int fr, int fq) const {
        const int row0 = u.pm * BM + wr * 64 + fr; const int col0 = u.pn * BM + wc * 32 + 8 * fq;
        const float* gt = mod + (size_t)((u.pm * BM) >> 13) * 12288 + 4096;
#pragma unroll
        for (int bj = 0; bj < 2; ++bj) { const int col = col0 + bj * HALF;
            const f32x4 g0 = *(const f32x4*)(gt + col), g1 = *(const f32x4*)(gt + col + 4);
#pragma unroll
            for (int ai = 0; ai < 2; ++ai)
#pragma unroll
                for (int m = 0; m < 4; ++m) { const size_t off = (size_t)(row0 + ai * HALF + m * 16) * 2048 + col;
                    const f32x4 x0 = *(const f32x4*)(X + off), x1 = *(const f32x4*)(X + off + 4);
                    *(f32x4*)(O + off) = x0 + g0 * acc[ai][bj][m][0]; *(f32x4*)(O + off + 4) = x1 + g1 * acc[ai][bj][m][1]; } }
    }
};
struct EpiF32 {
    static constexpr bool PERM = true;
    float* O;
    __device__ __forceinline__ void operator()(const f32x4 (&acc)[2][2][4][2], const Unit& u, int wr, int wc, int fr, int fq) const {
        const int row0 = u.pm * BM + wr * 64 + fr; const int col0 = u.pn * BM + wc * 32 + 8 * fq;
#pragma unroll
        for (int ai = 0; ai < 2; ++ai)
#pragma unroll
            for (int m = 0; m < 4; ++m) { float* rowp = O + (size_t)(row0 + ai * HALF + m * 16) * 2048 + col0;
#pragma unroll
                for (int bj = 0; bj < 2; ++bj) { *(f32x4*)(rowp + bj * HALF) = acc[ai][bj][m][0]; *(f32x4*)(rowp + bj * HALF + 4) = acc[ai][bj][m][1]; } }
    }
};
}

struct Args { const float* in[25]; float* out; unsigned char* ws; int ph_lo, ph_hi; };
enum { I_X = 0, I_C, I_WADA, I_BADA, I_N1G, I_WIN, I_LRE, I_LIM, I_LDT, I_BRE, I_BIM, I_CRE, I_CIM, I_SD, I_WGLU, I_QNG, I_KNG, I_WATT, I_WOUT, I_N2G, I_WQ, I_K1, I_K2, I_PU, I_PV };

__device__ __forceinline__ void ph_mod_partial(const float* __restrict__ c, const float* __restrict__ w_ada, float* modp, int gw, int ngw, int lane) {
    for (int task = gw; task < 48 * 32; task += ngw) {
        const int strip = task % 48, ks = task / 48, n0 = strip * 256 + lane * 4, k0 = ks * 64;
        f32x4 a0 = {0.f, 0.f, 0.f, 0.f}, a1 = {0.f, 0.f, 0.f, 0.f};
#pragma unroll 8
        for (int k = 0; k < 64; ++k) {
            const f32x4 w = *(const f32x4*)(w_ada + (size_t)(k0 + k) * 12288 + n0);
            float c0 = c[k0 + k], c1 = c[2048 + k0 + k];
            c0 = c0 / (1.0f + __expf(-c0)); c1 = c1 / (1.0f + __expf(-c1));
            a0 += c0 * w; a1 += c1 * w;
        }
        *(f32x4*)(modp + (size_t)(ks * 2 + 0) * 12288 + n0) = a0;
        *(f32x4*)(modp + (size_t)(ks * 2 + 1) * 12288 + n0) = a1;
    }
}

__device__ __forceinline__ void transpose_item(const float* __restrict__ W, int K, int N, bf16_t* WT, int drow0, int scol0, int k0, LAS float* scr, int lane) {
#pragma unroll 8
    for (int i = 0; i < 32; ++i) { const int kk = 2 * i + (lane >> 5); scr[kk * 33 + (lane & 31)] = W[(size_t)(k0 + kk) * N + scol0 + (lane & 31)]; }
    LDS_WAIT();
    const int c = lane & 7;
#pragma unroll
    for (int j = 0; j < 4; ++j) { const int n = (lane >> 3) + 8 * j; const LAS float* s = scr + (8 * c) * 33 + n;
        u32x4 o; o.x = cvt_pk_bf16(s[0 * 33], s[1 * 33]); o.y = cvt_pk_bf16(s[2 * 33], s[3 * 33]); o.z = cvt_pk_bf16(s[4 * 33], s[5 * 33]); o.w = cvt_pk_bf16(s[6 * 33], s[7 * 33]);
        *(u32x4*)(WT + (size_t)(drow0 + n) * K + k0 + 8 * c) = o; }
    LDS_WAIT();
}
__device__ __forceinline__ void ph_prologue(const Args& a, LAS unsigned char* lds, int gw, int ngw, int lane, int wave) {
    unsigned char* ws = a.ws;
    { const float* modp = (const float*)(ws + WS_MODP); float* mod = (float*)(ws + WS_MOD); const float* b_ada = a.in[I_BADA];
      for (int idx = gw * 64 + lane; idx < 2 * 12288; idx += ngw * 64) { const int b = idx / 12288, n = idx - b * 12288; float s = b_ada[n];
#pragma unroll 8
          for (int ks = 0; ks < 32; ++ks) s += modp[(size_t)(ks * 2 + b) * 12288 + n];
          mod[idx] = s; } }
    { bf16_t* WSC = (bf16_t*)(ws + WS_WSC);
      for (int item = gw; item < 512; item += ngw) {
          const int hj = item >> 5, kb = item & 31, k = kb * 64 + lane;
          const float* wq = a.in[I_WQ] + (size_t)k * 2048 + hj * 128;
          float w[128];
#pragma unroll
          for (int d = 0; d < 32; ++d) { const f32x4 v = *(const f32x4*)(wq + 4 * d); w[4 * d] = v[0]; w[4 * d + 1] = v[1]; w[4 * d + 2] = v[2]; w[4 * d + 3] = v[3]; }
          const float* kk = (hj & 1) ? a.in[I_K2] : a.in[I_K1];
          for (int key = 0; key < 128; ++key) {
              const float* kr = kk + key * 128;
              float s0 = 0.f, s1 = 0.f;
#pragma unroll
              for (int d = 0; d < 128; d += 2) { s0 += w[d] * kr[d]; s1 += w[d + 1] * kr[d + 1]; }
              WSC[(size_t)(hj * 128 + key) * 2048 + k] = (bf16_t)(cvt_pk_bf16(s0 + s1, 0.f) & 0xffffu);
          } } }
    { LAS float* scr = (LAS float*)(lds + wave * 8448);
      constexpr int I_IN = 32 * 256, I_GLU = 16 * 128, I_ATT = 16 * 64, I_OUT = 32 * 64, NIT = I_IN + I_GLU + I_ATT + I_OUT;
      for (int it = gw; it < NIT; it += ngw) {
          int r = it;
          if (r < I_IN) { const int kb = r / 256, nb = r % 256; transpose_item(a.in[I_WIN], 2048, 8192, (bf16_t*)(ws + WS_WIN), 32 * nb, 32 * nb, 64 * kb, scr, lane); continue; } r -= I_IN;
          if (r < I_GLU) { const int kb = r / 128, nb = r % 128, dr = 32 * nb; const int sc = ((dr >> 7) & 1) * 2048 + (dr >> 8) * 128 + (dr & 127);
              transpose_item(a.in[I_WGLU], 1024, 4096, (bf16_t*)(ws + WS_WGLU), dr, sc, 64 * kb, scr, lane); continue; } r -= I_GLU;
          if (r < I_ATT) { const int kb = r / 64, nb = r % 64; transpose_item(a.in[I_WATT], 1024, 2048, (bf16_t*)(ws + WS_WATT), 32 * nb, 32 * nb, 64 * kb, scr, lane); continue; } r -= I_ATT;
          { const int kb = r / 64, nb = r % 64; transpose_item(a.in[I_WOUT], 2048, 2048, (bf16_t*)(ws + WS_WOUT), 32 * nb, 32 * nb, 64 * kb, scr, lane); }
      } }
}

__device__ __forceinline__ void ph_norm(const float* X, bf16_t* Hout, const float* __restrict__ g, const float* mod, int sh_off, int sc_off, int gw, int ngw, int lane) {
    for (int row = gw; row < T_TOK; row += ngw) {
        const int b = row >> 13;
        const f32x4* xr = (const f32x4*)(X + (size_t)row * DM) + lane;
        f32x4 v[8]; float ss = 0.f;
#pragma unroll
        for (int j = 0; j < 8; ++j) { v[j] = xr[64 * j]; ss += (v[j][0] * v[j][0] + v[j][1] * v[j][1]) + (v[j][2] * v[j][2] + v[j][3] * v[j][3]); }
        ss = wave_sum(ss);
        const float rs = 1.0f / sqrtf(ss * (1.0f / DM) + EPS);
        const float* mb = mod + (size_t)b * 12288;
#pragma unroll
        for (int j = 0; j < 8; ++j) { const int col = 4 * (lane + 64 * j);
            const f32x4 gv = *(const f32x4*)(g + col), sc = *(const f32x4*)(mb + sc_off + col), sh = *(const f32x4*)(mb + sh_off + col);
            const f32x4 o = v[j] * rs * gv * (sc + 1.0f) + sh;
            u32x2 w; w.x = cvt_pk_bf16(o[0], o[1]); w.y = cvt_pk_bf16(o[2], o[3]);
            *(u32x2*)(Hout + (size_t)row * DM + col) = w; }
    }
}

__device__ __forceinline__ void ph_attn(LAS unsigned char* lds, const bf16_t* PA, bf16_t* ATT, const float* __restrict__ qg, const float* __restrict__ kg, int G) {
    const int tid = threadIdx.x, lane = tid & 63, wave = __builtin_amdgcn_readfirstlane(tid >> 6), c = lane & 15, g = lane >> 4;
    LAS unsigned char* KL = lds;
    LAS unsigned char* VT = lds + 17408;
    bf16x8 tri[6];
    { const int FS[6] = {0, 1, 0, 1, 2, 3}, FP[6] = {0, 0, 1, 1, 1, 1};
#pragma unroll
      for (int q = 0; q < 6; ++q)
#pragma unroll
          for (int jj = 0; jj < 8; ++jj) { const int kap = 32 * FP[q] + 16 * (jj >> 2) + 4 * g + (jj & 3); tri[q][jj] = (kap > 16 * FS[q] + c) ? (short)0x3F80 : (short)0; } }
    for (int u = blockIdx.x; u < 1024; u += G) {
        const int b = u >> 9, h = (u >> 6) & 7, qb = u & 63, t0 = qb * 128, tq0 = t0 + 16 * wave, tq = tq0 + c;
        bf16x8 qf[4];
        { const bf16_t* qrow = PA + (size_t)(b * SEQ + tq) * 4096 + 1024 + h * 128;
          u32x4 qr[4]; float ss = 0.f;
#pragma unroll
          for (int kk = 0; kk < 4; ++kk) { qr[kk] = *(const u32x4*)(qrow + 32 * kk + 8 * g);
#pragma unroll
              for (int e = 0; e < 4; ++e) { const float lo = bf_lo(qr[kk][e]), hi = bf_hi(qr[kk][e]); ss += lo * lo + hi * hi; } }
          ss += __shfl_xor(ss, 16); ss += __shfl_xor(ss, 32);
          const float rs = (1.0f / sqrtf(ss * (1.0f / 128.0f) + EPS)) * 0.08838834764831845f;
#pragma unroll
          for (int kk = 0; kk < 4; ++kk) { const f32x4 g0 = *(const f32x4*)(qg + 32 * kk + 8 * g), g1 = *(const f32x4*)(qg + 32 * kk + 8 * g + 4);
              u32x4 w;
              w.x = cvt_pk_bf16(bf_lo(qr[kk].x) * rs * g0[0], bf_hi(qr[kk].x) * rs * g0[1]);
              w.y = cvt_pk_bf16(bf_lo(qr[kk].y) * rs * g0[2], bf_hi(qr[kk].y) * rs * g0[3]);
              w.z = cvt_pk_bf16(bf_lo(qr[kk].z) * rs * g1[0], bf_hi(qr[kk].z) * rs * g1[1]);
              w.w = cvt_pk_bf16(bf_lo(qr[kk].w) * rs * g1[2], bf_hi(qr[kk].w) * rs * g1[3]);
              qf[kk] = __builtin_bit_cast(bf16x8, w); } }
        float carry = 0.f; int wdone = 0;
        f32x4 oacc[8];
#pragma unroll
        for (int fd = 0; fd < 8; ++fd) oacc[fd] = (f32x4){0.f, 0.f, 0.f, 0.f};
        for (int kt = 2 * qb + 1; kt >= 0; --kt) {
            const int k0 = kt * 64;
            if (__syncthreads_and(wdone)) break;
#pragma unroll
            for (int p = 0; p < 2; ++p) {
                const int ci = tid + 512 * p, key = ci >> 4, ch = ci & 15;
                const u32x4 kr = *(const u32x4*)(PA + (size_t)(b * SEQ + k0 + key) * 4096 + 2048 + h * 128 + 8 * ch);
                float f[8]; f[0] = bf_lo(kr.x); f[1] = bf_hi(kr.x); f[2] = bf_lo(kr.y); f[3] = bf_hi(kr.y); f[4] = bf_lo(kr.z); f[5] = bf_hi(kr.z); f[6] = bf_lo(kr.w); f[7] = bf_hi(kr.w);
                float ss = 0.f;
#pragma unroll
                for (int e = 0; e < 8; ++e) ss += f[e] * f[e];
                ss += __shfl_xor(ss, 1); ss += __shfl_xor(ss, 2); ss += __shfl_xor(ss, 4); ss += __shfl_xor(ss, 8);
                const float rs = 1.0f / sqrtf(ss * (1.0f / 128.0f) + EPS);
                const f32x4 g0 = *(const f32x4*)(kg + 8 * ch), g1 = *(const f32x4*)(kg + 8 * ch + 4);
                u32x4 w;
                w.x = cvt_pk_bf16(f[0] * rs * g0[0], f[1] * rs * g0[1]); w.y = cvt_pk_bf16(f[2] * rs * g0[2], f[3] * rs * g0[3]);
                w.z = cvt_pk_bf16(f[4] * rs * g1[0], f[5] * rs * g1[1]); w.w = cvt_pk_bf16(f[6] * rs * g1[2], f[7] * rs * g1[3]);
                *(LAS u32x4*)(KL + key * 272 + ch * 16) = w;
            }
#pragma unroll
            for (int p = 0; p < 2; ++p) {
                const int key = lane, ch = wave + 8 * p;
                const u32x4 vr = *(const u32x4*)(PA + (size_t)(b * SEQ + k0 + key) * 4096 + 3072 + h * 128 + 8 * ch);
                LAS unsigned short* vt = (LAS unsigned short*)(VT + (8 * ch) * 144 + key * 2);
                vt[0 * 72] = (unsigned short)(vr.x & 0xffffu); vt[1 * 72] = (unsigned short)(vr.x >> 16);
                vt[2 * 72] = (unsigned short)(vr.y & 0xffffu); vt[3 * 72] = (unsigned short)(vr.y >> 16);
                vt[4 * 72] = (unsigned short)(vr.z & 0xffffu); vt[5 * 72] = (unsigned short)(vr.z >> 16);
                vt[6 * 72] = (unsigned short)(vr.w & 0xffffu); vt[7 * 72] = (unsigned short)(vr.w >> 16);
            }
            __syncthreads();
            if (!wdone && k0 < tq0 + 15) {
                f32x4 zt[4];
#pragma unroll
                for (int f = 0; f < 4; ++f) { f32x4 acc = {0.f, 0.f, 0.f, 0.f};
#pragma unroll
                    for (int kk = 0; kk < 4; ++kk) { const bf16x8 kf = *(const LAS bf16x8*)(KL + (16 * f + c) * 272 + (32 * kk + 8 * g) * 2);
                        acc = __builtin_amdgcn_mfma_f32_16x16x32_bf16(kf, qf[kk], acc, 0, 0, 0); }
                    zt[f] = acc; }
                float lf[4][4], lz[4][4]; float tot = 0.f;
#pragma unroll
                for (int f = 0; f < 4; ++f)
#pragma unroll
                    for (int i = 0; i < 4; ++i) { const int s = k0 + 16 * f + 4 * g + i; const bool valid = s < tq; const float z = zt[f][i];
                        const float sp = fmaxf(z, 0.f) + __logf(1.0f + __expf(-fabsf(z)));
                        const float l = valid ? -sp : 0.f; lf[f][i] = l; lz[f][i] = valid ? (l + z) : -INFINITY; tot += l; }
                tot += __shfl_xor(tot, 16); tot += __shfl_xor(tot, 32);
                bf16x8 lh[2], ll[2];
#pragma unroll
                for (int fp = 0; fp < 2; ++fp) { u32x4 wh, wl;
#pragma unroll
                    for (int q = 0; q < 2; ++q) { const int f = 2 * fp + q;
                        const unsigned h0 = cvt_pk_bf16(lf[f][0], lf[f][1]), h1 = cvt_pk_bf16(lf[f][2], lf[f][3]);
                        const unsigned l0 = cvt_pk_bf16(lf[f][0] - bf_lo(h0), lf[f][1] - bf_hi(h0)), l1 = cvt_pk_bf16(lf[f][2] - bf_lo(h1), lf[f][3] - bf_hi(h1));
                        wh[2 * q] = h0; wh[2 * q + 1] = h1; wl[2 * q] = l0; wl[2 * q + 1] = l1; }
                    lh[fp] = __builtin_bit_cast(bf16x8, wh); ll[fp] = __builtin_bit_cast(bf16x8, wl); }
                f32x4 sf[4];
                { f32x4 z4 = {0.f, 0.f, 0.f, 0.f};
                  sf[0] = __builtin_amdgcn_mfma_f32_16x16x32_bf16(tri[0], lh[0], z4, 0, 0, 0); sf[0] = __builtin_amdgcn_mfma_f32_16x16x32_bf16(tri[0], ll[0], sf[0], 0, 0, 0);
                  sf[0] = __builtin_amdgcn_mfma_f32_16x16x32_bf16(tri[2], lh[1], sf[0], 0, 0, 0); sf[0] = __builtin_amdgcn_mfma_f32_16x16x32_bf16(tri[2], ll[1], sf[0], 0, 0, 0);
                  sf[1] = __builtin_amdgcn_mfma_f32_16x16x32_bf16(tri[1], lh[0], z4, 0, 0, 0); sf[1] = __builtin_amdgcn_mfma_f32_16x16x32_bf16(tri[1], ll[0], sf[1], 0, 0, 0);
                  sf[1] = __builtin_amdgcn_mfma_f32_16x16x32_bf16(tri[3], lh[1], sf[1], 0, 0, 0); sf[1] = __builtin_amdgcn_mfma_f32_16x16x32_bf16(tri[3], ll[1], sf[1], 0, 0, 0);
                  sf[2] = __builtin_amdgcn_mfma_f32_16x16x32_bf16(tri[4], lh[1], z4, 0, 0, 0); sf[2] = __builtin_amdgcn_mfma_f32_16x16x32_bf16(tri[4], ll[1], sf[2], 0, 0, 0);
                  sf[3] = __builtin_amdgcn_mfma_f32_16x16x32_bf16(tri[5], lh[1], z4, 0, 0, 0); sf[3] = __builtin_amdgcn_mfma_f32_16x16x32_bf16(tri[5], ll[1], sf[3], 0, 0, 0); }
                bf16x8 pb[2];
#pragma unroll
                for (int fp = 0; fp < 2; ++fp) { u32x4 w;
#pragma unroll
                    for (int q = 0; q < 2; ++q) { const int f = 2 * fp + q; float p[4];
#pragma unroll
                        for (int i = 0; i < 4; ++i) p[i] = __expf(lz[f][i] + sf[f][i] + carry);
                        w[2 * q] = cvt_pk_bf16(p[0], p[1]); w[2 * q + 1] = cvt_pk_bf16(p[2], p[3]); }
                    pb[fp] = __builtin_bit_cast(bf16x8, w); }
                carry += tot;
#pragma unroll
                for (int fd = 0; fd < 8; ++fd)
#pragma unroll
                    for (int fp = 0; fp < 2; ++fp) { const LAS unsigned char* vp = VT + (16 * fd + c) * 144 + (32 * fp + 4 * g) * 2;
                        const u32x2 v0 = *(const LAS u32x2*)vp, v1 = *(const LAS u32x2*)(vp + 32);
                        u32x4 vw; vw.x = v0.x; vw.y = v0.y; vw.z = v1.x; vw.w = v1.y;
                        oacc[fd] = __builtin_amdgcn_mfma_f32_16x16x32_bf16(__builtin_bit_cast(bf16x8, vw), pb[fp], oacc[fd], 0, 0, 0); }
                wdone = (__ballot(carry >= -105.0f) == 0ull) ? 1 : 0;
            }
        }
        { bf16_t* orow = ATT + (size_t)(b * SEQ + tq) * 1024 + h * 128 + 4 * g;
#pragma unroll
          for (int fd = 0; fd < 8; ++fd) { u32x2 w; w.x = cvt_pk_bf16(oacc[fd][0], oacc[fd][1]); w.y = cvt_pk_bf16(oacc[fd][2], oacc[fd][3]); *(u32x2*)(orow + 16 * fd) = w; } }
    }
    __syncthreads();
}

struct SsmP { float lbr, lbi; float bbr[16], bbi[16]; };
__device__ __forceinline__ void ssm_params(const Args& a, int g, int p, SsmP& P) {
    const float lr = a.in[I_LRE][g * 64 + p], li = a.in[I_LIM][g * 64 + p], dt = __expf(a.in[I_LDT][g]);
    const float mag = __expf(lr * dt);
    float rev = li * dt * 0.15915494309189535f; rev -= rintf(rev);
    const float sn = __builtin_amdgcn_sinf(rev), cs = __builtin_amdgcn_cosf(rev);
    P.lbr = mag * cs; P.lbi = mag * sn;
    const float nr = P.lbr - 1.0f, ni = P.lbi, den = 1.0f / (lr * lr + li * li);
    const float qr = (nr * lr + ni * li) * den, qi = (ni * lr - nr * li) * den;
    const float* br = a.in[I_BRE] + (size_t)(g * 64 + p) * 16; const float* bi = a.in[I_BIM] + (size_t)(g * 64 + p) * 16;
#pragma unroll
    for (int i = 0; i < 4; ++i) { const f32x4 r4 = *(const f32x4*)(br + 4 * i), i4 = *(const f32x4*)(bi + 4 * i);
#pragma unroll
        for (int e = 0; e < 4; ++e) { P.bbr[4 * i + e] = qr * r4[e] - qi * i4[e]; P.bbi[4 * i + e] = qr * i4[e] + qi * r4[e]; } }
}
__device__ __forceinline__ void ph_ssm_pass1(const Args& a, const bf16_t* PA, f32x2* E, int gw, int ngw, int lane) {
    for (int task = gw; task < 16384; task += ngw) {
        const int ci = task & 127, g = (task >> 7) & 63, b = task >> 13;
        SsmP P; ssm_params(a, g, lane, P);
        const bf16_t* urow = PA + (size_t)(b * SEQ + ci * 64 + lane) * 4096 + g * 16;
        const u32x4 ua = *(const u32x4*)urow, ub = *(const u32x4*)(urow + 8);
        float sr = 0.f, si = 0.f;
        for (int t = 0; t < 64; ++t) {
            unsigned uw[8];
            uw[0] = __builtin_amdgcn_readlane(ua.x, t); uw[1] = __builtin_amdgcn_readlane(ua.y, t); uw[2] = __builtin_amdgcn_readlane(ua.z, t); uw[3] = __builtin_amdgcn_readlane(ua.w, t);
            uw[4] = __builtin_amdgcn_readlane(ub.x, t); uw[5] = __builtin_amdgcn_readlane(ub.y, t); uw[6] = __builtin_amdgcn_readlane(ub.z, t); uw[7] = __builtin_amdgcn_readlane(ub.w, t);
            float bur = 0.f, bui = 0.f;
#pragma unroll
            for (int d = 0; d < 8; ++d) { const float u0 = bf_lo(uw[d]), u1 = bf_hi(uw[d]);
                bur += P.bbr[2 * d] * u0 + P.bbr[2 * d + 1] * u1; bui += P.bbi[2 * d] * u0 + P.bbi[2 * d + 1] * u1; }
            const float nr = P.lbr * sr - P.lbi * si + bur, ni = P.lbr * si + P.lbi * sr + bui; sr = nr; si = ni;
        }
        E[(size_t)((b * 64 + g) * 128 + ci) * 64 + lane] = (f32x2){sr, si};
    }
}
__device__ __forceinline__ void ph_ssm_pass3(const Args& a, const bf16_t* PA, const f32x2* E, bf16_t* YA, int gw, int ngw, int lane) {
    for (int task = gw; task < 16384; task += ngw) {
        const int ci = task & 127, g = (task >> 7) & 63, b = task >> 13;
        SsmP P; ssm_params(a, g, lane, P);
        float pr = P.lbr, pi = P.lbi;
#pragma unroll
        for (int q = 0; q < 6; ++q) { const float nr = pr * pr - pi * pi, ni = 2.0f * pr * pi; pr = nr; pi = ni; }
        float sr = 0.f, si = 0.f;
        { const f32x2* e = E + (size_t)((b * 64 + g) * 128) * 64 + lane;
          for (int cc = 0; cc < ci; ++cc) { const f32x2 ev = e[(size_t)cc * 64]; const float nr = pr * sr - pi * si + ev[0], ni = pr * si + pi * sr + ev[1]; sr = nr; si = ni; } }
        float cr[16], cim[16], d0[16];
#pragma unroll
        for (int i = 0; i < 16; ++i) { cr[i] = a.in[I_CRE][(size_t)(g * 16 + i) * 64 + lane]; cim[i] = a.in[I_CIM][(size_t)(g * 16 + i) * 64 + lane]; d0[i] = (lane == 0) ? a.in[I_SD][g * 16 + i] : 0.f; }
        const bf16_t* urow = PA + (size_t)(b * SEQ + ci * 64 + lane) * 4096 + g * 16;
        const u32x4 ua = *(const u32x4*)urow, ub = *(const u32x4*)(urow + 8);
        const int myi = ((lane >> 5) & 1) * 8 + ((lane >> 4) & 1) * 4 + ((lane >> 3) & 1) * 2 + ((lane >> 2) & 1);
        const bool h5 = lane & 32, h4 = lane & 16, h3 = lane & 8, h2 = lane & 4;
        for (int t = 0; t < 64; ++t) {
            unsigned uw[8];
            uw[0] = __builtin_amdgcn_readlane(ua.x, t); uw[1] = __builtin_amdgcn_readlane(ua.y, t); uw[2] = __builtin_amdgcn_readlane(ua.z, t); uw[3] = __builtin_amdgcn_readlane(ua.w, t);
            uw[4] = __builtin_amdgcn_readlane(ub.x, t); uw[5] = __builtin_amdgcn_readlane(ub.y, t); uw[6] = __builtin_amdgcn_readlane(ub.z, t); uw[7] = __builtin_amdgcn_readlane(ub.w, t);
            float uf[16]; float bur = 0.f, bui = 0.f;
#pragma unroll
            for (int d = 0; d < 8; ++d) { uf[2 * d] = bf_lo(uw[d]); uf[2 * d + 1] = bf_hi(uw[d]);
                bur += P.bbr[2 * d] * uf[2 * d] + P.bbr[2 * d + 1] * uf[2 * d + 1]; bui += P.bbi[2 * d] * uf[2 * d] + P.bbi[2 * d + 1] * uf[2 * d + 1]; }
            const float nr = P.lbr * sr - P.lbi * si + bur, ni = P.lbr * si + P.lbi * sr + bui; sr = nr; si = ni;
            float v[16];
#pragma unroll
            for (int i = 0; i < 16; ++i) v[i] = cr[i] * sr - cim[i] * si + d0[i] * uf[i];
            float w8[8], w4[4], w2[2], w1;
#pragma unroll
            for (int k = 0; k < 8; ++k) { const float keep = h5 ? v[k + 8] : v[k], send = h5 ? v[k] : v[k + 8]; w8[k] = keep + __shfl_xor(send, 32); }
#pragma unroll
            for (int k = 0; k < 4; ++k) { const float keep = h4 ? w8[k + 4] : w8[k], send = h4 ? w8[k] : w8[k + 4]; w4[k] = keep + __shfl_xor(send, 16); }
#pragma unroll
            for (int k = 0; k < 2; ++k) { const float keep = h3 ? w4[k + 2] : w4[k], send = h3 ? w4[k] : w4[k + 2]; w2[k] = keep + __shfl_xor(send, 8); }
            { const float keep = h2 ? w2[1] : w2[0], send = h2 ? w2[0] : w2[1]; w1 = keep + __shfl_xor(send, 4); }
            w1 += __shfl_xor(w1, 2); w1 += __shfl_xor(w1, 1);
            if ((lane & 3) == 0) YA[(size_t)(b * SEQ + ci * 64 + t) * 1024 + g * 16 + myi] = (bf16_t)(cvt_pk_bf16(gelu_tanh(w1), 0.f) & 0xffffu);
        }
    }
}

__device__ __forceinline__ void ph_table_cvt(const float* __restrict__ U, const float* __restrict__ V, bf16_t* UT, bf16_t* VT, int G) {
    const size_t n8 = (size_t)16384 * 2048 / 8, stride = (size_t)G * 512;
    for (size_t i = (size_t)blockIdx.x * 512 + threadIdx.x; i < 2 * n8; i += stride) {
        const bool sec = i >= n8; const size_t j = sec ? i - n8 : i;
        const float* src = (sec ? V : U) + j * 8; bf16_t* dst = (sec ? VT : UT) + j * 8;
        const f32x4 a0 = *(const f32x4*)src, a1 = *(const f32x4*)(src + 4);
        u32x4 w; w.x = cvt_pk_bf16(a0[0], a0[1]); w.y = cvt_pk_bf16(a0[2], a0[3]); w.z = cvt_pk_bf16(a1[0], a1[1]); w.w = cvt_pk_bf16(a1[2], a1[3]);
        *(u32x4*)dst = w;
    }
}

__device__ __forceinline__ void ph_peer(LAS unsigned char* lds, const float* SC, const bf16_t* H2, const bf16_t* UT, const bf16_t* VTb, const float* mod, float* OUT, int G) {
    const int tid = threadIdx.x, lane = tid & 63, wave = __builtin_amdgcn_readfirstlane(tid >> 6);
    LAS float* scr = (LAS float*)(lds + wave * 8448);
    LAS int* idxs = (LAS int*)(lds + 69632 + wave * 4096);
    LAS float* gates = (LAS float*)(lds + 69632 + wave * 4096 + 2048);
    LAS float* dotb = (LAS float*)(lds + 102400 + wave * 1024);
    for (int it = blockIdx.x; it < 512; it += G) {
        const int tokw = it * 32 + wave * 4;
        float tk[16];
#pragma unroll
        for (int i = 0; i < 16; ++i) tk[i] = -INFINITY;
        for (int q = 0; q < 4; ++q) {
#pragma unroll
            for (int j = 0; j < 8; ++j) { const int prob = (lane >> 3) + 8 * j, seg = lane & 7;
                const f32x4 v = *(const f32x4*)(SC + (size_t)(tokw + (prob >> 4)) * 2048 + (prob & 15) * 128 + 32 * q + 4 * seg);
                LAS float* d = scr + prob * 33 + 4 * seg; d[0] = v[0]; d[1] = v[1]; d[2] = v[2]; d[3] = v[3]; }
            LDS_WAIT();
#pragma unroll 4
            for (int vi = 0; vi < 32; ++vi) {
                float x = __uint_as_float((__float_as_uint(scr[lane * 33 + vi]) & ~127u) | (unsigned)(127 - (32 * q + vi)));
#pragma unroll
                for (int i = 0; i < 16; ++i) { const float hi = fmaxf(tk[i], x); x = fminf(tk[i], x); tk[i] = hi; }
            }
            LDS_WAIT();
        }
        float t2[16];
#pragma unroll
        for (int i = 0; i < 16; ++i) t2[i] = __shfl_xor(tk[i], 1);
        float bv[16]; int bp[16];
#pragma unroll
        for (int i = 0; i < 16; ++i) { bv[i] = -INFINITY; bp[i] = 0; }
#pragma unroll
        for (int aa = 0; aa < 16; ++aa)
#pragma unroll
            for (int bb = 0; bb < 16 / (aa + 1); ++bb) {
                const unsigned u1 = __float_as_uint(tk[aa]), u2 = __float_as_uint(t2[bb]);
                float x = __uint_as_float(u1 & ~127u) + __uint_as_float(u2 & ~127u);
                int px = (int)(((127u - (u1 & 127u)) << 7) | (127u - (u2 & 127u)));
#pragma unroll
                for (int i = 0; i < 16; ++i) { const bool gt = x > bv[i]; const float nv = gt ? x : bv[i], ox = gt ? bv[i] : x; const int np = gt ? px : bp[i], op = gt ? bp[i] : px;
                    bv[i] = nv; x = ox; bp[i] = np; px = op; }
            }
        { float e[16], sum = 0.f;
#pragma unroll
          for (int i = 0; i < 16; ++i) { e[i] = __expf(bv[i] - bv[0]); sum += e[i]; }
          const float inv = 1.0f / sum;
          if ((lane & 1) == 0) { const int tl = lane >> 4, head = (lane & 15) >> 1;
#pragma unroll
              for (int i = 0; i < 16; ++i) { idxs[tl * 128 + head * 16 + i] = bp[i]; gates[tl * 128 + head * 16 + i] = e[i] * inv; } } }
        LDS_WAIT();
        for (int tl = 0; tl < 4; ++tl) {
            const int token = tokw + tl;
            float hf[32];
            { const bf16_t* hrow = H2 + (size_t)token * 2048 + 8 * lane;
#pragma unroll
              for (int j = 0; j < 4; ++j) { const u32x4 w = *(const u32x4*)(hrow + 512 * j);
                  hf[8 * j + 0] = bf_lo(w.x); hf[8 * j + 1] = bf_hi(w.x); hf[8 * j + 2] = bf_lo(w.y); hf[8 * j + 3] = bf_hi(w.y);
                  hf[8 * j + 4] = bf_lo(w.z); hf[8 * j + 5] = bf_hi(w.z); hf[8 * j + 6] = bf_lo(w.w); hf[8 * j + 7] = bf_hi(w.w); } }
            for (int grp = 0; grp < 32; ++grp) {
                u32x4 ld[4][4];
#pragma unroll
                for (int r = 0; r < 4; ++r) { const int e = __builtin_amdgcn_readfirstlane(idxs[tl * 128 + grp * 4 + r]);
                    const bf16_t* urow = UT + (size_t)e * 2048 + 8 * lane;
#pragma unroll
                    for (int j = 0; j < 4; ++j) ld[r][j] = *(const u32x4*)(urow + 512 * j); }
                float pt[4];
#pragma unroll
                for (int r = 0; r < 4; ++r) { float s0 = 0.f, s1 = 0.f;
#pragma unroll
                    for (int j = 0; j < 4; ++j) { const u32x4 w = ld[r][j];
                        s0 += bf_lo(w.x) * hf[8 * j + 0]; s1 += bf_hi(w.x) * hf[8 * j + 1]; s0 += bf_lo(w.y) * hf[8 * j + 2]; s1 += bf_hi(w.y) * hf[8 * j + 3];
                        s0 += bf_lo(w.z) * hf[8 * j + 4]; s1 += bf_hi(w.z) * hf[8 * j + 5]; s0 += bf_lo(w.w) * hf[8 * j + 6]; s1 += bf_hi(w.w) * hf[8 * j + 7]; }
                    pt[r] = s0 + s1; }
                const bool h5 = lane & 32, h4 = lane & 16;
                float w2[2], w1;
#pragma unroll
                for (int k = 0; k < 2; ++k) { const float keep = h5 ? pt[k + 2] : pt[k], send = h5 ? pt[k] : pt[k + 2]; w2[k] = keep + __shfl_xor(send, 32); }
                { const float keep = h4 ? w2[1] : w2[0], send = h4 ? w2[0] : w2[1]; w1 = keep + __shfl_xor(send, 16); }
                w1 += __shfl_xor(w1, 8); w1 += __shfl_xor(w1, 4); w1 += __shfl_xor(w1, 2); w1 += __shfl_xor(w1, 1);
                if ((lane & 15) == 0) dotb[grp * 4 + ((lane >> 5) & 1) * 2 + ((lane >> 4) & 1)] = w1;
            }
            LDS_WAIT();
            { const float d0 = dotb[lane], d1 = dotb[lane + 64]; const float a0 = gates[tl * 128 + lane] * gelu_tanh(d0), a1 = gates[tl * 128 + lane + 64] * gelu_tanh(d1);
              LDS_WAIT(); dotb[lane] = a0; dotb[lane + 64] = a1; }
            LDS_WAIT();
            float acc[32];
#pragma unroll
            for (int i = 0; i < 32; ++i) acc[i] = 0.f;
            for (int grp = 0; grp < 32; ++grp) {
                u32x4 ld[4][4];
#pragma unroll
                for (int r = 0; r < 4; ++r) { const int e = __builtin_amdgcn_readfirstlane(idxs[tl * 128 + grp * 4 + r]);
                    const bf16_t* vrow = VTb + (size_t)e * 2048 + 8 * lane;
#pragma unroll
                    for (int j = 0; j < 4; ++j) ld[r][j] = *(const u32x4*)(vrow + 512 * j); }
#pragma unroll
                for (int r = 0; r < 4; ++r) { const float ar = dotb[grp * 4 + r];
#pragma unroll
                    for (int j = 0; j < 4; ++j) { const u32x4 w = ld[r][j];
                        acc[8 * j + 0] += ar * bf_lo(w.x); acc[8 * j + 1] += ar * bf_hi(w.x); acc[8 * j + 2] += ar * bf_lo(w.y); acc[8 * j + 3] += ar * bf_hi(w.y);
                        acc[8 * j + 4] += ar * bf_lo(w.z); acc[8 * j + 5] += ar * bf_hi(w.z); acc[8 * j + 6] += ar * bf_lo(w.w); acc[8 * j + 7] += ar * bf_hi(w.w); } }
            }
            { const int b = token >> 13; const float* gt2 = mod + (size_t)b * 12288 + 10240 + 8 * lane; float* orow = OUT + (size_t)token * 2048 + 8 * lane;
#pragma unroll
              for (int j = 0; j < 4; ++j) { const f32x4 x0 = *(const f32x4*)(orow + 512 * j), x1 = *(const f32x4*)(orow + 512 * j + 4);
                  const f32x4 g0 = *(const f32x4*)(gt2 + 512 * j), g1 = *(const f32x4*)(gt2 + 512 * j + 4);
                  f32x4 o0, o1;
#pragma unroll
                  for (int e = 0; e < 4; ++e) { o0[e] = x0[e] + g0[e] * acc[8 * j + e]; o1[e] = x1[e] + g1[e] * acc[8 * j + 4 + e]; }
                  *(f32x4*)(orow + 512 * j) = o0; *(f32x4*)(orow + 512 * j + 4) = o1; } }
            LDS_WAIT();
        }
    }
}

__global__ void __launch_bounds__(512, 2) mk_fwd(Args args) {
    extern __shared__ __attribute__((aligned(16))) unsigned char lds_raw[];
    LAS unsigned char* lds = (LAS unsigned char*)lds_raw;
    const int tid = threadIdx.x, lane = tid & 63, wave = __builtin_amdgcn_readfirstlane(tid >> 6);
    const int G = gridDim.x, gw = blockIdx.x * 8 + wave, ngw = G * 8;
    unsigned char* ws = args.ws;
    volatile LAS unsigned* misc = (volatile LAS unsigned*)(lds + LDS_MAIN);
    if (tid < 4) misc[tid] = 0u;
    __syncthreads();
    const int lo = args.ph_lo, hi = args.ph_hi;
    XcdBarrier bar; bar.bar = (unsigned*)(ws + WS_CTL); bar.x = 0; bar.st = misc;
    if (hi - lo > 1) bar = xcd_barrier_post((unsigned*)(ws + WS_CTL), misc);
#define IN(k) (lo <= (k) && (k) < hi)
#define SEAM(k) do { if (IN(k) && IN((k) + 1)) xcd_barrier(bar); } while (0)
    float* mod = (float*)(ws + WS_MOD);
    bf16_t* HB = (bf16_t*)(ws + WS_H); bf16_t* PA = (bf16_t*)(ws + WS_PA); bf16_t* PG = (bf16_t*)(ws + WS_PG);
    bf16_t* YA = (bf16_t*)(ws + WS_YA); bf16_t* ATT = (bf16_t*)(ws + WS_ATT); f32x2* EB = (f32x2*)(ws + WS_E);

    if (IN(0)) { ph_mod_partial(args.in[I_C], args.in[I_WADA], (float*)(ws + WS_MODP), gw, ngw, lane); }
    SEAM(0);
    if (IN(1)) { ph_prologue(args, lds, gw, ngw, lane, wave); }
    SEAM(1);
    if (IN(2)) { ph_norm(args.in[I_X], HB, args.in[I_N1G], mod, 0, 2048, gw, ngw, lane); }
    SEAM(2);
    if (IN(3)) { pg8::Gemm g{HB, (const bf16_t*)(ws + WS_WIN), T_TOK, 8192, 2048}; pg8::StaticOrder S; S.init(T_TOK, 8192, G, (int)blockIdx.x);
        pg8::EpiProj E{PA, PG}; pg8::gemm_phase<pg8::EpiProj, pg8::StaticOrder, true, true>(lds, g, S, E); }
    SEAM(3);
    if (IN(4)) { ph_attn(lds, PA, ATT, args.in[I_QNG], args.in[I_KNG], G); ph_ssm_pass1(args, PA, EB, gw, ngw, lane); }
    SEAM(4);
    if (IN(5)) { ph_ssm_pass3(args, PA, EB, YA, gw, ngw, lane); __syncthreads();
        pg8::Gemm g{ATT, (const bf16_t*)(ws + WS_WATT), T_TOK, 2048, 1024}; pg8::StaticOrder S; S.init(T_TOK, 2048, G, (int)blockIdx.x);
        pg8::EpiAttUp E{PG, HB}; pg8::gemm_phase<pg8::EpiAttUp, pg8::StaticOrder, true, true>(lds, g, S, E); }
    SEAM(5);
    if (IN(6)) { pg8::Gemm g{YA, (const bf16_t*)(ws + WS_WGLU), T_TOK, 4096, 1024}; pg8::StaticOrder S; S.init(T_TOK, 4096, G, (int)blockIdx.x);
        pg8::EpiGlu E{PG, HB}; pg8::gemm_phase<pg8::EpiGlu, pg8::StaticOrder, true, true>(lds, g, S, E); }
    SEAM(6);
    if (IN(7)) { pg8::Gemm g{HB, (const bf16_t*)(ws + WS_WOUT), T_TOK, 2048, 2048}; pg8::StaticOrder S; S.init(T_TOK, 2048, G, (int)blockIdx.x);
        pg8::EpiOut E{args.in[I_X], args.out, mod}; pg8::gemm_phase<pg8::EpiOut, pg8::StaticOrder, true, true>(lds, g, S, E);
        ph_table_cvt(args.in[I_PU], args.in[I_PV], (bf16_t*)(ws + WS_UT), (bf16_t*)(ws + WS_VT), G); }
    SEAM(7);
    if (IN(8)) { ph_norm(args.out, HB, args.in[I_N2G], mod, 6144, 8192, gw, ngw, lane); }
    SEAM(8);
    if (IN(9)) { pg8::Gemm g{HB, (const bf16_t*)(ws + WS_WSC), T_TOK, 2048, 2048}; pg8::StaticOrder S; S.init(T_TOK, 2048, G, (int)blockIdx.x);
        pg8::EpiF32 E{(float*)(ws + WS_SC)}; pg8::gemm_phase<pg8::EpiF32, pg8::StaticOrder, true, true>(lds, g, S, E); }
    SEAM(9);
    if (IN(10)) { ph_peer(lds, (const float*)(ws + WS_SC), HB, (const bf16_t*)(ws + WS_UT), (const bf16_t*)(ws + WS_VT), mod, args.out, G); }
#undef IN
#undef SEAM
}

extern "C" void kernel_launch(void* const* d_in, const int* in_sizes, int n_in, void* d_out, int out_size, void* d_ws, size_t ws_size, hipStream_t stream) {
    static int grid = 0;
    if (grid == 0) {
        if (n_in != 25 || out_size != T_TOK * DM || ws_size < WS_END) { fprintf(stderr, "kernel_launch: unexpected shapes (n_in %d out %d ws %zu need %zu)\n", n_in, out_size, ws_size, (size_t)WS_END); grid = -1; return; }
        int dev = 0, cus = 0, per_cu = 0;
        if (hipGetDevice(&dev) != hipSuccess || hipDeviceGetAttribute(&cus, hipDeviceAttributeMultiprocessorCount, dev) != hipSuccess) { grid = -1; return; }
        if (hipFuncSetAttribute((const void*)mk_fwd, hipFuncAttributeMaxDynamicSharedMemorySize, LDS_BYTES) != hipSuccess) { fprintf(stderr, "kernel_launch: hipFuncSetAttribute failed\n"); grid = -1; return; }
        if (hipOccupancyMaxActiveBlocksPerMultiprocessor(&per_cu, (const void*)mk_fwd, 512, LDS_BYTES) != hipSuccess || per_cu < 1) { fprintf(stderr, "kernel_launch: occupancy query says %d blocks/CU\n", per_cu); (void)hipGetLastError(); grid = -1; return; }
        grid = cus;
    }
    if (grid < 0) return;
    (void)hipMemsetAsync((char*)d_ws + WS_CTL, 0, 16384, stream);
    Args a{};
    for (int i = 0; i < 25; ++i) a.in[i] = (const float*)d_in[i];
    a.out = (float*)d_out; a.ws = (unsigned char*)d_ws;
#if MK_PER_PHASE
    for (int ph = 0; ph < NPHASE; ++ph) { a.ph_lo = ph; a.ph_hi = ph + 1; hipLaunchKernelGGL(mk_fwd, dim3(grid), dim3(512), LDS_BYTES, stream, a); }
#else
    a.ph_lo = 0; a.ph_hi = NPHASE;
    hipLaunchKernelGGL(mk_fwd, dim3(grid), dim3(512), LDS_BYTES, stream, a);
#endif
}
```

```cpp
#include <hip/hip_runtime.h>
#include <cstdio>
#include <cstdint>

#ifndef MK_PER_PHASE
#define MK_PER_PHASE 0
#endif

#define LAS __attribute__((address_space(3)))
typedef unsigned short bf16_t;
typedef short bf16x8 __attribute__((ext_vector_type(8)));
typedef float f32x4 __attribute__((ext_vector_type(4)));
typedef float f32x2 __attribute__((ext_vector_type(2)));
typedef unsigned u32x4 __attribute__((ext_vector_type(4)));
typedef unsigned u32x2 __attribute__((ext_vector_type(2)));

constexpr int T_TOK = 16384, DM = 2048, SEQ = 8192;
constexpr int NPHASE = 11;
constexpr float EPS = 1e-6f;

constexpr size_t WS_CTL   = 0;
constexpr size_t WS_MODP  = 65536;
constexpr size_t WS_MOD   = WS_MODP + (size_t)32 * 2 * 12288 * 4;
constexpr size_t WS_WIN   = WS_MOD + (size_t)2 * 12288 * 4;
constexpr size_t WS_WGLU  = WS_WIN + (size_t)8192 * 2048 * 2;
constexpr size_t WS_WATT  = WS_WGLU + (size_t)4096 * 1024 * 2;
constexpr size_t WS_WOUT  = WS_WATT + (size_t)2048 * 1024 * 2;
constexpr size_t WS_WSC   = WS_WOUT + (size_t)2048 * 2048 * 2;
constexpr size_t WS_H     = WS_WSC + (size_t)2048 * 2048 * 2;
constexpr size_t WS_PA    = WS_H + (size_t)T_TOK * 2048 * 2;
constexpr size_t WS_PG    = WS_PA + (size_t)T_TOK * 4096 * 2;
constexpr size_t WS_E     = WS_PG + (size_t)T_TOK * 4096 * 2;
constexpr size_t WS_YA    = WS_E + (size_t)2 * 64 * 128 * 64 * 8;
constexpr size_t WS_ATT   = WS_YA + (size_t)T_TOK * 1024 * 2;
constexpr size_t WS_END   = WS_ATT + (size_t)T_TOK * 1024 * 2;
constexpr size_t WS_SC    = WS_PA;
constexpr size_t WS_UT    = WS_PG;
constexpr size_t WS_VT    = WS_PG + (size_t)16384 * 2048;

constexpr int LDS_MAIN = 131072, LDS_BYTES = LDS_MAIN + 256;

__device__ __forceinline__ unsigned cvt_pk_bf16(float lo, float hi) { unsigned r; asm volatile("v_cvt_pk_bf16_f32 %0, %1, %2" : "=v"(r) : "v"(lo), "v"(hi)); return r; }
__device__ __forceinline__ float bf_lo(unsigned w) { return __uint_as_float(w << 16); }
__device__ __forceinline__ float bf_hi(unsigned w) { return __uint_as_float(w & 0xffff0000u); }
__device__ __forceinline__ float wave_sum(float v) {
#pragma unroll
    for (int o = 1; o < 64; o <<= 1) v += __shfl_xor(v, o);
    return v;
}
__device__ __forceinline__ float sigmoidf_(float x) { return 1.0f / (1.0f + __expf(-x)); }
__device__ __forceinline__ float gelu_tanh(float x) {
    const float a = 0.7978845608028654f * (x + 0.044715f * x * x * x);
    const float t = 1.0f - 2.0f / (__expf(2.0f * a) + 1.0f);
    return 0.5f * x * (1.0f + t);
}
#define LDS_WAIT() asm volatile("s_waitcnt lgkmcnt(0)" ::: "memory")

#define XB_TMO      128
#define XB_XCNT(j)  (256  + 64 * (j))
#define XB_XSUB(j)  (1280 + 64 * (j))
#define XB_XGEN(j)  (2304 + 64 * (j))
#define XB_TOP      3328
#define XB_TOPGEN   3392
#define XCD_BAR_WORDS 3456
#define XB_SPIN_CAP (1u << 22)
__device__ __forceinline__ unsigned xb_ld(unsigned* p)              { return __hip_atomic_load(p, __ATOMIC_RELAXED, __HIP_MEMORY_SCOPE_AGENT); }
__device__ __forceinline__ unsigned xb_add(unsigned* p, unsigned v) { return __hip_atomic_fetch_add(p, v, __ATOMIC_RELAXED, __HIP_MEMORY_SCOPE_AGENT); }
__device__ __forceinline__ unsigned xb_xcc_id() { return (unsigned)__builtin_amdgcn_s_getreg((3 << 11) | 20) & 0xFu; }
#define XB_SPIN(cond, bar) do { unsigned _sp = 0; while (cond) { __builtin_amdgcn_s_sleep(1); \
    if ((++_sp & 255u) == 0u) { if (xb_ld(&(bar)[XB_TMO])) break; if (_sp > XB_SPIN_CAP) { atomicAdd(&(bar)[XB_TMO], 1u); break; } } } } while (0)
struct XcdBarrier { unsigned* bar; unsigned x; volatile LAS unsigned* st; };
__device__ __forceinline__ XcdBarrier xcd_barrier_post(unsigned* bar, volatile LAS unsigned* st) {
    XcdBarrier b; b.bar = bar; b.x = xb_xcc_id(); b.st = st;
    if (threadIdx.x == 0) (void)xb_add(&bar[XB_XCNT(b.x)], 1u);
    return b;
}
__device__ __forceinline__ void xcd_barrier_complete(unsigned* bar, unsigned x, unsigned& nloc, unsigned& nx) {
    const unsigned G = gridDim.x * gridDim.y * gridDim.z;
    unsigned sum, cnt, mine, sp = 0u;
    for (;;) {
        sum = 0u; cnt = 0u; mine = 0u;
#pragma unroll
        for (unsigned j = 0; j < 16; ++j) { const unsigned c = xb_ld(&bar[XB_XCNT(j)]); sum += c; cnt += (c > 0u) ? 1u : 0u; mine = (j == x) ? c : mine; }
        if (sum == G) break;
        __builtin_amdgcn_s_sleep(1);
        if ((++sp & 255u) == 0u) { if (xb_ld(&bar[XB_TMO])) break; if (sp > XB_SPIN_CAP) { atomicAdd(&bar[XB_TMO], 1u); break; } }
    }
    nloc = mine > 0u ? mine : 1u; nx = cnt > 0u ? cnt : 1u;
}
__device__ __forceinline__ void xcd_barrier(const XcdBarrier& b) {
    asm volatile("s_waitcnt vmcnt(0)" ::: "memory");
    __syncthreads();
    if (threadIdx.x == 0) {
        unsigned* bar = b.bar;
        __builtin_amdgcn_s_waitcnt(0);
        unsigned nloc = b.st[0], nx = b.st[1];
        if (nloc == 0u) { xcd_barrier_complete(bar, b.x, nloc, nx); b.st[0] = nloc; b.st[1] = nx; }
        const unsigned old = xb_add(&bar[XB_XSUB(b.x)], 1u);
        const unsigned gen = old / nloc;
        if (old + 1u == (gen + 1u) * nloc) {
            __builtin_amdgcn_fence(__ATOMIC_RELEASE, "agent");
            asm volatile("s_waitcnt vmcnt(0)" ::: "memory");
            const unsigned og = xb_add(&bar[XB_TOP], 1u);
            const unsigned tg = og / nx;
            if (og + 1u == (tg + 1u) * nx) xb_add(&bar[XB_TOPGEN], 1u);
            else XB_SPIN(xb_ld(&bar[XB_TOPGEN]) == tg, bar);
            __builtin_amdgcn_fence(__ATOMIC_ACQUIRE, "agent");
            xb_add(&bar[XB_XGEN(b.x)], 1u);
            asm volatile("s_waitcnt vmcnt(0)" ::: "memory");
        } else {
            XB_SPIN(xb_ld(&bar[XB_XGEN(b.x)]) == gen, bar);
            __builtin_amdgcn_fence(__ATOMIC_ACQUIRE, "agent");
            asm volatile("s_waitcnt vmcnt(0)" ::: "memory");
        }
    }
    __syncthreads();
}

namespace pg8 {
constexpr int BM = 256, BK = 64, HALF = 128, HTB = HALF * BK * 2, STAGE_BYTES = 8 * HTB, NXCD = 8, WGM = 8;
__host__ __device__ __forceinline__ int lds_byte(int r, int c) { const int st = (r >> 4) * 2 + (c >> 5), rr = r & 15, cc = c & 31, ob = rr * 64 + cc * 2; return st * 1024 + (ob ^ (((ob >> 9) & 1) << 5)); }
__host__ __device__ __forceinline__ void stage_rc(int b, int& R, int& C) { const int st = b / 1024, sb = b % 1024, swz = sb ^ (((sb >> 9) & 1) << 5); R = (st >> 1) * 16 + swz / 64; C = (st & 1) * 32 + (swz % 64) / 2; }
__host__ __device__ __forceinline__ int perm32(int rho) { const int n = rho >> 4, i = rho & 15; return 8 * (i >> 2) + 4 * n + (i & 3); }
struct Unit { int pm, pn; };
struct Gemm { const bf16_t* A; const bf16_t* Bt; int M, N, K; };
struct StaticOrder {
    int nM, nN, nwg, G, c;
    __host__ __device__ void init(int M, int N, int G_, int c_) { nM = M / BM; nN = N / BM; nwg = nM * nN; G = G_; c = c_; }
    __host__ __device__ bool next(int i, Unit& u) const {
        const long L = (long)i * G + c; if (L >= nwg) return false;
        int wgid = (int)L; { const int q = nwg / NXCD, r = nwg % NXCD, xcd = wgid % NXCD, off = wgid / NXCD; wgid = (xcd < r ? xcd * (q + 1) : r * (q + 1) + (xcd - r) * q) + off; }
        const int nig = WGM * nN, gid = wgid / nig, fm = gid * WGM, gsz = (nM - fm) < WGM ? (nM - fm) : WGM;
        u.pm = fm + ((wgid % nig) % gsz); u.pn = (wgid % nig) / gsz; return true;
    }
    __device__ __forceinline__ void a_ready(const Unit&) const {}
    __device__ __forceinline__ void done(const Unit&) const {}
};
template <class Epi, class Sched, bool ALIGN_EPI = false, bool SP2 = false>
__device__ __forceinline__ void gemm_phase(LAS unsigned char* lds, const Gemm g, const Sched& S, const Epi& E) {
    const int tid = threadIdx.x, wid = __builtin_amdgcn_readfirstlane(tid >> 6), lane = tid & 63, wr = wid >> 2, wc = wid & 3, fr = lane & 15, fq = lane >> 4;
    const int K = g.K, nt = K / BK;
    unsigned voffA[2], voffB[2];
#pragma unroll
    for (int i = 0; i < 2; ++i) { int R, C; stage_rc(tid * 16 + i * 8192, R, C); const int Rb = Epi::PERM ? ((R & ~31) + perm32(R & 31)) : R;
        voffA[i] = (unsigned)(R * K + C) * 2u; voffB[i] = (unsigned)(Rb * K + C) * 2u; }
    const size_t kstep = (size_t)(BK * 2);
    const size_t hstep = (size_t)HALF * K * 2;
    const size_t tstep = 2 * hstep;
    const unsigned ldsw = (unsigned)wid * 1024u;
    const int aoff = lds_byte(wr * 64 + fr, fq * 8), boff = lds_byte(wc * 32 + fr, fq * 8);
#define PG8_SA(b, h) (((b) * 2 + (h)) * HTB)
#define PG8_SB(b, h) ((4 + (b) * 2 + (h)) * HTB)
#define PG8_STAGE(bufoff, gbase, voff) do { _Pragma("unroll") for (int _i = 0; _i < 2; ++_i) \
        __builtin_amdgcn_global_load_lds((const unsigned*)((const char*)(gbase) + (voff)[_i]), (LAS unsigned*)(lds + (bufoff) + ldsw + _i * 8192), 16, 0, 0); } while (0)
#define PG8_LDA(dst, b, h) do { _Pragma("unroll") for (int m = 0; m < 4; ++m) _Pragma("unroll") for (int k = 0; k < 2; ++k) dst[m][k] = *(const LAS bf16x8*)(lds + PG8_SA(b, h) + aoff + m * 2048 + k * 1024); } while (0)
#define PG8_LDB(dst, b, h) do { _Pragma("unroll") for (int n = 0; n < 2; ++n) _Pragma("unroll") for (int k = 0; k < 2; ++k) dst[n][k] = *(const LAS bf16x8*)(lds + PG8_SB(b, h) + boff + n * 2048 + k * 1024); } while (0)
#define PG8_MMA(ai, bj, At, Bt) do { __builtin_amdgcn_s_setprio(1); _Pragma("unroll") for (int m = 0; m < 4; ++m) _Pragma("unroll") for (int n = 0; n < 2; ++n) _Pragma("unroll") for (int k = 0; k < 2; ++k) \
        acc[ai][bj][m][n] = __builtin_amdgcn_mfma_f32_16x16x32_bf16(Bt[n][k], At[m][k], acc[ai][bj][m][n], 0, 0, 0); __builtin_amdgcn_s_setprio(0); } while (0)
#define PG8_WAIT_V(n) asm volatile("s_waitcnt vmcnt(" #n ")" ::: "memory")
#define PG8_WAIT_L(n) asm volatile("s_waitcnt lgkmcnt(" #n ")" ::: "memory")
#define PG8_BAR __builtin_amdgcn_s_barrier()
#define PG8_SCHED __builtin_amdgcn_sched_barrier(0)
    Unit cur, nxt; int ui = 0;
    if (!S.next(0, cur)) return;
    f32x4 acc[2][2][4][2];
#pragma unroll
    for (int a = 0; a < 2; ++a)
#pragma unroll
        for (int b = 0; b < 2; ++b)
#pragma unroll
            for (int m = 0; m < 4; ++m)
#pragma unroll
                for (int n = 0; n < 2; ++n) acc[a][b][m][n] = (f32x4){0.f, 0.f, 0.f, 0.f};
    bf16x8 At[4][2], B0[2][2], B1[2][2];
    const char* cA = (const char*)g.A + (size_t)cur.pm * tstep; const char* cB = (const char*)g.Bt + (size_t)cur.pn * tstep;
    S.a_ready(cur);
    if constexpr (SP2) {
        PG8_STAGE(PG8_SB(0, 0), cB, voffB); PG8_STAGE(PG8_SB(0, 1), cB + hstep, voffB); PG8_STAGE(PG8_SA(0, 0), cA, voffA); PG8_STAGE(PG8_SA(0, 1), cA + hstep, voffA);
        if (wr == 1) PG8_BAR;
        PG8_WAIT_V(2); PG8_BAR;
        PG8_STAGE(PG8_SB(1, 0), cB + kstep, voffB); PG8_STAGE(PG8_SA(1, 0), cA + kstep, voffA); PG8_STAGE(PG8_SB(1, 1), cB + hstep + kstep, voffB);
        PG8_WAIT_V(6); PG8_BAR;
    } else {
        PG8_STAGE(PG8_SB(0, 0), cB, voffB); PG8_STAGE(PG8_SA(0, 0), cA, voffA); PG8_STAGE(PG8_SB(0, 1), cB + hstep, voffB); PG8_STAGE(PG8_SA(0, 1), cA + hstep, voffA);
        if (wr == 1) PG8_BAR;
        PG8_WAIT_V(4); PG8_BAR;
        PG8_STAGE(PG8_SB(1, 0), cB + kstep, voffB); PG8_STAGE(PG8_SA(1, 0), cA + kstep, voffA); PG8_STAGE(PG8_SB(1, 1), cB + hstep + kstep, voffB);
        PG8_WAIT_V(6); PG8_BAR;
    }
    for (;;) {
        const bool has_next = S.next(ui + 1, nxt);
        const char* nA = has_next ? (const char*)g.A + (size_t)nxt.pm * tstep : cA; const char* nB = has_next ? (const char*)g.Bt + (size_t)nxt.pn * tstep : cB;
        for (int t = 0; t < nt; t += 2) {
            const bool last = (t == nt - 2);
            const char* a1 = cA + (size_t)(t + 1) * kstep;
            const char* a2 = last ? nA : cA + (size_t)(t + 2) * kstep; const char* b2 = last ? nB : cB + (size_t)(t + 2) * kstep;
            const char* a3 = a2 + kstep; const char* b3 = b2 + kstep;
            if (last && has_next) S.a_ready(nxt);
            if constexpr (SP2) {
            PG8_LDB(B0, 0, 0); PG8_LDB(B1, 0, 1); PG8_SCHED; PG8_LDA(At, 0, 0); PG8_STAGE(PG8_SA(1, 1), a1 + hstep, voffA);
            PG8_WAIT_V(8); PG8_WAIT_L(0); PG8_BAR; PG8_MMA(0, 0, At, B0); PG8_MMA(0, 1, At, B1); PG8_BAR; PG8_SCHED;
            PG8_LDA(At, 0, 1); PG8_STAGE(PG8_SB(0, 0), b2, voffB); PG8_STAGE(PG8_SB(0, 1), b2 + hstep, voffB); PG8_STAGE(PG8_SA(0, 0), a2, voffA);
            PG8_WAIT_V(8); PG8_WAIT_L(0); PG8_BAR; PG8_MMA(1, 0, At, B0); PG8_MMA(1, 1, At, B1); PG8_BAR; PG8_SCHED;
            PG8_LDB(B0, 1, 0); PG8_LDB(B1, 1, 1); PG8_SCHED; PG8_LDA(At, 1, 0); PG8_STAGE(PG8_SA(0, 1), a2 + hstep, voffA);
            PG8_WAIT_V(8); PG8_WAIT_L(0); PG8_BAR; PG8_MMA(0, 0, At, B0); PG8_MMA(0, 1, At, B1); PG8_BAR; PG8_SCHED;
            PG8_LDA(At, 1, 1); PG8_STAGE(PG8_SB(1, 0), b3, voffB); PG8_STAGE(PG8_SB(1, 1), b3 + hstep, voffB); PG8_STAGE(PG8_SA(1, 0), a3, voffA);
            PG8_WAIT_V(8); PG8_WAIT_L(0); PG8_BAR; PG8_MMA(1, 0, At, B0); PG8_MMA(1, 1, At, B1); PG8_BAR; PG8_SCHED;
            } else {
            PG8_LDB(B0, 0, 0); PG8_SCHED; PG8_LDA(At, 0, 0); PG8_STAGE(PG8_SA(1, 1), a1 + hstep, voffA);
            PG8_WAIT_L(8); PG8_BAR; PG8_WAIT_L(0); PG8_MMA(0, 0, At, B0); PG8_BAR; PG8_SCHED;
            PG8_LDB(B1, 0, 1); PG8_STAGE(PG8_SB(0, 0), b2, voffB);
            PG8_BAR; PG8_WAIT_L(0); PG8_MMA(0, 1, At, B1); PG8_BAR;
            PG8_LDA(At, 0, 1); PG8_STAGE(PG8_SA(0, 0), a2, voffA);
            PG8_BAR; PG8_WAIT_L(0); PG8_MMA(1, 0, At, B0); PG8_BAR; PG8_SCHED;
            PG8_STAGE(PG8_SB(0, 1), b2 + hstep, voffB);
            PG8_WAIT_V(6); PG8_BAR; PG8_MMA(1, 1, At, B1); PG8_BAR;
            PG8_LDB(B0, 1, 0); PG8_SCHED; PG8_LDA(At, 1, 0); PG8_STAGE(PG8_SA(0, 1), a2 + hstep, voffA);
            PG8_WAIT_L(8); PG8_BAR; PG8_WAIT_L(0); PG8_MMA(0, 0, At, B0); PG8_BAR; PG8_SCHED;
            PG8_LDB(B1, 1, 1); PG8_STAGE(PG8_SB(1, 0), b3, voffB);
            PG8_BAR; PG8_WAIT_L(0); PG8_MMA(0, 1, At, B1); PG8_BAR;
            PG8_LDA(At, 1, 1); PG8_STAGE(PG8_SA(1, 0), a3, voffA);
            PG8_BAR; PG8_WAIT_L(0); PG8_MMA(1, 0, At, B0); PG8_BAR; PG8_SCHED;
            PG8_STAGE(PG8_SB(1, 1), b3 + hstep, voffB);
            PG8_WAIT_V(6); PG8_BAR; PG8_MMA(1, 1, At, B1); PG8_BAR;
            }
        }
        if constexpr (ALIGN_EPI) { if (wr == 0) PG8_BAR; }
        E(acc, cur, wr, wc, fr, fq); S.done(cur);
        if (!has_next) break;
#pragma unroll
        for (int a = 0; a < 2; ++a)
#pragma unroll
            for (int b = 0; b < 2; ++b)
#pragma unroll
                for (int m = 0; m < 4; ++m)
#pragma unroll
                    for (int n = 0; n < 2; ++n) acc[a][b][m][n] = (f32x4){0.f, 0.f, 0.f, 0.f};
        cur = nxt; cA = nA; cB = nB; ++ui;
        if constexpr (ALIGN_EPI) { if (wr == 1) PG8_BAR; }
    }
    PG8_WAIT_V(0);
    if constexpr (!ALIGN_EPI) { if (wr == 0) PG8_BAR; }
    PG8_BAR;
#undef PG8_SA
#undef PG8_SB
#undef PG8_STAGE
#undef PG8_LDA
#undef PG8_LDB
#undef PG8_MMA
#undef PG8_WAIT_V
#undef PG8_WAIT_L
#undef PG8_BAR
#undef PG8_SCHED
}

struct EpiProj {
    static constexpr bool PERM = true;
    bf16_t* PA; bf16_t* PG;
    __device__ __forceinline__ void operator()(const f32x4 (&acc)[2][2][4][2], const Unit& u, int wr, int wc, int fr, int fq) const {
        const int row0 = u.pm * BM + wr * 64 + fr; int colt = u.pn * BM; bf16_t* base = colt < 4096 ? PA : PG; colt &= 4095;
        const int col0 = colt + wc * 32 + 8 * fq;
#pragma unroll
        for (int ai = 0; ai < 2; ++ai)
#pragma unroll
            for (int m = 0; m < 4; ++m) { bf16_t* rowp = base + (size_t)(row0 + ai * HALF + m * 16) * 4096 + col0;
#pragma unroll
                for (int bj = 0; bj < 2; ++bj) { const f32x4 v0 = acc[ai][bj][m][0], v1 = acc[ai][bj][m][1];
                    u32x4 w; w.x = cvt_pk_bf16(v0[0], v0[1]); w.y = cvt_pk_bf16(v0[2], v0[3]); w.z = cvt_pk_bf16(v1[0], v1[1]); w.w = cvt_pk_bf16(v1[2], v1[3]);
                    *(u32x4*)(rowp + bj * HALF) = w; } }
    }
};
struct EpiAttUp {
    static constexpr bool PERM = true;
    const bf16_t* PG; bf16_t* HB;
    __device__ __forceinline__ void operator()(const f32x4 (&acc)[2][2][4][2], const Unit& u, int wr, int wc, int fr, int fq) const {
        const int row0 = u.pm * BM + wr * 64 + fr; const int col0 = u.pn * BM + wc * 32 + 8 * fq;
#pragma unroll
        for (int ai = 0; ai < 2; ++ai)
#pragma unroll
            for (int m = 0; m < 4; ++m) { const size_t row = (size_t)(row0 + ai * HALF + m * 16);
#pragma unroll
                for (int bj = 0; bj < 2; ++bj) { const int col = col0 + bj * HALF;
                    const u32x4 gw = *(const u32x4*)(PG + row * 4096 + 2048 + col);
                    const f32x4 v0 = acc[ai][bj][m][0], v1 = acc[ai][bj][m][1];
                    u32x4 w;
                    w.x = cvt_pk_bf16(v0[0] * sigmoidf_(bf_lo(gw.x)), v0[1] * sigmoidf_(bf_hi(gw.x)));
                    w.y = cvt_pk_bf16(v0[2] * sigmoidf_(bf_lo(gw.y)), v0[3] * sigmoidf_(bf_hi(gw.y)));
                    w.z = cvt_pk_bf16(v1[0] * sigmoidf_(bf_lo(gw.z)), v1[1] * sigmoidf_(bf_hi(gw.z)));
                    w.w = cvt_pk_bf16(v1[2] * sigmoidf_(bf_lo(gw.w)), v1[3] * sigmoidf_(bf_hi(gw.w)));
                    *(u32x4*)(HB + row * 2048 + col) = w; } }
    }
};
struct EpiGlu {
    static constexpr bool PERM = true;
    const bf16_t* PG; bf16_t* HB;
    __device__ __forceinline__ void operator()(const f32x4 (&acc)[2][2][4][2], const Unit& u, int wr, int wc, int fr, int fq) const {
        const int row0 = u.pm * BM + wr * 64 + fr; const int col = u.pn * HALF + wc * 32 + 8 * fq;
#pragma unroll
        for (int ai = 0; ai < 2; ++ai)
#pragma unroll
            for (int m = 0; m < 4; ++m) { const size_t row = (size_t)(row0 + ai * HALF + m * 16);
                const u32x4 gw = *(const u32x4*)(PG + row * 4096 + col);
                const u32x4 aw = *(const u32x4*)(HB + row * 2048 + col);
                const f32x4 a0 = acc[ai][0][m][0], a1 = acc[ai][0][m][1], g0 = acc[ai][1][m][0], g1 = acc[ai][1][m][1];
                u32x4 w;
                w.x = cvt_pk_bf16(sigmoidf_(bf_lo(gw.x)) * a0[0] * sigmoidf_(g0[0]) + bf_lo(aw.x), sigmoidf_(bf_hi(gw.x)) * a0[1] * sigmoidf_(g0[1]) + bf_hi(aw.x));
                w.y = cvt_pk_bf16(sigmoidf_(bf_lo(gw.y)) * a0[2] * sigmoidf_(g0[2]) + bf_lo(aw.y), sigmoidf_(bf_hi(gw.y)) * a0[3] * sigmoidf_(g0[3]) + bf_hi(aw.y));
                w.z = cvt_pk_bf16(sigmoidf_(bf_lo(gw.z)) * a1[0] * sigmoidf_(g1[0]) + bf_lo(aw.z), sigmoidf_(bf_hi(gw.z)) * a1[1] * sigmoidf_(g1[1]) + bf_hi(aw.z));
                w.w = cvt_pk_bf16(sigmoidf_(bf_lo(gw.w)) * a1[2] * sigmoidf_(g1[2]) + bf_lo(aw.w), sigmoidf_(bf_hi(gw.w)) * a1[3] * sigmoidf_(g1[3]) + bf_hi(aw.w));
                *(u32x4*)(HB + row * 2048 + col) = w; }
    }
};
struct EpiOut {
    static constexpr bool PERM = true;
    const float* X; float* O; const float* mod;
    __device__ __forceinline__ void operator()(const f32x4 (&acc)[2][2][4][2], const Unit& u, int wr, int wc, int fr, int fq) const {
        const int row0 = u.pm * BM + wr * 64 + fr; const int col0 = u.pn * BM + wc * 32 + 8 * fq;
        const float* gt = mod + (size_t)((u.pm * BM) >> 13) * 12288 + 4096;
#pragma unroll
        for (int bj = 0; bj < 2; ++bj) { const int col = col0 + bj * HALF;
            const f32x4 g0 = *(const f32x4*)(gt + col), g1 = *(const f32x4*)(gt + col + 4);
#pragma unroll
            for (int ai = 0; ai < 2; ++ai)
#pragma unroll
                for (int m = 0; m < 4; ++m) { const size_t off = (size_t)(row0 + ai * HALF + m * 16) * 2048 + col;
                    const f32x4 x0 = *(const f32x4*)(X + off), x1 = *(const f32x4*)(X + off + 4);
                    *(f32x4*)(O + off) = x0 + g0 * acc[ai][bj][m][0]; *(f32x4*)(O + off + 4) = x1 + g1 * acc[ai][bj][m][1]; } }
    }
};
struct EpiF32 {
    static constexpr bool PERM = true;
    float* O;
    __device__ __forceinline__ void operator()(const f32x4 (&acc)[2][2][4][2], const Unit& u, int wr, int wc, int fr, int fq) const {
        const int row0 = u.pm * BM + wr * 64 + fr; const int col0 = u.pn * BM + wc * 32 + 8 * fq;
#pragma unroll
        for (int ai = 0; ai < 2; ++ai)
#pragma unroll
            for (int m = 0; m < 4; ++m) { float* rowp = O + (size_t)(row0 + ai * HALF + m * 16) * 2048 + col0;
#pragma unroll
                for (int bj = 0; bj < 2; ++bj) { *(f32x4*)(rowp + bj * HALF) = acc[ai][bj][m][0]; *(f32x4*)(rowp + bj * HALF + 4) = acc[ai][bj][m][1]; } }
    }
};
}

struct Args { const float* in[25]; float* out; unsigned char* ws; int ph_lo, ph_hi; };
enum { I_X = 0, I_C, I_WADA, I_BADA, I_N1G, I_WIN, I_LRE, I_LIM, I_LDT, I_BRE, I_BIM, I_CRE, I_CIM, I_SD, I_WGLU, I_QNG, I_KNG, I_WATT, I_WOUT, I_N2G, I_WQ, I_K1, I_K2, I_PU, I_PV };

__device__ __forceinline__ void ph_mod_partial(const float* __restrict__ c, const float* __restrict__ w_ada, float* modp, int gw, int ngw, int lane) {
    for (int task = gw; task < 48 * 32; task += ngw) {
        const int strip = task % 48, ks = task / 48, n0 = strip * 256 + lane * 4, k0 = ks * 64;
        f32x4 a0 = {0.f, 0.f, 0.f, 0.f}, a1 = {0.f, 0.f, 0.f, 0.f};
#pragma unroll 8
        for (int k = 0; k < 64; ++k) {
            const f32x4 w = *(const f32x4*)(w_ada + (size_t)(k0 + k) * 12288 + n0);
            float c0 = c[k0 + k], c1 = c[2048 + k0 + k];
            c0 = c0 / (1.0f + __expf(-c0)); c1 = c1 / (1.0f + __expf(-c1));
            a0 += c0 * w; a1 += c1 * w;
        }
        *(f32x4*)(modp + (size_t)(ks * 2 + 0) * 12288 + n0) = a0;
        *(f32x4*)(modp + (size_t)(ks * 2 + 1) * 12288 + n0) = a1;
    }
}

__device__ __forceinline__ void transpose_item(const float* __restrict__ W, int K, int N, bf16_t* WT, int drow0, int scol0, int k0, LAS float* scr, int lane) {
#pragma unroll 8
    for (int i = 0; i < 32; ++i) { const int kk = 2 * i + (lane >> 5); scr[kk * 33 + (lane & 31)] = W[(size_t)(k0 + kk) * N + scol0 + (lane & 31)]; }
    LDS_WAIT();
    const int c = lane & 7;
#pragma unroll
    for (int j = 0; j < 4; ++j) { const int n = (lane >> 3) + 8 * j; const LAS float* s = scr + (8 * c) * 33 + n;
        u32x4 o; o.x = cvt_pk_bf16(s[0 * 33], s[1 * 33]); o.y = cvt_pk_bf16(s[2 * 33], s[3 * 33]); o.z = cvt_pk_bf16(s[4 * 33], s[5 * 33]); o.w = cvt_pk_bf16(s[6 * 33], s[7 * 33]);
        *(u32x4*)(WT + (size_t)(drow0 + n) * K + k0 + 8 * c) = o; }
    LDS_WAIT();
}
__device__ __forceinline__ void ph_prologue(const Args& a, LAS unsigned char* lds, int gw, int ngw, int lane, int wave) {
    unsigned char* ws = a.ws;
    { const float* modp = (const float*)(ws + WS_MODP); float* mod = (float*)(ws + WS_MOD); const float* b_ada = a.in[I_BADA];
      for (int idx = gw * 64 + lane; idx < 2 * 12288; idx += ngw * 64) { const int b = idx / 12288, n = idx - b * 12288; float s = b_ada[n];
#pragma unroll 8
          for (int ks = 0; ks < 32; ++ks) s += modp[(size_t)(ks * 2 + b) * 12288 + n];
          mod[idx] = s; } }
    { bf16_t* WSC = (bf16_t*)(ws + WS_WSC);
      for (int item = gw; item < 512; item += ngw) {
          const int hj = item >> 5, kb = item & 31, k = kb * 64 + lane;
          const float* wq = a.in[I_WQ] + (size_t)k * 2048 + hj * 128;
          float w[128];
#pragma unroll
          for (int d = 0; d < 32; ++d) { const f32x4 v = *(const f32x4*)(wq + 4 * d); w[4 * d] = v[0]; w[4 * d + 1] = v[1]; w[4 * d + 2] = v[2]; w[4 * d + 3] = v[3]; }
          const float* kk = (hj & 1) ? a.in[I_K2] : a.in[I_K1];
          for (int key = 0; key < 128; ++key) {
              const float* kr = kk + key * 128;
              float s0 = 0.f, s1 = 0.f;
#pragma unroll
              for (int d = 0; d < 128; d += 2) { s0 += w[d] * kr[d]; s1 += w[d + 1] * kr[d + 1]; }
              WSC[(size_t)(hj * 128 + key) * 2048 + k] = (bf16_t)(cvt_pk_bf16(s0 + s1, 0.f) & 0xffffu);
          } } }
    { LAS float* scr = (LAS float*)(lds + wave * 8448);
      constexpr int I_IN = 32 * 256, I_GLU = 16 * 128, I_ATT = 16 * 64, I_OUT = 32 * 64, NIT = I_IN + I_GLU + I_ATT + I_OUT;
      for (int it = gw; it < NIT; it += ngw) {
          int r = it;
          if (r < I_IN) { const int kb = r / 256, nb = r % 256; transpose_item(a.in[I_WIN], 2048, 8192, (bf16_t*)(ws + WS_WIN), 32 * nb, 32 * nb, 64 * kb, scr, lane); continue; } r -= I_IN;
          if (r < I_GLU) { const int kb = r / 128, nb = r % 128, dr = 32 * nb; const int sc = ((dr >> 7) & 1) * 2048 + (dr >> 8) * 128 + (dr & 127);
              transpose_item(a.in[I_WGLU], 1024, 4096, (bf16_t*)(ws + WS_WGLU), dr, sc, 64 * kb, scr, lane); continue; } r -= I_GLU;
          if (r < I_ATT) { const int kb = r / 64, nb = r % 64; transpose_item(a.in[I_WATT], 1024, 2048, (bf16_t*)(ws + WS_WATT), 32 * nb, 32 * nb, 64 * kb, scr, lane); continue; } r -= I_ATT;
          { const int kb = r / 64, nb = r % 64; transpose_item(a.in[I_WOUT], 2048, 2048, (bf16_t*)(ws + WS_WOUT), 32 * nb, 32 * nb, 64 * kb, scr, lane); }
      } }
}

__device__ __forceinline__ void ph_norm(const float* X, bf16_t* Hout, const float* __restrict__ g, const float* mod, int sh_off, int sc_off, int gw, int ngw, int lane) {
    for (int row = gw; row < T_TOK; row += ngw) {
        const int b = row >> 13;
        const f32x4* xr = (const f32x4*)(X + (size_t)row * DM) + lane;
        f32x4 v[8]; float ss = 0.f;
#pragma unroll
        for (int j = 0; j < 8; ++j) { v[j] = xr[64 * j]; ss += (v[j][0] * v[j][0] + v[j][1] * v[j][1]) + (v[j][2] * v[j][2] + v[j][3] * v[j][3]); }
        ss = wave_sum(ss);
        const float rs = 1.0f / sqrtf(ss * (1.0f / DM) + EPS);
        const float* mb = mod + (size_t)b * 12288;
#pragma unroll
        for (int j = 0; j < 8; ++j) { const int col = 4 * (lane + 64 * j);
            const f32x4 gv = *(const f32x4*)(g + col), sc = *(const f32x4*)(mb + sc_off + col), sh = *(const f32x4*)(mb + sh_off + col);
            const f32x4 o = v[j] * rs * gv * (sc + 1.0f) + sh;
            u32x2 w; w.x = cvt_pk_bf16(o[0], o[1]); w.y = cvt_pk_bf16(o[2], o[3]);
            *(u32x2*)(Hout + (size_t)row * DM + col) = w; }
    }
}

__device__ __forceinline__ void ph_attn(LAS unsigned char* lds, const bf16_t* PA, bf16_t* ATT, const float* __restrict__ qg, const float* __restrict__ kg, int G) {
    const int tid = threadIdx.x, lane = tid & 63, wave = __builtin_amdgcn_readfirstlane(tid >> 6), c = lane & 15, g = lane >> 4;
    LAS unsigned char* KL = lds;
    LAS unsigned char* VT = lds + 17408;
    bf16x8 tri[6];
    { const int FS[6] = {0, 1, 0, 1, 2, 3}, FP[6] = {0, 0, 1, 1, 1, 1};
#pragma unroll
      for (int q = 0; q < 6; ++q)
#pragma unroll
          for (int jj = 0; jj < 8; ++jj) { const int kap = 32 * FP[q] + 16 * (jj >> 2) + 4 * g + (jj & 3); tri[q][jj] = (kap > 16 * FS[q] + c) ? (short)0x3F80 : (short)0; } }
    for (int u = blockIdx.x; u < 1024; u += G) {
        const int b = u >> 9, h = (u >> 6) & 7, qb = u & 63, t0 = qb * 128, tq0 = t0 + 16 * wave, tq = tq0 + c;
        bf16x8 qf[4];
        { const bf16_t* qrow = PA + (size_t)(b * SEQ + tq) * 4096 + 1024 + h * 128;
          u32x4 qr[4]; float ss = 0.f;
#pragma unroll
          for (int kk = 0; kk < 4; ++kk) { qr[kk] = *(const u32x4*)(qrow + 32 * kk + 8 * g);
#pragma unroll
              for (int e = 0; e < 4; ++e) { const float lo = bf_lo(qr[kk][e]), hi = bf_hi(qr[kk][e]); ss += lo * lo + hi * hi; } }
          ss += __shfl_xor(ss, 16); ss += __shfl_xor(ss, 32);
          const float rs = (1.0f / sqrtf(ss * (1.0f / 128.0f) + EPS)) * 0.08838834764831845f;
#pragma unroll
          for (int kk = 0; kk < 4; ++kk) { const f32x4 g0 = *(const f32x4*)(qg + 32 * kk + 8 * g), g1 = *(const f32x4*)(qg + 32 * kk + 8 * g + 4);
              u32x4 w;
              w.x = cvt_pk_bf16(bf_lo(qr[kk].x) * rs * g0[0], bf_hi(qr[kk].x) * rs * g0[1]);
              w.y = cvt_pk_bf16(bf_lo(qr[kk].y) * rs * g0[2], bf_hi(qr[kk].y) * rs * g0[3]);
              w.z = cvt_pk_bf16(bf_lo(qr[kk].z) * rs * g1[0], bf_hi(qr[kk].z) * rs * g1[1]);
              w.w = cvt_pk_bf16(bf_lo(qr[kk].w) * rs * g1[2], bf_hi(qr[kk].w) * rs * g1[3]);
              qf[kk] = __builtin_bit_cast(bf16x8, w); } }
        float carry = 0.f; int wdone = 0;
        f32x4 oacc[8];
#pragma unroll
        for (int fd = 0; fd < 8; ++fd) oacc[fd] = (f32x4){0.f, 0.f, 0.f, 0.f};
        for (int kt = 2 * qb + 1; kt >= 0; --kt) {
            const int k0 = kt * 64;
            if (__syncthreads_and(wdone)) break;
#pragma unroll
            for (int p = 0; p < 2; ++p) {
                const int ci = tid + 512 * p, key = ci >> 4, ch = ci & 15;
                const u32x4 kr = *(const u32x4*)(PA + (size_t)(b * SEQ + k0 + key) * 4096 + 2048 + h * 128 + 8 * ch);
                float f[8]; f[0] = bf_lo(kr.x); f[1] = bf_hi(kr.x); f[2] = bf_lo(kr.y); f[3] = bf_hi(kr.y); f[4] = bf_lo(kr.z); f[5] = bf_hi(kr.z); f[6] = bf_lo(kr.w); f[7] = bf_hi(kr.w);
                float ss = 0.f;
#pragma unroll
                for (int e = 0; e < 8; ++e) ss += f[e] * f[e];
                ss += __shfl_xor(ss, 1); ss += __shfl_xor(ss, 2); ss += __shfl_xor(ss, 4); ss += __shfl_xor(ss, 8);
                const float rs = 1.0f / sqrtf(ss * (1.0f / 128.0f) + EPS);
                const f32x4 g0 = *(const f32x4*)(kg + 8 * ch), g1 = *(const f32x4*)(kg + 8 * ch + 4);
                u32x4 w;
                w.x = cvt_pk_bf16(f[0] * rs * g0[0], f[1] * rs * g0[1]); w.y = cvt_pk_bf16(f[2] * rs * g0[2], f[3] * rs * g0[3]);
                w.z = cvt_pk_bf16(f[4] * rs * g1[0], f[5] * rs * g1[1]); w.w = cvt_pk_bf16(f[6] * rs * g1[2], f[7] * rs * g1[3]);
                *(LAS u32x4*)(KL + key * 272 + ch * 16) = w;
            }
#pragma unroll
            for (int p = 0; p < 2; ++p) {
                const int key = lane, ch = wave + 8 * p;
                const u32x4 vr = *(const u32x4*)(PA + (size_t)(b * SEQ + k0 + key) * 4096 + 3072 + h * 128 + 8 * ch);
                LAS unsigned short* vt = (LAS unsigned short*)(VT + (8 * ch) * 144 + key * 2);
                vt[0 * 72] = (unsigned short)(vr.x & 0xffffu); vt[1 * 72] = (unsigned short)(vr.x >> 16);
                vt[2 * 72] = (unsigned short)(vr.y & 0xffffu); vt[3 * 72] = (unsigned short)(vr.y >> 16);
                vt[4 * 72] = (unsigned short)(vr.z & 0xffffu); vt[5 * 72] = (unsigned short)(vr.z >> 16);
                vt[6 * 72] = (unsigned short)(vr.w & 0xffffu); vt[7 * 72] = (unsigned short)(vr.w >> 16);
            }
            __syncthreads();
            if (!wdone && k0 < tq0 + 15) {
                f32x4 zt[4];
#pragma unroll
                for (int f = 0; f < 4; ++f) { f32x4 acc = {0.f, 0.f, 0.f, 0.f};
#pragma unroll
                    for (int kk = 0; kk < 4; ++kk) { const bf16x8 kf = *(const LAS bf16x8*)(KL + (16 * f + c) * 272 + (32 * kk + 8 * g) * 2);
                        acc = __builtin_amdgcn_mfma_f32_16x16x32_bf16(kf, qf[kk], acc, 0, 0, 0); }
                    zt[f] = acc; }
                float lf[4][4], lz[4][4]; float tot = 0.f;
#pragma unroll
                for (int f = 0; f < 4; ++f)
#pragma unroll
                    for (int i = 0; i < 4; ++i) { const int s = k0 + 16 * f + 4 * g + i; const bool valid = s < tq; const float z = zt[f][i];
                        const float sp = fmaxf(z, 0.f) + __logf(1.0f + __expf(-fabsf(z)));
                        const float l = valid ? -sp : 0.f; lf[f][i] = l; lz[f][i] = valid ? (l + z) : -INFINITY; tot += l; }
                tot += __shfl_xor(tot, 16); tot += __shfl_xor(tot, 32);
                bf16x8 lh[2], ll[2];
#pragma unroll
                for (int fp = 0; fp < 2; ++fp) { u32x4 wh, wl;
#pragma unroll
                    for (int q = 0; q < 2; ++q) { const int f = 2 * fp + q;
                        const unsigned h0 = cvt_pk_bf16(lf[f][0], lf[f][1]), h1 = cvt_pk_bf16(lf[f][2], lf[f][3]);
                        const unsigned l0 = cvt_pk_bf16(lf[f][0] - bf_lo(h0), lf[f][1] - bf_hi(h0)), l1 = cvt_pk_bf16(lf[f][2] - bf_lo(h1), lf[f][3] - bf_hi(h1));
                        wh[2 * q] = h0; wh[2 * q + 1] = h1; wl[2 * q] = l0; wl[2 * q + 1] = l1; }
                    lh[fp] = __builtin_bit_cast(bf16x8, wh); ll[fp] = __builtin_bit_cast(bf16x8, wl); }
                f32x4 sf[4];
                { f32x4 z4 = {0.f, 0.f, 0.f, 0.f};
                  sf[0] = __builtin_amdgcn_mfma_f32_16x16x32_bf16(tri[0], lh[0], z4, 0, 0, 0); sf[0] = __builtin_amdgcn_mfma_f32_16x16x32_bf16(tri[0], ll[0], sf[0], 0, 0, 0);
                  sf[0] = __builtin_amdgcn_mfma_f32_16x16x32_bf16(tri[2], lh[1], sf[0], 0, 0, 0); sf[0] = __builtin_amdgcn_mfma_f32_16x16x32_bf16(tri[2], ll[1], sf[0], 0, 0, 0);
                  sf[1] = __builtin_amdgcn_mfma_f32_16x16x32_bf16(tri[1], lh[0], z4, 0, 0, 0); sf[1] = __builtin_amdgcn_mfma_f32_16x16x32_bf16(tri[1], ll[0], sf[1], 0, 0, 0);
                  sf[1] = __builtin_amdgcn_mfma_f32_16x16x32_bf16(tri[3], lh[1], sf[1], 0, 0, 0); sf[1] = __builtin_amdgcn_mfma_f32_16x16x32_bf16(tri[3], ll[1], sf[1], 0, 0, 0);
                  sf[2] = __builtin_amdgcn_mfma_f32_16x16x32_bf16(tri[4], lh[1], z4, 0, 0, 0); sf[2] = __builtin_amdgcn_mfma_f32_16x16x32_bf16(tri[4], ll[1], sf[2], 0, 0, 0);
                  sf[3] = __builtin_amdgcn_mfma_f32_16x16x32_bf16(tri[5], lh[1], z4, 0, 0, 0); sf[3] = __builtin_amdgcn_mfma_f32_16x16x32_bf16(tri[5], ll[1], sf[3], 0, 0, 0); }
                bf16x8 pb[2];
#pragma unroll
                for (int fp = 0; fp < 2; ++fp) { u32x4 w;
#pragma unroll
                    for (int q = 0; q < 2; ++q) { const int f = 2 * fp + q; float p[4];
#pragma unroll
                        for (int i = 0; i < 4; ++i) p[i] = __expf(lz[f][i] + sf[f][i] + carry);
                        w[2 * q] = cvt_pk_bf16(p[0], p[1]); w[2 * q + 1] = cvt_pk_bf16(p[2], p[3]); }
                    pb[fp] = __builtin_bit_cast(bf16x8, w); }
                carry += tot;
#pragma unroll
                for (int fd = 0; fd < 8; ++fd)
#pragma unroll
                    for (int fp = 0; fp < 2; ++fp) { const LAS unsigned char* vp = VT + (16 * fd + c) * 144 + (32 * fp + 4 * g) * 2;
                        const u32x2 v0 = *(const LAS u32x2*)vp, v1 = *(const LAS u32x2*)(vp + 32);
                        u32x4 vw; vw.x = v0.x; vw.y = v0.y; vw.z = v1.x; vw.w = v1.y;
                        oacc[fd] = __builtin_amdgcn_mfma_f32_16x16x32_bf16(__builtin_bit_cast(bf16x8, vw), pb[fp], oacc[fd], 0, 0, 0); }
                wdone = (__ballot(carry >= -105.0f) == 0ull) ? 1 : 0;
            }
        }
        { bf16_t* orow = ATT + (size_t)(b * SEQ + tq) * 1024 + h * 128 + 4 * g;
#pragma unroll
          for (int fd = 0; fd < 8; ++fd) { u32x2 w; w.x = cvt_pk_bf16(oacc[fd][0], oacc[fd][1]); w.y = cvt_pk_bf16(oacc[fd][2], oacc[fd][3]); *(u32x2*)(orow + 16 * fd) = w; } }
    }
    __syncthreads();
}

struct SsmP { float lbr, lbi; float bbr[16], bbi[16]; };
__device__ __forceinline__ void ssm_params(const Args& a, int g, int p, SsmP& P) {
    const float lr = a.in[I_LRE][g * 64 + p], li = a.in[I_LIM][g * 64 + p], dt = __expf(a.in[I_LDT][g]);
    const float mag = __expf(lr * dt);
    float rev = li * dt * 0.15915494309189535f; rev -= rintf(rev);
    const float sn = __builtin_amdgcn_sinf(rev), cs = __builtin_amdgcn_cosf(rev);
    P.lbr = mag * cs; P.lbi = mag * sn;
    const float nr = P.lbr - 1.0f, ni = P.lbi, den = 1.0f / (lr * lr + li * li);
    const float qr = (nr * lr + ni * li) * den, qi = (ni * lr - nr * li) * den;
    const float* br = a.in[I_BRE] + (size_t)(g * 64 + p) * 16; const float* bi = a.in[I_BIM] + (size_t)(g * 64 + p) * 16;
#pragma unroll
    for (int i = 0; i < 4; ++i) { const f32x4 r4 = *(const f32x4*)(br + 4 * i), i4 = *(const f32x4*)(bi + 4 * i);
#pragma unroll
        for (int e = 0; e < 4; ++e) { P.bbr[4 * i + e] = qr * r4[e] - qi * i4[e]; P.bbi[4 * i + e] = qr * i4[e] + qi * r4[e]; } }
}
__device__ __forceinline__ void ph_ssm_pass1(const Args& a, const bf16_t* PA, f32x2* E, int gw, int ngw, int lane) {
    for (int task = gw; task < 16384; task += ngw) {
        const int ci = task & 127, g = (task >> 7) & 63, b = task >> 13;
        SsmP P; ssm_params(a, g, lane, P);
        const bf16_t* urow = PA + (size_t)(b * SEQ + ci * 64 + lane) * 4096 + g * 16;
        const u32x4 ua = *(const u32x4*)urow, ub = *(const u32x4*)(urow + 8);
        float sr = 0.f, si = 0.f;
        for (int t = 0; t < 64; ++t) {
            unsigned uw[8];
            uw[0] = __builtin_amdgcn_readlane(ua.x, t); uw[1] = __builtin_amdgcn_readlane(ua.y, t); uw[2] = __builtin_amdgcn_readlane(ua.z, t); uw[3] = __builtin_amdgcn_readlane(ua.w, t);
            uw[4] = __builtin_amdgcn_readlane(ub.x, t); uw[5] = __builtin_amdgcn_readlane(ub.y, t); uw[6] = __builtin_amdgcn_readlane(ub.z, t); uw[7] = __builtin_amdgcn_readlane(ub.w, t);
            float bur = 0.f, bui = 0.f;
#pragma unroll
            for (int d = 0; d < 8; ++d) { const float u0 = bf_lo(uw[d]), u1 = bf_hi(uw[d]);
                bur += P.bbr[2 * d] * u0 + P.bbr[2 * d + 1] * u1; bui += P.bbi[2 * d] * u0 + P.bbi[2 * d + 1] * u1; }
            const float nr = P.lbr * sr - P.lbi * si + bur, ni = P.lbr * si + P.lbi * sr + bui; sr = nr; si = ni;
        }
        E[(size_t)((b * 64 + g) * 128 + ci) * 64 + lane] = (f32x2){sr, si};
    }
}
__device__ __forceinline__ void ph_ssm_pass3(const Args& a, const bf16_t* PA, const f32x2* E, bf16_t* YA, int gw, int ngw, int lane) {
    for (int task = gw; task < 16384; task += ngw) {
        const int ci = task & 127, g = (task >> 7) & 63, b = task >> 13;
        SsmP P; ssm_params(a, g, lane, P);
        float pr = P.lbr, pi = P.lbi;
#pragma unroll
        for (int q = 0; q < 6; ++q) { const float nr = pr * pr - pi * pi, ni = 2.0f * pr * pi; pr = nr; pi = ni; }
        float sr = 0.f, si = 0.f;
        { const f32x2* e = E + (size_t)((b * 64 + g) * 128) * 64 + lane;
          for (int cc = 0; cc < ci; ++cc) { const f32x2 ev = e[(size_t)cc * 64]; const float nr = pr * sr - pi * si + ev[0], ni = pr * si + pi * sr + ev[1]; sr = nr; si = ni; } }
        float cr[16], cim[16], d0[16];
#pragma unroll
        for (int i = 0; i < 16; ++i) { cr[i] = a.in[I_CRE][(size_t)(g * 16 + i) * 64 + lane]; cim[i] = a.in[I_CIM][(size_t)(g * 16 + i) * 64 + lane]; d0[i] = (lane == 0) ? a.in[I_SD][g * 16 + i] : 0.f; }
        const bf16_t* urow = PA + (size_t)(b * SEQ + ci * 64 + lane) * 4096 + g * 16;
        const u32x4 ua = *(const u32x4*)urow, ub = *(const u32x4*)(urow + 8);
        const int myi = ((lane >> 5) & 1) * 8 + ((lane >> 4) & 1) * 4 + ((lane >> 3) & 1) * 2 + ((lane >> 2) & 1);
        const bool h5 = lane & 32, h4 = lane & 16, h3 = lane & 8, h2 = lane & 4;
        for (int t = 0; t < 64; ++t) {
            unsigned uw[8];
            uw[0] = __builtin_amdgcn_readlane(ua.x, t); uw[1] = __builtin_amdgcn_readlane(ua.y, t); uw[2] = __builtin_amdgcn_readlane(ua.z, t); uw[3] = __builtin_amdgcn_readlane(ua.w, t);
            uw[4] = __builtin_amdgcn_readlane(ub.x, t); uw[5] = __builtin_amdgcn_readlane(ub.y, t); uw[6] = __builtin_amdgcn_readlane(ub.z, t); uw[7] = __builtin_amdgcn_readlane(ub.w, t);
            float uf[16]; float bur = 0.f, bui = 0.f;
#pragma unroll
            for (int d = 0; d < 8; ++d) { uf[2 * d] = bf_lo(uw[d]); uf[2 * d + 1] = bf_hi(uw[d]);
                bur += P.bbr[2 * d] * uf[2 * d] + P.bbr[2 * d + 1] * uf[2 * d + 1]; bui += P.bbi[2 * d] * uf[2 * d] + P.bbi[2 * d + 1] * uf[2 * d + 1]; }
            const float nr = P.lbr * sr - P.lbi * si + bur, ni = P.lbr * si + P.lbi * sr + bui; sr = nr; si = ni;
            float v[16];
#pragma unroll
            for (int i = 0; i < 16; ++i) v[i] = cr[i] * sr - cim[i] * si + d0[i] * uf[i];
            float w8[8], w4[4], w2[2], w1;
#pragma unroll
            for (int k = 0; k < 8; ++k) { const float keep = h5 ? v[k + 8] : v[k], send = h5 ? v[k] : v[k + 8]; w8[k] = keep + __shfl_xor(send, 32); }
#pragma unroll
            for (int k = 0; k < 4; ++k) { const float keep = h4 ? w8[k + 4] : w8[k], send = h4 ? w8[k] : w8[k + 4]; w4[k] = keep + __shfl_xor(send, 16); }
#pragma unroll
            for (int k = 0; k < 2; ++k) { const float keep = h3 ? w4[k + 2] : w4[k], send = h3 ? w4[k] : w4[k + 2]; w2[k] = keep + __shfl_xor(send, 8); }
            { const float keep = h2 ? w2[1] : w2[0], send = h2 ? w2[0] : w2[1]; w1 = keep + __shfl_xor(send, 4); }
            w1 += __shfl_xor(w1, 2); w1 += __shfl_xor(w1, 1);
            if ((lane & 3) == 0) YA[(size_t)(b * SEQ + ci * 64 + t) * 1024 + g * 16 + myi] = (bf16_t)(cvt_pk_bf16(gelu_tanh(w1), 0.f) & 0xffffu);
        }
    }
}

constexpr float PEER_SU = 512.0f, PEER_SV = 16.0f;
__device__ __forceinline__ void ph_table_cvt(const float* __restrict__ U, const float* __restrict__ V, unsigned char* UT, unsigned char* VT, int G) {
    const size_t n16 = (size_t)16384 * 2048 / 16, stride = (size_t)G * 512;
    for (size_t i = (size_t)blockIdx.x * 512 + threadIdx.x; i < 2 * n16; i += stride) {
        const bool sec = i >= n16; const size_t j = sec ? i - n16 : i; const float sc = sec ? PEER_SV : PEER_SU;
        const float* src = (sec ? V : U) + j * 16; unsigned char* dst = (sec ? VT : UT) + j * 16;
        u32x4 w;
#pragma unroll
        for (int q = 0; q < 4; ++q) { const f32x4 v = *(const f32x4*)(src + 4 * q); int p = 0;
            p = __builtin_amdgcn_cvt_pk_fp8_f32(v[0] * sc, v[1] * sc, p, false); p = __builtin_amdgcn_cvt_pk_fp8_f32(v[2] * sc, v[3] * sc, p, true); w[q] = (unsigned)p; }
        *(u32x4*)dst = w;
    }
}

__device__ __forceinline__ void ph_peer(LAS unsigned char* lds, const float* SC, const bf16_t* H2, const unsigned char* UT, const unsigned char* VTb, const float* mod, float* OUT, int G) {
    const int tid = threadIdx.x, lane = tid & 63, wave = __builtin_amdgcn_readfirstlane(tid >> 6);
    LAS float* scr = (LAS float*)(lds + wave * 8448);
    LAS int* idxs = (LAS int*)(lds + 69632 + wave * 4096);
    LAS float* gates = (LAS float*)(lds + 69632 + wave * 4096 + 2048);
    LAS float* dotb = (LAS float*)(lds + 102400 + wave * 1024);
    for (int it = blockIdx.x; it < 512; it += G) {
        const int tokw = it * 32 + wave * 4;
        float tk[16];
#pragma unroll
        for (int i = 0; i < 16; ++i) tk[i] = -INFINITY;
        for (int q = 0; q < 4; ++q) {
#pragma unroll
            for (int j = 0; j < 8; ++j) { const int prob = (lane >> 3) + 8 * j, seg = lane & 7;
                const f32x4 v = *(const f32x4*)(SC + (size_t)(tokw + (prob >> 4)) * 2048 + (prob & 15) * 128 + 32 * q + 4 * seg);
                LAS float* d = scr + prob * 33 + 4 * seg; d[0] = v[0]; d[1] = v[1]; d[2] = v[2]; d[3] = v[3]; }
            LDS_WAIT();
#pragma unroll 4
            for (int vi = 0; vi < 32; ++vi) {
                float x = __uint_as_float((__float_as_uint(scr[lane * 33 + vi]) & ~127u) | (unsigned)(127 - (32 * q + vi)));
#pragma unroll
                for (int i = 0; i < 16; ++i) { const float hi = fmaxf(tk[i], x); x = fminf(tk[i], x); tk[i] = hi; }
            }
            LDS_WAIT();
        }
        float t2[16];
#pragma unroll
        for (int i = 0; i < 16; ++i) t2[i] = __shfl_xor(tk[i], 1);
        float bv[16]; int bp[16];
#pragma unroll
        for (int i = 0; i < 16; ++i) { bv[i] = -INFINITY; bp[i] = 0; }
#pragma unroll
        for (int aa = 0; aa < 16; ++aa)
#pragma unroll
            for (int bb = 0; bb < 16 / (aa + 1); ++bb) {
                const unsigned u1 = __float_as_uint(tk[aa]), u2 = __float_as_uint(t2[bb]);
                float x = __uint_as_float(u1 & ~127u) + __uint_as_float(u2 & ~127u);
                int px = (int)(((127u - (u1 & 127u)) << 7) | (127u - (u2 & 127u)));
#pragma unroll
                for (int i = 0; i < 16; ++i) { const bool gt = x > bv[i]; const float nv = gt ? x : bv[i], ox = gt ? bv[i] : x; const int np = gt ? px : bp[i], op = gt ? bp[i] : px;
                    bv[i] = nv; x = ox; bp[i] = np; px = op; }
            }
        { float e[16], sum = 0.f;
#pragma unroll
          for (int i = 0; i < 16; ++i) { e[i] = __expf(bv[i] - bv[0]); sum += e[i]; }
          const float inv = 1.0f / sum;
          if ((lane & 1) == 0) { const int tl = lane >> 4, head = (lane & 15) >> 1;
#pragma unroll
              for (int i = 0; i < 16; ++i) { idxs[tl * 128 + head * 16 + i] = bp[i]; gates[tl * 128 + head * 16 + i] = e[i] * inv; } } }
        LDS_WAIT();
        for (int tl = 0; tl < 4; ++tl) {
            const int token = tokw + tl;
            f32x2 ha[16];
            { const bf16_t* hrow = H2 + (size_t)token * 2048 + 16 * lane;
#pragma unroll
              for (int j = 0; j < 2; ++j) { const u32x4 w0 = *(const u32x4*)(hrow + 1024 * j), w1 = *(const u32x4*)(hrow + 1024 * j + 8);
                  ha[8 * j + 0] = (f32x2){bf_lo(w0.x), bf_hi(w0.x)}; ha[8 * j + 1] = (f32x2){bf_lo(w0.y), bf_hi(w0.y)}; ha[8 * j + 2] = (f32x2){bf_lo(w0.z), bf_hi(w0.z)}; ha[8 * j + 3] = (f32x2){bf_lo(w0.w), bf_hi(w0.w)};
                  ha[8 * j + 4] = (f32x2){bf_lo(w1.x), bf_hi(w1.x)}; ha[8 * j + 5] = (f32x2){bf_lo(w1.y), bf_hi(w1.y)}; ha[8 * j + 6] = (f32x2){bf_lo(w1.z), bf_hi(w1.z)}; ha[8 * j + 7] = (f32x2){bf_lo(w1.w), bf_hi(w1.w)}; } }
            for (int grp = 0; grp < 16; ++grp) {
                u32x4 buf[8][2];
#pragma unroll
                for (int r = 0; r < 8; ++r) { const int e = __builtin_amdgcn_readfirstlane(idxs[tl * 128 + grp * 8 + r]);
                    const unsigned char* rp = UT + (size_t)e * 2048 + 16 * lane; buf[r][0] = *(const u32x4*)rp; buf[r][1] = *(const u32x4*)(rp + 1024); }
                float pt[8];
#pragma unroll
                for (int r = 0; r < 8; ++r) { f32x2 s = {0.f, 0.f};
#pragma unroll
                    for (int j = 0; j < 2; ++j)
#pragma unroll
                        for (int q = 0; q < 4; ++q) { const int w = (int)buf[r][j][q];
                            s = __builtin_amdgcn_cvt_pk_f32_fp8(w, false) * ha[8 * j + 2 * q] + s; s = __builtin_amdgcn_cvt_pk_f32_fp8(w, true) * ha[8 * j + 2 * q + 1] + s; }
                    pt[r] = s.x + s.y; }
                const bool h5 = lane & 32, h4 = lane & 16, h3 = lane & 8; float w4[4], w2[2], w1;
#pragma unroll
                for (int k = 0; k < 4; ++k) { const float keep = h5 ? pt[k + 4] : pt[k], send = h5 ? pt[k] : pt[k + 4]; w4[k] = keep + __shfl_xor(send, 32); }
#pragma unroll
                for (int k = 0; k < 2; ++k) { const float keep = h4 ? w4[k + 2] : w4[k], send = h4 ? w4[k] : w4[k + 2]; w2[k] = keep + __shfl_xor(send, 16); }
                { const float keep = h3 ? w2[1] : w2[0], send = h3 ? w2[0] : w2[1]; w1 = keep + __shfl_xor(send, 8); }
                w1 += __shfl_xor(w1, 4); w1 += __shfl_xor(w1, 2); w1 += __shfl_xor(w1, 1);
                if ((lane & 7) == 0) dotb[grp * 8 + ((lane >> 5) & 1) * 4 + ((lane >> 4) & 1) * 2 + ((lane >> 3) & 1)] = w1;
            }
            LDS_WAIT();
            { const float d0 = dotb[lane] * (1.0f / PEER_SU), d1 = dotb[lane + 64] * (1.0f / PEER_SU);
              const float a0 = gates[tl * 128 + lane] * gelu_tanh(d0) * (1.0f / PEER_SV), a1 = gates[tl * 128 + lane + 64] * gelu_tanh(d1) * (1.0f / PEER_SV);
              LDS_WAIT(); dotb[lane] = a0; dotb[lane + 64] = a1; }
            LDS_WAIT();
#pragma unroll
            for (int i = 0; i < 16; ++i) ha[i] = (f32x2){0.f, 0.f};
            for (int grp = 0; grp < 16; ++grp) {
                u32x4 buf[8][2];
#pragma unroll
                for (int r = 0; r < 8; ++r) { const int e = __builtin_amdgcn_readfirstlane(idxs[tl * 128 + grp * 8 + r]);
                    const unsigned char* rp = VTb + (size_t)e * 2048 + 16 * lane; buf[r][0] = *(const u32x4*)rp; buf[r][1] = *(const u32x4*)(rp + 1024); }
#pragma unroll
                for (int r = 0; r < 8; ++r) { const float ar = dotb[grp * 8 + r]; const f32x2 a2 = {ar, ar};
#pragma unroll
                    for (int j = 0; j < 2; ++j)
#pragma unroll
                        for (int q = 0; q < 4; ++q) { const int w = (int)buf[r][j][q];
                            ha[8 * j + 2 * q] = __builtin_amdgcn_cvt_pk_f32_fp8(w, false) * a2 + ha[8 * j + 2 * q]; ha[8 * j + 2 * q + 1] = __builtin_amdgcn_cvt_pk_f32_fp8(w, true) * a2 + ha[8 * j + 2 * q + 1]; } }
            }
            { const int b = token >> 13; const float* gt2 = mod + (size_t)b * 12288 + 10240 + 16 * lane; float* orow = OUT + (size_t)token * 2048 + 16 * lane;
#pragma unroll
              for (int j = 0; j < 2; ++j)
#pragma unroll
                  for (int q = 0; q < 4; ++q) { const f32x4 x0 = *(const f32x4*)(orow + 1024 * j + 4 * q), g0 = *(const f32x4*)(gt2 + 1024 * j + 4 * q); f32x4 o;
                      o[0] = x0[0] + g0[0] * ha[8 * j + 2 * q].x; o[1] = x0[1] + g0[1] * ha[8 * j + 2 * q].y; o[2] = x0[2] + g0[2] * ha[8 * j + 2 * q + 1].x; o[3] = x0[3] + g0[3] * ha[8 * j + 2 * q + 1].y;
                      *(f32x4*)(orow + 1024 * j + 4 * q) = o; } }
            LDS_WAIT();
        }
    }
}

__global__ void __launch_bounds__(512, 2) mk_fwd(Args args) {
    extern __shared__ __attribute__((aligned(16))) unsigned char lds_raw[];
    LAS unsigned char* lds = (LAS unsigned char*)lds_raw;
    const int tid = threadIdx.x, lane = tid & 63, wave = __builtin_amdgcn_readfirstlane(tid >> 6);
    const int G = gridDim.x, gw = blockIdx.x * 8 + wave, ngw = G * 8;
    unsigned char* ws = args.ws;
    volatile LAS unsigned* misc = (volatile LAS unsigned*)(lds + LDS_MAIN);
    if (tid < 4) misc[tid] = 0u;
    __syncthreads();
    const int lo = args.ph_lo, hi = args.ph_hi;
    XcdBarrier bar; bar.bar = (unsigned*)(ws + WS_CTL); bar.x = 0; bar.st = misc;
    if (hi - lo > 1) bar = xcd_barrier_post((unsigned*)(ws + WS_CTL), misc);
#define IN(k) (lo <= (k) && (k) < hi)
#define SEAM(k) do { if (IN(k) && IN((k) + 1)) xcd_barrier(bar); } while (0)
    float* mod = (float*)(ws + WS_MOD);
    bf16_t* HB = (bf16_t*)(ws + WS_H); bf16_t* PA = (bf16_t*)(ws + WS_PA); bf16_t* PG = (bf16_t*)(ws + WS_PG);
    bf16_t* YA = (bf16_t*)(ws + WS_YA); bf16_t* ATT = (bf16_t*)(ws + WS_ATT); f32x2* EB = (f32x2*)(ws + WS_E);

    if (IN(0)) { ph_mod_partial(args.in[I_C], args.in[I_WADA], (float*)(ws + WS_MODP), gw, ngw, lane); }
    SEAM(0);
    if (IN(1)) { ph_prologue(args, lds, gw, ngw, lane, wave); }
    SEAM(1);
    if (IN(2)) { ph_norm(args.in[I_X], HB, args.in[I_N1G], mod, 0, 2048, gw, ngw, lane); }
    SEAM(2);
    if (IN(3)) { pg8::Gemm g{HB, (const bf16_t*)(ws + WS_WIN), T_TOK, 8192, 2048}; pg8::StaticOrder S; S.init(T_TOK, 8192, G, (int)blockIdx.x);
        pg8::EpiProj E{PA, PG}; pg8::gemm_phase<pg8::EpiProj, pg8::StaticOrder, true, true>(lds, g, S, E); }
    SEAM(3);
    if (IN(4)) { ph_attn(lds, PA, ATT, args.in[I_QNG], args.in[I_KNG], G); ph_ssm_pass1(args, PA, EB, gw, ngw, lane); }
    SEAM(4);
    if (IN(5)) { ph_ssm_pass3(args, PA, EB, YA, gw, ngw, lane); __syncthreads();
        pg8::Gemm g{ATT, (const bf16_t*)(ws + WS_WATT), T_TOK, 2048, 1024}; pg8::StaticOrder S; S.init(T_TOK, 2048, G, (int)blockIdx.x);
        pg8::EpiAttUp E{PG, HB}; pg8::gemm_phase<pg8::EpiAttUp, pg8::StaticOrder, true, true>(lds, g, S, E); }
    SEAM(5);
    if (IN(6)) { pg8::Gemm g{YA, (const bf16_t*)(ws + WS_WGLU), T_TOK, 4096, 1024}; pg8::StaticOrder S; S.init(T_TOK, 4096, G, (int)blockIdx.x);
        pg8::EpiGlu E{PG, HB}; pg8::gemm_phase<pg8::EpiGlu, pg8::StaticOrder, true, true>(lds, g, S, E); }
    SEAM(6);
    if (IN(7)) { pg8::Gemm g{HB, (const bf16_t*)(ws + WS_WOUT), T_TOK, 2048, 2048}; pg8::StaticOrder S; S.init(T_TOK, 2048, G, (int)blockIdx.x);
        pg8::EpiOut E{args.in[I_X], args.out, mod}; pg8::gemm_phase<pg8::EpiOut, pg8::StaticOrder, true, true>(lds, g, S, E);
        ph_table_cvt(args.in[I_PU], args.in[I_PV], ws + WS_UT, ws + WS_VT, G); }
    SEAM(7);
    if (IN(8)) { ph_norm(args.out, HB, args.in[I_N2G], mod, 6144, 8192, gw, ngw, lane); }
    SEAM(8);
    if (IN(9)) { pg8::Gemm g{HB, (const bf16_t*)(ws + WS_WSC), T_TOK, 2048, 2048}; pg8::StaticOrder S; S.init(T_TOK, 2048, G, (int)blockIdx.x);
        pg8::EpiF32 E{(float*)(ws + WS_SC)}; pg8::gemm_phase<pg8::EpiF32, pg8::StaticOrder, true, true>(lds, g, S, E); }
    SEAM(9);
    if (IN(10)) { ph_peer(lds, (const float*)(ws + WS_SC), HB, ws + WS_UT, ws + WS_VT, mod, args.out, G); }
#undef IN
#undef SEAM
}

extern "C" void kernel_launch(void* const* d_in, const int* in_sizes, int n_in, void* d_out, int out_size, void* d_ws, size_t ws_size, hipStream_t stream) {
    static int grid = 0;
    if (grid == 0) {
        if (n_in != 25 || out_size != T_TOK * DM || ws_size < WS_END) { fprintf(stderr, "kernel_launch: unexpected shapes (n_in %d out %d ws %zu need %zu)\n", n_in, out_size, ws_size, (size_t)WS_END); grid = -1; return; }
        int dev = 0, cus = 0, per_cu = 0;
        if (hipGetDevice(&dev) != hipSuccess || hipDeviceGetAttribute(&cus, hipDeviceAttributeMultiprocessorCount, dev) != hipSuccess) { grid = -1; return; }
        if (hipFuncSetAttribute((const void*)mk_fwd, hipFuncAttributeMaxDynamicSharedMemorySize, LDS_BYTES) != hipSuccess) { fprintf(stderr, "kernel_launch: hipFuncSetAttribute failed\n"); grid = -1; return; }
        if (hipOccupancyMaxActiveBlocksPerMultiprocessor(&per_cu, (const void*)mk_fwd, 512, LDS_BYTES) != hipSuccess || per_cu < 1) { fprintf(stderr, "kernel_launch: occupancy query says %d blocks/CU\n", per_cu); (void)hipGetLastError(); grid = -1; return; }
        grid = cus;
    }
    if (grid < 0) return;
    (void)hipMemsetAsync((char*)d_ws + WS_CTL, 0, 16384, stream);
    Args a{};
    for (int i = 0; i < 25; ++i) a.in[i] = (const float*)d_in[i];
    a.out = (float*)d_out; a.ws = (unsigned char*)d_ws;
#if MK_PER_PHASE
    for (int ph = 0; ph < NPHASE; ++ph) { a.ph_lo = ph; a.ph_hi = ph + 1; hipLaunchKernelGGL(mk_fwd, dim3(grid), dim3(512), LDS_BYTES, stream, a); }
#else
    a.ph_lo = 0; a.ph_hi = NPHASE;
    hipLaunchKernelGGL(mk_fwd, dim3(grid), dim3(512), LDS_BYTES, stream, a);
#endif
}
```

```cpp
#include <hip/hip_runtime.h>
#include <cstdio>
#include <cstdint>

#ifndef MK_PER_PHASE
#define MK_PER_PHASE 0
#endif

#define LAS __attribute__((address_space(3)))
typedef unsigned short bf16_t;
typedef short bf16x8 __attribute__((ext_vector_type(8)));
typedef float f32x4 __attribute__((ext_vector_type(4)));
typedef float f32x2 __attribute__((ext_vector_type(2)));
typedef unsigned u32x4 __attribute__((ext_vector_type(4)));
typedef unsigned u32x2 __attribute__((ext_vector_type(2)));

constexpr int T_TOK = 16384, DM = 2048, SEQ = 8192;
constexpr int NPHASE = 11;
constexpr float EPS = 1e-6f;

constexpr size_t WS_CTL   = 0;
constexpr size_t WS_MODP  = 65536;
constexpr size_t WS_MOD   = WS_MODP + (size_t)32 * 2 * 12288 * 4;
constexpr size_t WS_WIN   = WS_MOD + (size_t)2 * 12288 * 4;
constexpr size_t WS_WGLU  = WS_WIN + (size_t)8192 * 2048 * 2;
constexpr size_t WS_WATT  = WS_WGLU + (size_t)4096 * 1024 * 2;
constexpr size_t WS_WOUT  = WS_WATT + (size_t)2048 * 1024 * 2;
constexpr size_t WS_WSC   = WS_WOUT + (size_t)2048 * 2048 * 2;
constexpr size_t WS_H     = WS_WSC + (size_t)2048 * 2048 * 2;
constexpr size_t WS_PA    = WS_H + (size_t)T_TOK * 2048 * 2;
constexpr size_t WS_PG    = WS_PA + (size_t)T_TOK * 4096 * 2;
constexpr size_t WS_E     = WS_PG + (size_t)T_TOK * 4096 * 2;
constexpr size_t WS_YA    = WS_E + (size_t)2 * 64 * 128 * 64 * 8;
constexpr size_t WS_ATT   = WS_YA + (size_t)T_TOK * 1024 * 2;
constexpr size_t WS_UB    = WS_ATT + (size_t)T_TOK * 1024 * 2;
constexpr size_t WS_END   = WS_UB + (size_t)T_TOK * 1024 * 2;
constexpr size_t WS_SC    = WS_PA;
constexpr size_t WS_UT    = WS_PG;
constexpr size_t WS_VT    = WS_PG + (size_t)16384 * 2048;

constexpr int LDS_MAIN = 131072, LDS_BYTES = LDS_MAIN + 256;

typedef __bf16 bf16x2_t __attribute__((ext_vector_type(2)));
__device__ __forceinline__ unsigned cvt_pk_bf16(float lo, float hi) { const f32x2 v = {lo, hi}; return __builtin_bit_cast(unsigned, __builtin_convertvector(v, bf16x2_t)); }
__device__ __forceinline__ float bf_lo(unsigned w) { return __uint_as_float(w << 16); }
__device__ __forceinline__ float bf_hi(unsigned w) { return __uint_as_float(w & 0xffff0000u); }
__device__ __forceinline__ float wave_sum(float v) {
#pragma unroll
    for (int o = 1; o < 64; o <<= 1) v += __shfl_xor(v, o);
    return v;
}
__device__ __forceinline__ float sigmoidf_(float x) { return 1.0f / (1.0f + __expf(-x)); }
__device__ __forceinline__ float gelu_tanh(float x) {
    const float a = 0.7978845608028654f * (x + 0.044715f * x * x * x);
    const float t = 1.0f - 2.0f / (__expf(2.0f * a) + 1.0f);
    return 0.5f * x * (1.0f + t);
}
#define LDS_WAIT() asm volatile("s_waitcnt lgkmcnt(0)" ::: "memory")
__device__ __forceinline__ int opaque_tid() { int t = threadIdx.x; asm volatile("" : "+v"(t)); return t; }

#define XB_TMO      128
#define XB_XCNT(j)  (256  + 64 * (j))
#define XB_XSUB(j)  (1280 + 64 * (j))
#define XB_XGEN(j)  (2304 + 64 * (j))
#define XB_TOP      3328
#define XB_TOPGEN   3392
#define XCD_BAR_WORDS 3456
#define XB_SPIN_CAP (1u << 22)
__device__ __forceinline__ unsigned xb_ld(unsigned* p)              { return __hip_atomic_load(p, __ATOMIC_RELAXED, __HIP_MEMORY_SCOPE_AGENT); }
__device__ __forceinline__ unsigned xb_add(unsigned* p, unsigned v) { return __hip_atomic_fetch_add(p, v, __ATOMIC_RELAXED, __HIP_MEMORY_SCOPE_AGENT); }
__device__ __forceinline__ unsigned xb_xcc_id() { return (unsigned)__builtin_amdgcn_s_getreg((3 << 11) | 20) & 0xFu; }
#define XB_SPIN(cond, bar) do { unsigned _sp = 0; while (cond) { __builtin_amdgcn_s_sleep(1); \
    if ((++_sp & 255u) == 0u) { if (xb_ld(&(bar)[XB_TMO])) break; if (_sp > XB_SPIN_CAP) { atomicAdd(&(bar)[XB_TMO], 1u); break; } } } } while (0)
struct XcdBarrier { unsigned* bar; unsigned x; volatile LAS unsigned* st; };
__device__ __forceinline__ XcdBarrier xcd_barrier_post(unsigned* bar, volatile LAS unsigned* st) {
    XcdBarrier b; b.bar = bar; b.x = xb_xcc_id(); b.st = st;
    if (threadIdx.x == 0) (void)xb_add(&bar[XB_XCNT(b.x)], 1u);
    return b;
}
__device__ __forceinline__ void xcd_barrier_complete(unsigned* bar, unsigned x, unsigned& nloc, unsigned& nx) {
    const unsigned G = gridDim.x * gridDim.y * gridDim.z;
    unsigned sum, cnt, mine, sp = 0u;
    for (;;) {
        sum = 0u; cnt = 0u; mine = 0u;
#pragma unroll
        for (unsigned j = 0; j < 16; ++j) { const unsigned c = xb_ld(&bar[XB_XCNT(j)]); sum += c; cnt += (c > 0u) ? 1u : 0u; mine = (j == x) ? c : mine; }
        if (sum == G) break;
        __builtin_amdgcn_s_sleep(1);
        if ((++sp & 255u) == 0u) { if (xb_ld(&bar[XB_TMO])) break; if (sp > XB_SPIN_CAP) { atomicAdd(&bar[XB_TMO], 1u); break; } }
    }
    nloc = mine > 0u ? mine : 1u; nx = cnt > 0u ? cnt : 1u;
}
__device__ __forceinline__ void xcd_barrier(const XcdBarrier& b) {
    asm volatile("s_waitcnt vmcnt(0)" ::: "memory");
    __syncthreads();
    if (threadIdx.x == 0) {
        unsigned* bar = b.bar;
        __builtin_amdgcn_s_waitcnt(0);
        unsigned nloc = b.st[0], nx = b.st[1];
        if (nloc == 0u) { xcd_barrier_complete(bar, b.x, nloc, nx); b.st[0] = nloc; b.st[1] = nx; }
        const unsigned old = xb_add(&bar[XB_XSUB(b.x)], 1u);
        const unsigned gen = old / nloc;
        if (old + 1u == (gen + 1u) * nloc) {
            __builtin_amdgcn_fence(__ATOMIC_RELEASE, "agent");
            asm volatile("s_waitcnt vmcnt(0)" ::: "memory");
            const unsigned og = xb_add(&bar[XB_TOP], 1u);
            const unsigned tg = og / nx;
            if (og + 1u == (tg + 1u) * nx) xb_add(&bar[XB_TOPGEN], 1u);
            else XB_SPIN(xb_ld(&bar[XB_TOPGEN]) == tg, bar);
            __builtin_amdgcn_fence(__ATOMIC_ACQUIRE, "agent");
            xb_add(&bar[XB_XGEN(b.x)], 1u);
            asm volatile("s_waitcnt vmcnt(0)" ::: "memory");
        } else {
            XB_SPIN(xb_ld(&bar[XB_XGEN(b.x)]) == gen, bar);
            __builtin_amdgcn_fence(__ATOMIC_ACQUIRE, "agent");
            asm volatile("s_waitcnt vmcnt(0)" ::: "memory");
        }
    }
    __syncthreads();
}

namespace pg8 {
constexpr int BM = 256, BK = 64, HALF = 128, HTB = HALF * BK * 2, STAGE_BYTES = 8 * HTB, NXCD = 8, WGM = 8;
__host__ __device__ __forceinline__ int lds_byte(int r, int c) { const int st = (r >> 4) * 2 + (c >> 5), rr = r & 15, cc = c & 31, ob = rr * 64 + cc * 2; return st * 1024 + (ob ^ (((ob >> 9) & 1) << 5)); }
__host__ __device__ __forceinline__ void stage_rc(int b, int& R, int& C) { const int st = b / 1024, sb = b % 1024, swz = sb ^ (((sb >> 9) & 1) << 5); R = (st >> 1) * 16 + swz / 64; C = (st & 1) * 32 + (swz % 64) / 2; }
__host__ __device__ __forceinline__ int perm32(int rho) { const int n = rho >> 4, i = rho & 15; return 8 * (i >> 2) + 4 * n + (i & 3); }
struct Unit { int pm, pn; };
struct Gemm { const bf16_t* A; const bf16_t* Bt; int M, N, K; };
struct StaticOrder {
    int nM, nN, nwg, G, c;
    __host__ __device__ void init(int M, int N, int G_, int c_) { nM = M / BM; nN = N / BM; nwg = nM * nN; G = G_; c = c_; }
    __host__ __device__ bool next(int i, Unit& u) const {
        const long L = (long)i * G + c; if (L >= nwg) return false;
        int wgid = (int)L; { const int q = nwg / NXCD, r = nwg % NXCD, xcd = wgid % NXCD, off = wgid / NXCD; wgid = (xcd < r ? xcd * (q + 1) : r * (q + 1) + (xcd - r) * q) + off; }
        const int nig = WGM * nN, gid = wgid / nig, fm = gid * WGM, gsz = (nM - fm) < WGM ? (nM - fm) : WGM;
        u.pm = fm + ((wgid % nig) % gsz); u.pn = (wgid % nig) / gsz; return true;
    }
    __device__ __forceinline__ void a_ready(const Unit&) const {}
    __device__ __forceinline__ void done(const Unit&) const {}
};
template <class Epi, class Sched, bool ALIGN_EPI = false, bool SP2 = false>
__device__ __forceinline__ void gemm_phase(LAS unsigned char* lds, const Gemm g, const Sched& S, const Epi& E) {
    const int tid = opaque_tid(), wid = __builtin_amdgcn_readfirstlane(tid >> 6), lane = tid & 63, wr = wid >> 2, wc = wid & 3, fr = lane & 15, fq = lane >> 4;
    const int K = g.K, nt = K / BK;
    unsigned voffA[2], voffB[2];
#pragma unroll
    for (int i = 0; i < 2; ++i) { int R, C; stage_rc(tid * 16 + i * 8192, R, C); const int Rb = Epi::PERM ? ((R & ~31) + perm32(R & 31)) : R;
        voffA[i] = (unsigned)(R * K + C) * 2u; voffB[i] = (unsigned)(Rb * K + C) * 2u; }
    const size_t kstep = (size_t)(BK * 2);
    const size_t hstep = (size_t)HALF * K * 2;
    const size_t tstep = 2 * hstep;
    const unsigned ldsw = (unsigned)wid * 1024u;
    const int aoff = lds_byte(wr * 64 + fr, fq * 8), boff = lds_byte(wc * 32 + fr, fq * 8);
#define PG8_SA(b, h) (((b) * 2 + (h)) * HTB)
#define PG8_SB(b, h) ((4 + (b) * 2 + (h)) * HTB)
#define PG8_STAGE(bufoff, gbase, voff) do { _Pragma("unroll") for (int _i = 0; _i < 2; ++_i) \
        __builtin_amdgcn_global_load_lds((const unsigned*)((const char*)(gbase) + (voff)[_i]), (LAS unsigned*)(lds + (bufoff) + ldsw + _i * 8192), 16, 0, 0); } while (0)
#define PG8_LDA(dst, b, h) do { _Pragma("unroll") for (int m = 0; m < 4; ++m) _Pragma("unroll") for (int k = 0; k < 2; ++k) dst[m][k] = *(const LAS bf16x8*)(lds + PG8_SA(b, h) + aoff + m * 2048 + k * 1024); } while (0)
#define PG8_LDB(dst, b, h) do { _Pragma("unroll") for (int n = 0; n < 2; ++n) _Pragma("unroll") for (int k = 0; k < 2; ++k) dst[n][k] = *(const LAS bf16x8*)(lds + PG8_SB(b, h) + boff + n * 2048 + k * 1024); } while (0)
#define PG8_MMA(ai, bj, At, Bt) do { __builtin_amdgcn_s_setprio(1); _Pragma("unroll") for (int m = 0; m < 4; ++m) _Pragma("unroll") for (int n = 0; n < 2; ++n) _Pragma("unroll") for (int k = 0; k < 2; ++k) \
        acc[ai][bj][m][n] = __builtin_amdgcn_mfma_f32_16x16x32_bf16(Bt[n][k], At[m][k], acc[ai][bj][m][n], 0, 0, 0); __builtin_amdgcn_s_setprio(0); } while (0)
#define PG8_WAIT_V(n) asm volatile("s_waitcnt vmcnt(" #n ")" ::: "memory")
#define PG8_WAIT_L(n) asm volatile("s_waitcnt lgkmcnt(" #n ")" ::: "memory")
#define PG8_BAR __builtin_amdgcn_s_barrier()
#define PG8_SCHED __builtin_amdgcn_sched_barrier(0)
    Unit cur, nxt; int ui = 0;
    if (!S.next(0, cur)) return;
    f32x4 acc[2][2][4][2];
#pragma unroll
    for (int a = 0; a < 2; ++a)
#pragma unroll
        for (int b = 0; b < 2; ++b)
#pragma unroll
            for (int m = 0; m < 4; ++m)
#pragma unroll
                for (int n = 0; n < 2; ++n) acc[a][b][m][n] = (f32x4){0.f, 0.f, 0.f, 0.f};
    bf16x8 At[4][2], B0[2][2], B1[2][2];
    const char* cA = (const char*)g.A + (size_t)cur.pm * tstep; const char* cB = (const char*)g.Bt + (size_t)cur.pn * tstep;
    S.a_ready(cur);
    if constexpr (SP2) {
        PG8_STAGE(PG8_SB(0, 0), cB, voffB); PG8_STAGE(PG8_SB(0, 1), cB + hstep, voffB); PG8_STAGE(PG8_SA(0, 0), cA, voffA); PG8_STAGE(PG8_SA(0, 1), cA + hstep, voffA);
        if (wr == 1) PG8_BAR;
        PG8_WAIT_V(2); PG8_BAR;
        PG8_STAGE(PG8_SB(1, 0), cB + kstep, voffB); PG8_STAGE(PG8_SA(1, 0), cA + kstep, voffA); PG8_STAGE(PG8_SB(1, 1), cB + hstep + kstep, voffB);
        PG8_WAIT_V(6); PG8_BAR;
    } else {
        PG8_STAGE(PG8_SB(0, 0), cB, voffB); PG8_STAGE(PG8_SA(0, 0), cA, voffA); PG8_STAGE(PG8_SB(0, 1), cB + hstep, voffB); PG8_STAGE(PG8_SA(0, 1), cA + hstep, voffA);
        if (wr == 1) PG8_BAR;
        PG8_WAIT_V(4); PG8_BAR;
        PG8_STAGE(PG8_SB(1, 0), cB + kstep, voffB); PG8_STAGE(PG8_SA(1, 0), cA + kstep, voffA); PG8_STAGE(PG8_SB(1, 1), cB + hstep + kstep, voffB);
        PG8_WAIT_V(6); PG8_BAR;
    }
    for (;;) {
        const bool has_next = S.next(ui + 1, nxt);
        const char* nA = has_next ? (const char*)g.A + (size_t)nxt.pm * tstep : cA; const char* nB = has_next ? (const char*)g.Bt + (size_t)nxt.pn * tstep : cB;
        for (int t = 0; t < nt; t += 2) {
            const bool last = (t == nt - 2);
            const char* a1 = cA + (size_t)(t + 1) * kstep;
            const char* a2 = last ? nA : cA + (size_t)(t + 2) * kstep; const char* b2 = last ? nB : cB + (size_t)(t + 2) * kstep;
            const char* a3 = a2 + kstep; const char* b3 = b2 + kstep;
            if (last && has_next) S.a_ready(nxt);
            if constexpr (SP2) {
            PG8_LDB(B0, 0, 0); PG8_LDB(B1, 0, 1); PG8_SCHED; PG8_LDA(At, 0, 0); PG8_STAGE(PG8_SA(1, 1), a1 + hstep, voffA);
            PG8_WAIT_V(8); PG8_WAIT_L(0); PG8_BAR; PG8_MMA(0, 0, At, B0); PG8_MMA(0, 1, At, B1); PG8_BAR; PG8_SCHED;
            PG8_LDA(At, 0, 1); PG8_STAGE(PG8_SB(0, 0), b2, voffB); PG8_STAGE(PG8_SB(0, 1), b2 + hstep, voffB); PG8_STAGE(PG8_SA(0, 0), a2, voffA);
            PG8_WAIT_V(8); PG8_WAIT_L(0); PG8_BAR; PG8_MMA(1, 0, At, B0); PG8_MMA(1, 1, At, B1); PG8_BAR; PG8_SCHED;
            PG8_LDB(B0, 1, 0); PG8_LDB(B1, 1, 1); PG8_SCHED; PG8_LDA(At, 1, 0); PG8_STAGE(PG8_SA(0, 1), a2 + hstep, voffA);
            PG8_WAIT_V(8); PG8_WAIT_L(0); PG8_BAR; PG8_MMA(0, 0, At, B0); PG8_MMA(0, 1, At, B1); PG8_BAR; PG8_SCHED;
            PG8_LDA(At, 1, 1); PG8_STAGE(PG8_SB(1, 0), b3, voffB); PG8_STAGE(PG8_SB(1, 1), b3 + hstep, voffB); PG8_STAGE(PG8_SA(1, 0), a3, voffA);
            PG8_WAIT_V(8); PG8_WAIT_L(0); PG8_BAR; PG8_MMA(1, 0, At, B0); PG8_MMA(1, 1, At, B1); PG8_BAR; PG8_SCHED;
            } else {
            PG8_LDB(B0, 0, 0); PG8_SCHED; PG8_LDA(At, 0, 0); PG8_STAGE(PG8_SA(1, 1), a1 + hstep, voffA);
            PG8_WAIT_L(8); PG8_BAR; PG8_WAIT_L(0); PG8_MMA(0, 0, At, B0); PG8_BAR; PG8_SCHED;
            PG8_LDB(B1, 0, 1); PG8_STAGE(PG8_SB(0, 0), b2, voffB);
            PG8_BAR; PG8_WAIT_L(0); PG8_MMA(0, 1, At, B1); PG8_BAR;
            PG8_LDA(At, 0, 1); PG8_STAGE(PG8_SA(0, 0), a2, voffA);
            PG8_BAR; PG8_WAIT_L(0); PG8_MMA(1, 0, At, B0); PG8_BAR; PG8_SCHED;
            PG8_STAGE(PG8_SB(0, 1), b2 + hstep, voffB);
            PG8_WAIT_V(6); PG8_BAR; PG8_MMA(1, 1, At, B1); PG8_BAR;
            PG8_LDB(B0, 1, 0); PG8_SCHED; PG8_LDA(At, 1, 0); PG8_STAGE(PG8_SA(0, 1), a2 + hstep, voffA);
            PG8_WAIT_L(8); PG8_BAR; PG8_WAIT_L(0); PG8_MMA(0, 0, At, B0); PG8_BAR; PG8_SCHED;
            PG8_LDB(B1, 1, 1); PG8_STAGE(PG8_SB(1, 0), b3, voffB);
            PG8_BAR; PG8_WAIT_L(0); PG8_MMA(0, 1, At, B1); PG8_BAR;
            PG8_LDA(At, 1, 1); PG8_STAGE(PG8_SA(1, 0), a3, voffA);
            PG8_BAR; PG8_WAIT_L(0); PG8_MMA(1, 0, At, B0); PG8_BAR; PG8_SCHED;
            PG8_STAGE(PG8_SB(1, 1), b3 + hstep, voffB);
            PG8_WAIT_V(6); PG8_BAR; PG8_MMA(1, 1, At, B1); PG8_BAR;
            }
        }
        if constexpr (ALIGN_EPI) { if (wr == 0) PG8_BAR; }
        E(acc, cur, wr, wc, fr, fq); S.done(cur);
        if (!has_next) break;
#pragma unroll
        for (int a = 0; a < 2; ++a)
#pragma unroll
            for (int b = 0; b < 2; ++b)
#pragma unroll
                for (int m = 0; m < 4; ++m)
#pragma unroll
                    for (int n = 0; n < 2; ++n) acc[a][b][m][n] = (f32x4){0.f, 0.f, 0.f, 0.f};
        cur = nxt; cA = nA; cB = nB; ++ui;
        if constexpr (ALIGN_EPI) { if (wr == 1) PG8_BAR; }
    }
    PG8_WAIT_V(0);
    if constexpr (!ALIGN_EPI) { if (wr == 0) PG8_BAR; }
    PG8_BAR;
#undef PG8_SA
#undef PG8_SB
#undef PG8_STAGE
#undef PG8_LDA
#undef PG8_LDB
#undef PG8_MMA
#undef PG8_WAIT_V
#undef PG8_WAIT_L
#undef PG8_BAR
#undef PG8_SCHED
}

struct EpiProj {
    static constexpr bool PERM = true;
    bf16_t* PA; bf16_t* PG; bf16_t* UB;
    __device__ __forceinline__ void operator()(const f32x4 (&acc)[2][2][4][2], const Unit& u, int wr, int wc, int fr, int fq) const {
        const int row0 = u.pm * BM + wr * 64 + fr; int colt = u.pn * BM; const bool isu = colt < 1024; bf16_t* base = colt < 4096 ? PA : PG; colt &= 4095;
        const int col0 = colt + wc * 32 + 8 * fq;
#pragma unroll
        for (int ai = 0; ai < 2; ++ai)
#pragma unroll
            for (int m = 0; m < 4; ++m) { const int row = row0 + ai * HALF + m * 16; bf16_t* rowp = base + (size_t)row * 4096 + col0;
#pragma unroll
                for (int bj = 0; bj < 2; ++bj) { const f32x4 v0 = acc[ai][bj][m][0], v1 = acc[ai][bj][m][1];
                    u32x4 w; w.x = cvt_pk_bf16(v0[0], v0[1]); w.y = cvt_pk_bf16(v0[2], v0[3]); w.z = cvt_pk_bf16(v1[0], v1[1]); w.w = cvt_pk_bf16(v1[2], v1[3]);
                    if (isu) { const int cu = col0 + bj * HALF; *(u32x4*)(UB + (((size_t)((row >> 13) * 64 + (cu >> 4)) * 8192 + (row & 8191)) * 16 + (cu & 8))) = w; }
                    else *(u32x4*)(rowp + bj * HALF) = w; } }
    }
};
struct EpiAttUp {
    static constexpr bool PERM = true;
    const bf16_t* PG; bf16_t* HB;
    __device__ __forceinline__ void operator()(const f32x4 (&acc)[2][2][4][2], const Unit& u, int wr, int wc, int fr, int fq) const {
        const int row0 = u.pm * BM + wr * 64 + fr; const int col0 = u.pn * BM + wc * 32 + 8 * fq;
#pragma unroll
        for (int ai = 0; ai < 2; ++ai)
#pragma unroll
            for (int m = 0; m < 4; ++m) { const size_t row = (size_t)(row0 + ai * HALF + m * 16);
#pragma unroll
                for (int bj = 0; bj < 2; ++bj) { const int col = col0 + bj * HALF;
                    const u32x4 gw = *(const u32x4*)(PG + row * 4096 + 2048 + col);
                    const f32x4 v0 = acc[ai][bj][m][0], v1 = acc[ai][bj][m][1];
                    u32x4 w;
                    w.x = cvt_pk_bf16(v0[0] * sigmoidf_(bf_lo(gw.x)), v0[1] * sigmoidf_(bf_hi(gw.x)));
                    w.y = cvt_pk_bf16(v0[2] * sigmoidf_(bf_lo(gw.y)), v0[3] * sigmoidf_(bf_hi(gw.y)));
                    w.z = cvt_pk_bf16(v1[0] * sigmoidf_(bf_lo(gw.z)), v1[1] * sigmoidf_(bf_hi(gw.z)));
                    w.w = cvt_pk_bf16(v1[2] * sigmoidf_(bf_lo(gw.w)), v1[3] * sigmoidf_(bf_hi(gw.w)));
                    *(u32x4*)(HB + row * 2048 + col) = w; } }
    }
};
struct EpiGlu {
    static constexpr bool PERM = true;
    const bf16_t* PG; bf16_t* HB;
    __device__ __forceinline__ void operator()(const f32x4 (&acc)[2][2][4][2], const Unit& u, int wr, int wc, int fr, int fq) const {
        const int row0 = u.pm * BM + wr * 64 + fr; const int col = u.pn * HALF + wc * 32 + 8 * fq;
#pragma unroll
        for (int ai = 0; ai < 2; ++ai)
#pragma unroll
            for (int m = 0; m < 4; ++m) { const size_t row = (size_t)(row0 + ai * HALF + m * 16);
                const u32x4 gw = *(const u32x4*)(PG + row * 4096 + col);
                const u32x4 aw = *(const u32x4*)(HB + row * 2048 + col);
                const f32x4 a0 = acc[ai][0][m][0], a1 = acc[ai][0][m][1], g0 = acc[ai][1][m][0], g1 = acc[ai][1][m][1];
                u32x4 w;
                w.x = cvt_pk_bf16(sigmoidf_(bf_lo(gw.x)) * a0[0] * sigmoidf_(g0[0]) + bf_lo(aw.x), sigmoidf_(bf_hi(gw.x)) * a0[1] * sigmoidf_(g0[1]) + bf_hi(aw.x));
                w.y = cvt_pk_bf16(sigmoidf_(bf_lo(gw.y)) * a0[2] * sigmoidf_(g0[2]) + bf_lo(aw.y), sigmoidf_(bf_hi(gw.y)) * a0[3] * sigmoidf_(g0[3]) + bf_hi(aw.y));
                w.z = cvt_pk_bf16(sigmoidf_(bf_lo(gw.z)) * a1[0] * sigmoidf_(g1[0]) + bf_lo(aw.z), sigmoidf_(bf_hi(gw.z)) * a1[1] * sigmoidf_(g1[1]) + bf_hi(aw.z));
                w.w = cvt_pk_bf16(sigmoidf_(bf_lo(gw.w)) * a1[2] * sigmoidf_(g1[2]) + bf_lo(aw.w), sigmoidf_(bf_hi(gw.w)) * a1[3] * sigmoidf_(g1[3]) + bf_hi(aw.w));
                *(u32x4*)(HB + row * 2048 + col) = w; }
    }
};
struct EpiOut {
    static constexpr bool PERM = true;
    const float* X; float* O; const float* mod;
    __device__ __forceinline__ void operator()(const f32x4 (&acc)[2][2][4][2], const Unit& u, int wr, int wc, int fr, int fq) const {
        const int row0 = u.pm * BM + wr * 64 + fr; const int col0 = u.pn * BM + wc * 32 + 8 * fq;
        const float* gt = mod + (size_t)((u.pm * BM) >> 13) * 12288 + 4096;
#pragma unroll
        for (int bj = 0; bj < 2; ++bj) { const int col = col0 + bj * HALF;
            const f32x4 g0 = *(const f32x4*)(gt + col), g1 = *(const f32x4*)(gt + col + 4);
#pragma unroll
            for (int ai = 0; ai < 2; ++ai)
#pragma unroll
                for (int m = 0; m < 4; ++m) { const size_t off = (size_t)(row0 + ai * HALF + m * 16) * 2048 + col;
                    const f32x4 x0 = *(const f32x4*)(X + off), x1 = *(const f32x4*)(X + off + 4);
                    *(f32x4*)(O + off) = x0 + g0 * acc[ai][bj][m][0]; *(f32x4*)(O + off + 4) = x1 + g1 * acc[ai][bj][m][1]; } }
    }
};
struct EpiF32 {
    static constexpr bool PERM = true;
    float* O;
    __device__ __forceinline__ void operator()(const f32x4 (&acc)[2][2][4][2], const Unit& u, int wr, int wc, int fr, int fq) const {
        const int row0 = u.pm * BM + wr * 64 + fr; const int col0 = u.pn * BM + wc * 32 + 8 * fq;
#pragma unroll
        for (int ai = 0; ai < 2; ++ai)
#pragma unroll
            for (int m = 0; m < 4; ++m) { float* rowp = O + (size_t)(row0 + ai * HALF + m * 16) * 2048 + col0;
#pragma unroll
                for (int bj = 0; bj < 2; ++bj) { *(f32x4*)(rowp + bj * HALF) = acc[ai][bj][m][0]; *(f32x4*)(rowp + bj * HALF + 4) = acc[ai][bj][m][1]; } }
    }
};
}

struct Args { const float* in[25]; float* out; unsigned char* ws; int ph_lo, ph_hi; };
enum { I_X = 0, I_C, I_WADA, I_BADA, I_N1G, I_WIN, I_LRE, I_LIM, I_LDT, I_BRE, I_BIM, I_CRE, I_CIM, I_SD, I_WGLU, I_QNG, I_KNG, I_WATT, I_WOUT, I_N2G, I_WQ, I_K1, I_K2, I_PU, I_PV };

__device__ __forceinline__ void ph_mod_partial(const float* __restrict__ c, const float* __restrict__ w_ada, float* modp, int gw, int ngw, int lane) {
    for (int task = gw; task < 48 * 32; task += ngw) {
        const int strip = task % 48, ks = task / 48, n0 = strip * 256 + lane * 4, k0 = ks * 64;
        f32x4 a0 = {0.f, 0.f, 0.f, 0.f}, a1 = {0.f, 0.f, 0.f, 0.f};
#pragma unroll 8
        for (int k = 0; k < 64; ++k) {
            const f32x4 w = *(const f32x4*)(w_ada + (size_t)(k0 + k) * 12288 + n0);
            float c0 = c[k0 + k], c1 = c[2048 + k0 + k];
            c0 = c0 / (1.0f + __expf(-c0)); c1 = c1 / (1.0f + __expf(-c1));
            a0 += c0 * w; a1 += c1 * w;
        }
        *(f32x4*)(modp + (size_t)(ks * 2 + 0) * 12288 + n0) = a0;
        *(f32x4*)(modp + (size_t)(ks * 2 + 1) * 12288 + n0) = a1;
    }
}

__device__ __forceinline__ void transpose_item(const float* __restrict__ W, int K, int N, bf16_t* WT, int drow0, int scol0, int k0, LAS float* scr, int lane) {
#pragma unroll 8
    for (int i = 0; i < 32; ++i) { const int kk = 2 * i + (lane >> 5); scr[kk * 33 + (lane & 31)] = W[(size_t)(k0 + kk) * N + scol0 + (lane & 31)]; }
    LDS_WAIT();
    const int c = lane & 7;
#pragma unroll
    for (int j = 0; j < 4; ++j) { const int n = (lane >> 3) + 8 * j; const LAS float* s = scr + (8 * c) * 33 + n;
        u32x4 o; o.x = cvt_pk_bf16(s[0 * 33], s[1 * 33]); o.y = cvt_pk_bf16(s[2 * 33], s[3 * 33]); o.z = cvt_pk_bf16(s[4 * 33], s[5 * 33]); o.w = cvt_pk_bf16(s[6 * 33], s[7 * 33]);
        *(u32x4*)(WT + (size_t)(drow0 + n) * K + k0 + 8 * c) = o; }
    LDS_WAIT();
}
__device__ __forceinline__ void wsc_item(const float* wq, const float* kk, bf16_t* out, int lane) {
    const int r = lane & 15, q = lane >> 4;
    f32x4 acc[8];
#pragma unroll
    for (int f = 0; f < 8; ++f) acc[f] = (f32x4){0.f, 0.f, 0.f, 0.f};
    const float* ap = kk + r * 128 + 4 * q; const float* bp = wq + (size_t)r * 2048 + 4 * q;
#pragma unroll 2
    for (int d0 = 0; d0 < 128; d0 += 16) {
        const f32x4 bv = *(const f32x4*)(bp + d0);
        f32x4 av[8];
#pragma unroll
        for (int f = 0; f < 8; ++f) av[f] = *(const f32x4*)(ap + f * 2048 + d0);
#pragma unroll
        for (int j = 0; j < 4; ++j)
#pragma unroll
            for (int f = 0; f < 8; ++f) acc[f] = __builtin_amdgcn_mfma_f32_16x16x4f32(av[f][j], bv[j], acc[f], 0, 0, 0);
    }
#pragma unroll
    for (int f = 0; f < 8; ++f)
#pragma unroll
        for (int i = 0; i < 4; ++i) out[(size_t)(16 * f + 4 * q + i) * 2048 + r] = (bf16_t)(cvt_pk_bf16(acc[f][i], 0.f) & 0xffffu);
}
__device__ __forceinline__ void ph_prologue(const Args& a, LAS unsigned char* lds, int gw, int ngw, int lane, int wave) {
    unsigned char* ws = a.ws;
    { const float* modp = (const float*)(ws + WS_MODP); float* mod = (float*)(ws + WS_MOD); const float* b_ada = a.in[I_BADA];
      for (int idx = gw * 64 + lane; idx < 2 * 12288; idx += ngw * 64) { const int b = idx / 12288, n = idx - b * 12288; float s = b_ada[n];
#pragma unroll 8
          for (int ks = 0; ks < 32; ++ks) s += modp[(size_t)(ks * 2 + b) * 12288 + n];
          mod[idx] = s; } }
    for (int item = gw; item < 2048; item += ngw) { const int hj = item >> 7, k0 = (item & 127) * 16;
        wsc_item(a.in[I_WQ] + (size_t)k0 * 2048 + hj * 128, (hj & 1) ? a.in[I_K2] : a.in[I_K1], (bf16_t*)(ws + WS_WSC) + (size_t)(hj * 128) * 2048 + k0, lane); }
    { LAS float* scr = (LAS float*)(lds + wave * 8448);
      constexpr int I_IN = 32 * 256, I_GLU = 16 * 128, I_ATT = 16 * 64, I_OUT = 32 * 64, NIT = I_IN + I_GLU + I_ATT + I_OUT;
      for (int it = gw; it < NIT; it += ngw) {
          int r = it;
          if (r < I_IN) { const int kb = r / 256, nb = r % 256; transpose_item(a.in[I_WIN], 2048, 8192, (bf16_t*)(ws + WS_WIN), 32 * nb, 32 * nb, 64 * kb, scr, lane); continue; } r -= I_IN;
          if (r < I_GLU) { const int kb = r / 128, nb = r % 128, dr = 32 * nb; const int sc = ((dr >> 7) & 1) * 2048 + (dr >> 8) * 128 + (dr & 127);
              transpose_item(a.in[I_WGLU], 1024, 4096, (bf16_t*)(ws + WS_WGLU), dr, sc, 64 * kb, scr, lane); continue; } r -= I_GLU;
          if (r < I_ATT) { const int kb = r / 64, nb = r % 64; transpose_item(a.in[I_WATT], 1024, 2048, (bf16_t*)(ws + WS_WATT), 32 * nb, 32 * nb, 64 * kb, scr, lane); continue; } r -= I_ATT;
          { const int kb = r / 64, nb = r % 64; transpose_item(a.in[I_WOUT], 2048, 2048, (bf16_t*)(ws + WS_WOUT), 32 * nb, 32 * nb, 64 * kb, scr, lane); }
      } }
}

__device__ __forceinline__ void ph_norm(const float* X, bf16_t* Hout, const float* __restrict__ g, const float* mod, int sh_off, int sc_off, int gw, int ngw, int lane) {
    for (int row = gw; row < T_TOK; row += ngw) {
        const int b = row >> 13;
        const f32x4* xr = (const f32x4*)(X + (size_t)row * DM) + lane;
        f32x4 v[8]; float ss = 0.f;
#pragma unroll
        for (int j = 0; j < 8; ++j) { v[j] = xr[64 * j]; ss += (v[j][0] * v[j][0] + v[j][1] * v[j][1]) + (v[j][2] * v[j][2] + v[j][3] * v[j][3]); }
        ss = wave_sum(ss);
        const float rs = 1.0f / sqrtf(ss * (1.0f / DM) + EPS);
        const float* mb = mod + (size_t)b * 12288;
#pragma unroll
        for (int j = 0; j < 8; ++j) { const int col = 4 * (lane + 64 * j);
            const f32x4 gv = *(const f32x4*)(g + col), sc = *(const f32x4*)(mb + sc_off + col), sh = *(const f32x4*)(mb + sh_off + col);
            const f32x4 o = v[j] * rs * gv * (sc + 1.0f) + sh;
            u32x2 w; w.x = cvt_pk_bf16(o[0], o[1]); w.y = cvt_pk_bf16(o[2], o[3]);
            *(u32x2*)(Hout + (size_t)row * DM + col) = w; }
    }
}

__device__ __forceinline__ void ph_attn(LAS unsigned char* lds, const bf16_t* PA, bf16_t* ATT, const float* __restrict__ qg, const float* __restrict__ kg, int G) {
    const int tid = opaque_tid(), lane = tid & 63, wave = __builtin_amdgcn_readfirstlane(tid >> 6), c = lane & 15, g = lane >> 4;
    LAS unsigned char* KL = lds;
    LAS unsigned char* VT = lds + 17408;
    bf16x8 tri[6];
    { const int FS[6] = {0, 1, 0, 1, 2, 3}, FP[6] = {0, 0, 1, 1, 1, 1};
#pragma unroll
      for (int q = 0; q < 6; ++q)
#pragma unroll
          for (int jj = 0; jj < 8; ++jj) { const int kap = 32 * FP[q] + 16 * (jj >> 2) + 4 * g + (jj & 3); tri[q][jj] = (kap > 16 * FS[q] + c) ? (short)0x3F80 : (short)0; } }
    for (int u = blockIdx.x; u < 1024; u += G) {
        const int b = u >> 9, h = (u >> 6) & 7, qb = u & 63, t0 = qb * 128, tq0 = t0 + 16 * wave, tq = tq0 + c;
        bf16x8 qf[4];
        { const bf16_t* qrow = PA + (size_t)(b * SEQ + tq) * 4096 + 1024 + h * 128;
          u32x4 qr[4]; float ss = 0.f;
#pragma unroll
          for (int kk = 0; kk < 4; ++kk) { qr[kk] = *(const u32x4*)(qrow + 32 * kk + 8 * g);
#pragma unroll
              for (int e = 0; e < 4; ++e) { const float lo = bf_lo(qr[kk][e]), hi = bf_hi(qr[kk][e]); ss += lo * lo + hi * hi; } }
          ss += __shfl_xor(ss, 16); ss += __shfl_xor(ss, 32);
          const float rs = (1.0f / sqrtf(ss * (1.0f / 128.0f) + EPS)) * 0.08838834764831845f;
#pragma unroll
          for (int kk = 0; kk < 4; ++kk) { const f32x4 g0 = *(const f32x4*)(qg + 32 * kk + 8 * g), g1 = *(const f32x4*)(qg + 32 * kk + 8 * g + 4);
              u32x4 w;
              w.x = cvt_pk_bf16(bf_lo(qr[kk].x) * rs * g0[0], bf_hi(qr[kk].x) * rs * g0[1]);
              w.y = cvt_pk_bf16(bf_lo(qr[kk].y) * rs * g0[2], bf_hi(qr[kk].y) * rs * g0[3]);
              w.z = cvt_pk_bf16(bf_lo(qr[kk].z) * rs * g1[0], bf_hi(qr[kk].z) * rs * g1[1]);
              w.w = cvt_pk_bf16(bf_lo(qr[kk].w) * rs * g1[2], bf_hi(qr[kk].w) * rs * g1[3]);
              qf[kk] = __builtin_bit_cast(bf16x8, w); } }
        float carry = 0.f; int wdone = 0;
        f32x4 oacc[8];
#pragma unroll
        for (int fd = 0; fd < 8; ++fd) oacc[fd] = (f32x4){0.f, 0.f, 0.f, 0.f};
        for (int kt = 2 * qb + 1; kt >= 0; --kt) {
            const int k0 = kt * 64;
            if (__syncthreads_and(wdone)) break;
#pragma unroll
            for (int p = 0; p < 2; ++p) {
                const int ci = tid + 512 * p, key = ci >> 4, ch = ci & 15;
                const u32x4 kr = *(const u32x4*)(PA + (size_t)(b * SEQ + k0 + key) * 4096 + 2048 + h * 128 + 8 * ch);
                float f[8]; f[0] = bf_lo(kr.x); f[1] = bf_hi(kr.x); f[2] = bf_lo(kr.y); f[3] = bf_hi(kr.y); f[4] = bf_lo(kr.z); f[5] = bf_hi(kr.z); f[6] = bf_lo(kr.w); f[7] = bf_hi(kr.w);
                float ss = 0.f;
#pragma unroll
                for (int e = 0; e < 8; ++e) ss += f[e] * f[e];
                ss += __shfl_xor(ss, 1); ss += __shfl_xor(ss, 2); ss += __shfl_xor(ss, 4); ss += __shfl_xor(ss, 8);
                const float rs = 1.0f / sqrtf(ss * (1.0f / 128.0f) + EPS);
                const f32x4 g0 = *(const f32x4*)(kg + 8 * ch), g1 = *(const f32x4*)(kg + 8 * ch + 4);
                u32x4 w;
                w.x = cvt_pk_bf16(f[0] * rs * g0[0], f[1] * rs * g0[1]); w.y = cvt_pk_bf16(f[2] * rs * g0[2], f[3] * rs * g0[3]);
                w.z = cvt_pk_bf16(f[4] * rs * g1[0], f[5] * rs * g1[1]); w.w = cvt_pk_bf16(f[6] * rs * g1[2], f[7] * rs * g1[3]);
                *(LAS u32x4*)(KL + key * 272 + ch * 16) = w;
            }
#pragma unroll
            for (int p = 0; p < 2; ++p) {
                const int key = lane, ch = wave + 8 * p;
                const u32x4 vr = *(const u32x4*)(PA + (size_t)(b * SEQ + k0 + key) * 4096 + 3072 + h * 128 + 8 * ch);
                LAS unsigned short* vt = (LAS unsigned short*)(VT + (8 * ch) * 144 + key * 2);
                vt[0 * 72] = (unsigned short)(vr.x & 0xffffu); vt[1 * 72] = (unsigned short)(vr.x >> 16);
                vt[2 * 72] = (unsigned short)(vr.y & 0xffffu); vt[3 * 72] = (unsigned short)(vr.y >> 16);
                vt[4 * 72] = (unsigned short)(vr.z & 0xffffu); vt[5 * 72] = (unsigned short)(vr.z >> 16);
                vt[6 * 72] = (unsigned short)(vr.w & 0xffffu); vt[7 * 72] = (unsigned short)(vr.w >> 16);
            }
            __syncthreads();
            if (!wdone && k0 < tq0 + 15) {
                f32x4 zt[4];
#pragma unroll
                for (int f = 0; f < 4; ++f) { f32x4 acc = {0.f, 0.f, 0.f, 0.f};
#pragma unroll
                    for (int kk = 0; kk < 4; ++kk) { const bf16x8 kf = *(const LAS bf16x8*)(KL + (16 * f + c) * 272 + (32 * kk + 8 * g) * 2);
                        acc = __builtin_amdgcn_mfma_f32_16x16x32_bf16(kf, qf[kk], acc, 0, 0, 0); }
                    zt[f] = acc; }
                float lf[4][4], lz[4][4]; float tot = 0.f;
#pragma unroll
                for (int f = 0; f < 4; ++f)
#pragma unroll
                    for (int i = 0; i < 4; ++i) { const int s = k0 + 16 * f + 4 * g + i; const bool valid = s < tq; const float z = zt[f][i];
                        const float sp = fmaxf(z, 0.f) + __logf(1.0f + __expf(-fabsf(z)));
                        const float l = valid ? -sp : 0.f; lf[f][i] = l; lz[f][i] = valid ? (l + z) : -INFINITY; tot += l; }
                tot += __shfl_xor(tot, 16); tot += __shfl_xor(tot, 32);
                bf16x8 lh[2], ll[2];
#pragma unroll
                for (int fp = 0; fp < 2; ++fp) { u32x4 wh, wl;
#pragma unroll
                    for (int q = 0; q < 2; ++q) { const int f = 2 * fp + q;
                        const unsigned h0 = cvt_pk_bf16(lf[f][0], lf[f][1]), h1 = cvt_pk_bf16(lf[f][2], lf[f][3]);
                        const unsigned l0 = cvt_pk_bf16(lf[f][0] - bf_lo(h0), lf[f][1] - bf_hi(h0)), l1 = cvt_pk_bf16(lf[f][2] - bf_lo(h1), lf[f][3] - bf_hi(h1));
                        wh[2 * q] = h0; wh[2 * q + 1] = h1; wl[2 * q] = l0; wl[2 * q + 1] = l1; }
                    lh[fp] = __builtin_bit_cast(bf16x8, wh); ll[fp] = __builtin_bit_cast(bf16x8, wl); }
                f32x4 sf[4];
                { f32x4 z4 = {0.f, 0.f, 0.f, 0.f};
                  sf[0] = __builtin_amdgcn_mfma_f32_16x16x32_bf16(tri[0], lh[0], z4, 0, 0, 0); sf[0] = __builtin_amdgcn_mfma_f32_16x16x32_bf16(tri[0], ll[0], sf[0], 0, 0, 0);
                  sf[0] = __builtin_amdgcn_mfma_f32_16x16x32_bf16(tri[2], lh[1], sf[0], 0, 0, 0); sf[0] = __builtin_amdgcn_mfma_f32_16x16x32_bf16(tri[2], ll[1], sf[0], 0, 0, 0);
                  sf[1] = __builtin_amdgcn_mfma_f32_16x16x32_bf16(tri[1], lh[0], z4, 0, 0, 0); sf[1] = __builtin_amdgcn_mfma_f32_16x16x32_bf16(tri[1], ll[0], sf[1], 0, 0, 0);
                  sf[1] = __builtin_amdgcn_mfma_f32_16x16x32_bf16(tri[3], lh[1], sf[1], 0, 0, 0); sf[1] = __builtin_amdgcn_mfma_f32_16x16x32_bf16(tri[3], ll[1], sf[1], 0, 0, 0);
                  sf[2] = __builtin_amdgcn_mfma_f32_16x16x32_bf16(tri[4], lh[1], z4, 0, 0, 0); sf[2] = __builtin_amdgcn_mfma_f32_16x16x32_bf16(tri[4], ll[1], sf[2], 0, 0, 0);
                  sf[3] = __builtin_amdgcn_mfma_f32_16x16x32_bf16(tri[5], lh[1], z4, 0, 0, 0); sf[3] = __builtin_amdgcn_mfma_f32_16x16x32_bf16(tri[5], ll[1], sf[3], 0, 0, 0); }
                bf16x8 pb[2];
#pragma unroll
                for (int fp = 0; fp < 2; ++fp) { u32x4 w;
#pragma unroll
                    for (int q = 0; q < 2; ++q) { const int f = 2 * fp + q; float p[4];
#pragma unroll
                        for (int i = 0; i < 4; ++i) p[i] = __expf(lz[f][i] + sf[f][i] + carry);
                        w[2 * q] = cvt_pk_bf16(p[0], p[1]); w[2 * q + 1] = cvt_pk_bf16(p[2], p[3]); }
                    pb[fp] = __builtin_bit_cast(bf16x8, w); }
                carry += tot;
#pragma unroll
                for (int fd = 0; fd < 8; ++fd)
#pragma unroll
                    for (int fp = 0; fp < 2; ++fp) { const LAS unsigned char* vp = VT + (16 * fd + c) * 144 + (32 * fp + 4 * g) * 2;
                        const u32x2 v0 = *(const LAS u32x2*)vp, v1 = *(const LAS u32x2*)(vp + 32);
                        u32x4 vw; vw.x = v0.x; vw.y = v0.y; vw.z = v1.x; vw.w = v1.y;
                        oacc[fd] = __builtin_amdgcn_mfma_f32_16x16x32_bf16(__builtin_bit_cast(bf16x8, vw), pb[fp], oacc[fd], 0, 0, 0); }
                wdone = (__ballot(carry >= -105.0f) == 0ull) ? 1 : 0;
            }
        }
        { bf16_t* orow = ATT + (size_t)(b * SEQ + tq) * 1024 + h * 128 + 4 * g;
#pragma unroll
          for (int fd = 0; fd < 8; ++fd) { u32x2 w; w.x = cvt_pk_bf16(oacc[fd][0], oacc[fd][1]); w.y = cvt_pk_bf16(oacc[fd][2], oacc[fd][3]); *(u32x2*)(orow + 16 * fd) = w; } }
    }
    __syncthreads();
}

__device__ __forceinline__ void ssm_lambda(const Args& a, int g, int st, float& lbr, float& lbi, float& qr, float& qi) {
    const float lr = a.in[I_LRE][g * 64 + st], li = a.in[I_LIM][g * 64 + st], dt = __expf(a.in[I_LDT][g]);
    const float mag = __expf(lr * dt);
    float rev = li * dt * 0.15915494309189535f; rev -= rintf(rev);
    lbr = mag * __builtin_amdgcn_cosf(rev); lbi = mag * __builtin_amdgcn_sinf(rev);
    const float nr = lbr - 1.0f, ni = lbi, den = 1.0f / (lr * lr + li * li);
    qr = (nr * lr + ni * li) * den; qi = (ni * lr - nr * li) * den;
}
template <bool WITH_Y>
__device__ __forceinline__ void ph_ssm_mfma(const Args& a, LAS unsigned char* lds, const bf16_t* UB, f32x2* E, bf16_t* YA, int G) {
    const int tid = opaque_tid(), lane = tid & 63, wave = __builtin_amdgcn_readfirstlane(tid >> 6), c = lane & 15, gl = lane >> 4;
    LAS f32x2* sl = (LAS f32x2*)(lds + wave * 8192);
    LAS f32x4* tab = (LAS f32x4*)(lds + 65536 + wave * 1024);
    LAS u32x4* cml = (LAS u32x4*)(lds + 73728 + wave * 5120) + lane;
    for (int item = blockIdx.x; item < 128; item += G) {
        const int b = item >> 6, cb = (item >> 3) & 7, g = (item & 7) * 8 + wave, c0 = cb * 16;
        float mur, mui;
        { float lbr, lbi, qr, qi; ssm_lambda(a, g, lane, lbr, lbi, qr, qi); tab[lane] = (f32x4){lbr, lbi, qr, qi}; mur = lbr; mui = lbi; }
        LDS_WAIT();
        bf16x8 bm[8];
        const float* brb = a.in[I_BRE] + (g * 64 + (c >> 1)) * 16 + 8 * (gl & 1); const float* bib = a.in[I_BIM] + (g * 64 + (c >> 1)) * 16 + 8 * (gl & 1);
        const LAS f32x4* tabb = tab + (c >> 1);
#pragma unroll
        for (int f = 0; f < 8; ++f) { const f32x4 tv = tabb[8 * f]; const float qr = tv[2], qi = tv[3];
            const float* br = brb + 128 * f; const float* bim = bib + 128 * f;
            const f32x4 r0 = *(const f32x4*)br, r1 = *(const f32x4*)(br + 4), i0 = *(const f32x4*)bim, i1 = *(const f32x4*)(bim + 4);
            float v[8];
#pragma unroll
            for (int e = 0; e < 4; ++e) { const float vr0 = qr * r0[e] - qi * i0[e], vi0 = qr * i0[e] + qi * r0[e], vr1 = qr * r1[e] - qi * i1[e], vi1 = qr * i1[e] + qi * r1[e];
                v[e] = (c & 1) ? vi0 : vr0; v[4 + e] = (c & 1) ? vi1 : vr1; }
            if (gl >= 2) {
#pragma unroll
                for (int e = 0; e < 8; ++e) v[e] = 0.f; }
            u32x4 w; w.x = cvt_pk_bf16(v[0], v[1]); w.y = cvt_pk_bf16(v[2], v[3]); w.z = cvt_pk_bf16(v[4], v[5]); w.w = cvt_pk_bf16(v[6], v[7]);
            bm[f] = __builtin_bit_cast(bf16x8, w); }
        float lmr[16], lmi[16];
#pragma unroll
        for (int k = 0; k < 16; ++k) { const f32x4 tv = tab[2 * gl + 8 * (k >> 1) + (k & 1)]; lmr[k] = tv[0]; lmi[k] = tv[1]; }
        if (WITH_Y) {
            const float* crb = a.in[I_CRE] + (g * 16 + c) * 64 + 2 * gl; const float* cib = a.in[I_CIM] + (g * 16 + c) * 64 + 2 * gl;
#pragma unroll
            for (int kk = 0; kk < 4; ++kk) { float v[8];
#pragma unroll
                for (int jh = 0; jh < 2; ++jh) { const f32x2 r = *(const f32x2*)(crb + 8 * (2 * kk + jh)), m = *(const f32x2*)(cib + 8 * (2 * kk + jh));
                    v[4 * jh] = r.x; v[4 * jh + 1] = -m.x; v[4 * jh + 2] = r.y; v[4 * jh + 3] = -m.y; }
                u32x4 w; w.x = cvt_pk_bf16(v[0], v[1]); w.y = cvt_pk_bf16(v[2], v[3]); w.z = cvt_pk_bf16(v[4], v[5]); w.w = cvt_pk_bf16(v[6], v[7]);
                cml[64 * kk] = w; }
            { const float dv = a.in[I_SD][g * 16 + c]; float v[8];
#pragma unroll
              for (int jj = 0; jj < 8; ++jj) v[jj] = (gl < 2 && (8 * gl + jj) == c) ? dv : 0.f;
              u32x4 w; w.x = cvt_pk_bf16(v[0], v[1]); w.y = cvt_pk_bf16(v[2], v[3]); w.z = cvt_pk_bf16(v[4], v[5]); w.w = cvt_pk_bf16(v[6], v[7]);
              cml[256] = w; }
        }
        f32x4 s[8];
#pragma unroll
        for (int f = 0; f < 8; ++f) s[f] = (f32x4){0.f, 0.f, 0.f, 0.f};
        if (WITH_Y) {
            float pr = mur, pi = mui;
#pragma unroll
            for (int q = 0; q < 6; ++q) { const float nr = pr * pr - pi * pi, ni = 2.0f * pr * pi; pr = nr; pi = ni; }
            float sr = 0.f, si = 0.f;
            const f32x2* ep = E + (size_t)((b * 64 + g) * 128) * 64 + lane;
            for (int cc = 0; cc <= c0; cc += 16) {
                f32x2 ev[16];
#pragma unroll
                for (int k = 0; k < 16; ++k) ev[k] = ep[(size_t)(cc + k) * 64];
#pragma unroll
                for (int k = 0; k < 16; ++k) { if (cc == c0) sl[k * 64 + lane] = (f32x2){sr, si};
                    const float nr = pr * sr - pi * si + ev[k][0], ni = pr * si + pi * sr + ev[k][1]; sr = nr; si = ni; }
            }
            LDS_WAIT();
#pragma unroll
            for (int f = 0; f < 8; ++f) s[f] = *(const LAS f32x4*)(sl + c * 64 + 8 * f + 2 * gl);
            LDS_WAIT();
        }
        const bf16_t* up = UB + ((size_t)(b * 64 + g) * 8192 + (size_t)(c0 + c) * 64) * 16 + 8 * (gl & 1);
        bf16_t* yp = YA + (size_t)(b * SEQ + (c0 + c) * 64) * 1024 + g * 16 + 4 * gl;
        u32x4 u0 = *(const u32x4*)(up), u1 = *(const u32x4*)(up + 16), u2 = *(const u32x4*)(up + 32), u3 = *(const u32x4*)(up + 48), u4 = *(const u32x4*)(up + 64), u5 = *(const u32x4*)(up + 80);
#pragma unroll 1
        for (int tau = 0; tau < 64; ++tau) {
            const u32x4 u6 = *(const u32x4*)(up + (size_t)(tau + 6) * 16);
            const bf16x8 uf = __builtin_bit_cast(bf16x8, u0);
#pragma unroll
            for (int f = 0; f < 8; ++f) { f32x4 ci;
                ci[0] = lmr[2 * f] * s[f][0] - lmi[2 * f] * s[f][1]; ci[1] = lmr[2 * f] * s[f][1] + lmi[2 * f] * s[f][0];
                ci[2] = lmr[2 * f + 1] * s[f][2] - lmi[2 * f + 1] * s[f][3]; ci[3] = lmr[2 * f + 1] * s[f][3] + lmi[2 * f + 1] * s[f][2];
                s[f] = __builtin_amdgcn_mfma_f32_16x16x32_bf16(bm[f], uf, ci, 0, 0, 0); }
            if (WITH_Y) {
                f32x4 y = __builtin_amdgcn_mfma_f32_16x16x32_bf16(__builtin_bit_cast(bf16x8, cml[256]), uf, (f32x4){0.f, 0.f, 0.f, 0.f}, 0, 0, 0);
#pragma unroll
                for (int kk = 0; kk < 4; ++kk) { u32x4 w; w.x = cvt_pk_bf16(s[2 * kk][0], s[2 * kk][1]); w.y = cvt_pk_bf16(s[2 * kk][2], s[2 * kk][3]);
                    w.z = cvt_pk_bf16(s[2 * kk + 1][0], s[2 * kk + 1][1]); w.w = cvt_pk_bf16(s[2 * kk + 1][2], s[2 * kk + 1][3]);
                    y = __builtin_amdgcn_mfma_f32_16x16x32_bf16(__builtin_bit_cast(bf16x8, cml[64 * kk]), __builtin_bit_cast(bf16x8, w), y, 0, 0, 0); }
                u32x2 o; o.x = cvt_pk_bf16(gelu_tanh(y[0]), gelu_tanh(y[1])); o.y = cvt_pk_bf16(gelu_tanh(y[2]), gelu_tanh(y[3]));
                *(u32x2*)(yp + (size_t)tau * 1024) = o;
            }
            u0 = u1; u1 = u2; u2 = u3; u3 = u4; u4 = u5; u5 = u6;
        }
        if (!WITH_Y) { f32x2* eo = E + (size_t)((b * 64 + g) * 128 + c0 + c) * 64 + 2 * gl;
#pragma unroll
            for (int f = 0; f < 8; ++f) *(f32x4*)(eo + 8 * f) = s[f]; }
    }
}

constexpr float PEER_SU = 512.0f, PEER_SV = 16.0f;
__device__ __forceinline__ void ph_table_cvt(const float* __restrict__ U, const float* __restrict__ V, unsigned char* UT, unsigned char* VT, int G) {
    const size_t n16 = (size_t)16384 * 2048 / 16, stride = (size_t)G * 512;
    for (size_t i = (size_t)blockIdx.x * 512 + threadIdx.x; i < 2 * n16; i += stride) {
        const bool sec = i >= n16; const size_t j = sec ? i - n16 : i; const float sc = sec ? PEER_SV : PEER_SU;
        const float* src = (sec ? V : U) + j * 16; unsigned char* dst = (sec ? VT : UT) + j * 16;
        u32x4 w;
#pragma unroll
        for (int q = 0; q < 4; ++q) { const f32x4 v = *(const f32x4*)(src + 4 * q); int p = 0;
            p = __builtin_amdgcn_cvt_pk_fp8_f32(v[0] * sc, v[1] * sc, p, false); p = __builtin_amdgcn_cvt_pk_fp8_f32(v[2] * sc, v[3] * sc, p, true); w[q] = (unsigned)p; }
        *(u32x4*)dst = w;
    }
}

__device__ __forceinline__ void ph_peer(LAS unsigned char* lds, const float* SC, const bf16_t* H2, const unsigned char* UT, const unsigned char* VTb, const float* mod, float* OUT, int G) {
    const int tid = opaque_tid(), lane = tid & 63, wave = __builtin_amdgcn_readfirstlane(tid >> 6);
    LAS float* scr = (LAS float*)(lds + wave * 8448);
    LAS int* idxs = (LAS int*)(lds + 69632 + wave * 4096);
    LAS float* gates = (LAS float*)(lds + 69632 + wave * 4096 + 2048);
    LAS float* dotb = (LAS float*)(lds + 102400 + wave * 1024);
    for (int it = blockIdx.x; it < 512; it += G) {
        const int tokw = it * 32 + wave * 4;
        float tk[16];
#pragma unroll
        for (int i = 0; i < 16; ++i) tk[i] = -INFINITY;
        for (int q = 0; q < 4; ++q) {
#pragma unroll
            for (int j = 0; j < 8; ++j) { const int prob = (lane >> 3) + 8 * j, seg = lane & 7;
                const f32x4 v = *(const f32x4*)(SC + (size_t)(tokw + (prob >> 4)) * 2048 + (prob & 15) * 128 + 32 * q + 4 * seg);
                LAS float* d = scr + prob * 33 + 4 * seg; d[0] = v[0]; d[1] = v[1]; d[2] = v[2]; d[3] = v[3]; }
            LDS_WAIT();
#pragma unroll 4
            for (int vi = 0; vi < 32; ++vi) {
                float x = __uint_as_float((__float_as_uint(scr[lane * 33 + vi]) & ~127u) | (unsigned)(127 - (32 * q + vi)));
#pragma unroll
                for (int i = 0; i < 16; ++i) { const float hi = fmaxf(tk[i], x); x = fminf(tk[i], x); tk[i] = hi; }
            }
            LDS_WAIT();
        }
        float t2[16];
#pragma unroll
        for (int i = 0; i < 16; ++i) t2[i] = __shfl_xor(tk[i], 1);
        float bv[16]; int bp[16];
#pragma unroll
        for (int i = 0; i < 16; ++i) { bv[i] = -INFINITY; bp[i] = 0; }
#pragma unroll
        for (int aa = 0; aa < 16; ++aa)
#pragma unroll
            for (int bb = 0; bb < 16 / (aa + 1); ++bb) {
                const unsigned u1 = __float_as_uint(tk[aa]), u2 = __float_as_uint(t2[bb]);
                float x = __uint_as_float(u1 & ~127u) + __uint_as_float(u2 & ~127u);
                int px = (int)(((127u - (u1 & 127u)) << 7) | (127u - (u2 & 127u)));
#pragma unroll
                for (int i = 0; i < 16; ++i) { const bool gt = x > bv[i]; const float nv = gt ? x : bv[i], ox = gt ? bv[i] : x; const int np = gt ? px : bp[i], op = gt ? bp[i] : px;
                    bv[i] = nv; x = ox; bp[i] = np; px = op; }
            }
        { float e[16], sum = 0.f;
#pragma unroll
          for (int i = 0; i < 16; ++i) { e[i] = __expf(bv[i] - bv[0]); sum += e[i]; }
          const float inv = 1.0f / sum;
          if ((lane & 1) == 0) { const int tl = lane >> 4, head = (lane & 15) >> 1;
#pragma unroll
              for (int i = 0; i < 16; ++i) { idxs[tl * 128 + head * 16 + i] = bp[i]; gates[tl * 128 + head * 16 + i] = e[i] * inv; } } }
        LDS_WAIT();
        for (int tl = 0; tl < 4; ++tl) {
            const int token = tokw + tl;
            f32x2 ha[16];
            { const bf16_t* hrow = H2 + (size_t)token * 2048 + 16 * lane;
#pragma unroll
              for (int j = 0; j < 2; ++j) { const u32x4 w0 = *(const u32x4*)(hrow + 1024 * j), w1 = *(const u32x4*)(hrow + 1024 * j + 8);
                  ha[8 * j + 0] = (f32x2){bf_lo(w0.x), bf_hi(w0.x)}; ha[8 * j + 1] = (f32x2){bf_lo(w0.y), bf_hi(w0.y)}; ha[8 * j + 2] = (f32x2){bf_lo(w0.z), bf_hi(w0.z)}; ha[8 * j + 3] = (f32x2){bf_lo(w0.w), bf_hi(w0.w)};
                  ha[8 * j + 4] = (f32x2){bf_lo(w1.x), bf_hi(w1.x)}; ha[8 * j + 5] = (f32x2){bf_lo(w1.y), bf_hi(w1.y)}; ha[8 * j + 6] = (f32x2){bf_lo(w1.z), bf_hi(w1.z)}; ha[8 * j + 7] = (f32x2){bf_lo(w1.w), bf_hi(w1.w)}; } }
            for (int grp = 0; grp < 16; ++grp) {
                u32x4 buf[8][2];
#pragma unroll
                for (int r = 0; r < 8; ++r) { const int e = __builtin_amdgcn_readfirstlane(idxs[tl * 128 + grp * 8 + r]);
                    const unsigned char* rp = UT + (size_t)e * 2048 + 16 * lane; buf[r][0] = *(const u32x4*)rp; buf[r][1] = *(const u32x4*)(rp + 1024); }
                float pt[8];
#pragma unroll
                for (int r = 0; r < 8; ++r) { f32x2 s = {0.f, 0.f};
#pragma unroll
                    for (int j = 0; j < 2; ++j)
#pragma unroll
                        for (int q = 0; q < 4; ++q) { const int w = (int)buf[r][j][q];
                            s = __builtin_amdgcn_cvt_pk_f32_fp8(w, false) * ha[8 * j + 2 * q] + s; s = __builtin_amdgcn_cvt_pk_f32_fp8(w, true) * ha[8 * j + 2 * q + 1] + s; }
                    pt[r] = s.x + s.y; }
                const bool h5 = lane & 32, h4 = lane & 16, h3 = lane & 8; float w4[4], w2[2], w1;
#pragma unroll
                for (int k = 0; k < 4; ++k) { const float keep = h5 ? pt[k + 4] : pt[k], send = h5 ? pt[k] : pt[k + 4]; w4[k] = keep + __shfl_xor(send, 32); }
#pragma unroll
                for (int k = 0; k < 2; ++k) { const float keep = h4 ? w4[k + 2] : w4[k], send = h4 ? w4[k] : w4[k + 2]; w2[k] = keep + __shfl_xor(send, 16); }
                { const float keep = h3 ? w2[1] : w2[0], send = h3 ? w2[0] : w2[1]; w1 = keep + __shfl_xor(send, 8); }
                w1 += __shfl_xor(w1, 4); w1 += __shfl_xor(w1, 2); w1 += __shfl_xor(w1, 1);
                if ((lane & 7) == 0) dotb[grp * 8 + ((lane >> 5) & 1) * 4 + ((lane >> 4) & 1) * 2 + ((lane >> 3) & 1)] = w1;
            }
            LDS_WAIT();
            { const float d0 = dotb[lane] * (1.0f / PEER_SU), d1 = dotb[lane + 64] * (1.0f / PEER_SU);
              const float a0 = gates[tl * 128 + lane] * gelu_tanh(d0) * (1.0f / PEER_SV), a1 = gates[tl * 128 + lane + 64] * gelu_tanh(d1) * (1.0f / PEER_SV);
              LDS_WAIT(); dotb[lane] = a0; dotb[lane + 64] = a1; }
            LDS_WAIT();
#pragma unroll
            for (int i = 0; i < 16; ++i) ha[i] = (f32x2){0.f, 0.f};
            for (int grp = 0; grp < 16; ++grp) {
                u32x4 buf[8][2];
#pragma unroll
                for (int r = 0; r < 8; ++r) { const int e = __builtin_amdgcn_readfirstlane(idxs[tl * 128 + grp * 8 + r]);
                    const unsigned char* rp = VTb + (size_t)e * 2048 + 16 * lane; buf[r][0] = *(const u32x4*)rp; buf[r][1] = *(const u32x4*)(rp + 1024); }
#pragma unroll
                for (int r = 0; r < 8; ++r) { const float ar = dotb[grp * 8 + r]; const f32x2 a2 = {ar, ar};
#pragma unroll
                    for (int j = 0; j < 2; ++j)
#pragma unroll
                        for (int q = 0; q < 4; ++q) { const int w = (int)buf[r][j][q];
                            ha[8 * j + 2 * q] = __builtin_amdgcn_cvt_pk_f32_fp8(w, false) * a2 + ha[8 * j + 2 * q]; ha[8 * j + 2 * q + 1] = __builtin_amdgcn_cvt_pk_f32_fp8(w, true) * a2 + ha[8 * j + 2 * q + 1]; } }
            }
            { const int b = token >> 13; const float* gt2 = mod + (size_t)b * 12288 + 10240 + 16 * lane; float* orow = OUT + (size_t)token * 2048 + 16 * lane;
#pragma unroll
              for (int j = 0; j < 2; ++j)
#pragma unroll
                  for (int q = 0; q < 4; ++q) { const f32x4 x0 = *(const f32x4*)(orow + 1024 * j + 4 * q), g0 = *(const f32x4*)(gt2 + 1024 * j + 4 * q); f32x4 o;
                      o[0] = x0[0] + g0[0] * ha[8 * j + 2 * q].x; o[1] = x0[1] + g0[1] * ha[8 * j + 2 * q].y; o[2] = x0[2] + g0[2] * ha[8 * j + 2 * q + 1].x; o[3] = x0[3] + g0[3] * ha[8 * j + 2 * q + 1].y;
                      *(f32x4*)(orow + 1024 * j + 4 * q) = o; } }
            LDS_WAIT();
        }
    }
}

__global__ void __launch_bounds__(512, 2) mk_fwd(Args args) {
    extern __shared__ __attribute__((aligned(16))) unsigned char lds_raw[];
    LAS unsigned char* lds = (LAS unsigned char*)lds_raw;
    const int tid = threadIdx.x, lane = tid & 63, wave = __builtin_amdgcn_readfirstlane(tid >> 6);
    const int G = gridDim.x, gw = blockIdx.x * 8 + wave, ngw = G * 8;
    unsigned char* ws = args.ws;
    volatile LAS unsigned* misc = (volatile LAS unsigned*)(lds + LDS_MAIN);
    if (tid < 4) misc[tid] = 0u;
    __syncthreads();
    const int lo = args.ph_lo, hi = args.ph_hi;
    XcdBarrier bar; bar.bar = (unsigned*)(ws + WS_CTL); bar.x = 0; bar.st = misc;
    if (hi - lo > 1) bar = xcd_barrier_post((unsigned*)(ws + WS_CTL), misc);
#ifndef PHMASK
#define PHMASK 0x7ff
#endif
#define IN(k) (((PHMASK >> (k)) & 1) && lo <= (k) && (k) < hi)
#define SEAM(k) do { if (IN(k) && IN((k) + 1)) xcd_barrier(bar); } while (0)
    float* mod = (float*)(ws + WS_MOD);
    bf16_t* HB = (bf16_t*)(ws + WS_H); bf16_t* PA = (bf16_t*)(ws + WS_PA); bf16_t* PG = (bf16_t*)(ws + WS_PG);
    bf16_t* YA = (bf16_t*)(ws + WS_YA); bf16_t* ATT = (bf16_t*)(ws + WS_ATT); f32x2* EB = (f32x2*)(ws + WS_E); bf16_t* UBp = (bf16_t*)(ws + WS_UB);

#ifndef DUP
#define DUP -1
#endif
#define PH(k, ...) do { if (IN(k)) { __VA_ARGS__ if (DUP == (k)) { xcd_barrier(bar); __VA_ARGS__ } } } while (0)
    PH(0, { ph_mod_partial(args.in[I_C], args.in[I_WADA], (float*)(ws + WS_MODP), gw, ngw, lane); });
    SEAM(0);
    PH(1, { ph_prologue(args, lds, gw, ngw, lane, wave); });
    SEAM(1);
    PH(2, { ph_norm(args.in[I_X], HB, args.in[I_N1G], mod, 0, 2048, gw, ngw, lane); });
    SEAM(2);
    PH(3, { pg8::Gemm g{HB, (const bf16_t*)(ws + WS_WIN), T_TOK, 8192, 2048}; pg8::StaticOrder S; S.init(T_TOK, 8192, G, (int)blockIdx.x);
        pg8::EpiProj E{PA, PG, UBp}; pg8::gemm_phase<pg8::EpiProj, pg8::StaticOrder, true, true>(lds, g, S, E); });
    SEAM(3);
    PH(4, { ph_attn(lds, PA, ATT, args.in[I_QNG], args.in[I_KNG], G); __syncthreads(); ph_ssm_mfma<false>(args, lds, UBp, EB, YA, G); });
    SEAM(4);
    PH(5, { ph_ssm_mfma<true>(args, lds, UBp, EB, YA, G); __syncthreads();
        pg8::Gemm g{ATT, (const bf16_t*)(ws + WS_WATT), T_TOK, 2048, 1024}; pg8::StaticOrder S; S.init(T_TOK, 2048, G, (int)blockIdx.x);
        pg8::EpiAttUp E{PG, HB}; pg8::gemm_phase<pg8::EpiAttUp, pg8::StaticOrder, true, true>(lds, g, S, E); });
    SEAM(5);
    PH(6, { pg8::Gemm g{YA, (const bf16_t*)(ws + WS_WGLU), T_TOK, 4096, 1024}; pg8::StaticOrder S; S.init(T_TOK, 4096, G, (int)blockIdx.x);
        pg8::EpiGlu E{PG, HB}; pg8::gemm_phase<pg8::EpiGlu, pg8::StaticOrder, true, true>(lds, g, S, E); });
    SEAM(6);
    PH(7, { pg8::Gemm g{HB, (const bf16_t*)(ws + WS_WOUT), T_TOK, 2048, 2048}; pg8::StaticOrder S; S.init(T_TOK, 2048, G, (int)blockIdx.x);
        pg8::EpiOut E{args.in[I_X], args.out, mod}; pg8::gemm_phase<pg8::EpiOut, pg8::StaticOrder, true, true>(lds, g, S, E);
        ph_table_cvt(args.in[I_PU], args.in[I_PV], ws + WS_UT, ws + WS_VT, G); });
    SEAM(7);
    PH(8, { ph_norm(args.out, HB, args.in[I_N2G], mod, 6144, 8192, gw, ngw, lane); });
    SEAM(8);
    PH(9, { pg8::Gemm g{HB, (const bf16_t*)(ws + WS_WSC), T_TOK, 2048, 2048}; pg8::StaticOrder S; S.init(T_TOK, 2048, G, (int)blockIdx.x);
        pg8::EpiF32 E{(float*)(ws + WS_SC)}; pg8::gemm_phase<pg8::EpiF32, pg8::StaticOrder, true, true>(lds, g, S, E); });
    SEAM(9);
    PH(10, { ph_peer(lds, (const float*)(ws + WS_SC), HB, ws + WS_UT, ws + WS_VT, mod, args.out, G); });
#undef IN
#undef SEAM
}

extern "C" void kernel_launch(void* const* d_in, const int* in_sizes, int n_in, void* d_out, int out_size, void* d_ws, size_t ws_size, hipStream_t stream) {
    static int grid = 0;
    if (grid == 0) {
        if (n_in != 25 || out_size != T_TOK * DM || ws_size < WS_END) { fprintf(stderr, "kernel_launch: unexpected shapes (n_in %d out %d ws %zu need %zu)\n", n_in, out_size, ws_size, (size_t)WS_END); grid = -1; return; }
        int dev = 0, cus = 0, per_cu = 0;
        if (hipGetDevice(&dev) != hipSuccess || hipDeviceGetAttribute(&cus, hipDeviceAttributeMultiprocessorCount, dev) != hipSuccess) { grid = -1; return; }
        if (hipFuncSetAttribute((const void*)mk_fwd, hipFuncAttributeMaxDynamicSharedMemorySize, LDS_BYTES) != hipSuccess) { fprintf(stderr, "kernel_launch: hipFuncSetAttribute failed\n"); grid = -1; return; }
        if (hipOccupancyMaxActiveBlocksPerMultiprocessor(&per_cu, (const void*)mk_fwd, 512, LDS_BYTES) != hipSuccess || per_cu < 1) { fprintf(stderr, "kernel_launch: occupancy query says %d blocks/CU\n", per_cu); (void)hipGetLastError(); grid = -1; return; }
        grid = cus;
    }
    if (grid < 0) return;
    (void)hipMemsetAsync((char*)d_ws + WS_CTL, 0, 16384, stream);
    Args a{};
    for (int i = 0; i < 25; ++i) a.in[i] = (const float*)d_in[i];
    a.out = (float*)d_out; a.ws = (unsigned char*)d_ws;
#if MK_PER_PHASE
    for (int ph = 0; ph < NPHASE; ++ph) { a.ph_lo = ph; a.ph_hi = ph + 1; hipLaunchKernelGGL(mk_fwd, dim3(grid), dim3(512), LDS_BYTES, stream, a); }
#else
    a.ph_lo = 0; a.ph_hi = NPHASE;
    hipLaunchKernelGGL(mk_fwd, dim3(grid), dim3(512), LDS_BYTES, stream, a);
#endif
}
```

```cpp
#include <hip/hip_runtime.h>
#include <cstdio>
#include <cstdint>

#ifndef MK_PER_PHASE
#define MK_PER_PHASE 0
#endif

#ifndef DUP
#define DUP -1
#endif
#define LAS __attribute__((address_space(3)))
typedef unsigned short bf16_t;
typedef short bf16x8 __attribute__((ext_vector_type(8)));
typedef float f32x4 __attribute__((ext_vector_type(4)));
typedef float f32x2 __attribute__((ext_vector_type(2)));
typedef unsigned u32x4 __attribute__((ext_vector_type(4)));
typedef unsigned u32x2 __attribute__((ext_vector_type(2)));

constexpr int T_TOK = 16384, DM = 2048, SEQ = 8192;
constexpr int NPHASE = 11;
constexpr float EPS = 1e-6f;

constexpr size_t WS_CTL   = 0;
constexpr size_t WS_MODP  = 65536;
constexpr size_t WS_MOD   = WS_MODP + (size_t)32 * 2 * 12288 * 4;
constexpr size_t WS_WIN   = WS_MOD + (size_t)2 * 12288 * 4;
constexpr size_t WS_WGLU  = WS_WIN + (size_t)8192 * 2048 * 2;
constexpr size_t WS_WATT  = WS_WGLU + (size_t)4096 * 1024 * 2;
constexpr size_t WS_WOUT  = WS_WATT + (size_t)2048 * 1024 * 2;
constexpr size_t WS_WSC   = WS_WOUT + (size_t)2048 * 2048 * 2;
constexpr size_t WS_H     = WS_WSC + (size_t)2048 * 2048 * 2;
constexpr size_t WS_PA    = WS_H + (size_t)T_TOK * 2048 * 2;
constexpr size_t WS_PG    = WS_PA + (size_t)T_TOK * 4096 * 2;
constexpr size_t WS_E     = WS_PG + (size_t)T_TOK * 4096 * 2;
constexpr size_t WS_YA    = WS_E + (size_t)2 * 64 * 128 * 64 * 8;
constexpr size_t WS_ATT   = WS_YA + (size_t)T_TOK * 1024 * 2;
constexpr size_t WS_UB    = WS_ATT + (size_t)T_TOK * 1024 * 2;
constexpr size_t WS_END   = WS_UB + (size_t)T_TOK * 1024 * 2;
constexpr size_t WS_SC    = WS_PA;
constexpr size_t WS_UT    = WS_PG;
constexpr size_t WS_VT    = WS_PG + (size_t)16384 * 1536;

constexpr int LDS_MAIN = 131072, LDS_BYTES = LDS_MAIN + 256;

typedef __bf16 bf16x2_t __attribute__((ext_vector_type(2)));
__device__ __forceinline__ unsigned cvt_pk_bf16(float lo, float hi) { const f32x2 v = {lo, hi}; return __builtin_bit_cast(unsigned, __builtin_convertvector(v, bf16x2_t)); }
__device__ __forceinline__ float bf_lo(unsigned w) { return __uint_as_float(w << 16); }
__device__ __forceinline__ float bf_hi(unsigned w) { return __uint_as_float(w & 0xffff0000u); }
__device__ __forceinline__ float wave_sum(float v) {
#pragma unroll
    for (int o = 1; o < 64; o <<= 1) v += __shfl_xor(v, o);
    return v;
}
__device__ __forceinline__ float sigmoidf_(float x) { return 1.0f / (1.0f + __expf(-x)); }
__device__ __forceinline__ float gelu_tanh(float x) {
    const float a = 0.7978845608028654f * (x + 0.044715f * x * x * x);
    const float t = 1.0f - 2.0f / (__expf(2.0f * a) + 1.0f);
    return 0.5f * x * (1.0f + t);
}
#define LDS_WAIT() asm volatile("s_waitcnt lgkmcnt(0)" ::: "memory")
__device__ __forceinline__ int opaque_tid() { int t = threadIdx.x; asm volatile("" : "+v"(t)); return t; }

#define XB_TMO      128
#define XB_XCNT(j)  (256  + 64 * (j))
#define XB_XSUB(j)  (1280 + 64 * (j))
#define XB_XGEN(j)  (2304 + 64 * (j))
#define XB_TOP      3328
#define XB_TOPGEN   3392
#define XCD_BAR_WORDS 3456
#define XB_SPIN_CAP (1u << 22)
__device__ __forceinline__ unsigned xb_ld(unsigned* p)              { return __hip_atomic_load(p, __ATOMIC_RELAXED, __HIP_MEMORY_SCOPE_AGENT); }
__device__ __forceinline__ unsigned xb_add(unsigned* p, unsigned v) { return __hip_atomic_fetch_add(p, v, __ATOMIC_RELAXED, __HIP_MEMORY_SCOPE_AGENT); }
__device__ __forceinline__ unsigned xb_xcc_id() { return (unsigned)__builtin_amdgcn_s_getreg((3 << 11) | 20) & 0xFu; }
#define XB_SPIN(cond, bar) do { unsigned _sp = 0; while (cond) { __builtin_amdgcn_s_sleep(1); \
    if ((++_sp & 255u) == 0u) { if (xb_ld(&(bar)[XB_TMO])) break; if (_sp > XB_SPIN_CAP) { atomicAdd(&(bar)[XB_TMO], 1u); break; } } } } while (0)
struct XcdBarrier { unsigned* bar; unsigned x; volatile LAS unsigned* st; };
__device__ __forceinline__ XcdBarrier xcd_barrier_post(unsigned* bar, volatile LAS unsigned* st) {
    XcdBarrier b; b.bar = bar; b.x = xb_xcc_id(); b.st = st;
    if (threadIdx.x == 0) (void)xb_add(&bar[XB_XCNT(b.x)], 1u);
    return b;
}
__device__ __forceinline__ void xcd_barrier_complete(unsigned* bar, unsigned x, unsigned& nloc, unsigned& nx) {
    const unsigned G = gridDim.x * gridDim.y * gridDim.z;
    unsigned sum, cnt, mine, sp = 0u;
    for (;;) {
        sum = 0u; cnt = 0u; mine = 0u;
#pragma unroll
        for (unsigned j = 0; j < 16; ++j) { const unsigned c = xb_ld(&bar[XB_XCNT(j)]); sum += c; cnt += (c > 0u) ? 1u : 0u; mine = (j == x) ? c : mine; }
        if (sum == G) break;
        __builtin_amdgcn_s_sleep(1);
        if ((++sp & 255u) == 0u) { if (xb_ld(&bar[XB_TMO])) break; if (sp > XB_SPIN_CAP) { atomicAdd(&bar[XB_TMO], 1u); break; } }
    }
    nloc = mine > 0u ? mine : 1u; nx = cnt > 0u ? cnt : 1u;
}
__device__ __forceinline__ void xcd_barrier(const XcdBarrier& b) {
    asm volatile("s_waitcnt vmcnt(0)" ::: "memory");
    __syncthreads();
    if (threadIdx.x == 0) {
        unsigned* bar = b.bar;
        __builtin_amdgcn_s_waitcnt(0);
        unsigned nloc = b.st[0], nx = b.st[1];
        if (nloc == 0u) { xcd_barrier_complete(bar, b.x, nloc, nx); b.st[0] = nloc; b.st[1] = nx; }
        const unsigned old = xb_add(&bar[XB_XSUB(b.x)], 1u);
        const unsigned gen = old / nloc;
        if (old + 1u == (gen + 1u) * nloc) {
            __builtin_amdgcn_fence(__ATOMIC_RELEASE, "agent");
            asm volatile("s_waitcnt vmcnt(0)" ::: "memory");
            const unsigned og = xb_add(&bar[XB_TOP], 1u);
            const unsigned tg = og / nx;
            if (og + 1u == (tg + 1u) * nx) xb_add(&bar[XB_TOPGEN], 1u);
            else XB_SPIN(xb_ld(&bar[XB_TOPGEN]) == tg, bar);
            __builtin_amdgcn_fence(__ATOMIC_ACQUIRE, "agent");
            xb_add(&bar[XB_XGEN(b.x)], 1u);
            asm volatile("s_waitcnt vmcnt(0)" ::: "memory");
        } else {
            XB_SPIN(xb_ld(&bar[XB_XGEN(b.x)]) == gen, bar);
            __builtin_amdgcn_fence(__ATOMIC_ACQUIRE, "agent");
            asm volatile("s_waitcnt vmcnt(0)" ::: "memory");
        }
    }
    __syncthreads();
}

namespace pg8 {
constexpr int BM = 256, BK = 64, HALF = 128, HTB = HALF * BK * 2, STAGE_BYTES = 8 * HTB, NXCD = 8, WGM = 8;
__host__ __device__ __forceinline__ int lds_byte(int r, int c) { const int st = (r >> 4) * 2 + (c >> 5), rr = r & 15, cc = c & 31, ob = rr * 64 + cc * 2; return st * 1024 + (ob ^ (((ob >> 9) & 1) << 5)); }
__host__ __device__ __forceinline__ void stage_rc(int b, int& R, int& C) { const int st = b / 1024, sb = b % 1024, swz = sb ^ (((sb >> 9) & 1) << 5); R = (st >> 1) * 16 + swz / 64; C = (st & 1) * 32 + (swz % 64) / 2; }
__host__ __device__ __forceinline__ int perm32(int rho) { const int n = rho >> 4, i = rho & 15; return 8 * (i >> 2) + 4 * n + (i & 3); }
struct Unit { int pm, pn; };
struct Gemm { const bf16_t* A; const bf16_t* Bt; int M, N, K; };
struct StaticOrder {
    int nM, nN, nwg, G, c;
    __host__ __device__ void init(int M, int N, int G_, int c_) { nM = M / BM; nN = N / BM; nwg = nM * nN; G = G_; c = c_; }
    __host__ __device__ bool next(int i, Unit& u) const {
        const long L = (long)i * G + c; if (L >= nwg) return false;
        int wgid = (int)L; { const int q = nwg / NXCD, r = nwg % NXCD, xcd = wgid % NXCD, off = wgid / NXCD; wgid = (xcd < r ? xcd * (q + 1) : r * (q + 1) + (xcd - r) * q) + off; }
        const int nig = WGM * nN, gid = wgid / nig, fm = gid * WGM, gsz = (nM - fm) < WGM ? (nM - fm) : WGM;
        u.pm = fm + ((wgid % nig) % gsz); u.pn = (wgid % nig) / gsz; return true;
    }
    __device__ __forceinline__ void a_ready(const Unit&) const {}
    __device__ __forceinline__ void done(const Unit&) const {}
};
template <class Epi, class Sched, bool ALIGN_EPI = false, bool SP2 = false>
__device__ __forceinline__ void gemm_phase(LAS unsigned char* lds, const Gemm g, const Sched& S, const Epi& E) {
    const int tid = opaque_tid(), wid = __builtin_amdgcn_readfirstlane(tid >> 6), lane = tid & 63, wr = wid >> 2, wc = wid & 3, fr = lane & 15, fq = lane >> 4;
    const int K = g.K, nt = K / BK;
    unsigned voffA[2], voffB[2];
#pragma unroll
    for (int i = 0; i < 2; ++i) { int R, C; stage_rc(tid * 16 + i * 8192, R, C); const int Rb = Epi::PERM ? ((R & ~31) + perm32(R & 31)) : R;
        voffA[i] = (unsigned)(R * K + C) * 2u; voffB[i] = (unsigned)(Rb * K + C) * 2u; }
    const size_t kstep = (size_t)(BK * 2);
    const size_t hstep = (size_t)HALF * K * 2;
    const size_t tstep = 2 * hstep;
    const unsigned ldsw = (unsigned)wid * 1024u;
    const int aoff = lds_byte(wr * 64 + fr, fq * 8), boff = lds_byte(wc * 32 + fr, fq * 8);
#define PG8_SA(b, h) (((b) * 2 + (h)) * HTB)
#define PG8_SB(b, h) ((4 + (b) * 2 + (h)) * HTB)
#define PG8_STAGE(bufoff, gbase, voff) do { _Pragma("unroll") for (int _i = 0; _i < 2; ++_i) \
        __builtin_amdgcn_global_load_lds((const unsigned*)((const char*)(gbase) + (voff)[_i]), (LAS unsigned*)(lds + (bufoff) + ldsw + _i * 8192), 16, 0, 0); } while (0)
#define PG8_LDA(dst, b, h) do { _Pragma("unroll") for (int m = 0; m < 4; ++m) _Pragma("unroll") for (int k = 0; k < 2; ++k) dst[m][k] = *(const LAS bf16x8*)(lds + PG8_SA(b, h) + aoff + m * 2048 + k * 1024); } while (0)
#define PG8_LDB(dst, b, h) do { _Pragma("unroll") for (int n = 0; n < 2; ++n) _Pragma("unroll") for (int k = 0; k < 2; ++k) dst[n][k] = *(const LAS bf16x8*)(lds + PG8_SB(b, h) + boff + n * 2048 + k * 1024); } while (0)
#define PG8_MMA(ai, bj, At, Bt) do { __builtin_amdgcn_s_setprio(1); _Pragma("unroll") for (int m = 0; m < 4; ++m) _Pragma("unroll") for (int n = 0; n < 2; ++n) _Pragma("unroll") for (int k = 0; k < 2; ++k) \
        acc[ai][bj][m][n] = __builtin_amdgcn_mfma_f32_16x16x32_bf16(Bt[n][k], At[m][k], acc[ai][bj][m][n], 0, 0, 0); __builtin_amdgcn_s_setprio(0); } while (0)
#define PG8_WAIT_V(n) asm volatile("s_waitcnt vmcnt(" #n ")" ::: "memory")
#define PG8_WAIT_L(n) asm volatile("s_waitcnt lgkmcnt(" #n ")" ::: "memory")
#define PG8_BAR __builtin_amdgcn_s_barrier()
#define PG8_SCHED __builtin_amdgcn_sched_barrier(0)
    Unit cur, nxt; int ui = 0;
    if (!S.next(0, cur)) return;
    f32x4 acc[2][2][4][2];
#pragma unroll
    for (int a = 0; a < 2; ++a)
#pragma unroll
        for (int b = 0; b < 2; ++b)
#pragma unroll
            for (int m = 0; m < 4; ++m)
#pragma unroll
                for (int n = 0; n < 2; ++n) acc[a][b][m][n] = (f32x4){0.f, 0.f, 0.f, 0.f};
    bf16x8 At[4][2], B0[2][2], B1[2][2];
    const char* cA = (const char*)g.A + (size_t)cur.pm * tstep; const char* cB = (const char*)g.Bt + (size_t)cur.pn * tstep;
    S.a_ready(cur);
    if constexpr (SP2) {
        PG8_STAGE(PG8_SB(0, 0), cB, voffB); PG8_STAGE(PG8_SB(0, 1), cB + hstep, voffB); PG8_STAGE(PG8_SA(0, 0), cA, voffA); PG8_STAGE(PG8_SA(0, 1), cA + hstep, voffA);
        if (wr == 1) PG8_BAR;
        PG8_WAIT_V(2); PG8_BAR;
        PG8_STAGE(PG8_SB(1, 0), cB + kstep, voffB); PG8_STAGE(PG8_SA(1, 0), cA + kstep, voffA); PG8_STAGE(PG8_SB(1, 1), cB + hstep + kstep, voffB);
        PG8_WAIT_V(6); PG8_BAR;
    } else {
        PG8_STAGE(PG8_SB(0, 0), cB, voffB); PG8_STAGE(PG8_SA(0, 0), cA, voffA); PG8_STAGE(PG8_SB(0, 1), cB + hstep, voffB); PG8_STAGE(PG8_SA(0, 1), cA + hstep, voffA);
        if (wr == 1) PG8_BAR;
        PG8_WAIT_V(4); PG8_BAR;
        PG8_STAGE(PG8_SB(1, 0), cB + kstep, voffB); PG8_STAGE(PG8_SA(1, 0), cA + kstep, voffA); PG8_STAGE(PG8_SB(1, 1), cB + hstep + kstep, voffB);
        PG8_WAIT_V(6); PG8_BAR;
    }
    for (;;) {
        const bool has_next = S.next(ui + 1, nxt);
        const char* nA = has_next ? (const char*)g.A + (size_t)nxt.pm * tstep : cA; const char* nB = has_next ? (const char*)g.Bt + (size_t)nxt.pn * tstep : cB;
        for (int t = 0; t < nt; t += 2) {
            const bool last = (t == nt - 2);
            const char* a1 = cA + (size_t)(t + 1) * kstep;
            const char* a2 = last ? nA : cA + (size_t)(t + 2) * kstep; const char* b2 = last ? nB : cB + (size_t)(t + 2) * kstep;
            const char* a3 = a2 + kstep; const char* b3 = b2 + kstep;
            if (last && has_next) S.a_ready(nxt);
            if constexpr (SP2) {
            PG8_LDB(B0, 0, 0); PG8_LDB(B1, 0, 1); PG8_SCHED; PG8_LDA(At, 0, 0); PG8_STAGE(PG8_SA(1, 1), a1 + hstep, voffA);
            PG8_WAIT_V(8); PG8_WAIT_L(0); PG8_BAR; PG8_MMA(0, 0, At, B0); PG8_MMA(0, 1, At, B1); PG8_BAR; PG8_SCHED;
            PG8_LDA(At, 0, 1); PG8_STAGE(PG8_SB(0, 0), b2, voffB); PG8_STAGE(PG8_SB(0, 1), b2 + hstep, voffB); PG8_STAGE(PG8_SA(0, 0), a2, voffA);
            PG8_WAIT_V(8); PG8_WAIT_L(0); PG8_BAR; PG8_MMA(1, 0, At, B0); PG8_MMA(1, 1, At, B1); PG8_BAR; PG8_SCHED;
            PG8_LDB(B0, 1, 0); PG8_LDB(B1, 1, 1); PG8_SCHED; PG8_LDA(At, 1, 0); PG8_STAGE(PG8_SA(0, 1), a2 + hstep, voffA);
            PG8_WAIT_V(8); PG8_WAIT_L(0); PG8_BAR; PG8_MMA(0, 0, At, B0); PG8_MMA(0, 1, At, B1); PG8_BAR; PG8_SCHED;
            PG8_LDA(At, 1, 1); PG8_STAGE(PG8_SB(1, 0), b3, voffB); PG8_STAGE(PG8_SB(1, 1), b3 + hstep, voffB); PG8_STAGE(PG8_SA(1, 0), a3, voffA);
            PG8_WAIT_V(8); PG8_WAIT_L(0); PG8_BAR; PG8_MMA(1, 0, At, B0); PG8_MMA(1, 1, At, B1); PG8_BAR; PG8_SCHED;
            } else {
            PG8_LDB(B0, 0, 0); PG8_SCHED; PG8_LDA(At, 0, 0); PG8_STAGE(PG8_SA(1, 1), a1 + hstep, voffA);
            PG8_WAIT_L(8); PG8_BAR; PG8_WAIT_L(0); PG8_MMA(0, 0, At, B0); PG8_BAR; PG8_SCHED;
            PG8_LDB(B1, 0, 1); PG8_STAGE(PG8_SB(0, 0), b2, voffB);
            PG8_BAR; PG8_WAIT_L(0); PG8_MMA(0, 1, At, B1); PG8_BAR;
            PG8_LDA(At, 0, 1); PG8_STAGE(PG8_SA(0, 0), a2, voffA);
            PG8_BAR; PG8_WAIT_L(0); PG8_MMA(1, 0, At, B0); PG8_BAR; PG8_SCHED;
            PG8_STAGE(PG8_SB(0, 1), b2 + hstep, voffB);
            PG8_WAIT_V(6); PG8_BAR; PG8_MMA(1, 1, At, B1); PG8_BAR;
            PG8_LDB(B0, 1, 0); PG8_SCHED; PG8_LDA(At, 1, 0); PG8_STAGE(PG8_SA(0, 1), a2 + hstep, voffA);
            PG8_WAIT_L(8); PG8_BAR; PG8_WAIT_L(0); PG8_MMA(0, 0, At, B0); PG8_BAR; PG8_SCHED;
            PG8_LDB(B1, 1, 1); PG8_STAGE(PG8_SB(1, 0), b3, voffB);
            PG8_BAR; PG8_WAIT_L(0); PG8_MMA(0, 1, At, B1); PG8_BAR;
            PG8_LDA(At, 1, 1); PG8_STAGE(PG8_SA(1, 0), a3, voffA);
            PG8_BAR; PG8_WAIT_L(0); PG8_MMA(1, 0, At, B0); PG8_BAR; PG8_SCHED;
            PG8_STAGE(PG8_SB(1, 1), b3 + hstep, voffB);
            PG8_WAIT_V(6); PG8_BAR; PG8_MMA(1, 1, At, B1); PG8_BAR;
            }
        }
        if constexpr (ALIGN_EPI) { if (wr == 0) PG8_BAR; }
        E(acc, cur, wr, wc, fr, fq); S.done(cur);
        if (!has_next) break;
#pragma unroll
        for (int a = 0; a < 2; ++a)
#pragma unroll
            for (int b = 0; b < 2; ++b)
#pragma unroll
                for (int m = 0; m < 4; ++m)
#pragma unroll
                    for (int n = 0; n < 2; ++n) acc[a][b][m][n] = (f32x4){0.f, 0.f, 0.f, 0.f};
        cur = nxt; cA = nA; cB = nB; ++ui;
        if constexpr (ALIGN_EPI) { if (wr == 1) PG8_BAR; }
    }
    PG8_WAIT_V(0);
    if constexpr (!ALIGN_EPI) { if (wr == 0) PG8_BAR; }
    PG8_BAR;
#undef PG8_SA
#undef PG8_SB
#undef PG8_STAGE
#undef PG8_LDA
#undef PG8_LDB
#undef PG8_MMA
#undef PG8_WAIT_V
#undef PG8_WAIT_L
#undef PG8_BAR
#undef PG8_SCHED
}

struct EpiProj {
    static constexpr bool PERM = true;
    bf16_t* PA; bf16_t* PG; bf16_t* UB;
    __device__ __forceinline__ void operator()(const f32x4 (&acc)[2][2][4][2], const Unit& u, int wr, int wc, int fr, int fq) const {
        const int row0 = u.pm * BM + wr * 64 + fr; int colt = u.pn * BM; const bool isu = colt < 1024; bf16_t* base = colt < 4096 ? PA : PG; colt &= 4095;
        const int col0 = colt + wc * 32 + 8 * fq;
#pragma unroll
        for (int ai = 0; ai < 2; ++ai)
#pragma unroll
            for (int m = 0; m < 4; ++m) { const int row = row0 + ai * HALF + m * 16; bf16_t* rowp = base + (size_t)row * 4096 + col0;
#pragma unroll
                for (int bj = 0; bj < 2; ++bj) { const f32x4 v0 = acc[ai][bj][m][0], v1 = acc[ai][bj][m][1];
                    u32x4 w; w.x = cvt_pk_bf16(v0[0], v0[1]); w.y = cvt_pk_bf16(v0[2], v0[3]); w.z = cvt_pk_bf16(v1[0], v1[1]); w.w = cvt_pk_bf16(v1[2], v1[3]);
                    if (isu) { const int cu = col0 + bj * HALF; *(u32x4*)(UB + (((size_t)((row >> 13) * 64 + (cu >> 4)) * 8192 + (row & 8191)) * 16 + (cu & 8))) = w; }
                    else *(u32x4*)(rowp + bj * HALF) = w; } }
    }
};
struct EpiAttUp {
    static constexpr bool PERM = true;
    const bf16_t* PG; bf16_t* HB;
    __device__ __forceinline__ void operator()(const f32x4 (&acc)[2][2][4][2], const Unit& u, int wr, int wc, int fr, int fq) const {
        const int row0 = u.pm * BM + wr * 64 + fr; const int col0 = u.pn * BM + wc * 32 + 8 * fq;
#pragma unroll
        for (int ai = 0; ai < 2; ++ai)
#pragma unroll
            for (int m = 0; m < 4; ++m) { const size_t row = (size_t)(row0 + ai * HALF + m * 16);
#pragma unroll
                for (int bj = 0; bj < 2; ++bj) { const int col = col0 + bj * HALF;
                    const u32x4 gw = *(const u32x4*)(PG + row * 4096 + 2048 + col);
                    const f32x4 v0 = acc[ai][bj][m][0], v1 = acc[ai][bj][m][1];
                    u32x4 w;
                    w.x = cvt_pk_bf16(v0[0] * sigmoidf_(bf_lo(gw.x)), v0[1] * sigmoidf_(bf_hi(gw.x)));
                    w.y = cvt_pk_bf16(v0[2] * sigmoidf_(bf_lo(gw.y)), v0[3] * sigmoidf_(bf_hi(gw.y)));
                    w.z = cvt_pk_bf16(v1[0] * sigmoidf_(bf_lo(gw.z)), v1[1] * sigmoidf_(bf_hi(gw.z)));
                    w.w = cvt_pk_bf16(v1[2] * sigmoidf_(bf_lo(gw.w)), v1[3] * sigmoidf_(bf_hi(gw.w)));
                    *(u32x4*)(HB + row * 2048 + col) = w; } }
    }
};
struct EpiGlu {
    static constexpr bool PERM = true;
    const bf16_t* PG; bf16_t* HB;
    __device__ __forceinline__ void operator()(const f32x4 (&acc)[2][2][4][2], const Unit& u, int wr, int wc, int fr, int fq) const {
        const int row0 = u.pm * BM + wr * 64 + fr; const int col = u.pn * HALF + wc * 32 + 8 * fq;
#pragma unroll
        for (int ai = 0; ai < 2; ++ai)
#pragma unroll
            for (int m = 0; m < 4; ++m) { const size_t row = (size_t)(row0 + ai * HALF + m * 16);
                const u32x4 gw = *(const u32x4*)(PG + row * 4096 + col);
                const u32x4 aw = *(const u32x4*)(HB + row * 2048 + col);
                const f32x4 a0 = acc[ai][0][m][0], a1 = acc[ai][0][m][1], g0 = acc[ai][1][m][0], g1 = acc[ai][1][m][1];
                u32x4 w;
                w.x = cvt_pk_bf16(sigmoidf_(bf_lo(gw.x)) * a0[0] * sigmoidf_(g0[0]) + bf_lo(aw.x), sigmoidf_(bf_hi(gw.x)) * a0[1] * sigmoidf_(g0[1]) + bf_hi(aw.x));
                w.y = cvt_pk_bf16(sigmoidf_(bf_lo(gw.y)) * a0[2] * sigmoidf_(g0[2]) + bf_lo(aw.y), sigmoidf_(bf_hi(gw.y)) * a0[3] * sigmoidf_(g0[3]) + bf_hi(aw.y));
                w.z = cvt_pk_bf16(sigmoidf_(bf_lo(gw.z)) * a1[0] * sigmoidf_(g1[0]) + bf_lo(aw.z), sigmoidf_(bf_hi(gw.z)) * a1[1] * sigmoidf_(g1[1]) + bf_hi(aw.z));
                w.w = cvt_pk_bf16(sigmoidf_(bf_lo(gw.w)) * a1[2] * sigmoidf_(g1[2]) + bf_lo(aw.w), sigmoidf_(bf_hi(gw.w)) * a1[3] * sigmoidf_(g1[3]) + bf_hi(aw.w));
                *(u32x4*)(HB + row * 2048 + col) = w; }
    }
};
struct EpiOut {
    static constexpr bool PERM = true;
    const float* X; float* O; const float* mod;
    __device__ __forceinline__ void operator()(const f32x4 (&acc)[2][2][4][2], const Unit& u, int wr, int wc, int fr, int fq) const {
        const int row0 = u.pm * BM + wr * 64 + fr; const int col0 = u.pn * BM + wc * 32 + 8 * fq;
        const float* gt = mod + (size_t)((u.pm * BM) >> 13) * 12288 + 4096;
#pragma unroll
        for (int bj = 0; bj < 2; ++bj) { const int col = col0 + bj * HALF;
            const f32x4 g0 = *(const f32x4*)(gt + col), g1 = *(const f32x4*)(gt + col + 4);
#pragma unroll
            for (int ai = 0; ai < 2; ++ai)
#pragma unroll
                for (int m = 0; m < 4; ++m) { const size_t off = (size_t)(row0 + ai * HALF + m * 16) * 2048 + col;
                    const f32x4 x0 = *(const f32x4*)(X + off), x1 = *(const f32x4*)(X + off + 4);
                    *(f32x4*)(O + off) = x0 + g0 * acc[ai][bj][m][0]; *(f32x4*)(O + off + 4) = x1 + g1 * acc[ai][bj][m][1]; } }
    }
};
struct EpiF32 {
    static constexpr bool PERM = true;
    float* O;
    __device__ __forceinline__ void operator()(const f32x4 (&acc)[2][2][4][2], const Unit& u, int wr, int wc, int fr, int fq) const {
        const int row0 = u.pm * BM + wr * 64 + fr; const int col0 = u.pn * BM + wc * 32 + 8 * fq;
#pragma unroll
        for (int ai = 0; ai < 2; ++ai)
#pragma unroll
            for (int m = 0; m < 4; ++m) { float* rowp = O + (size_t)(row0 + ai * HALF + m * 16) * 2048 + col0;
#pragma unroll
                for (int bj = 0; bj < 2; ++bj) { *(f32x4*)(rowp + bj * HALF) = acc[ai][bj][m][0]; *(f32x4*)(rowp + bj * HALF + 4) = acc[ai][bj][m][1]; } }
    }
};
}

struct Args { const float* in[25]; float* out; unsigned char* ws; int ph_lo, ph_hi; };
enum { I_X = 0, I_C, I_WADA, I_BADA, I_N1G, I_WIN, I_LRE, I_LIM, I_LDT, I_BRE, I_BIM, I_CRE, I_CIM, I_SD, I_WGLU, I_QNG, I_KNG, I_WATT, I_WOUT, I_N2G, I_WQ, I_K1, I_K2, I_PU, I_PV };

__device__ __forceinline__ void ph_mod_partial(const float* __restrict__ c, const float* __restrict__ w_ada, float* modp, int gw, int ngw, int lane) {
    for (int task = gw; task < 48 * 32; task += ngw) {
        const int strip = task % 48, ks = task / 48, n0 = strip * 256 + lane * 4, k0 = ks * 64;
        f32x4 a0 = {0.f, 0.f, 0.f, 0.f}, a1 = {0.f, 0.f, 0.f, 0.f};
#pragma unroll 8
        for (int k = 0; k < 64; ++k) {
            const f32x4 w = *(const f32x4*)(w_ada + (size_t)(k0 + k) * 12288 + n0);
            float c0 = c[k0 + k], c1 = c[2048 + k0 + k];
            c0 = c0 / (1.0f + __expf(-c0)); c1 = c1 / (1.0f + __expf(-c1));
            a0 += c0 * w; a1 += c1 * w;
        }
        *(f32x4*)(modp + (size_t)(ks * 2 + 0) * 12288 + n0) = a0;
        *(f32x4*)(modp + (size_t)(ks * 2 + 1) * 12288 + n0) = a1;
    }
}

__device__ __forceinline__ void transpose_item(const float* __restrict__ W, int K, int N, bf16_t* WT, int drow0, int scol0, int k0, LAS float* scr, int lane) {
#pragma unroll 8
    for (int i = 0; i < 32; ++i) { const int kk = 2 * i + (lane >> 5); scr[kk * 33 + (lane & 31)] = W[(size_t)(k0 + kk) * N + scol0 + (lane & 31)]; }
    LDS_WAIT();
    const int c = lane & 7;
#pragma unroll
    for (int j = 0; j < 4; ++j) { const int n = (lane >> 3) + 8 * j; const LAS float* s = scr + (8 * c) * 33 + n;
        u32x4 o; o.x = cvt_pk_bf16(s[0 * 33], s[1 * 33]); o.y = cvt_pk_bf16(s[2 * 33], s[3 * 33]); o.z = cvt_pk_bf16(s[4 * 33], s[5 * 33]); o.w = cvt_pk_bf16(s[6 * 33], s[7 * 33]);
        *(u32x4*)(WT + (size_t)(drow0 + n) * K + k0 + 8 * c) = o; }
    LDS_WAIT();
}
__device__ __forceinline__ void wsc_item(const float* wq, const float* kk, bf16_t* out, int lane) {
    const int r = lane & 15, q = lane >> 4;
    f32x4 acc[8];
#pragma unroll
    for (int f = 0; f < 8; ++f) acc[f] = (f32x4){0.f, 0.f, 0.f, 0.f};
    const float* ap = kk + r * 128 + 4 * q; const float* bp = wq + (size_t)r * 2048 + 4 * q;
#pragma unroll 2
    for (int d0 = 0; d0 < 128; d0 += 16) {
        const f32x4 bv = *(const f32x4*)(bp + d0);
        f32x4 av[8];
#pragma unroll
        for (int f = 0; f < 8; ++f) av[f] = *(const f32x4*)(ap + f * 2048 + d0);
#pragma unroll
        for (int j = 0; j < 4; ++j)
#pragma unroll
            for (int f = 0; f < 8; ++f) acc[f] = __builtin_amdgcn_mfma_f32_16x16x4f32(av[f][j], bv[j], acc[f], 0, 0, 0);
    }
#pragma unroll
    for (int f = 0; f < 8; ++f)
#pragma unroll
        for (int i = 0; i < 4; ++i) out[(size_t)(16 * f + 4 * q + i) * 2048 + r] = (bf16_t)(cvt_pk_bf16(acc[f][i], 0.f) & 0xffffu);
}
__device__ __forceinline__ void ph_prologue(const Args& a, LAS unsigned char* lds, int gw, int ngw, int lane, int wave) {
    unsigned char* ws = a.ws;
    { const float* modp = (const float*)(ws + WS_MODP); float* mod = (float*)(ws + WS_MOD); const float* b_ada = a.in[I_BADA];
      for (int idx = gw * 64 + lane; idx < 2 * 12288; idx += ngw * 64) { const int b = idx / 12288, n = idx - b * 12288; float s = b_ada[n];
#pragma unroll 8
          for (int ks = 0; ks < 32; ++ks) s += modp[(size_t)(ks * 2 + b) * 12288 + n];
          mod[idx] = s; } }
    for (int item = gw; item < 2048; item += ngw) { const int hj = item >> 7, k0 = (item & 127) * 16;
        wsc_item(a.in[I_WQ] + (size_t)k0 * 2048 + hj * 128, (hj & 1) ? a.in[I_K2] : a.in[I_K1], (bf16_t*)(ws + WS_WSC) + (size_t)(hj * 128) * 2048 + k0, lane); }
    { LAS float* scr = (LAS float*)(lds + wave * 8448);
      constexpr int I_IN = 32 * 256, I_GLU = 16 * 128, I_ATT = 16 * 64, I_OUT = 32 * 64, NIT = I_IN + I_GLU + I_ATT + I_OUT;
      for (int it = gw; it < NIT; it += ngw) {
          int r = it;
          if (r < I_IN) { const int kb = r / 256, nb = r % 256; transpose_item(a.in[I_WIN], 2048, 8192, (bf16_t*)(ws + WS_WIN), 32 * nb, 32 * nb, 64 * kb, scr, lane); continue; } r -= I_IN;
          if (r < I_GLU) { const int kb = r / 128, nb = r % 128, dr = 32 * nb; const int sc = ((dr >> 7) & 1) * 2048 + (dr >> 8) * 128 + (dr & 127);
              transpose_item(a.in[I_WGLU], 1024, 4096, (bf16_t*)(ws + WS_WGLU), dr, sc, 64 * kb, scr, lane); continue; } r -= I_GLU;
          if (r < I_ATT) { const int kb = r / 64, nb = r % 64; transpose_item(a.in[I_WATT], 1024, 2048, (bf16_t*)(ws + WS_WATT), 32 * nb, 32 * nb, 64 * kb, scr, lane); continue; } r -= I_ATT;
          { const int kb = r / 64, nb = r % 64; transpose_item(a.in[I_WOUT], 2048, 2048, (bf16_t*)(ws + WS_WOUT), 32 * nb, 32 * nb, 64 * kb, scr, lane); }
      } }
}

__device__ __forceinline__ void ph_norm(const float* X, bf16_t* Hout, const float* __restrict__ g, const float* mod, int sh_off, int sc_off, int gw, int ngw, int lane) {
    for (int row = gw; row < T_TOK; row += ngw) {
        const int b = row >> 13;
        const f32x4* xr = (const f32x4*)(X + (size_t)row * DM) + lane;
        f32x4 v[8]; float ss = 0.f;
#pragma unroll
        for (int j = 0; j < 8; ++j) { v[j] = xr[64 * j]; ss += (v[j][0] * v[j][0] + v[j][1] * v[j][1]) + (v[j][2] * v[j][2] + v[j][3] * v[j][3]); }
        ss = wave_sum(ss);
        const float rs = 1.0f / sqrtf(ss * (1.0f / DM) + EPS);
        const float* mb = mod + (size_t)b * 12288;
#pragma unroll
        for (int j = 0; j < 8; ++j) { const int col = 4 * (lane + 64 * j);
            const f32x4 gv = *(const f32x4*)(g + col), sc = *(const f32x4*)(mb + sc_off + col), sh = *(const f32x4*)(mb + sh_off + col);
            const f32x4 o = v[j] * rs * gv * (sc + 1.0f) + sh;
            u32x2 w; w.x = cvt_pk_bf16(o[0], o[1]); w.y = cvt_pk_bf16(o[2], o[3]);
            *(u32x2*)(Hout + (size_t)row * DM + col) = w; }
    }
}

__device__ __forceinline__ void ph_attn(LAS unsigned char* lds, const bf16_t* PA, bf16_t* ATT, const float* __restrict__ qg, const float* __restrict__ kg, int G) {
    const int tid = opaque_tid(), lane = tid & 63, wave = __builtin_amdgcn_readfirstlane(tid >> 6), c = lane & 15, g = lane >> 4;
    LAS unsigned char* KL = lds;
    LAS unsigned char* VT = lds + 17408;
    bf16x8 tri[6];
    { const int FS[6] = {0, 1, 0, 1, 2, 3}, FP[6] = {0, 0, 1, 1, 1, 1};
#pragma unroll
      for (int q = 0; q < 6; ++q)
#pragma unroll
          for (int jj = 0; jj < 8; ++jj) { const int kap = 32 * FP[q] + 16 * (jj >> 2) + 4 * g + (jj & 3); tri[q][jj] = (kap > 16 * FS[q] + c) ? (short)0x3F80 : (short)0; } }
    for (int u = blockIdx.x; u < 1024; u += G) {
        const int b = u >> 9, h = (u >> 6) & 7, qb = u & 63, t0 = qb * 128, tq0 = t0 + 16 * wave, tq = tq0 + c;
        bf16x8 qf[4];
        { const bf16_t* qrow = PA + (size_t)(b * SEQ + tq) * 4096 + 1024 + h * 128;
          u32x4 qr[4]; float ss = 0.f;
#pragma unroll
          for (int kk = 0; kk < 4; ++kk) { qr[kk] = *(const u32x4*)(qrow + 32 * kk + 8 * g);
#pragma unroll
              for (int e = 0; e < 4; ++e) { const float lo = bf_lo(qr[kk][e]), hi = bf_hi(qr[kk][e]); ss += lo * lo + hi * hi; } }
          ss += __shfl_xor(ss, 16); ss += __shfl_xor(ss, 32);
          const float rs = (1.0f / sqrtf(ss * (1.0f / 128.0f) + EPS)) * 0.08838834764831845f;
#pragma unroll
          for (int kk = 0; kk < 4; ++kk) { const f32x4 g0 = *(const f32x4*)(qg + 32 * kk + 8 * g), g1 = *(const f32x4*)(qg + 32 * kk + 8 * g + 4);
              u32x4 w;
              w.x = cvt_pk_bf16(bf_lo(qr[kk].x) * rs * g0[0], bf_hi(qr[kk].x) * rs * g0[1]);
              w.y = cvt_pk_bf16(bf_lo(qr[kk].y) * rs * g0[2], bf_hi(qr[kk].y) * rs * g0[3]);
              w.z = cvt_pk_bf16(bf_lo(qr[kk].z) * rs * g1[0], bf_hi(qr[kk].z) * rs * g1[1]);
              w.w = cvt_pk_bf16(bf_lo(qr[kk].w) * rs * g1[2], bf_hi(qr[kk].w) * rs * g1[3]);
              qf[kk] = __builtin_bit_cast(bf16x8, w); } }
        float carry = 0.f; int wdone = 0;
        f32x4 oacc[8];
#pragma unroll
        for (int fd = 0; fd < 8; ++fd) oacc[fd] = (f32x4){0.f, 0.f, 0.f, 0.f};
        for (int kt = 2 * qb + 1; kt >= 0; --kt) {
            const int k0 = kt * 64;
            if (__syncthreads_and(wdone)) break;
#pragma unroll
            for (int p = 0; p < 2; ++p) {
                const int ci = tid + 512 * p, key = ci >> 4, ch = ci & 15;
                const u32x4 kr = *(const u32x4*)(PA + (size_t)(b * SEQ + k0 + key) * 4096 + 2048 + h * 128 + 8 * ch);
                float f[8]; f[0] = bf_lo(kr.x); f[1] = bf_hi(kr.x); f[2] = bf_lo(kr.y); f[3] = bf_hi(kr.y); f[4] = bf_lo(kr.z); f[5] = bf_hi(kr.z); f[6] = bf_lo(kr.w); f[7] = bf_hi(kr.w);
                float ss = 0.f;
#pragma unroll
                for (int e = 0; e < 8; ++e) ss += f[e] * f[e];
                ss += __shfl_xor(ss, 1); ss += __shfl_xor(ss, 2); ss += __shfl_xor(ss, 4); ss += __shfl_xor(ss, 8);
                const float rs = 1.0f / sqrtf(ss * (1.0f / 128.0f) + EPS);
                const f32x4 g0 = *(const f32x4*)(kg + 8 * ch), g1 = *(const f32x4*)(kg + 8 * ch + 4);
                u32x4 w;
                w.x = cvt_pk_bf16(f[0] * rs * g0[0], f[1] * rs * g0[1]); w.y = cvt_pk_bf16(f[2] * rs * g0[2], f[3] * rs * g0[3]);
                w.z = cvt_pk_bf16(f[4] * rs * g1[0], f[5] * rs * g1[1]); w.w = cvt_pk_bf16(f[6] * rs * g1[2], f[7] * rs * g1[3]);
                *(LAS u32x4*)(KL + key * 272 + ch * 16) = w;
            }
#pragma unroll
            for (int p = 0; p < 2; ++p) {
                const int key = lane, ch = wave + 8 * p;
                const u32x4 vr = *(const u32x4*)(PA + (size_t)(b * SEQ + k0 + key) * 4096 + 3072 + h * 128 + 8 * ch);
                LAS unsigned short* vt = (LAS unsigned short*)(VT + (8 * ch) * 144 + key * 2);
                vt[0 * 72] = (unsigned short)(vr.x & 0xffffu); vt[1 * 72] = (unsigned short)(vr.x >> 16);
                vt[2 * 72] = (unsigned short)(vr.y & 0xffffu); vt[3 * 72] = (unsigned short)(vr.y >> 16);
                vt[4 * 72] = (unsigned short)(vr.z & 0xffffu); vt[5 * 72] = (unsigned short)(vr.z >> 16);
                vt[6 * 72] = (unsigned short)(vr.w & 0xffffu); vt[7 * 72] = (unsigned short)(vr.w >> 16);
            }
            __syncthreads();
            if (!wdone && k0 < tq0 + 15) {
                f32x4 zt[4];
#pragma unroll
                for (int f = 0; f < 4; ++f) { f32x4 acc = {0.f, 0.f, 0.f, 0.f};
#pragma unroll
                    for (int kk = 0; kk < 4; ++kk) { const bf16x8 kf = *(const LAS bf16x8*)(KL + (16 * f + c) * 272 + (32 * kk + 8 * g) * 2);
                        acc = __builtin_amdgcn_mfma_f32_16x16x32_bf16(kf, qf[kk], acc, 0, 0, 0); }
                    zt[f] = acc; }
                float lf[4][4], lz[4][4]; float tot = 0.f;
#pragma unroll
                for (int f = 0; f < 4; ++f)
#pragma unroll
                    for (int i = 0; i < 4; ++i) { const int s = k0 + 16 * f + 4 * g + i; const bool valid = s < tq; const float z = zt[f][i];
                        const float sp = fmaxf(z, 0.f) + __logf(1.0f + __expf(-fabsf(z)));
                        const float l = valid ? -sp : 0.f; lf[f][i] = l; lz[f][i] = valid ? (l + z) : -INFINITY; tot += l; }
                tot += __shfl_xor(tot, 16); tot += __shfl_xor(tot, 32);
                bf16x8 lh[2], ll[2];
#pragma unroll
                for (int fp = 0; fp < 2; ++fp) { u32x4 wh, wl;
#pragma unroll
                    for (int q = 0; q < 2; ++q) { const int f = 2 * fp + q;
                        const unsigned h0 = cvt_pk_bf16(lf[f][0], lf[f][1]), h1 = cvt_pk_bf16(lf[f][2], lf[f][3]);
                        const unsigned l0 = cvt_pk_bf16(lf[f][0] - bf_lo(h0), lf[f][1] - bf_hi(h0)), l1 = cvt_pk_bf16(lf[f][2] - bf_lo(h1), lf[f][3] - bf_hi(h1));
                        wh[2 * q] = h0; wh[2 * q + 1] = h1; wl[2 * q] = l0; wl[2 * q + 1] = l1; }
                    lh[fp] = __builtin_bit_cast(bf16x8, wh); ll[fp] = __builtin_bit_cast(bf16x8, wl); }
                f32x4 sf[4];
                { f32x4 z4 = {0.f, 0.f, 0.f, 0.f};
                  sf[0] = __builtin_amdgcn_mfma_f32_16x16x32_bf16(tri[0], lh[0], z4, 0, 0, 0); sf[0] = __builtin_amdgcn_mfma_f32_16x16x32_bf16(tri[0], ll[0], sf[0], 0, 0, 0);
                  sf[0] = __builtin_amdgcn_mfma_f32_16x16x32_bf16(tri[2], lh[1], sf[0], 0, 0, 0); sf[0] = __builtin_amdgcn_mfma_f32_16x16x32_bf16(tri[2], ll[1], sf[0], 0, 0, 0);
                  sf[1] = __builtin_amdgcn_mfma_f32_16x16x32_bf16(tri[1], lh[0], z4, 0, 0, 0); sf[1] = __builtin_amdgcn_mfma_f32_16x16x32_bf16(tri[1], ll[0], sf[1], 0, 0, 0);
                  sf[1] = __builtin_amdgcn_mfma_f32_16x16x32_bf16(tri[3], lh[1], sf[1], 0, 0, 0); sf[1] = __builtin_amdgcn_mfma_f32_16x16x32_bf16(tri[3], ll[1], sf[1], 0, 0, 0);
                  sf[2] = __builtin_amdgcn_mfma_f32_16x16x32_bf16(tri[4], lh[1], z4, 0, 0, 0); sf[2] = __builtin_amdgcn_mfma_f32_16x16x32_bf16(tri[4], ll[1], sf[2], 0, 0, 0);
                  sf[3] = __builtin_amdgcn_mfma_f32_16x16x32_bf16(tri[5], lh[1], z4, 0, 0, 0); sf[3] = __builtin_amdgcn_mfma_f32_16x16x32_bf16(tri[5], ll[1], sf[3], 0, 0, 0); }
                bf16x8 pb[2];
#pragma unroll
                for (int fp = 0; fp < 2; ++fp) { u32x4 w;
#pragma unroll
                    for (int q = 0; q < 2; ++q) { const int f = 2 * fp + q; float p[4];
#pragma unroll
                        for (int i = 0; i < 4; ++i) p[i] = __expf(lz[f][i] + sf[f][i] + carry);
                        w[2 * q] = cvt_pk_bf16(p[0], p[1]); w[2 * q + 1] = cvt_pk_bf16(p[2], p[3]); }
                    pb[fp] = __builtin_bit_cast(bf16x8, w); }
                carry += tot;
#pragma unroll
                for (int fd = 0; fd < 8; ++fd)
#pragma unroll
                    for (int fp = 0; fp < 2; ++fp) { const LAS unsigned char* vp = VT + (16 * fd + c) * 144 + (32 * fp + 4 * g) * 2;
                        const u32x2 v0 = *(const LAS u32x2*)vp, v1 = *(const LAS u32x2*)(vp + 32);
                        u32x4 vw; vw.x = v0.x; vw.y = v0.y; vw.z = v1.x; vw.w = v1.y;
                        oacc[fd] = __builtin_amdgcn_mfma_f32_16x16x32_bf16(__builtin_bit_cast(bf16x8, vw), pb[fp], oacc[fd], 0, 0, 0); }
                wdone = (__ballot(carry >= -105.0f) == 0ull) ? 1 : 0;
            }
        }
        { bf16_t* orow = ATT + (size_t)(b * SEQ + tq) * 1024 + h * 128 + 4 * g;
#pragma unroll
          for (int fd = 0; fd < 8; ++fd) { u32x2 w; w.x = cvt_pk_bf16(oacc[fd][0], oacc[fd][1]); w.y = cvt_pk_bf16(oacc[fd][2], oacc[fd][3]); *(u32x2*)(orow + 16 * fd) = w; } }
    }
    __syncthreads();
}

__device__ __forceinline__ void ssm_lambda(const Args& a, int g, int st, float& lbr, float& lbi, float& qr, float& qi) {
    const float lr = a.in[I_LRE][g * 64 + st], li = a.in[I_LIM][g * 64 + st], dt = __expf(a.in[I_LDT][g]);
    const float mag = __expf(lr * dt);
    float rev = li * dt * 0.15915494309189535f; rev -= rintf(rev);
    lbr = mag * __builtin_amdgcn_cosf(rev); lbi = mag * __builtin_amdgcn_sinf(rev);
    const float nr = lbr - 1.0f, ni = lbi, den = 1.0f / (lr * lr + li * li);
    qr = (nr * lr + ni * li) * den; qi = (ni * lr - nr * li) * den;
}
template <bool WITH_Y>
__device__ __forceinline__ void ph_ssm_mfma(const Args& a, LAS unsigned char* lds, const bf16_t* UB, f32x2* E, bf16_t* YA, int G) {
    const int tid = opaque_tid(), lane = tid & 63, wave = __builtin_amdgcn_readfirstlane(tid >> 6), c = lane & 15, gl = lane >> 4;
    LAS f32x2* sl = (LAS f32x2*)(lds + wave * 8192);
    LAS f32x4* tab = (LAS f32x4*)(lds + 65536 + wave * 1024);
    LAS u32x4* cml = (LAS u32x4*)(lds + 73728 + wave * 5120) + lane;
    for (int item = blockIdx.x; item < 128; item += G) {
        const int b = item >> 6, cb = (item >> 3) & 7, g = (item & 7) * 8 + wave, c0 = cb * 16;
        float mur, mui;
        { float lbr, lbi, qr, qi; ssm_lambda(a, g, lane, lbr, lbi, qr, qi); tab[lane] = (f32x4){lbr, lbi, qr, qi}; mur = lbr; mui = lbi; }
        LDS_WAIT();
        bf16x8 bm[8];
        const float* brb = a.in[I_BRE] + (g * 64 + (c >> 1)) * 16 + 8 * (gl & 1); const float* bib = a.in[I_BIM] + (g * 64 + (c >> 1)) * 16 + 8 * (gl & 1);
        const LAS f32x4* tabb = tab + (c >> 1);
#pragma unroll
        for (int f = 0; f < 8; ++f) { const f32x4 tv = tabb[8 * f]; const float qr = tv[2], qi = tv[3];
            const float* br = brb + 128 * f; const float* bim = bib + 128 * f;
            const f32x4 r0 = *(const f32x4*)br, r1 = *(const f32x4*)(br + 4), i0 = *(const f32x4*)bim, i1 = *(const f32x4*)(bim + 4);
            float v[8];
#pragma unroll
            for (int e = 0; e < 4; ++e) { const float vr0 = qr * r0[e] - qi * i0[e], vi0 = qr * i0[e] + qi * r0[e], vr1 = qr * r1[e] - qi * i1[e], vi1 = qr * i1[e] + qi * r1[e];
                v[e] = (c & 1) ? vi0 : vr0; v[4 + e] = (c & 1) ? vi1 : vr1; }
            if (gl >= 2) {
#pragma unroll
                for (int e = 0; e < 8; ++e) v[e] = 0.f; }
            u32x4 w; w.x = cvt_pk_bf16(v[0], v[1]); w.y = cvt_pk_bf16(v[2], v[3]); w.z = cvt_pk_bf16(v[4], v[5]); w.w = cvt_pk_bf16(v[6], v[7]);
            bm[f] = __builtin_bit_cast(bf16x8, w); }
        float lmr[16], lmi[16];
#pragma unroll
        for (int k = 0; k < 16; ++k) { const f32x4 tv = tab[2 * gl + 8 * (k >> 1) + (k & 1)]; lmr[k] = tv[0]; lmi[k] = tv[1]; }
        if (WITH_Y) {
            const float* crb = a.in[I_CRE] + (g * 16 + c) * 64 + 2 * gl; const float* cib = a.in[I_CIM] + (g * 16 + c) * 64 + 2 * gl;
#pragma unroll
            for (int kk = 0; kk < 4; ++kk) { float v[8];
#pragma unroll
                for (int jh = 0; jh < 2; ++jh) { const f32x2 r = *(const f32x2*)(crb + 8 * (2 * kk + jh)), m = *(const f32x2*)(cib + 8 * (2 * kk + jh));
                    v[4 * jh] = r.x; v[4 * jh + 1] = -m.x; v[4 * jh + 2] = r.y; v[4 * jh + 3] = -m.y; }
                u32x4 w; w.x = cvt_pk_bf16(v[0], v[1]); w.y = cvt_pk_bf16(v[2], v[3]); w.z = cvt_pk_bf16(v[4], v[5]); w.w = cvt_pk_bf16(v[6], v[7]);
                cml[64 * kk] = w; }
            { const float dv = a.in[I_SD][g * 16 + c]; float v[8];
#pragma unroll
              for (int jj = 0; jj < 8; ++jj) v[jj] = (gl < 2 && (8 * gl + jj) == c) ? dv : 0.f;
              u32x4 w; w.x = cvt_pk_bf16(v[0], v[1]); w.y = cvt_pk_bf16(v[2], v[3]); w.z = cvt_pk_bf16(v[4], v[5]); w.w = cvt_pk_bf16(v[6], v[7]);
              cml[256] = w; }
        }
        f32x4 s[8];
#pragma unroll
        for (int f = 0; f < 8; ++f) s[f] = (f32x4){0.f, 0.f, 0.f, 0.f};
        if (WITH_Y) {
            float pr = mur, pi = mui;
#pragma unroll
            for (int q = 0; q < 6; ++q) { const float nr = pr * pr - pi * pi, ni = 2.0f * pr * pi; pr = nr; pi = ni; }
            float sr = 0.f, si = 0.f;
            const f32x2* ep = E + (size_t)((b * 64 + g) * 128) * 64 + lane;
            for (int cc = 0; cc <= c0; cc += 16) {
                f32x2 ev[16];
#pragma unroll
                for (int k = 0; k < 16; ++k) ev[k] = ep[(size_t)(cc + k) * 64];
#pragma unroll
                for (int k = 0; k < 16; ++k) { if (cc == c0) sl[k * 64 + lane] = (f32x2){sr, si};
                    const float nr = pr * sr - pi * si + ev[k][0], ni = pr * si + pi * sr + ev[k][1]; sr = nr; si = ni; }
            }
            LDS_WAIT();
#pragma unroll
            for (int f = 0; f < 8; ++f) s[f] = *(const LAS f32x4*)(sl + c * 64 + 8 * f + 2 * gl);
            LDS_WAIT();
        }
        const bf16_t* up = UB + ((size_t)(b * 64 + g) * 8192 + (size_t)(c0 + c) * 64) * 16 + 8 * (gl & 1);
        bf16_t* yp = YA + (size_t)(b * SEQ + (c0 + c) * 64) * 1024 + g * 16 + 4 * gl;
        u32x4 u0 = *(const u32x4*)(up), u1 = *(const u32x4*)(up + 16), u2 = *(const u32x4*)(up + 32), u3 = *(const u32x4*)(up + 48), u4 = *(const u32x4*)(up + 64), u5 = *(const u32x4*)(up + 80);
#pragma unroll 1
        for (int tau = 0; tau < 64; ++tau) {
            const u32x4 u6 = *(const u32x4*)(up + (size_t)(tau + 6) * 16);
            const bf16x8 uf = __builtin_bit_cast(bf16x8, u0);
#pragma unroll
            for (int f = 0; f < 8; ++f) { f32x4 ci;
                ci[0] = lmr[2 * f] * s[f][0] - lmi[2 * f] * s[f][1]; ci[1] = lmr[2 * f] * s[f][1] + lmi[2 * f] * s[f][0];
                ci[2] = lmr[2 * f + 1] * s[f][2] - lmi[2 * f + 1] * s[f][3]; ci[3] = lmr[2 * f + 1] * s[f][3] + lmi[2 * f + 1] * s[f][2];
                s[f] = __builtin_amdgcn_mfma_f32_16x16x32_bf16(bm[f], uf, ci, 0, 0, 0); }
            if (WITH_Y) {
                f32x4 y = __builtin_amdgcn_mfma_f32_16x16x32_bf16(__builtin_bit_cast(bf16x8, cml[256]), uf, (f32x4){0.f, 0.f, 0.f, 0.f}, 0, 0, 0);
#pragma unroll
                for (int kk = 0; kk < 4; ++kk) { u32x4 w; w.x = cvt_pk_bf16(s[2 * kk][0], s[2 * kk][1]); w.y = cvt_pk_bf16(s[2 * kk][2], s[2 * kk][3]);
                    w.z = cvt_pk_bf16(s[2 * kk + 1][0], s[2 * kk + 1][1]); w.w = cvt_pk_bf16(s[2 * kk + 1][2], s[2 * kk + 1][3]);
                    y = __builtin_amdgcn_mfma_f32_16x16x32_bf16(__builtin_bit_cast(bf16x8, cml[64 * kk]), __builtin_bit_cast(bf16x8, w), y, 0, 0, 0); }
                u32x2 o; o.x = cvt_pk_bf16(gelu_tanh(y[0]), gelu_tanh(y[1])); o.y = cvt_pk_bf16(gelu_tanh(y[2]), gelu_tanh(y[3]));
                *(u32x2*)(yp + (size_t)tau * 1024) = o;
            }
            u0 = u1; u1 = u2; u2 = u3; u3 = u4; u4 = u5; u5 = u6;
        }
        if (!WITH_Y) { f32x2* eo = E + (size_t)((b * 64 + g) * 128 + c0 + c) * 64 + 2 * gl;
#pragma unroll
            for (int f = 0; f < 8; ++f) *(f32x4*)(eo + 8 * f) = s[f]; }
    }
}

#ifndef FP6_INTERLEAVED
#define FP6_INTERLEAVED 1
#endif
typedef float f32x16 __attribute__((ext_vector_type(16)));
typedef float f32x32 __attribute__((ext_vector_type(32)));
typedef unsigned u32x6 __attribute__((ext_vector_type(6)));
constexpr float PEER_SU = 64.0f, PEER_SV = 1.4f;
__device__ __forceinline__ void ph_table_cvt(const float* __restrict__ U, const float* __restrict__ V, unsigned char* UT, unsigned char* VT, int gw, int ngw, int lane) {
    for (int row = gw; row < 2 * 16384; row += ngw) {
        const bool sec = row >= 16384; const int r = sec ? row - 16384 : row; const float sc = sec ? PEER_SV : PEER_SU;
        const float* src = (sec ? V : U) + (size_t)r * 2048 + 32 * lane; unsigned char* dst = (sec ? VT : UT) + (size_t)r * 1536;
        f32x16 a, b;
#pragma unroll
        for (int q = 0; q < 4; ++q) { const f32x4 v0 = *(const f32x4*)(src + 4 * q), v1 = *(const f32x4*)(src + 16 + 4 * q);
#pragma unroll
            for (int e = 0; e < 4; ++e) { a[4 * q + e] = v0[e] * sc; b[4 * q + e] = v1[e] * sc; } }
        const u32x6 p = __builtin_amdgcn_cvt_scalef32_2xpk16_fp6_f32(a, b, 1.0f);
        *(u32x4*)(dst + 16 * lane) = (u32x4){p[0], p[1], p[2], p[3]};
        *(u32x2*)(dst + 1024 + 8 * lane) = (u32x2){p[4], p[5]};
    }
}

__device__ __forceinline__ void ph_peer(LAS unsigned char* lds, const float* SC, const bf16_t* H2, const unsigned char* UT, const unsigned char* VTb, const float* mod, float* OUT, int G) {
    const int tid = opaque_tid(), lane = tid & 63, wave = __builtin_amdgcn_readfirstlane(tid >> 6);
    LAS float* scr = (LAS float*)(lds + wave * 8448);
    LAS int* idxs = (LAS int*)(lds + 69632 + wave * 4096);
    LAS float* gates = (LAS float*)(lds + 69632 + wave * 4096 + 2048);
    LAS float* dotb = (LAS float*)(lds + 102400 + wave * 1024);
    for (int it = blockIdx.x; it < 512; it += G) {
        const int tokw = it * 32 + wave * 4;
        for (int rep = 0; rep < ((DUP == 101) ? 2 : 1); ++rep) {
        float tk[16];
#pragma unroll
        for (int i = 0; i < 16; ++i) tk[i] = -INFINITY;
        for (int q = 0; q < 4; ++q) {
#pragma unroll
            for (int j = 0; j < 8; ++j) { const int prob = (lane >> 3) + 8 * j, seg = lane & 7;
                const f32x4 v = *(const f32x4*)(SC + (size_t)(tokw + (prob >> 4)) * 2048 + (prob & 15) * 128 + 32 * q + 4 * seg);
                LAS float* d = scr + prob * 33 + 4 * seg; d[0] = v[0]; d[1] = v[1]; d[2] = v[2]; d[3] = v[3]; }
            LDS_WAIT();
#pragma unroll 4
            for (int vi = 0; vi < 32; ++vi) {
                float x = __uint_as_float((__float_as_uint(scr[lane * 33 + vi]) & ~127u) | (unsigned)(127 - (32 * q + vi)));
#pragma unroll
                for (int i = 0; i < 16; ++i) { const float hi = fmaxf(tk[i], x); x = fminf(tk[i], x); tk[i] = hi; }
            }
            LDS_WAIT();
        }
        float t2[16];
#pragma unroll
        for (int i = 0; i < 16; ++i) t2[i] = __shfl_xor(tk[i], 1);
        float bv[16]; int bp[16];
#pragma unroll
        for (int i = 0; i < 16; ++i) { bv[i] = -INFINITY; bp[i] = 0; }
#pragma unroll
        for (int aa = 0; aa < 16; ++aa)
#pragma unroll
            for (int bb = 0; bb < 16 / (aa + 1); ++bb) {
                const unsigned u1 = __float_as_uint(tk[aa]), u2 = __float_as_uint(t2[bb]);
                float x = __uint_as_float(u1 & ~127u) + __uint_as_float(u2 & ~127u);
                int px = (int)(((127u - (u1 & 127u)) << 7) | (127u - (u2 & 127u)));
#pragma unroll
                for (int i = 0; i < 16; ++i) { const bool gt = x > bv[i]; const float nv = gt ? x : bv[i], ox = gt ? bv[i] : x; const int np = gt ? px : bp[i], op = gt ? bp[i] : px;
                    bv[i] = nv; x = ox; bp[i] = np; px = op; }
            }
        { float e[16], sum = 0.f;
#pragma unroll
          for (int i = 0; i < 16; ++i) { e[i] = __expf(bv[i] - bv[0]); sum += e[i]; }
          const float inv = 1.0f / sum;
          if ((lane & 1) == 0) { const int tl = lane >> 4, head = (lane & 15) >> 1;
#pragma unroll
              for (int i = 0; i < 16; ++i) { idxs[tl * 128 + head * 16 + i] = bp[i]; gates[tl * 128 + head * 16 + i] = e[i] * inv; } } }
        LDS_WAIT();
        }
        for (int tl = 0; tl < 4; ++tl) {
            const int token = tokw + tl;
            f32x2 ha[16];
            { const bf16_t* hrow = H2 + (size_t)token * 2048 + 32 * lane; float hv[32];
#pragma unroll
              for (int q = 0; q < 4; ++q) { const u32x4 w = *(const u32x4*)(hrow + 8 * q);
                  hv[8 * q + 0] = bf_lo(w.x); hv[8 * q + 1] = bf_hi(w.x); hv[8 * q + 2] = bf_lo(w.y); hv[8 * q + 3] = bf_hi(w.y);
                  hv[8 * q + 4] = bf_lo(w.z); hv[8 * q + 5] = bf_hi(w.z); hv[8 * q + 6] = bf_lo(w.w); hv[8 * q + 7] = bf_hi(w.w); }
#pragma unroll
              for (int k = 0; k < 16; ++k) ha[k] = FP6_INTERLEAVED ? (f32x2){hv[k], hv[16 + k]} : (f32x2){hv[2 * k], hv[2 * k + 1]}; }
            for (int grp = 0; grp < 16; ++grp) {
                u32x4 b4[8]; u32x2 b2[8];
#pragma unroll
                for (int r = 0; r < 8; ++r) { const int e = __builtin_amdgcn_readfirstlane(idxs[tl * 128 + grp * 8 + r]);
                    const unsigned char* rp = UT + (size_t)e * 1536; b4[r] = *(const u32x4*)(rp + 16 * lane); b2[r] = *(const u32x2*)(rp + 1024 + 8 * lane); }
                float pt[8];
#pragma unroll
                for (int r = 0; r < 8; ++r) { const u32x6 p6 = {b4[r].x, b4[r].y, b4[r].z, b4[r].w, b2[r].x, b2[r].y};
                    const f32x32 uv = __builtin_amdgcn_cvt_scalef32_pk32_f32_fp6(p6, 1.0f); f32x2 s = {0.f, 0.f};
#pragma unroll
                    for (int k = 0; k < 16; ++k) s = (f32x2){uv[2 * k], uv[2 * k + 1]} * ha[k] + s;
                    pt[r] = s.x + s.y; }
                const bool h5 = lane & 32, h4 = lane & 16, h3 = lane & 8; float w4[4], w2[2], w1;
#pragma unroll
                for (int k = 0; k < 4; ++k) { const float keep = h5 ? pt[k + 4] : pt[k], send = h5 ? pt[k] : pt[k + 4]; w4[k] = keep + __shfl_xor(send, 32); }
#pragma unroll
                for (int k = 0; k < 2; ++k) { const float keep = h4 ? w4[k + 2] : w4[k], send = h4 ? w4[k] : w4[k + 2]; w2[k] = keep + __shfl_xor(send, 16); }
                { const float keep = h3 ? w2[1] : w2[0], send = h3 ? w2[0] : w2[1]; w1 = keep + __shfl_xor(send, 8); }
                w1 += __shfl_xor(w1, 4); w1 += __shfl_xor(w1, 2); w1 += __shfl_xor(w1, 1);
                if ((lane & 7) == 0) dotb[grp * 8 + ((lane >> 5) & 1) * 4 + ((lane >> 4) & 1) * 2 + ((lane >> 3) & 1)] = w1;
            }
            LDS_WAIT();
            { const float d0 = dotb[lane] * (1.0f / PEER_SU), d1 = dotb[lane + 64] * (1.0f / PEER_SU);
              const float a0 = gates[tl * 128 + lane] * gelu_tanh(d0) * (1.0f / PEER_SV), a1 = gates[tl * 128 + lane + 64] * gelu_tanh(d1) * (1.0f / PEER_SV);
              LDS_WAIT(); dotb[lane] = a0; dotb[lane + 64] = a1; }
            LDS_WAIT();
#pragma unroll
            for (int i = 0; i < 16; ++i) ha[i] = (f32x2){0.f, 0.f};
            for (int grp = 0; grp < 16; ++grp) {
                u32x4 b4[8]; u32x2 b2[8];
#pragma unroll
                for (int r = 0; r < 8; ++r) { const int e = __builtin_amdgcn_readfirstlane(idxs[tl * 128 + grp * 8 + r]);
                    const unsigned char* rp = VTb + (size_t)e * 1536; b4[r] = *(const u32x4*)(rp + 16 * lane); b2[r] = *(const u32x2*)(rp + 1024 + 8 * lane); }
#pragma unroll
                for (int r = 0; r < 8; ++r) { const float ar = dotb[grp * 8 + r]; const f32x2 a2 = {ar, ar};
                    const u32x6 p6 = {b4[r].x, b4[r].y, b4[r].z, b4[r].w, b2[r].x, b2[r].y};
                    const f32x32 vv = __builtin_amdgcn_cvt_scalef32_pk32_f32_fp6(p6, 1.0f);
#pragma unroll
                    for (int k = 0; k < 16; ++k) ha[k] = (f32x2){vv[2 * k], vv[2 * k + 1]} * a2 + ha[k]; }
            }
            { const int b = token >> 13; const float* gt2 = mod + (size_t)b * 12288 + 10240 + 32 * lane; float* orow = OUT + (size_t)token * 2048 + 32 * lane;
              float av[32];
#pragma unroll
              for (int k = 0; k < 16; ++k) { if (FP6_INTERLEAVED) { av[k] = ha[k].x; av[16 + k] = ha[k].y; } else { av[2 * k] = ha[k].x; av[2 * k + 1] = ha[k].y; } }
#pragma unroll
              for (int q = 0; q < 8; ++q) { const f32x4 x0 = *(const f32x4*)(orow + 4 * q), g0 = *(const f32x4*)(gt2 + 4 * q); f32x4 o;
#pragma unroll
                  for (int e = 0; e < 4; ++e) o[e] = x0[e] + g0[e] * av[4 * q + e];
                  *(f32x4*)(orow + 4 * q) = o; } }
            LDS_WAIT();
        }
    }
}

__global__ void __launch_bounds__(512, 2) mk_fwd(Args args) {
    extern __shared__ __attribute__((aligned(16))) unsigned char lds_raw[];
    LAS unsigned char* lds = (LAS unsigned char*)lds_raw;
    const int tid = threadIdx.x, lane = tid & 63, wave = __builtin_amdgcn_readfirstlane(tid >> 6);
    const int G = gridDim.x, gw = blockIdx.x * 8 + wave, ngw = G * 8;
    unsigned char* ws = args.ws;
    volatile LAS unsigned* misc = (volatile LAS unsigned*)(lds + LDS_MAIN);
    if (tid < 4) misc[tid] = 0u;
    __syncthreads();
    const int lo = args.ph_lo, hi = args.ph_hi;
    XcdBarrier bar; bar.bar = (unsigned*)(ws + WS_CTL); bar.x = 0; bar.st = misc;
    if (hi - lo > 1) bar = xcd_barrier_post((unsigned*)(ws + WS_CTL), misc);
#ifndef PHMASK
#define PHMASK 0x7ff
#endif
#define IN(k) (((PHMASK >> (k)) & 1) && lo <= (k) && (k) < hi)
#define SEAM(k) do { if (IN(k) && IN((k) + 1)) xcd_barrier(bar); } while (0)
    float* mod = (float*)(ws + WS_MOD);
    bf16_t* HB = (bf16_t*)(ws + WS_H); bf16_t* PA = (bf16_t*)(ws + WS_PA); bf16_t* PG = (bf16_t*)(ws + WS_PG);
    bf16_t* YA = (bf16_t*)(ws + WS_YA); bf16_t* ATT = (bf16_t*)(ws + WS_ATT); f32x2* EB = (f32x2*)(ws + WS_E); bf16_t* UBp = (bf16_t*)(ws + WS_UB);

#define PHS(code, ...) do { __VA_ARGS__ if (DUP == (code)) { xcd_barrier(bar); __VA_ARGS__ } } while (0)
#define PH(k, ...) do { if (IN(k)) { __VA_ARGS__ if (DUP == (k)) { xcd_barrier(bar); __VA_ARGS__ } } } while (0)
    PH(0, { ph_mod_partial(args.in[I_C], args.in[I_WADA], (float*)(ws + WS_MODP), gw, ngw, lane); });
    SEAM(0);
    PH(1, { ph_prologue(args, lds, gw, ngw, lane, wave); });
    SEAM(1);
    PH(2, { ph_norm(args.in[I_X], HB, args.in[I_N1G], mod, 0, 2048, gw, ngw, lane); });
    SEAM(2);
    PH(3, { pg8::Gemm g{HB, (const bf16_t*)(ws + WS_WIN), T_TOK, 8192, 2048}; pg8::StaticOrder S; S.init(T_TOK, 8192, G, (int)blockIdx.x);
        pg8::EpiProj E{PA, PG, UBp}; pg8::gemm_phase<pg8::EpiProj, pg8::StaticOrder, true, true>(lds, g, S, E); });
    SEAM(3);
    PH(4, { PHS(41, { ph_attn(lds, PA, ATT, args.in[I_QNG], args.in[I_KNG], G); __syncthreads(); }); PHS(42, { ph_ssm_mfma<false>(args, lds, UBp, EB, YA, G); }); });
    SEAM(4);
    PH(5, { PHS(51, { ph_ssm_mfma<true>(args, lds, UBp, EB, YA, G); __syncthreads(); });
        PHS(52, { pg8::Gemm g{ATT, (const bf16_t*)(ws + WS_WATT), T_TOK, 2048, 1024}; pg8::StaticOrder S; S.init(T_TOK, 2048, G, (int)blockIdx.x);
        pg8::EpiAttUp E{PG, HB}; pg8::gemm_phase<pg8::EpiAttUp, pg8::StaticOrder, true, true>(lds, g, S, E); }); });
    SEAM(5);
    PH(6, { pg8::Gemm g{YA, (const bf16_t*)(ws + WS_WGLU), T_TOK, 4096, 1024}; pg8::StaticOrder S; S.init(T_TOK, 4096, G, (int)blockIdx.x);
        pg8::EpiGlu E{PG, HB}; pg8::gemm_phase<pg8::EpiGlu, pg8::StaticOrder, true, true>(lds, g, S, E); });
    SEAM(6);
    PH(7, { pg8::Gemm g{HB, (const bf16_t*)(ws + WS_WOUT), T_TOK, 2048, 2048}; pg8::StaticOrder S; S.init(T_TOK, 2048, G, (int)blockIdx.x);
        pg8::EpiOut E{args.in[I_X], args.out, mod}; pg8::gemm_phase<pg8::EpiOut, pg8::StaticOrder, true, true>(lds, g, S, E);
        ph_table_cvt(args.in[I_PU], args.in[I_PV], ws + WS_UT, ws + WS_VT, gw, ngw, lane); });
    SEAM(7);
    PH(8, { ph_norm(args.out, HB, args.in[I_N2G], mod, 6144, 8192, gw, ngw, lane); });
    SEAM(8);
    PH(9, { pg8::Gemm g{HB, (const bf16_t*)(ws + WS_WSC), T_TOK, 2048, 2048}; pg8::StaticOrder S; S.init(T_TOK, 2048, G, (int)blockIdx.x);
        pg8::EpiF32 E{(float*)(ws + WS_SC)}; pg8::gemm_phase<pg8::EpiF32, pg8::StaticOrder, true, true>(lds, g, S, E); });
    SEAM(9);
    PH(10, { ph_peer(lds, (const float*)(ws + WS_SC), HB, ws + WS_UT, ws + WS_VT, mod, args.out, G); });
#undef IN
#undef SEAM
}

extern "C" void kernel_launch(void* const* d_in, const int* in_sizes, int n_in, void* d_out, int out_size, void* d_ws, size_t ws_size, hipStream_t stream) {
    static int grid = 0;
    if (grid == 0) {
        if (n_in != 25 || out_size != T_TOK * DM || ws_size < WS_END) { fprintf(stderr, "kernel_launch: unexpected shapes (n_in %d out %d ws %zu need %zu)\n", n_in, out_size, ws_size, (size_t)WS_END); grid = -1; return; }
        int dev = 0, cus = 0, per_cu = 0;
        if (hipGetDevice(&dev) != hipSuccess || hipDeviceGetAttribute(&cus, hipDeviceAttributeMultiprocessorCount, dev) != hipSuccess) { grid = -1; return; }
        if (hipFuncSetAttribute((const void*)mk_fwd, hipFuncAttributeMaxDynamicSharedMemorySize, LDS_BYTES) != hipSuccess) { fprintf(stderr, "kernel_launch: hipFuncSetAttribute failed\n"); grid = -1; return; }
        if (hipOccupancyMaxActiveBlocksPerMultiprocessor(&per_cu, (const void*)mk_fwd, 512, LDS_BYTES) != hipSuccess || per_cu < 1) { fprintf(stderr, "kernel_launch: occupancy query says %d blocks/CU\n", per_cu); (void)hipGetLastError(); grid = -1; return; }
        grid = cus;
    }
    if (grid < 0) return;
    (void)hipMemsetAsync((char*)d_ws + WS_CTL, 0, 16384, stream);
    Args a{};
    for (int i = 0; i < 25; ++i) a.in[i] = (const float*)d_in[i];
    a.out = (float*)d_out; a.ws = (unsigned char*)d_ws;
#if MK_PER_PHASE
    for (int ph = 0; ph < NPHASE; ++ph) { a.ph_lo = ph; a.ph_hi = ph + 1; hipLaunchKernelGGL(mk_fwd, dim3(grid), dim3(512), LDS_BYTES, stream, a); }
#else
    a.ph_lo = 0; a.ph_hi = NPHASE;
    hipLaunchKernelGGL(mk_fwd, dim3(grid), dim3(512), LDS_BYTES, stream, a);
#endif
}
```

```cpp
#include <hip/hip_runtime.h>
#include <cstdio>
#include <cstdint>

#ifndef MK_PER_PHASE
#define MK_PER_PHASE 0
#endif

#ifndef DUP
#define DUP -1
#endif
#define LAS __attribute__((address_space(3)))
typedef unsigned short bf16_t;
typedef short bf16x8 __attribute__((ext_vector_type(8)));
typedef float f32x4 __attribute__((ext_vector_type(4)));
typedef float f32x2 __attribute__((ext_vector_type(2)));
typedef unsigned u32x4 __attribute__((ext_vector_type(4)));
typedef unsigned u32x2 __attribute__((ext_vector_type(2)));
typedef int i32x4 __attribute__((ext_vector_type(4)));

constexpr int T_TOK = 16384, DM = 2048, SEQ = 8192;
constexpr int NPHASE = 11;
constexpr float EPS = 1e-6f;

constexpr size_t WS_CTL   = 0;
constexpr size_t WS_MODP  = 65536;
constexpr size_t WS_MOD   = WS_MODP + (size_t)32 * 2 * 12288 * 4;
constexpr size_t WS_WIN   = WS_MOD + (size_t)2 * 12288 * 4;
constexpr size_t WS_WGLU  = WS_WIN + (size_t)8192 * 2048 * 2;
constexpr size_t WS_WATT  = WS_WGLU + (size_t)4096 * 1024 * 2;
constexpr size_t WS_WOUT  = WS_WATT + (size_t)2048 * 1024 * 2;
constexpr size_t WS_WSC   = WS_WOUT + (size_t)2048 * 2048 * 2;
constexpr size_t WS_H     = WS_WSC + (size_t)2048 * 2048 * 2;
constexpr size_t WS_PA    = WS_H + (size_t)T_TOK * 2048 * 2;
constexpr size_t WS_PG    = WS_PA + (size_t)T_TOK * 4096 * 2;
constexpr size_t WS_E     = WS_PG + (size_t)T_TOK * 4096 * 2;
constexpr size_t WS_YA    = WS_E + (size_t)2 * 64 * 128 * 64 * 8;
constexpr size_t WS_ATT   = WS_YA + (size_t)T_TOK * 1024 * 2;
constexpr size_t WS_UB    = WS_ATT + (size_t)T_TOK * 1024 * 2;
constexpr size_t WS_SA    = WS_UB + (size_t)T_TOK * 1024 * 2;
constexpr size_t WS_SB    = WS_SA + (size_t)T_TOK * 4;
constexpr size_t WS_CMAXP = WS_SB + (size_t)8192 * 4;
constexpr size_t WS_END   = WS_CMAXP + (size_t)32 * 8192 * 4;
constexpr size_t WS_SC    = WS_PA;
constexpr size_t WS_UT    = WS_PG;
constexpr size_t WS_VT    = WS_PG + (size_t)16384 * 1536;

constexpr int LDS_MAIN = 131072, LDS_BYTES = LDS_MAIN + 256;

typedef __bf16 bf16x2_t __attribute__((ext_vector_type(2)));
__device__ __forceinline__ unsigned cvt_pk_bf16(float lo, float hi) { const f32x2 v = {lo, hi}; return __builtin_bit_cast(unsigned, __builtin_convertvector(v, bf16x2_t)); }
__device__ __forceinline__ float bf_lo(unsigned w) { return __uint_as_float(w << 16); }
__device__ __forceinline__ float bf_hi(unsigned w) { return __uint_as_float(w & 0xffff0000u); }
__device__ __forceinline__ float wave_sum(float v) {
#pragma unroll
    for (int o = 1; o < 64; o <<= 1) v += __shfl_xor(v, o);
    return v;
}
__device__ __forceinline__ float sigmoidf_(float x) { return 1.0f / (1.0f + __expf(-x)); }
__device__ __forceinline__ float gelu_tanh(float x) {
    const float a = 0.7978845608028654f * (x + 0.044715f * x * x * x);
    const float t = 1.0f - 2.0f / (__expf(2.0f * a) + 1.0f);
    return 0.5f * x * (1.0f + t);
}
#define LDS_WAIT() asm volatile("s_waitcnt lgkmcnt(0)" ::: "memory")
__device__ __forceinline__ int opaque_tid() { int t = threadIdx.x; asm volatile("" : "+v"(t)); return t; }

#define XB_TMO      128
#define XB_XCNT(j)  (256  + 64 * (j))
#define XB_XSUB(j)  (1280 + 64 * (j))
#define XB_XGEN(j)  (2304 + 64 * (j))
#define XB_TOP      3328
#define XB_TOPGEN   3392
#define XCD_BAR_WORDS 3456
#define XB_SPIN_CAP (1u << 22)
__device__ __forceinline__ unsigned xb_ld(unsigned* p)              { return __hip_atomic_load(p, __ATOMIC_RELAXED, __HIP_MEMORY_SCOPE_AGENT); }
__device__ __forceinline__ unsigned xb_add(unsigned* p, unsigned v) { return __hip_atomic_fetch_add(p, v, __ATOMIC_RELAXED, __HIP_MEMORY_SCOPE_AGENT); }
__device__ __forceinline__ unsigned xb_xcc_id() { return (unsigned)__builtin_amdgcn_s_getreg((3 << 11) | 20) & 0xFu; }
#define XB_SPIN(cond, bar) do { unsigned _sp = 0; while (cond) { __builtin_amdgcn_s_sleep(1); \
    if ((++_sp & 255u) == 0u) { if (xb_ld(&(bar)[XB_TMO])) break; if (_sp > XB_SPIN_CAP) { atomicAdd(&(bar)[XB_TMO], 1u); break; } } } } while (0)
struct XcdBarrier { unsigned* bar; unsigned x; volatile LAS unsigned* st; };
__device__ __forceinline__ XcdBarrier xcd_barrier_post(unsigned* bar, volatile LAS unsigned* st) {
    XcdBarrier b; b.bar = bar; b.x = xb_xcc_id(); b.st = st;
    if (threadIdx.x == 0) (void)xb_add(&bar[XB_XCNT(b.x)], 1u);
    return b;
}
__device__ __forceinline__ void xcd_barrier_complete(unsigned* bar, unsigned x, unsigned& nloc, unsigned& nx) {
    const unsigned G = gridDim.x * gridDim.y * gridDim.z;
    unsigned sum, cnt, mine, sp = 0u;
    for (;;) {
        sum = 0u; cnt = 0u; mine = 0u;
#pragma unroll
        for (unsigned j = 0; j < 16; ++j) { const unsigned c = xb_ld(&bar[XB_XCNT(j)]); sum += c; cnt += (c > 0u) ? 1u : 0u; mine = (j == x) ? c : mine; }
        if (sum == G) break;
        __builtin_amdgcn_s_sleep(1);
        if ((++sp & 255u) == 0u) { if (xb_ld(&bar[XB_TMO])) break; if (sp > XB_SPIN_CAP) { atomicAdd(&bar[XB_TMO], 1u); break; } }
    }
    nloc = mine > 0u ? mine : 1u; nx = cnt > 0u ? cnt : 1u;
}
__device__ __forceinline__ void xcd_barrier(const XcdBarrier& b) {
    asm volatile("s_waitcnt vmcnt(0)" ::: "memory");
    __syncthreads();
    if (threadIdx.x == 0) {
        unsigned* bar = b.bar;
        __builtin_amdgcn_s_waitcnt(0);
        unsigned nloc = b.st[0], nx = b.st[1];
        if (nloc == 0u) { xcd_barrier_complete(bar, b.x, nloc, nx); b.st[0] = nloc; b.st[1] = nx; }
        const unsigned old = xb_add(&bar[XB_XSUB(b.x)], 1u);
        const unsigned gen = old / nloc;
        if (old + 1u == (gen + 1u) * nloc) {
            __builtin_amdgcn_fence(__ATOMIC_RELEASE, "agent");
            asm volatile("s_waitcnt vmcnt(0)" ::: "memory");
            const unsigned og = xb_add(&bar[XB_TOP], 1u);
            const unsigned tg = og / nx;
            if (og + 1u == (tg + 1u) * nx) xb_add(&bar[XB_TOPGEN], 1u);
            else XB_SPIN(xb_ld(&bar[XB_TOPGEN]) == tg, bar);
            __builtin_amdgcn_fence(__ATOMIC_ACQUIRE, "agent");
            xb_add(&bar[XB_XGEN(b.x)], 1u);
            asm volatile("s_waitcnt vmcnt(0)" ::: "memory");
        } else {
            XB_SPIN(xb_ld(&bar[XB_XGEN(b.x)]) == gen, bar);
            __builtin_amdgcn_fence(__ATOMIC_ACQUIRE, "agent");
            asm volatile("s_waitcnt vmcnt(0)" ::: "memory");
        }
    }
    __syncthreads();
}

namespace pg8 {
constexpr int BM = 256, BK = 64, HALF = 128, HTB = HALF * BK * 2, STAGE_BYTES = 8 * HTB, NXCD = 8, WGM = 8;
__host__ __device__ __forceinline__ int lds_byte(int r, int c) { const int st = (r >> 4) * 2 + (c >> 5), rr = r & 15, cc = c & 31, ob = rr * 64 + cc * 2; return st * 1024 + (ob ^ (((ob >> 9) & 1) << 5)); }
__host__ __device__ __forceinline__ void stage_rc(int b, int& R, int& C) { const int st = b / 1024, sb = b % 1024, swz = sb ^ (((sb >> 9) & 1) << 5); R = (st >> 1) * 16 + swz / 64; C = (st & 1) * 32 + (swz % 64) / 2; }
__host__ __device__ __forceinline__ int perm32(int rho) { const int n = rho >> 4, i = rho & 15; return 8 * (i >> 2) + 4 * n + (i & 3); }
struct Unit { int pm, pn; };
struct Gemm { const bf16_t* A; const bf16_t* Bt; int M, N, K; };
struct StaticOrder {
    int nM, nN, nwg, G, c;
    __host__ __device__ void init(int M, int N, int G_, int c_) { nM = M / BM; nN = N / BM; nwg = nM * nN; G = G_; c = c_; }
    __host__ __device__ bool next(int i, Unit& u) const { return at((long)i * G + c, u); }
    __host__ __device__ bool at(long L, Unit& u) const {
        if (L >= nwg) return false;
        int wgid = (int)L; { const int q = nwg / NXCD, r = nwg % NXCD, xcd = wgid % NXCD, off = wgid / NXCD; wgid = (xcd < r ? xcd * (q + 1) : r * (q + 1) + (xcd - r) * q) + off; }
        const int nig = WGM * nN, gid = wgid / nig, fm = gid * WGM, gsz = (nM - fm) < WGM ? (nM - fm) : WGM;
        u.pm = fm + ((wgid % nig) % gsz); u.pn = (wgid % nig) / gsz; return true;
    }
    __device__ __forceinline__ void a_ready(const Unit&) const {}
    __device__ __forceinline__ void done(const Unit&) const {}
};
struct SplitOrder {
    StaticOrder b;
    __host__ __device__ void init(int M, int N, int G_, int c_) { b.init(M, N, G_, c_); }
    __host__ __device__ bool next(int i, Unit& u) const {
        if (b.G != 256 || b.nwg != 512) return b.next(i, u);
        if (b.c < 128) return i < 1 ? b.at(b.c, u) : false;
        return i < 3 ? b.at(128 + (b.c - 128) * 3 + i, u) : false;
    }
    __device__ __forceinline__ void a_ready(const Unit&) const {}
    __device__ __forceinline__ void done(const Unit&) const {}
};
template <class Epi, class Sched, bool ALIGN_EPI = false, bool SP2 = false, bool I8 = false>
__device__ __forceinline__ void gemm_phase(LAS unsigned char* lds, const Gemm g, const Sched& S, const Epi& E) {
    const int tid = opaque_tid(), wid = __builtin_amdgcn_readfirstlane(tid >> 6), lane = tid & 63, wr = wid >> 2, wc = wid & 3, fr = lane & 15, fq = lane >> 4;
    const int K = g.K, nt = K / BK;
    unsigned voffA[2], voffB[2];
#pragma unroll
    for (int i = 0; i < 2; ++i) { int R, C; stage_rc(tid * 16 + i * 8192, R, C); const int Rb = Epi::PERM ? ((R & ~31) + perm32(R & 31)) : R;
        voffA[i] = (unsigned)(R * K + C) * 2u; voffB[i] = (unsigned)(Rb * K + C) * 2u; }
    const size_t kstep = (size_t)(BK * 2);
    const size_t hstep = (size_t)HALF * K * 2;
    const size_t tstep = 2 * hstep;
    const unsigned ldsw = (unsigned)wid * 1024u;
    const int aoff = lds_byte(wr * 64 + fr, fq * 8), boff = lds_byte(wc * 32 + fr, fq * 8);
#define PG8_SA(b, h) (((b) * 2 + (h)) * HTB)
#define PG8_SB(b, h) ((4 + (b) * 2 + (h)) * HTB)
#define PG8_STAGE(bufoff, gbase, voff) do { _Pragma("unroll") for (int _i = 0; _i < 2; ++_i) \
        __builtin_amdgcn_global_load_lds((const unsigned*)((const char*)(gbase) + (voff)[_i]), (LAS unsigned*)(lds + (bufoff) + ldsw + _i * 8192), 16, 0, 0); } while (0)
#define PG8_LDA(dst, b, h) do { _Pragma("unroll") for (int m = 0; m < 4; ++m) _Pragma("unroll") for (int k = 0; k < 2; ++k) dst[m][k] = *(const LAS bf16x8*)(lds + PG8_SA(b, h) + aoff + m * 2048 + k * 1024); } while (0)
#define PG8_LDB(dst, b, h) do { _Pragma("unroll") for (int n = 0; n < 2; ++n) _Pragma("unroll") for (int k = 0; k < 2; ++k) dst[n][k] = *(const LAS bf16x8*)(lds + PG8_SB(b, h) + boff + n * 2048 + k * 1024); } while (0)
#define PG8_MMA(ai, bj, At, Bt) do { __builtin_amdgcn_s_setprio(1); _Pragma("unroll") for (int m = 0; m < 4; ++m) _Pragma("unroll") for (int n = 0; n < 2; ++n) _Pragma("unroll") for (int k = 0; k < 2; ++k) \
        acc[ai][bj][m][n] = I8 ? __builtin_bit_cast(f32x4, __builtin_amdgcn_mfma_i32_16x16x64_i8(__builtin_bit_cast(i32x4, Bt[n][k]), __builtin_bit_cast(i32x4, At[m][k]), __builtin_bit_cast(i32x4, acc[ai][bj][m][n]), 0, 0, 0)) \
                                      : __builtin_amdgcn_mfma_f32_16x16x32_bf16(Bt[n][k], At[m][k], acc[ai][bj][m][n], 0, 0, 0); __builtin_amdgcn_s_setprio(0); } while (0)
#define PG8_WAIT_V(n) asm volatile("s_waitcnt vmcnt(" #n ")" ::: "memory")
#define PG8_WAIT_L(n) asm volatile("s_waitcnt lgkmcnt(" #n ")" ::: "memory")
#define PG8_BAR __builtin_amdgcn_s_barrier()
#define PG8_SCHED __builtin_amdgcn_sched_barrier(0)
    Unit cur, nxt; int ui = 0;
    if (!S.next(0, cur)) return;
    f32x4 acc[2][2][4][2];
#pragma unroll
    for (int a = 0; a < 2; ++a)
#pragma unroll
        for (int b = 0; b < 2; ++b)
#pragma unroll
            for (int m = 0; m < 4; ++m)
#pragma unroll
                for (int n = 0; n < 2; ++n) acc[a][b][m][n] = (f32x4){0.f, 0.f, 0.f, 0.f};
    bf16x8 At[4][2], B0[2][2], B1[2][2];
    const char* cA = (const char*)g.A + (size_t)cur.pm * tstep; const char* cB = (const char*)g.Bt + (size_t)cur.pn * tstep;
    S.a_ready(cur);
    if constexpr (SP2) {
        PG8_STAGE(PG8_SB(0, 0), cB, voffB); PG8_STAGE(PG8_SB(0, 1), cB + hstep, voffB); PG8_STAGE(PG8_SA(0, 0), cA, voffA); PG8_STAGE(PG8_SA(0, 1), cA + hstep, voffA);
        if (wr == 1) PG8_BAR;
        PG8_WAIT_V(2); PG8_BAR;
        PG8_STAGE(PG8_SB(1, 0), cB + kstep, voffB); PG8_STAGE(PG8_SA(1, 0), cA + kstep, voffA); PG8_STAGE(PG8_SB(1, 1), cB + hstep + kstep, voffB);
        PG8_WAIT_V(6); PG8_BAR;
    } else {
        PG8_STAGE(PG8_SB(0, 0), cB, voffB); PG8_STAGE(PG8_SA(0, 0), cA, voffA); PG8_STAGE(PG8_SB(0, 1), cB + hstep, voffB); PG8_STAGE(PG8_SA(0, 1), cA + hstep, voffA);
        if (wr == 1) PG8_BAR;
        PG8_WAIT_V(4); PG8_BAR;
        PG8_STAGE(PG8_SB(1, 0), cB + kstep, voffB); PG8_STAGE(PG8_SA(1, 0), cA + kstep, voffA); PG8_STAGE(PG8_SB(1, 1), cB + hstep + kstep, voffB);
        PG8_WAIT_V(6); PG8_BAR;
    }
    for (;;) {
        const bool has_next = S.next(ui + 1, nxt);
        const char* nA = has_next ? (const char*)g.A + (size_t)nxt.pm * tstep : cA; const char* nB = has_next ? (const char*)g.Bt + (size_t)nxt.pn * tstep : cB;
        for (int t = 0; t < nt; t += 2) {
            const bool last = (t == nt - 2);
            const char* a1 = cA + (size_t)(t + 1) * kstep;
            const char* a2 = last ? nA : cA + (size_t)(t + 2) * kstep; const char* b2 = last ? nB : cB + (size_t)(t + 2) * kstep;
            const char* a3 = a2 + kstep; const char* b3 = b2 + kstep;
            if (last && has_next) S.a_ready(nxt);
            if constexpr (SP2) {
            PG8_LDB(B0, 0, 0); PG8_LDB(B1, 0, 1); PG8_SCHED; PG8_LDA(At, 0, 0); PG8_STAGE(PG8_SA(1, 1), a1 + hstep, voffA);
            PG8_WAIT_V(8); PG8_WAIT_L(0); PG8_BAR; PG8_MMA(0, 0, At, B0); PG8_MMA(0, 1, At, B1); PG8_BAR; PG8_SCHED;
            PG8_LDA(At, 0, 1); PG8_STAGE(PG8_SB(0, 0), b2, voffB); PG8_STAGE(PG8_SB(0, 1), b2 + hstep, voffB); PG8_STAGE(PG8_SA(0, 0), a2, voffA);
            PG8_WAIT_V(8); PG8_WAIT_L(0); PG8_BAR; PG8_MMA(1, 0, At, B0); PG8_MMA(1, 1, At, B1); PG8_BAR; PG8_SCHED;
            PG8_LDB(B0, 1, 0); PG8_LDB(B1, 1, 1); PG8_SCHED; PG8_LDA(At, 1, 0); PG8_STAGE(PG8_SA(0, 1), a2 + hstep, voffA);
            PG8_WAIT_V(8); PG8_WAIT_L(0); PG8_BAR; PG8_MMA(0, 0, At, B0); PG8_MMA(0, 1, At, B1); PG8_BAR; PG8_SCHED;
            PG8_LDA(At, 1, 1); PG8_STAGE(PG8_SB(1, 0), b3, voffB); PG8_STAGE(PG8_SB(1, 1), b3 + hstep, voffB); PG8_STAGE(PG8_SA(1, 0), a3, voffA);
            PG8_WAIT_V(8); PG8_WAIT_L(0); PG8_BAR; PG8_MMA(1, 0, At, B0); PG8_MMA(1, 1, At, B1); PG8_BAR; PG8_SCHED;
            } else {
            PG8_LDB(B0, 0, 0); PG8_SCHED; PG8_LDA(At, 0, 0); PG8_STAGE(PG8_SA(1, 1), a1 + hstep, voffA);
            PG8_WAIT_L(8); PG8_BAR; PG8_WAIT_L(0); PG8_MMA(0, 0, At, B0); PG8_BAR; PG8_SCHED;
            PG8_LDB(B1, 0, 1); PG8_STAGE(PG8_SB(0, 0), b2, voffB);
            PG8_BAR; PG8_WAIT_L(0); PG8_MMA(0, 1, At, B1); PG8_BAR;
            PG8_LDA(At, 0, 1); PG8_STAGE(PG8_SA(0, 0), a2, voffA);
            PG8_BAR; PG8_WAIT_L(0); PG8_MMA(1, 0, At, B0); PG8_BAR; PG8_SCHED;
            PG8_STAGE(PG8_SB(0, 1), b2 + hstep, voffB);
            PG8_WAIT_V(6); PG8_BAR; PG8_MMA(1, 1, At, B1); PG8_BAR;
            PG8_LDB(B0, 1, 0); PG8_SCHED; PG8_LDA(At, 1, 0); PG8_STAGE(PG8_SA(0, 1), a2 + hstep, voffA);
            PG8_WAIT_L(8); PG8_BAR; PG8_WAIT_L(0); PG8_MMA(0, 0, At, B0); PG8_BAR; PG8_SCHED;
            PG8_LDB(B1, 1, 1); PG8_STAGE(PG8_SB(1, 0), b3, voffB);
            PG8_BAR; PG8_WAIT_L(0); PG8_MMA(0, 1, At, B1); PG8_BAR;
            PG8_LDA(At, 1, 1); PG8_STAGE(PG8_SA(1, 0), a3, voffA);
            PG8_BAR; PG8_WAIT_L(0); PG8_MMA(1, 0, At, B0); PG8_BAR; PG8_SCHED;
            PG8_STAGE(PG8_SB(1, 1), b3 + hstep, voffB);
            PG8_WAIT_V(6); PG8_BAR; PG8_MMA(1, 1, At, B1); PG8_BAR;
            }
        }
        if constexpr (ALIGN_EPI) { if (wr == 0) PG8_BAR; }
        E(acc, cur, wr, wc, fr, fq); S.done(cur);
        if (!has_next) break;
#pragma unroll
        for (int a = 0; a < 2; ++a)
#pragma unroll
            for (int b = 0; b < 2; ++b)
#pragma unroll
                for (int m = 0; m < 4; ++m)
#pragma unroll
                    for (int n = 0; n < 2; ++n) acc[a][b][m][n] = (f32x4){0.f, 0.f, 0.f, 0.f};
        cur = nxt; cA = nA; cB = nB; ++ui;
        if constexpr (ALIGN_EPI) { if (wr == 1) PG8_BAR; }
    }
    PG8_WAIT_V(0);
    if constexpr (!ALIGN_EPI) { if (wr == 0) PG8_BAR; }
    PG8_BAR;
#undef PG8_SA
#undef PG8_SB
#undef PG8_STAGE
#undef PG8_LDA
#undef PG8_LDB
#undef PG8_MMA
#undef PG8_WAIT_V
#undef PG8_WAIT_L
#undef PG8_BAR
#undef PG8_SCHED
}

struct EpiProj {
    static constexpr bool PERM = true;
    bf16_t* PA; bf16_t* PG; bf16_t* UB; const float* SA; const float* SB;
    __device__ __forceinline__ void operator()(const f32x4 (&acc)[2][2][4][2], const Unit& u, int wr, int wc, int fr, int fq) const {
        const int row0 = u.pm * BM + wr * 64 + fr; int colt = u.pn * BM; const bool isu = colt < 1024; bf16_t* base = colt < 4096 ? PA : PG;
        const int gcol0 = colt + wc * 32 + 8 * fq; colt &= 4095;
        const int col0 = colt + wc * 32 + 8 * fq;
        f32x4 sb[2][2];
#pragma unroll
        for (int bj = 0; bj < 2; ++bj) { sb[bj][0] = *(const f32x4*)(SB + gcol0 + bj * HALF); sb[bj][1] = *(const f32x4*)(SB + gcol0 + bj * HALF + 4); }
#pragma unroll
        for (int ai = 0; ai < 2; ++ai)
#pragma unroll
            for (int m = 0; m < 4; ++m) { const int row = row0 + ai * HALF + m * 16; bf16_t* rowp = base + (size_t)row * 4096 + col0; const float sa = SA[row];
#pragma unroll
                for (int bj = 0; bj < 2; ++bj) { const i32x4 i0 = __builtin_bit_cast(i32x4, acc[ai][bj][m][0]), i1 = __builtin_bit_cast(i32x4, acc[ai][bj][m][1]);
                    f32x4 v0, v1;
#pragma unroll
                    for (int e = 0; e < 4; ++e) { v0[e] = (float)i0[e] * sa * sb[bj][0][e]; v1[e] = (float)i1[e] * sa * sb[bj][1][e]; }
                    u32x4 w; w.x = cvt_pk_bf16(v0[0], v0[1]); w.y = cvt_pk_bf16(v0[2], v0[3]); w.z = cvt_pk_bf16(v1[0], v1[1]); w.w = cvt_pk_bf16(v1[2], v1[3]);
                    if (isu) { const int cu = col0 + bj * HALF; *(u32x4*)(UB + (((size_t)((row >> 13) * 64 + (cu >> 4)) * 8192 + (row & 8191)) * 16 + (cu & 8))) = w; }
                    else *(u32x4*)(rowp + bj * HALF) = w; } }
    }
};
struct EpiAttUp {
    static constexpr bool PERM = true;
    const bf16_t* PG; bf16_t* HB;
    __device__ __forceinline__ void operator()(const f32x4 (&acc)[2][2][4][2], const Unit& u, int wr, int wc, int fr, int fq) const {
        const int row0 = u.pm * BM + wr * 64 + fr; const int col0 = u.pn * BM + wc * 32 + 8 * fq;
#pragma unroll
        for (int ai = 0; ai < 2; ++ai)
#pragma unroll
            for (int m = 0; m < 4; ++m) { const size_t row = (size_t)(row0 + ai * HALF + m * 16);
#pragma unroll
                for (int bj = 0; bj < 2; ++bj) { const int col = col0 + bj * HALF;
                    const u32x4 gw = *(const u32x4*)(PG + row * 4096 + 2048 + col);
                    const f32x4 v0 = acc[ai][bj][m][0], v1 = acc[ai][bj][m][1];
                    u32x4 w;
                    w.x = cvt_pk_bf16(v0[0] * sigmoidf_(bf_lo(gw.x)), v0[1] * sigmoidf_(bf_hi(gw.x)));
                    w.y = cvt_pk_bf16(v0[2] * sigmoidf_(bf_lo(gw.y)), v0[3] * sigmoidf_(bf_hi(gw.y)));
                    w.z = cvt_pk_bf16(v1[0] * sigmoidf_(bf_lo(gw.z)), v1[1] * sigmoidf_(bf_hi(gw.z)));
                    w.w = cvt_pk_bf16(v1[2] * sigmoidf_(bf_lo(gw.w)), v1[3] * sigmoidf_(bf_hi(gw.w)));
                    *(u32x4*)(HB + row * 2048 + col) = w; } }
    }
};
struct EpiGlu {
    static constexpr bool PERM = true;
    const bf16_t* PG; bf16_t* HB;
    __device__ __forceinline__ void operator()(const f32x4 (&acc)[2][2][4][2], const Unit& u, int wr, int wc, int fr, int fq) const {
        const int row0 = u.pm * BM + wr * 64 + fr; const int col = u.pn * HALF + wc * 32 + 8 * fq;
#pragma unroll
        for (int ai = 0; ai < 2; ++ai)
#pragma unroll
            for (int m = 0; m < 4; ++m) { const size_t row = (size_t)(row0 + ai * HALF + m * 16);
                const u32x4 gw = *(const u32x4*)(PG + row * 4096 + col);
                const u32x4 aw = *(const u32x4*)(HB + row * 2048 + col);
                const f32x4 a0 = acc[ai][0][m][0], a1 = acc[ai][0][m][1], g0 = acc[ai][1][m][0], g1 = acc[ai][1][m][1];
                u32x4 w;
                w.x = cvt_pk_bf16(sigmoidf_(bf_lo(gw.x)) * a0[0] * sigmoidf_(g0[0]) + bf_lo(aw.x), sigmoidf_(bf_hi(gw.x)) * a0[1] * sigmoidf_(g0[1]) + bf_hi(aw.x));
                w.y = cvt_pk_bf16(sigmoidf_(bf_lo(gw.y)) * a0[2] * sigmoidf_(g0[2]) + bf_lo(aw.y), sigmoidf_(bf_hi(gw.y)) * a0[3] * sigmoidf_(g0[3]) + bf_hi(aw.y));
                w.z = cvt_pk_bf16(sigmoidf_(bf_lo(gw.z)) * a1[0] * sigmoidf_(g1[0]) + bf_lo(aw.z), sigmoidf_(bf_hi(gw.z)) * a1[1] * sigmoidf_(g1[1]) + bf_hi(aw.z));
                w.w = cvt_pk_bf16(sigmoidf_(bf_lo(gw.w)) * a1[2] * sigmoidf_(g1[2]) + bf_lo(aw.w), sigmoidf_(bf_hi(gw.w)) * a1[3] * sigmoidf_(g1[3]) + bf_hi(aw.w));
                *(u32x4*)(HB + row * 2048 + col) = w; }
    }
};
struct EpiOut {
    static constexpr bool PERM = true;
    const float* X; float* O; const float* mod;
    __device__ __forceinline__ void operator()(const f32x4 (&acc)[2][2][4][2], const Unit& u, int wr, int wc, int fr, int fq) const {
        const int row0 = u.pm * BM + wr * 64 + fr; const int col0 = u.pn * BM + wc * 32 + 8 * fq;
        const float* gt = mod + (size_t)((u.pm * BM) >> 13) * 12288 + 4096;
#pragma unroll
        for (int bj = 0; bj < 2; ++bj) { const int col = col0 + bj * HALF;
            const f32x4 g0 = *(const f32x4*)(gt + col), g1 = *(const f32x4*)(gt + col + 4);
#pragma unroll
            for (int ai = 0; ai < 2; ++ai)
#pragma unroll
                for (int m = 0; m < 4; ++m) { const size_t off = (size_t)(row0 + ai * HALF + m * 16) * 2048 + col;
                    const f32x4 x0 = *(const f32x4*)(X + off), x1 = *(const f32x4*)(X + off + 4);
                    *(f32x4*)(O + off) = x0 + g0 * acc[ai][bj][m][0]; *(f32x4*)(O + off + 4) = x1 + g1 * acc[ai][bj][m][1]; } }
    }
};
struct EpiF32 {
    static constexpr bool PERM = true;
    float* O;
    __device__ __forceinline__ void operator()(const f32x4 (&acc)[2][2][4][2], const Unit& u, int wr, int wc, int fr, int fq) const {
        const int row0 = u.pm * BM + wr * 64 + fr; const int col0 = u.pn * BM + wc * 32 + 8 * fq;
#pragma unroll
        for (int ai = 0; ai < 2; ++ai)
#pragma unroll
            for (int m = 0; m < 4; ++m) { float* rowp = O + (size_t)(row0 + ai * HALF + m * 16) * 2048 + col0;
#pragma unroll
                for (int bj = 0; bj < 2; ++bj) { *(f32x4*)(rowp + bj * HALF) = acc[ai][bj][m][0]; *(f32x4*)(rowp + bj * HALF + 4) = acc[ai][bj][m][1]; } }
    }
};
}

struct Args { const float* in[25]; float* out; unsigned char* ws; int ph_lo, ph_hi; };
enum { I_X = 0, I_C, I_WADA, I_BADA, I_N1G, I_WIN, I_LRE, I_LIM, I_LDT, I_BRE, I_BIM, I_CRE, I_CIM, I_SD, I_WGLU, I_QNG, I_KNG, I_WATT, I_WOUT, I_N2G, I_WQ, I_K1, I_K2, I_PU, I_PV };

__device__ __forceinline__ void ph_mod_partial(const float* __restrict__ c, const float* __restrict__ w_ada, float* modp, int gw, int ngw, int lane) {
    for (int task = gw; task < 48 * 32; task += ngw) {
        const int strip = task % 48, ks = task / 48, n0 = strip * 256 + lane * 4, k0 = ks * 64;
        f32x4 a0 = {0.f, 0.f, 0.f, 0.f}, a1 = {0.f, 0.f, 0.f, 0.f};
#pragma unroll 8
        for (int k = 0; k < 64; ++k) {
            const f32x4 w = *(const f32x4*)(w_ada + (size_t)(k0 + k) * 12288 + n0);
            float c0 = c[k0 + k], c1 = c[2048 + k0 + k];
            c0 = c0 / (1.0f + __expf(-c0)); c1 = c1 / (1.0f + __expf(-c1));
            a0 += c0 * w; a1 += c1 * w;
        }
        *(f32x4*)(modp + (size_t)(ks * 2 + 0) * 12288 + n0) = a0;
        *(f32x4*)(modp + (size_t)(ks * 2 + 1) * 12288 + n0) = a1;
    }
}

__device__ __forceinline__ void ph_colmax_partial(const float* __restrict__ w_in, float* cmaxp, int gw, int ngw, int lane) {
    for (int task = gw; task < 32 * 32; task += ngw) {
        const int strip = task & 31, ks = task >> 5, n0 = strip * 256 + lane * 4, k0 = ks * 64;
        f32x4 m = {0.f, 0.f, 0.f, 0.f};
#pragma unroll 8
        for (int k = 0; k < 64; ++k) { const f32x4 w = *(const f32x4*)(w_in + (size_t)(k0 + k) * 8192 + n0);
            m[0] = fmaxf(m[0], fabsf(w[0])); m[1] = fmaxf(m[1], fabsf(w[1])); m[2] = fmaxf(m[2], fabsf(w[2])); m[3] = fmaxf(m[3], fabsf(w[3])); }
        *(f32x4*)(cmaxp + (size_t)ks * 8192 + n0) = m;
    }
}

__device__ __forceinline__ void transpose_item_i8(const float* __restrict__ W, signed char* WT8, const float* cmaxp, float* SB, int n0, int k0, LAS float* scr, int lane) {
#pragma unroll 8
    for (int i = 0; i < 32; ++i) { const int kk = 2 * i + (lane >> 5); scr[kk * 33 + (lane & 31)] = W[(size_t)(k0 + kk) * 8192 + n0 + (lane & 31)]; }
    const int n = lane >> 1, half = lane & 1;
    float cm = 0.f;
#pragma unroll 8
    for (int ks = 0; ks < 32; ++ks) cm = fmaxf(cm, cmaxp[(size_t)ks * 8192 + n0 + n]);
    const float sb = fmaxf(cm, 1e-30f) * (1.0f / 127.0f), inv = 1.0f / sb;
    if (k0 == 0 && half == 0) SB[n0 + n] = sb;
    LDS_WAIT();
    const LAS float* s = scr + (32 * half) * 33 + n;
    u32x4 o[2];
#pragma unroll
    for (int q = 0; q < 8; ++q) { unsigned w = 0;
#pragma unroll
        for (int e = 0; e < 4; ++e) { const int v = (int)rintf(s[(4 * q + e) * 33] * inv); w |= ((unsigned)v & 0xffu) << (8 * e); }
        o[q >> 2][q & 3] = w; }
    *(u32x4*)(WT8 + (size_t)(n0 + n) * 2048 + k0 + 32 * half) = o[0];
    *(u32x4*)(WT8 + (size_t)(n0 + n) * 2048 + k0 + 32 * half + 16) = o[1];
    LDS_WAIT();
}

__device__ __forceinline__ void transpose_item(const float* __restrict__ W, int K, int N, bf16_t* WT, int drow0, int scol0, int k0, LAS float* scr, int lane) {
#pragma unroll 8
    for (int i = 0; i < 32; ++i) { const int kk = 2 * i + (lane >> 5); scr[kk * 33 + (lane & 31)] = W[(size_t)(k0 + kk) * N + scol0 + (lane & 31)]; }
    LDS_WAIT();
    const int c = lane & 7;
#pragma unroll
    for (int j = 0; j < 4; ++j) { const int n = (lane >> 3) + 8 * j; const LAS float* s = scr + (8 * c) * 33 + n;
        u32x4 o; o.x = cvt_pk_bf16(s[0 * 33], s[1 * 33]); o.y = cvt_pk_bf16(s[2 * 33], s[3 * 33]); o.z = cvt_pk_bf16(s[4 * 33], s[5 * 33]); o.w = cvt_pk_bf16(s[6 * 33], s[7 * 33]);
        *(u32x4*)(WT + (size_t)(drow0 + n) * K + k0 + 8 * c) = o; }
    LDS_WAIT();
}
__device__ __forceinline__ void wsc_item(const float* wq, const float* kk, bf16_t* out, int lane) {
    const int r = lane & 15, q = lane >> 4;
    f32x4 acc[8];
#pragma unroll
    for (int f = 0; f < 8; ++f) acc[f] = (f32x4){0.f, 0.f, 0.f, 0.f};
    const float* ap = kk + r * 128 + 4 * q; const float* bp = wq + (size_t)r * 2048 + 4 * q;
#pragma unroll 2
    for (int d0 = 0; d0 < 128; d0 += 16) {
        const f32x4 bv = *(const f32x4*)(bp + d0);
        f32x4 av[8];
#pragma unroll
        for (int f = 0; f < 8; ++f) av[f] = *(const f32x4*)(ap + f * 2048 + d0);
#pragma unroll
        for (int j = 0; j < 4; ++j)
#pragma unroll
            for (int f = 0; f < 8; ++f) acc[f] = __builtin_amdgcn_mfma_f32_16x16x4f32(av[f][j], bv[j], acc[f], 0, 0, 0);
    }
#pragma unroll
    for (int f = 0; f < 8; ++f)
#pragma unroll
        for (int i = 0; i < 4; ++i) out[(size_t)(16 * f + 4 * q + i) * 2048 + r] = (bf16_t)(cvt_pk_bf16(acc[f][i], 0.f) & 0xffffu);
}
__device__ __forceinline__ void ph_prologue(const Args& a, LAS unsigned char* lds, int gw, int ngw, int lane, int wave) {
    unsigned char* ws = a.ws;
    { const float* modp = (const float*)(ws + WS_MODP); float* mod = (float*)(ws + WS_MOD); const float* b_ada = a.in[I_BADA];
      for (int idx = gw * 64 + lane; idx < 2 * 12288; idx += ngw * 64) { const int b = idx / 12288, n = idx - b * 12288; float s = b_ada[n];
#pragma unroll 8
          for (int ks = 0; ks < 32; ++ks) s += modp[(size_t)(ks * 2 + b) * 12288 + n];
          mod[idx] = s; } }
    for (int item = gw; item < 2048; item += ngw) { const int hj = item >> 7, k0 = (item & 127) * 16;
        wsc_item(a.in[I_WQ] + (size_t)k0 * 2048 + hj * 128, (hj & 1) ? a.in[I_K2] : a.in[I_K1], (bf16_t*)(ws + WS_WSC) + (size_t)(hj * 128) * 2048 + k0, lane); }
    { LAS float* scr = (LAS float*)(lds + wave * 8448);
      constexpr int I_IN = 32 * 256, I_GLU = 16 * 128, I_ATT = 16 * 64, I_OUT = 32 * 64, NIT = I_IN + I_GLU + I_ATT + I_OUT;
      for (int it = gw; it < NIT; it += ngw) {
          int r = it;
          if (r < I_IN) { const int kb = r / 256, nb = r % 256; transpose_item_i8(a.in[I_WIN], (signed char*)(ws + WS_WIN), (const float*)(ws + WS_CMAXP), (float*)(ws + WS_SB), 32 * nb, 64 * kb, scr, lane); continue; } r -= I_IN;
          if (r < I_GLU) { const int kb = r / 128, nb = r % 128, dr = 32 * nb; const int sc = ((dr >> 7) & 1) * 2048 + (dr >> 8) * 128 + (dr & 127);
              transpose_item(a.in[I_WGLU], 1024, 4096, (bf16_t*)(ws + WS_WGLU), dr, sc, 64 * kb, scr, lane); continue; } r -= I_GLU;
          if (r < I_ATT) { const int kb = r / 64, nb = r % 64; transpose_item(a.in[I_WATT], 1024, 2048, (bf16_t*)(ws + WS_WATT), 32 * nb, 32 * nb, 64 * kb, scr, lane); continue; } r -= I_ATT;
          { const int kb = r / 64, nb = r % 64; transpose_item(a.in[I_WOUT], 2048, 2048, (bf16_t*)(ws + WS_WOUT), 32 * nb, 32 * nb, 64 * kb, scr, lane); }
      } }
}

template <bool I8>
__device__ __forceinline__ void ph_norm(const float* X, bf16_t* Hout, float* SA, const float* __restrict__ g, const float* mod, int sh_off, int sc_off, int gw, int ngw, int lane) {
    for (int row = gw; row < T_TOK; row += ngw) {
        const int b = row >> 13;
        const f32x4* xr = (const f32x4*)(X + (size_t)row * DM) + lane;
        f32x4 v[8]; float ss = 0.f;
#pragma unroll
        for (int j = 0; j < 8; ++j) { v[j] = xr[64 * j]; ss += (v[j][0] * v[j][0] + v[j][1] * v[j][1]) + (v[j][2] * v[j][2] + v[j][3] * v[j][3]); }
        ss = wave_sum(ss);
        const float rs = 1.0f / sqrtf(ss * (1.0f / DM) + EPS);
        const float* mb = mod + (size_t)b * 12288;
        float amax = 0.f;
#pragma unroll
        for (int j = 0; j < 8; ++j) { const int col = 4 * (lane + 64 * j);
            const f32x4 gv = *(const f32x4*)(g + col), sc = *(const f32x4*)(mb + sc_off + col), sh = *(const f32x4*)(mb + sh_off + col);
            const f32x4 o = v[j] * rs * gv * (sc + 1.0f) + sh;
            if (I8) { v[j] = o; amax = fmaxf(fmaxf(amax, fmaxf(fabsf(o[0]), fabsf(o[1]))), fmaxf(fabsf(o[2]), fabsf(o[3]))); }
            else { u32x2 w; w.x = cvt_pk_bf16(o[0], o[1]); w.y = cvt_pk_bf16(o[2], o[3]); *(u32x2*)(Hout + (size_t)row * DM + col) = w; } }
        if (I8) {
#pragma unroll
            for (int o = 1; o < 64; o <<= 1) amax = fmaxf(amax, __shfl_xor(amax, o));
            const float sa = fmaxf(amax, 1e-30f) * (1.0f / 127.0f), inv = 1.0f / sa;
            if (lane == 0) SA[row] = sa;
            unsigned* h8 = (unsigned*)((signed char*)Hout + (size_t)row * DM) + lane;
#pragma unroll
            for (int j = 0; j < 8; ++j) { unsigned w = 0;
#pragma unroll
                for (int e = 0; e < 4; ++e) { const int q = (int)rintf(v[j][e] * inv); w |= ((unsigned)q & 0xffu) << (8 * e); }
                h8[64 * j] = w; }
        }
    }
}

template <int MODE>
__device__ __forceinline__ void ph_attn(LAS unsigned char* lds, const bf16_t* PA, bf16_t* ATT, const float* __restrict__ qg, const float* __restrict__ kg, int G) {
    const int tid = opaque_tid(), lane = tid & 63, wave = __builtin_amdgcn_readfirstlane(tid >> 6), c = lane & 15, g = lane >> 4;
    LAS unsigned char* KL = lds;
    LAS unsigned char* VT = lds + 17408;
    bf16x8 tri[6];
    { const int FS[6] = {0, 1, 0, 1, 2, 3}, FP[6] = {0, 0, 1, 1, 1, 1};
#pragma unroll
      for (int q = 0; q < 6; ++q)
#pragma unroll
          for (int jj = 0; jj < 8; ++jj) { const int kap = 32 * FP[q] + 16 * (jj >> 2) + 4 * g + (jj & 3); tri[q][jj] = (kap > 16 * FS[q] + c) ? (short)0x3F80 : (short)0; } }
    for (int u = blockIdx.x; u < 1024; u += G) {
        const int b = u >> 9, h = (u >> 6) & 7, qb = u & 63, t0 = qb * 128, tq0 = t0 + 16 * wave, tq = tq0 + c;
        bf16x8 qf[4];
        { const bf16_t* qrow = PA + (size_t)(b * SEQ + tq) * 4096 + 1024 + h * 128;
          u32x4 qr[4]; float ss = 0.f;
#pragma unroll
          for (int kk = 0; kk < 4; ++kk) { qr[kk] = *(const u32x4*)(qrow + 32 * kk + 8 * g);
#pragma unroll
              for (int e = 0; e < 4; ++e) { const float lo = bf_lo(qr[kk][e]), hi = bf_hi(qr[kk][e]); ss += lo * lo + hi * hi; } }
          ss += __shfl_xor(ss, 16); ss += __shfl_xor(ss, 32);
          const float rs = (1.0f / sqrtf(ss * (1.0f / 128.0f) + EPS)) * 0.08838834764831845f;
#pragma unroll
          for (int kk = 0; kk < 4; ++kk) { const f32x4 g0 = *(const f32x4*)(qg + 32 * kk + 8 * g), g1 = *(const f32x4*)(qg + 32 * kk + 8 * g + 4);
              u32x4 w;
              w.x = cvt_pk_bf16(bf_lo(qr[kk].x) * rs * g0[0], bf_hi(qr[kk].x) * rs * g0[1]);
              w.y = cvt_pk_bf16(bf_lo(qr[kk].y) * rs * g0[2], bf_hi(qr[kk].y) * rs * g0[3]);
              w.z = cvt_pk_bf16(bf_lo(qr[kk].z) * rs * g1[0], bf_hi(qr[kk].z) * rs * g1[1]);
              w.w = cvt_pk_bf16(bf_lo(qr[kk].w) * rs * g1[2], bf_hi(qr[kk].w) * rs * g1[3]);
              qf[kk] = __builtin_bit_cast(bf16x8, w); } }
        float carry = 0.f; int wdone = 0;
        f32x4 oacc[8];
#pragma unroll
        for (int fd = 0; fd < 8; ++fd) oacc[fd] = (f32x4){0.f, 0.f, 0.f, 0.f};
        u32x4 kreg[2], vreg[2];
        { const int k0n = (2 * qb + 1) * 64;
#pragma unroll
          for (int p = 0; p < 2; ++p) { const int ci = tid + 512 * p, key = ci >> 4, ch = ci & 15;
              kreg[p] = *(const u32x4*)(PA + (size_t)(b * SEQ + k0n + key) * 4096 + 2048 + h * 128 + 8 * ch);
              vreg[p] = *(const u32x4*)(PA + (size_t)(b * SEQ + k0n + lane) * 4096 + 3072 + h * 128 + 8 * (wave + 8 * p)); } }
        for (int kt = 2 * qb + 1; kt >= 0; --kt) {
            const int k0 = kt * 64;
            if (__syncthreads_and(wdone)) break;
#pragma unroll
            for (int p = 0; p < 2; ++p) {
                const int ci = tid + 512 * p, key = ci >> 4, ch = ci & 15;
                const u32x4 kr = kreg[p];
                float f[8]; f[0] = bf_lo(kr.x); f[1] = bf_hi(kr.x); f[2] = bf_lo(kr.y); f[3] = bf_hi(kr.y); f[4] = bf_lo(kr.z); f[5] = bf_hi(kr.z); f[6] = bf_lo(kr.w); f[7] = bf_hi(kr.w);
                float ss = 0.f;
#pragma unroll
                for (int e = 0; e < 8; ++e) ss += f[e] * f[e];
                ss += __shfl_xor(ss, 1); ss += __shfl_xor(ss, 2); ss += __shfl_xor(ss, 4); ss += __shfl_xor(ss, 8);
                const float rs = 1.0f / sqrtf(ss * (1.0f / 128.0f) + EPS);
                const f32x4 g0 = *(const f32x4*)(kg + 8 * ch), g1 = *(const f32x4*)(kg + 8 * ch + 4);
                u32x4 w;
                w.x = cvt_pk_bf16(f[0] * rs * g0[0], f[1] * rs * g0[1]); w.y = cvt_pk_bf16(f[2] * rs * g0[2], f[3] * rs * g0[3]);
                w.z = cvt_pk_bf16(f[4] * rs * g1[0], f[5] * rs * g1[1]); w.w = cvt_pk_bf16(f[6] * rs * g1[2], f[7] * rs * g1[3]);
                *(LAS u32x4*)(KL + key * 272 + ch * 16) = w;
            }
#pragma unroll
            for (int p = 0; p < 2; ++p) {
                const int key = lane, ch = wave + 8 * p;
                const u32x4 vr = vreg[p];
                LAS unsigned short* vt = (LAS unsigned short*)(VT + (8 * ch) * 144 + key * 2);
                vt[0 * 72] = (unsigned short)(vr.x & 0xffffu); vt[1 * 72] = (unsigned short)(vr.x >> 16);
                vt[2 * 72] = (unsigned short)(vr.y & 0xffffu); vt[3 * 72] = (unsigned short)(vr.y >> 16);
                vt[4 * 72] = (unsigned short)(vr.z & 0xffffu); vt[5 * 72] = (unsigned short)(vr.z >> 16);
                vt[6 * 72] = (unsigned short)(vr.w & 0xffffu); vt[7 * 72] = (unsigned short)(vr.w >> 16);
            }
            if (kt > 0) { const int k0n = k0 - 64;
#pragma unroll
                for (int p = 0; p < 2; ++p) { const int ci = tid + 512 * p, key = ci >> 4, ch = ci & 15;
                    kreg[p] = *(const u32x4*)(PA + (size_t)(b * SEQ + k0n + key) * 4096 + 2048 + h * 128 + 8 * ch);
                    vreg[p] = *(const u32x4*)(PA + (size_t)(b * SEQ + k0n + lane) * 4096 + 3072 + h * 128 + 8 * (wave + 8 * p)); } }
            __syncthreads();
            if (MODE == 1) { if (kt <= 2 * qb - 3) wdone = 1; }
            if (MODE == 0 && !wdone && k0 < tq0 + 15) {
                f32x4 zt[4];
#pragma unroll
                for (int f = 0; f < 4; ++f) { f32x4 acc = {0.f, 0.f, 0.f, 0.f};
#pragma unroll
                    for (int kk = 0; kk < 4; ++kk) { const bf16x8 kf = *(const LAS bf16x8*)(KL + (16 * f + c) * 272 + (32 * kk + 8 * g) * 2);
                        acc = __builtin_amdgcn_mfma_f32_16x16x32_bf16(kf, qf[kk], acc, 0, 0, 0); }
                    zt[f] = acc; }
                float lf[4][4], lz[4][4]; float tot = 0.f;
#pragma unroll
                for (int f = 0; f < 4; ++f)
#pragma unroll
                    for (int i = 0; i < 4; ++i) { const int s = k0 + 16 * f + 4 * g + i; const bool valid = s < tq; const float z = zt[f][i];
                        const float sp = fmaxf(z, 0.f) + __logf(1.0f + __expf(-fabsf(z)));
                        const float l = valid ? -sp : 0.f; lf[f][i] = l; lz[f][i] = valid ? (l + z) : -INFINITY; tot += l; }
                tot += __shfl_xor(tot, 16); tot += __shfl_xor(tot, 32);
                bf16x8 lh[2], ll[2];
#pragma unroll
                for (int fp = 0; fp < 2; ++fp) { u32x4 wh, wl;
#pragma unroll
                    for (int q = 0; q < 2; ++q) { const int f = 2 * fp + q;
                        const unsigned h0 = cvt_pk_bf16(lf[f][0], lf[f][1]), h1 = cvt_pk_bf16(lf[f][2], lf[f][3]);
                        const unsigned l0 = cvt_pk_bf16(lf[f][0] - bf_lo(h0), lf[f][1] - bf_hi(h0)), l1 = cvt_pk_bf16(lf[f][2] - bf_lo(h1), lf[f][3] - bf_hi(h1));
                        wh[2 * q] = h0; wh[2 * q + 1] = h1; wl[2 * q] = l0; wl[2 * q + 1] = l1; }
                    lh[fp] = __builtin_bit_cast(bf16x8, wh); ll[fp] = __builtin_bit_cast(bf16x8, wl); }
                f32x4 sf[4];
                { f32x4 z4 = {0.f, 0.f, 0.f, 0.f};
                  sf[0] = __builtin_amdgcn_mfma_f32_16x16x32_bf16(tri[0], lh[0], z4, 0, 0, 0); sf[0] = __builtin_amdgcn_mfma_f32_16x16x32_bf16(tri[0], ll[0], sf[0], 0, 0, 0);
                  sf[0] = __builtin_amdgcn_mfma_f32_16x16x32_bf16(tri[2], lh[1], sf[0], 0, 0, 0); sf[0] = __builtin_amdgcn_mfma_f32_16x16x32_bf16(tri[2], ll[1], sf[0], 0, 0, 0);
                  sf[1] = __builtin_amdgcn_mfma_f32_16x16x32_bf16(tri[1], lh[0], z4, 0, 0, 0); sf[1] = __builtin_amdgcn_mfma_f32_16x16x32_bf16(tri[1], ll[0], sf[1], 0, 0, 0);
                  sf[1] = __builtin_amdgcn_mfma_f32_16x16x32_bf16(tri[3], lh[1], sf[1], 0, 0, 0); sf[1] = __builtin_amdgcn_mfma_f32_16x16x32_bf16(tri[3], ll[1], sf[1], 0, 0, 0);
                  sf[2] = __builtin_amdgcn_mfma_f32_16x16x32_bf16(tri[4], lh[1], z4, 0, 0, 0); sf[2] = __builtin_amdgcn_mfma_f32_16x16x32_bf16(tri[4], ll[1], sf[2], 0, 0, 0);
                  sf[3] = __builtin_amdgcn_mfma_f32_16x16x32_bf16(tri[5], lh[1], z4, 0, 0, 0); sf[3] = __builtin_amdgcn_mfma_f32_16x16x32_bf16(tri[5], ll[1], sf[3], 0, 0, 0); }
                bf16x8 pb[2];
#pragma unroll
                for (int fp = 0; fp < 2; ++fp) { u32x4 w;
#pragma unroll
                    for (int q = 0; q < 2; ++q) { const int f = 2 * fp + q; float p[4];
#pragma unroll
                        for (int i = 0; i < 4; ++i) p[i] = __expf(lz[f][i] + sf[f][i] + carry);
                        w[2 * q] = cvt_pk_bf16(p[0], p[1]); w[2 * q + 1] = cvt_pk_bf16(p[2], p[3]); }
                    pb[fp] = __builtin_bit_cast(bf16x8, w); }
                carry += tot;
#pragma unroll
                for (int fd = 0; fd < 8; ++fd)
#pragma unroll
                    for (int fp = 0; fp < 2; ++fp) { const LAS unsigned char* vp = VT + (16 * fd + c) * 144 + (32 * fp + 4 * g) * 2;
                        const u32x2 v0 = *(const LAS u32x2*)vp, v1 = *(const LAS u32x2*)(vp + 32);
                        u32x4 vw; vw.x = v0.x; vw.y = v0.y; vw.z = v1.x; vw.w = v1.y;
                        oacc[fd] = __builtin_amdgcn_mfma_f32_16x16x32_bf16(__builtin_bit_cast(bf16x8, vw), pb[fp], oacc[fd], 0, 0, 0); }
                wdone = (__ballot(carry >= -105.0f) == 0ull) ? 1 : 0;
            }
        }
        if (MODE == 0) { bf16_t* orow = ATT + (size_t)(b * SEQ + tq) * 1024 + h * 128 + 4 * g;
#pragma unroll
          for (int fd = 0; fd < 8; ++fd) { u32x2 w; w.x = cvt_pk_bf16(oacc[fd][0], oacc[fd][1]); w.y = cvt_pk_bf16(oacc[fd][2], oacc[fd][3]); *(u32x2*)(orow + 16 * fd) = w; } }
    }
    __syncthreads();
}

__device__ __forceinline__ void ssm_lambda(const Args& a, int g, int st, float& lbr, float& lbi, float& qr, float& qi) {
    const float lr = a.in[I_LRE][g * 64 + st], li = a.in[I_LIM][g * 64 + st], dt = __expf(a.in[I_LDT][g]);
    const float mag = __expf(lr * dt);
    float rev = li * dt * 0.15915494309189535f; rev -= rintf(rev);
    lbr = mag * __builtin_amdgcn_cosf(rev); lbi = mag * __builtin_amdgcn_sinf(rev);
    const float nr = lbr - 1.0f, ni = lbi, den = 1.0f / (lr * lr + li * li);
    qr = (nr * lr + ni * li) * den; qi = (ni * lr - nr * li) * den;
}
template <bool WITH_Y>
__device__ __forceinline__ void ph_ssm_mfma(const Args& a, LAS unsigned char* lds, const bf16_t* UB, f32x2* E, bf16_t* YA, int G) {
    const int tid = opaque_tid(), lane = tid & 63, wave = __builtin_amdgcn_readfirstlane(tid >> 6), c = lane & 15, gl = lane >> 4;
    LAS f32x2* sl = (LAS f32x2*)(lds + wave * 8192);
    LAS f32x4* tab = (LAS f32x4*)(lds + 65536 + wave * 1024);
    LAS u32x4* cml = (LAS u32x4*)(lds + 73728 + wave * 5120) + lane;
    for (int item = blockIdx.x; item < 128; item += G) {
        const int b = item >> 6, cb = (item >> 3) & 7, g = (item & 7) * 8 + wave, c0 = cb * 16;
        float mur, mui;
        { float lbr, lbi, qr, qi; ssm_lambda(a, g, lane, lbr, lbi, qr, qi); tab[lane] = (f32x4){lbr, lbi, qr, qi}; mur = lbr; mui = lbi; }
        LDS_WAIT();
        bf16x8 bm[8];
        const float* brb = a.in[I_BRE] + (g * 64 + (c >> 1)) * 16 + 8 * (gl & 1); const float* bib = a.in[I_BIM] + (g * 64 + (c >> 1)) * 16 + 8 * (gl & 1);
        const LAS f32x4* tabb = tab + (c >> 1);
#pragma unroll
        for (int f = 0; f < 8; ++f) { const f32x4 tv = tabb[8 * f]; const float qr = tv[2], qi = tv[3];
            const float* br = brb + 128 * f; const float* bim = bib + 128 * f;
            const f32x4 r0 = *(const f32x4*)br, r1 = *(const f32x4*)(br + 4), i0 = *(const f32x4*)bim, i1 = *(const f32x4*)(bim + 4);
            float v[8];
#pragma unroll
            for (int e = 0; e < 4; ++e) { const float vr0 = qr * r0[e] - qi * i0[e], vi0 = qr * i0[e] + qi * r0[e], vr1 = qr * r1[e] - qi * i1[e], vi1 = qr * i1[e] + qi * r1[e];
                v[e] = (c & 1) ? vi0 : vr0; v[4 + e] = (c & 1) ? vi1 : vr1; }
            if (gl >= 2) {
#pragma unroll
                for (int e = 0; e < 8; ++e) v[e] = 0.f; }
            u32x4 w; w.x = cvt_pk_bf16(v[0], v[1]); w.y = cvt_pk_bf16(v[2], v[3]); w.z = cvt_pk_bf16(v[4], v[5]); w.w = cvt_pk_bf16(v[6], v[7]);
            bm[f] = __builtin_bit_cast(bf16x8, w); }
        float lmr[16], lmi[16];
#pragma unroll
        for (int k = 0; k < 16; ++k) { const f32x4 tv = tab[2 * gl + 8 * (k >> 1) + (k & 1)]; lmr[k] = tv[0]; lmi[k] = tv[1]; }
        if (WITH_Y) {
            const float* crb = a.in[I_CRE] + (g * 16 + c) * 64 + 2 * gl; const float* cib = a.in[I_CIM] + (g * 16 + c) * 64 + 2 * gl;
#pragma unroll
            for (int kk = 0; kk < 4; ++kk) { float v[8];
#pragma unroll
                for (int jh = 0; jh < 2; ++jh) { const f32x2 r = *(const f32x2*)(crb + 8 * (2 * kk + jh)), m = *(const f32x2*)(cib + 8 * (2 * kk + jh));
                    v[4 * jh] = r.x; v[4 * jh + 1] = -m.x; v[4 * jh + 2] = r.y; v[4 * jh + 3] = -m.y; }
                u32x4 w; w.x = cvt_pk_bf16(v[0], v[1]); w.y = cvt_pk_bf16(v[2], v[3]); w.z = cvt_pk_bf16(v[4], v[5]); w.w = cvt_pk_bf16(v[6], v[7]);
                cml[64 * kk] = w; }
            { const float dv = a.in[I_SD][g * 16 + c]; float v[8];
#pragma unroll
              for (int jj = 0; jj < 8; ++jj) v[jj] = (gl < 2 && (8 * gl + jj) == c) ? dv : 0.f;
              u32x4 w; w.x = cvt_pk_bf16(v[0], v[1]); w.y = cvt_pk_bf16(v[2], v[3]); w.z = cvt_pk_bf16(v[4], v[5]); w.w = cvt_pk_bf16(v[6], v[7]);
              cml[256] = w; }
        }
        f32x4 s[8];
#pragma unroll
        for (int f = 0; f < 8; ++f) s[f] = (f32x4){0.f, 0.f, 0.f, 0.f};
        if (WITH_Y) {
            float pr = mur, pi = mui;
#pragma unroll
            for (int q = 0; q < 6; ++q) { const float nr = pr * pr - pi * pi, ni = 2.0f * pr * pi; pr = nr; pi = ni; }
            float sr = 0.f, si = 0.f;
            const f32x2* ep = E + (size_t)((b * 64 + g) * 128) * 64 + lane;
            f32x2 ev[8], en[8];
#pragma unroll
            for (int k = 0; k < 8; ++k) ev[k] = ep[(size_t)k * 64];
            for (int cc = 0; cc < c0 + 16; cc += 8) {
                if (cc + 8 < c0 + 16) {
#pragma unroll
                    for (int k = 0; k < 8; ++k) en[k] = ep[(size_t)(cc + 8 + k) * 64]; }
#pragma unroll
                for (int k = 0; k < 8; ++k) { if (cc >= c0) sl[(cc - c0 + k) * 64 + lane] = (f32x2){sr, si};
                    const float nr = pr * sr - pi * si + ev[k][0], ni = pr * si + pi * sr + ev[k][1]; sr = nr; si = ni; }
#pragma unroll
                for (int k = 0; k < 8; ++k) ev[k] = en[k];
            }
            LDS_WAIT();
#pragma unroll
            for (int f = 0; f < 8; ++f) s[f] = *(const LAS f32x4*)(sl + c * 64 + 8 * f + 2 * gl);
            LDS_WAIT();
        }
        const bf16_t* up = UB + ((size_t)(b * 64 + g) * 8192 + (size_t)(c0 + c) * 64) * 16 + 8 * (gl & 1);
        bf16_t* yp = YA + (size_t)(b * SEQ + (c0 + c) * 64) * 1024 + g * 16 + 4 * gl;
        u32x4 u0 = *(const u32x4*)(up), u1 = *(const u32x4*)(up + 16), u2 = *(const u32x4*)(up + 32), u3 = *(const u32x4*)(up + 48), u4 = *(const u32x4*)(up + 64), u5 = *(const u32x4*)(up + 80);
#pragma unroll 1
        for (int tau = 0; tau < 64; ++tau) {
            const u32x4 u6 = *(const u32x4*)(up + (size_t)(tau + 6) * 16);
            const bf16x8 uf = __builtin_bit_cast(bf16x8, u0);
#pragma unroll
            for (int f = 0; f < 8; ++f) { f32x4 ci;
                ci[0] = lmr[2 * f] * s[f][0] - lmi[2 * f] * s[f][1]; ci[1] = lmr[2 * f] * s[f][1] + lmi[2 * f] * s[f][0];
                ci[2] = lmr[2 * f + 1] * s[f][2] - lmi[2 * f + 1] * s[f][3]; ci[3] = lmr[2 * f + 1] * s[f][3] + lmi[2 * f + 1] * s[f][2];
                s[f] = __builtin_amdgcn_mfma_f32_16x16x32_bf16(bm[f], uf, ci, 0, 0, 0); }
            if (WITH_Y) {
                f32x4 y = __builtin_amdgcn_mfma_f32_16x16x32_bf16(__builtin_bit_cast(bf16x8, cml[256]), uf, (f32x4){0.f, 0.f, 0.f, 0.f}, 0, 0, 0);
#pragma unroll
                for (int kk = 0; kk < 4; ++kk) { u32x4 w; w.x = cvt_pk_bf16(s[2 * kk][0], s[2 * kk][1]); w.y = cvt_pk_bf16(s[2 * kk][2], s[2 * kk][3]);
                    w.z = cvt_pk_bf16(s[2 * kk + 1][0], s[2 * kk + 1][1]); w.w = cvt_pk_bf16(s[2 * kk + 1][2], s[2 * kk + 1][3]);
                    y = __builtin_amdgcn_mfma_f32_16x16x32_bf16(__builtin_bit_cast(bf16x8, cml[64 * kk]), __builtin_bit_cast(bf16x8, w), y, 0, 0, 0); }
                u32x2 o; o.x = cvt_pk_bf16(gelu_tanh(y[0]), gelu_tanh(y[1])); o.y = cvt_pk_bf16(gelu_tanh(y[2]), gelu_tanh(y[3]));
                *(u32x2*)(yp + (size_t)tau * 1024) = o;
            }
            u0 = u1; u1 = u2; u2 = u3; u3 = u4; u4 = u5; u5 = u6;
        }
        if (!WITH_Y) { f32x2* eo = E + (size_t)((b * 64 + g) * 128 + c0 + c) * 64 + 2 * gl;
#pragma unroll
            for (int f = 0; f < 8; ++f) *(f32x4*)(eo + 8 * f) = s[f]; }
    }
}

#ifndef FP6_INTERLEAVED
#define FP6_INTERLEAVED 1
#endif
typedef float f32x16 __attribute__((ext_vector_type(16)));
typedef float f32x32 __attribute__((ext_vector_type(32)));
typedef unsigned u32x6 __attribute__((ext_vector_type(6)));
constexpr float PEER_SU = 64.0f, PEER_SV = 1.4f;
__device__ __forceinline__ void ph_table_cvt(const float* __restrict__ U, const float* __restrict__ V, unsigned char* UT, unsigned char* VT, int gw, int ngw, int lane) {
    for (int row = gw; row < 2 * 16384; row += ngw) {
        const bool sec = row >= 16384; const int r = sec ? row - 16384 : row; const float sc = sec ? PEER_SV : PEER_SU;
        const float* src = (sec ? V : U) + (size_t)r * 2048 + 4 * lane; unsigned char* dst = (sec ? VT : UT) + (size_t)r * 1536;
        f32x16 a, b;
#pragma unroll
        for (int q = 0; q < 4; ++q) { const f32x4 v0 = *(const f32x4*)(src + 256 * q), v1 = *(const f32x4*)(src + 1024 + 256 * q);
#pragma unroll
            for (int e = 0; e < 4; ++e) { a[4 * q + e] = v0[e] * sc; b[4 * q + e] = v1[e] * sc; } }
        const u32x6 p = __builtin_amdgcn_cvt_scalef32_2xpk16_fp6_f32(a, b, 1.0f);
        *(u32x4*)(dst + 16 * lane) = (u32x4){p[0], p[1], p[2], p[3]};
        *(u32x2*)(dst + 1024 + 8 * lane) = (u32x2){p[4], p[5]};
    }
}

__device__ __forceinline__ void ph_peer(LAS unsigned char* lds, const float* SC, const bf16_t* H2, const unsigned char* UT, const unsigned char* VTb, const float* mod, float* OUT, int G) {
    const int tid = opaque_tid(), lane = tid & 63, wave = __builtin_amdgcn_readfirstlane(tid >> 6);
    LAS float* scr = (LAS float*)(lds + wave * 8448);
    LAS int* idxs = (LAS int*)(lds + 69632 + wave * 4096);
    LAS float* gates = (LAS float*)(lds + 69632 + wave * 4096 + 2048);
    LAS float* dotb = (LAS float*)(lds + 102400 + wave * 1024);
    for (int it = blockIdx.x; it < 512; it += G) {
        const int tokw = it * 32 + wave * 4;
        for (int rep = 0; rep < ((DUP == 101) ? 2 : 1); ++rep) {
        float tk[16];
#pragma unroll
        for (int i = 0; i < 16; ++i) tk[i] = -INFINITY;
        for (int q = 0; q < 4; ++q) {
#pragma unroll
            for (int j = 0; j < 8; ++j) { const int prob = (lane >> 3) + 8 * j, seg = lane & 7;
                const f32x4 v = *(const f32x4*)(SC + (size_t)(tokw + (prob >> 4)) * 2048 + (prob & 15) * 128 + 32 * q + 4 * seg);
                LAS float* d = scr + prob * 33 + 4 * seg; d[0] = v[0]; d[1] = v[1]; d[2] = v[2]; d[3] = v[3]; }
            LDS_WAIT();
#pragma unroll 4
            for (int vi = 0; vi < 32; ++vi) {
                float x = __uint_as_float((__float_as_uint(scr[lane * 33 + vi]) & ~127u) | (unsigned)(127 - (32 * q + vi)));
#pragma unroll
                for (int i = 0; i < 16; ++i) { const float hi = fmaxf(tk[i], x); x = fminf(tk[i], x); tk[i] = hi; }
            }
            LDS_WAIT();
        }
        float t2[16];
#pragma unroll
        for (int i = 0; i < 16; ++i) t2[i] = __shfl_xor(tk[i], 1);
        float bv[16]; int bp[16];
#pragma unroll
        for (int i = 0; i < 16; ++i) { bv[i] = -INFINITY; bp[i] = 0; }
#pragma unroll
        for (int aa = 0; aa < 16; ++aa)
#pragma unroll
            for (int bb = 0; bb < 16 / (aa + 1); ++bb) {
                const unsigned u1 = __float_as_uint(tk[aa]), u2 = __float_as_uint(t2[bb]);
                float x = __uint_as_float(u1 & ~127u) + __uint_as_float(u2 & ~127u);
                int px = (int)(((127u - (u1 & 127u)) << 7) | (127u - (u2 & 127u)));
#pragma unroll
                for (int i = 0; i < 16; ++i) { const bool gt = x > bv[i]; const float nv = gt ? x : bv[i], ox = gt ? bv[i] : x; const int np = gt ? px : bp[i], op = gt ? bp[i] : px;
                    bv[i] = nv; x = ox; bp[i] = np; px = op; }
            }
        { float e[16], sum = 0.f;
#pragma unroll
          for (int i = 0; i < 16; ++i) { e[i] = __expf(bv[i] - bv[0]); sum += e[i]; }
          const float inv = 1.0f / sum;
          if ((lane & 1) == 0) { const int tl = lane >> 4, head = (lane & 15) >> 1;
#pragma unroll
              for (int i = 0; i < 16; ++i) { idxs[tl * 128 + head * 16 + i] = bp[i]; gates[tl * 128 + head * 16 + i] = e[i] * inv; } } }
        LDS_WAIT();
        }
        for (int tl = 0; tl < 4; ++tl) {
            const int token = tokw + tl;
            f32x2 ha[16];
            { const bf16_t* hrow = H2 + (size_t)token * 2048 + 4 * lane;
              u32x2 hw[8];
#pragma unroll
              for (int j = 0; j < 8; ++j) hw[j] = *(const u32x2*)(hrow + 256 * j);
#pragma unroll
              for (int j = 0; j < 4; ++j) { ha[4 * j + 0] = (f32x2){bf_lo(hw[j].x), bf_lo(hw[j + 4].x)}; ha[4 * j + 1] = (f32x2){bf_hi(hw[j].x), bf_hi(hw[j + 4].x)};
                  ha[4 * j + 2] = (f32x2){bf_lo(hw[j].y), bf_lo(hw[j + 4].y)}; ha[4 * j + 3] = (f32x2){bf_hi(hw[j].y), bf_hi(hw[j + 4].y)}; } }
            for (int grp = 0; grp < 16; ++grp) {
                u32x4 b4[8]; u32x2 b2[8];
#pragma unroll
                for (int r = 0; r < 8; ++r) { const int e = __builtin_amdgcn_readfirstlane(idxs[tl * 128 + grp * 8 + r]);
                    const unsigned char* rp = UT + (size_t)e * 1536; b4[r] = *(const u32x4*)(rp + 16 * lane); b2[r] = *(const u32x2*)(rp + 1024 + 8 * lane); }
                float pt[8];
#pragma unroll
                for (int r = 0; r < 8; ++r) { const u32x6 p6 = {b4[r].x, b4[r].y, b4[r].z, b4[r].w, b2[r].x, b2[r].y};
                    const f32x32 uv = __builtin_amdgcn_cvt_scalef32_pk32_f32_fp6(p6, 1.0f); f32x2 s = {0.f, 0.f};
#pragma unroll
                    for (int k = 0; k < 16; ++k) s = (f32x2){uv[2 * k], uv[2 * k + 1]} * ha[k] + s;
                    pt[r] = s.x + s.y; }
                const bool h5 = lane & 32, h4 = lane & 16, h3 = lane & 8; float w4[4], w2[2], w1;
#pragma unroll
                for (int k = 0; k < 4; ++k) { const float keep = h5 ? pt[k + 4] : pt[k], send = h5 ? pt[k] : pt[k + 4]; w4[k] = keep + __shfl_xor(send, 32); }
#pragma unroll
                for (int k = 0; k < 2; ++k) { const float keep = h4 ? w4[k + 2] : w4[k], send = h4 ? w4[k] : w4[k + 2]; w2[k] = keep + __shfl_xor(send, 16); }
                { const float keep = h3 ? w2[1] : w2[0], send = h3 ? w2[0] : w2[1]; w1 = keep + __shfl_xor(send, 8); }
                w1 += __shfl_xor(w1, 4); w1 += __shfl_xor(w1, 2); w1 += __shfl_xor(w1, 1);
                if ((lane & 7) == 0) dotb[grp * 8 + ((lane >> 5) & 1) * 4 + ((lane >> 4) & 1) * 2 + ((lane >> 3) & 1)] = w1;
            }
            LDS_WAIT();
            { const float d0 = dotb[lane] * (1.0f / PEER_SU), d1 = dotb[lane + 64] * (1.0f / PEER_SU);
              const float a0 = gates[tl * 128 + lane] * gelu_tanh(d0) * (1.0f / PEER_SV), a1 = gates[tl * 128 + lane + 64] * gelu_tanh(d1) * (1.0f / PEER_SV);
              LDS_WAIT(); dotb[lane] = a0; dotb[lane + 64] = a1; }
            LDS_WAIT();
#pragma unroll
            for (int i = 0; i < 16; ++i) ha[i] = (f32x2){0.f, 0.f};
            for (int grp = 0; grp < 16; ++grp) {
                u32x4 b4[8]; u32x2 b2[8];
#pragma unroll
                for (int r = 0; r < 8; ++r) { const int e = __builtin_amdgcn_readfirstlane(idxs[tl * 128 + grp * 8 + r]);
                    const unsigned char* rp = VTb + (size_t)e * 1536; b4[r] = *(const u32x4*)(rp + 16 * lane); b2[r] = *(const u32x2*)(rp + 1024 + 8 * lane); }
#pragma unroll
                for (int r = 0; r < 8; ++r) { const float ar = dotb[grp * 8 + r]; const f32x2 a2 = {ar, ar};
                    const u32x6 p6 = {b4[r].x, b4[r].y, b4[r].z, b4[r].w, b2[r].x, b2[r].y};
                    const f32x32 vv = __builtin_amdgcn_cvt_scalef32_pk32_f32_fp6(p6, 1.0f);
#pragma unroll
                    for (int k = 0; k < 16; ++k) ha[k] = (f32x2){vv[2 * k], vv[2 * k + 1]} * a2 + ha[k]; }
            }
            { const int b = token >> 13; const float* gt2 = mod + (size_t)b * 12288 + 10240 + 4 * lane; float* orow = OUT + (size_t)token * 2048 + 4 * lane;
#pragma unroll
              for (int j = 0; j < 4; ++j) { const f32x4 x0 = *(const f32x4*)(orow + 256 * j), x1 = *(const f32x4*)(orow + 1024 + 256 * j);
                  const f32x4 g0 = *(const f32x4*)(gt2 + 256 * j), g1 = *(const f32x4*)(gt2 + 1024 + 256 * j); f32x4 o0, o1;
#pragma unroll
                  for (int e = 0; e < 4; ++e) { o0[e] = x0[e] + g0[e] * ha[4 * j + e].x; o1[e] = x1[e] + g1[e] * ha[4 * j + e].y; }
                  *(f32x4*)(orow + 256 * j) = o0; *(f32x4*)(orow + 1024 + 256 * j) = o1; } }
            LDS_WAIT();
        }
    }
}

__global__ void __launch_bounds__(512, 2) mk_fwd(Args args) {
    extern __shared__ __attribute__((aligned(16))) unsigned char lds_raw[];
    LAS unsigned char* lds = (LAS unsigned char*)lds_raw;
    const int tid = threadIdx.x, lane = tid & 63, wave = __builtin_amdgcn_readfirstlane(tid >> 6);
    const int G = gridDim.x, gw = blockIdx.x * 8 + wave, ngw = G * 8;
    unsigned char* ws = args.ws;
    volatile LAS unsigned* misc = (volatile LAS unsigned*)(lds + LDS_MAIN);
    if (tid < 4) misc[tid] = 0u;
    __syncthreads();
    const int lo = args.ph_lo, hi = args.ph_hi;
    XcdBarrier bar; bar.bar = (unsigned*)(ws + WS_CTL); bar.x = 0; bar.st = misc;
    if (hi - lo > 1) bar = xcd_barrier_post((unsigned*)(ws + WS_CTL), misc);
#ifndef PHMASK
#define PHMASK 0x7ff
#endif
#define IN(k) (((PHMASK >> (k)) & 1) && lo <= (k) && (k) < hi)
#define SEAM(k) do { if (IN(k) && IN((k) + 1)) xcd_barrier(bar); } while (0)
    float* mod = (float*)(ws + WS_MOD);
    bf16_t* HB = (bf16_t*)(ws + WS_H); bf16_t* PA = (bf16_t*)(ws + WS_PA); bf16_t* PG = (bf16_t*)(ws + WS_PG);
    bf16_t* YA = (bf16_t*)(ws + WS_YA); bf16_t* ATT = (bf16_t*)(ws + WS_ATT); f32x2* EB = (f32x2*)(ws + WS_E); bf16_t* UBp = (bf16_t*)(ws + WS_UB);

#define PHS(code, ...) do { __VA_ARGS__ if (DUP == (code)) { xcd_barrier(bar); __VA_ARGS__ } } while (0)
#define PH(k, ...) do { if (IN(k)) { __VA_ARGS__ if (DUP == (k)) { xcd_barrier(bar); __VA_ARGS__ } } } while (0)
    PH(0, { ph_mod_partial(args.in[I_C], args.in[I_WADA], (float*)(ws + WS_MODP), gw, ngw, lane); ph_colmax_partial(args.in[I_WIN], (float*)(ws + WS_CMAXP), gw, ngw, lane); });
    SEAM(0);
    PH(1, { ph_prologue(args, lds, gw, ngw, lane, wave); });
    SEAM(1);
    PH(2, { ph_norm<true>(args.in[I_X], HB, (float*)(ws + WS_SA), args.in[I_N1G], mod, 0, 2048, gw, ngw, lane); });
    SEAM(2);
    PH(3, { pg8::Gemm g{HB, (const bf16_t*)(ws + WS_WIN), T_TOK, 8192, 1024}; pg8::StaticOrder S; S.init(T_TOK, 8192, G, (int)blockIdx.x);
        pg8::EpiProj E{PA, PG, UBp, (const float*)(ws + WS_SA), (const float*)(ws + WS_SB)}; pg8::gemm_phase<pg8::EpiProj, pg8::StaticOrder, true, true, true>(lds, g, S, E); });
    SEAM(3);
    PH(4, { PHS(41, { ph_attn<0>(lds, PA, ATT, args.in[I_QNG], args.in[I_KNG], G); __syncthreads(); });
        if (DUP == 411) { xcd_barrier(bar); ph_attn<1>(lds, PA, ATT, args.in[I_QNG], args.in[I_KNG], G); __syncthreads(); } PHS(42, { ph_ssm_mfma<false>(args, lds, UBp, EB, YA, G); }); });
    SEAM(4);
    PH(5, { PHS(51, { ph_ssm_mfma<true>(args, lds, UBp, EB, YA, G); __syncthreads(); });
        PHS(52, { pg8::Gemm g{ATT, (const bf16_t*)(ws + WS_WATT), T_TOK, 2048, 1024}; pg8::SplitOrder S; S.init(T_TOK, 2048, G, (int)blockIdx.x);
        pg8::EpiAttUp E{PG, HB}; pg8::gemm_phase<pg8::EpiAttUp, pg8::SplitOrder, true, true>(lds, g, S, E); }); });
    SEAM(5);
    PH(6, { pg8::Gemm g{YA, (const bf16_t*)(ws + WS_WGLU), T_TOK, 4096, 1024}; pg8::StaticOrder S; S.init(T_TOK, 4096, G, (int)blockIdx.x);
        pg8::EpiGlu E{PG, HB}; pg8::gemm_phase<pg8::EpiGlu, pg8::StaticOrder, true, true>(lds, g, S, E); });
    SEAM(6);
    PH(7, { pg8::Gemm g{HB, (const bf16_t*)(ws + WS_WOUT), T_TOK, 2048, 2048}; pg8::StaticOrder S; S.init(T_TOK, 2048, G, (int)blockIdx.x);
        pg8::EpiOut E{args.in[I_X], args.out, mod}; pg8::gemm_phase<pg8::EpiOut, pg8::StaticOrder, true, true>(lds, g, S, E);
        ph_table_cvt(args.in[I_PU], args.in[I_PV], ws + WS_UT, ws + WS_VT, gw, ngw, lane); });
    SEAM(7);
    PH(8, { ph_norm<false>(args.out, HB, nullptr, args.in[I_N2G], mod, 6144, 8192, gw, ngw, lane); });
    SEAM(8);
    PH(9, { pg8::Gemm g{HB, (const bf16_t*)(ws + WS_WSC), T_TOK, 2048, 2048}; pg8::StaticOrder S; S.init(T_TOK, 2048, G, (int)blockIdx.x);
        pg8::EpiF32 E{(float*)(ws + WS_SC)}; pg8::gemm_phase<pg8::EpiF32, pg8::StaticOrder, true, true>(lds, g, S, E); });
    SEAM(9);
    PH(10, { ph_peer(lds, (const float*)(ws + WS_SC), HB, ws + WS_UT, ws + WS_VT, mod, args.out, G); });
#undef IN
#undef SEAM
}

extern "C" void kernel_launch(void* const* d_in, const int* in_sizes, int n_in, void* d_out, int out_size, void* d_ws, size_t ws_size, hipStream_t stream) {
    static int grid = 0;
    if (grid == 0) {
        if (n_in != 25 || out_size != T_TOK * DM || ws_size < WS_END) { fprintf(stderr, "kernel_launch: unexpected shapes (n_in %d out %d ws %zu need %zu)\n", n_in, out_size, ws_size, (size_t)WS_END); grid = -1; return; }
        int dev = 0, cus = 0, per_cu = 0;
        if (hipGetDevice(&dev) != hipSuccess || hipDeviceGetAttribute(&cus, hipDeviceAttributeMultiprocessorCount, dev) != hipSuccess) { grid = -1; return; }
        if (hipFuncSetAttribute((const void*)mk_fwd, hipFuncAttributeMaxDynamicSharedMemorySize, LDS_BYTES) != hipSuccess) { fprintf(stderr, "kernel_launch: hipFuncSetAttribute failed\n"); grid = -1; return; }
        if (hipOccupancyMaxActiveBlocksPerMultiprocessor(&per_cu, (const void*)mk_fwd, 512, LDS_BYTES) != hipSuccess || per_cu < 1) { fprintf(stderr, "kernel_launch: occupancy query says %d blocks/CU\n", per_cu); (void)hipGetLastError(); grid = -1; return; }
        grid = cus;
    }
    if (grid < 0) return;
    (void)hipMemsetAsync((char*)d_ws + WS_CTL, 0, 16384, stream);
    Args a{};
    for (int i = 0; i < 25; ++i) a.in[i] = (const float*)d_in[i];
    a.out = (float*)d_out; a.ws = (unsigned char*)d_ws;
#if MK_PER_PHASE
    for (int ph = 0; ph < NPHASE; ++ph) { a.ph_lo = ph; a.ph_hi = ph + 1; hipLaunchKernelGGL(mk_fwd, dim3(grid), dim3(512), LDS_BYTES, stream, a); }
#else
    a.ph_lo = 0; a.ph_hi = NPHASE;
    hipLaunchKernelGGL(mk_fwd, dim3(grid), dim3(512), LDS_BYTES, stream, a);
#endif
}
```

```cpp
#include <hip/hip_runtime.h>
#include <cstdio>
#include <cstdint>

#ifndef MK_PER_PHASE
#define MK_PER_PHASE 0
#endif

#ifndef DUP
#define DUP -1
#endif
#define LAS __attribute__((address_space(3)))
typedef unsigned short bf16_t;
typedef short bf16x8 __attribute__((ext_vector_type(8)));
typedef float f32x4 __attribute__((ext_vector_type(4)));
typedef float f32x2 __attribute__((ext_vector_type(2)));
typedef unsigned u32x4 __attribute__((ext_vector_type(4)));
typedef unsigned u32x2 __attribute__((ext_vector_type(2)));
typedef int i32x4 __attribute__((ext_vector_type(4)));

constexpr int T_TOK = 16384, DM = 2048, SEQ = 8192;
constexpr int NPHASE = 11;
constexpr float EPS = 1e-6f;

constexpr size_t WS_CTL   = 0;
constexpr size_t WS_MODP  = 65536;
constexpr size_t WS_MOD   = WS_MODP + (size_t)32 * 2 * 12288 * 4;
constexpr size_t WS_WIN   = WS_MOD + (size_t)2 * 12288 * 4;
constexpr size_t WS_WGLU  = WS_WIN + (size_t)8192 * 2048 * 2;
constexpr size_t WS_WATT  = WS_WGLU + (size_t)4096 * 1024 * 2;
constexpr size_t WS_WOUT  = WS_WATT + (size_t)2048 * 1024 * 2;
constexpr size_t WS_WSC   = WS_WOUT + (size_t)2048 * 2048 * 2;
constexpr size_t WS_H     = WS_WSC + (size_t)2048 * 2048 * 2;
constexpr size_t WS_PA    = WS_H + (size_t)T_TOK * 2048 * 2;
constexpr size_t WS_PG    = WS_PA + (size_t)T_TOK * 4096 * 2;
constexpr size_t WS_E     = WS_PG + (size_t)T_TOK * 4096 * 2;
constexpr size_t WS_YA    = WS_E + (size_t)2 * 64 * 128 * 64 * 8;
constexpr size_t WS_ATT   = WS_YA + (size_t)T_TOK * 1024 * 2;
constexpr size_t WS_UB    = WS_ATT + (size_t)T_TOK * 1024 * 2;
constexpr size_t WS_SA    = WS_UB + (size_t)T_TOK * 1024 * 2;
constexpr size_t WS_SB    = WS_SA + (size_t)T_TOK * 4;
constexpr size_t WS_CMAXP = WS_SB + (size_t)8192 * 4;
constexpr size_t WS_END   = WS_CMAXP + (size_t)32 * 8192 * 4;
constexpr size_t WS_SC    = WS_PA;
constexpr size_t WS_UT    = WS_PG;
constexpr size_t WS_VT    = WS_PG + (size_t)16384 * 1536;

constexpr int LDS_MAIN = 131072, LDS_BYTES = LDS_MAIN + 256;

typedef __bf16 bf16x2_t __attribute__((ext_vector_type(2)));
__device__ __forceinline__ unsigned cvt_pk_bf16(float lo, float hi) { const f32x2 v = {lo, hi}; return __builtin_bit_cast(unsigned, __builtin_convertvector(v, bf16x2_t)); }
__device__ __forceinline__ float bf_lo(unsigned w) { return __uint_as_float(w << 16); }
__device__ __forceinline__ float bf_hi(unsigned w) { return __uint_as_float(w & 0xffff0000u); }
__device__ __forceinline__ float wave_sum(float v) {
#pragma unroll
    for (int o = 1; o < 64; o <<= 1) v += __shfl_xor(v, o);
    return v;
}
__device__ __forceinline__ float sigmoidf_(float x) { return 1.0f / (1.0f + __expf(-x)); }
__device__ __forceinline__ float gelu_tanh(float x) {
    const float a = 0.7978845608028654f * (x + 0.044715f * x * x * x);
    const float t = 1.0f - 2.0f / (__expf(2.0f * a) + 1.0f);
    return 0.5f * x * (1.0f + t);
}
constexpr float F8_SA = 8.0f, F8_SW = 64.0f, F8_INV = 1.0f / 512.0f;
__device__ __forceinline__ unsigned pack4_fp8(float a, float b, float c, float d, float sc) {
    a = fminf(fmaxf(a * sc, -448.f), 448.f); b = fminf(fmaxf(b * sc, -448.f), 448.f); c = fminf(fmaxf(c * sc, -448.f), 448.f); d = fminf(fmaxf(d * sc, -448.f), 448.f);
    int p = 0; p = __builtin_amdgcn_cvt_pk_fp8_f32(a, b, p, false); p = __builtin_amdgcn_cvt_pk_fp8_f32(c, d, p, true); return (unsigned)p; }
#define LDS_WAIT() asm volatile("s_waitcnt lgkmcnt(0)" ::: "memory")
__device__ __forceinline__ int opaque_tid() { int t = threadIdx.x; asm volatile("" : "+v"(t)); return t; }

#define XB_TMO      128
#define XB_XCNT(j)  (256  + 64 * (j))
#define XB_XSUB(j)  (1280 + 64 * (j))
#define XB_XGEN(j)  (2304 + 64 * (j))
#define XB_TOP      3328
#define XB_TOPGEN   3392
#define XCD_BAR_WORDS 3456
#define XB_SPIN_CAP (1u << 22)
__device__ __forceinline__ unsigned xb_ld(unsigned* p)              { return __hip_atomic_load(p, __ATOMIC_RELAXED, __HIP_MEMORY_SCOPE_AGENT); }
__device__ __forceinline__ unsigned xb_add(unsigned* p, unsigned v) { return __hip_atomic_fetch_add(p, v, __ATOMIC_RELAXED, __HIP_MEMORY_SCOPE_AGENT); }
__device__ __forceinline__ unsigned xb_xcc_id() { return (unsigned)__builtin_amdgcn_s_getreg((3 << 11) | 20) & 0xFu; }
#define XB_SPIN(cond, bar) do { unsigned _sp = 0; while (cond) { __builtin_amdgcn_s_sleep(1); \
    if ((++_sp & 255u) == 0u) { if (xb_ld(&(bar)[XB_TMO])) break; if (_sp > XB_SPIN_CAP) { atomicAdd(&(bar)[XB_TMO], 1u); break; } } } } while (0)
struct XcdBarrier { unsigned* bar; unsigned x; volatile LAS unsigned* st; };
__device__ __forceinline__ XcdBarrier xcd_barrier_post(unsigned* bar, volatile LAS unsigned* st) {
    XcdBarrier b; b.bar = bar; b.x = xb_xcc_id(); b.st = st;
    if (threadIdx.x == 0) (void)xb_add(&bar[XB_XCNT(b.x)], 1u);
    return b;
}
__device__ __forceinline__ void xcd_barrier_complete(unsigned* bar, unsigned x, unsigned& nloc, unsigned& nx) {
    const unsigned G = gridDim.x * gridDim.y * gridDim.z;
    unsigned sum, cnt, mine, sp = 0u;
    for (;;) {
        sum = 0u; cnt = 0u; mine = 0u;
#pragma unroll
        for (unsigned j = 0; j < 16; ++j) { const unsigned c = xb_ld(&bar[XB_XCNT(j)]); sum += c; cnt += (c > 0u) ? 1u : 0u; mine = (j == x) ? c : mine; }
        if (sum == G) break;
        __builtin_amdgcn_s_sleep(1);
        if ((++sp & 255u) == 0u) { if (xb_ld(&bar[XB_TMO])) break; if (sp > XB_SPIN_CAP) { atomicAdd(&bar[XB_TMO], 1u); break; } }
    }
    nloc = mine > 0u ? mine : 1u; nx = cnt > 0u ? cnt : 1u;
}
__device__ __forceinline__ void xcd_barrier(const XcdBarrier& b) {
    asm volatile("s_waitcnt vmcnt(0)" ::: "memory");
    __syncthreads();
    if (threadIdx.x == 0) {
        unsigned* bar = b.bar;
        __builtin_amdgcn_s_waitcnt(0);
        unsigned nloc = b.st[0], nx = b.st[1];
        if (nloc == 0u) { xcd_barrier_complete(bar, b.x, nloc, nx); b.st[0] = nloc; b.st[1] = nx; }
        const unsigned old = xb_add(&bar[XB_XSUB(b.x)], 1u);
        const unsigned gen = old / nloc;
        if (old + 1u == (gen + 1u) * nloc) {
            __builtin_amdgcn_fence(__ATOMIC_RELEASE, "agent");
            asm volatile("s_waitcnt vmcnt(0)" ::: "memory");
            const unsigned og = xb_add(&bar[XB_TOP], 1u);
            const unsigned tg = og / nx;
            if (og + 1u == (tg + 1u) * nx) xb_add(&bar[XB_TOPGEN], 1u);
            else XB_SPIN(xb_ld(&bar[XB_TOPGEN]) == tg, bar);
            __builtin_amdgcn_fence(__ATOMIC_ACQUIRE, "agent");
            xb_add(&bar[XB_XGEN(b.x)], 1u);
            asm volatile("s_waitcnt vmcnt(0)" ::: "memory");
        } else {
            XB_SPIN(xb_ld(&bar[XB_XGEN(b.x)]) == gen, bar);
            __builtin_amdgcn_fence(__ATOMIC_ACQUIRE, "agent");
            asm volatile("s_waitcnt vmcnt(0)" ::: "memory");
        }
    }
    __syncthreads();
}

namespace pg8 {
constexpr int BM = 256, BK = 64, HALF = 128, HTB = HALF * BK * 2, STAGE_BYTES = 8 * HTB, NXCD = 8, WGM = 8;
__host__ __device__ __forceinline__ int lds_byte(int r, int c) { const int st = (r >> 4) * 2 + (c >> 5), rr = r & 15, cc = c & 31, ob = rr * 64 + cc * 2; return st * 1024 + (ob ^ (((ob >> 9) & 1) << 5)); }
__host__ __device__ __forceinline__ void stage_rc(int b, int& R, int& C) { const int st = b / 1024, sb = b % 1024, swz = sb ^ (((sb >> 9) & 1) << 5); R = (st >> 1) * 16 + swz / 64; C = (st & 1) * 32 + (swz % 64) / 2; }
__host__ __device__ __forceinline__ int perm32(int rho) { const int n = rho >> 4, i = rho & 15; return 8 * (i >> 2) + 4 * n + (i & 3); }
struct Unit { int pm, pn; };
struct Gemm { const bf16_t* A; const bf16_t* Bt; int M, N, K; };
struct StaticOrder {
    int nM, nN, nwg, G, c;
    __host__ __device__ void init(int M, int N, int G_, int c_) { nM = M / BM; nN = N / BM; nwg = nM * nN; G = G_; c = c_; }
    __host__ __device__ bool next(int i, Unit& u) const { return at((long)i * G + c, u); }
    __host__ __device__ bool at(long L, Unit& u) const {
        if (L >= nwg) return false;
        int wgid = (int)L; { const int q = nwg / NXCD, r = nwg % NXCD, xcd = wgid % NXCD, off = wgid / NXCD; wgid = (xcd < r ? xcd * (q + 1) : r * (q + 1) + (xcd - r) * q) + off; }
        const int nig = WGM * nN, gid = wgid / nig, fm = gid * WGM, gsz = (nM - fm) < WGM ? (nM - fm) : WGM;
        u.pm = fm + ((wgid % nig) % gsz); u.pn = (wgid % nig) / gsz; return true;
    }
    __device__ __forceinline__ void a_ready(const Unit&) const {}
    __device__ __forceinline__ void done(const Unit&) const {}
};
struct SplitOrder {
    StaticOrder b;
    __host__ __device__ void init(int M, int N, int G_, int c_) { b.init(M, N, G_, c_); }
    __host__ __device__ bool next(int i, Unit& u) const {
        if (b.G != 256 || b.nwg != 512) return b.next(i, u);
        if (b.c < 128) return i < 1 ? b.at(b.c, u) : false;
        return i < 3 ? b.at(128 + (b.c - 128) * 3 + i, u) : false;
    }
    __device__ __forceinline__ void a_ready(const Unit&) const {}
    __device__ __forceinline__ void done(const Unit&) const {}
};
typedef int i32x8 __attribute__((ext_vector_type(8)));
template <class Epi, class Sched, bool ALIGN_EPI = false, bool SP2 = false, int MODE = 0>
__device__ __forceinline__ void gemm_phase(LAS unsigned char* lds, const Gemm g, const Sched& S, const Epi& E) {
    const int tid = threadIdx.x, wid = __builtin_amdgcn_readfirstlane(tid >> 6), lane = tid & 63, wr = wid >> 2, wc = wid & 3, fr = lane & 15, fq = lane >> 4;
    const int K = g.K, nt = K / BK;
    unsigned voffA[2], voffB[2];
#pragma unroll
    for (int i = 0; i < 2; ++i) { int R, C; stage_rc(tid * 16 + i * 8192, R, C); const int Rb = Epi::PERM ? ((R & ~31) + perm32(R & 31)) : R;
        voffA[i] = (unsigned)(R * K + C) * 2u; voffB[i] = (unsigned)(Rb * K + C) * 2u; }
    const size_t kstep = (size_t)(BK * 2);
    const size_t hstep = (size_t)HALF * K * 2;
    const size_t tstep = 2 * hstep;
    const unsigned ldsw = (unsigned)wid * 1024u;
    const int aoff = lds_byte(wr * 64 + fr, fq * 8), boff = lds_byte(wc * 32 + fr, fq * 8);
#define PG8_SA(b, h) (((b) * 2 + (h)) * HTB)
#define PG8_SB(b, h) ((4 + (b) * 2 + (h)) * HTB)
#define PG8_STAGE(bufoff, gbase, voff) do { _Pragma("unroll") for (int _i = 0; _i < 2; ++_i) \
        __builtin_amdgcn_global_load_lds((const unsigned*)((const char*)(gbase) + (voff)[_i]), (LAS unsigned*)(lds + (bufoff) + ldsw + _i * 8192), 16, 0, 0); } while (0)
#define PG8_LD8(p_) ({ const i32x4 _lo = *(const LAS i32x4*)(p_), _hi = *(const LAS i32x4*)((p_) + 1024); (i32x8){_lo[0], _lo[1], _lo[2], _lo[3], _hi[0], _hi[1], _hi[2], _hi[3]}; })
#define PG8_LDA(dst, b, h) do { _Pragma("unroll") for (int m = 0; m < 4; ++m) dst[m] = PG8_LD8(lds + PG8_SA(b, h) + aoff + m * 2048); } while (0)
#define PG8_LDB(dst, b, h) do { _Pragma("unroll") for (int n = 0; n < 2; ++n) dst[n] = PG8_LD8(lds + PG8_SB(b, h) + boff + n * 2048); } while (0)
#define PG8_HALF(v, k) ((k) == 0 ? __builtin_shufflevector(v, v, 0, 1, 2, 3) : __builtin_shufflevector(v, v, 4, 5, 6, 7))
#define PG8_MMA(ai, bj, At, Bt) do { __builtin_amdgcn_s_setprio(1); _Pragma("unroll") for (int m = 0; m < 4; ++m) _Pragma("unroll") for (int n = 0; n < 2; ++n) { \
        if (MODE == 2) asm volatile("v_mfma_scale_f32_16x16x128_f8f6f4 %0, %1, %2, %0, %3, %3 op_sel_hi:[0,0,0]" : "+v"(acc[ai][bj][m][n]) : "v"(Bt[n]), "v"(At[m]), "v"(scl1)); \
        else { _Pragma("unroll") for (int k = 0; k < 2; ++k) \
            acc[ai][bj][m][n] = (MODE == 1) ? __builtin_bit_cast(f32x4, __builtin_amdgcn_mfma_i32_16x16x64_i8(PG8_HALF(Bt[n], k), PG8_HALF(At[m], k), __builtin_bit_cast(i32x4, acc[ai][bj][m][n]), 0, 0, 0)) \
                                            : __builtin_amdgcn_mfma_f32_16x16x32_bf16(__builtin_bit_cast(bf16x8, PG8_HALF(Bt[n], k)), __builtin_bit_cast(bf16x8, PG8_HALF(At[m], k)), acc[ai][bj][m][n], 0, 0, 0); } } __builtin_amdgcn_s_setprio(0); } while (0)
#define PG8_WAIT_V(n) asm volatile("s_waitcnt vmcnt(" #n ")" ::: "memory")
#define PG8_WAIT_L(n) asm volatile("s_waitcnt lgkmcnt(" #n ")" ::: "memory")
#define PG8_BAR __builtin_amdgcn_s_barrier()
#define PG8_SCHED __builtin_amdgcn_sched_barrier(0)
    const int scl1 = 0x7f7f7f7f;
    Unit cur, nxt; int ui = 0;
    if (!S.next(0, cur)) return;
    f32x4 acc[2][2][4][2];
#pragma unroll
    for (int a = 0; a < 2; ++a)
#pragma unroll
        for (int b = 0; b < 2; ++b)
#pragma unroll
            for (int m = 0; m < 4; ++m)
#pragma unroll
                for (int n = 0; n < 2; ++n) acc[a][b][m][n] = (f32x4){0.f, 0.f, 0.f, 0.f};
    i32x8 At[4], B0[2], B1[2];
    const char* cA = (const char*)g.A + (size_t)cur.pm * tstep; const char* cB = (const char*)g.Bt + (size_t)cur.pn * tstep;
    S.a_ready(cur);
    if constexpr (SP2) {
        PG8_STAGE(PG8_SB(0, 0), cB, voffB); PG8_STAGE(PG8_SB(0, 1), cB + hstep, voffB); PG8_STAGE(PG8_SA(0, 0), cA, voffA); PG8_STAGE(PG8_SA(0, 1), cA + hstep, voffA);
        if (wr == 1) PG8_BAR;
        PG8_WAIT_V(2); PG8_BAR;
        PG8_STAGE(PG8_SB(1, 0), cB + kstep, voffB); PG8_STAGE(PG8_SA(1, 0), cA + kstep, voffA); PG8_STAGE(PG8_SB(1, 1), cB + hstep + kstep, voffB);
        PG8_WAIT_V(6); PG8_BAR;
    } else {
        PG8_STAGE(PG8_SB(0, 0), cB, voffB); PG8_STAGE(PG8_SA(0, 0), cA, voffA); PG8_STAGE(PG8_SB(0, 1), cB + hstep, voffB); PG8_STAGE(PG8_SA(0, 1), cA + hstep, voffA);
        if (wr == 1) PG8_BAR;
        PG8_WAIT_V(4); PG8_BAR;
        PG8_STAGE(PG8_SB(1, 0), cB + kstep, voffB); PG8_STAGE(PG8_SA(1, 0), cA + kstep, voffA); PG8_STAGE(PG8_SB(1, 1), cB + hstep + kstep, voffB);
        PG8_WAIT_V(6); PG8_BAR;
    }
    for (;;) {
        const bool has_next = S.next(ui + 1, nxt);
        const char* nA = has_next ? (const char*)g.A + (size_t)nxt.pm * tstep : cA; const char* nB = has_next ? (const char*)g.Bt + (size_t)nxt.pn * tstep : cB;
#pragma unroll 1
        for (int t = 0; t < nt; t += 2) {
            const bool last = (t == nt - 2);
            const char* a1 = cA + (size_t)(t + 1) * kstep;
            const char* a2 = last ? nA : cA + (size_t)(t + 2) * kstep; const char* b2 = last ? nB : cB + (size_t)(t + 2) * kstep;
            const char* a3 = a2 + kstep; const char* b3 = b2 + kstep;
            if (last && has_next) S.a_ready(nxt);
            if constexpr (SP2) {
            PG8_LDB(B0, 0, 0); PG8_LDB(B1, 0, 1); PG8_SCHED; PG8_LDA(At, 0, 0); PG8_STAGE(PG8_SA(1, 1), a1 + hstep, voffA);
            PG8_WAIT_V(8); PG8_WAIT_L(0); PG8_BAR; PG8_MMA(0, 0, At, B0); PG8_MMA(0, 1, At, B1); PG8_BAR; PG8_SCHED;
            PG8_LDA(At, 0, 1); PG8_STAGE(PG8_SB(0, 0), b2, voffB); PG8_STAGE(PG8_SB(0, 1), b2 + hstep, voffB); PG8_STAGE(PG8_SA(0, 0), a2, voffA);
            PG8_WAIT_V(8); PG8_WAIT_L(0); PG8_BAR; PG8_MMA(1, 0, At, B0); PG8_MMA(1, 1, At, B1); PG8_BAR; PG8_SCHED;
            PG8_LDB(B0, 1, 0); PG8_LDB(B1, 1, 1); PG8_SCHED; PG8_LDA(At, 1, 0); PG8_STAGE(PG8_SA(0, 1), a2 + hstep, voffA);
            PG8_WAIT_V(8); PG8_WAIT_L(0); PG8_BAR; PG8_MMA(0, 0, At, B0); PG8_MMA(0, 1, At, B1); PG8_BAR; PG8_SCHED;
            PG8_LDA(At, 1, 1); PG8_STAGE(PG8_SB(1, 0), b3, voffB); PG8_STAGE(PG8_SB(1, 1), b3 + hstep, voffB); PG8_STAGE(PG8_SA(1, 0), a3, voffA);
            PG8_WAIT_V(8); PG8_WAIT_L(0); PG8_BAR; PG8_MMA(1, 0, At, B0); PG8_MMA(1, 1, At, B1); PG8_BAR; PG8_SCHED;
            } else {
            PG8_LDB(B0, 0, 0); PG8_SCHED; PG8_LDA(At, 0, 0); PG8_STAGE(PG8_SA(1, 1), a1 + hstep, voffA);
            PG8_WAIT_L(8); PG8_BAR; PG8_WAIT_L(0); PG8_MMA(0, 0, At, B0); PG8_BAR; PG8_SCHED;
            PG8_LDB(B1, 0, 1); PG8_STAGE(PG8_SB(0, 0), b2, voffB);
            PG8_BAR; PG8_WAIT_L(0); PG8_MMA(0, 1, At, B1); PG8_BAR;
            PG8_LDA(At, 0, 1); PG8_STAGE(PG8_SA(0, 0), a2, voffA);
            PG8_BAR; PG8_WAIT_L(0); PG8_MMA(1, 0, At, B0); PG8_BAR; PG8_SCHED;
            PG8_STAGE(PG8_SB(0, 1), b2 + hstep, voffB);
            PG8_WAIT_V(6); PG8_BAR; PG8_MMA(1, 1, At, B1); PG8_BAR;
            PG8_LDB(B0, 1, 0); PG8_SCHED; PG8_LDA(At, 1, 0); PG8_STAGE(PG8_SA(0, 1), a2 + hstep, voffA);
            PG8_WAIT_L(8); PG8_BAR; PG8_WAIT_L(0); PG8_MMA(0, 0, At, B0); PG8_BAR; PG8_SCHED;
            PG8_LDB(B1, 1, 1); PG8_STAGE(PG8_SB(1, 0), b3, voffB);
            PG8_BAR; PG8_WAIT_L(0); PG8_MMA(0, 1, At, B1); PG8_BAR;
            PG8_LDA(At, 1, 1); PG8_STAGE(PG8_SA(1, 0), a3, voffA);
            PG8_BAR; PG8_WAIT_L(0); PG8_MMA(1, 0, At, B0); PG8_BAR; PG8_SCHED;
            PG8_STAGE(PG8_SB(1, 1), b3 + hstep, voffB);
            PG8_WAIT_V(6); PG8_BAR; PG8_MMA(1, 1, At, B1); PG8_BAR;
            }
        }
        if constexpr (ALIGN_EPI) { if (wr == 0) PG8_BAR; }
        if (MODE == 2) asm volatile("s_nop 15\n\ts_nop 15" ::: "memory");
        E(acc, cur, wr, wc, fr, fq); S.done(cur);
        if (!has_next) break;
#pragma unroll
        for (int a = 0; a < 2; ++a)
#pragma unroll
            for (int b = 0; b < 2; ++b)
#pragma unroll
                for (int m = 0; m < 4; ++m)
#pragma unroll
                    for (int n = 0; n < 2; ++n) acc[a][b][m][n] = (f32x4){0.f, 0.f, 0.f, 0.f};
        cur = nxt; cA = nA; cB = nB; ++ui;
        if constexpr (ALIGN_EPI) { if (wr == 1) PG8_BAR; }
    }
    PG8_WAIT_V(0);
    if constexpr (!ALIGN_EPI) { if (wr == 0) PG8_BAR; }
    PG8_BAR;
#undef PG8_SA
#undef PG8_SB
#undef PG8_STAGE
#undef PG8_LDA
#undef PG8_LDB
#undef PG8_MMA
#undef PG8_WAIT_V
#undef PG8_WAIT_L
#undef PG8_BAR
#undef PG8_SCHED
}

struct EpiProj {
    static constexpr bool PERM = true;
    bf16_t* PA; bf16_t* PG; bf16_t* UB; const float* SA; const float* SB;
    __device__ __forceinline__ void operator()(const f32x4 (&acc)[2][2][4][2], const Unit& u, int wr, int wc, int fr, int fq) const {
        const int row0 = u.pm * BM + wr * 64 + fr; int colt = u.pn * BM; const bool isu = colt < 1024; bf16_t* base = colt < 4096 ? PA : PG;
        const int gcol0 = colt + wc * 32 + 8 * fq; colt &= 4095;
        const int col0 = colt + wc * 32 + 8 * fq;
        f32x4 sb[2][2];
#pragma unroll
        for (int bj = 0; bj < 2; ++bj) { sb[bj][0] = *(const f32x4*)(SB + gcol0 + bj * HALF); sb[bj][1] = *(const f32x4*)(SB + gcol0 + bj * HALF + 4); }
#pragma unroll
        for (int ai = 0; ai < 2; ++ai)
#pragma unroll
            for (int m = 0; m < 4; ++m) { const int row = row0 + ai * HALF + m * 16; bf16_t* rowp = base + (size_t)row * 4096 + col0; const float sa = SA[row];
#pragma unroll
                for (int bj = 0; bj < 2; ++bj) { const i32x4 i0 = __builtin_bit_cast(i32x4, acc[ai][bj][m][0]), i1 = __builtin_bit_cast(i32x4, acc[ai][bj][m][1]);
                    f32x4 v0, v1;
#pragma unroll
                    for (int e = 0; e < 4; ++e) { v0[e] = (float)i0[e] * sa * sb[bj][0][e]; v1[e] = (float)i1[e] * sa * sb[bj][1][e]; }
                    u32x4 w; w.x = cvt_pk_bf16(v0[0], v0[1]); w.y = cvt_pk_bf16(v0[2], v0[3]); w.z = cvt_pk_bf16(v1[0], v1[1]); w.w = cvt_pk_bf16(v1[2], v1[3]);
                    if (isu) { const int cu = col0 + bj * HALF; *(u32x4*)(UB + (((size_t)((row >> 13) * 64 + (cu >> 4)) * 8192 + (row & 8191)) * 16 + (cu & 8))) = w; }
                    else *(u32x4*)(rowp + bj * HALF) = w; } }
    }
};
struct EpiAttUp {
    static constexpr bool PERM = true;
    const bf16_t* PG; bf16_t* HB;
    __device__ __forceinline__ void operator()(const f32x4 (&acc)[2][2][4][2], const Unit& u, int wr, int wc, int fr, int fq) const {
        const int row0 = u.pm * BM + wr * 64 + fr; const int col0 = u.pn * BM + wc * 32 + 8 * fq;
#pragma unroll
        for (int ai = 0; ai < 2; ++ai)
#pragma unroll
            for (int m = 0; m < 4; ++m) { const size_t row = (size_t)(row0 + ai * HALF + m * 16);
#pragma unroll
                for (int bj = 0; bj < 2; ++bj) { const int col = col0 + bj * HALF;
                    const u32x4 gw = *(const u32x4*)(PG + row * 4096 + 2048 + col);
                    const f32x4 v0 = acc[ai][bj][m][0] * F8_INV, v1 = acc[ai][bj][m][1] * F8_INV;
                    u32x4 w;
                    w.x = cvt_pk_bf16(v0[0] * sigmoidf_(bf_lo(gw.x)), v0[1] * sigmoidf_(bf_hi(gw.x)));
                    w.y = cvt_pk_bf16(v0[2] * sigmoidf_(bf_lo(gw.y)), v0[3] * sigmoidf_(bf_hi(gw.y)));
                    w.z = cvt_pk_bf16(v1[0] * sigmoidf_(bf_lo(gw.z)), v1[1] * sigmoidf_(bf_hi(gw.z)));
                    w.w = cvt_pk_bf16(v1[2] * sigmoidf_(bf_lo(gw.w)), v1[3] * sigmoidf_(bf_hi(gw.w)));
                    *(u32x4*)(HB + row * 2048 + col) = w; } asm volatile("" ::: "memory"); }
    }
};
struct EpiGlu {
    static constexpr bool PERM = true;
    const bf16_t* PG; const bf16_t* HB; unsigned char* M8;
    __device__ __forceinline__ void operator()(const f32x4 (&acc)[2][2][4][2], const Unit& u, int wr, int wc, int fr, int fq) const {
        const int row0 = u.pm * BM + wr * 64 + fr; const int col = u.pn * HALF + wc * 32 + 8 * fq;
#pragma unroll
        for (int ai = 0; ai < 2; ++ai)
#pragma unroll
            for (int m = 0; m < 4; ++m) { const size_t row = (size_t)(row0 + ai * HALF + m * 16);
                const u32x4 gw = *(const u32x4*)(PG + row * 4096 + col);
                const u32x4 aw = *(const u32x4*)(HB + row * 2048 + col);
                const f32x4 a0 = acc[ai][0][m][0] * F8_INV, a1 = acc[ai][0][m][1] * F8_INV, g0 = acc[ai][1][m][0] * F8_INV, g1 = acc[ai][1][m][1] * F8_INV;
                u32x2 w;
                w.x = pack4_fp8(sigmoidf_(bf_lo(gw.x)) * a0[0] * sigmoidf_(g0[0]) + bf_lo(aw.x), sigmoidf_(bf_hi(gw.x)) * a0[1] * sigmoidf_(g0[1]) + bf_hi(aw.x),
                                sigmoidf_(bf_lo(gw.y)) * a0[2] * sigmoidf_(g0[2]) + bf_lo(aw.y), sigmoidf_(bf_hi(gw.y)) * a0[3] * sigmoidf_(g0[3]) + bf_hi(aw.y), F8_SA);
                w.y = pack4_fp8(sigmoidf_(bf_lo(gw.z)) * a1[0] * sigmoidf_(g1[0]) + bf_lo(aw.z), sigmoidf_(bf_hi(gw.z)) * a1[1] * sigmoidf_(g1[1]) + bf_hi(aw.z),
                                sigmoidf_(bf_lo(gw.w)) * a1[2] * sigmoidf_(g1[2]) + bf_lo(aw.w), sigmoidf_(bf_hi(gw.w)) * a1[3] * sigmoidf_(g1[3]) + bf_hi(aw.w), F8_SA);
                *(u32x2*)(M8 + row * 2048 + col) = w; asm volatile("" ::: "memory"); }
    }
};
struct EpiOut {
    static constexpr bool PERM = true;
    const float* X; float* O; const float* mod;
    __device__ __forceinline__ void operator()(const f32x4 (&acc)[2][2][4][2], const Unit& u, int wr, int wc, int fr, int fq) const {
        const int row0 = u.pm * BM + wr * 64 + fr; const int col0 = u.pn * BM + wc * 32 + 8 * fq;
        const float* gt = mod + (size_t)((u.pm * BM) >> 13) * 12288 + 4096;
#pragma unroll
        for (int bj = 0; bj < 2; ++bj) { const int col = col0 + bj * HALF;
            const f32x4 g0 = *(const f32x4*)(gt + col), g1 = *(const f32x4*)(gt + col + 4);
#pragma unroll
            for (int ai = 0; ai < 2; ++ai)
#pragma unroll
                for (int m = 0; m < 4; ++m) { const size_t off = (size_t)(row0 + ai * HALF + m * 16) * 2048 + col;
                    const f32x4 x0 = *(const f32x4*)(X + off), x1 = *(const f32x4*)(X + off + 4);
                    *(f32x4*)(O + off) = x0 + g0 * (acc[ai][bj][m][0] * F8_INV); *(f32x4*)(O + off + 4) = x1 + g1 * (acc[ai][bj][m][1] * F8_INV); } }
    }
};
struct EpiF32 {
    static constexpr bool PERM = true;
    float* O;
    __device__ __forceinline__ void operator()(const f32x4 (&acc)[2][2][4][2], const Unit& u, int wr, int wc, int fr, int fq) const {
        const int row0 = u.pm * BM + wr * 64 + fr; const int col0 = u.pn * BM + wc * 32 + 8 * fq;
#pragma unroll
        for (int ai = 0; ai < 2; ++ai)
#pragma unroll
            for (int m = 0; m < 4; ++m) { float* rowp = O + (size_t)(row0 + ai * HALF + m * 16) * 2048 + col0;
#pragma unroll
                for (int bj = 0; bj < 2; ++bj) { *(f32x4*)(rowp + bj * HALF) = acc[ai][bj][m][0]; *(f32x4*)(rowp + bj * HALF + 4) = acc[ai][bj][m][1]; } }
    }
};
}

struct Args { const float* in[25]; float* out; unsigned char* ws; int ph_lo, ph_hi; };
enum { I_X = 0, I_C, I_WADA, I_BADA, I_N1G, I_WIN, I_LRE, I_LIM, I_LDT, I_BRE, I_BIM, I_CRE, I_CIM, I_SD, I_WGLU, I_QNG, I_KNG, I_WATT, I_WOUT, I_N2G, I_WQ, I_K1, I_K2, I_PU, I_PV };

__device__ __forceinline__ void ph_mod_partial(const float* __restrict__ c, const float* __restrict__ w_ada, float* modp, int gw, int ngw, int lane) {
    for (int task = gw; task < 48 * 32; task += ngw) {
        const int strip = task % 48, ks = task / 48, n0 = strip * 256 + lane * 4, k0 = ks * 64;
        f32x4 a0 = {0.f, 0.f, 0.f, 0.f}, a1 = {0.f, 0.f, 0.f, 0.f};
#pragma unroll 8
        for (int k = 0; k < 64; ++k) {
            const f32x4 w = *(const f32x4*)(w_ada + (size_t)(k0 + k) * 12288 + n0);
            float c0 = c[k0 + k], c1 = c[2048 + k0 + k];
            c0 = c0 / (1.0f + __expf(-c0)); c1 = c1 / (1.0f + __expf(-c1));
            a0 += c0 * w; a1 += c1 * w;
        }
        *(f32x4*)(modp + (size_t)(ks * 2 + 0) * 12288 + n0) = a0;
        *(f32x4*)(modp + (size_t)(ks * 2 + 1) * 12288 + n0) = a1;
    }
}

__device__ __forceinline__ void ph_colmax_partial(const float* __restrict__ w_in, float* cmaxp, int gw, int ngw, int lane) {
    for (int task = gw; task < 32 * 32; task += ngw) {
        const int strip = task & 31, ks = task >> 5, n0 = strip * 256 + lane * 4, k0 = ks * 64;
        f32x4 m = {0.f, 0.f, 0.f, 0.f};
#pragma unroll 8
        for (int k = 0; k < 64; ++k) { const f32x4 w = *(const f32x4*)(w_in + (size_t)(k0 + k) * 8192 + n0);
            m[0] = fmaxf(m[0], fabsf(w[0])); m[1] = fmaxf(m[1], fabsf(w[1])); m[2] = fmaxf(m[2], fabsf(w[2])); m[3] = fmaxf(m[3], fabsf(w[3])); }
        *(f32x4*)(cmaxp + (size_t)ks * 8192 + n0) = m;
    }
}

__device__ __forceinline__ void transpose_item_f8(const float* __restrict__ W, int K, int N, unsigned char* WT8, int drow0, int scol0, int k0, LAS float* scr, int lane) {
#pragma unroll 8
    for (int i = 0; i < 32; ++i) { const int kk = 2 * i + (lane >> 5); scr[kk * 33 + (lane & 31)] = W[(size_t)(k0 + kk) * N + scol0 + (lane & 31)]; }
    LDS_WAIT();
    const int n = lane >> 1, half = lane & 1;
    const LAS float* s = scr + (32 * half) * 33 + n;
    u32x4 o[2];
#pragma unroll
    for (int q = 0; q < 8; ++q) o[q >> 2][q & 3] = pack4_fp8(s[(4 * q) * 33], s[(4 * q + 1) * 33], s[(4 * q + 2) * 33], s[(4 * q + 3) * 33], F8_SW);
    *(u32x4*)(WT8 + (size_t)(drow0 + n) * K + k0 + 32 * half) = o[0];
    *(u32x4*)(WT8 + (size_t)(drow0 + n) * K + k0 + 32 * half + 16) = o[1];
    LDS_WAIT();
}
__device__ __forceinline__ void transpose_item_i8(const float* __restrict__ W, signed char* WT8, const float* cmaxp, float* SB, int n0, int k0, LAS float* scr, int lane) {
#pragma unroll 8
    for (int i = 0; i < 32; ++i) { const int kk = 2 * i + (lane >> 5); scr[kk * 33 + (lane & 31)] = W[(size_t)(k0 + kk) * 8192 + n0 + (lane & 31)]; }
    const int n = lane >> 1, half = lane & 1;
    float cm = 0.f;
#pragma unroll 8
    for (int ks = 0; ks < 32; ++ks) cm = fmaxf(cm, cmaxp[(size_t)ks * 8192 + n0 + n]);
    const float sb = fmaxf(cm, 1e-30f) * (1.0f / 127.0f), inv = 1.0f / sb;
    if (k0 == 0 && half == 0) SB[n0 + n] = sb;
    LDS_WAIT();
    const LAS float* s = scr + (32 * half) * 33 + n;
    u32x4 o[2];
#pragma unroll
    for (int q = 0; q < 8; ++q) { unsigned w = 0;
#pragma unroll
        for (int e = 0; e < 4; ++e) { const int v = (int)rintf(s[(4 * q + e) * 33] * inv); w |= ((unsigned)v & 0xffu) << (8 * e); }
        o[q >> 2][q & 3] = w; }
    *(u32x4*)(WT8 + (size_t)(n0 + n) * 2048 + k0 + 32 * half) = o[0];
    *(u32x4*)(WT8 + (size_t)(n0 + n) * 2048 + k0 + 32 * half + 16) = o[1];
    LDS_WAIT();
}

__device__ __forceinline__ void transpose_item(const float* __restrict__ W, int K, int N, bf16_t* WT, int drow0, int scol0, int k0, LAS float* scr, int lane) {
#pragma unroll 8
    for (int i = 0; i < 32; ++i) { const int kk = 2 * i + (lane >> 5); scr[kk * 33 + (lane & 31)] = W[(size_t)(k0 + kk) * N + scol0 + (lane & 31)]; }
    LDS_WAIT();
    const int c = lane & 7;
#pragma unroll
    for (int j = 0; j < 4; ++j) { const int n = (lane >> 3) + 8 * j; const LAS float* s = scr + (8 * c) * 33 + n;
        u32x4 o; o.x = cvt_pk_bf16(s[0 * 33], s[1 * 33]); o.y = cvt_pk_bf16(s[2 * 33], s[3 * 33]); o.z = cvt_pk_bf16(s[4 * 33], s[5 * 33]); o.w = cvt_pk_bf16(s[6 * 33], s[7 * 33]);
        *(u32x4*)(WT + (size_t)(drow0 + n) * K + k0 + 8 * c) = o; }
    LDS_WAIT();
}
__device__ __forceinline__ void wsc_item(const float* wq, const float* kk, bf16_t* out, int lane) {
    const int r = lane & 15, q = lane >> 4;
    f32x4 acc[8];
#pragma unroll
    for (int f = 0; f < 8; ++f) acc[f] = (f32x4){0.f, 0.f, 0.f, 0.f};
    const float* ap = kk + r * 128 + 4 * q; const float* bp = wq + (size_t)r * 2048 + 4 * q;
#pragma unroll 2
    for (int d0 = 0; d0 < 128; d0 += 16) {
        const f32x4 bv = *(const f32x4*)(bp + d0);
        f32x4 av[8];
#pragma unroll
        for (int f = 0; f < 8; ++f) av[f] = *(const f32x4*)(ap + f * 2048 + d0);
#pragma unroll
        for (int j = 0; j < 4; ++j)
#pragma unroll
            for (int f = 0; f < 8; ++f) acc[f] = __builtin_amdgcn_mfma_f32_16x16x4f32(av[f][j], bv[j], acc[f], 0, 0, 0);
    }
#pragma unroll
    for (int f = 0; f < 8; ++f)
#pragma unroll
        for (int i = 0; i < 4; ++i) out[(size_t)(16 * f + 4 * q + i) * 2048 + r] = (bf16_t)(cvt_pk_bf16(acc[f][i], 0.f) & 0xffffu);
}
__device__ __forceinline__ void ph_prologue(const Args& a, LAS unsigned char* lds, int gw, int ngw, int lane, int wave) {
    unsigned char* ws = a.ws;
    { const float* modp = (const float*)(ws + WS_MODP); float* mod = (float*)(ws + WS_MOD); const float* b_ada = a.in[I_BADA];
      for (int idx = gw * 64 + lane; idx < 2 * 12288; idx += ngw * 64) { const int b = idx / 12288, n = idx - b * 12288; float s = b_ada[n];
#pragma unroll 8
          for (int ks = 0; ks < 32; ++ks) s += modp[(size_t)(ks * 2 + b) * 12288 + n];
          mod[idx] = s; } }
    for (int item = gw; item < 2048; item += ngw) { const int hj = item >> 7, k0 = (item & 127) * 16;
        wsc_item(a.in[I_WQ] + (size_t)k0 * 2048 + hj * 128, (hj & 1) ? a.in[I_K2] : a.in[I_K1], (bf16_t*)(ws + WS_WSC) + (size_t)(hj * 128) * 2048 + k0, lane); }
    { LAS float* scr = (LAS float*)(lds + wave * 8448);
      constexpr int I_IN = 32 * 256, I_GLU = 16 * 128, I_ATT = 16 * 64, I_OUT = 32 * 64, NIT = I_IN + I_GLU + I_ATT + I_OUT;
      for (int it = gw; it < NIT; it += ngw) {
          int r = it;
          if (r < I_IN) { const int kb = r / 256, nb = r % 256; transpose_item_i8(a.in[I_WIN], (signed char*)(ws + WS_WIN), (const float*)(ws + WS_CMAXP), (float*)(ws + WS_SB), 32 * nb, 64 * kb, scr, lane); continue; } r -= I_IN;
          if (r < I_GLU) { const int kb = r / 128, nb = r % 128, dr = 32 * nb; const int sc = ((dr >> 7) & 1) * 2048 + (dr >> 8) * 128 + (dr & 127);
              transpose_item_f8(a.in[I_WGLU], 1024, 4096, ws + WS_WGLU, dr, sc, 64 * kb, scr, lane); continue; } r -= I_GLU;
          if (r < I_ATT) { const int kb = r / 64, nb = r % 64; transpose_item_f8(a.in[I_WATT], 1024, 2048, ws + WS_WATT, 32 * nb, 32 * nb, 64 * kb, scr, lane); continue; } r -= I_ATT;
          { const int kb = r / 64, nb = r % 64; transpose_item_f8(a.in[I_WOUT], 2048, 2048, ws + WS_WOUT, 32 * nb, 32 * nb, 64 * kb, scr, lane); }
      } }
}

template <bool I8>
__device__ __forceinline__ void ph_norm(const float* X, bf16_t* Hout, float* SA, const float* __restrict__ g, const float* mod, int sh_off, int sc_off, int gw, int ngw, int lane) {
    for (int row = gw; row < T_TOK; row += ngw) {
        const int b = row >> 13;
        const f32x4* xr = (const f32x4*)(X + (size_t)row * DM) + lane;
        f32x4 v[8]; float ss = 0.f;
#pragma unroll
        for (int j = 0; j < 8; ++j) { v[j] = xr[64 * j]; ss += (v[j][0] * v[j][0] + v[j][1] * v[j][1]) + (v[j][2] * v[j][2] + v[j][3] * v[j][3]); }
        ss = wave_sum(ss);
        const float rs = 1.0f / sqrtf(ss * (1.0f / DM) + EPS);
        const float* mb = mod + (size_t)b * 12288;
        float amax = 0.f;
#pragma unroll
        for (int j = 0; j < 8; ++j) { const int col = 4 * (lane + 64 * j);
            const f32x4 gv = *(const f32x4*)(g + col), sc = *(const f32x4*)(mb + sc_off + col), sh = *(const f32x4*)(mb + sh_off + col);
            const f32x4 o = v[j] * rs * gv * (sc + 1.0f) + sh;
            if (I8) { v[j] = o; amax = fmaxf(fmaxf(amax, fmaxf(fabsf(o[0]), fabsf(o[1]))), fmaxf(fabsf(o[2]), fabsf(o[3]))); }
            else { u32x2 w; w.x = cvt_pk_bf16(o[0], o[1]); w.y = cvt_pk_bf16(o[2], o[3]); *(u32x2*)(Hout + (size_t)row * DM + col) = w; } }
        if (I8) {
#pragma unroll
            for (int o = 1; o < 64; o <<= 1) amax = fmaxf(amax, __shfl_xor(amax, o));
            const float sa = fmaxf(amax, 1e-30f) * (1.0f / 127.0f), inv = 1.0f / sa;
            if (lane == 0) SA[row] = sa;
            unsigned* h8 = (unsigned*)((signed char*)Hout + (size_t)row * DM) + lane;
#pragma unroll
            for (int j = 0; j < 8; ++j) { unsigned w = 0;
#pragma unroll
                for (int e = 0; e < 4; ++e) { const int q = (int)rintf(v[j][e] * inv); w |= ((unsigned)q & 0xffu) << (8 * e); }
                h8[64 * j] = w; }
        }
    }
}

template <int MODE>
__device__ __forceinline__ void ph_attn(LAS unsigned char* lds, const bf16_t* PA, bf16_t* ATT, const float* __restrict__ qg, const float* __restrict__ kg, int G) {
    const int tid = opaque_tid(), lane = tid & 63, wave = __builtin_amdgcn_readfirstlane(tid >> 6), c = lane & 15, g = lane >> 4;
    LAS unsigned char* KL = lds;
    LAS unsigned char* VT = lds + 17408;
    bf16x8 tri[6];
    { const int FS[6] = {0, 1, 0, 1, 2, 3}, FP[6] = {0, 0, 1, 1, 1, 1};
#pragma unroll
      for (int q = 0; q < 6; ++q)
#pragma unroll
          for (int jj = 0; jj < 8; ++jj) { const int kap = 32 * FP[q] + 16 * (jj >> 2) + 4 * g + (jj & 3); tri[q][jj] = (kap > 16 * FS[q] + c) ? (short)0x3F80 : (short)0; } }
    for (int u = blockIdx.x; u < 1024; u += G) {
        const int b = u >> 9, h = (u >> 6) & 7, qb = u & 63, t0 = qb * 128, tq0 = t0 + 16 * wave, tq = tq0 + c;
        bf16x8 qf[4];
        { const bf16_t* qrow = PA + (size_t)(b * SEQ + tq) * 4096 + 1024 + h * 128;
          u32x4 qr[4]; float ss = 0.f;
#pragma unroll
          for (int kk = 0; kk < 4; ++kk) { qr[kk] = *(const u32x4*)(qrow + 32 * kk + 8 * g);
#pragma unroll
              for (int e = 0; e < 4; ++e) { const float lo = bf_lo(qr[kk][e]), hi = bf_hi(qr[kk][e]); ss += lo * lo + hi * hi; } }
          ss += __shfl_xor(ss, 16); ss += __shfl_xor(ss, 32);
          const float rs = (1.0f / sqrtf(ss * (1.0f / 128.0f) + EPS)) * 0.08838834764831845f;
#pragma unroll
          for (int kk = 0; kk < 4; ++kk) { const f32x4 g0 = *(const f32x4*)(qg + 32 * kk + 8 * g), g1 = *(const f32x4*)(qg + 32 * kk + 8 * g + 4);
              u32x4 w;
              w.x = cvt_pk_bf16(bf_lo(qr[kk].x) * rs * g0[0], bf_hi(qr[kk].x) * rs * g0[1]);
              w.y = cvt_pk_bf16(bf_lo(qr[kk].y) * rs * g0[2], bf_hi(qr[kk].y) * rs * g0[3]);
              w.z = cvt_pk_bf16(bf_lo(qr[kk].z) * rs * g1[0], bf_hi(qr[kk].z) * rs * g1[1]);
              w.w = cvt_pk_bf16(bf_lo(qr[kk].w) * rs * g1[2], bf_hi(qr[kk].w) * rs * g1[3]);
              qf[kk] = __builtin_bit_cast(bf16x8, w); } }
        float carry = 0.f; int wdone = 0;
        f32x4 oacc[8];
#pragma unroll
        for (int fd = 0; fd < 8; ++fd) oacc[fd] = (f32x4){0.f, 0.f, 0.f, 0.f};
        u32x4 kreg[2], vreg[2];
        { const int k0n = (2 * qb + 1) * 64;
#pragma unroll
          for (int p = 0; p < 2; ++p) { const int ci = tid + 512 * p, key = ci >> 4, ch = ci & 15;
              kreg[p] = *(const u32x4*)(PA + (size_t)(b * SEQ + k0n + key) * 4096 + 2048 + h * 128 + 8 * ch);
              vreg[p] = *(const u32x4*)(PA + (size_t)(b * SEQ + k0n + lane) * 4096 + 3072 + h * 128 + 8 * (wave + 8 * p)); } }
        for (int kt = 2 * qb + 1; kt >= 0; --kt) {
            const int k0 = kt * 64;
            if (__syncthreads_and(wdone)) break;
#pragma unroll
            for (int p = 0; p < 2; ++p) {
                const int ci = tid + 512 * p, key = ci >> 4, ch = ci & 15;
                const u32x4 kr = kreg[p];
                float f[8]; f[0] = bf_lo(kr.x); f[1] = bf_hi(kr.x); f[2] = bf_lo(kr.y); f[3] = bf_hi(kr.y); f[4] = bf_lo(kr.z); f[5] = bf_hi(kr.z); f[6] = bf_lo(kr.w); f[7] = bf_hi(kr.w);
                float ss = 0.f;
#pragma unroll
                for (int e = 0; e < 8; ++e) ss += f[e] * f[e];
                ss += __shfl_xor(ss, 1); ss += __shfl_xor(ss, 2); ss += __shfl_xor(ss, 4); ss += __shfl_xor(ss, 8);
                const float rs = 1.0f / sqrtf(ss * (1.0f / 128.0f) + EPS);
                const f32x4 g0 = *(const f32x4*)(kg + 8 * ch), g1 = *(const f32x4*)(kg + 8 * ch + 4);
                u32x4 w;
                w.x = cvt_pk_bf16(f[0] * rs * g0[0], f[1] * rs * g0[1]); w.y = cvt_pk_bf16(f[2] * rs * g0[2], f[3] * rs * g0[3]);
                w.z = cvt_pk_bf16(f[4] * rs * g1[0], f[5] * rs * g1[1]); w.w = cvt_pk_bf16(f[6] * rs * g1[2], f[7] * rs * g1[3]);
                *(LAS u32x4*)(KL + key * 272 + ch * 16) = w;
            }
#pragma unroll
            for (int p = 0; p < 2; ++p) {
                const int key = lane, ch = wave + 8 * p;
                const u32x4 vr = vreg[p];
                LAS unsigned short* vt = (LAS unsigned short*)(VT + (8 * ch) * 144 + key * 2);
                vt[0 * 72] = (unsigned short)(vr.x & 0xffffu); vt[1 * 72] = (unsigned short)(vr.x >> 16);
                vt[2 * 72] = (unsigned short)(vr.y & 0xffffu); vt[3 * 72] = (unsigned short)(vr.y >> 16);
                vt[4 * 72] = (unsigned short)(vr.z & 0xffffu); vt[5 * 72] = (unsigned short)(vr.z >> 16);
                vt[6 * 72] = (unsigned short)(vr.w & 0xffffu); vt[7 * 72] = (unsigned short)(vr.w >> 16);
            }
            if (kt > 0) { const int k0n = k0 - 64;
#pragma unroll
                for (int p = 0; p < 2; ++p) { const int ci = tid + 512 * p, key = ci >> 4, ch = ci & 15;
                    kreg[p] = *(const u32x4*)(PA + (size_t)(b * SEQ + k0n + key) * 4096 + 2048 + h * 128 + 8 * ch);
                    vreg[p] = *(const u32x4*)(PA + (size_t)(b * SEQ + k0n + lane) * 4096 + 3072 + h * 128 + 8 * (wave + 8 * p)); } }
            __syncthreads();
            if (MODE == 1) { if (kt <= 2 * qb - 3) wdone = 1; }
            if (MODE == 0 && !wdone && k0 < tq0 + 15) {
                f32x4 zt[4];
#pragma unroll
                for (int f = 0; f < 4; ++f) { f32x4 acc = {0.f, 0.f, 0.f, 0.f};
#pragma unroll
                    for (int kk = 0; kk < 4; ++kk) { const bf16x8 kf = *(const LAS bf16x8*)(KL + (16 * f + c) * 272 + (32 * kk + 8 * g) * 2);
                        acc = __builtin_amdgcn_mfma_f32_16x16x32_bf16(kf, qf[kk], acc, 0, 0, 0); }
                    zt[f] = acc; }
                float lf[4][4], lz[4][4]; float tot = 0.f;
#pragma unroll
                for (int f = 0; f < 4; ++f)
#pragma unroll
                    for (int i = 0; i < 4; ++i) { const int s = k0 + 16 * f + 4 * g + i; const bool valid = s < tq; const float z = zt[f][i];
                        const float sp = fmaxf(z, 0.f) + __logf(1.0f + __expf(-fabsf(z)));
                        const float l = valid ? -sp : 0.f; lf[f][i] = l; lz[f][i] = valid ? (l + z) : -INFINITY; tot += l; }
                tot += __shfl_xor(tot, 16); tot += __shfl_xor(tot, 32);
                bf16x8 lh[2], ll[2];
#pragma unroll
                for (int fp = 0; fp < 2; ++fp) { u32x4 wh, wl;
#pragma unroll
                    for (int q = 0; q < 2; ++q) { const int f = 2 * fp + q;
                        const unsigned h0 = cvt_pk_bf16(lf[f][0], lf[f][1]), h1 = cvt_pk_bf16(lf[f][2], lf[f][3]);
                        const unsigned l0 = cvt_pk_bf16(lf[f][0] - bf_lo(h0), lf[f][1] - bf_hi(h0)), l1 = cvt_pk_bf16(lf[f][2] - bf_lo(h1), lf[f][3] - bf_hi(h1));
                        wh[2 * q] = h0; wh[2 * q + 1] = h1; wl[2 * q] = l0; wl[2 * q + 1] = l1; }
                    lh[fp] = __builtin_bit_cast(bf16x8, wh); ll[fp] = __builtin_bit_cast(bf16x8, wl); }
                f32x4 sf[4];
                { f32x4 z4 = {0.f, 0.f, 0.f, 0.f};
                  sf[0] = __builtin_amdgcn_mfma_f32_16x16x32_bf16(tri[0], lh[0], z4, 0, 0, 0); sf[0] = __builtin_amdgcn_mfma_f32_16x16x32_bf16(tri[0], ll[0], sf[0], 0, 0, 0);
                  sf[0] = __builtin_amdgcn_mfma_f32_16x16x32_bf16(tri[2], lh[1], sf[0], 0, 0, 0); sf[0] = __builtin_amdgcn_mfma_f32_16x16x32_bf16(tri[2], ll[1], sf[0], 0, 0, 0);
                  sf[1] = __builtin_amdgcn_mfma_f32_16x16x32_bf16(tri[1], lh[0], z4, 0, 0, 0); sf[1] = __builtin_amdgcn_mfma_f32_16x16x32_bf16(tri[1], ll[0], sf[1], 0, 0, 0);
                  sf[1] = __builtin_amdgcn_mfma_f32_16x16x32_bf16(tri[3], lh[1], sf[1], 0, 0, 0); sf[1] = __builtin_amdgcn_mfma_f32_16x16x32_bf16(tri[3], ll[1], sf[1], 0, 0, 0);
                  sf[2] = __builtin_amdgcn_mfma_f32_16x16x32_bf16(tri[4], lh[1], z4, 0, 0, 0); sf[2] = __builtin_amdgcn_mfma_f32_16x16x32_bf16(tri[4], ll[1], sf[2], 0, 0, 0);
                  sf[3] = __builtin_amdgcn_mfma_f32_16x16x32_bf16(tri[5], lh[1], z4, 0, 0, 0); sf[3] = __builtin_amdgcn_mfma_f32_16x16x32_bf16(tri[5], ll[1], sf[3], 0, 0, 0); }
                bf16x8 pb[2];
#pragma unroll
                for (int fp = 0; fp < 2; ++fp) { u32x4 w;
#pragma unroll
                    for (int q = 0; q < 2; ++q) { const int f = 2 * fp + q; float p[4];
#pragma unroll
                        for (int i = 0; i < 4; ++i) p[i] = __expf(lz[f][i] + sf[f][i] + carry);
                        w[2 * q] = cvt_pk_bf16(p[0], p[1]); w[2 * q + 1] = cvt_pk_bf16(p[2], p[3]); }
                    pb[fp] = __builtin_bit_cast(bf16x8, w); }
                carry += tot;
#pragma unroll
                for (int fd = 0; fd < 8; ++fd)
#pragma unroll
                    for (int fp = 0; fp < 2; ++fp) { const LAS unsigned char* vp = VT + (16 * fd + c) * 144 + (32 * fp + 4 * g) * 2;
                        const u32x2 v0 = *(const LAS u32x2*)vp, v1 = *(const LAS u32x2*)(vp + 32);
                        u32x4 vw; vw.x = v0.x; vw.y = v0.y; vw.z = v1.x; vw.w = v1.y;
                        oacc[fd] = __builtin_amdgcn_mfma_f32_16x16x32_bf16(__builtin_bit_cast(bf16x8, vw), pb[fp], oacc[fd], 0, 0, 0); }
                wdone = (__ballot(carry >= -105.0f) == 0ull) ? 1 : 0;
            }
        }
        if (MODE == 0) { unsigned char* orow = (unsigned char*)ATT + (size_t)(b * SEQ + tq) * 1024 + h * 128 + 4 * g;
#pragma unroll
          for (int fd = 0; fd < 8; ++fd) *(unsigned*)(orow + 16 * fd) = pack4_fp8(oacc[fd][0], oacc[fd][1], oacc[fd][2], oacc[fd][3], F8_SA); }
    }
    __syncthreads();
}

__device__ __forceinline__ void ssm_lambda(const Args& a, int g, int st, float& lbr, float& lbi, float& qr, float& qi) {
    const float lr = a.in[I_LRE][g * 64 + st], li = a.in[I_LIM][g * 64 + st], dt = __expf(a.in[I_LDT][g]);
    const float mag = __expf(lr * dt);
    float rev = li * dt * 0.15915494309189535f; rev -= rintf(rev);
    lbr = mag * __builtin_amdgcn_cosf(rev); lbi = mag * __builtin_amdgcn_sinf(rev);
    const float nr = lbr - 1.0f, ni = lbi, den = 1.0f / (lr * lr + li * li);
    qr = (nr * lr + ni * li) * den; qi = (ni * lr - nr * li) * den;
}
template <bool WITH_Y>
__device__ __forceinline__ void ph_ssm_mfma(const Args& a, LAS unsigned char* lds, const bf16_t* UB, f32x2* E, bf16_t* YA, int G) {
    const int tid = opaque_tid(), lane = tid & 63, wave = __builtin_amdgcn_readfirstlane(tid >> 6), c = lane & 15, gl = lane >> 4;
    LAS f32x2* sl = (LAS f32x2*)(lds + wave * 8192);
    LAS f32x4* tab = (LAS f32x4*)(lds + 65536 + wave * 1024);
    LAS u32x4* cml = (LAS u32x4*)(lds + 73728 + wave * 5120) + lane;
    for (int item = blockIdx.x; item < 128; item += G) {
        const int b = item >> 6, cb = (item >> 3) & 7, g = (item & 7) * 8 + wave, c0 = cb * 16;
        float mur, mui;
        { float lbr, lbi, qr, qi; ssm_lambda(a, g, lane, lbr, lbi, qr, qi); tab[lane] = (f32x4){lbr, lbi, qr, qi}; mur = lbr; mui = lbi; }
        LDS_WAIT();
        bf16x8 bm[8];
        const float* brb = a.in[I_BRE] + (g * 64 + (c >> 1)) * 16 + 8 * (gl & 1); const float* bib = a.in[I_BIM] + (g * 64 + (c >> 1)) * 16 + 8 * (gl & 1);
        const LAS f32x4* tabb = tab + (c >> 1);
#pragma unroll
        for (int f = 0; f < 8; ++f) { const f32x4 tv = tabb[8 * f]; const float qr = tv[2], qi = tv[3];
            const float* br = brb + 128 * f; const float* bim = bib + 128 * f;
            const f32x4 r0 = *(const f32x4*)br, r1 = *(const f32x4*)(br + 4), i0 = *(const f32x4*)bim, i1 = *(const f32x4*)(bim + 4);
            float v[8];
#pragma unroll
            for (int e = 0; e < 4; ++e) { const float vr0 = qr * r0[e] - qi * i0[e], vi0 = qr * i0[e] + qi * r0[e], vr1 = qr * r1[e] - qi * i1[e], vi1 = qr * i1[e] + qi * r1[e];
                v[e] = (c & 1) ? vi0 : vr0; v[4 + e] = (c & 1) ? vi1 : vr1; }
            if (gl >= 2) {
#pragma unroll
                for (int e = 0; e < 8; ++e) v[e] = 0.f; }
            u32x4 w; w.x = cvt_pk_bf16(v[0], v[1]); w.y = cvt_pk_bf16(v[2], v[3]); w.z = cvt_pk_bf16(v[4], v[5]); w.w = cvt_pk_bf16(v[6], v[7]);
            bm[f] = __builtin_bit_cast(bf16x8, w); }
        float lmr[16], lmi[16];
#pragma unroll
        for (int k = 0; k < 16; ++k) { const f32x4 tv = tab[2 * gl + 8 * (k >> 1) + (k & 1)]; lmr[k] = tv[0]; lmi[k] = tv[1]; }
        if (WITH_Y) {
            const float* crb = a.in[I_CRE] + (g * 16 + c) * 64 + 2 * gl; const float* cib = a.in[I_CIM] + (g * 16 + c) * 64 + 2 * gl;
#pragma unroll
            for (int kk = 0; kk < 4; ++kk) { float v[8];
#pragma unroll
                for (int jh = 0; jh < 2; ++jh) { const f32x2 r = *(const f32x2*)(crb + 8 * (2 * kk + jh)), m = *(const f32x2*)(cib + 8 * (2 * kk + jh));
                    v[4 * jh] = r.x; v[4 * jh + 1] = -m.x; v[4 * jh + 2] = r.y; v[4 * jh + 3] = -m.y; }
                u32x4 w; w.x = cvt_pk_bf16(v[0], v[1]); w.y = cvt_pk_bf16(v[2], v[3]); w.z = cvt_pk_bf16(v[4], v[5]); w.w = cvt_pk_bf16(v[6], v[7]);
                cml[64 * kk] = w; }
            { const float dv = a.in[I_SD][g * 16 + c]; float v[8];
#pragma unroll
              for (int jj = 0; jj < 8; ++jj) v[jj] = (gl < 2 && (8 * gl + jj) == c) ? dv : 0.f;
              u32x4 w; w.x = cvt_pk_bf16(v[0], v[1]); w.y = cvt_pk_bf16(v[2], v[3]); w.z = cvt_pk_bf16(v[4], v[5]); w.w = cvt_pk_bf16(v[6], v[7]);
              cml[256] = w; }
        }
        f32x4 s[8];
#pragma unroll
        for (int f = 0; f < 8; ++f) s[f] = (f32x4){0.f, 0.f, 0.f, 0.f};
        if (WITH_Y) {
            float pr = mur, pi = mui;
#pragma unroll
            for (int q = 0; q < 6; ++q) { const float nr = pr * pr - pi * pi, ni = 2.0f * pr * pi; pr = nr; pi = ni; }
            float sr = 0.f, si = 0.f;
            const f32x2* ep = E + (size_t)((b * 64 + g) * 128) * 64 + lane;
            f32x2 ev[8], en[8];
#pragma unroll
            for (int k = 0; k < 8; ++k) ev[k] = ep[(size_t)k * 64];
            for (int cc = 0; cc < c0 + 16; cc += 8) {
                if (cc + 8 < c0 + 16) {
#pragma unroll
                    for (int k = 0; k < 8; ++k) en[k] = ep[(size_t)(cc + 8 + k) * 64]; }
#pragma unroll
                for (int k = 0; k < 8; ++k) { if (cc >= c0) sl[(cc - c0 + k) * 64 + lane] = (f32x2){sr, si};
                    const float nr = pr * sr - pi * si + ev[k][0], ni = pr * si + pi * sr + ev[k][1]; sr = nr; si = ni; }
#pragma unroll
                for (int k = 0; k < 8; ++k) ev[k] = en[k];
            }
            LDS_WAIT();
#pragma unroll
            for (int f = 0; f < 8; ++f) s[f] = *(const LAS f32x4*)(sl + c * 64 + 8 * f + 2 * gl);
            LDS_WAIT();
        }
        const bf16_t* up = UB + ((size_t)(b * 64 + g) * 8192 + (size_t)(c0 + c) * 64) * 16 + 8 * (gl & 1);
        unsigned char* yp = (unsigned char*)YA + (size_t)(b * SEQ + (c0 + c) * 64) * 1024 + g * 16 + 4 * gl;
        u32x4 u0 = *(const u32x4*)(up), u1 = *(const u32x4*)(up + 16), u2 = *(const u32x4*)(up + 32), u3 = *(const u32x4*)(up + 48), u4 = *(const u32x4*)(up + 64), u5 = *(const u32x4*)(up + 80);
#pragma unroll 1
        for (int tau = 0; tau < 64; ++tau) {
            const u32x4 u6 = *(const u32x4*)(up + (size_t)(tau + 6) * 16);
            const bf16x8 uf = __builtin_bit_cast(bf16x8, u0);
#pragma unroll
            for (int f = 0; f < 8; ++f) { f32x4 ci;
                ci[0] = lmr[2 * f] * s[f][0] - lmi[2 * f] * s[f][1]; ci[1] = lmr[2 * f] * s[f][1] + lmi[2 * f] * s[f][0];
                ci[2] = lmr[2 * f + 1] * s[f][2] - lmi[2 * f + 1] * s[f][3]; ci[3] = lmr[2 * f + 1] * s[f][3] + lmi[2 * f + 1] * s[f][2];
                s[f] = __builtin_amdgcn_mfma_f32_16x16x32_bf16(bm[f], uf, ci, 0, 0, 0); }
            if (WITH_Y) {
                f32x4 y = __builtin_amdgcn_mfma_f32_16x16x32_bf16(__builtin_bit_cast(bf16x8, cml[256]), uf, (f32x4){0.f, 0.f, 0.f, 0.f}, 0, 0, 0);
#pragma unroll
                for (int kk = 0; kk < 4; ++kk) { u32x4 w; w.x = cvt_pk_bf16(s[2 * kk][0], s[2 * kk][1]); w.y = cvt_pk_bf16(s[2 * kk][2], s[2 * kk][3]);
                    w.z = cvt_pk_bf16(s[2 * kk + 1][0], s[2 * kk + 1][1]); w.w = cvt_pk_bf16(s[2 * kk + 1][2], s[2 * kk + 1][3]);
                    y = __builtin_amdgcn_mfma_f32_16x16x32_bf16(__builtin_bit_cast(bf16x8, cml[64 * kk]), __builtin_bit_cast(bf16x8, w), y, 0, 0, 0); }
                *(unsigned*)(yp + (size_t)tau * 1024) = pack4_fp8(gelu_tanh(y[0]), gelu_tanh(y[1]), gelu_tanh(y[2]), gelu_tanh(y[3]), F8_SA);
            }
            u0 = u1; u1 = u2; u2 = u3; u3 = u4; u4 = u5; u5 = u6;
        }
        if (!WITH_Y) { f32x2* eo = E + (size_t)((b * 64 + g) * 128 + c0 + c) * 64 + 2 * gl;
#pragma unroll
            for (int f = 0; f < 8; ++f) *(f32x4*)(eo + 8 * f) = s[f]; }
    }
}

#ifndef FP6_INTERLEAVED
#define FP6_INTERLEAVED 1
#endif
typedef float f32x16 __attribute__((ext_vector_type(16)));
typedef float f32x32 __attribute__((ext_vector_type(32)));
typedef unsigned u32x6 __attribute__((ext_vector_type(6)));
constexpr float PEER_SU = 64.0f, PEER_SV = 1.4f;
__device__ __forceinline__ void ph_table_cvt(const float* __restrict__ U, const float* __restrict__ V, unsigned char* UT, unsigned char* VT, int gw, int ngw, int lane) {
    for (int row = gw; row < 2 * 16384; row += ngw) {
        const bool sec = row >= 16384; const int r = sec ? row - 16384 : row; const float sc = sec ? PEER_SV : PEER_SU;
        const float* src = (sec ? V : U) + (size_t)r * 2048 + 4 * lane; unsigned char* dst = (sec ? VT : UT) + (size_t)r * 1536;
        f32x16 a, b;
#pragma unroll
        for (int q = 0; q < 4; ++q) { const f32x4 v0 = *(const f32x4*)(src + 256 * q), v1 = *(const f32x4*)(src + 1024 + 256 * q);
#pragma unroll
            for (int e = 0; e < 4; ++e) { a[4 * q + e] = v0[e] * sc; b[4 * q + e] = v1[e] * sc; } }
        const u32x6 p = __builtin_amdgcn_cvt_scalef32_2xpk16_fp6_f32(a, b, 1.0f);
        *(u32x4*)(dst + 16 * lane) = (u32x4){p[0], p[1], p[2], p[3]};
        *(u32x2*)(dst + 1024 + 8 * lane) = (u32x2){p[4], p[5]};
    }
}

__device__ __forceinline__ void ph_peer(LAS unsigned char* lds, const float* SC, const bf16_t* H2, const unsigned char* UT, const unsigned char* VTb, const float* mod, float* OUT, int G) {
    const int tid = opaque_tid(), lane = tid & 63, wave = __builtin_amdgcn_readfirstlane(tid >> 6);
    LAS float* scr = (LAS float*)(lds + wave * 8448);
    LAS int* idxs = (LAS int*)(lds + 69632 + wave * 4096);
    LAS float* gates = (LAS float*)(lds + 69632 + wave * 4096 + 2048);
    LAS float* dotb = (LAS float*)(lds + 102400 + wave * 1024);
    for (int it = blockIdx.x; it < 512; it += G) {
        const int tokw = it * 32 + wave * 4;
        for (int rep = 0; rep < ((DUP == 101) ? 2 : 1); ++rep) {
        float tk[16];
#pragma unroll
        for (int i = 0; i < 16; ++i) tk[i] = -INFINITY;
        for (int q = 0; q < 4; ++q) {
#pragma unroll
            for (int j = 0; j < 8; ++j) { const int prob = (lane >> 3) + 8 * j, seg = lane & 7;
                const f32x4 v = *(const f32x4*)(SC + (size_t)(tokw + (prob >> 4)) * 2048 + (prob & 15) * 128 + 32 * q + 4 * seg);
                LAS float* d = scr + prob * 33 + 4 * seg; d[0] = v[0]; d[1] = v[1]; d[2] = v[2]; d[3] = v[3]; }
            LDS_WAIT();
#pragma unroll 4
            for (int vi = 0; vi < 32; ++vi) {
                float x = __uint_as_float((__float_as_uint(scr[lane * 33 + vi]) & ~127u) | (unsigned)(127 - (32 * q + vi)));
#pragma unroll
                for (int i = 0; i < 16; ++i) { const float hi = fmaxf(tk[i], x); x = fminf(tk[i], x); tk[i] = hi; }
            }
            LDS_WAIT();
        }
        float t2[16];
#pragma unroll
        for (int i = 0; i < 16; ++i) t2[i] = __shfl_xor(tk[i], 1);
        float bv[16]; int bp[16];
#pragma unroll
        for (int i = 0; i < 16; ++i) { bv[i] = -INFINITY; bp[i] = 0; }
#pragma unroll
        for (int aa = 0; aa < 16; ++aa)
#pragma unroll
            for (int bb = 0; bb < 16 / (aa + 1); ++bb) {
                const unsigned u1 = __float_as_uint(tk[aa]), u2 = __float_as_uint(t2[bb]);
                float x = __uint_as_float(u1 & ~127u) + __uint_as_float(u2 & ~127u);
                int px = (int)(((127u - (u1 & 127u)) << 7) | (127u - (u2 & 127u)));
#pragma unroll
                for (int i = 0; i < 16; ++i) { const bool gt = x > bv[i]; const float nv = gt ? x : bv[i], ox = gt ? bv[i] : x; const int np = gt ? px : bp[i], op = gt ? bp[i] : px;
                    bv[i] = nv; x = ox; bp[i] = np; px = op; }
            }
        { float e[16], sum = 0.f;
#pragma unroll
          for (int i = 0; i < 16; ++i) { e[i] = __expf(bv[i] - bv[0]); sum += e[i]; }
          const float inv = 1.0f / sum;
          if ((lane & 1) == 0) { const int tl = lane >> 4, head = (lane & 15) >> 1;
#pragma unroll
              for (int i = 0; i < 16; ++i) { idxs[tl * 128 + head * 16 + i] = bp[i]; gates[tl * 128 + head * 16 + i] = e[i] * inv; } } }
        LDS_WAIT();
        }
        for (int tl = 0; tl < 4; ++tl) {
            const int token = tokw + tl;
            f32x2 ha[16];
            { const bf16_t* hrow = H2 + (size_t)token * 2048 + 4 * lane;
              u32x2 hw[8];
#pragma unroll
              for (int j = 0; j < 8; ++j) hw[j] = *(const u32x2*)(hrow + 256 * j);
#pragma unroll
              for (int j = 0; j < 4; ++j) { ha[4 * j + 0] = (f32x2){bf_lo(hw[j].x), bf_lo(hw[j + 4].x)}; ha[4 * j + 1] = (f32x2){bf_hi(hw[j].x), bf_hi(hw[j + 4].x)};
                  ha[4 * j + 2] = (f32x2){bf_lo(hw[j].y), bf_lo(hw[j + 4].y)}; ha[4 * j + 3] = (f32x2){bf_hi(hw[j].y), bf_hi(hw[j + 4].y)}; } }
            for (int grp = 0; grp < 16; ++grp) {
                u32x4 b4[8]; u32x2 b2[8];
#pragma unroll
                for (int r = 0; r < 8; ++r) { const int e = __builtin_amdgcn_readfirstlane(idxs[tl * 128 + grp * 8 + r]);
                    const unsigned char* rp = UT + (size_t)e * 1536; b4[r] = *(const u32x4*)(rp + 16 * lane); b2[r] = *(const u32x2*)(rp + 1024 + 8 * lane); }
                float pt[8];
#pragma unroll
                for (int r = 0; r < 8; ++r) { const u32x6 p6 = {b4[r].x, b4[r].y, b4[r].z, b4[r].w, b2[r].x, b2[r].y};
                    const f32x32 uv = __builtin_amdgcn_cvt_scalef32_pk32_f32_fp6(p6, 1.0f); f32x2 s = {0.f, 0.f};
#pragma unroll
                    for (int k = 0; k < 16; ++k) s = (f32x2){uv[2 * k], uv[2 * k + 1]} * ha[k] + s;
                    pt[r] = s.x + s.y; }
                const bool h5 = lane & 32, h4 = lane & 16, h3 = lane & 8; float w4[4], w2[2], w1;
#pragma unroll
                for (int k = 0; k < 4; ++k) { const float keep = h5 ? pt[k + 4] : pt[k], send = h5 ? pt[k] : pt[k + 4]; w4[k] = keep + __shfl_xor(send, 32); }
#pragma unroll
                for (int k = 0; k < 2; ++k) { const float keep = h4 ? w4[k + 2] : w4[k], send = h4 ? w4[k] : w4[k + 2]; w2[k] = keep + __shfl_xor(send, 16); }
                { const float keep = h3 ? w2[1] : w2[0], send = h3 ? w2[0] : w2[1]; w1 = keep + __shfl_xor(send, 8); }
                w1 += __shfl_xor(w1, 4); w1 += __shfl_xor(w1, 2); w1 += __shfl_xor(w1, 1);
                if ((lane & 7) == 0) dotb[grp * 8 + ((lane >> 5) & 1) * 4 + ((lane >> 4) & 1) * 2 + ((lane >> 3) & 1)] = w1;
            }
            LDS_WAIT();
            { const float d0 = dotb[lane] * (1.0f / PEER_SU), d1 = dotb[lane + 64] * (1.0f / PEER_SU);
              const float a0 = gates[tl * 128 + lane] * gelu_tanh(d0) * (1.0f / PEER_SV), a1 = gates[tl * 128 + lane + 64] * gelu_tanh(d1) * (1.0f / PEER_SV);
              LDS_WAIT(); dotb[lane] = a0; dotb[lane + 64] = a1; }
            LDS_WAIT();
#pragma unroll
            for (int i = 0; i < 16; ++i) ha[i] = (f32x2){0.f, 0.f};
            for (int grp = 0; grp < 16; ++grp) {
                u32x4 b4[8]; u32x2 b2[8];
#pragma unroll
                for (int r = 0; r < 8; ++r) { const int e = __builtin_amdgcn_readfirstlane(idxs[tl * 128 + grp * 8 + r]);
                    const unsigned char* rp = VTb + (size_t)e * 1536; b4[r] = *(const u32x4*)(rp + 16 * lane); b2[r] = *(const u32x2*)(rp + 1024 + 8 * lane); }
#pragma unroll
                for (int r = 0; r < 8; ++r) { const float ar = dotb[grp * 8 + r]; const f32x2 a2 = {ar, ar};
                    const u32x6 p6 = {b4[r].x, b4[r].y, b4[r].z, b4[r].w, b2[r].x, b2[r].y};
                    const f32x32 vv = __builtin_amdgcn_cvt_scalef32_pk32_f32_fp6(p6, 1.0f);
#pragma unroll
                    for (int k = 0; k < 16; ++k) ha[k] = (f32x2){vv[2 * k], vv[2 * k + 1]} * a2 + ha[k]; }
            }
            { const int b = token >> 13; const float* gt2 = mod + (size_t)b * 12288 + 10240 + 4 * lane; float* orow = OUT + (size_t)token * 2048 + 4 * lane;
#pragma unroll
              for (int j = 0; j < 4; ++j) { const f32x4 x0 = *(const f32x4*)(orow + 256 * j), x1 = *(const f32x4*)(orow + 1024 + 256 * j);
                  const f32x4 g0 = *(const f32x4*)(gt2 + 256 * j), g1 = *(const f32x4*)(gt2 + 1024 + 256 * j); f32x4 o0, o1;
#pragma unroll
                  for (int e = 0; e < 4; ++e) { o0[e] = x0[e] + g0[e] * ha[4 * j + e].x; o1[e] = x1[e] + g1[e] * ha[4 * j + e].y; }
                  *(f32x4*)(orow + 256 * j) = o0; *(f32x4*)(orow + 1024 + 256 * j) = o1; } }
            LDS_WAIT();
        }
    }
}

__global__ void __launch_bounds__(512, 2) mk_fwd(Args args) {
    extern __shared__ __attribute__((aligned(16))) unsigned char lds_raw[];
    LAS unsigned char* lds = (LAS unsigned char*)lds_raw;
    const int tid = threadIdx.x, lane = tid & 63, wave = __builtin_amdgcn_readfirstlane(tid >> 6);
    const int G = gridDim.x, gw = blockIdx.x * 8 + wave, ngw = G * 8;
    unsigned char* ws = args.ws;
    volatile LAS unsigned* misc = (volatile LAS unsigned*)(lds + LDS_MAIN);
    if (tid < 4) misc[tid] = 0u;
    __syncthreads();
    const int lo = args.ph_lo, hi = args.ph_hi;
    XcdBarrier bar; bar.bar = (unsigned*)(ws + WS_CTL); bar.x = 0; bar.st = misc;
    if (hi - lo > 1) bar = xcd_barrier_post((unsigned*)(ws + WS_CTL), misc);
#ifndef PHMASK
#define PHMASK 0x7ff
#endif
#define IN(k) (((PHMASK >> (k)) & 1) && lo <= (k) && (k) < hi)
#define SEAM(k) do { if (IN(k) && IN((k) + 1)) xcd_barrier(bar); } while (0)
    float* mod = (float*)(ws + WS_MOD);
    bf16_t* HB = (bf16_t*)(ws + WS_H); bf16_t* PA = (bf16_t*)(ws + WS_PA); bf16_t* PG = (bf16_t*)(ws + WS_PG);
    bf16_t* YA = (bf16_t*)(ws + WS_YA); bf16_t* ATT = (bf16_t*)(ws + WS_ATT); f32x2* EB = (f32x2*)(ws + WS_E); bf16_t* UBp = (bf16_t*)(ws + WS_UB);

#define PHS(code, ...) do { __VA_ARGS__ if (DUP == (code)) { xcd_barrier(bar); __VA_ARGS__ } } while (0)
#define PH(k, ...) do { if (IN(k)) { __VA_ARGS__ if (DUP == (k)) { xcd_barrier(bar); __VA_ARGS__ } } } while (0)
    PH(0, { ph_mod_partial(args.in[I_C], args.in[I_WADA], (float*)(ws + WS_MODP), gw, ngw, lane); ph_colmax_partial(args.in[I_WIN], (float*)(ws + WS_CMAXP), gw, ngw, lane); });
    SEAM(0);
    PH(1, { ph_prologue(args, lds, gw, ngw, lane, wave); });
    SEAM(1);
    PH(2, { ph_norm<true>(args.in[I_X], HB, (float*)(ws + WS_SA), args.in[I_N1G], mod, 0, 2048, gw, ngw, lane); });
    SEAM(2);
    PH(3, { pg8::Gemm g{HB, (const bf16_t*)(ws + WS_WIN), T_TOK, 8192, 1024}; pg8::StaticOrder S; S.init(T_TOK, 8192, G, (int)blockIdx.x);
        pg8::EpiProj E{PA, PG, UBp, (const float*)(ws + WS_SA), (const float*)(ws + WS_SB)}; pg8::gemm_phase<pg8::EpiProj, pg8::StaticOrder, true, true, 1>(lds, g, S, E); });
    SEAM(3);
    PH(4, { PHS(41, { ph_attn<0>(lds, PA, ATT, args.in[I_QNG], args.in[I_KNG], G); __syncthreads(); });
        if (DUP == 411) { xcd_barrier(bar); ph_attn<1>(lds, PA, ATT, args.in[I_QNG], args.in[I_KNG], G); __syncthreads(); } PHS(42, { ph_ssm_mfma<false>(args, lds, UBp, EB, YA, G); }); });
    SEAM(4);
    PH(5, { PHS(51, { ph_ssm_mfma<true>(args, lds, UBp, EB, YA, G); __syncthreads(); });
        PHS(52, { pg8::Gemm g{ATT, (const bf16_t*)(ws + WS_WATT), T_TOK, 2048, 512}; pg8::SplitOrder S; S.init(T_TOK, 2048, G, (int)blockIdx.x);
        pg8::EpiAttUp E{PG, HB}; pg8::gemm_phase<pg8::EpiAttUp, pg8::SplitOrder, true, true, 2>(lds, g, S, E); }); });
    SEAM(5);
    PH(6, { pg8::Gemm g{YA, (const bf16_t*)(ws + WS_WGLU), T_TOK, 4096, 512}; pg8::StaticOrder S; S.init(T_TOK, 4096, G, (int)blockIdx.x);
        pg8::EpiGlu E{PG, HB, (unsigned char*)ATT}; pg8::gemm_phase<pg8::EpiGlu, pg8::StaticOrder, true, true, 2>(lds, g, S, E); });
    SEAM(6);
    PH(7, { pg8::Gemm g{ATT, (const bf16_t*)(ws + WS_WOUT), T_TOK, 2048, 1024}; pg8::StaticOrder S; S.init(T_TOK, 2048, G, (int)blockIdx.x);
        pg8::EpiOut E{args.in[I_X], args.out, mod}; pg8::gemm_phase<pg8::EpiOut, pg8::StaticOrder, true, true, 2>(lds, g, S, E);
        ph_table_cvt(args.in[I_PU], args.in[I_PV], ws + WS_UT, ws + WS_VT, gw, ngw, lane); });
    SEAM(7);
    PH(8, { ph_norm<false>(args.out, HB, nullptr, args.in[I_N2G], mod, 6144, 8192, gw, ngw, lane); });
    SEAM(8);
    PH(9, { pg8::Gemm g{HB, (const bf16_t*)(ws + WS_WSC), T_TOK, 2048, 2048}; pg8::StaticOrder S; S.init(T_TOK, 2048, G, (int)blockIdx.x);
        pg8::EpiF32 E{(float*)(ws + WS_SC)}; pg8::gemm_phase<pg8::EpiF32, pg8::StaticOrder, true, true>(lds, g, S, E); });
    SEAM(9);
    PH(10, { ph_peer(lds, (const float*)(ws + WS_SC), HB, ws + WS_UT, ws + WS_VT, mod, args.out, G); });
#undef IN
#undef SEAM
}

extern "C" void kernel_launch(void* const* d_in, const int* in_sizes, int n_in, void* d_out, int out_size, void* d_ws, size_t ws_size, hipStream_t stream) {
    static int grid = 0;
    if (grid == 0) {
        if (n_in != 25 || out_size != T_TOK * DM || ws_size < WS_END) { fprintf(stderr, "kernel_launch: unexpected shapes (n_in %d out %d ws %zu need %zu)\n", n_in, out_size, ws_size, (size_t)WS_END); grid = -1; return; }
        int dev = 0, cus = 0, per_cu = 0;
        if (hipGetDevice(&dev) != hipSuccess || hipDeviceGetAttribute(&cus, hipDeviceAttributeMultiprocessorCount, dev) != hipSuccess) { grid = -1; return; }
        if (hipFuncSetAttribute((const void*)mk_fwd, hipFuncAttributeMaxDynamicSharedMemorySize, LDS_BYTES) != hipSuccess) { fprintf(stderr, "kernel_launch: hipFuncSetAttribute failed\n"); grid = -1; return; }
        if (hipOccupancyMaxActiveBlocksPerMultiprocessor(&per_cu, (const void*)mk_fwd, 512, LDS_BYTES) != hipSuccess || per_cu < 1) { fprintf(stderr, "kernel_launch: occupancy query says %d blocks/CU\n", per_cu); (void)hipGetLastError(); grid = -1; return; }
        grid = cus;
    }
    if (grid < 0) return;
    (void)hipMemsetAsync((char*)d_ws + WS_CTL, 0, 16384, stream);
    Args a{};
    for (int i = 0; i < 25; ++i) a.in[i] = (const float*)d_in[i];
    a.out = (float*)d_out; a.ws = (unsigned char*)d_ws;
#if MK_PER_PHASE
    for (int ph = 0; ph < NPHASE; ++ph) { a.ph_lo = ph; a.ph_hi = ph + 1; hipLaunchKernelGGL(mk_fwd, dim3(grid), dim3(512), LDS_BYTES, stream, a); }
#else
    a.ph_lo = 0; a.ph_hi = NPHASE;
    hipLaunchKernelGGL(mk_fwd, dim3(grid), dim3(512), LDS_BYTES, stream, a);
#endif
}
```

```cpp
#include <hip/hip_runtime.h>
#include <cstdio>
#include <cstdint>

#ifndef MK_PER_PHASE
#define MK_PER_PHASE 0
#endif

#ifndef DUP
#define DUP -1
#endif
#define LAS __attribute__((address_space(3)))
typedef unsigned short bf16_t;
typedef short bf16x8 __attribute__((ext_vector_type(8)));
typedef float f32x4 __attribute__((ext_vector_type(4)));
typedef float f32x2 __attribute__((ext_vector_type(2)));
typedef unsigned u32x4 __attribute__((ext_vector_type(4)));
typedef unsigned u32x2 __attribute__((ext_vector_type(2)));
typedef int i32x4 __attribute__((ext_vector_type(4)));

constexpr int T_TOK = 16384, DM = 2048, SEQ = 8192;
constexpr int NPHASE = 11;
constexpr float EPS = 1e-6f;

constexpr size_t WS_CTL   = 0;
constexpr size_t WS_MODP  = 65536;
constexpr size_t WS_MOD   = WS_MODP + (size_t)32 * 2 * 12288 * 4;
constexpr size_t WS_WIN   = WS_MOD + (size_t)2 * 12288 * 4;
constexpr size_t WS_WGLU  = WS_WIN + (size_t)8192 * 2048 * 2;
constexpr size_t WS_WATT  = WS_WGLU + (size_t)4096 * 1024 * 2;
constexpr size_t WS_WOUT  = WS_WATT + (size_t)2048 * 1024 * 2;
constexpr size_t WS_WSC   = WS_WOUT + (size_t)2048 * 2048 * 2;
constexpr size_t WS_H     = WS_WSC + (size_t)2048 * 2048 * 2;
constexpr size_t WS_PA    = WS_H + (size_t)T_TOK * 2048 * 2;
constexpr size_t WS_PG    = WS_PA + (size_t)T_TOK * 4096 * 2;
constexpr size_t WS_E     = WS_PG + (size_t)T_TOK * 4096 * 2;
constexpr size_t WS_YA    = WS_E + (size_t)2 * 64 * 128 * 64 * 8;
constexpr size_t WS_ATT   = WS_YA + (size_t)T_TOK * 1024 * 2;
constexpr size_t WS_UB    = WS_ATT + (size_t)T_TOK * 1024 * 2;
constexpr size_t WS_SA    = WS_UB + (size_t)T_TOK * 1024 * 2;
constexpr size_t WS_SB    = WS_SA + (size_t)T_TOK * 4;
constexpr size_t WS_CMAXP = WS_SB + (size_t)8192 * 4;
constexpr size_t WS_END   = WS_CMAXP + (size_t)32 * 8192 * 4;
constexpr size_t WS_SC    = WS_PA;
constexpr size_t WS_UT    = WS_PG;
constexpr size_t WS_VT    = WS_PG + (size_t)16384 * 1536;
constexpr size_t WS_VT4   = WS_VT + (size_t)16384 * 1536;

constexpr int LDS_MAIN = 131072, LDS_BYTES = LDS_MAIN + 256;

typedef __bf16 bf16x2_t __attribute__((ext_vector_type(2)));
__device__ __forceinline__ unsigned cvt_pk_bf16(float lo, float hi) { const f32x2 v = {lo, hi}; return __builtin_bit_cast(unsigned, __builtin_convertvector(v, bf16x2_t)); }
__device__ __forceinline__ float bf_lo(unsigned w) { return __uint_as_float(w << 16); }
__device__ __forceinline__ float bf_hi(unsigned w) { return __uint_as_float(w & 0xffff0000u); }
__device__ __forceinline__ float wave_sum(float v) {
#pragma unroll
    for (int o = 1; o < 64; o <<= 1) v += __shfl_xor(v, o);
    return v;
}
__device__ __forceinline__ float sigmoidf_(float x) { return 1.0f / (1.0f + __expf(-x)); }
__device__ __forceinline__ float gelu_tanh(float x) {
    const float a = 0.7978845608028654f * (x + 0.044715f * x * x * x);
    const float t = 1.0f - 2.0f / (__expf(2.0f * a) + 1.0f);
    return 0.5f * x * (1.0f + t);
}
constexpr float F8_SA = 8.0f, F8_SW = 64.0f, F8_INV = 1.0f / 512.0f;
__device__ __forceinline__ unsigned pack4_fp8(float a, float b, float c, float d, float sc) {
    a = fminf(fmaxf(a * sc, -448.f), 448.f); b = fminf(fmaxf(b * sc, -448.f), 448.f); c = fminf(fmaxf(c * sc, -448.f), 448.f); d = fminf(fmaxf(d * sc, -448.f), 448.f);
    int p = 0; p = __builtin_amdgcn_cvt_pk_fp8_f32(a, b, p, false); p = __builtin_amdgcn_cvt_pk_fp8_f32(c, d, p, true); return (unsigned)p; }
#define LDS_WAIT() asm volatile("s_waitcnt lgkmcnt(0)" ::: "memory")
__device__ __forceinline__ int opaque_tid() { int t = threadIdx.x; asm volatile("" : "+v"(t)); return t; }

#define XB_TMO      128
#define XB_XCNT(j)  (256  + 64 * (j))
#define XB_XSUB(j)  (1280 + 64 * (j))
#define XB_XGEN(j)  (2304 + 64 * (j))
#define XB_TOP      3328
#define XB_TOPGEN   3392
#define XCD_BAR_WORDS 3456
#define XB_SPIN_CAP (1u << 22)
__device__ __forceinline__ unsigned xb_ld(unsigned* p)              { return __hip_atomic_load(p, __ATOMIC_RELAXED, __HIP_MEMORY_SCOPE_AGENT); }
__device__ __forceinline__ unsigned xb_add(unsigned* p, unsigned v) { return __hip_atomic_fetch_add(p, v, __ATOMIC_RELAXED, __HIP_MEMORY_SCOPE_AGENT); }
__device__ __forceinline__ unsigned xb_xcc_id() { return (unsigned)__builtin_amdgcn_s_getreg((3 << 11) | 20) & 0xFu; }
#define XB_SPIN(cond, bar) do { unsigned _sp = 0; while (cond) { __builtin_amdgcn_s_sleep(1); \
    if ((++_sp & 255u) == 0u) { if (xb_ld(&(bar)[XB_TMO])) break; if (_sp > XB_SPIN_CAP) { atomicAdd(&(bar)[XB_TMO], 1u); break; } } } } while (0)
struct XcdBarrier { unsigned* bar; unsigned x; volatile LAS unsigned* st; };
__device__ __forceinline__ XcdBarrier xcd_barrier_post(unsigned* bar, volatile LAS unsigned* st) {
    XcdBarrier b; b.bar = bar; b.x = xb_xcc_id(); b.st = st;
    if (threadIdx.x == 0) (void)xb_add(&bar[XB_XCNT(b.x)], 1u);
    return b;
}
__device__ __forceinline__ void xcd_barrier_complete(unsigned* bar, unsigned x, unsigned& nloc, unsigned& nx) {
    const unsigned G = gridDim.x * gridDim.y * gridDim.z;
    unsigned sum, cnt, mine, sp = 0u;
    for (;;) {
        sum = 0u; cnt = 0u; mine = 0u;
#pragma unroll
        for (unsigned j = 0; j < 16; ++j) { const unsigned c = xb_ld(&bar[XB_XCNT(j)]); sum += c; cnt += (c > 0u) ? 1u : 0u; mine = (j == x) ? c : mine; }
        if (sum == G) break;
        __builtin_amdgcn_s_sleep(1);
        if ((++sp & 255u) == 0u) { if (xb_ld(&bar[XB_TMO])) break; if (sp > XB_SPIN_CAP) { atomicAdd(&bar[XB_TMO], 1u); break; } }
    }
    nloc = mine > 0u ? mine : 1u; nx = cnt > 0u ? cnt : 1u;
}
__device__ __forceinline__ void xcd_barrier(const XcdBarrier& b) {
    asm volatile("s_waitcnt vmcnt(0)" ::: "memory");
    __syncthreads();
    if (threadIdx.x == 0) {
        unsigned* bar = b.bar;
        __builtin_amdgcn_s_waitcnt(0);
        unsigned nloc = b.st[0], nx = b.st[1];
        if (nloc == 0u) { xcd_barrier_complete(bar, b.x, nloc, nx); b.st[0] = nloc; b.st[1] = nx; }
        const unsigned old = xb_add(&bar[XB_XSUB(b.x)], 1u);
        const unsigned gen = old / nloc;
        if (old + 1u == (gen + 1u) * nloc) {
            __builtin_amdgcn_fence(__ATOMIC_RELEASE, "agent");
            asm volatile("s_waitcnt vmcnt(0)" ::: "memory");
            const unsigned og = xb_add(&bar[XB_TOP], 1u);
            const unsigned tg = og / nx;
            if (og + 1u == (tg + 1u) * nx) xb_add(&bar[XB_TOPGEN], 1u);
            else XB_SPIN(xb_ld(&bar[XB_TOPGEN]) == tg, bar);
            __builtin_amdgcn_fence(__ATOMIC_ACQUIRE, "agent");
            xb_add(&bar[XB_XGEN(b.x)], 1u);
            asm volatile("s_waitcnt vmcnt(0)" ::: "memory");
        } else {
            XB_SPIN(xb_ld(&bar[XB_XGEN(b.x)]) == gen, bar);
            __builtin_amdgcn_fence(__ATOMIC_ACQUIRE, "agent");
            asm volatile("s_waitcnt vmcnt(0)" ::: "memory");
        }
    }
    __syncthreads();
}

namespace pg8 {
constexpr int BM = 256, BK = 64, HALF = 128, HTB = HALF * BK * 2, STAGE_BYTES = 8 * HTB, NXCD = 8, WGM = 8;
__host__ __device__ __forceinline__ int lds_byte(int r, int c) { const int st = (r >> 4) * 2 + (c >> 5), rr = r & 15, cc = c & 31, ob = rr * 64 + cc * 2; return st * 1024 + (ob ^ (((ob >> 9) & 1) << 5)); }
__host__ __device__ __forceinline__ void stage_rc(int b, int& R, int& C) { const int st = b / 1024, sb = b % 1024, swz = sb ^ (((sb >> 9) & 1) << 5); R = (st >> 1) * 16 + swz / 64; C = (st & 1) * 32 + (swz % 64) / 2; }
__host__ __device__ __forceinline__ int perm32(int rho) { const int n = rho >> 4, i = rho & 15; return 8 * (i >> 2) + 4 * n + (i & 3); }
struct Unit { int pm, pn; };
struct Gemm { const bf16_t* A; const bf16_t* Bt; int M, N, K; };
struct StaticOrder {
    int nM, nN, nwg, G, c;
    __host__ __device__ void init(int M, int N, int G_, int c_) { nM = M / BM; nN = N / BM; nwg = nM * nN; G = G_; c = c_; }
    __host__ __device__ bool next(int i, Unit& u) const { return at((long)i * G + c, u); }
    __host__ __device__ bool at(long L, Unit& u) const {
        if (L >= nwg) return false;
        int wgid = (int)L; { const int q = nwg / NXCD, r = nwg % NXCD, xcd = wgid % NXCD, off = wgid / NXCD; wgid = (xcd < r ? xcd * (q + 1) : r * (q + 1) + (xcd - r) * q) + off; }
        const int nig = WGM * nN, gid = wgid / nig, fm = gid * WGM, gsz = (nM - fm) < WGM ? (nM - fm) : WGM;
        u.pm = fm + ((wgid % nig) % gsz); u.pn = (wgid % nig) / gsz; return true;
    }
    __device__ __forceinline__ void a_ready(const Unit&) const {}
    __device__ __forceinline__ void done(const Unit&) const {}
};
struct SplitOrder {
    StaticOrder b;
    __host__ __device__ void init(int M, int N, int G_, int c_) { b.init(M, N, G_, c_); }
    __host__ __device__ bool next(int i, Unit& u) const {
        if (b.G != 256 || b.nwg != 512) return b.next(i, u);
        if (b.c < 128) return i < 1 ? b.at(b.c, u) : false;
        return i < 3 ? b.at(128 + (b.c - 128) * 3 + i, u) : false;
    }
    __device__ __forceinline__ void a_ready(const Unit&) const {}
    __device__ __forceinline__ void done(const Unit&) const {}
};
typedef int i32x8 __attribute__((ext_vector_type(8)));
template <class Epi, class Sched, bool ALIGN_EPI = false, bool SP2 = false, int MODE = 0>
__device__ __forceinline__ void gemm_phase(LAS unsigned char* lds, const Gemm g, const Sched& S, const Epi& E) {
    const int tid = threadIdx.x, wid = __builtin_amdgcn_readfirstlane(tid >> 6), lane = tid & 63, wr = wid >> 2, wc = wid & 3, fr = lane & 15, fq = lane >> 4;
    const int K = g.K, nt = K / BK;
    unsigned voffA[2], voffB[2];
#pragma unroll
    for (int i = 0; i < 2; ++i) { int R, C; stage_rc(tid * 16 + i * 8192, R, C); const int Rb = Epi::PERM ? ((R & ~31) + perm32(R & 31)) : R;
        voffA[i] = (unsigned)(R * K + C) * 2u; voffB[i] = (unsigned)(Rb * K + C) * 2u; }
    const size_t kstep = (size_t)(BK * 2);
    const size_t hstep = (size_t)HALF * K * 2;
    const size_t tstep = 2 * hstep;
    const unsigned ldsw = (unsigned)wid * 1024u;
    const int aoff = lds_byte(wr * 64 + fr, fq * 8), boff = lds_byte(wc * 32 + fr, fq * 8);
#define PG8_SA(b, h) (((b) * 2 + (h)) * HTB)
#define PG8_SB(b, h) ((4 + (b) * 2 + (h)) * HTB)
#define PG8_STAGE(bufoff, gbase, voff) do { _Pragma("unroll") for (int _i = 0; _i < 2; ++_i) \
        __builtin_amdgcn_global_load_lds((const unsigned*)((const char*)(gbase) + (voff)[_i]), (LAS unsigned*)(lds + (bufoff) + ldsw + _i * 8192), 16, 0, 0); } while (0)
#define PG8_LD8(p_) ({ const i32x4 _lo = *(const LAS i32x4*)(p_), _hi = *(const LAS i32x4*)((p_) + 1024); (i32x8){_lo[0], _lo[1], _lo[2], _lo[3], _hi[0], _hi[1], _hi[2], _hi[3]}; })
#define PG8_LDA(dst, b, h) do { _Pragma("unroll") for (int m = 0; m < 4; ++m) dst[m] = PG8_LD8(lds + PG8_SA(b, h) + aoff + m * 2048); } while (0)
#define PG8_LDB(dst, b, h) do { _Pragma("unroll") for (int n = 0; n < 2; ++n) dst[n] = PG8_LD8(lds + PG8_SB(b, h) + boff + n * 2048); } while (0)
#define PG8_HALF(v, k) ((k) == 0 ? __builtin_shufflevector(v, v, 0, 1, 2, 3) : __builtin_shufflevector(v, v, 4, 5, 6, 7))
#define PG8_MMA(ai, bj, At, Bt) do { __builtin_amdgcn_s_setprio(1); _Pragma("unroll") for (int m = 0; m < 4; ++m) _Pragma("unroll") for (int n = 0; n < 2; ++n) { \
        if (MODE == 2) asm volatile("v_mfma_scale_f32_16x16x128_f8f6f4 %0, %1, %2, %0, %3, %3 op_sel_hi:[0,0,0]" : "+v"(acc[ai][bj][m][n]) : "v"(Bt[n]), "v"(At[m]), "v"(scl1)); \
        else { _Pragma("unroll") for (int k = 0; k < 2; ++k) \
            acc[ai][bj][m][n] = (MODE == 1) ? __builtin_bit_cast(f32x4, __builtin_amdgcn_mfma_i32_16x16x64_i8(PG8_HALF(Bt[n], k), PG8_HALF(At[m], k), __builtin_bit_cast(i32x4, acc[ai][bj][m][n]), 0, 0, 0)) \
                                            : __builtin_amdgcn_mfma_f32_16x16x32_bf16(__builtin_bit_cast(bf16x8, PG8_HALF(Bt[n], k)), __builtin_bit_cast(bf16x8, PG8_HALF(At[m], k)), acc[ai][bj][m][n], 0, 0, 0); } } __builtin_amdgcn_s_setprio(0); } while (0)
#define PG8_WAIT_V(n) asm volatile("s_waitcnt vmcnt(" #n ")" ::: "memory")
#define PG8_WAIT_L(n) asm volatile("s_waitcnt lgkmcnt(" #n ")" ::: "memory")
#define PG8_BAR __builtin_amdgcn_s_barrier()
#define PG8_SCHED __builtin_amdgcn_sched_barrier(0)
    const int scl1 = 0x7f7f7f7f;
    Unit cur, nxt; int ui = 0;
    if (!S.next(0, cur)) return;
    f32x4 acc[2][2][4][2];
#pragma unroll
    for (int a = 0; a < 2; ++a)
#pragma unroll
        for (int b = 0; b < 2; ++b)
#pragma unroll
            for (int m = 0; m < 4; ++m)
#pragma unroll
                for (int n = 0; n < 2; ++n) acc[a][b][m][n] = (f32x4){0.f, 0.f, 0.f, 0.f};
    i32x8 At[4], B0[2], B1[2];
    const char* cA = (const char*)g.A + (size_t)cur.pm * tstep; const char* cB = (const char*)g.Bt + (size_t)cur.pn * tstep;
    S.a_ready(cur);
    if constexpr (SP2) {
        PG8_STAGE(PG8_SB(0, 0), cB, voffB); PG8_STAGE(PG8_SB(0, 1), cB + hstep, voffB); PG8_STAGE(PG8_SA(0, 0), cA, voffA); PG8_STAGE(PG8_SA(0, 1), cA + hstep, voffA);
        if (wr == 1) PG8_BAR;
        PG8_WAIT_V(2); PG8_BAR;
        PG8_STAGE(PG8_SB(1, 0), cB + kstep, voffB); PG8_STAGE(PG8_SA(1, 0), cA + kstep, voffA); PG8_STAGE(PG8_SB(1, 1), cB + hstep + kstep, voffB);
        PG8_WAIT_V(6); PG8_BAR;
    } else {
        PG8_STAGE(PG8_SB(0, 0), cB, voffB); PG8_STAGE(PG8_SA(0, 0), cA, voffA); PG8_STAGE(PG8_SB(0, 1), cB + hstep, voffB); PG8_STAGE(PG8_SA(0, 1), cA + hstep, voffA);
        if (wr == 1) PG8_BAR;
        PG8_WAIT_V(4); PG8_BAR;
        PG8_STAGE(PG8_SB(1, 0), cB + kstep, voffB); PG8_STAGE(PG8_SA(1, 0), cA + kstep, voffA); PG8_STAGE(PG8_SB(1, 1), cB + hstep + kstep, voffB);
        PG8_WAIT_V(6); PG8_BAR;
    }
    for (;;) {
        const bool has_next = S.next(ui + 1, nxt);
        const char* nA = has_next ? (const char*)g.A + (size_t)nxt.pm * tstep : cA; const char* nB = has_next ? (const char*)g.Bt + (size_t)nxt.pn * tstep : cB;
#pragma unroll 1
        for (int t = 0; t < nt; t += 2) {
            const bool last = (t == nt - 2);
            const char* a1 = cA + (size_t)(t + 1) * kstep;
            const char* a2 = last ? nA : cA + (size_t)(t + 2) * kstep; const char* b2 = last ? nB : cB + (size_t)(t + 2) * kstep;
            const char* a3 = a2 + kstep; const char* b3 = b2 + kstep;
            if (last && has_next) S.a_ready(nxt);
            if constexpr (SP2) {
            PG8_LDB(B0, 0, 0); PG8_LDB(B1, 0, 1); PG8_SCHED; PG8_LDA(At, 0, 0); PG8_STAGE(PG8_SA(1, 1), a1 + hstep, voffA);
            PG8_WAIT_V(8); PG8_WAIT_L(0); PG8_BAR; PG8_MMA(0, 0, At, B0); PG8_MMA(0, 1, At, B1); PG8_BAR; PG8_SCHED;
            PG8_LDA(At, 0, 1); PG8_STAGE(PG8_SB(0, 0), b2, voffB); PG8_STAGE(PG8_SB(0, 1), b2 + hstep, voffB); PG8_STAGE(PG8_SA(0, 0), a2, voffA);
            PG8_WAIT_V(8); PG8_WAIT_L(0); PG8_BAR; PG8_MMA(1, 0, At, B0); PG8_MMA(1, 1, At, B1); PG8_BAR; PG8_SCHED;
            PG8_LDB(B0, 1, 0); PG8_LDB(B1, 1, 1); PG8_SCHED; PG8_LDA(At, 1, 0); PG8_STAGE(PG8_SA(0, 1), a2 + hstep, voffA);
            PG8_WAIT_V(8); PG8_WAIT_L(0); PG8_BAR; PG8_MMA(0, 0, At, B0); PG8_MMA(0, 1, At, B1); PG8_BAR; PG8_SCHED;
            PG8_LDA(At, 1, 1); PG8_STAGE(PG8_SB(1, 0), b3, voffB); PG8_STAGE(PG8_SB(1, 1), b3 + hstep, voffB); PG8_STAGE(PG8_SA(1, 0), a3, voffA);
            PG8_WAIT_V(8); PG8_WAIT_L(0); PG8_BAR; PG8_MMA(1, 0, At, B0); PG8_MMA(1, 1, At, B1); PG8_BAR; PG8_SCHED;
            } else {
            PG8_LDB(B0, 0, 0); PG8_SCHED; PG8_LDA(At, 0, 0); PG8_STAGE(PG8_SA(1, 1), a1 + hstep, voffA);
            PG8_WAIT_L(8); PG8_BAR; PG8_WAIT_L(0); PG8_MMA(0, 0, At, B0); PG8_BAR; PG8_SCHED;
            PG8_LDB(B1, 0, 1); PG8_STAGE(PG8_SB(0, 0), b2, voffB);
            PG8_BAR; PG8_WAIT_L(0); PG8_MMA(0, 1, At, B1); PG8_BAR;
            PG8_LDA(At, 0, 1); PG8_STAGE(PG8_SA(0, 0), a2, voffA);
            PG8_BAR; PG8_WAIT_L(0); PG8_MMA(1, 0, At, B0); PG8_BAR; PG8_SCHED;
            PG8_STAGE(PG8_SB(0, 1), b2 + hstep, voffB);
            PG8_WAIT_V(6); PG8_BAR; PG8_MMA(1, 1, At, B1); PG8_BAR;
            PG8_LDB(B0, 1, 0); PG8_SCHED; PG8_LDA(At, 1, 0); PG8_STAGE(PG8_SA(0, 1), a2 + hstep, voffA);
            PG8_WAIT_L(8); PG8_BAR; PG8_WAIT_L(0); PG8_MMA(0, 0, At, B0); PG8_BAR; PG8_SCHED;
            PG8_LDB(B1, 1, 1); PG8_STAGE(PG8_SB(1, 0), b3, voffB);
            PG8_BAR; PG8_WAIT_L(0); PG8_MMA(0, 1, At, B1); PG8_BAR;
            PG8_LDA(At, 1, 1); PG8_STAGE(PG8_SA(1, 0), a3, voffA);
            PG8_BAR; PG8_WAIT_L(0); PG8_MMA(1, 0, At, B0); PG8_BAR; PG8_SCHED;
            PG8_STAGE(PG8_SB(1, 1), b3 + hstep, voffB);
            PG8_WAIT_V(6); PG8_BAR; PG8_MMA(1, 1, At, B1); PG8_BAR;
            }
        }
        if constexpr (ALIGN_EPI) { if (wr == 0) PG8_BAR; }
        if (MODE == 2) asm volatile("s_nop 15\n\ts_nop 15" ::: "memory");
        E(acc, cur, wr, wc, fr, fq); S.done(cur);
        if (!has_next) break;
#pragma unroll
        for (int a = 0; a < 2; ++a)
#pragma unroll
            for (int b = 0; b < 2; ++b)
#pragma unroll
                for (int m = 0; m < 4; ++m)
#pragma unroll
                    for (int n = 0; n < 2; ++n) acc[a][b][m][n] = (f32x4){0.f, 0.f, 0.f, 0.f};
        cur = nxt; cA = nA; cB = nB; ++ui;
        if constexpr (ALIGN_EPI) { if (wr == 1) PG8_BAR; }
    }
    PG8_WAIT_V(0);
    if constexpr (!ALIGN_EPI) { if (wr == 0) PG8_BAR; }
    PG8_BAR;
#undef PG8_SA
#undef PG8_SB
#undef PG8_STAGE
#undef PG8_LDA
#undef PG8_LDB
#undef PG8_MMA
#undef PG8_WAIT_V
#undef PG8_WAIT_L
#undef PG8_BAR
#undef PG8_SCHED
}

struct EpiProj {
    static constexpr bool PERM = true;
    bf16_t* PA; bf16_t* PG; bf16_t* UB; const float* SA; const float* SB;
    __device__ __forceinline__ void operator()(const f32x4 (&acc)[2][2][4][2], const Unit& u, int wr, int wc, int fr, int fq) const {
        const int row0 = u.pm * BM + wr * 64 + fr; int colt = u.pn * BM; const bool isu = colt < 1024; bf16_t* base = colt < 4096 ? PA : PG;
        const int gcol0 = colt + wc * 32 + 8 * fq; colt &= 4095;
        const int col0 = colt + wc * 32 + 8 * fq;
        f32x4 sb[2][2];
#pragma unroll
        for (int bj = 0; bj < 2; ++bj) { sb[bj][0] = *(const f32x4*)(SB + gcol0 + bj * HALF); sb[bj][1] = *(const f32x4*)(SB + gcol0 + bj * HALF + 4); }
#pragma unroll
        for (int ai = 0; ai < 2; ++ai)
#pragma unroll
            for (int m = 0; m < 4; ++m) { const int row = row0 + ai * HALF + m * 16; bf16_t* rowp = base + (size_t)row * 4096 + col0; const float sa = SA[row];
#pragma unroll
                for (int bj = 0; bj < 2; ++bj) { const i32x4 i0 = __builtin_bit_cast(i32x4, acc[ai][bj][m][0]), i1 = __builtin_bit_cast(i32x4, acc[ai][bj][m][1]);
                    f32x4 v0, v1;
#pragma unroll
                    for (int e = 0; e < 4; ++e) { v0[e] = (float)i0[e] * sa * sb[bj][0][e]; v1[e] = (float)i1[e] * sa * sb[bj][1][e]; }
                    u32x4 w; w.x = cvt_pk_bf16(v0[0], v0[1]); w.y = cvt_pk_bf16(v0[2], v0[3]); w.z = cvt_pk_bf16(v1[0], v1[1]); w.w = cvt_pk_bf16(v1[2], v1[3]);
                    if (isu) { const int cu = col0 + bj * HALF; *(u32x4*)(UB + (((size_t)((row >> 13) * 64 + (cu >> 4)) * 8192 + (row & 8191)) * 16 + (cu & 8))) = w; }
                    else *(u32x4*)(rowp + bj * HALF) = w; } }
    }
};
struct EpiAttUp {
    static constexpr bool PERM = true;
    const bf16_t* PG; bf16_t* HB;
    __device__ __forceinline__ void operator()(const f32x4 (&acc)[2][2][4][2], const Unit& u, int wr, int wc, int fr, int fq) const {
        const int row0 = u.pm * BM + wr * 64 + fr; const int col0 = u.pn * BM + wc * 32 + 8 * fq;
#pragma unroll
        for (int ai = 0; ai < 2; ++ai)
#pragma unroll
            for (int m = 0; m < 4; ++m) { const size_t row = (size_t)(row0 + ai * HALF + m * 16);
#pragma unroll
                for (int bj = 0; bj < 2; ++bj) { const int col = col0 + bj * HALF;
                    const u32x4 gw = *(const u32x4*)(PG + row * 4096 + 2048 + col);
                    const f32x4 v0 = acc[ai][bj][m][0] * F8_INV, v1 = acc[ai][bj][m][1] * F8_INV;
                    u32x4 w;
                    w.x = cvt_pk_bf16(v0[0] * sigmoidf_(bf_lo(gw.x)), v0[1] * sigmoidf_(bf_hi(gw.x)));
                    w.y = cvt_pk_bf16(v0[2] * sigmoidf_(bf_lo(gw.y)), v0[3] * sigmoidf_(bf_hi(gw.y)));
                    w.z = cvt_pk_bf16(v1[0] * sigmoidf_(bf_lo(gw.z)), v1[1] * sigmoidf_(bf_hi(gw.z)));
                    w.w = cvt_pk_bf16(v1[2] * sigmoidf_(bf_lo(gw.w)), v1[3] * sigmoidf_(bf_hi(gw.w)));
                    *(u32x4*)(HB + row * 2048 + col) = w; } asm volatile("" ::: "memory"); }
    }
};
struct EpiGlu {
    static constexpr bool PERM = true;
    const bf16_t* PG; const bf16_t* HB; unsigned char* M8;
    __device__ __forceinline__ void operator()(const f32x4 (&acc)[2][2][4][2], const Unit& u, int wr, int wc, int fr, int fq) const {
        const int row0 = u.pm * BM + wr * 64 + fr; const int col = u.pn * HALF + wc * 32 + 8 * fq;
#pragma unroll
        for (int ai = 0; ai < 2; ++ai)
#pragma unroll
            for (int m = 0; m < 4; ++m) { const size_t row = (size_t)(row0 + ai * HALF + m * 16);
                const u32x4 gw = *(const u32x4*)(PG + row * 4096 + col);
                const u32x4 aw = *(const u32x4*)(HB + row * 2048 + col);
                const f32x4 a0 = acc[ai][0][m][0] * F8_INV, a1 = acc[ai][0][m][1] * F8_INV, g0 = acc[ai][1][m][0] * F8_INV, g1 = acc[ai][1][m][1] * F8_INV;
                u32x2 w;
                w.x = pack4_fp8(sigmoidf_(bf_lo(gw.x)) * a0[0] * sigmoidf_(g0[0]) + bf_lo(aw.x), sigmoidf_(bf_hi(gw.x)) * a0[1] * sigmoidf_(g0[1]) + bf_hi(aw.x),
                                sigmoidf_(bf_lo(gw.y)) * a0[2] * sigmoidf_(g0[2]) + bf_lo(aw.y), sigmoidf_(bf_hi(gw.y)) * a0[3] * sigmoidf_(g0[3]) + bf_hi(aw.y), F8_SA);
                w.y = pack4_fp8(sigmoidf_(bf_lo(gw.z)) * a1[0] * sigmoidf_(g1[0]) + bf_lo(aw.z), sigmoidf_(bf_hi(gw.z)) * a1[1] * sigmoidf_(g1[1]) + bf_hi(aw.z),
                                sigmoidf_(bf_lo(gw.w)) * a1[2] * sigmoidf_(g1[2]) + bf_lo(aw.w), sigmoidf_(bf_hi(gw.w)) * a1[3] * sigmoidf_(g1[3]) + bf_hi(aw.w), F8_SA);
                *(u32x2*)(M8 + row * 2048 + col) = w; asm volatile("" ::: "memory"); }
    }
};
struct EpiOut {
    static constexpr bool PERM = true;
    const float* X; float* O; const float* mod;
    __device__ __forceinline__ void operator()(const f32x4 (&acc)[2][2][4][2], const Unit& u, int wr, int wc, int fr, int fq) const {
        const int row0 = u.pm * BM + wr * 64 + fr; const int col0 = u.pn * BM + wc * 32 + 8 * fq;
        const float* gt = mod + (size_t)((u.pm * BM) >> 13) * 12288 + 4096;
#pragma unroll
        for (int bj = 0; bj < 2; ++bj) { const int col = col0 + bj * HALF;
            const f32x4 g0 = *(const f32x4*)(gt + col), g1 = *(const f32x4*)(gt + col + 4);
#pragma unroll
            for (int ai = 0; ai < 2; ++ai)
#pragma unroll
                for (int m = 0; m < 4; ++m) { const size_t off = (size_t)(row0 + ai * HALF + m * 16) * 2048 + col;
                    const f32x4 x0 = *(const f32x4*)(X + off), x1 = *(const f32x4*)(X + off + 4);
                    *(f32x4*)(O + off) = x0 + g0 * (acc[ai][bj][m][0] * F8_INV); *(f32x4*)(O + off + 4) = x1 + g1 * (acc[ai][bj][m][1] * F8_INV); } }
    }
};
struct EpiF32 {
    static constexpr bool PERM = true;
    float* O;
    __device__ __forceinline__ void operator()(const f32x4 (&acc)[2][2][4][2], const Unit& u, int wr, int wc, int fr, int fq) const {
        const int row0 = u.pm * BM + wr * 64 + fr; const int col0 = u.pn * BM + wc * 32 + 8 * fq;
#pragma unroll
        for (int ai = 0; ai < 2; ++ai)
#pragma unroll
            for (int m = 0; m < 4; ++m) { float* rowp = O + (size_t)(row0 + ai * HALF + m * 16) * 2048 + col0;
#pragma unroll
                for (int bj = 0; bj < 2; ++bj) { *(f32x4*)(rowp + bj * HALF) = acc[ai][bj][m][0]; *(f32x4*)(rowp + bj * HALF + 4) = acc[ai][bj][m][1]; } }
    }
};
}

struct Args { const float* in[25]; float* out; unsigned char* ws; int ph_lo, ph_hi; };
enum { I_X = 0, I_C, I_WADA, I_BADA, I_N1G, I_WIN, I_LRE, I_LIM, I_LDT, I_BRE, I_BIM, I_CRE, I_CIM, I_SD, I_WGLU, I_QNG, I_KNG, I_WATT, I_WOUT, I_N2G, I_WQ, I_K1, I_K2, I_PU, I_PV };

__device__ __forceinline__ void ph_mod_partial(const float* __restrict__ c, const float* __restrict__ w_ada, float* modp, int gw, int ngw, int lane) {
    for (int task = gw; task < 48 * 32; task += ngw) {
        const int strip = task % 48, ks = task / 48, n0 = strip * 256 + lane * 4, k0 = ks * 64;
        f32x4 a0 = {0.f, 0.f, 0.f, 0.f}, a1 = {0.f, 0.f, 0.f, 0.f};
#pragma unroll 8
        for (int k = 0; k < 64; ++k) {
            const f32x4 w = *(const f32x4*)(w_ada + (size_t)(k0 + k) * 12288 + n0);
            float c0 = c[k0 + k], c1 = c[2048 + k0 + k];
            c0 = c0 / (1.0f + __expf(-c0)); c1 = c1 / (1.0f + __expf(-c1));
            a0 += c0 * w; a1 += c1 * w;
        }
        *(f32x4*)(modp + (size_t)(ks * 2 + 0) * 12288 + n0) = a0;
        *(f32x4*)(modp + (size_t)(ks * 2 + 1) * 12288 + n0) = a1;
    }
}

__device__ __forceinline__ void ph_colmax_partial(const float* __restrict__ w_in, float* cmaxp, int gw, int ngw, int lane) {
    for (int task = gw; task < 32 * 32; task += ngw) {
        const int strip = task & 31, ks = task >> 5, n0 = strip * 256 + lane * 4, k0 = ks * 64;
        f32x4 m = {0.f, 0.f, 0.f, 0.f};
#pragma unroll 8
        for (int k = 0; k < 64; ++k) { const f32x4 w = *(const f32x4*)(w_in + (size_t)(k0 + k) * 8192 + n0);
            m[0] = fmaxf(m[0], fabsf(w[0])); m[1] = fmaxf(m[1], fabsf(w[1])); m[2] = fmaxf(m[2], fabsf(w[2])); m[3] = fmaxf(m[3], fabsf(w[3])); }
        *(f32x4*)(cmaxp + (size_t)ks * 8192 + n0) = m;
    }
}

__device__ __forceinline__ void transpose_item_f8(const float* __restrict__ W, int K, int N, unsigned char* WT8, int drow0, int scol0, int k0, LAS float* scr, int lane) {
#pragma unroll 8
    for (int i = 0; i < 32; ++i) { const int kk = 2 * i + (lane >> 5); scr[kk * 33 + (lane & 31)] = W[(size_t)(k0 + kk) * N + scol0 + (lane & 31)]; }
    LDS_WAIT();
    const int n = lane >> 1, half = lane & 1;
    const LAS float* s = scr + (32 * half) * 33 + n;
    u32x4 o[2];
#pragma unroll
    for (int q = 0; q < 8; ++q) o[q >> 2][q & 3] = pack4_fp8(s[(4 * q) * 33], s[(4 * q + 1) * 33], s[(4 * q + 2) * 33], s[(4 * q + 3) * 33], F8_SW);
    *(u32x4*)(WT8 + (size_t)(drow0 + n) * K + k0 + 32 * half) = o[0];
    *(u32x4*)(WT8 + (size_t)(drow0 + n) * K + k0 + 32 * half + 16) = o[1];
    LDS_WAIT();
}
__device__ __forceinline__ void transpose_item_i8(const float* __restrict__ W, signed char* WT8, const float* cmaxp, float* SB, int n0, int k0, LAS float* scr, int lane) {
#pragma unroll 8
    for (int i = 0; i < 32; ++i) { const int kk = 2 * i + (lane >> 5); scr[kk * 33 + (lane & 31)] = W[(size_t)(k0 + kk) * 8192 + n0 + (lane & 31)]; }
    const int n = lane >> 1, half = lane & 1;
    float cm = 0.f;
#pragma unroll 8
    for (int ks = 0; ks < 32; ++ks) cm = fmaxf(cm, cmaxp[(size_t)ks * 8192 + n0 + n]);
    const float sb = fmaxf(cm, 1e-30f) * (1.0f / 127.0f), inv = 1.0f / sb;
    if (k0 == 0 && half == 0) SB[n0 + n] = sb;
    LDS_WAIT();
    const LAS float* s = scr + (32 * half) * 33 + n;
    u32x4 o[2];
#pragma unroll
    for (int q = 0; q < 8; ++q) { unsigned w = 0;
#pragma unroll
        for (int e = 0; e < 4; ++e) { const int v = (int)rintf(s[(4 * q + e) * 33] * inv); w |= ((unsigned)v & 0xffu) << (8 * e); }
        o[q >> 2][q & 3] = w; }
    *(u32x4*)(WT8 + (size_t)(n0 + n) * 2048 + k0 + 32 * half) = o[0];
    *(u32x4*)(WT8 + (size_t)(n0 + n) * 2048 + k0 + 32 * half + 16) = o[1];
    LDS_WAIT();
}

__device__ __forceinline__ void transpose_item(const float* __restrict__ W, int K, int N, bf16_t* WT, int drow0, int scol0, int k0, LAS float* scr, int lane) {
#pragma unroll 8
    for (int i = 0; i < 32; ++i) { const int kk = 2 * i + (lane >> 5); scr[kk * 33 + (lane & 31)] = W[(size_t)(k0 + kk) * N + scol0 + (lane & 31)]; }
    LDS_WAIT();
    const int c = lane & 7;
#pragma unroll
    for (int j = 0; j < 4; ++j) { const int n = (lane >> 3) + 8 * j; const LAS float* s = scr + (8 * c) * 33 + n;
        u32x4 o; o.x = cvt_pk_bf16(s[0 * 33], s[1 * 33]); o.y = cvt_pk_bf16(s[2 * 33], s[3 * 33]); o.z = cvt_pk_bf16(s[4 * 33], s[5 * 33]); o.w = cvt_pk_bf16(s[6 * 33], s[7 * 33]);
        *(u32x4*)(WT + (size_t)(drow0 + n) * K + k0 + 8 * c) = o; }
    LDS_WAIT();
}
__device__ __forceinline__ void wsc_item(const float* wq, const float* kk, bf16_t* out, int lane) {
    const int r = lane & 15, q = lane >> 4;
    f32x4 acc[8];
#pragma unroll
    for (int f = 0; f < 8; ++f) acc[f] = (f32x4){0.f, 0.f, 0.f, 0.f};
    const float* ap = kk + r * 128 + 4 * q; const float* bp = wq + (size_t)r * 2048 + 4 * q;
#pragma unroll 2
    for (int d0 = 0; d0 < 128; d0 += 16) {
        const f32x4 bv = *(const f32x4*)(bp + d0);
        f32x4 av[8];
#pragma unroll
        for (int f = 0; f < 8; ++f) av[f] = *(const f32x4*)(ap + f * 2048 + d0);
#pragma unroll
        for (int j = 0; j < 4; ++j)
#pragma unroll
            for (int f = 0; f < 8; ++f) acc[f] = __builtin_amdgcn_mfma_f32_16x16x4f32(av[f][j], bv[j], acc[f], 0, 0, 0);
    }
#pragma unroll
    for (int f = 0; f < 8; ++f)
#pragma unroll
        for (int i = 0; i < 4; ++i) out[(size_t)(16 * f + 4 * q + i) * 2048 + r] = (bf16_t)(cvt_pk_bf16(acc[f][i], 0.f) & 0xffffu);
}
__device__ __forceinline__ void ph_prologue(const Args& a, LAS unsigned char* lds, int gw, int ngw, int lane, int wave) {
    unsigned char* ws = a.ws;
    { const float* modp = (const float*)(ws + WS_MODP); float* mod = (float*)(ws + WS_MOD); const float* b_ada = a.in[I_BADA];
      for (int idx = gw * 64 + lane; idx < 2 * 12288; idx += ngw * 64) { const int b = idx / 12288, n = idx - b * 12288; float s = b_ada[n];
#pragma unroll 8
          for (int ks = 0; ks < 32; ++ks) s += modp[(size_t)(ks * 2 + b) * 12288 + n];
          mod[idx] = s; } }
    for (int item = gw; item < 2048; item += ngw) { const int hj = item >> 7, k0 = (item & 127) * 16;
        wsc_item(a.in[I_WQ] + (size_t)k0 * 2048 + hj * 128, (hj & 1) ? a.in[I_K2] : a.in[I_K1], (bf16_t*)(ws + WS_WSC) + (size_t)(hj * 128) * 2048 + k0, lane); }
    { LAS float* scr = (LAS float*)(lds + wave * 8448);
      constexpr int I_IN = 32 * 256, I_GLU = 16 * 128, I_ATT = 16 * 64, I_OUT = 32 * 64, NIT = I_IN + I_GLU + I_ATT + I_OUT;
      for (int it = gw; it < NIT; it += ngw) {
          int r = it;
          if (r < I_IN) { const int kb = r / 256, nb = r % 256; transpose_item_i8(a.in[I_WIN], (signed char*)(ws + WS_WIN), (const float*)(ws + WS_CMAXP), (float*)(ws + WS_SB), 32 * nb, 64 * kb, scr, lane); continue; } r -= I_IN;
          if (r < I_GLU) { const int kb = r / 128, nb = r % 128, dr = 32 * nb; const int sc = ((dr >> 7) & 1) * 2048 + (dr >> 8) * 128 + (dr & 127);
              transpose_item_f8(a.in[I_WGLU], 1024, 4096, ws + WS_WGLU, dr, sc, 64 * kb, scr, lane); continue; } r -= I_GLU;
          if (r < I_ATT) { const int kb = r / 64, nb = r % 64; transpose_item_f8(a.in[I_WATT], 1024, 2048, ws + WS_WATT, 32 * nb, 32 * nb, 64 * kb, scr, lane); continue; } r -= I_ATT;
          { const int kb = r / 64, nb = r % 64; transpose_item_f8(a.in[I_WOUT], 2048, 2048, ws + WS_WOUT, 32 * nb, 32 * nb, 64 * kb, scr, lane); }
      } }
}

template <bool I8>
__device__ __forceinline__ void ph_norm(const float* X, bf16_t* Hout, float* SA, const float* __restrict__ g, const float* mod, int sh_off, int sc_off, int gw, int ngw, int lane) {
    for (int row = gw; row < T_TOK; row += ngw) {
        const int b = row >> 13;
        const f32x4* xr = (const f32x4*)(X + (size_t)row * DM) + lane;
        f32x4 v[8]; float ss = 0.f;
#pragma unroll
        for (int j = 0; j < 8; ++j) { v[j] = xr[64 * j]; ss += (v[j][0] * v[j][0] + v[j][1] * v[j][1]) + (v[j][2] * v[j][2] + v[j][3] * v[j][3]); }
        ss = wave_sum(ss);
        const float rs = 1.0f / sqrtf(ss * (1.0f / DM) + EPS);
        const float* mb = mod + (size_t)b * 12288;
        float amax = 0.f;
#pragma unroll
        for (int j = 0; j < 8; ++j) { const int col = 4 * (lane + 64 * j);
            const f32x4 gv = *(const f32x4*)(g + col), sc = *(const f32x4*)(mb + sc_off + col), sh = *(const f32x4*)(mb + sh_off + col);
            const f32x4 o = v[j] * rs * gv * (sc + 1.0f) + sh;
            if (I8) { v[j] = o; amax = fmaxf(fmaxf(amax, fmaxf(fabsf(o[0]), fabsf(o[1]))), fmaxf(fabsf(o[2]), fabsf(o[3]))); }
            else { u32x2 w; w.x = cvt_pk_bf16(o[0], o[1]); w.y = cvt_pk_bf16(o[2], o[3]); *(u32x2*)(Hout + (size_t)row * DM + col) = w; } }
        if (I8) {
#pragma unroll
            for (int o = 1; o < 64; o <<= 1) amax = fmaxf(amax, __shfl_xor(amax, o));
            const float sa = fmaxf(amax, 1e-30f) * (1.0f / 127.0f), inv = 1.0f / sa;
            if (lane == 0) SA[row] = sa;
            unsigned* h8 = (unsigned*)((signed char*)Hout + (size_t)row * DM) + lane;
#pragma unroll
            for (int j = 0; j < 8; ++j) { unsigned w = 0;
#pragma unroll
                for (int e = 0; e < 4; ++e) { const int q = (int)rintf(v[j][e] * inv); w |= ((unsigned)q & 0xffu) << (8 * e); }
                h8[64 * j] = w; }
        }
    }
}

template <int MODE>
__device__ __forceinline__ void ph_attn(LAS unsigned char* lds, const bf16_t* PA, bf16_t* ATT, const float* __restrict__ qg, const float* __restrict__ kg, int G) {
    const int tid = opaque_tid(), lane = tid & 63, wave = __builtin_amdgcn_readfirstlane(tid >> 6), c = lane & 15, g = lane >> 4;
    LAS unsigned char* KL = lds;
    LAS unsigned char* VT = lds + 17408;
    bf16x8 tri[6];
    { const int FS[6] = {0, 1, 0, 1, 2, 3}, FP[6] = {0, 0, 1, 1, 1, 1};
#pragma unroll
      for (int q = 0; q < 6; ++q)
#pragma unroll
          for (int jj = 0; jj < 8; ++jj) { const int kap = 32 * FP[q] + 16 * (jj >> 2) + 4 * g + (jj & 3); tri[q][jj] = (kap > 16 * FS[q] + c) ? (short)0x3F80 : (short)0; } }
    for (int u = blockIdx.x; u < 1024; u += G) {
        const int b = u >> 9, h = (u >> 6) & 7, qb = u & 63, t0 = qb * 128, tq0 = t0 + 16 * wave, tq = tq0 + c;
        bf16x8 qf[4];
        { const bf16_t* qrow = PA + (size_t)(b * SEQ + tq) * 4096 + 1024 + h * 128;
          u32x4 qr[4]; float ss = 0.f;
#pragma unroll
          for (int kk = 0; kk < 4; ++kk) { qr[kk] = *(const u32x4*)(qrow + 32 * kk + 8 * g);
#pragma unroll
              for (int e = 0; e < 4; ++e) { const float lo = bf_lo(qr[kk][e]), hi = bf_hi(qr[kk][e]); ss += lo * lo + hi * hi; } }
          ss += __shfl_xor(ss, 16); ss += __shfl_xor(ss, 32);
          const float rs = (1.0f / sqrtf(ss * (1.0f / 128.0f) + EPS)) * (0.08838834764831845f * 1.4426950408889634f);
#pragma unroll
          for (int kk = 0; kk < 4; ++kk) { const f32x4 g0 = *(const f32x4*)(qg + 32 * kk + 8 * g), g1 = *(const f32x4*)(qg + 32 * kk + 8 * g + 4);
              u32x4 w;
              w.x = cvt_pk_bf16(bf_lo(qr[kk].x) * rs * g0[0], bf_hi(qr[kk].x) * rs * g0[1]);
              w.y = cvt_pk_bf16(bf_lo(qr[kk].y) * rs * g0[2], bf_hi(qr[kk].y) * rs * g0[3]);
              w.z = cvt_pk_bf16(bf_lo(qr[kk].z) * rs * g1[0], bf_hi(qr[kk].z) * rs * g1[1]);
              w.w = cvt_pk_bf16(bf_lo(qr[kk].w) * rs * g1[2], bf_hi(qr[kk].w) * rs * g1[3]);
              qf[kk] = __builtin_bit_cast(bf16x8, w); } }
        float carry = 0.f; int wdone = 0;
        f32x4 oacc[8];
#pragma unroll
        for (int fd = 0; fd < 8; ++fd) oacc[fd] = (f32x4){0.f, 0.f, 0.f, 0.f};
        u32x4 kreg[2], vreg[2];
        { const int k0n = (2 * qb + 1) * 64;
#pragma unroll
          for (int p = 0; p < 2; ++p) { const int ci = tid + 512 * p, key = ci >> 4, ch = ci & 15;
              kreg[p] = *(const u32x4*)(PA + (size_t)(b * SEQ + k0n + key) * 4096 + 2048 + h * 128 + 8 * ch);
              vreg[p] = *(const u32x4*)(PA + (size_t)(b * SEQ + k0n + lane) * 4096 + 3072 + h * 128 + 8 * (wave + 8 * p)); } }
        for (int kt = 2 * qb + 1; kt >= 0; --kt) {
            const int k0 = kt * 64;
            if (__syncthreads_and(wdone)) break;
#pragma unroll
            for (int p = 0; p < 2; ++p) {
                const int ci = tid + 512 * p, key = ci >> 4, ch = ci & 15;
                const u32x4 kr = kreg[p];
                float f[8]; f[0] = bf_lo(kr.x); f[1] = bf_hi(kr.x); f[2] = bf_lo(kr.y); f[3] = bf_hi(kr.y); f[4] = bf_lo(kr.z); f[5] = bf_hi(kr.z); f[6] = bf_lo(kr.w); f[7] = bf_hi(kr.w);
                float ss = 0.f;
#pragma unroll
                for (int e = 0; e < 8; ++e) ss += f[e] * f[e];
                ss += __shfl_xor(ss, 1); ss += __shfl_xor(ss, 2); ss += __shfl_xor(ss, 4); ss += __shfl_xor(ss, 8);
                const float rs = 1.0f / sqrtf(ss * (1.0f / 128.0f) + EPS);
                const f32x4 g0 = *(const f32x4*)(kg + 8 * ch), g1 = *(const f32x4*)(kg + 8 * ch + 4);
                u32x4 w;
                w.x = cvt_pk_bf16(f[0] * rs * g0[0], f[1] * rs * g0[1]); w.y = cvt_pk_bf16(f[2] * rs * g0[2], f[3] * rs * g0[3]);
                w.z = cvt_pk_bf16(f[4] * rs * g1[0], f[5] * rs * g1[1]); w.w = cvt_pk_bf16(f[6] * rs * g1[2], f[7] * rs * g1[3]);
                *(LAS u32x4*)(KL + key * 272 + ch * 16) = w;
            }
#pragma unroll
            for (int p = 0; p < 2; ++p) {
                const int key = lane, ch = wave + 8 * p;
                const u32x4 vr = vreg[p];
                LAS unsigned short* vt = (LAS unsigned short*)(VT + (8 * ch) * 144 + key * 2);
                vt[0 * 72] = (unsigned short)(vr.x & 0xffffu); vt[1 * 72] = (unsigned short)(vr.x >> 16);
                vt[2 * 72] = (unsigned short)(vr.y & 0xffffu); vt[3 * 72] = (unsigned short)(vr.y >> 16);
                vt[4 * 72] = (unsigned short)(vr.z & 0xffffu); vt[5 * 72] = (unsigned short)(vr.z >> 16);
                vt[6 * 72] = (unsigned short)(vr.w & 0xffffu); vt[7 * 72] = (unsigned short)(vr.w >> 16);
            }
            if (kt > 0) { const int k0n = k0 - 64;
#pragma unroll
                for (int p = 0; p < 2; ++p) { const int ci = tid + 512 * p, key = ci >> 4, ch = ci & 15;
                    kreg[p] = *(const u32x4*)(PA + (size_t)(b * SEQ + k0n + key) * 4096 + 2048 + h * 128 + 8 * ch);
                    vreg[p] = *(const u32x4*)(PA + (size_t)(b * SEQ + k0n + lane) * 4096 + 3072 + h * 128 + 8 * (wave + 8 * p)); } }
            __syncthreads();
            if (MODE == 1) { if (kt <= 2 * qb - 3) wdone = 1; }
            if (MODE == 0 && !wdone && k0 < tq0 + 15) {
                f32x4 zt[4];
#pragma unroll
                for (int f = 0; f < 4; ++f) { f32x4 acc = {0.f, 0.f, 0.f, 0.f};
#pragma unroll
                    for (int kk = 0; kk < 4; ++kk) { const bf16x8 kf = *(const LAS bf16x8*)(KL + (16 * f + c) * 272 + (32 * kk + 8 * g) * 2);
                        acc = __builtin_amdgcn_mfma_f32_16x16x32_bf16(kf, qf[kk], acc, 0, 0, 0); }
                    zt[f] = acc; }
                float lf[4][4], lz[4][4]; float tot = 0.f;
                if (k0 + 63 >= tq0) {
#pragma unroll
                    for (int f = 0; f < 4; ++f)
#pragma unroll
                        for (int i = 0; i < 4; ++i) { const int s = k0 + 16 * f + 4 * g + i; const bool valid = s < tq; const float z = zt[f][i];
                            const float sp = fmaxf(z, 0.f) + __builtin_amdgcn_logf(1.0f + __builtin_amdgcn_exp2f(-fabsf(z)));
                            const float l = valid ? -sp : 0.f; lf[f][i] = l; lz[f][i] = valid ? (l + z) : -INFINITY; tot += l; }
                } else {
#pragma unroll
                    for (int f = 0; f < 4; ++f)
#pragma unroll
                        for (int i = 0; i < 4; ++i) { const float z = zt[f][i];
                            const float l = -(fmaxf(z, 0.f) + __builtin_amdgcn_logf(1.0f + __builtin_amdgcn_exp2f(-fabsf(z)))); lf[f][i] = l; lz[f][i] = l + z; tot += l; }
                }
                tot += __shfl_xor(tot, 16); tot += __shfl_xor(tot, 32);
                bf16x8 lh[2];
#pragma unroll
                for (int fp = 0; fp < 2; ++fp) { u32x4 wh;
#pragma unroll
                    for (int q = 0; q < 2; ++q) { const int f = 2 * fp + q; wh[2 * q] = cvt_pk_bf16(lf[f][0], lf[f][1]); wh[2 * q + 1] = cvt_pk_bf16(lf[f][2], lf[f][3]); }
                    lh[fp] = __builtin_bit_cast(bf16x8, wh); }
                f32x4 sf[4];
                { f32x4 z4 = {0.f, 0.f, 0.f, 0.f};
                  sf[0] = __builtin_amdgcn_mfma_f32_16x16x32_bf16(tri[0], lh[0], z4, 0, 0, 0); sf[0] = __builtin_amdgcn_mfma_f32_16x16x32_bf16(tri[2], lh[1], sf[0], 0, 0, 0);
                  sf[1] = __builtin_amdgcn_mfma_f32_16x16x32_bf16(tri[1], lh[0], z4, 0, 0, 0); sf[1] = __builtin_amdgcn_mfma_f32_16x16x32_bf16(tri[3], lh[1], sf[1], 0, 0, 0);
                  sf[2] = __builtin_amdgcn_mfma_f32_16x16x32_bf16(tri[4], lh[1], z4, 0, 0, 0);
                  sf[3] = __builtin_amdgcn_mfma_f32_16x16x32_bf16(tri[5], lh[1], z4, 0, 0, 0); }
                bf16x8 pb[2];
#pragma unroll
                for (int fp = 0; fp < 2; ++fp) { u32x4 w;
#pragma unroll
                    for (int q = 0; q < 2; ++q) { const int f = 2 * fp + q; float p[4];
#pragma unroll
                        for (int i = 0; i < 4; ++i) p[i] = __builtin_amdgcn_exp2f(lz[f][i] + sf[f][i] + carry);
                        w[2 * q] = cvt_pk_bf16(p[0], p[1]); w[2 * q + 1] = cvt_pk_bf16(p[2], p[3]); }
                    pb[fp] = __builtin_bit_cast(bf16x8, w); }
                carry += tot;
#pragma unroll
                for (int fd = 0; fd < 8; ++fd)
#pragma unroll
                    for (int fp = 0; fp < 2; ++fp) { const LAS unsigned char* vp = VT + (16 * fd + c) * 144 + (32 * fp + 4 * g) * 2;
                        const u32x2 v0 = *(const LAS u32x2*)vp, v1 = *(const LAS u32x2*)(vp + 32);
                        u32x4 vw; vw.x = v0.x; vw.y = v0.y; vw.z = v1.x; vw.w = v1.y;
                        oacc[fd] = __builtin_amdgcn_mfma_f32_16x16x32_bf16(__builtin_bit_cast(bf16x8, vw), pb[fp], oacc[fd], 0, 0, 0); }
                wdone = (__ballot(carry >= -152.0f) == 0ull) ? 1 : 0;
            }
        }
        if (MODE == 0) { unsigned char* orow = (unsigned char*)ATT + (size_t)(b * SEQ + tq) * 1024 + h * 128 + 4 * g;
#pragma unroll
          for (int fd = 0; fd < 8; ++fd) *(unsigned*)(orow + 16 * fd) = pack4_fp8(oacc[fd][0], oacc[fd][1], oacc[fd][2], oacc[fd][3], F8_SA); }
    }
    __syncthreads();
}

__device__ __forceinline__ void ssm_lambda(const Args& a, int g, int st, float& lbr, float& lbi, float& qr, float& qi) {
    const float lr = a.in[I_LRE][g * 64 + st], li = a.in[I_LIM][g * 64 + st], dt = __expf(a.in[I_LDT][g]);
    const float mag = __expf(lr * dt);
    float rev = li * dt * 0.15915494309189535f; rev -= rintf(rev);
    lbr = mag * __builtin_amdgcn_cosf(rev); lbi = mag * __builtin_amdgcn_sinf(rev);
    const float nr = lbr - 1.0f, ni = lbi, den = 1.0f / (lr * lr + li * li);
    qr = (nr * lr + ni * li) * den; qi = (ni * lr - nr * li) * den;
}
template <bool WITH_Y>
__device__ __forceinline__ void ph_ssm_mfma(const Args& a, LAS unsigned char* lds, const bf16_t* UB, f32x2* E, bf16_t* YA, int G) {
    const int tid = opaque_tid(), lane = tid & 63, wave = __builtin_amdgcn_readfirstlane(tid >> 6), c = lane & 15, gl = lane >> 4;
    LAS f32x2* sl = (LAS f32x2*)(lds + wave * 8192);
    LAS f32x4* tab = (LAS f32x4*)(lds + 65536 + wave * 1024);
    LAS u32x4* cml = (LAS u32x4*)(lds + 73728 + wave * 5120) + lane;
    for (int item = blockIdx.x; item < 128; item += G) {
        const int b = item >> 6, cb = (item >> 3) & 7, g = (item & 7) * 8 + wave, c0 = cb * 16;
        float mur, mui;
        { float lbr, lbi, qr, qi; ssm_lambda(a, g, lane, lbr, lbi, qr, qi); tab[lane] = (f32x4){lbr, lbi, qr, qi}; mur = lbr; mui = lbi; }
        LDS_WAIT();
        bf16x8 bm[8];
        const float* brb = a.in[I_BRE] + (g * 64 + (c >> 1)) * 16 + 8 * (gl & 1); const float* bib = a.in[I_BIM] + (g * 64 + (c >> 1)) * 16 + 8 * (gl & 1);
        const LAS f32x4* tabb = tab + (c >> 1);
#pragma unroll
        for (int f = 0; f < 8; ++f) { const f32x4 tv = tabb[8 * f]; const float qr = tv[2], qi = tv[3];
            const float* br = brb + 128 * f; const float* bim = bib + 128 * f;
            const f32x4 r0 = *(const f32x4*)br, r1 = *(const f32x4*)(br + 4), i0 = *(const f32x4*)bim, i1 = *(const f32x4*)(bim + 4);
            float v[8];
#pragma unroll
            for (int e = 0; e < 4; ++e) { const float vr0 = qr * r0[e] - qi * i0[e], vi0 = qr * i0[e] + qi * r0[e], vr1 = qr * r1[e] - qi * i1[e], vi1 = qr * i1[e] + qi * r1[e];
                v[e] = (c & 1) ? vi0 : vr0; v[4 + e] = (c & 1) ? vi1 : vr1; }
            if (gl >= 2) {
#pragma unroll
                for (int e = 0; e < 8; ++e) v[e] = 0.f; }
            u32x4 w; w.x = cvt_pk_bf16(v[0], v[1]); w.y = cvt_pk_bf16(v[2], v[3]); w.z = cvt_pk_bf16(v[4], v[5]); w.w = cvt_pk_bf16(v[6], v[7]);
            bm[f] = __builtin_bit_cast(bf16x8, w); }
        float lmr[16], lmi[16];
#pragma unroll
        for (int k = 0; k < 16; ++k) { const f32x4 tv = tab[2 * gl + 8 * (k >> 1) + (k & 1)]; lmr[k] = tv[0]; lmi[k] = tv[1]; }
        if (WITH_Y) {
            const float* crb = a.in[I_CRE] + (g * 16 + c) * 64 + 2 * gl; const float* cib = a.in[I_CIM] + (g * 16 + c) * 64 + 2 * gl;
#pragma unroll
            for (int kk = 0; kk < 4; ++kk) { float v[8];
#pragma unroll
                for (int jh = 0; jh < 2; ++jh) { const f32x2 r = *(const f32x2*)(crb + 8 * (2 * kk + jh)), m = *(const f32x2*)(cib + 8 * (2 * kk + jh));
                    v[4 * jh] = r.x; v[4 * jh + 1] = -m.x; v[4 * jh + 2] = r.y; v[4 * jh + 3] = -m.y; }
                u32x4 w; w.x = cvt_pk_bf16(v[0], v[1]); w.y = cvt_pk_bf16(v[2], v[3]); w.z = cvt_pk_bf16(v[4], v[5]); w.w = cvt_pk_bf16(v[6], v[7]);
                cml[64 * kk] = w; }
            { const float dv = a.in[I_SD][g * 16 + c]; float v[8];
#pragma unroll
              for (int jj = 0; jj < 8; ++jj) v[jj] = (gl < 2 && (8 * gl + jj) == c) ? dv : 0.f;
              u32x4 w; w.x = cvt_pk_bf16(v[0], v[1]); w.y = cvt_pk_bf16(v[2], v[3]); w.z = cvt_pk_bf16(v[4], v[5]); w.w = cvt_pk_bf16(v[6], v[7]);
              cml[256] = w; }
        }
        f32x4 s[8];
#pragma unroll
        for (int f = 0; f < 8; ++f) s[f] = (f32x4){0.f, 0.f, 0.f, 0.f};
        if (WITH_Y) {
            float pr = mur, pi = mui;
#pragma unroll
            for (int q = 0; q < 6; ++q) { const float nr = pr * pr - pi * pi, ni = 2.0f * pr * pi; pr = nr; pi = ni; }
            float sr = 0.f, si = 0.f;
            const f32x2* ep = E + (size_t)((b * 64 + g) * 128) * 64 + lane;
            f32x2 ev[8], en[8];
#pragma unroll
            for (int k = 0; k < 8; ++k) ev[k] = ep[(size_t)k * 64];
            for (int cc = 0; cc < c0 + 16; cc += 8) {
                if (cc + 8 < c0 + 16) {
#pragma unroll
                    for (int k = 0; k < 8; ++k) en[k] = ep[(size_t)(cc + 8 + k) * 64]; }
#pragma unroll
                for (int k = 0; k < 8; ++k) { if (cc >= c0) sl[(cc - c0 + k) * 64 + lane] = (f32x2){sr, si};
                    const float nr = pr * sr - pi * si + ev[k][0], ni = pr * si + pi * sr + ev[k][1]; sr = nr; si = ni; }
#pragma unroll
                for (int k = 0; k < 8; ++k) ev[k] = en[k];
            }
            LDS_WAIT();
#pragma unroll
            for (int f = 0; f < 8; ++f) s[f] = *(const LAS f32x4*)(sl + c * 64 + 8 * f + 2 * gl);
            LDS_WAIT();
        }
        const bf16_t* up = UB + ((size_t)(b * 64 + g) * 8192 + (size_t)(c0 + c) * 64) * 16 + 8 * (gl & 1);
        unsigned char* yp = (unsigned char*)YA + (size_t)(b * SEQ + (c0 + c) * 64) * 1024 + g * 16 + 4 * gl;
        u32x4 u0 = *(const u32x4*)(up), u1 = *(const u32x4*)(up + 16), u2 = *(const u32x4*)(up + 32), u3 = *(const u32x4*)(up + 48), u4 = *(const u32x4*)(up + 64), u5 = *(const u32x4*)(up + 80);
#pragma unroll 1
        for (int tau = 0; tau < 64; ++tau) {
            const u32x4 u6 = *(const u32x4*)(up + (size_t)(tau + 6) * 16);
            const bf16x8 uf = __builtin_bit_cast(bf16x8, u0);
#pragma unroll
            for (int f = 0; f < 8; ++f) { f32x4 ci;
                ci[0] = lmr[2 * f] * s[f][0] - lmi[2 * f] * s[f][1]; ci[1] = lmr[2 * f] * s[f][1] + lmi[2 * f] * s[f][0];
                ci[2] = lmr[2 * f + 1] * s[f][2] - lmi[2 * f + 1] * s[f][3]; ci[3] = lmr[2 * f + 1] * s[f][3] + lmi[2 * f + 1] * s[f][2];
                s[f] = __builtin_amdgcn_mfma_f32_16x16x32_bf16(bm[f], uf, ci, 0, 0, 0); }
            if (WITH_Y) {
                f32x4 y = __builtin_amdgcn_mfma_f32_16x16x32_bf16(__builtin_bit_cast(bf16x8, cml[256]), uf, (f32x4){0.f, 0.f, 0.f, 0.f}, 0, 0, 0);
#pragma unroll
                for (int kk = 0; kk < 4; ++kk) { u32x4 w; w.x = cvt_pk_bf16(s[2 * kk][0], s[2 * kk][1]); w.y = cvt_pk_bf16(s[2 * kk][2], s[2 * kk][3]);
                    w.z = cvt_pk_bf16(s[2 * kk + 1][0], s[2 * kk + 1][1]); w.w = cvt_pk_bf16(s[2 * kk + 1][2], s[2 * kk + 1][3]);
                    y = __builtin_amdgcn_mfma_f32_16x16x32_bf16(__builtin_bit_cast(bf16x8, cml[64 * kk]), __builtin_bit_cast(bf16x8, w), y, 0, 0, 0); }
                *(unsigned*)(yp + (size_t)tau * 1024) = pack4_fp8(gelu_tanh(y[0]), gelu_tanh(y[1]), gelu_tanh(y[2]), gelu_tanh(y[3]), F8_SA);
            }
            u0 = u1; u1 = u2; u2 = u3; u3 = u4; u4 = u5; u5 = u6;
        }
        if (!WITH_Y) { f32x2* eo = E + (size_t)((b * 64 + g) * 128 + c0 + c) * 64 + 2 * gl;
#pragma unroll
            for (int f = 0; f < 8; ++f) *(f32x4*)(eo + 8 * f) = s[f]; }
    }
}

#ifndef FP6_INTERLEAVED
#define FP6_INTERLEAVED 1
#endif
typedef float f32x16 __attribute__((ext_vector_type(16)));
typedef float f32x32 __attribute__((ext_vector_type(32)));
typedef unsigned u32x6 __attribute__((ext_vector_type(6)));
constexpr float PEER_SU = 64.0f, PEER_SV = 1.4f, PEER_SV4 = 2.0f;
__device__ __forceinline__ void ph_table_cvt(const float* __restrict__ U, const float* __restrict__ V, unsigned char* UT, unsigned char* VT, unsigned char* VT4, int gw, int ngw, int lane) {
    for (int row = gw; row < 2 * 16384; row += ngw) {
        const bool sec = row >= 16384; const int r = sec ? row - 16384 : row; const float sc = sec ? PEER_SV : PEER_SU;
        const float* src = (sec ? V : U) + (size_t)r * 2048 + 4 * lane; unsigned char* dst = (sec ? VT : UT) + (size_t)r * 1536;
        f32x16 a, b;
#pragma unroll
        for (int q = 0; q < 4; ++q) { const f32x4 v0 = *(const f32x4*)(src + 256 * q), v1 = *(const f32x4*)(src + 1024 + 256 * q);
#pragma unroll
            for (int e = 0; e < 4; ++e) { a[4 * q + e] = v0[e] * sc; b[4 * q + e] = v1[e] * sc; } }
        const u32x6 p = __builtin_amdgcn_cvt_scalef32_2xpk16_fp6_f32(a, b, 1.0f);
        *(u32x4*)(dst + 16 * lane) = (u32x4){p[0], p[1], p[2], p[3]};
        *(u32x2*)(dst + 1024 + 8 * lane) = (u32x2){p[4], p[5]};
        if (sec) {
            const float r4 = PEER_SV4 / PEER_SV; u32x4 w4;
#pragma unroll
            for (int q = 0; q < 4; ++q) { unsigned w = 0;
                w = __builtin_amdgcn_cvt_scalef32_pk_fp4_f32(w, a[4 * q + 0] * r4, b[4 * q + 0] * r4, 1.0f, 0); w = __builtin_amdgcn_cvt_scalef32_pk_fp4_f32(w, a[4 * q + 1] * r4, b[4 * q + 1] * r4, 1.0f, 1);
                w = __builtin_amdgcn_cvt_scalef32_pk_fp4_f32(w, a[4 * q + 2] * r4, b[4 * q + 2] * r4, 1.0f, 2); w = __builtin_amdgcn_cvt_scalef32_pk_fp4_f32(w, a[4 * q + 3] * r4, b[4 * q + 3] * r4, 1.0f, 3);
                w4[q] = w; }
            *(u32x4*)(VT4 + (size_t)r * 1024 + 16 * lane) = w4; }
    }
}

__device__ __forceinline__ void ph_peer(LAS unsigned char* lds, const float* SC, const bf16_t* H2, const unsigned char* UT, const unsigned char* VTb, const unsigned char* VT4, const float* mod, float* OUT, int G) {
    const int tid = opaque_tid(), lane = tid & 63, wave = __builtin_amdgcn_readfirstlane(tid >> 6);
    LAS float* scr = (LAS float*)(lds + wave * 8448);
    LAS int* idxs = (LAS int*)(lds + 69632 + wave * 4096);
    LAS float* gates = (LAS float*)(lds + 69632 + wave * 4096 + 2048);
    LAS float* dotb = (LAS float*)(lds + 102400 + wave * 1024);
    LAS int* hiI = (LAS int*)(lds + wave * 8448); LAS float* hiA = (LAS float*)(lds + wave * 8448 + 544);
    LAS int* loI = (LAS int*)(lds + wave * 8448 + 1088); LAS float* loA = (LAS float*)(lds + wave * 8448 + 1632);
    for (int it = blockIdx.x; it < 512; it += G) {
        const int tokw = it * 32 + wave * 4;
        for (int rep = 0; rep < ((DUP == 101) ? 2 : 1); ++rep) {
        float tk[16];
#pragma unroll
        for (int i = 0; i < 16; ++i) tk[i] = -INFINITY;
        for (int q = 0; q < 4; ++q) {
#pragma unroll
            for (int j = 0; j < 8; ++j) { const int prob = (lane >> 3) + 8 * j, seg = lane & 7;
                const f32x4 v = *(const f32x4*)(SC + (size_t)(tokw + (prob >> 4)) * 2048 + (prob & 15) * 128 + 32 * q + 4 * seg);
                LAS float* d = scr + prob * 33 + 4 * seg; d[0] = v[0]; d[1] = v[1]; d[2] = v[2]; d[3] = v[3]; }
            LDS_WAIT();
#pragma unroll 4
            for (int vi = 0; vi < 32; ++vi) {
                float x = __uint_as_float((__float_as_uint(scr[lane * 33 + vi]) & ~127u) | (unsigned)(127 - (32 * q + vi)));
#pragma unroll
                for (int i = 0; i < 16; ++i) { const float hi = fmaxf(tk[i], x); x = fminf(tk[i], x); tk[i] = hi; }
            }
            LDS_WAIT();
        }
        float t2[16];
#pragma unroll
        for (int i = 0; i < 16; ++i) t2[i] = __shfl_xor(tk[i], 1);
        float bv[16]; int bp[16];
#pragma unroll
        for (int i = 0; i < 16; ++i) { bv[i] = -INFINITY; bp[i] = 0; }
#pragma unroll
        for (int aa = 0; aa < 16; ++aa)
#pragma unroll
            for (int bb = 0; bb < 16 / (aa + 1); ++bb) {
                const unsigned u1 = __float_as_uint(tk[aa]), u2 = __float_as_uint(t2[bb]);
                float x = __uint_as_float(u1 & ~127u) + __uint_as_float(u2 & ~127u);
                int px = (int)(((127u - (u1 & 127u)) << 7) | (127u - (u2 & 127u)));
#pragma unroll
                for (int i = 0; i < 16; ++i) { const bool gt = x > bv[i]; const float nv = gt ? x : bv[i], ox = gt ? bv[i] : x; const int np = gt ? px : bp[i], op = gt ? bp[i] : px;
                    bv[i] = nv; x = ox; bp[i] = np; px = op; }
            }
        { float e[16], sum = 0.f;
#pragma unroll
          for (int i = 0; i < 16; ++i) { e[i] = __expf(bv[i] - bv[0]); sum += e[i]; }
          const float inv = 1.0f / sum;
          if ((lane & 1) == 0) { const int tl = lane >> 4, head = (lane & 15) >> 1;
#pragma unroll
              for (int i = 0; i < 16; ++i) { idxs[tl * 128 + head * 16 + i] = bp[i]; gates[tl * 128 + head * 16 + i] = e[i] * inv; } } }
        LDS_WAIT();
        }
        for (int tl = 0; tl < 4; ++tl) {
            const int token = tokw + tl;
            f32x2 ha[16];
            { const bf16_t* hrow = H2 + (size_t)token * 2048 + 4 * lane;
              u32x2 hw[8];
#pragma unroll
              for (int j = 0; j < 8; ++j) hw[j] = *(const u32x2*)(hrow + 256 * j);
#pragma unroll
              for (int j = 0; j < 4; ++j) { ha[4 * j + 0] = (f32x2){bf_lo(hw[j].x), bf_lo(hw[j + 4].x)}; ha[4 * j + 1] = (f32x2){bf_hi(hw[j].x), bf_hi(hw[j + 4].x)};
                  ha[4 * j + 2] = (f32x2){bf_lo(hw[j].y), bf_lo(hw[j + 4].y)}; ha[4 * j + 3] = (f32x2){bf_hi(hw[j].y), bf_hi(hw[j + 4].y)}; } }
            for (int grp = 0; grp < 8; ++grp) {
                u32x4 b4[16]; u32x2 b2[16];
#pragma unroll
                for (int r = 0; r < 16; ++r) { const int e = __builtin_amdgcn_readfirstlane(idxs[tl * 128 + grp * 16 + r]);
                    const unsigned char* rp = UT + (size_t)e * 1536; b4[r] = *(const u32x4*)(rp + 16 * lane); b2[r] = *(const u32x2*)(rp + 1024 + 8 * lane); }
                float pt[16];
#pragma unroll
                for (int r = 0; r < 16; ++r) { const u32x6 p6 = {b4[r].x, b4[r].y, b4[r].z, b4[r].w, b2[r].x, b2[r].y};
                    const f32x32 uv = __builtin_amdgcn_cvt_scalef32_pk32_f32_fp6(p6, 1.0f); f32x2 s = {0.f, 0.f};
#pragma unroll
                    for (int k = 0; k < 16; ++k) s = (f32x2){uv[2 * k], uv[2 * k + 1]} * ha[k] + s;
                    pt[r] = s.x + s.y; }
                const bool h5 = lane & 32, h4 = lane & 16, h3 = lane & 8, h2 = lane & 4; float w8[8], w4[4], w2[2], w1;
#pragma unroll
                for (int k = 0; k < 8; ++k) { const float keep = h5 ? pt[k + 8] : pt[k], send = h5 ? pt[k] : pt[k + 8]; w8[k] = keep + __shfl_xor(send, 32); }
#pragma unroll
                for (int k = 0; k < 4; ++k) { const float keep = h4 ? w8[k + 4] : w8[k], send = h4 ? w8[k] : w8[k + 4]; w4[k] = keep + __shfl_xor(send, 16); }
#pragma unroll
                for (int k = 0; k < 2; ++k) { const float keep = h3 ? w4[k + 2] : w4[k], send = h3 ? w4[k] : w4[k + 2]; w2[k] = keep + __shfl_xor(send, 8); }
                { const float keep = h2 ? w2[1] : w2[0], send = h2 ? w2[0] : w2[1]; w1 = keep + __shfl_xor(send, 4); }
                w1 += __shfl_xor(w1, 2); w1 += __shfl_xor(w1, 1);
                if ((lane & 3) == 0) dotb[grp * 16 + ((lane >> 5) & 1) * 8 + ((lane >> 4) & 1) * 4 + ((lane >> 3) & 1) * 2 + ((lane >> 2) & 1)] = w1;
            }
            LDS_WAIT();
            int nh, nl;
            { const float d0 = dotb[lane] * (1.0f / PEER_SU), d1 = dotb[lane + 64] * (1.0f / PEER_SU);
              const float a0 = gates[tl * 128 + lane] * gelu_tanh(d0), a1 = gates[tl * 128 + lane + 64] * gelu_tanh(d1);
              const int e0 = idxs[tl * 128 + lane], e1 = idxs[tl * 128 + lane + 64];
              const float thr2 = wave_sum(a0 * a0 + a1 * a1) * (0.25f / 128.0f);
              const bool hi0 = a0 * a0 >= thr2, hi1 = a1 * a1 >= thr2;
              const unsigned long long m0 = __ballot(hi0), m1 = __ballot(hi1), below = (1ull << lane) - 1ull;
              const int nh0 = __popcll(m0); nh = nh0 + __popcll(m1); nl = 128 - nh;
              const int p0 = hi0 ? __popcll(m0 & below) : __popcll(~m0 & below);
              const int p1 = hi1 ? nh0 + __popcll(m1 & below) : (64 - nh0) + __popcll(~m1 & below);
              LAS int* i0 = hi0 ? hiI : loI; LAS float* f0 = hi0 ? hiA : loA; LAS int* i1 = hi1 ? hiI : loI; LAS float* f1 = hi1 ? hiA : loA;
              LDS_WAIT();
              i0[p0] = e0; f0[p0] = a0 * (hi0 ? (1.0f / PEER_SV) : (1.0f / PEER_SV4)); i1[p1] = e1; f1[p1] = a1 * (hi1 ? (1.0f / PEER_SV) : (1.0f / PEER_SV4));
              if (lane < 8) { hiI[nh + lane] = 0; hiA[nh + lane] = 0.f; loI[nl + lane] = 0; loA[nl + lane] = 0.f; }
            }
            LDS_WAIT();
#pragma unroll
            for (int i = 0; i < 16; ++i) ha[i] = (f32x2){0.f, 0.f};
            for (int base = 0; base < nh; base += 8) {
                u32x4 b4[8]; u32x2 b2[8];
#pragma unroll
                for (int r = 0; r < 8; ++r) { const int e = __builtin_amdgcn_readfirstlane(hiI[base + r]);
                    const unsigned char* rp = VTb + (size_t)e * 1536; b4[r] = *(const u32x4*)(rp + 16 * lane); b2[r] = *(const u32x2*)(rp + 1024 + 8 * lane); }
#pragma unroll
                for (int r = 0; r < 8; ++r) { const float ar = hiA[base + r]; const f32x2 a2 = {ar, ar};
                    const u32x6 p6 = {b4[r].x, b4[r].y, b4[r].z, b4[r].w, b2[r].x, b2[r].y};
                    const f32x32 vv = __builtin_amdgcn_cvt_scalef32_pk32_f32_fp6(p6, 1.0f);
#pragma unroll
                    for (int k = 0; k < 16; ++k) ha[k] = (f32x2){vv[2 * k], vv[2 * k + 1]} * a2 + ha[k]; }
            }
            for (int base = 0; base < nl; base += 8) {
                u32x4 b4[8];
#pragma unroll
                for (int r = 0; r < 8; ++r) { const int e = __builtin_amdgcn_readfirstlane(loI[base + r]); b4[r] = *(const u32x4*)(VT4 + (size_t)e * 1024 + 16 * lane); }
#pragma unroll
                for (int r = 0; r < 8; ++r) { const float ar = loA[base + r]; const f32x2 a2 = {ar, ar};
#pragma unroll
                    for (int q = 0; q < 4; ++q) { const unsigned w = b4[r][q];
                        ha[4 * q + 0] = __builtin_amdgcn_cvt_scalef32_pk_f32_fp4(w, 1.0f, 0) * a2 + ha[4 * q + 0]; ha[4 * q + 1] = __builtin_amdgcn_cvt_scalef32_pk_f32_fp4(w, 1.0f, 1) * a2 + ha[4 * q + 1];
                        ha[4 * q + 2] = __builtin_amdgcn_cvt_scalef32_pk_f32_fp4(w, 1.0f, 2) * a2 + ha[4 * q + 2]; ha[4 * q + 3] = __builtin_amdgcn_cvt_scalef32_pk_f32_fp4(w, 1.0f, 3) * a2 + ha[4 * q + 3]; } }
            }
            { const int b = token >> 13; const float* gt2 = mod + (size_t)b * 12288 + 10240 + 4 * lane; float* orow = OUT + (size_t)token * 2048 + 4 * lane;
#pragma unroll
              for (int j = 0; j < 4; ++j) { const f32x4 x0 = *(const f32x4*)(orow + 256 * j), x1 = *(const f32x4*)(orow + 1024 + 256 * j);
                  const f32x4 g0 = *(const f32x4*)(gt2 + 256 * j), g1 = *(const f32x4*)(gt2 + 1024 + 256 * j); f32x4 o0, o1;
#pragma unroll
                  for (int e = 0; e < 4; ++e) { o0[e] = x0[e] + g0[e] * ha[4 * j + e].x; o1[e] = x1[e] + g1[e] * ha[4 * j + e].y; }
                  *(f32x4*)(orow + 256 * j) = o0; *(f32x4*)(orow + 1024 + 256 * j) = o1; } }
            LDS_WAIT();
        }
    }
}

__global__ void __launch_bounds__(512, 2) mk_fwd(Args args) {
    extern __shared__ __attribute__((aligned(16))) unsigned char lds_raw[];
    LAS unsigned char* lds = (LAS unsigned char*)lds_raw;
    const int tid = threadIdx.x, lane = tid & 63, wave = __builtin_amdgcn_readfirstlane(tid >> 6);
    const int G = gridDim.x, gw = blockIdx.x * 8 + wave, ngw = G * 8;
    unsigned char* ws = args.ws;
    volatile LAS unsigned* misc = (volatile LAS unsigned*)(lds + LDS_MAIN);
    if (tid < 4) misc[tid] = 0u;
    __syncthreads();
    const int lo = args.ph_lo, hi = args.ph_hi;
    XcdBarrier bar; bar.bar = (unsigned*)(ws + WS_CTL); bar.x = 0; bar.st = misc;
    if (hi - lo > 1) bar = xcd_barrier_post((unsigned*)(ws + WS_CTL), misc);
#ifndef PHMASK
#define PHMASK 0x7ff
#endif
#define IN(k) (((PHMASK >> (k)) & 1) && lo <= (k) && (k) < hi)
#define SEAM(k) do { if (IN(k) && IN((k) + 1)) xcd_barrier(bar); } while (0)
    float* mod = (float*)(ws + WS_MOD);
    bf16_t* HB = (bf16_t*)(ws + WS_H); bf16_t* PA = (bf16_t*)(ws + WS_PA); bf16_t* PG = (bf16_t*)(ws + WS_PG);
    bf16_t* YA = (bf16_t*)(ws + WS_YA); bf16_t* ATT = (bf16_t*)(ws + WS_ATT); f32x2* EB = (f32x2*)(ws + WS_E); bf16_t* UBp = (bf16_t*)(ws + WS_UB);

#define PHS(code, ...) do { __VA_ARGS__ if (DUP == (code)) { xcd_barrier(bar); __VA_ARGS__ } } while (0)
#define PH(k, ...) do { if (IN(k)) { __VA_ARGS__ if (DUP == (k)) { xcd_barrier(bar); __VA_ARGS__ } } } while (0)
    PH(0, { ph_mod_partial(args.in[I_C], args.in[I_WADA], (float*)(ws + WS_MODP), gw, ngw, lane); ph_colmax_partial(args.in[I_WIN], (float*)(ws + WS_CMAXP), gw, ngw, lane); });
    SEAM(0);
    PH(1, { ph_prologue(args, lds, gw, ngw, lane, wave); });
    SEAM(1);
    PH(2, { ph_norm<true>(args.in[I_X], HB, (float*)(ws + WS_SA), args.in[I_N1G], mod, 0, 2048, gw, ngw, lane); });
    SEAM(2);
    PH(3, { pg8::Gemm g{HB, (const bf16_t*)(ws + WS_WIN), T_TOK, 8192, 1024}; pg8::StaticOrder S; S.init(T_TOK, 8192, G, (int)blockIdx.x);
        pg8::EpiProj E{PA, PG, UBp, (const float*)(ws + WS_SA), (const float*)(ws + WS_SB)}; pg8::gemm_phase<pg8::EpiProj, pg8::StaticOrder, true, true, 1>(lds, g, S, E); });
    SEAM(3);
    PH(4, { PHS(41, { ph_attn<0>(lds, PA, ATT, args.in[I_QNG], args.in[I_KNG], G); __syncthreads(); });
        if (DUP == 411) { xcd_barrier(bar); ph_attn<1>(lds, PA, ATT, args.in[I_QNG], args.in[I_KNG], G); __syncthreads(); } PHS(42, { ph_ssm_mfma<false>(args, lds, UBp, EB, YA, G); }); });
    SEAM(4);
    PH(5, { PHS(51, { ph_ssm_mfma<true>(args, lds, UBp, EB, YA, G); __syncthreads(); });
        PHS(52, { pg8::Gemm g{ATT, (const bf16_t*)(ws + WS_WATT), T_TOK, 2048, 512}; pg8::SplitOrder S; S.init(T_TOK, 2048, G, (int)blockIdx.x);
        pg8::EpiAttUp E{PG, HB}; pg8::gemm_phase<pg8::EpiAttUp, pg8::SplitOrder, true, true, 2>(lds, g, S, E); }); });
    SEAM(5);
    PH(6, { pg8::Gemm g{YA, (const bf16_t*)(ws + WS_WGLU), T_TOK, 4096, 512}; pg8::StaticOrder S; S.init(T_TOK, 4096, G, (int)blockIdx.x);
        pg8::EpiGlu E{PG, HB, (unsigned char*)ATT}; pg8::gemm_phase<pg8::EpiGlu, pg8::StaticOrder, true, true, 2>(lds, g, S, E); });
    SEAM(6);
    PH(7, { pg8::Gemm g{ATT, (const bf16_t*)(ws + WS_WOUT), T_TOK, 2048, 1024}; pg8::StaticOrder S; S.init(T_TOK, 2048, G, (int)blockIdx.x);
        pg8::EpiOut E{args.in[I_X], args.out, mod}; pg8::gemm_phase<pg8::EpiOut, pg8::StaticOrder, true, true, 2>(lds, g, S, E);
        ph_table_cvt(args.in[I_PU], args.in[I_PV], ws + WS_UT, ws + WS_VT, ws + WS_VT4, gw, ngw, lane); });
    SEAM(7);
    PH(8, { ph_norm<false>(args.out, HB, nullptr, args.in[I_N2G], mod, 6144, 8192, gw, ngw, lane); });
    SEAM(8);
    PH(9, { pg8::Gemm g{HB, (const bf16_t*)(ws + WS_WSC), T_TOK, 2048, 2048}; pg8::StaticOrder S; S.init(T_TOK, 2048, G, (int)blockIdx.x);
        pg8::EpiF32 E{(float*)(ws + WS_SC)}; pg8::gemm_phase<pg8::EpiF32, pg8::StaticOrder, true, true>(lds, g, S, E); });
    SEAM(9);
    PH(10, { ph_peer(lds, (const float*)(ws + WS_SC), HB, ws + WS_UT, ws + WS_VT, ws + WS_VT4, mod, args.out, G); });
#undef IN
#undef SEAM
}

extern "C" void kernel_launch(void* const* d_in, const int* in_sizes, int n_in, void* d_out, int out_size, void* d_ws, size_t ws_size, hipStream_t stream) {
    static int grid = 0;
    if (grid == 0) {
        if (n_in != 25 || out_size != T_TOK * DM || ws_size < WS_END) { fprintf(stderr, "kernel_launch: unexpected shapes (n_in %d out %d ws %zu need %zu)\n", n_in, out_size, ws_size, (size_t)WS_END); grid = -1; return; }
        int dev = 0, cus = 0, per_cu = 0;
        if (hipGetDevice(&dev) != hipSuccess || hipDeviceGetAttribute(&cus, hipDeviceAttributeMultiprocessorCount, dev) != hipSuccess) { grid = -1; return; }
        if (hipFuncSetAttribute((const void*)mk_fwd, hipFuncAttributeMaxDynamicSharedMemorySize, LDS_BYTES) != hipSuccess) { fprintf(stderr, "kernel_launch: hipFuncSetAttribute failed\n"); grid = -1; return; }
        if (hipOccupancyMaxActiveBlocksPerMultiprocessor(&per_cu, (const void*)mk_fwd, 512, LDS_BYTES) != hipSuccess || per_cu < 1) { fprintf(stderr, "kernel_launch: occupancy query says %d blocks/CU\n", per_cu); (void)hipGetLastError(); grid = -1; return; }
        grid = cus;
    }
    if (grid < 0) return;
    (void)hipMemsetAsync((char*)d_ws + WS_CTL, 0, 16384, stream);
    Args a{};
    for (int i = 0; i < 25; ++i) a.in[i] = (const float*)d_in[i];
    a.out = (float*)d_out; a.ws = (unsigned char*)d_ws;
#if MK_PER_PHASE
    for (int ph = 0; ph < NPHASE; ++ph) { a.ph_lo = ph; a.ph_hi = ph + 1; hipLaunchKernelGGL(mk_fwd, dim3(grid), dim3(512), LDS_BYTES, stream, a); }
#else
    a.ph_lo = 0; a.ph_hi = NPHASE;
    hipLaunchKernelGGL(mk_fwd, dim3(grid), dim3(512), LDS_BYTES, stream, a);
#endif
}
```

```cpp
#include <hip/hip_runtime.h>
#include <cstdio>
#include <cstdint>

#ifndef MK_PER_PHASE
#define MK_PER_PHASE 0
#endif

#ifndef DUP
#define DUP -1
#endif
#define LAS __attribute__((address_space(3)))
typedef unsigned short bf16_t;
typedef short bf16x8 __attribute__((ext_vector_type(8)));
typedef float f32x4 __attribute__((ext_vector_type(4)));
typedef float f32x2 __attribute__((ext_vector_type(2)));
typedef unsigned u32x4 __attribute__((ext_vector_type(4)));
typedef unsigned u32x2 __attribute__((ext_vector_type(2)));
typedef int i32x4 __attribute__((ext_vector_type(4)));

constexpr int T_TOK = 16384, DM = 2048, SEQ = 8192;
constexpr int NPHASE = 14;
constexpr float EPS = 1e-6f;

constexpr size_t WS_CTL   = 0;
constexpr size_t WS_MODP  = 65536;
constexpr size_t WS_MOD   = WS_MODP + (size_t)32 * 2 * 12288 * 4;
constexpr size_t WS_WIN   = WS_MOD + (size_t)2 * 12288 * 4;
constexpr size_t WS_WGLU  = WS_WIN + (size_t)8192 * 2048 * 2;
constexpr size_t WS_WATT  = WS_WGLU + (size_t)4096 * 1024 * 2;
constexpr size_t WS_WOUT  = WS_WATT + (size_t)2048 * 1024 * 2;
constexpr size_t WS_WSC   = WS_WOUT + (size_t)2048 * 2048 * 2;
constexpr size_t WS_H     = WS_WSC + (size_t)2048 * 2048 * 2;
constexpr size_t WS_PA    = WS_H + (size_t)T_TOK * 2048 * 2;
constexpr size_t WS_PG    = WS_PA + (size_t)T_TOK * 4096 * 2;
constexpr size_t WS_E     = WS_PG + (size_t)T_TOK * 4096 * 2;
constexpr size_t WS_YA    = WS_E + (size_t)2 * 64 * 128 * 64 * 8;
constexpr size_t WS_ATT   = WS_YA + (size_t)T_TOK * 1024 * 2;
constexpr size_t WS_UB    = WS_ATT + (size_t)T_TOK * 1024 * 2;
constexpr size_t WS_SA    = WS_UB + (size_t)T_TOK * 1024 * 2;
constexpr size_t WS_SB    = WS_SA + (size_t)T_TOK * 4;
constexpr size_t WS_CMAXP = WS_SB + (size_t)8192 * 4;
constexpr size_t WS_END   = WS_CMAXP + (size_t)32 * 8192 * 4;
constexpr size_t WS_SC    = WS_PA;
constexpr size_t WS_UT    = WS_PG;
constexpr size_t WS_VT    = WS_PG + (size_t)8 * 16384 * 192;
constexpr size_t WS_PDOT  = WS_VT + (size_t)8 * 16384 * 192;
constexpr size_t WS_IDX   = WS_YA;
constexpr size_t WS_GATE  = WS_YA + (size_t)T_TOK * 128 * 4;
constexpr size_t WS_ACT   = WS_GATE + (size_t)T_TOK * 128 * 4;
static_assert(WS_PDOT + (size_t)8 * T_TOK * 128 * 4 <= WS_PG + (size_t)T_TOK * 4096 * 2, "PEER buffers must fit the dead g_ssm|g_att region");
static_assert(WS_ACT + (size_t)T_TOK * 128 * 4 <= WS_YA + (size_t)T_TOK * 1024 * 2, "PEER index buffers must fit the dead YA region");
constexpr int LDS_MAIN = 131072, LDS_BYTES = LDS_MAIN + 256;

typedef __bf16 bf16x2_t __attribute__((ext_vector_type(2)));
__device__ __forceinline__ unsigned cvt_pk_bf16(float lo, float hi) { const f32x2 v = {lo, hi}; return __builtin_bit_cast(unsigned, __builtin_convertvector(v, bf16x2_t)); }
__device__ __forceinline__ float bf_lo(unsigned w) { return __uint_as_float(w << 16); }
__device__ __forceinline__ float bf_hi(unsigned w) { return __uint_as_float(w & 0xffff0000u); }
__device__ __forceinline__ float wave_sum(float v) {
#pragma unroll
    for (int o = 1; o < 64; o <<= 1) v += __shfl_xor(v, o);
    return v;
}
__device__ __forceinline__ float sigmoidf_(float x) { return 1.0f / (1.0f + __expf(-x)); }
__device__ __forceinline__ float gelu_tanh(float x) {
    const float a = 0.7978845608028654f * (x + 0.044715f * x * x * x);
    const float t = 1.0f - 2.0f / (__expf(2.0f * a) + 1.0f);
    return 0.5f * x * (1.0f + t);
}
constexpr float F8_SA = 8.0f, F8_SW = 64.0f, F8_INV = 1.0f / 512.0f;
__device__ __forceinline__ unsigned pack4_fp8(float a, float b, float c, float d, float sc) {
    a = fminf(fmaxf(a * sc, -448.f), 448.f); b = fminf(fmaxf(b * sc, -448.f), 448.f); c = fminf(fmaxf(c * sc, -448.f), 448.f); d = fminf(fmaxf(d * sc, -448.f), 448.f);
    int p = 0; p = __builtin_amdgcn_cvt_pk_fp8_f32(a, b, p, false); p = __builtin_amdgcn_cvt_pk_fp8_f32(c, d, p, true); return (unsigned)p; }
#define LDS_WAIT() asm volatile("s_waitcnt lgkmcnt(0)" ::: "memory")
__device__ __forceinline__ int opaque_tid() { int t = threadIdx.x; asm volatile("" : "+v"(t)); return t; }

#define XB_TMO      128
#define XB_XCNT(j)  (256  + 64 * (j))
#define XB_XSUB(j)  (1280 + 64 * (j))
#define XB_XGEN(j)  (2304 + 64 * (j))
#define XB_TOP      3328
#define XB_TOPGEN   3392
#define XCD_BAR_WORDS 3456
#define XB_SPIN_CAP (1u << 22)
__device__ __forceinline__ unsigned xb_ld(unsigned* p)              { return __hip_atomic_load(p, __ATOMIC_RELAXED, __HIP_MEMORY_SCOPE_AGENT); }
__device__ __forceinline__ unsigned xb_add(unsigned* p, unsigned v) { return __hip_atomic_fetch_add(p, v, __ATOMIC_RELAXED, __HIP_MEMORY_SCOPE_AGENT); }
__device__ __forceinline__ unsigned xb_xcc_id() { return (unsigned)__builtin_amdgcn_s_getreg((3 << 11) | 20) & 0xFu; }
#define XB_SPIN(cond, bar) do { unsigned _sp = 0; while (cond) { __builtin_amdgcn_s_sleep(1); \
    if ((++_sp & 255u) == 0u) { if (xb_ld(&(bar)[XB_TMO])) break; if (_sp > XB_SPIN_CAP) { atomicAdd(&(bar)[XB_TMO], 1u); break; } } } } while (0)
struct XcdBarrier { unsigned* bar; unsigned x; volatile LAS unsigned* st; };
__device__ __forceinline__ XcdBarrier xcd_barrier_post(unsigned* bar, volatile LAS unsigned* st) {
    XcdBarrier b; b.bar = bar; b.x = xb_xcc_id(); b.st = st;
    if (threadIdx.x == 0) (void)xb_add(&bar[XB_XCNT(b.x)], 1u);
    return b;
}
__device__ __forceinline__ void xcd_barrier_complete(unsigned* bar, unsigned x, unsigned& nloc, unsigned& nx) {
    const unsigned G = gridDim.x * gridDim.y * gridDim.z;
    unsigned sum, cnt, mine, sp = 0u;
    for (;;) {
        sum = 0u; cnt = 0u; mine = 0u;
#pragma unroll
        for (unsigned j = 0; j < 16; ++j) { const unsigned c = xb_ld(&bar[XB_XCNT(j)]); sum += c; cnt += (c > 0u) ? 1u : 0u; mine = (j == x) ? c : mine; }
        if (sum == G) break;
        __builtin_amdgcn_s_sleep(1);
        if ((++sp & 255u) == 0u) { if (xb_ld(&bar[XB_TMO])) break; if (sp > XB_SPIN_CAP) { atomicAdd(&bar[XB_TMO], 1u); break; } }
    }
    nloc = mine > 0u ? mine : 1u; nx = cnt > 0u ? cnt : 1u;
}
__device__ __forceinline__ void xcd_barrier(const XcdBarrier& b) {
    asm volatile("s_waitcnt vmcnt(0)" ::: "memory");
    __syncthreads();
    if (threadIdx.x == 0) {
        unsigned* bar = b.bar;
        __builtin_amdgcn_s_waitcnt(0);
        unsigned nloc = b.st[0], nx = b.st[1];
        if (nloc == 0u) { xcd_barrier_complete(bar, b.x, nloc, nx); b.st[0] = nloc; b.st[1] = nx; }
        const unsigned old = xb_add(&bar[XB_XSUB(b.x)], 1u);
        const unsigned gen = old / nloc;
        if (old + 1u == (gen + 1u) * nloc) {
            __builtin_amdgcn_fence(__ATOMIC_RELEASE, "agent");
            asm volatile("s_waitcnt vmcnt(0)" ::: "memory");
            const unsigned og = xb_add(&bar[XB_TOP], 1u);
            const unsigned tg = og / nx;
            if (og + 1u == (tg + 1u) * nx) xb_add(&bar[XB_TOPGEN], 1u);
            else XB_SPIN(xb_ld(&bar[XB_TOPGEN]) == tg, bar);
            __builtin_amdgcn_fence(__ATOMIC_ACQUIRE, "agent");
            xb_add(&bar[XB_XGEN(b.x)], 1u);
            asm volatile("s_waitcnt vmcnt(0)" ::: "memory");
        } else {
            XB_SPIN(xb_ld(&bar[XB_XGEN(b.x)]) == gen, bar);
            __builtin_amdgcn_fence(__ATOMIC_ACQUIRE, "agent");
            asm volatile("s_waitcnt vmcnt(0)" ::: "memory");
        }
    }
    __syncthreads();
}

namespace pg8 {
constexpr int BM = 256, BK = 64, HALF = 128, HTB = HALF * BK * 2, STAGE_BYTES = 8 * HTB, NXCD = 8, WGM = 8;
__host__ __device__ __forceinline__ int lds_byte(int r, int c) { const int st = (r >> 4) * 2 + (c >> 5), rr = r & 15, cc = c & 31, ob = rr * 64 + cc * 2; return st * 1024 + (ob ^ (((ob >> 9) & 1) << 5)); }
__host__ __device__ __forceinline__ void stage_rc(int b, int& R, int& C) { const int st = b / 1024, sb = b % 1024, swz = sb ^ (((sb >> 9) & 1) << 5); R = (st >> 1) * 16 + swz / 64; C = (st & 1) * 32 + (swz % 64) / 2; }
__host__ __device__ __forceinline__ int perm32(int rho) { const int n = rho >> 4, i = rho & 15; return 8 * (i >> 2) + 4 * n + (i & 3); }
struct Unit { int pm, pn; };
struct Gemm { const bf16_t* A; const bf16_t* Bt; int M, N, K; };
struct StaticOrder {
    int nM, nN, nwg, G, c;
    __host__ __device__ void init(int M, int N, int G_, int c_) { nM = M / BM; nN = N / BM; nwg = nM * nN; G = G_; c = c_; }
    __host__ __device__ bool next(int i, Unit& u) const { return at((long)i * G + c, u); }
    __host__ __device__ bool at(long L, Unit& u) const {
        if (L >= nwg) return false;
        int wgid = (int)L; { const int q = nwg / NXCD, r = nwg % NXCD, xcd = wgid % NXCD, off = wgid / NXCD; wgid = (xcd < r ? xcd * (q + 1) : r * (q + 1) + (xcd - r) * q) + off; }
        const int nig = WGM * nN, gid = wgid / nig, fm = gid * WGM, gsz = (nM - fm) < WGM ? (nM - fm) : WGM;
        u.pm = fm + ((wgid % nig) % gsz); u.pn = (wgid % nig) / gsz; return true;
    }
    __device__ __forceinline__ void a_ready(const Unit&) const {}
    __device__ __forceinline__ void done(const Unit&) const {}
};
struct SplitOrder {
    StaticOrder b;
    __host__ __device__ void init(int M, int N, int G_, int c_) { b.init(M, N, G_, c_); }
    __host__ __device__ bool next(int i, Unit& u) const {
        if (b.G != 256 || b.nwg != 512) return b.next(i, u);
        if (b.c < 128) return i < 1 ? b.at(b.c, u) : false;
        return i < 3 ? b.at(128 + (b.c - 128) * 3 + i, u) : false;
    }
    __device__ __forceinline__ void a_ready(const Unit&) const {}
    __device__ __forceinline__ void done(const Unit&) const {}
};
typedef int i32x8 __attribute__((ext_vector_type(8)));
template <class Epi, class Sched, bool ALIGN_EPI = false, bool SP2 = false, int MODE = 0>
__device__ __forceinline__ void gemm_phase(LAS unsigned char* lds, const Gemm g, const Sched& S, const Epi& E) {
    const int tid = threadIdx.x, wid = __builtin_amdgcn_readfirstlane(tid >> 6), lane = tid & 63, wr = wid >> 2, wc = wid & 3, fr = lane & 15, fq = lane >> 4;
    const int K = g.K, nt = K / BK;
    unsigned voffA[2], voffB[2];
#pragma unroll
    for (int i = 0; i < 2; ++i) { int R, C; stage_rc(tid * 16 + i * 8192, R, C); const int Rb = Epi::PERM ? ((R & ~31) + perm32(R & 31)) : R;
        voffA[i] = (unsigned)(R * K + C) * 2u; voffB[i] = (unsigned)(Rb * K + C) * 2u; }
    const size_t kstep = (size_t)(BK * 2);
    const size_t hstep = (size_t)HALF * K * 2;
    const size_t tstep = 2 * hstep;
    const unsigned ldsw = (unsigned)wid * 1024u;
    const int aoff = lds_byte(wr * 64 + fr, fq * 8), boff = lds_byte(wc * 32 + fr, fq * 8);
#define PG8_SA(b, h) (((b) * 2 + (h)) * HTB)
#define PG8_SB(b, h) ((4 + (b) * 2 + (h)) * HTB)
#define PG8_STAGE(bufoff, gbase, voff) do { _Pragma("unroll") for (int _i = 0; _i < 2; ++_i) \
        __builtin_amdgcn_global_load_lds((const unsigned*)((const char*)(gbase) + (voff)[_i]), (LAS unsigned*)(lds + (bufoff) + ldsw + _i * 8192), 16, 0, 0); } while (0)
#define PG8_LD8(p_) ({ const i32x4 _lo = *(const LAS i32x4*)(p_), _hi = *(const LAS i32x4*)((p_) + 1024); (i32x8){_lo[0], _lo[1], _lo[2], _lo[3], _hi[0], _hi[1], _hi[2], _hi[3]}; })
#define PG8_LDA(dst, b, h) do { _Pragma("unroll") for (int m = 0; m < 4; ++m) dst[m] = PG8_LD8(lds + PG8_SA(b, h) + aoff + m * 2048); } while (0)
#define PG8_LDB(dst, b, h) do { _Pragma("unroll") for (int n = 0; n < 2; ++n) dst[n] = PG8_LD8(lds + PG8_SB(b, h) + boff + n * 2048); } while (0)
#define PG8_HALF(v, k) ((k) == 0 ? __builtin_shufflevector(v, v, 0, 1, 2, 3) : __builtin_shufflevector(v, v, 4, 5, 6, 7))
#define PG8_MMA(ai, bj, At, Bt) do { __builtin_amdgcn_s_setprio(1); _Pragma("unroll") for (int m = 0; m < 4; ++m) _Pragma("unroll") for (int n = 0; n < 2; ++n) { \
        if (MODE == 2) asm volatile("v_mfma_scale_f32_16x16x128_f8f6f4 %0, %1, %2, %0, %3, %3 op_sel_hi:[0,0,0]" : "+v"(acc[ai][bj][m][n]) : "v"(Bt[n]), "v"(At[m]), "v"(scl1)); \
        else { _Pragma("unroll") for (int k = 0; k < 2; ++k) \
            acc[ai][bj][m][n] = (MODE == 1) ? __builtin_bit_cast(f32x4, __builtin_amdgcn_mfma_i32_16x16x64_i8(PG8_HALF(Bt[n], k), PG8_HALF(At[m], k), __builtin_bit_cast(i32x4, acc[ai][bj][m][n]), 0, 0, 0)) \
                                            : __builtin_amdgcn_mfma_f32_16x16x32_bf16(__builtin_bit_cast(bf16x8, PG8_HALF(Bt[n], k)), __builtin_bit_cast(bf16x8, PG8_HALF(At[m], k)), acc[ai][bj][m][n], 0, 0, 0); } } __builtin_amdgcn_s_setprio(0); } while (0)
#define PG8_WAIT_V(n) asm volatile("s_waitcnt vmcnt(" #n ")" ::: "memory")
#define PG8_WAIT_L(n) asm volatile("s_waitcnt lgkmcnt(" #n ")" ::: "memory")
#define PG8_BAR __builtin_amdgcn_s_barrier()
#define PG8_SCHED __builtin_amdgcn_sched_barrier(0)
    const int scl1 = 0x7f7f7f7f;
    Unit cur, nxt; int ui = 0;
    if (!S.next(0, cur)) return;
    f32x4 acc[2][2][4][2];
#pragma unroll
    for (int a = 0; a < 2; ++a)
#pragma unroll
        for (int b = 0; b < 2; ++b)
#pragma unroll
            for (int m = 0; m < 4; ++m)
#pragma unroll
                for (int n = 0; n < 2; ++n) acc[a][b][m][n] = (f32x4){0.f, 0.f, 0.f, 0.f};
    i32x8 At[4], B0[2], B1[2];
    const char* cA = (const char*)g.A + (size_t)cur.pm * tstep; const char* cB = (const char*)g.Bt + (size_t)cur.pn * tstep;
    S.a_ready(cur);
    if constexpr (SP2) {
        PG8_STAGE(PG8_SB(0, 0), cB, voffB); PG8_STAGE(PG8_SB(0, 1), cB + hstep, voffB); PG8_STAGE(PG8_SA(0, 0), cA, voffA); PG8_STAGE(PG8_SA(0, 1), cA + hstep, voffA);
        if (wr == 1) PG8_BAR;
        PG8_WAIT_V(2); PG8_BAR;
        PG8_STAGE(PG8_SB(1, 0), cB + kstep, voffB); PG8_STAGE(PG8_SA(1, 0), cA + kstep, voffA); PG8_STAGE(PG8_SB(1, 1), cB + hstep + kstep, voffB);
        PG8_WAIT_V(6); PG8_BAR;
    } else {
        PG8_STAGE(PG8_SB(0, 0), cB, voffB); PG8_STAGE(PG8_SA(0, 0), cA, voffA); PG8_STAGE(PG8_SB(0, 1), cB + hstep, voffB); PG8_STAGE(PG8_SA(0, 1), cA + hstep, voffA);
        if (wr == 1) PG8_BAR;
        PG8_WAIT_V(4); PG8_BAR;
        PG8_STAGE(PG8_SB(1, 0), cB + kstep, voffB); PG8_STAGE(PG8_SA(1, 0), cA + kstep, voffA); PG8_STAGE(PG8_SB(1, 1), cB + hstep + kstep, voffB);
        PG8_WAIT_V(6); PG8_BAR;
    }
    for (;;) {
        const bool has_next = S.next(ui + 1, nxt);
        const char* nA = has_next ? (const char*)g.A + (size_t)nxt.pm * tstep : cA; const char* nB = has_next ? (const char*)g.Bt + (size_t)nxt.pn * tstep : cB;
#pragma unroll 1
        for (int t = 0; t < nt; t += 2) {
            const bool last = (t == nt - 2);
            const char* a1 = cA + (size_t)(t + 1) * kstep;
            const char* a2 = last ? nA : cA + (size_t)(t + 2) * kstep; const char* b2 = last ? nB : cB + (size_t)(t + 2) * kstep;
            const char* a3 = a2 + kstep; const char* b3 = b2 + kstep;
            if (last && has_next) S.a_ready(nxt);
            if constexpr (SP2) {
            PG8_LDB(B0, 0, 0); PG8_LDB(B1, 0, 1); PG8_SCHED; PG8_LDA(At, 0, 0); PG8_STAGE(PG8_SA(1, 1), a1 + hstep, voffA);
            PG8_WAIT_V(8); PG8_WAIT_L(0); PG8_BAR; PG8_MMA(0, 0, At, B0); PG8_MMA(0, 1, At, B1); PG8_BAR; PG8_SCHED;
            PG8_LDA(At, 0, 1); PG8_STAGE(PG8_SB(0, 0), b2, voffB); PG8_STAGE(PG8_SB(0, 1), b2 + hstep, voffB); PG8_STAGE(PG8_SA(0, 0), a2, voffA);
            PG8_WAIT_V(8); PG8_WAIT_L(0); PG8_BAR; PG8_MMA(1, 0, At, B0); PG8_MMA(1, 1, At, B1); PG8_BAR; PG8_SCHED;
            PG8_LDB(B0, 1, 0); PG8_LDB(B1, 1, 1); PG8_SCHED; PG8_LDA(At, 1, 0); PG8_STAGE(PG8_SA(0, 1), a2 + hstep, voffA);
            PG8_WAIT_V(8); PG8_WAIT_L(0); PG8_BAR; PG8_MMA(0, 0, At, B0); PG8_MMA(0, 1, At, B1); PG8_BAR; PG8_SCHED;
            PG8_LDA(At, 1, 1); PG8_STAGE(PG8_SB(1, 0), b3, voffB); PG8_STAGE(PG8_SB(1, 1), b3 + hstep, voffB); PG8_STAGE(PG8_SA(1, 0), a3, voffA);
            PG8_WAIT_V(8); PG8_WAIT_L(0); PG8_BAR; PG8_MMA(1, 0, At, B0); PG8_MMA(1, 1, At, B1); PG8_BAR; PG8_SCHED;
            } else {
            PG8_LDB(B0, 0, 0); PG8_SCHED; PG8_LDA(At, 0, 0); PG8_STAGE(PG8_SA(1, 1), a1 + hstep, voffA);
            PG8_WAIT_L(8); PG8_BAR; PG8_WAIT_L(0); PG8_MMA(0, 0, At, B0); PG8_BAR; PG8_SCHED;
            PG8_LDB(B1, 0, 1); PG8_STAGE(PG8_SB(0, 0), b2, voffB);
            PG8_BAR; PG8_WAIT_L(0); PG8_MMA(0, 1, At, B1); PG8_BAR;
            PG8_LDA(At, 0, 1); PG8_STAGE(PG8_SA(0, 0), a2, voffA);
            PG8_BAR; PG8_WAIT_L(0); PG8_MMA(1, 0, At, B0); PG8_BAR; PG8_SCHED;
            PG8_STAGE(PG8_SB(0, 1), b2 + hstep, voffB);
            PG8_WAIT_V(6); PG8_BAR; PG8_MMA(1, 1, At, B1); PG8_BAR;
            PG8_LDB(B0, 1, 0); PG8_SCHED; PG8_LDA(At, 1, 0); PG8_STAGE(PG8_SA(0, 1), a2 + hstep, voffA);
            PG8_WAIT_L(8); PG8_BAR; PG8_WAIT_L(0); PG8_MMA(0, 0, At, B0); PG8_BAR; PG8_SCHED;
            PG8_LDB(B1, 1, 1); PG8_STAGE(PG8_SB(1, 0), b3, voffB);
            PG8_BAR; PG8_WAIT_L(0); PG8_MMA(0, 1, At, B1); PG8_BAR;
            PG8_LDA(At, 1, 1); PG8_STAGE(PG8_SA(1, 0), a3, voffA);
            PG8_BAR; PG8_WAIT_L(0); PG8_MMA(1, 0, At, B0); PG8_BAR; PG8_SCHED;
            PG8_STAGE(PG8_SB(1, 1), b3 + hstep, voffB);
            PG8_WAIT_V(6); PG8_BAR; PG8_MMA(1, 1, At, B1); PG8_BAR;
            }
        }
        if constexpr (ALIGN_EPI) { if (wr == 0) PG8_BAR; }
        if (MODE == 2) asm volatile("s_nop 15\n\ts_nop 15" ::: "memory");
        E(acc, cur, wr, wc, fr, fq); S.done(cur);
        if (!has_next) break;
#pragma unroll
        for (int a = 0; a < 2; ++a)
#pragma unroll
            for (int b = 0; b < 2; ++b)
#pragma unroll
                for (int m = 0; m < 4; ++m)
#pragma unroll
                    for (int n = 0; n < 2; ++n) acc[a][b][m][n] = (f32x4){0.f, 0.f, 0.f, 0.f};
        cur = nxt; cA = nA; cB = nB; ++ui;
        if constexpr (ALIGN_EPI) { if (wr == 1) PG8_BAR; }
    }
    PG8_WAIT_V(0);
    if constexpr (!ALIGN_EPI) { if (wr == 0) PG8_BAR; }
    PG8_BAR;
#undef PG8_SA
#undef PG8_SB
#undef PG8_STAGE
#undef PG8_LDA
#undef PG8_LDB
#undef PG8_MMA
#undef PG8_WAIT_V
#undef PG8_WAIT_L
#undef PG8_BAR
#undef PG8_SCHED
}

struct EpiProj {
    static constexpr bool PERM = true;
    bf16_t* PA; bf16_t* PG; bf16_t* UB; const float* SA; const float* SB;
    __device__ __forceinline__ void operator()(const f32x4 (&acc)[2][2][4][2], const Unit& u, int wr, int wc, int fr, int fq) const {
        const int row0 = u.pm * BM + wr * 64 + fr; int colt = u.pn * BM; const bool isu = colt < 1024; bf16_t* base = colt < 4096 ? PA : PG;
        const int gcol0 = colt + wc * 32 + 8 * fq; colt &= 4095;
        const int col0 = colt + wc * 32 + 8 * fq;
        f32x4 sb[2][2];
#pragma unroll
        for (int bj = 0; bj < 2; ++bj) { sb[bj][0] = *(const f32x4*)(SB + gcol0 + bj * HALF); sb[bj][1] = *(const f32x4*)(SB + gcol0 + bj * HALF + 4); }
#pragma unroll
        for (int ai = 0; ai < 2; ++ai)
#pragma unroll
            for (int m = 0; m < 4; ++m) { const int row = row0 + ai * HALF + m * 16; bf16_t* rowp = base + (size_t)row * 4096 + col0; const float sa = SA[row];
#pragma unroll
                for (int bj = 0; bj < 2; ++bj) { const i32x4 i0 = __builtin_bit_cast(i32x4, acc[ai][bj][m][0]), i1 = __builtin_bit_cast(i32x4, acc[ai][bj][m][1]);
                    f32x4 v0, v1;
#pragma unroll
                    for (int e = 0; e < 4; ++e) { v0[e] = (float)i0[e] * sa * sb[bj][0][e]; v1[e] = (float)i1[e] * sa * sb[bj][1][e]; }
                    u32x4 w; w.x = cvt_pk_bf16(v0[0], v0[1]); w.y = cvt_pk_bf16(v0[2], v0[3]); w.z = cvt_pk_bf16(v1[0], v1[1]); w.w = cvt_pk_bf16(v1[2], v1[3]);
                    if (isu) { const int cu = col0 + bj * HALF; *(u32x4*)(UB + (((size_t)((row >> 13) * 64 + (cu >> 4)) * 8192 + (row & 8191)) * 16 + (cu & 8))) = w; }
                    else *(u32x4*)(rowp + bj * HALF) = w; } }
    }
};
struct EpiAttUp {
    static constexpr bool PERM = true;
    const bf16_t* PG; bf16_t* HB;
    __device__ __forceinline__ void operator()(const f32x4 (&acc)[2][2][4][2], const Unit& u, int wr, int wc, int fr, int fq) const {
        const int row0 = u.pm * BM + wr * 64 + fr; const int col0 = u.pn * BM + wc * 32 + 8 * fq;
#pragma unroll
        for (int ai = 0; ai < 2; ++ai)
#pragma unroll
            for (int m = 0; m < 4; ++m) { const size_t row = (size_t)(row0 + ai * HALF + m * 16);
#pragma unroll
                for (int bj = 0; bj < 2; ++bj) { const int col = col0 + bj * HALF;
                    const u32x4 gw = *(const u32x4*)(PG + row * 4096 + 2048 + col);
                    const f32x4 v0 = acc[ai][bj][m][0] * F8_INV, v1 = acc[ai][bj][m][1] * F8_INV;
                    u32x4 w;
                    w.x = cvt_pk_bf16(v0[0] * sigmoidf_(bf_lo(gw.x)), v0[1] * sigmoidf_(bf_hi(gw.x)));
                    w.y = cvt_pk_bf16(v0[2] * sigmoidf_(bf_lo(gw.y)), v0[3] * sigmoidf_(bf_hi(gw.y)));
                    w.z = cvt_pk_bf16(v1[0] * sigmoidf_(bf_lo(gw.z)), v1[1] * sigmoidf_(bf_hi(gw.z)));
                    w.w = cvt_pk_bf16(v1[2] * sigmoidf_(bf_lo(gw.w)), v1[3] * sigmoidf_(bf_hi(gw.w)));
                    *(u32x4*)(HB + row * 2048 + col) = w; } asm volatile("" ::: "memory"); }
    }
};
struct EpiGlu {
    static constexpr bool PERM = true;
    const bf16_t* PG; const bf16_t* HB; unsigned char* M8;
    __device__ __forceinline__ void operator()(const f32x4 (&acc)[2][2][4][2], const Unit& u, int wr, int wc, int fr, int fq) const {
        const int row0 = u.pm * BM + wr * 64 + fr; const int col = u.pn * HALF + wc * 32 + 8 * fq;
#pragma unroll
        for (int ai = 0; ai < 2; ++ai)
#pragma unroll
            for (int m = 0; m < 4; ++m) { const size_t row = (size_t)(row0 + ai * HALF + m * 16);
                const u32x4 gw = *(const u32x4*)(PG + row * 4096 + col);
                const u32x4 aw = *(const u32x4*)(HB + row * 2048 + col);
                const f32x4 a0 = acc[ai][0][m][0] * F8_INV, a1 = acc[ai][0][m][1] * F8_INV, g0 = acc[ai][1][m][0] * F8_INV, g1 = acc[ai][1][m][1] * F8_INV;
                u32x2 w;
                w.x = pack4_fp8(sigmoidf_(bf_lo(gw.x)) * a0[0] * sigmoidf_(g0[0]) + bf_lo(aw.x), sigmoidf_(bf_hi(gw.x)) * a0[1] * sigmoidf_(g0[1]) + bf_hi(aw.x),
                                sigmoidf_(bf_lo(gw.y)) * a0[2] * sigmoidf_(g0[2]) + bf_lo(aw.y), sigmoidf_(bf_hi(gw.y)) * a0[3] * sigmoidf_(g0[3]) + bf_hi(aw.y), F8_SA);
                w.y = pack4_fp8(sigmoidf_(bf_lo(gw.z)) * a1[0] * sigmoidf_(g1[0]) + bf_lo(aw.z), sigmoidf_(bf_hi(gw.z)) * a1[1] * sigmoidf_(g1[1]) + bf_hi(aw.z),
                                sigmoidf_(bf_lo(gw.w)) * a1[2] * sigmoidf_(g1[2]) + bf_lo(aw.w), sigmoidf_(bf_hi(gw.w)) * a1[3] * sigmoidf_(g1[3]) + bf_hi(aw.w), F8_SA);
                *(u32x2*)(M8 + row * 2048 + col) = w; asm volatile("" ::: "memory"); }
    }
};
struct EpiOut {
    static constexpr bool PERM = true;
    const float* X; float* O; const float* mod;
    __device__ __forceinline__ void operator()(const f32x4 (&acc)[2][2][4][2], const Unit& u, int wr, int wc, int fr, int fq) const {
        const int row0 = u.pm * BM + wr * 64 + fr; const int col0 = u.pn * BM + wc * 32 + 8 * fq;
        const float* gt = mod + (size_t)((u.pm * BM) >> 13) * 12288 + 4096;
#pragma unroll
        for (int bj = 0; bj < 2; ++bj) { const int col = col0 + bj * HALF;
            const f32x4 g0 = *(const f32x4*)(gt + col), g1 = *(const f32x4*)(gt + col + 4);
#pragma unroll
            for (int ai = 0; ai < 2; ++ai)
#pragma unroll
                for (int m = 0; m < 4; ++m) { const size_t off = (size_t)(row0 + ai * HALF + m * 16) * 2048 + col;
                    const f32x4 x0 = *(const f32x4*)(X + off), x1 = *(const f32x4*)(X + off + 4);
                    *(f32x4*)(O + off) = x0 + g0 * (acc[ai][bj][m][0] * F8_INV); *(f32x4*)(O + off + 4) = x1 + g1 * (acc[ai][bj][m][1] * F8_INV); } }
    }
};
struct EpiF32 {
    static constexpr bool PERM = true;
    float* O;
    __device__ __forceinline__ void operator()(const f32x4 (&acc)[2][2][4][2], const Unit& u, int wr, int wc, int fr, int fq) const {
        const int row0 = u.pm * BM + wr * 64 + fr; const int col0 = u.pn * BM + wc * 32 + 8 * fq;
#pragma unroll
        for (int ai = 0; ai < 2; ++ai)
#pragma unroll
            for (int m = 0; m < 4; ++m) { float* rowp = O + (size_t)(row0 + ai * HALF + m * 16) * 2048 + col0;
#pragma unroll
                for (int bj = 0; bj < 2; ++bj) { *(f32x4*)(rowp + bj * HALF) = acc[ai][bj][m][0]; *(f32x4*)(rowp + bj * HALF + 4) = acc[ai][bj][m][1]; } }
    }
};
}

struct Args { const float* in[25]; float* out; unsigned char* ws; int ph_lo, ph_hi; };
enum { I_X = 0, I_C, I_WADA, I_BADA, I_N1G, I_WIN, I_LRE, I_LIM, I_LDT, I_BRE, I_BIM, I_CRE, I_CIM, I_SD, I_WGLU, I_QNG, I_KNG, I_WATT, I_WOUT, I_N2G, I_WQ, I_K1, I_K2, I_PU, I_PV };

__device__ __forceinline__ void ph_mod_partial(const float* __restrict__ c, const float* __restrict__ w_ada, float* modp, int gw, int ngw, int lane) {
    for (int task = gw; task < 48 * 32; task += ngw) {
        const int strip = task % 48, ks = task / 48, n0 = strip * 256 + lane * 4, k0 = ks * 64;
        f32x4 a0 = {0.f, 0.f, 0.f, 0.f}, a1 = {0.f, 0.f, 0.f, 0.f};
#pragma unroll 8
        for (int k = 0; k < 64; ++k) {
            const f32x4 w = *(const f32x4*)(w_ada + (size_t)(k0 + k) * 12288 + n0);
            float c0 = c[k0 + k], c1 = c[2048 + k0 + k];
            c0 = c0 / (1.0f + __expf(-c0)); c1 = c1 / (1.0f + __expf(-c1));
            a0 += c0 * w; a1 += c1 * w;
        }
        *(f32x4*)(modp + (size_t)(ks * 2 + 0) * 12288 + n0) = a0;
        *(f32x4*)(modp + (size_t)(ks * 2 + 1) * 12288 + n0) = a1;
    }
}

__device__ __forceinline__ void ph_colmax_partial(const float* __restrict__ w_in, float* cmaxp, int gw, int ngw, int lane) {
    for (int task = gw; task < 32 * 32; task += ngw) {
        const int strip = task & 31, ks = task >> 5, n0 = strip * 256 + lane * 4, k0 = ks * 64;
        f32x4 m = {0.f, 0.f, 0.f, 0.f};
#pragma unroll 8
        for (int k = 0; k < 64; ++k) { const f32x4 w = *(const f32x4*)(w_in + (size_t)(k0 + k) * 8192 + n0);
            m[0] = fmaxf(m[0], fabsf(w[0])); m[1] = fmaxf(m[1], fabsf(w[1])); m[2] = fmaxf(m[2], fabsf(w[2])); m[3] = fmaxf(m[3], fabsf(w[3])); }
        *(f32x4*)(cmaxp + (size_t)ks * 8192 + n0) = m;
    }
}

__device__ __forceinline__ void transpose_item_f8(const float* __restrict__ W, int K, int N, unsigned char* WT8, int drow0, int scol0, int k0, LAS float* scr, int lane) {
#pragma unroll 8
    for (int i = 0; i < 32; ++i) { const int kk = 2 * i + (lane >> 5); scr[kk * 33 + (lane & 31)] = W[(size_t)(k0 + kk) * N + scol0 + (lane & 31)]; }
    LDS_WAIT();
    const int n = lane >> 1, half = lane & 1;
    const LAS float* s = scr + (32 * half) * 33 + n;
    u32x4 o[2];
#pragma unroll
    for (int q = 0; q < 8; ++q) o[q >> 2][q & 3] = pack4_fp8(s[(4 * q) * 33], s[(4 * q + 1) * 33], s[(4 * q + 2) * 33], s[(4 * q + 3) * 33], F8_SW);
    *(u32x4*)(WT8 + (size_t)(drow0 + n) * K + k0 + 32 * half) = o[0];
    *(u32x4*)(WT8 + (size_t)(drow0 + n) * K + k0 + 32 * half + 16) = o[1];
    LDS_WAIT();
}
__device__ __forceinline__ void transpose_item_i8(const float* __restrict__ W, signed char* WT8, const float* cmaxp, float* SB, int n0, int k0, LAS float* scr, int lane) {
#pragma unroll 8
    for (int i = 0; i < 32; ++i) { const int kk = 2 * i + (lane >> 5); scr[kk * 33 + (lane & 31)] = W[(size_t)(k0 + kk) * 8192 + n0 + (lane & 31)]; }
    const int n = lane >> 1, half = lane & 1;
    float cm = 0.f;
#pragma unroll 8
    for (int ks = 0; ks < 32; ++ks) cm = fmaxf(cm, cmaxp[(size_t)ks * 8192 + n0 + n]);
    const float sb = fmaxf(cm, 1e-30f) * (1.0f / 127.0f), inv = 1.0f / sb;
    if (k0 == 0 && half == 0) SB[n0 + n] = sb;
    LDS_WAIT();
    const LAS float* s = scr + (32 * half) * 33 + n;
    u32x4 o[2];
#pragma unroll
    for (int q = 0; q < 8; ++q) { unsigned w = 0;
#pragma unroll
        for (int e = 0; e < 4; ++e) { const int v = (int)rintf(s[(4 * q + e) * 33] * inv); w |= ((unsigned)v & 0xffu) << (8 * e); }
        o[q >> 2][q & 3] = w; }
    *(u32x4*)(WT8 + (size_t)(n0 + n) * 2048 + k0 + 32 * half) = o[0];
    *(u32x4*)(WT8 + (size_t)(n0 + n) * 2048 + k0 + 32 * half + 16) = o[1];
    LDS_WAIT();
}

__device__ __forceinline__ void transpose_item(const float* __restrict__ W, int K, int N, bf16_t* WT, int drow0, int scol0, int k0, LAS float* scr, int lane) {
#pragma unroll 8
    for (int i = 0; i < 32; ++i) { const int kk = 2 * i + (lane >> 5); scr[kk * 33 + (lane & 31)] = W[(size_t)(k0 + kk) * N + scol0 + (lane & 31)]; }
    LDS_WAIT();
    const int c = lane & 7;
#pragma unroll
    for (int j = 0; j < 4; ++j) { const int n = (lane >> 3) + 8 * j; const LAS float* s = scr + (8 * c) * 33 + n;
        u32x4 o; o.x = cvt_pk_bf16(s[0 * 33], s[1 * 33]); o.y = cvt_pk_bf16(s[2 * 33], s[3 * 33]); o.z = cvt_pk_bf16(s[4 * 33], s[5 * 33]); o.w = cvt_pk_bf16(s[6 * 33], s[7 * 33]);
        *(u32x4*)(WT + (size_t)(drow0 + n) * K + k0 + 8 * c) = o; }
    LDS_WAIT();
}
__device__ __forceinline__ void wsc_item(const float* wq, const float* kk, bf16_t* out, int lane) {
    const int r = lane & 15, q = lane >> 4;
    f32x4 acc[8];
#pragma unroll
    for (int f = 0; f < 8; ++f) acc[f] = (f32x4){0.f, 0.f, 0.f, 0.f};
    const float* ap = kk + r * 128 + 4 * q; const float* bp = wq + (size_t)r * 2048 + 4 * q;
#pragma unroll 2
    for (int d0 = 0; d0 < 128; d0 += 16) {
        const f32x4 bv = *(const f32x4*)(bp + d0);
        f32x4 av[8];
#pragma unroll
        for (int f = 0; f < 8; ++f) av[f] = *(const f32x4*)(ap + f * 2048 + d0);
#pragma unroll
        for (int j = 0; j < 4; ++j)
#pragma unroll
            for (int f = 0; f < 8; ++f) acc[f] = __builtin_amdgcn_mfma_f32_16x16x4f32(av[f][j], bv[j], acc[f], 0, 0, 0);
    }
#pragma unroll
    for (int f = 0; f < 8; ++f)
#pragma unroll
        for (int i = 0; i < 4; ++i) out[(size_t)(16 * f + 4 * q + i) * 2048 + r] = (bf16_t)(cvt_pk_bf16(acc[f][i], 0.f) & 0xffffu);
}
__device__ __forceinline__ void ph_prologue(const Args& a, LAS unsigned char* lds, int gw, int ngw, int lane, int wave) {
    unsigned char* ws = a.ws;
    { const float* modp = (const float*)(ws + WS_MODP); float* mod = (float*)(ws + WS_MOD); const float* b_ada = a.in[I_BADA];
      for (int idx = gw * 64 + lane; idx < 2 * 12288; idx += ngw * 64) { const int b = idx / 12288, n = idx - b * 12288; float s = b_ada[n];
#pragma unroll 8
          for (int ks = 0; ks < 32; ++ks) s += modp[(size_t)(ks * 2 + b) * 12288 + n];
          mod[idx] = s; } }
    for (int item = gw; item < 2048; item += ngw) { const int hj = item >> 7, k0 = (item & 127) * 16;
        wsc_item(a.in[I_WQ] + (size_t)k0 * 2048 + hj * 128, (hj & 1) ? a.in[I_K2] : a.in[I_K1], (bf16_t*)(ws + WS_WSC) + (size_t)(hj * 128) * 2048 + k0, lane); }
    { LAS float* scr = (LAS float*)(lds + wave * 8448);
      constexpr int I_IN = 32 * 256, I_GLU = 16 * 128, I_ATT = 16 * 64, I_OUT = 32 * 64, NIT = I_IN + I_GLU + I_ATT + I_OUT;
      for (int it = gw; it < NIT; it += ngw) {
          int r = it;
          if (r < I_IN) { const int kb = r / 256, nb = r % 256; transpose_item_i8(a.in[I_WIN], (signed char*)(ws + WS_WIN), (const float*)(ws + WS_CMAXP), (float*)(ws + WS_SB), 32 * nb, 64 * kb, scr, lane); continue; } r -= I_IN;
          if (r < I_GLU) { const int kb = r / 128, nb = r % 128, dr = 32 * nb; const int sc = ((dr >> 7) & 1) * 2048 + (dr >> 8) * 128 + (dr & 127);
              transpose_item_f8(a.in[I_WGLU], 1024, 4096, ws + WS_WGLU, dr, sc, 64 * kb, scr, lane); continue; } r -= I_GLU;
          if (r < I_ATT) { const int kb = r / 64, nb = r % 64; transpose_item_f8(a.in[I_WATT], 1024, 2048, ws + WS_WATT, 32 * nb, 32 * nb, 64 * kb, scr, lane); continue; } r -= I_ATT;
          { const int kb = r / 64, nb = r % 64; transpose_item_f8(a.in[I_WOUT], 2048, 2048, ws + WS_WOUT, 32 * nb, 32 * nb, 64 * kb, scr, lane); }
      } }
}

template <bool I8>
__device__ __forceinline__ void ph_norm(const float* X, bf16_t* Hout, float* SA, const float* __restrict__ g, const float* mod, int sh_off, int sc_off, int gw, int ngw, int lane) {
    for (int row = gw; row < T_TOK; row += ngw) {
        const int b = row >> 13;
        const f32x4* xr = (const f32x4*)(X + (size_t)row * DM) + lane;
        f32x4 v[8]; float ss = 0.f;
#pragma unroll
        for (int j = 0; j < 8; ++j) { v[j] = xr[64 * j]; ss += (v[j][0] * v[j][0] + v[j][1] * v[j][1]) + (v[j][2] * v[j][2] + v[j][3] * v[j][3]); }
        ss = wave_sum(ss);
        const float rs = 1.0f / sqrtf(ss * (1.0f / DM) + EPS);
        const float* mb = mod + (size_t)b * 12288;
        float amax = 0.f;
#pragma unroll
        for (int j = 0; j < 8; ++j) { const int col = 4 * (lane + 64 * j);
            const f32x4 gv = *(const f32x4*)(g + col), sc = *(const f32x4*)(mb + sc_off + col), sh = *(const f32x4*)(mb + sh_off + col);
            const f32x4 o = v[j] * rs * gv * (sc + 1.0f) + sh;
            if (I8) { v[j] = o; amax = fmaxf(fmaxf(amax, fmaxf(fabsf(o[0]), fabsf(o[1]))), fmaxf(fabsf(o[2]), fabsf(o[3]))); }
            else { u32x2 w; w.x = cvt_pk_bf16(o[0], o[1]); w.y = cvt_pk_bf16(o[2], o[3]); *(u32x2*)(Hout + (size_t)row * DM + col) = w; } }
        if (I8) {
#pragma unroll
            for (int o = 1; o < 64; o <<= 1) amax = fmaxf(amax, __shfl_xor(amax, o));
            const float sa = fmaxf(amax, 1e-30f) * (1.0f / 127.0f), inv = 1.0f / sa;
            if (lane == 0) SA[row] = sa;
            unsigned* h8 = (unsigned*)((signed char*)Hout + (size_t)row * DM) + lane;
#pragma unroll
            for (int j = 0; j < 8; ++j) { unsigned w = 0;
#pragma unroll
                for (int e = 0; e < 4; ++e) { const int q = (int)rintf(v[j][e] * inv); w |= ((unsigned)q & 0xffu) << (8 * e); }
                h8[64 * j] = w; }
        }
    }
}

template <int MODE>
__device__ __forceinline__ void ph_attn(LAS unsigned char* lds, const bf16_t* PA, bf16_t* ATT, const float* __restrict__ qg, const float* __restrict__ kg, int G) {
    const int tid = opaque_tid(), lane = tid & 63, wave = __builtin_amdgcn_readfirstlane(tid >> 6), c = lane & 15, g = lane >> 4;
    LAS unsigned char* KL = lds;
    LAS unsigned char* VT = lds + 17408;
    bf16x8 tri[6];
    { const int FS[6] = {0, 1, 0, 1, 2, 3}, FP[6] = {0, 0, 1, 1, 1, 1};
#pragma unroll
      for (int q = 0; q < 6; ++q)
#pragma unroll
          for (int jj = 0; jj < 8; ++jj) { const int kap = 32 * FP[q] + 16 * (jj >> 2) + 4 * g + (jj & 3); tri[q][jj] = (kap > 16 * FS[q] + c) ? (short)0x3F80 : (short)0; } }
    for (int u = blockIdx.x; u < 1024; u += G) {
        const int b = u >> 9, h = (u >> 6) & 7, qb = u & 63, t0 = qb * 128, tq0 = t0 + 16 * wave, tq = tq0 + c;
        bf16x8 qf[4];
        { const bf16_t* qrow = PA + (size_t)(b * SEQ + tq) * 4096 + 1024 + h * 128;
          u32x4 qr[4]; float ss = 0.f;
#pragma unroll
          for (int kk = 0; kk < 4; ++kk) { qr[kk] = *(const u32x4*)(qrow + 32 * kk + 8 * g);
#pragma unroll
              for (int e = 0; e < 4; ++e) { const float lo = bf_lo(qr[kk][e]), hi = bf_hi(qr[kk][e]); ss += lo * lo + hi * hi; } }
          ss += __shfl_xor(ss, 16); ss += __shfl_xor(ss, 32);
          const float rs = (1.0f / sqrtf(ss * (1.0f / 128.0f) + EPS)) * (0.08838834764831845f * 1.4426950408889634f);
#pragma unroll
          for (int kk = 0; kk < 4; ++kk) { const f32x4 g0 = *(const f32x4*)(qg + 32 * kk + 8 * g), g1 = *(const f32x4*)(qg + 32 * kk + 8 * g + 4);
              u32x4 w;
              w.x = cvt_pk_bf16(bf_lo(qr[kk].x) * rs * g0[0], bf_hi(qr[kk].x) * rs * g0[1]);
              w.y = cvt_pk_bf16(bf_lo(qr[kk].y) * rs * g0[2], bf_hi(qr[kk].y) * rs * g0[3]);
              w.z = cvt_pk_bf16(bf_lo(qr[kk].z) * rs * g1[0], bf_hi(qr[kk].z) * rs * g1[1]);
              w.w = cvt_pk_bf16(bf_lo(qr[kk].w) * rs * g1[2], bf_hi(qr[kk].w) * rs * g1[3]);
              qf[kk] = __builtin_bit_cast(bf16x8, w); } }
        float carry = 0.f; int wdone = 0;
        f32x4 oacc[8];
#pragma unroll
        for (int fd = 0; fd < 8; ++fd) oacc[fd] = (f32x4){0.f, 0.f, 0.f, 0.f};
        u32x4 kreg[2], vreg[2];
        { const int k0n = (2 * qb + 1) * 64;
#pragma unroll
          for (int p = 0; p < 2; ++p) { const int ci = tid + 512 * p, key = ci >> 4, ch = ci & 15;
              kreg[p] = *(const u32x4*)(PA + (size_t)(b * SEQ + k0n + key) * 4096 + 2048 + h * 128 + 8 * ch);
              vreg[p] = *(const u32x4*)(PA + (size_t)(b * SEQ + k0n + lane) * 4096 + 3072 + h * 128 + 8 * (wave + 8 * p)); } }
        for (int kt = 2 * qb + 1; kt >= 0; --kt) {
            const int k0 = kt * 64;
            if (__syncthreads_and(wdone)) break;
#pragma unroll
            for (int p = 0; p < 2; ++p) {
                const int ci = tid + 512 * p, key = ci >> 4, ch = ci & 15;
                const u32x4 kr = kreg[p];
                float f[8]; f[0] = bf_lo(kr.x); f[1] = bf_hi(kr.x); f[2] = bf_lo(kr.y); f[3] = bf_hi(kr.y); f[4] = bf_lo(kr.z); f[5] = bf_hi(kr.z); f[6] = bf_lo(kr.w); f[7] = bf_hi(kr.w);
                float ss = 0.f;
#pragma unroll
                for (int e = 0; e < 8; ++e) ss += f[e] * f[e];
                ss += __shfl_xor(ss, 1); ss += __shfl_xor(ss, 2); ss += __shfl_xor(ss, 4); ss += __shfl_xor(ss, 8);
                const float rs = 1.0f / sqrtf(ss * (1.0f / 128.0f) + EPS);
                const f32x4 g0 = *(const f32x4*)(kg + 8 * ch), g1 = *(const f32x4*)(kg + 8 * ch + 4);
                u32x4 w;
                w.x = cvt_pk_bf16(f[0] * rs * g0[0], f[1] * rs * g0[1]); w.y = cvt_pk_bf16(f[2] * rs * g0[2], f[3] * rs * g0[3]);
                w.z = cvt_pk_bf16(f[4] * rs * g1[0], f[5] * rs * g1[1]); w.w = cvt_pk_bf16(f[6] * rs * g1[2], f[7] * rs * g1[3]);
                *(LAS u32x4*)(KL + key * 272 + ch * 16) = w;
            }
#pragma unroll
            for (int p = 0; p < 2; ++p) {
                const int key = lane, ch = wave + 8 * p;
                const u32x4 vr = vreg[p];
                LAS unsigned short* vt = (LAS unsigned short*)(VT + (8 * ch) * 144 + key * 2);
                vt[0 * 72] = (unsigned short)(vr.x & 0xffffu); vt[1 * 72] = (unsigned short)(vr.x >> 16);
                vt[2 * 72] = (unsigned short)(vr.y & 0xffffu); vt[3 * 72] = (unsigned short)(vr.y >> 16);
                vt[4 * 72] = (unsigned short)(vr.z & 0xffffu); vt[5 * 72] = (unsigned short)(vr.z >> 16);
                vt[6 * 72] = (unsigned short)(vr.w & 0xffffu); vt[7 * 72] = (unsigned short)(vr.w >> 16);
            }
            if (kt > 0) { const int k0n = k0 - 64;
#pragma unroll
                for (int p = 0; p < 2; ++p) { const int ci = tid + 512 * p, key = ci >> 4, ch = ci & 15;
                    kreg[p] = *(const u32x4*)(PA + (size_t)(b * SEQ + k0n + key) * 4096 + 2048 + h * 128 + 8 * ch);
                    vreg[p] = *(const u32x4*)(PA + (size_t)(b * SEQ + k0n + lane) * 4096 + 3072 + h * 128 + 8 * (wave + 8 * p)); } }
            __syncthreads();
            if (MODE == 1) { if (kt <= 2 * qb - 3) wdone = 1; }
            if (MODE == 0 && !wdone && k0 < tq0 + 15) {
                f32x4 zt[4];
#pragma unroll
                for (int f = 0; f < 4; ++f) { f32x4 acc = {0.f, 0.f, 0.f, 0.f};
#pragma unroll
                    for (int kk = 0; kk < 4; ++kk) { const bf16x8 kf = *(const LAS bf16x8*)(KL + (16 * f + c) * 272 + (32 * kk + 8 * g) * 2);
                        acc = __builtin_amdgcn_mfma_f32_16x16x32_bf16(kf, qf[kk], acc, 0, 0, 0); }
                    zt[f] = acc; }
                float lf[4][4], lz[4][4]; float tot = 0.f;
                if (k0 + 63 >= tq0) {
#pragma unroll
                    for (int f = 0; f < 4; ++f)
#pragma unroll
                        for (int i = 0; i < 4; ++i) { const int s = k0 + 16 * f + 4 * g + i; const bool valid = s < tq; const float z = zt[f][i];
                            const float sp = fmaxf(z, 0.f) + __builtin_amdgcn_logf(1.0f + __builtin_amdgcn_exp2f(-fabsf(z)));
                            const float l = valid ? -sp : 0.f; lf[f][i] = l; lz[f][i] = valid ? (l + z) : -INFINITY; tot += l; }
                } else {
#pragma unroll
                    for (int f = 0; f < 4; ++f)
#pragma unroll
                        for (int i = 0; i < 4; ++i) { const float z = zt[f][i];
                            const float l = -(fmaxf(z, 0.f) + __builtin_amdgcn_logf(1.0f + __builtin_amdgcn_exp2f(-fabsf(z)))); lf[f][i] = l; lz[f][i] = l + z; tot += l; }
                }
                tot += __shfl_xor(tot, 16); tot += __shfl_xor(tot, 32);
                bf16x8 lh[2];
#pragma unroll
                for (int fp = 0; fp < 2; ++fp) { u32x4 wh;
#pragma unroll
                    for (int q = 0; q < 2; ++q) { const int f = 2 * fp + q; wh[2 * q] = cvt_pk_bf16(lf[f][0], lf[f][1]); wh[2 * q + 1] = cvt_pk_bf16(lf[f][2], lf[f][3]); }
                    lh[fp] = __builtin_bit_cast(bf16x8, wh); }
                f32x4 sf[4];
                { f32x4 z4 = {0.f, 0.f, 0.f, 0.f};
                  sf[0] = __builtin_amdgcn_mfma_f32_16x16x32_bf16(tri[0], lh[0], z4, 0, 0, 0); sf[0] = __builtin_amdgcn_mfma_f32_16x16x32_bf16(tri[2], lh[1], sf[0], 0, 0, 0);
                  sf[1] = __builtin_amdgcn_mfma_f32_16x16x32_bf16(tri[1], lh[0], z4, 0, 0, 0); sf[1] = __builtin_amdgcn_mfma_f32_16x16x32_bf16(tri[3], lh[1], sf[1], 0, 0, 0);
                  sf[2] = __builtin_amdgcn_mfma_f32_16x16x32_bf16(tri[4], lh[1], z4, 0, 0, 0);
                  sf[3] = __builtin_amdgcn_mfma_f32_16x16x32_bf16(tri[5], lh[1], z4, 0, 0, 0); }
                bf16x8 pb[2];
#pragma unroll
                for (int fp = 0; fp < 2; ++fp) { u32x4 w;
#pragma unroll
                    for (int q = 0; q < 2; ++q) { const int f = 2 * fp + q; float p[4];
#pragma unroll
                        for (int i = 0; i < 4; ++i) p[i] = __builtin_amdgcn_exp2f(lz[f][i] + sf[f][i] + carry);
                        w[2 * q] = cvt_pk_bf16(p[0], p[1]); w[2 * q + 1] = cvt_pk_bf16(p[2], p[3]); }
                    pb[fp] = __builtin_bit_cast(bf16x8, w); }
                carry += tot;
#pragma unroll
                for (int fd = 0; fd < 8; ++fd)
#pragma unroll
                    for (int fp = 0; fp < 2; ++fp) { const LAS unsigned char* vp = VT + (16 * fd + c) * 144 + (32 * fp + 4 * g) * 2;
                        const u32x2 v0 = *(const LAS u32x2*)vp, v1 = *(const LAS u32x2*)(vp + 32);
                        u32x4 vw; vw.x = v0.x; vw.y = v0.y; vw.z = v1.x; vw.w = v1.y;
                        oacc[fd] = __builtin_amdgcn_mfma_f32_16x16x32_bf16(__builtin_bit_cast(bf16x8, vw), pb[fp], oacc[fd], 0, 0, 0); }
                wdone = (__ballot(carry >= -152.0f) == 0ull) ? 1 : 0;
            }
        }
        if (MODE == 0) { unsigned char* orow = (unsigned char*)ATT + (size_t)(b * SEQ + tq) * 1024 + h * 128 + 4 * g;
#pragma unroll
          for (int fd = 0; fd < 8; ++fd) *(unsigned*)(orow + 16 * fd) = pack4_fp8(oacc[fd][0], oacc[fd][1], oacc[fd][2], oacc[fd][3], F8_SA); }
    }
    __syncthreads();
}

__device__ __forceinline__ void ssm_lambda(const Args& a, int g, int st, float& lbr, float& lbi, float& qr, float& qi) {
    const float lr = a.in[I_LRE][g * 64 + st], li = a.in[I_LIM][g * 64 + st], dt = __expf(a.in[I_LDT][g]);
    const float mag = __expf(lr * dt);
    float rev = li * dt * 0.15915494309189535f; rev -= rintf(rev);
    lbr = mag * __builtin_amdgcn_cosf(rev); lbi = mag * __builtin_amdgcn_sinf(rev);
    const float nr = lbr - 1.0f, ni = lbi, den = 1.0f / (lr * lr + li * li);
    qr = (nr * lr + ni * li) * den; qi = (ni * lr - nr * li) * den;
}
template <bool WITH_Y>
__device__ __forceinline__ void ph_ssm_mfma(const Args& a, LAS unsigned char* lds, const bf16_t* UB, f32x2* E, bf16_t* YA, int G) {
    const int tid = opaque_tid(), lane = tid & 63, wave = __builtin_amdgcn_readfirstlane(tid >> 6), c = lane & 15, gl = lane >> 4;
    LAS f32x2* sl = (LAS f32x2*)(lds + wave * 8192);
    LAS f32x4* tab = (LAS f32x4*)(lds + 65536 + wave * 1024);
    LAS u32x4* cml = (LAS u32x4*)(lds + 73728 + wave * 5120) + lane;
    for (int item = blockIdx.x; item < 128; item += G) {
        const int b = item >> 6, cb = (item >> 3) & 7, g = (item & 7) * 8 + wave, c0 = cb * 16;
        float mur, mui;
        { float lbr, lbi, qr, qi; ssm_lambda(a, g, lane, lbr, lbi, qr, qi); tab[lane] = (f32x4){lbr, lbi, qr, qi}; mur = lbr; mui = lbi; }
        LDS_WAIT();
        bf16x8 bm[8];
        const float* brb = a.in[I_BRE] + (g * 64 + (c >> 1)) * 16 + 8 * (gl & 1); const float* bib = a.in[I_BIM] + (g * 64 + (c >> 1)) * 16 + 8 * (gl & 1);
        const LAS f32x4* tabb = tab + (c >> 1);
#pragma unroll
        for (int f = 0; f < 8; ++f) { const f32x4 tv = tabb[8 * f]; const float qr = tv[2], qi = tv[3];
            const float* br = brb + 128 * f; const float* bim = bib + 128 * f;
            const f32x4 r0 = *(const f32x4*)br, r1 = *(const f32x4*)(br + 4), i0 = *(const f32x4*)bim, i1 = *(const f32x4*)(bim + 4);
            float v[8];
#pragma unroll
            for (int e = 0; e < 4; ++e) { const float vr0 = qr * r0[e] - qi * i0[e], vi0 = qr * i0[e] + qi * r0[e], vr1 = qr * r1[e] - qi * i1[e], vi1 = qr * i1[e] + qi * r1[e];
                v[e] = (c & 1) ? vi0 : vr0; v[4 + e] = (c & 1) ? vi1 : vr1; }
            if (gl >= 2) {
#pragma unroll
                for (int e = 0; e < 8; ++e) v[e] = 0.f; }
            u32x4 w; w.x = cvt_pk_bf16(v[0], v[1]); w.y = cvt_pk_bf16(v[2], v[3]); w.z = cvt_pk_bf16(v[4], v[5]); w.w = cvt_pk_bf16(v[6], v[7]);
            bm[f] = __builtin_bit_cast(bf16x8, w); }
        float lmr[16], lmi[16];
#pragma unroll
        for (int k = 0; k < 16; ++k) { const f32x4 tv = tab[2 * gl + 8 * (k >> 1) + (k & 1)]; lmr[k] = tv[0]; lmi[k] = tv[1]; }
        if (WITH_Y) {
            const float* crb = a.in[I_CRE] + (g * 16 + c) * 64 + 2 * gl; const float* cib = a.in[I_CIM] + (g * 16 + c) * 64 + 2 * gl;
#pragma unroll
            for (int kk = 0; kk < 4; ++kk) { float v[8];
#pragma unroll
                for (int jh = 0; jh < 2; ++jh) { const f32x2 r = *(const f32x2*)(crb + 8 * (2 * kk + jh)), m = *(const f32x2*)(cib + 8 * (2 * kk + jh));
                    v[4 * jh] = r.x; v[4 * jh + 1] = -m.x; v[4 * jh + 2] = r.y; v[4 * jh + 3] = -m.y; }
                u32x4 w; w.x = cvt_pk_bf16(v[0], v[1]); w.y = cvt_pk_bf16(v[2], v[3]); w.z = cvt_pk_bf16(v[4], v[5]); w.w = cvt_pk_bf16(v[6], v[7]);
                cml[64 * kk] = w; }
            { const float dv = a.in[I_SD][g * 16 + c]; float v[8];
#pragma unroll
              for (int jj = 0; jj < 8; ++jj) v[jj] = (gl < 2 && (8 * gl + jj) == c) ? dv : 0.f;
              u32x4 w; w.x = cvt_pk_bf16(v[0], v[1]); w.y = cvt_pk_bf16(v[2], v[3]); w.z = cvt_pk_bf16(v[4], v[5]); w.w = cvt_pk_bf16(v[6], v[7]);
              cml[256] = w; }
        }
        f32x4 s[8];
#pragma unroll
        for (int f = 0; f < 8; ++f) s[f] = (f32x4){0.f, 0.f, 0.f, 0.f};
        if (WITH_Y) {
            float pr = mur, pi = mui;
#pragma unroll
            for (int q = 0; q < 6; ++q) { const float nr = pr * pr - pi * pi, ni = 2.0f * pr * pi; pr = nr; pi = ni; }
            float sr = 0.f, si = 0.f;
            const f32x2* ep = E + (size_t)((b * 64 + g) * 128) * 64 + lane;
            f32x2 ev[8], en[8];
#pragma unroll
            for (int k = 0; k < 8; ++k) ev[k] = ep[(size_t)k * 64];
            for (int cc = 0; cc < c0 + 16; cc += 8) {
                if (cc + 8 < c0 + 16) {
#pragma unroll
                    for (int k = 0; k < 8; ++k) en[k] = ep[(size_t)(cc + 8 + k) * 64]; }
#pragma unroll
                for (int k = 0; k < 8; ++k) { if (cc >= c0) sl[(cc - c0 + k) * 64 + lane] = (f32x2){sr, si};
                    const float nr = pr * sr - pi * si + ev[k][0], ni = pr * si + pi * sr + ev[k][1]; sr = nr; si = ni; }
#pragma unroll
                for (int k = 0; k < 8; ++k) ev[k] = en[k];
            }
            LDS_WAIT();
#pragma unroll
            for (int f = 0; f < 8; ++f) s[f] = *(const LAS f32x4*)(sl + c * 64 + 8 * f + 2 * gl);
            LDS_WAIT();
        }
        const bf16_t* up = UB + ((size_t)(b * 64 + g) * 8192 + (size_t)(c0 + c) * 64) * 16 + 8 * (gl & 1);
        unsigned char* yp = (unsigned char*)YA + (size_t)(b * SEQ + (c0 + c) * 64) * 1024 + g * 16 + 4 * gl;
        u32x4 u0 = *(const u32x4*)(up), u1 = *(const u32x4*)(up + 16), u2 = *(const u32x4*)(up + 32), u3 = *(const u32x4*)(up + 48);
#pragma unroll 1
        for (int tau = 0; tau < 64; ++tau) {
            const u32x4 u4 = *(const u32x4*)(up + (size_t)(tau + 4) * 16);
            const bf16x8 uf = __builtin_bit_cast(bf16x8, u0);
#pragma unroll
            for (int f = 0; f < 8; ++f) { f32x4 ci;
                ci[0] = lmr[2 * f] * s[f][0] - lmi[2 * f] * s[f][1]; ci[1] = lmr[2 * f] * s[f][1] + lmi[2 * f] * s[f][0];
                ci[2] = lmr[2 * f + 1] * s[f][2] - lmi[2 * f + 1] * s[f][3]; ci[3] = lmr[2 * f + 1] * s[f][3] + lmi[2 * f + 1] * s[f][2];
                s[f] = __builtin_amdgcn_mfma_f32_16x16x32_bf16(bm[f], uf, ci, 0, 0, 0); }
            if (WITH_Y) {
                f32x4 y = __builtin_amdgcn_mfma_f32_16x16x32_bf16(__builtin_bit_cast(bf16x8, cml[256]), uf, (f32x4){0.f, 0.f, 0.f, 0.f}, 0, 0, 0);
#pragma unroll
                for (int kk = 0; kk < 4; ++kk) { u32x4 w; w.x = cvt_pk_bf16(s[2 * kk][0], s[2 * kk][1]); w.y = cvt_pk_bf16(s[2 * kk][2], s[2 * kk][3]);
                    w.z = cvt_pk_bf16(s[2 * kk + 1][0], s[2 * kk + 1][1]); w.w = cvt_pk_bf16(s[2 * kk + 1][2], s[2 * kk + 1][3]);
                    y = __builtin_amdgcn_mfma_f32_16x16x32_bf16(__builtin_bit_cast(bf16x8, cml[64 * kk]), __builtin_bit_cast(bf16x8, w), y, 0, 0, 0); }
                *(unsigned*)(yp + (size_t)tau * 1024) = pack4_fp8(gelu_tanh(y[0]), gelu_tanh(y[1]), gelu_tanh(y[2]), gelu_tanh(y[3]), F8_SA);
            }
            u0 = u1; u1 = u2; u2 = u3; u3 = u4;
        }
        if (!WITH_Y) { f32x2* eo = E + (size_t)((b * 64 + g) * 128 + c0 + c) * 64 + 2 * gl;
#pragma unroll
            for (int f = 0; f < 8; ++f) *(f32x4*)(eo + 8 * f) = s[f]; }
    }
}

typedef float f32x16 __attribute__((ext_vector_type(16)));
typedef float f32x32 __attribute__((ext_vector_type(32)));
typedef unsigned u32x6 __attribute__((ext_vector_type(6)));
constexpr float PEER_SU = 64.0f, PEER_SV = 1.4f;
constexpr size_t PEER_SHARD_BYTES = (size_t)16384 * 192;
__device__ __forceinline__ void ph_table_cvt(const float* __restrict__ U, const float* __restrict__ V, unsigned char* UT, unsigned char* VT, int gw, int ngw, int lane) {
    for (int row = gw; row < 2 * 16384; row += ngw) {
        const bool sec = row >= 16384; const int r = sec ? row - 16384 : row; const float sc = sec ? PEER_SV : PEER_SU;
        const float* src = (sec ? V : U) + (size_t)r * 2048 + 32 * lane;
        unsigned char* dst = (sec ? VT : UT) + (size_t)(lane >> 3) * PEER_SHARD_BYTES + (size_t)r * 192;
        f32x16 a, b;
#pragma unroll
        for (int q = 0; q < 4; ++q) { const f32x4 v0 = *(const f32x4*)(src + 4 * q), v1 = *(const f32x4*)(src + 16 + 4 * q);
#pragma unroll
            for (int e = 0; e < 4; ++e) { a[4 * q + e] = v0[e] * sc; b[4 * q + e] = v1[e] * sc; } }
        const u32x6 p = __builtin_amdgcn_cvt_scalef32_2xpk16_fp6_f32(a, b, 1.0f);
        *(u32x4*)(dst + 16 * (lane & 7)) = (u32x4){p[0], p[1], p[2], p[3]};
        *(u32x2*)(dst + 128 + 8 * (lane & 7)) = (u32x2){p[4], p[5]};
    }
}

__device__ __forceinline__ void ph_peer_topk(LAS unsigned char* lds, const float* SC, int* idxG, float* gateG, int G) {
    const int tid = opaque_tid(), lane = tid & 63, wave = __builtin_amdgcn_readfirstlane(tid >> 6);
    LAS float* scr = (LAS float*)(lds + wave * 8448);
    for (int it = blockIdx.x; it < 512; it += G) {
        const int tokw = it * 32 + wave * 4;
        float tk[16];
#pragma unroll
        for (int i = 0; i < 16; ++i) tk[i] = -INFINITY;
        for (int q = 0; q < 4; ++q) {
#pragma unroll
            for (int j = 0; j < 8; ++j) { const int prob = (lane >> 3) + 8 * j, seg = lane & 7;
                const f32x4 v = *(const f32x4*)(SC + (size_t)(tokw + (prob >> 4)) * 2048 + (prob & 15) * 128 + 32 * q + 4 * seg);
                LAS float* d = scr + prob * 33 + 4 * seg; d[0] = v[0]; d[1] = v[1]; d[2] = v[2]; d[3] = v[3]; }
            LDS_WAIT();
#pragma unroll 4
            for (int vi = 0; vi < 32; ++vi) {
                float x = __uint_as_float((__float_as_uint(scr[lane * 33 + vi]) & ~127u) | (unsigned)(127 - (32 * q + vi)));
#pragma unroll
                for (int i = 0; i < 16; ++i) { const float hi = fmaxf(tk[i], x); x = fminf(tk[i], x); tk[i] = hi; }
            }
            LDS_WAIT();
        }
        float t2[16];
#pragma unroll
        for (int i = 0; i < 16; ++i) t2[i] = __shfl_xor(tk[i], 1);
        float bv[16];
#pragma unroll
        for (int i = 0; i < 16; ++i) bv[i] = -INFINITY;
#pragma unroll
        for (int aa = 0; aa < 16; ++aa)
#pragma unroll
            for (int bb = 0; bb < 16 / (aa + 1); ++bb) {
                const float sum = __uint_as_float(__float_as_uint(tk[aa]) & ~127u) + __uint_as_float(__float_as_uint(t2[bb]) & ~127u);
                float x = __uint_as_float((__float_as_uint(sum) & ~255u) | (unsigned)(255 - (16 * aa + bb)));
#pragma unroll
                for (int i = 0; i < 16; ++i) { const float hi = fmaxf(bv[i], x); x = fminf(bv[i], x); bv[i] = hi; }
            }
        unsigned p1[4], p2[4];
#pragma unroll
        for (int j = 0; j < 4; ++j) { p1[j] = 0u; p2[j] = 0u;
#pragma unroll
            for (int e = 0; e < 4; ++e) { p1[j] |= (127u - (__float_as_uint(tk[4 * j + e]) & 127u)) << (8 * e); p2[j] |= (127u - (__float_as_uint(t2[4 * j + e]) & 127u)) << (8 * e); } }
        { float e[16], sum = 0.f; unsigned ex[16];
          const float top = __uint_as_float(__float_as_uint(bv[0]) & ~255u);
#pragma unroll
          for (int i = 0; i < 16; ++i) { const unsigned bits = __float_as_uint(bv[i]); const unsigned flat = 255u - (bits & 255u), aa = flat >> 4, bb = flat & 15u;
              const unsigned w1 = (aa >> 2) == 0u ? p1[0] : (aa >> 2) == 1u ? p1[1] : (aa >> 2) == 2u ? p1[2] : p1[3];
              const unsigned w2 = (bb >> 2) == 0u ? p2[0] : (bb >> 2) == 1u ? p2[1] : (bb >> 2) == 2u ? p2[2] : p2[3];
              ex[i] = (((w1 >> (8u * (aa & 3u))) & 127u) << 7) | ((w2 >> (8u * (bb & 3u))) & 127u);
              e[i] = __expf(__uint_as_float(bits & ~255u) - top); sum += e[i]; }
          const float inv = 1.0f / sum;
          if ((lane & 1) == 0) { const int tl = lane >> 4, head = (lane & 15) >> 1; const size_t o = (size_t)(tokw + tl) * 128 + head * 16;
#pragma unroll
              for (int i = 0; i < 4; ++i) { *(u32x4*)(idxG + o + 4 * i) = (u32x4){ex[4 * i], ex[4 * i + 1], ex[4 * i + 2], ex[4 * i + 3]};
                  *(f32x4*)(gateG + o + 4 * i) = (f32x4){e[4 * i] * inv, e[4 * i + 1] * inv, e[4 * i + 2] * inv, e[4 * i + 3] * inv}; } } }
    }
}

__device__ __forceinline__ void ph_peer_u(const unsigned char* UT, const bf16_t* H2, const int* idxG, float* pdot, int G) {
    const int tid = opaque_tid(), lane = tid & 63, wave = __builtin_amdgcn_readfirstlane(tid >> 6), r = lane >> 3, c = lane & 7;
    const int shard = blockIdx.x & 7, ws = (blockIdx.x >> 3) * 8 + wave, nws = (G >> 3) * 8;
    const unsigned char* tab = UT + (size_t)shard * PEER_SHARD_BYTES;
    int ni0 = idxG[(size_t)ws * 128 + lane], ni1 = idxG[(size_t)ws * 128 + 64 + lane];
    u32x4 nw0, nw1, nw2, nw3;
    { const bf16_t* hp = H2 + (size_t)ws * 2048 + 256 * shard + 32 * c; nw0 = *(const u32x4*)hp; nw1 = *(const u32x4*)(hp + 8); nw2 = *(const u32x4*)(hp + 16); nw3 = *(const u32x4*)(hp + 24); }
    for (int t = ws; t < T_TOK; t += nws) {
        const int i0 = ni0, i1 = ni1; const u32x4 w0 = nw0, w1 = nw1, w2 = nw2, w3 = nw3;
        { const int tn = (t + nws < T_TOK) ? t + nws : t;
          ni0 = idxG[(size_t)tn * 128 + lane]; ni1 = idxG[(size_t)tn * 128 + 64 + lane];
          const bf16_t* hp = H2 + (size_t)tn * 2048 + 256 * shard + 32 * c; nw0 = *(const u32x4*)hp; nw1 = *(const u32x4*)(hp + 8); nw2 = *(const u32x4*)(hp + 16); nw3 = *(const u32x4*)(hp + 24); }
        f32x2 ha[16];
        {
          ha[0] = (f32x2){bf_lo(w0.x), bf_lo(w2.x)}; ha[1] = (f32x2){bf_hi(w0.x), bf_hi(w2.x)}; ha[2] = (f32x2){bf_lo(w0.y), bf_lo(w2.y)}; ha[3] = (f32x2){bf_hi(w0.y), bf_hi(w2.y)};
          ha[4] = (f32x2){bf_lo(w0.z), bf_lo(w2.z)}; ha[5] = (f32x2){bf_hi(w0.z), bf_hi(w2.z)}; ha[6] = (f32x2){bf_lo(w0.w), bf_lo(w2.w)}; ha[7] = (f32x2){bf_hi(w0.w), bf_hi(w2.w)};
          ha[8] = (f32x2){bf_lo(w1.x), bf_lo(w3.x)}; ha[9] = (f32x2){bf_hi(w1.x), bf_hi(w3.x)}; ha[10] = (f32x2){bf_lo(w1.y), bf_lo(w3.y)}; ha[11] = (f32x2){bf_hi(w1.y), bf_hi(w3.y)};
          ha[12] = (f32x2){bf_lo(w1.z), bf_lo(w3.z)}; ha[13] = (f32x2){bf_hi(w1.z), bf_hi(w3.z)}; ha[14] = (f32x2){bf_lo(w1.w), bf_lo(w3.w)}; ha[15] = (f32x2){bf_hi(w1.w), bf_hi(w3.w)}; }
#pragma unroll
        for (int half = 0; half < 2; ++half) {
            u32x4 b4[8]; u32x2 b2[8];
#pragma unroll
            for (int gq = 0; gq < 8; ++gq) { const int e = __shfl(half ? i1 : i0, 8 * gq + r);
                const unsigned ro = (unsigned)e * 192u; b4[gq] = *(const u32x4*)(tab + (ro + 16u * (unsigned)c)); b2[gq] = *(const u32x2*)(tab + (ro + 128u + 8u * (unsigned)c)); }
            float mine = 0.f;
#pragma unroll
            for (int gq = 0; gq < 8; ++gq) { const u32x6 p6 = {b4[gq].x, b4[gq].y, b4[gq].z, b4[gq].w, b2[gq].x, b2[gq].y};
                const f32x32 uv = __builtin_amdgcn_cvt_scalef32_pk32_f32_fp6(p6, 1.0f); f32x2 s = {0.f, 0.f};
#pragma unroll
                for (int k = 0; k < 16; ++k) s = (f32x2){uv[2 * k], uv[2 * k + 1]} * ha[k] + s;
                float d = s.x + s.y; d += __shfl_xor(d, 1); d += __shfl_xor(d, 2); d += __shfl_xor(d, 4);
                mine = (gq == c) ? d : mine; }
            pdot[((size_t)shard * T_TOK + t) * 128 + 64 * half + 8 * c + r] = mine;
        }
    }
}
__device__ __forceinline__ void ph_peer_act(const float* pdot, const float* gateG, float* actG, int G) {
    const size_t n = (size_t)T_TOK * 128, stride = (size_t)G * 512;
    for (size_t i = (size_t)blockIdx.x * 512 + threadIdx.x; i < n; i += stride) {
        float d = 0.f;
#pragma unroll
        for (int x = 0; x < 8; ++x) d += pdot[(size_t)x * n + i];
        actG[i] = gateG[i] * gelu_tanh(d * (1.0f / PEER_SU)) * (1.0f / PEER_SV);
    }
}
template <bool DRY>
__device__ __forceinline__ void ph_peer_v(LAS unsigned char* lds, const unsigned char* VT, const int* idxG, const float* actG, const float* mod, float* OUT, int G) {
    const int tid = opaque_tid(), lane = tid & 63, wave = __builtin_amdgcn_readfirstlane(tid >> 6), r = lane >> 3, c = lane & 7;
    const int shard = blockIdx.x & 7, ws = (blockIdx.x >> 3) * 8 + wave, nws = (G >> 3) * 8;
    const unsigned char* tab = VT + (size_t)shard * PEER_SHARD_BYTES;
    LAS float* red = (LAS float*)(lds + wave * 9216);
    int ni0 = idxG[(size_t)ws * 128 + lane], ni1 = idxG[(size_t)ws * 128 + 64 + lane];
    float na0 = actG[(size_t)ws * 128 + lane], na1 = actG[(size_t)ws * 128 + 64 + lane];
    f32x4 nx0 = *(const f32x4*)(OUT + (size_t)ws * 2048 + 256 * shard + 4 * lane);
    for (int t = ws; t < T_TOK; t += nws) {
        const int i0 = ni0, i1 = ni1; const float a0 = na0, a1 = na1; const f32x4 x0 = nx0;
        { const int tn = (t + nws < T_TOK) ? t + nws : t;
          ni0 = idxG[(size_t)tn * 128 + lane]; ni1 = idxG[(size_t)tn * 128 + 64 + lane]; na0 = actG[(size_t)tn * 128 + lane]; na1 = actG[(size_t)tn * 128 + 64 + lane];
          nx0 = *(const f32x4*)(OUT + (size_t)tn * 2048 + 256 * shard + 4 * lane); }
        f32x2 acc[16];
#pragma unroll
        for (int k = 0; k < 16; ++k) acc[k] = (f32x2){0.f, 0.f};
#pragma unroll
        for (int half = 0; half < 2; ++half) {
            u32x4 b4[8]; u32x2 b2[8];
#pragma unroll
            for (int gq = 0; gq < 8; ++gq) { const int e = __shfl(half ? i1 : i0, 8 * gq + r);
                const unsigned ro = (unsigned)e * 192u; b4[gq] = *(const u32x4*)(tab + (ro + 16u * (unsigned)c)); b2[gq] = *(const u32x2*)(tab + (ro + 128u + 8u * (unsigned)c)); }
#pragma unroll
            for (int gq = 0; gq < 8; ++gq) { const float ar = __shfl(half ? a1 : a0, 8 * gq + r); const f32x2 a2 = {ar, ar};
                const u32x6 p6 = {b4[gq].x, b4[gq].y, b4[gq].z, b4[gq].w, b2[gq].x, b2[gq].y};
                const f32x32 vv = __builtin_amdgcn_cvt_scalef32_pk32_f32_fp6(p6, 1.0f);
#pragma unroll
                for (int k = 0; k < 16; ++k) acc[k] = (f32x2){vv[2 * k], vv[2 * k + 1]} * a2 + acc[k];
                __builtin_amdgcn_sched_barrier(0); }
        }
        { LAS float* w = red + (r * 8 + c) * 36;
#pragma unroll
          for (int q = 0; q < 4; ++q) { *(LAS f32x4*)(w + 4 * q) = (f32x4){acc[4 * q].x, acc[4 * q + 1].x, acc[4 * q + 2].x, acc[4 * q + 3].x};
              *(LAS f32x4*)(w + 16 + 4 * q) = (f32x4){acc[4 * q].y, acc[4 * q + 1].y, acc[4 * q + 2].y, acc[4 * q + 3].y}; } }
        LDS_WAIT();
        { f32x4 s = {0.f, 0.f, 0.f, 0.f}; const LAS float* rd = red + (lane >> 3) * 36 + 4 * (lane & 7);
#pragma unroll
          for (int rr = 0; rr < 8; ++rr) s += *(const LAS f32x4*)(rd + rr * 288);
          const int b = t >> 13; const float* gt2 = mod + (size_t)b * 12288 + 10240 + 256 * shard + 4 * lane; float* op = OUT + (size_t)t * 2048 + 256 * shard + 4 * lane;
          const f32x4 g0 = *(const f32x4*)gt2;
          if (!DRY) *(f32x4*)op = x0 + g0 * s; else asm volatile("" :: "v"(s), "v"(g0)); }
        LDS_WAIT();
    }
}

__global__ void __launch_bounds__(512, 2) mk_fwd(Args args) {
    extern __shared__ __attribute__((aligned(16))) unsigned char lds_raw[];
    LAS unsigned char* lds = (LAS unsigned char*)lds_raw;
    const int tid = threadIdx.x, lane = tid & 63, wave = __builtin_amdgcn_readfirstlane(tid >> 6);
    const int G = gridDim.x, gw = blockIdx.x * 8 + wave, ngw = G * 8;
    unsigned char* ws = args.ws;
    volatile LAS unsigned* misc = (volatile LAS unsigned*)(lds + LDS_MAIN);
    if (tid < 4) misc[tid] = 0u;
    __syncthreads();
    const int lo = args.ph_lo, hi = args.ph_hi;
    XcdBarrier bar; bar.bar = (unsigned*)(ws + WS_CTL); bar.x = 0; bar.st = misc;
    if (hi - lo > 1) bar = xcd_barrier_post((unsigned*)(ws + WS_CTL), misc);
#ifndef PHMASK
#define PHMASK 0x3fff
#endif
#define IN(k) (((PHMASK >> (k)) & 1) && lo <= (k) && (k) < hi)
#define SEAM(k) do { if (IN(k) && IN((k) + 1)) xcd_barrier(bar); } while (0)
    float* mod = (float*)(ws + WS_MOD);
    bf16_t* HB = (bf16_t*)(ws + WS_H); bf16_t* PA = (bf16_t*)(ws + WS_PA); bf16_t* PG = (bf16_t*)(ws + WS_PG);
    bf16_t* YA = (bf16_t*)(ws + WS_YA); bf16_t* ATT = (bf16_t*)(ws + WS_ATT); f32x2* EB = (f32x2*)(ws + WS_E); bf16_t* UBp = (bf16_t*)(ws + WS_UB);

#define PHS(code, ...) do { __VA_ARGS__ if (DUP == (code)) { xcd_barrier(bar); __VA_ARGS__ } } while (0)
#define PH(k, ...) do { if (IN(k)) { __VA_ARGS__ if (DUP == (k)) { xcd_barrier(bar); __VA_ARGS__ } } } while (0)
    PH(0, { ph_mod_partial(args.in[I_C], args.in[I_WADA], (float*)(ws + WS_MODP), gw, ngw, lane); ph_colmax_partial(args.in[I_WIN], (float*)(ws + WS_CMAXP), gw, ngw, lane); });
    SEAM(0);
    PH(1, { ph_prologue(args, lds, gw, ngw, lane, wave); });
    SEAM(1);
    PH(2, { ph_norm<true>(args.in[I_X], HB, (float*)(ws + WS_SA), args.in[I_N1G], mod, 0, 2048, gw, ngw, lane); });
    SEAM(2);
    PH(3, { pg8::Gemm g{HB, (const bf16_t*)(ws + WS_WIN), T_TOK, 8192, 1024}; pg8::StaticOrder S; S.init(T_TOK, 8192, G, (int)blockIdx.x);
        pg8::EpiProj E{PA, PG, UBp, (const float*)(ws + WS_SA), (const float*)(ws + WS_SB)}; pg8::gemm_phase<pg8::EpiProj, pg8::StaticOrder, true, true, 1>(lds, g, S, E); });
    SEAM(3);
    PH(4, { PHS(41, { ph_attn<0>(lds, PA, ATT, args.in[I_QNG], args.in[I_KNG], G); __syncthreads(); });
        if (DUP == 411) { xcd_barrier(bar); ph_attn<1>(lds, PA, ATT, args.in[I_QNG], args.in[I_KNG], G); __syncthreads(); } PHS(42, { ph_ssm_mfma<false>(args, lds, UBp, EB, YA, G); }); });
    SEAM(4);
    PH(5, { PHS(51, { ph_ssm_mfma<true>(args, lds, UBp, EB, YA, G); __syncthreads(); });
        PHS(52, { pg8::Gemm g{ATT, (const bf16_t*)(ws + WS_WATT), T_TOK, 2048, 512}; pg8::SplitOrder S; S.init(T_TOK, 2048, G, (int)blockIdx.x);
        pg8::EpiAttUp E{PG, HB}; pg8::gemm_phase<pg8::EpiAttUp, pg8::SplitOrder, true, true, 2>(lds, g, S, E); }); });
    SEAM(5);
    PH(6, { pg8::Gemm g{YA, (const bf16_t*)(ws + WS_WGLU), T_TOK, 4096, 512}; pg8::StaticOrder S; S.init(T_TOK, 4096, G, (int)blockIdx.x);
        pg8::EpiGlu E{PG, HB, (unsigned char*)ATT}; pg8::gemm_phase<pg8::EpiGlu, pg8::StaticOrder, true, true, 2>(lds, g, S, E); });
    SEAM(6);
    PH(7, { pg8::Gemm g{ATT, (const bf16_t*)(ws + WS_WOUT), T_TOK, 2048, 1024}; pg8::StaticOrder S; S.init(T_TOK, 2048, G, (int)blockIdx.x);
        pg8::EpiOut E{args.in[I_X], args.out, mod}; pg8::gemm_phase<pg8::EpiOut, pg8::StaticOrder, true, true, 2>(lds, g, S, E);
        ph_table_cvt(args.in[I_PU], args.in[I_PV], ws + WS_UT, ws + WS_VT, gw, ngw, lane); });
    SEAM(7);
    PH(8, { ph_norm<false>(args.out, HB, nullptr, args.in[I_N2G], mod, 6144, 8192, gw, ngw, lane); });
    SEAM(8);
    PH(9, { pg8::Gemm g{HB, (const bf16_t*)(ws + WS_WSC), T_TOK, 2048, 2048}; pg8::StaticOrder S; S.init(T_TOK, 2048, G, (int)blockIdx.x);
        pg8::EpiF32 E{(float*)(ws + WS_SC)}; pg8::gemm_phase<pg8::EpiF32, pg8::StaticOrder, true, true>(lds, g, S, E); });
    SEAM(9);
    PH(10, { ph_peer_topk(lds, (const float*)(ws + WS_SC), (int*)(ws + WS_IDX), (float*)(ws + WS_GATE), G); });
    SEAM(10);
    PH(11, { ph_peer_u(ws + WS_UT, HB, (const int*)(ws + WS_IDX), (float*)(ws + WS_PDOT), G); });
    SEAM(11);
    PH(12, { ph_peer_act((const float*)(ws + WS_PDOT), (const float*)(ws + WS_GATE), (float*)(ws + WS_ACT), G); });
    SEAM(12);
    if (IN(13)) { if (DUP == 13) { ph_peer_v<true>(lds, ws + WS_VT, (const int*)(ws + WS_IDX), (const float*)(ws + WS_ACT), mod, args.out, G); xcd_barrier(bar); }
        ph_peer_v<false>(lds, ws + WS_VT, (const int*)(ws + WS_IDX), (const float*)(ws + WS_ACT), mod, args.out, G); }
#undef IN
#undef SEAM
}

extern "C" void kernel_launch(void* const* d_in, const int* in_sizes, int n_in, void* d_out, int out_size, void* d_ws, size_t ws_size, hipStream_t stream) {
    static int grid = 0;
    if (grid == 0) {
        if (n_in != 25 || out_size != T_TOK * DM || ws_size < WS_END) { fprintf(stderr, "kernel_launch: unexpected shapes (n_in %d out %d ws %zu need %zu)\n", n_in, out_size, ws_size, (size_t)WS_END); grid = -1; return; }
        int dev = 0, cus = 0, per_cu = 0;
        if (hipGetDevice(&dev) != hipSuccess || hipDeviceGetAttribute(&cus, hipDeviceAttributeMultiprocessorCount, dev) != hipSuccess) { grid = -1; return; }
        if (hipFuncSetAttribute((const void*)mk_fwd, hipFuncAttributeMaxDynamicSharedMemorySize, LDS_BYTES) != hipSuccess) { fprintf(stderr, "kernel_launch: hipFuncSetAttribute failed\n"); grid = -1; return; }
        if (hipOccupancyMaxActiveBlocksPerMultiprocessor(&per_cu, (const void*)mk_fwd, 512, LDS_BYTES) != hipSuccess || per_cu < 1) { fprintf(stderr, "kernel_launch: occupancy query says %d blocks/CU\n", per_cu); (void)hipGetLastError(); grid = -1; return; }
        grid = cus;
    }
    if (grid < 0) return;
    (void)hipMemsetAsync((char*)d_ws + WS_CTL, 0, 16384, stream);
    Args a{};
    for (int i = 0; i < 25; ++i) a.in[i] = (const float*)d_in[i];
    a.out = (float*)d_out; a.ws = (unsigned char*)d_ws;
#if MK_PER_PHASE
    for (int ph = 0; ph < NPHASE; ++ph) { a.ph_lo = ph; a.ph_hi = ph + 1; hipLaunchKernelGGL(mk_fwd, dim3(grid), dim3(512), LDS_BYTES, stream, a); }
#else
    a.ph_lo = 0; a.ph_hi = NPHASE;
    hipLaunchKernelGGL(mk_fwd, dim3(grid), dim3(512), LDS_BYTES, stream, a);
#endif
}
```

```cpp
#include <hip/hip_runtime.h>
#include <cstdio>
#include <cstdint>

#ifndef MK_PER_PHASE
#define MK_PER_PHASE 0
#endif

#ifndef DUP
#define DUP -1
#endif
#define LAS __attribute__((address_space(3)))
typedef unsigned short bf16_t;
typedef short bf16x8 __attribute__((ext_vector_type(8)));
typedef float f32x4 __attribute__((ext_vector_type(4)));
typedef float f32x2 __attribute__((ext_vector_type(2)));
typedef unsigned u32x4 __attribute__((ext_vector_type(4)));
typedef unsigned u32x2 __attribute__((ext_vector_type(2)));
typedef int i32x4 __attribute__((ext_vector_type(4)));

constexpr int T_TOK = 16384, DM = 2048, SEQ = 8192;
constexpr int NPHASE = 14;
constexpr float EPS = 1e-6f;

constexpr size_t WS_CTL   = 0;
constexpr size_t WS_MODP  = 65536;
constexpr size_t WS_MOD   = WS_MODP + (size_t)32 * 2 * 12288 * 4;
constexpr size_t WS_WIN   = WS_MOD + (size_t)2 * 12288 * 4;
constexpr size_t WS_WGLU  = WS_WIN + (size_t)8192 * 2048 * 2;
constexpr size_t WS_WATT  = WS_WGLU + (size_t)4096 * 1024 * 2;
constexpr size_t WS_WOUT  = WS_WATT + (size_t)2048 * 1024 * 2;
constexpr size_t WS_WSC   = WS_WOUT + (size_t)2048 * 2048 * 2;
constexpr size_t WS_H     = WS_WSC + (size_t)2048 * 2048 * 2;
constexpr size_t WS_PA    = WS_H + (size_t)T_TOK * 2048 * 2;
constexpr size_t WS_PG    = WS_PA + (size_t)T_TOK * 4096 * 2;
constexpr size_t WS_E     = WS_PG + (size_t)T_TOK * 4096 * 2;
constexpr size_t WS_YA    = WS_E + (size_t)2 * 64 * 128 * 64 * 8;
constexpr size_t WS_ATT   = WS_YA + (size_t)T_TOK * 1024 * 2;
constexpr size_t WS_UB    = WS_ATT + (size_t)T_TOK * 1024 * 2;
constexpr size_t WS_SA    = WS_UB + (size_t)T_TOK * 1024 * 2;
constexpr size_t WS_SB    = WS_SA + (size_t)T_TOK * 4;
constexpr size_t WS_CMAXP = WS_SB + (size_t)8192 * 4;
constexpr size_t WS_END   = WS_CMAXP + (size_t)32 * 8192 * 4;
constexpr size_t WS_SC    = WS_PA;
constexpr size_t WS_UT    = WS_PG;
constexpr size_t WS_VT    = WS_PG + (size_t)8 * 16384 * 192;
constexpr size_t WS_PDOT  = WS_VT + (size_t)8 * 16384 * 192;
constexpr size_t WS_IDX   = WS_YA;
constexpr size_t WS_GATE  = WS_YA + (size_t)T_TOK * 128 * 4;
constexpr size_t WS_ACT   = WS_GATE + (size_t)T_TOK * 128 * 4;
static_assert(WS_PDOT + (size_t)8 * T_TOK * 128 * 4 <= WS_PG + (size_t)T_TOK * 4096 * 2, "PEER buffers must fit the dead g_ssm|g_att region");
static_assert(WS_ACT + (size_t)T_TOK * 128 * 4 <= WS_YA + (size_t)T_TOK * 1024 * 2, "PEER index buffers must fit the dead YA region");
constexpr int LDS_MAIN = 131072, LDS_BYTES = LDS_MAIN + 256;

typedef __bf16 bf16x2_t __attribute__((ext_vector_type(2)));
__device__ __forceinline__ unsigned cvt_pk_bf16(float lo, float hi) { const f32x2 v = {lo, hi}; return __builtin_bit_cast(unsigned, __builtin_convertvector(v, bf16x2_t)); }
__device__ __forceinline__ float bf_lo(unsigned w) { return __uint_as_float(w << 16); }
__device__ __forceinline__ float bf_hi(unsigned w) { return __uint_as_float(w & 0xffff0000u); }
__device__ __forceinline__ float wave_sum(float v) {
#pragma unroll
    for (int o = 1; o < 64; o <<= 1) v += __shfl_xor(v, o);
    return v;
}
__device__ __forceinline__ float sigmoidf_(float x) { return 1.0f / (1.0f + __expf(-x)); }
__device__ __forceinline__ float gelu_tanh(float x) {
    const float a = 0.7978845608028654f * (x + 0.044715f * x * x * x);
    const float t = 1.0f - 2.0f / (__expf(2.0f * a) + 1.0f);
    return 0.5f * x * (1.0f + t);
}
constexpr float F8_SA = 8.0f, F8_SW = 64.0f, F8_INV = 1.0f / 512.0f;
__device__ __forceinline__ unsigned pack4_fp8(float a, float b, float c, float d, float sc) {
    a = fminf(fmaxf(a * sc, -448.f), 448.f); b = fminf(fmaxf(b * sc, -448.f), 448.f); c = fminf(fmaxf(c * sc, -448.f), 448.f); d = fminf(fmaxf(d * sc, -448.f), 448.f);
    int p = 0; p = __builtin_amdgcn_cvt_pk_fp8_f32(a, b, p, false); p = __builtin_amdgcn_cvt_pk_fp8_f32(c, d, p, true); return (unsigned)p; }
__device__ __forceinline__ float sum8_dpp(float v) {
    v += __builtin_bit_cast(float, __builtin_amdgcn_update_dpp(0, __builtin_bit_cast(int, v), 0xB1, 0xF, 0xF, true));
    v += __builtin_bit_cast(float, __builtin_amdgcn_update_dpp(0, __builtin_bit_cast(int, v), 0x4E, 0xF, 0xF, true));
    v += __builtin_bit_cast(float, __builtin_amdgcn_update_dpp(0, __builtin_bit_cast(int, v), 0x141, 0xF, 0xF, true));
    return v; }
#define LDS_WAIT() asm volatile("s_waitcnt lgkmcnt(0)" ::: "memory")
__device__ __forceinline__ int opaque_tid() { int t = threadIdx.x; asm volatile("" : "+v"(t)); return t; }

#define XB_TMO      128
#define XB_XCNT(j)  (256  + 64 * (j))
#define XB_XSUB(j)  (1280 + 64 * (j))
#define XB_XGEN(j)  (2304 + 64 * (j))
#define XB_TOP      3328
#define XB_TOPGEN   3392
#define XCD_BAR_WORDS 3456
#define XB_SPIN_CAP (1u << 22)
__device__ __forceinline__ unsigned xb_ld(unsigned* p)              { return __hip_atomic_load(p, __ATOMIC_RELAXED, __HIP_MEMORY_SCOPE_AGENT); }
__device__ __forceinline__ unsigned xb_add(unsigned* p, unsigned v) { return __hip_atomic_fetch_add(p, v, __ATOMIC_RELAXED, __HIP_MEMORY_SCOPE_AGENT); }
__device__ __forceinline__ unsigned xb_xcc_id() { return (unsigned)__builtin_amdgcn_s_getreg((3 << 11) | 20) & 0xFu; }
#define XB_SPIN(cond, bar) do { unsigned _sp = 0; while (cond) { __builtin_amdgcn_s_sleep(1); \
    if ((++_sp & 255u) == 0u) { if (xb_ld(&(bar)[XB_TMO])) break; if (_sp > XB_SPIN_CAP) { atomicAdd(&(bar)[XB_TMO], 1u); break; } } } } while (0)
struct XcdBarrier { unsigned* bar; unsigned x; volatile LAS unsigned* st; };
__device__ __forceinline__ XcdBarrier xcd_barrier_post(unsigned* bar, volatile LAS unsigned* st) {
    XcdBarrier b; b.bar = bar; b.x = xb_xcc_id(); b.st = st;
    if (threadIdx.x == 0) (void)xb_add(&bar[XB_XCNT(b.x)], 1u);
    return b;
}
__device__ __forceinline__ void xcd_barrier_complete(unsigned* bar, unsigned x, unsigned& nloc, unsigned& nx) {
    const unsigned G = gridDim.x * gridDim.y * gridDim.z;
    unsigned sum, cnt, mine, sp = 0u;
    for (;;) {
        sum = 0u; cnt = 0u; mine = 0u;
#pragma unroll
        for (unsigned j = 0; j < 16; ++j) { const unsigned c = xb_ld(&bar[XB_XCNT(j)]); sum += c; cnt += (c > 0u) ? 1u : 0u; mine = (j == x) ? c : mine; }
        if (sum == G) break;
        __builtin_amdgcn_s_sleep(1);
        if ((++sp & 255u) == 0u) { if (xb_ld(&bar[XB_TMO])) break; if (sp > XB_SPIN_CAP) { atomicAdd(&bar[XB_TMO], 1u); break; } }
    }
    nloc = mine > 0u ? mine : 1u; nx = cnt > 0u ? cnt : 1u;
}
__device__ __forceinline__ void xcd_barrier(const XcdBarrier& b) {
    asm volatile("s_waitcnt vmcnt(0)" ::: "memory");
    __syncthreads();
    if (threadIdx.x == 0) {
        unsigned* bar = b.bar;
        __builtin_amdgcn_s_waitcnt(0);
        unsigned nloc = b.st[0], nx = b.st[1];
        if (nloc == 0u) { xcd_barrier_complete(bar, b.x, nloc, nx); b.st[0] = nloc; b.st[1] = nx; }
        const unsigned old = xb_add(&bar[XB_XSUB(b.x)], 1u);
        const unsigned gen = old / nloc;
        if (old + 1u == (gen + 1u) * nloc) {
            __builtin_amdgcn_fence(__ATOMIC_RELEASE, "agent");
            asm volatile("s_waitcnt vmcnt(0)" ::: "memory");
            const unsigned og = xb_add(&bar[XB_TOP], 1u);
            const unsigned tg = og / nx;
            if (og + 1u == (tg + 1u) * nx) xb_add(&bar[XB_TOPGEN], 1u);
            else XB_SPIN(xb_ld(&bar[XB_TOPGEN]) == tg, bar);
            __builtin_amdgcn_fence(__ATOMIC_ACQUIRE, "agent");
            xb_add(&bar[XB_XGEN(b.x)], 1u);
            asm volatile("s_waitcnt vmcnt(0)" ::: "memory");
        } else {
            XB_SPIN(xb_ld(&bar[XB_XGEN(b.x)]) == gen, bar);
            __builtin_amdgcn_fence(__ATOMIC_ACQUIRE, "agent");
            asm volatile("s_waitcnt vmcnt(0)" ::: "memory");
        }
    }
    __syncthreads();
}

namespace pg8 {
constexpr int BM = 256, BK = 64, HALF = 128, HTB = HALF * BK * 2, STAGE_BYTES = 8 * HTB, NXCD = 8, WGM = 8;
__host__ __device__ __forceinline__ int lds_byte(int r, int c) { const int st = (r >> 4) * 2 + (c >> 5), rr = r & 15, cc = c & 31, ob = rr * 64 + cc * 2; return st * 1024 + (ob ^ (((ob >> 9) & 1) << 5)); }
__host__ __device__ __forceinline__ void stage_rc(int b, int& R, int& C) { const int st = b / 1024, sb = b % 1024, swz = sb ^ (((sb >> 9) & 1) << 5); R = (st >> 1) * 16 + swz / 64; C = (st & 1) * 32 + (swz % 64) / 2; }
__host__ __device__ __forceinline__ int perm32(int rho) { const int n = rho >> 4, i = rho & 15; return 8 * (i >> 2) + 4 * n + (i & 3); }
struct Unit { int pm, pn; };
struct Gemm { const bf16_t* A; const bf16_t* Bt; int M, N, K; };
struct StaticOrder {
    int nM, nN, nwg, G, c;
    __host__ __device__ void init(int M, int N, int G_, int c_) { nM = M / BM; nN = N / BM; nwg = nM * nN; G = G_; c = c_; }
    __host__ __device__ bool next(int i, Unit& u) const { return at((long)i * G + c, u); }
    __host__ __device__ bool at(long L, Unit& u) const {
        if (L >= nwg) return false;
        int wgid = (int)L; { const int q = nwg / NXCD, r = nwg % NXCD, xcd = wgid % NXCD, off = wgid / NXCD; wgid = (xcd < r ? xcd * (q + 1) : r * (q + 1) + (xcd - r) * q) + off; }
        const int nig = WGM * nN, gid = wgid / nig, fm = gid * WGM, gsz = (nM - fm) < WGM ? (nM - fm) : WGM;
        u.pm = fm + ((wgid % nig) % gsz); u.pn = (wgid % nig) / gsz; return true;
    }
    __device__ __forceinline__ void a_ready(const Unit&) const {}
    __device__ __forceinline__ void done(const Unit&) const {}
};
struct SplitOrder {
    StaticOrder b;
    __host__ __device__ void init(int M, int N, int G_, int c_) { b.init(M, N, G_, c_); }
    __host__ __device__ bool next(int i, Unit& u) const {
        if (b.G != 256 || b.nwg != 512) return b.next(i, u);
        if (b.c < 128) return i < 1 ? b.at(b.c, u) : false;
        return i < 3 ? b.at(128 + (b.c - 128) * 3 + i, u) : false;
    }
    __device__ __forceinline__ void a_ready(const Unit&) const {}
    __device__ __forceinline__ void done(const Unit&) const {}
};
typedef int i32x8 __attribute__((ext_vector_type(8)));
template <class Epi, class Sched, bool ALIGN_EPI = false, bool SP2 = false, int MODE = 0>
__device__ __forceinline__ void gemm_phase(LAS unsigned char* lds, const Gemm g, const Sched& S, const Epi& E) {
    const int tid = threadIdx.x, wid = __builtin_amdgcn_readfirstlane(tid >> 6), lane = tid & 63, wr = wid >> 2, wc = wid & 3, fr = lane & 15, fq = lane >> 4;
    const int K = g.K, nt = K / BK;
    unsigned voffA[2], voffB[2];
#pragma unroll
    for (int i = 0; i < 2; ++i) { int R, C; stage_rc(tid * 16 + i * 8192, R, C); const int Rb = Epi::PERM ? ((R & ~31) + perm32(R & 31)) : R;
        voffA[i] = (unsigned)(R * K + C) * 2u; voffB[i] = (unsigned)(Rb * K + C) * 2u; }
    const size_t kstep = (size_t)(BK * 2);
    const size_t hstep = (size_t)HALF * K * 2;
    const size_t tstep = 2 * hstep;
    const unsigned ldsw = (unsigned)wid * 1024u;
    const int aoff = lds_byte(wr * 64 + fr, fq * 8), boff = lds_byte(wc * 32 + fr, fq * 8);
#define PG8_SA(b, h) (((b) * 2 + (h)) * HTB)
#define PG8_SB(b, h) ((4 + (b) * 2 + (h)) * HTB)
#define PG8_STAGE(bufoff, gbase, voff) do { _Pragma("unroll") for (int _i = 0; _i < 2; ++_i) \
        __builtin_amdgcn_global_load_lds((const unsigned*)((const char*)(gbase) + (voff)[_i]), (LAS unsigned*)(lds + (bufoff) + ldsw + _i * 8192), 16, 0, 0); } while (0)
#define PG8_LD8(p_) ({ const i32x4 _lo = *(const LAS i32x4*)(p_), _hi = *(const LAS i32x4*)((p_) + 1024); (i32x8){_lo[0], _lo[1], _lo[2], _lo[3], _hi[0], _hi[1], _hi[2], _hi[3]}; })
#define PG8_LDA(dst, b, h) do { _Pragma("unroll") for (int m = 0; m < 4; ++m) dst[m] = PG8_LD8(lds + PG8_SA(b, h) + aoff + m * 2048); } while (0)
#define PG8_LDB(dst, b, h) do { _Pragma("unroll") for (int n = 0; n < 2; ++n) dst[n] = PG8_LD8(lds + PG8_SB(b, h) + boff + n * 2048); } while (0)
#define PG8_HALF(v, k) ((k) == 0 ? __builtin_shufflevector(v, v, 0, 1, 2, 3) : __builtin_shufflevector(v, v, 4, 5, 6, 7))
#define PG8_MMA(ai, bj, At, Bt) do { __builtin_amdgcn_s_setprio(1); _Pragma("unroll") for (int m = 0; m < 4; ++m) _Pragma("unroll") for (int n = 0; n < 2; ++n) { \
        if (MODE == 2) asm volatile("v_mfma_scale_f32_16x16x128_f8f6f4 %0, %1, %2, %0, %3, %3 op_sel_hi:[0,0,0]" : "+v"(acc[ai][bj][m][n]) : "v"(Bt[n]), "v"(At[m]), "v"(scl1)); \
        else { _Pragma("unroll") for (int k = 0; k < 2; ++k) \
            acc[ai][bj][m][n] = (MODE == 1) ? __builtin_bit_cast(f32x4, __builtin_amdgcn_mfma_i32_16x16x64_i8(PG8_HALF(Bt[n], k), PG8_HALF(At[m], k), __builtin_bit_cast(i32x4, acc[ai][bj][m][n]), 0, 0, 0)) \
                                            : __builtin_amdgcn_mfma_f32_16x16x32_bf16(__builtin_bit_cast(bf16x8, PG8_HALF(Bt[n], k)), __builtin_bit_cast(bf16x8, PG8_HALF(At[m], k)), acc[ai][bj][m][n], 0, 0, 0); } } __builtin_amdgcn_s_setprio(0); } while (0)
#define PG8_WAIT_V(n) asm volatile("s_waitcnt vmcnt(" #n ")" ::: "memory")
#define PG8_WAIT_L(n) asm volatile("s_waitcnt lgkmcnt(" #n ")" ::: "memory")
#define PG8_BAR __builtin_amdgcn_s_barrier()
#define PG8_SCHED __builtin_amdgcn_sched_barrier(0)
    const int scl1 = 0x7f7f7f7f;
    Unit cur, nxt; int ui = 0;
    if (!S.next(0, cur)) return;
    f32x4 acc[2][2][4][2];
#pragma unroll
    for (int a = 0; a < 2; ++a)
#pragma unroll
        for (int b = 0; b < 2; ++b)
#pragma unroll
            for (int m = 0; m < 4; ++m)
#pragma unroll
                for (int n = 0; n < 2; ++n) acc[a][b][m][n] = (f32x4){0.f, 0.f, 0.f, 0.f};
    i32x8 At[4], B0[2], B1[2];
    const char* cA = (const char*)g.A + (size_t)cur.pm * tstep; const char* cB = (const char*)g.Bt + (size_t)cur.pn * tstep;
    S.a_ready(cur);
    if constexpr (SP2) {
        PG8_STAGE(PG8_SB(0, 0), cB, voffB); PG8_STAGE(PG8_SB(0, 1), cB + hstep, voffB); PG8_STAGE(PG8_SA(0, 0), cA, voffA); PG8_STAGE(PG8_SA(0, 1), cA + hstep, voffA);
        if (wr == 1) PG8_BAR;
        PG8_WAIT_V(2); PG8_BAR;
        PG8_STAGE(PG8_SB(1, 0), cB + kstep, voffB); PG8_STAGE(PG8_SA(1, 0), cA + kstep, voffA); PG8_STAGE(PG8_SB(1, 1), cB + hstep + kstep, voffB);
        PG8_WAIT_V(6); PG8_BAR;
    } else {
        PG8_STAGE(PG8_SB(0, 0), cB, voffB); PG8_STAGE(PG8_SA(0, 0), cA, voffA); PG8_STAGE(PG8_SB(0, 1), cB + hstep, voffB); PG8_STAGE(PG8_SA(0, 1), cA + hstep, voffA);
        if (wr == 1) PG8_BAR;
        PG8_WAIT_V(4); PG8_BAR;
        PG8_STAGE(PG8_SB(1, 0), cB + kstep, voffB); PG8_STAGE(PG8_SA(1, 0), cA + kstep, voffA); PG8_STAGE(PG8_SB(1, 1), cB + hstep + kstep, voffB);
        PG8_WAIT_V(6); PG8_BAR;
    }
    for (;;) {
        const bool has_next = S.next(ui + 1, nxt);
        const char* nA = has_next ? (const char*)g.A + (size_t)nxt.pm * tstep : cA; const char* nB = has_next ? (const char*)g.Bt + (size_t)nxt.pn * tstep : cB;
#pragma unroll 1
        for (int t = 0; t < nt; t += 2) {
            const bool last = (t == nt - 2);
            const char* a1 = cA + (size_t)(t + 1) * kstep;
            const char* a2 = last ? nA : cA + (size_t)(t + 2) * kstep; const char* b2 = last ? nB : cB + (size_t)(t + 2) * kstep;
            const char* a3 = a2 + kstep; const char* b3 = b2 + kstep;
            if (last && has_next) S.a_ready(nxt);
            if constexpr (SP2) {
            PG8_LDB(B0, 0, 0); PG8_LDB(B1, 0, 1); PG8_SCHED; PG8_LDA(At, 0, 0); PG8_STAGE(PG8_SA(1, 1), a1 + hstep, voffA);
            PG8_WAIT_V(8); PG8_WAIT_L(0); PG8_BAR; PG8_MMA(0, 0, At, B0); PG8_MMA(0, 1, At, B1); PG8_BAR; PG8_SCHED;
            PG8_LDA(At, 0, 1); PG8_STAGE(PG8_SB(0, 0), b2, voffB); PG8_STAGE(PG8_SB(0, 1), b2 + hstep, voffB); PG8_STAGE(PG8_SA(0, 0), a2, voffA);
            PG8_WAIT_V(8); PG8_WAIT_L(0); PG8_BAR; PG8_MMA(1, 0, At, B0); PG8_MMA(1, 1, At, B1); PG8_BAR; PG8_SCHED;
            PG8_LDB(B0, 1, 0); PG8_LDB(B1, 1, 1); PG8_SCHED; PG8_LDA(At, 1, 0); PG8_STAGE(PG8_SA(0, 1), a2 + hstep, voffA);
            PG8_WAIT_V(8); PG8_WAIT_L(0); PG8_BAR; PG8_MMA(0, 0, At, B0); PG8_MMA(0, 1, At, B1); PG8_BAR; PG8_SCHED;
            PG8_LDA(At, 1, 1); PG8_STAGE(PG8_SB(1, 0), b3, voffB); PG8_STAGE(PG8_SB(1, 1), b3 + hstep, voffB); PG8_STAGE(PG8_SA(1, 0), a3, voffA);
            PG8_WAIT_V(8); PG8_WAIT_L(0); PG8_BAR; PG8_MMA(1, 0, At, B0); PG8_MMA(1, 1, At, B1); PG8_BAR; PG8_SCHED;
            } else {
            PG8_LDB(B0, 0, 0); PG8_SCHED; PG8_LDA(At, 0, 0); PG8_STAGE(PG8_SA(1, 1), a1 + hstep, voffA);
            PG8_WAIT_L(8); PG8_BAR; PG8_WAIT_L(0); PG8_MMA(0, 0, At, B0); PG8_BAR; PG8_SCHED;
            PG8_LDB(B1, 0, 1); PG8_STAGE(PG8_SB(0, 0), b2, voffB);
            PG8_BAR; PG8_WAIT_L(0); PG8_MMA(0, 1, At, B1); PG8_BAR;
            PG8_LDA(At, 0, 1); PG8_STAGE(PG8_SA(0, 0), a2, voffA);
            PG8_BAR; PG8_WAIT_L(0); PG8_MMA(1, 0, At, B0); PG8_BAR; PG8_SCHED;
            PG8_STAGE(PG8_SB(0, 1), b2 + hstep, voffB);
            PG8_WAIT_V(6); PG8_BAR; PG8_MMA(1, 1, At, B1); PG8_BAR;
            PG8_LDB(B0, 1, 0); PG8_SCHED; PG8_LDA(At, 1, 0); PG8_STAGE(PG8_SA(0, 1), a2 + hstep, voffA);
            PG8_WAIT_L(8); PG8_BAR; PG8_WAIT_L(0); PG8_MMA(0, 0, At, B0); PG8_BAR; PG8_SCHED;
            PG8_LDB(B1, 1, 1); PG8_STAGE(PG8_SB(1, 0), b3, voffB);
            PG8_BAR; PG8_WAIT_L(0); PG8_MMA(0, 1, At, B1); PG8_BAR;
            PG8_LDA(At, 1, 1); PG8_STAGE(PG8_SA(1, 0), a3, voffA);
            PG8_BAR; PG8_WAIT_L(0); PG8_MMA(1, 0, At, B0); PG8_BAR; PG8_SCHED;
            PG8_STAGE(PG8_SB(1, 1), b3 + hstep, voffB);
            PG8_WAIT_V(6); PG8_BAR; PG8_MMA(1, 1, At, B1); PG8_BAR;
            }
        }
        if constexpr (ALIGN_EPI) { if (wr == 0) PG8_BAR; }
        if (MODE == 2) asm volatile("s_nop 15\n\ts_nop 15" ::: "memory");
        E(acc, cur, wr, wc, fr, fq); S.done(cur);
        if (!has_next) break;
#pragma unroll
        for (int a = 0; a < 2; ++a)
#pragma unroll
            for (int b = 0; b < 2; ++b)
#pragma unroll
                for (int m = 0; m < 4; ++m)
#pragma unroll
                    for (int n = 0; n < 2; ++n) acc[a][b][m][n] = (f32x4){0.f, 0.f, 0.f, 0.f};
        cur = nxt; cA = nA; cB = nB; ++ui;
        if constexpr (ALIGN_EPI) { if (wr == 1) PG8_BAR; }
    }
    PG8_WAIT_V(0);
    if constexpr (!ALIGN_EPI) { if (wr == 0) PG8_BAR; }
    PG8_BAR;
#undef PG8_SA
#undef PG8_SB
#undef PG8_STAGE
#undef PG8_LDA
#undef PG8_LDB
#undef PG8_MMA
#undef PG8_WAIT_V
#undef PG8_WAIT_L
#undef PG8_BAR
#undef PG8_SCHED
}

struct EpiProj {
    static constexpr bool PERM = true;
    bf16_t* PA; bf16_t* PG; bf16_t* UB; const float* SA; const float* SB;
    __device__ __forceinline__ void operator()(const f32x4 (&acc)[2][2][4][2], const Unit& u, int wr, int wc, int fr, int fq) const {
        const int row0 = u.pm * BM + wr * 64 + fr; int colt = u.pn * BM; const bool isu = colt < 1024; bf16_t* base = colt < 4096 ? PA : PG;
        const int gcol0 = colt + wc * 32 + 8 * fq; colt &= 4095;
        const int col0 = colt + wc * 32 + 8 * fq;
        f32x4 sb[2][2];
#pragma unroll
        for (int bj = 0; bj < 2; ++bj) { sb[bj][0] = *(const f32x4*)(SB + gcol0 + bj * HALF); sb[bj][1] = *(const f32x4*)(SB + gcol0 + bj * HALF + 4); }
#pragma unroll
        for (int ai = 0; ai < 2; ++ai)
#pragma unroll
            for (int m = 0; m < 4; ++m) { const int row = row0 + ai * HALF + m * 16; bf16_t* rowp = base + (size_t)row * 4096 + col0; const float sa = SA[row];
#pragma unroll
                for (int bj = 0; bj < 2; ++bj) { const i32x4 i0 = __builtin_bit_cast(i32x4, acc[ai][bj][m][0]), i1 = __builtin_bit_cast(i32x4, acc[ai][bj][m][1]);
                    f32x4 v0, v1;
#pragma unroll
                    for (int e = 0; e < 4; ++e) { v0[e] = (float)i0[e] * sa * sb[bj][0][e]; v1[e] = (float)i1[e] * sa * sb[bj][1][e]; }
                    u32x4 w; w.x = cvt_pk_bf16(v0[0], v0[1]); w.y = cvt_pk_bf16(v0[2], v0[3]); w.z = cvt_pk_bf16(v1[0], v1[1]); w.w = cvt_pk_bf16(v1[2], v1[3]);
                    if (isu) { const int cu = col0 + bj * HALF; *(u32x4*)(UB + (((size_t)((row >> 13) * 64 + (cu >> 4)) * 8192 + (row & 8191)) * 16 + (cu & 8))) = w; }
                    else *(u32x4*)(rowp + bj * HALF) = w; } }
    }
};
struct EpiAttUp {
    static constexpr bool PERM = true;
    const bf16_t* PG; bf16_t* HB;
    __device__ __forceinline__ void operator()(const f32x4 (&acc)[2][2][4][2], const Unit& u, int wr, int wc, int fr, int fq) const {
        const int row0 = u.pm * BM + wr * 64 + fr; const int col0 = u.pn * BM + wc * 32 + 8 * fq;
#pragma unroll
        for (int ai = 0; ai < 2; ++ai)
#pragma unroll
            for (int m = 0; m < 4; ++m) { const size_t row = (size_t)(row0 + ai * HALF + m * 16);
#pragma unroll
                for (int bj = 0; bj < 2; ++bj) { const int col = col0 + bj * HALF;
                    const u32x4 gw = *(const u32x4*)(PG + row * 4096 + 2048 + col);
                    const f32x4 v0 = acc[ai][bj][m][0] * F8_INV, v1 = acc[ai][bj][m][1] * F8_INV;
                    u32x4 w;
                    w.x = cvt_pk_bf16(v0[0] * sigmoidf_(bf_lo(gw.x)), v0[1] * sigmoidf_(bf_hi(gw.x)));
                    w.y = cvt_pk_bf16(v0[2] * sigmoidf_(bf_lo(gw.y)), v0[3] * sigmoidf_(bf_hi(gw.y)));
                    w.z = cvt_pk_bf16(v1[0] * sigmoidf_(bf_lo(gw.z)), v1[1] * sigmoidf_(bf_hi(gw.z)));
                    w.w = cvt_pk_bf16(v1[2] * sigmoidf_(bf_lo(gw.w)), v1[3] * sigmoidf_(bf_hi(gw.w)));
                    *(u32x4*)(HB + row * 2048 + col) = w; } asm volatile("" ::: "memory"); }
    }
};
struct EpiGlu {
    static constexpr bool PERM = true;
    const bf16_t* PG; const bf16_t* HB; unsigned char* M8;
    __device__ __forceinline__ void operator()(const f32x4 (&acc)[2][2][4][2], const Unit& u, int wr, int wc, int fr, int fq) const {
        const int row0 = u.pm * BM + wr * 64 + fr; const int col = u.pn * HALF + wc * 32 + 8 * fq;
#pragma unroll
        for (int ai = 0; ai < 2; ++ai)
#pragma unroll
            for (int m = 0; m < 4; ++m) { const size_t row = (size_t)(row0 + ai * HALF + m * 16);
                const u32x4 gw = *(const u32x4*)(PG + row * 4096 + col);
                const u32x4 aw = *(const u32x4*)(HB + row * 2048 + col);
                const f32x4 a0 = acc[ai][0][m][0] * F8_INV, a1 = acc[ai][0][m][1] * F8_INV, g0 = acc[ai][1][m][0] * F8_INV, g1 = acc[ai][1][m][1] * F8_INV;
                u32x2 w;
                w.x = pack4_fp8(sigmoidf_(bf_lo(gw.x)) * a0[0] * sigmoidf_(g0[0]) + bf_lo(aw.x), sigmoidf_(bf_hi(gw.x)) * a0[1] * sigmoidf_(g0[1]) + bf_hi(aw.x),
                                sigmoidf_(bf_lo(gw.y)) * a0[2] * sigmoidf_(g0[2]) + bf_lo(aw.y), sigmoidf_(bf_hi(gw.y)) * a0[3] * sigmoidf_(g0[3]) + bf_hi(aw.y), F8_SA);
                w.y = pack4_fp8(sigmoidf_(bf_lo(gw.z)) * a1[0] * sigmoidf_(g1[0]) + bf_lo(aw.z), sigmoidf_(bf_hi(gw.z)) * a1[1] * sigmoidf_(g1[1]) + bf_hi(aw.z),
                                sigmoidf_(bf_lo(gw.w)) * a1[2] * sigmoidf_(g1[2]) + bf_lo(aw.w), sigmoidf_(bf_hi(gw.w)) * a1[3] * sigmoidf_(g1[3]) + bf_hi(aw.w), F8_SA);
                *(u32x2*)(M8 + row * 2048 + col) = w; asm volatile("" ::: "memory"); }
    }
};
struct EpiOut {
    static constexpr bool PERM = true;
    const float* X; float* O; const float* mod;
    __device__ __forceinline__ void operator()(const f32x4 (&acc)[2][2][4][2], const Unit& u, int wr, int wc, int fr, int fq) const {
        const int row0 = u.pm * BM + wr * 64 + fr; const int col0 = u.pn * BM + wc * 32 + 8 * fq;
        const float* gt = mod + (size_t)((u.pm * BM) >> 13) * 12288 + 4096;
#pragma unroll
        for (int bj = 0; bj < 2; ++bj) { const int col = col0 + bj * HALF;
            const f32x4 g0 = *(const f32x4*)(gt + col), g1 = *(const f32x4*)(gt + col + 4);
#pragma unroll
            for (int ai = 0; ai < 2; ++ai)
#pragma unroll
                for (int m = 0; m < 4; ++m) { const size_t off = (size_t)(row0 + ai * HALF + m * 16) * 2048 + col;
                    const f32x4 x0 = *(const f32x4*)(X + off), x1 = *(const f32x4*)(X + off + 4);
                    *(f32x4*)(O + off) = x0 + g0 * (acc[ai][bj][m][0] * F8_INV); *(f32x4*)(O + off + 4) = x1 + g1 * (acc[ai][bj][m][1] * F8_INV); } }
    }
};
struct EpiF32 {
    static constexpr bool PERM = true;
    float* O;
    __device__ __forceinline__ void operator()(const f32x4 (&acc)[2][2][4][2], const Unit& u, int wr, int wc, int fr, int fq) const {
        const int row0 = u.pm * BM + wr * 64 + fr; const int col0 = u.pn * BM + wc * 32 + 8 * fq;
#pragma unroll
        for (int ai = 0; ai < 2; ++ai)
#pragma unroll
            for (int m = 0; m < 4; ++m) { float* rowp = O + (size_t)(row0 + ai * HALF + m * 16) * 2048 + col0;
#pragma unroll
                for (int bj = 0; bj < 2; ++bj) { *(f32x4*)(rowp + bj * HALF) = acc[ai][bj][m][0]; *(f32x4*)(rowp + bj * HALF + 4) = acc[ai][bj][m][1]; } }
    }
};
}

struct Args { const float* in[25]; float* out; unsigned char* ws; int ph_lo, ph_hi; };
enum { I_X = 0, I_C, I_WADA, I_BADA, I_N1G, I_WIN, I_LRE, I_LIM, I_LDT, I_BRE, I_BIM, I_CRE, I_CIM, I_SD, I_WGLU, I_QNG, I_KNG, I_WATT, I_WOUT, I_N2G, I_WQ, I_K1, I_K2, I_PU, I_PV };

__device__ __forceinline__ void ph_mod_partial(const float* __restrict__ c, const float* __restrict__ w_ada, float* modp, int gw, int ngw, int lane) {
    for (int task = gw; task < 48 * 32; task += ngw) {
        const int strip = task % 48, ks = task / 48, n0 = strip * 256 + lane * 4, k0 = ks * 64;
        f32x4 a0 = {0.f, 0.f, 0.f, 0.f}, a1 = {0.f, 0.f, 0.f, 0.f};
#pragma unroll 8
        for (int k = 0; k < 64; ++k) {
            const f32x4 w = *(const f32x4*)(w_ada + (size_t)(k0 + k) * 12288 + n0);
            float c0 = c[k0 + k], c1 = c[2048 + k0 + k];
            c0 = c0 / (1.0f + __expf(-c0)); c1 = c1 / (1.0f + __expf(-c1));
            a0 += c0 * w; a1 += c1 * w;
        }
        *(f32x4*)(modp + (size_t)(ks * 2 + 0) * 12288 + n0) = a0;
        *(f32x4*)(modp + (size_t)(ks * 2 + 1) * 12288 + n0) = a1;
    }
}

__device__ __forceinline__ void ph_colmax_partial(const float* __restrict__ w_in, float* cmaxp, int gw, int ngw, int lane) {
    for (int task = gw; task < 32 * 32; task += ngw) {
        const int strip = task & 31, ks = task >> 5, n0 = strip * 256 + lane * 4, k0 = ks * 64;
        f32x4 m = {0.f, 0.f, 0.f, 0.f};
#pragma unroll 8
        for (int k = 0; k < 64; ++k) { const f32x4 w = *(const f32x4*)(w_in + (size_t)(k0 + k) * 8192 + n0);
            m[0] = fmaxf(m[0], fabsf(w[0])); m[1] = fmaxf(m[1], fabsf(w[1])); m[2] = fmaxf(m[2], fabsf(w[2])); m[3] = fmaxf(m[3], fabsf(w[3])); }
        *(f32x4*)(cmaxp + (size_t)ks * 8192 + n0) = m;
    }
}

__device__ __forceinline__ void transpose_item_f8(const float* __restrict__ W, int K, int N, unsigned char* WT8, int drow0, int scol0, int k0, LAS float* scr, int lane) {
#pragma unroll 8
    for (int i = 0; i < 32; ++i) { const int kk = 2 * i + (lane >> 5); scr[kk * 33 + (lane & 31)] = W[(size_t)(k0 + kk) * N + scol0 + (lane & 31)]; }
    LDS_WAIT();
    const int n = lane >> 1, half = lane & 1;
    const LAS float* s = scr + (32 * half) * 33 + n;
    u32x4 o[2];
#pragma unroll
    for (int q = 0; q < 8; ++q) o[q >> 2][q & 3] = pack4_fp8(s[(4 * q) * 33], s[(4 * q + 1) * 33], s[(4 * q + 2) * 33], s[(4 * q + 3) * 33], F8_SW);
    *(u32x4*)(WT8 + (size_t)(drow0 + n) * K + k0 + 32 * half) = o[0];
    *(u32x4*)(WT8 + (size_t)(drow0 + n) * K + k0 + 32 * half + 16) = o[1];
    LDS_WAIT();
}
__device__ __forceinline__ void transpose_item_i8(const float* __restrict__ W, signed char* WT8, const float* cmaxp, float* SB, int n0, int k0, LAS float* scr, int lane) {
#pragma unroll 8
    for (int i = 0; i < 32; ++i) { const int kk = 2 * i + (lane >> 5); scr[kk * 33 + (lane & 31)] = W[(size_t)(k0 + kk) * 8192 + n0 + (lane & 31)]; }
    const int n = lane >> 1, half = lane & 1;
    float cm = 0.f;
#pragma unroll 8
    for (int ks = 0; ks < 32; ++ks) cm = fmaxf(cm, cmaxp[(size_t)ks * 8192 + n0 + n]);
    const float sb = fmaxf(cm, 1e-30f) * (1.0f / 127.0f), inv = 1.0f / sb;
    if (k0 == 0 && half == 0) SB[n0 + n] = sb;
    LDS_WAIT();
    const LAS float* s = scr + (32 * half) * 33 + n;
    u32x4 o[2];
#pragma unroll
    for (int q = 0; q < 8; ++q) { unsigned w = 0;
#pragma unroll
        for (int e = 0; e < 4; ++e) { const int v = (int)rintf(s[(4 * q + e) * 33] * inv); w |= ((unsigned)v & 0xffu) << (8 * e); }
        o[q >> 2][q & 3] = w; }
    *(u32x4*)(WT8 + (size_t)(n0 + n) * 2048 + k0 + 32 * half) = o[0];
    *(u32x4*)(WT8 + (size_t)(n0 + n) * 2048 + k0 + 32 * half + 16) = o[1];
    LDS_WAIT();
}

__device__ __forceinline__ void transpose_item(const float* __restrict__ W, int K, int N, bf16_t* WT, int drow0, int scol0, int k0, LAS float* scr, int lane) {
#pragma unroll 8
    for (int i = 0; i < 32; ++i) { const int kk = 2 * i + (lane >> 5); scr[kk * 33 + (lane & 31)] = W[(size_t)(k0 + kk) * N + scol0 + (lane & 31)]; }
    LDS_WAIT();
    const int c = lane & 7;
#pragma unroll
    for (int j = 0; j < 4; ++j) { const int n = (lane >> 3) + 8 * j; const LAS float* s = scr + (8 * c) * 33 + n;
        u32x4 o; o.x = cvt_pk_bf16(s[0 * 33], s[1 * 33]); o.y = cvt_pk_bf16(s[2 * 33], s[3 * 33]); o.z = cvt_pk_bf16(s[4 * 33], s[5 * 33]); o.w = cvt_pk_bf16(s[6 * 33], s[7 * 33]);
        *(u32x4*)(WT + (size_t)(drow0 + n) * K + k0 + 8 * c) = o; }
    LDS_WAIT();
}
__device__ __forceinline__ void wsc_item(const float* wq, const float* kk, bf16_t* out, int lane) {
    const int r = lane & 15, q = lane >> 4;
    f32x4 acc[8];
#pragma unroll
    for (int f = 0; f < 8; ++f) acc[f] = (f32x4){0.f, 0.f, 0.f, 0.f};
    const float* ap = kk + r * 128 + 4 * q; const float* bp = wq + (size_t)r * 2048 + 4 * q;
#pragma unroll 2
    for (int d0 = 0; d0 < 128; d0 += 16) {
        const f32x4 bv = *(const f32x4*)(bp + d0);
        f32x4 av[8];
#pragma unroll
        for (int f = 0; f < 8; ++f) av[f] = *(const f32x4*)(ap + f * 2048 + d0);
#pragma unroll
        for (int j = 0; j < 4; ++j)
#pragma unroll
            for (int f = 0; f < 8; ++f) acc[f] = __builtin_amdgcn_mfma_f32_16x16x4f32(av[f][j], bv[j], acc[f], 0, 0, 0);
    }
#pragma unroll
    for (int f = 0; f < 8; ++f)
#pragma unroll
        for (int i = 0; i < 4; ++i) out[(size_t)(16 * f + 4 * q + i) * 2048 + r] = (bf16_t)(cvt_pk_bf16(acc[f][i], 0.f) & 0xffffu);
}
__device__ __forceinline__ void ph_prologue(const Args& a, LAS unsigned char* lds, int gw, int ngw, int lane, int wave) {
    unsigned char* ws = a.ws;
    { const float* modp = (const float*)(ws + WS_MODP); float* mod = (float*)(ws + WS_MOD); const float* b_ada = a.in[I_BADA];
      for (int idx = gw * 64 + lane; idx < 2 * 12288; idx += ngw * 64) { const int b = idx / 12288, n = idx - b * 12288; float s = b_ada[n];
#pragma unroll 8
          for (int ks = 0; ks < 32; ++ks) s += modp[(size_t)(ks * 2 + b) * 12288 + n];
          mod[idx] = s; } }
    for (int item = gw; item < 2048; item += ngw) { const int hj = item >> 7, k0 = (item & 127) * 16;
        wsc_item(a.in[I_WQ] + (size_t)k0 * 2048 + hj * 128, (hj & 1) ? a.in[I_K2] : a.in[I_K1], (bf16_t*)(ws + WS_WSC) + (size_t)(hj * 128) * 2048 + k0, lane); }
    { LAS float* scr = (LAS float*)(lds + wave * 8448);
      constexpr int I_IN = 32 * 256, I_GLU = 16 * 128, I_ATT = 16 * 64, I_OUT = 32 * 64, NIT = I_IN + I_GLU + I_ATT + I_OUT;
      for (int it = gw; it < NIT; it += ngw) {
          int r = it;
          if (r < I_IN) { const int kb = r / 256, nb = r % 256; transpose_item_i8(a.in[I_WIN], (signed char*)(ws + WS_WIN), (const float*)(ws + WS_CMAXP), (float*)(ws + WS_SB), 32 * nb, 64 * kb, scr, lane); continue; } r -= I_IN;
          if (r < I_GLU) { const int kb = r / 128, nb = r % 128, dr = 32 * nb; const int sc = ((dr >> 7) & 1) * 2048 + (dr >> 8) * 128 + (dr & 127);
              transpose_item_f8(a.in[I_WGLU], 1024, 4096, ws + WS_WGLU, dr, sc, 64 * kb, scr, lane); continue; } r -= I_GLU;
          if (r < I_ATT) { const int kb = r / 64, nb = r % 64; transpose_item_f8(a.in[I_WATT], 1024, 2048, ws + WS_WATT, 32 * nb, 32 * nb, 64 * kb, scr, lane); continue; } r -= I_ATT;
          { const int kb = r / 64, nb = r % 64; transpose_item_f8(a.in[I_WOUT], 2048, 2048, ws + WS_WOUT, 32 * nb, 32 * nb, 64 * kb, scr, lane); }
      } }
}

template <bool I8>
__device__ __forceinline__ void ph_norm(const float* X, bf16_t* Hout, float* SA, const float* __restrict__ g, const float* mod, int sh_off, int sc_off, int gw, int ngw, int lane) {
    for (int row = gw; row < T_TOK; row += ngw) {
        const int b = row >> 13;
        const f32x4* xr = (const f32x4*)(X + (size_t)row * DM) + lane;
        f32x4 v[8]; float ss = 0.f;
#pragma unroll
        for (int j = 0; j < 8; ++j) { v[j] = xr[64 * j]; ss += (v[j][0] * v[j][0] + v[j][1] * v[j][1]) + (v[j][2] * v[j][2] + v[j][3] * v[j][3]); }
        ss = wave_sum(ss);
        const float rs = 1.0f / sqrtf(ss * (1.0f / DM) + EPS);
        const float* mb = mod + (size_t)b * 12288;
        float amax = 0.f;
#pragma unroll
        for (int j = 0; j < 8; ++j) { const int col = 4 * (lane + 64 * j);
            const f32x4 gv = *(const f32x4*)(g + col), sc = *(const f32x4*)(mb + sc_off + col), sh = *(const f32x4*)(mb + sh_off + col);
            const f32x4 o = v[j] * rs * gv * (sc + 1.0f) + sh;
            if (I8) { v[j] = o; amax = fmaxf(fmaxf(amax, fmaxf(fabsf(o[0]), fabsf(o[1]))), fmaxf(fabsf(o[2]), fabsf(o[3]))); }
            else { u32x2 w; w.x = cvt_pk_bf16(o[0], o[1]); w.y = cvt_pk_bf16(o[2], o[3]); *(u32x2*)(Hout + (size_t)row * DM + col) = w; } }
        if (I8) {
#pragma unroll
            for (int o = 1; o < 64; o <<= 1) amax = fmaxf(amax, __shfl_xor(amax, o));
            const float sa = fmaxf(amax, 1e-30f) * (1.0f / 127.0f), inv = 1.0f / sa;
            if (lane == 0) SA[row] = sa;
            unsigned* h8 = (unsigned*)((signed char*)Hout + (size_t)row * DM) + lane;
#pragma unroll
            for (int j = 0; j < 8; ++j) { unsigned w = 0;
#pragma unroll
                for (int e = 0; e < 4; ++e) { const int q = (int)rintf(v[j][e] * inv); w |= ((unsigned)q & 0xffu) << (8 * e); }
                h8[64 * j] = w; }
        }
    }
}

template <int MODE>
__device__ __forceinline__ void ph_attn(LAS unsigned char* lds, const bf16_t* PA, bf16_t* ATT, const float* __restrict__ qg, const float* __restrict__ kg, int G) {
    const int tid = opaque_tid(), lane = tid & 63, wave = __builtin_amdgcn_readfirstlane(tid >> 6), c = lane & 15, g = lane >> 4;
    LAS unsigned char* KL = lds;
    LAS unsigned char* VT = lds + 17408;
    bf16x8 tri[6];
    { const int FS[6] = {0, 1, 0, 1, 2, 3}, FP[6] = {0, 0, 1, 1, 1, 1};
#pragma unroll
      for (int q = 0; q < 6; ++q)
#pragma unroll
          for (int jj = 0; jj < 8; ++jj) { const int kap = 32 * FP[q] + 16 * (jj >> 2) + 4 * g + (jj & 3); tri[q][jj] = (kap > 16 * FS[q] + c) ? (short)0x3F80 : (short)0; } }
    for (int u = blockIdx.x; u < 1024; u += G) {
        const int b = u >> 9, h = (u >> 6) & 7, qb = u & 63, t0 = qb * 128, tq0 = t0 + 16 * wave, tq = tq0 + c;
        bf16x8 qf[4];
        { const bf16_t* qrow = PA + (size_t)(b * SEQ + tq) * 4096 + 1024 + h * 128;
          u32x4 qr[4]; float ss = 0.f;
#pragma unroll
          for (int kk = 0; kk < 4; ++kk) { qr[kk] = *(const u32x4*)(qrow + 32 * kk + 8 * g);
#pragma unroll
              for (int e = 0; e < 4; ++e) { const float lo = bf_lo(qr[kk][e]), hi = bf_hi(qr[kk][e]); ss += lo * lo + hi * hi; } }
          ss += __shfl_xor(ss, 16); ss += __shfl_xor(ss, 32);
          const float rs = (1.0f / sqrtf(ss * (1.0f / 128.0f) + EPS)) * (0.08838834764831845f * 1.4426950408889634f);
#pragma unroll
          for (int kk = 0; kk < 4; ++kk) { const f32x4 g0 = *(const f32x4*)(qg + 32 * kk + 8 * g), g1 = *(const f32x4*)(qg + 32 * kk + 8 * g + 4);
              u32x4 w;
              w.x = cvt_pk_bf16(bf_lo(qr[kk].x) * rs * g0[0], bf_hi(qr[kk].x) * rs * g0[1]);
              w.y = cvt_pk_bf16(bf_lo(qr[kk].y) * rs * g0[2], bf_hi(qr[kk].y) * rs * g0[3]);
              w.z = cvt_pk_bf16(bf_lo(qr[kk].z) * rs * g1[0], bf_hi(qr[kk].z) * rs * g1[1]);
              w.w = cvt_pk_bf16(bf_lo(qr[kk].w) * rs * g1[2], bf_hi(qr[kk].w) * rs * g1[3]);
              qf[kk] = __builtin_bit_cast(bf16x8, w); } }
        float carry = 0.f; int wdone = 0;
        f32x4 oacc[8];
#pragma unroll
        for (int fd = 0; fd < 8; ++fd) oacc[fd] = (f32x4){0.f, 0.f, 0.f, 0.f};
        u32x4 kreg[2], vreg[2];
        { const int k0n = (2 * qb + 1) * 64;
#pragma unroll
          for (int p = 0; p < 2; ++p) { const int ci = tid + 512 * p, key = ci >> 4, ch = ci & 15;
              kreg[p] = *(const u32x4*)(PA + (size_t)(b * SEQ + k0n + key) * 4096 + 2048 + h * 128 + 8 * ch);
              vreg[p] = *(const u32x4*)(PA + (size_t)(b * SEQ + k0n + lane) * 4096 + 3072 + h * 128 + 8 * (wave + 8 * p)); } }
        for (int kt = 2 * qb + 1; kt >= 0; --kt) {
            const int k0 = kt * 64;
            if (__syncthreads_and(wdone)) break;
#pragma unroll
            for (int p = 0; p < 2; ++p) {
                const int ci = tid + 512 * p, key = ci >> 4, ch = ci & 15;
                const u32x4 kr = kreg[p];
                float f[8]; f[0] = bf_lo(kr.x); f[1] = bf_hi(kr.x); f[2] = bf_lo(kr.y); f[3] = bf_hi(kr.y); f[4] = bf_lo(kr.z); f[5] = bf_hi(kr.z); f[6] = bf_lo(kr.w); f[7] = bf_hi(kr.w);
                float ss = 0.f;
#pragma unroll
                for (int e = 0; e < 8; ++e) ss += f[e] * f[e];
                ss += __shfl_xor(ss, 1); ss += __shfl_xor(ss, 2); ss += __shfl_xor(ss, 4); ss += __shfl_xor(ss, 8);
                const float rs = 1.0f / sqrtf(ss * (1.0f / 128.0f) + EPS);
                const f32x4 g0 = *(const f32x4*)(kg + 8 * ch), g1 = *(const f32x4*)(kg + 8 * ch + 4);
                u32x4 w;
                w.x = cvt_pk_bf16(f[0] * rs * g0[0], f[1] * rs * g0[1]); w.y = cvt_pk_bf16(f[2] * rs * g0[2], f[3] * rs * g0[3]);
                w.z = cvt_pk_bf16(f[4] * rs * g1[0], f[5] * rs * g1[1]); w.w = cvt_pk_bf16(f[6] * rs * g1[2], f[7] * rs * g1[3]);
                *(LAS u32x4*)(KL + key * 272 + ch * 16) = w;
            }
#pragma unroll
            for (int p = 0; p < 2; ++p) {
                const int key = lane, ch = wave + 8 * p;
                const u32x4 vr = vreg[p];
                LAS unsigned short* vt = (LAS unsigned short*)(VT + (8 * ch) * 144 + key * 2);
                vt[0 * 72] = (unsigned short)(vr.x & 0xffffu); vt[1 * 72] = (unsigned short)(vr.x >> 16);
                vt[2 * 72] = (unsigned short)(vr.y & 0xffffu); vt[3 * 72] = (unsigned short)(vr.y >> 16);
                vt[4 * 72] = (unsigned short)(vr.z & 0xffffu); vt[5 * 72] = (unsigned short)(vr.z >> 16);
                vt[6 * 72] = (unsigned short)(vr.w & 0xffffu); vt[7 * 72] = (unsigned short)(vr.w >> 16);
            }
            if (kt > 0) { const int k0n = k0 - 64;
#pragma unroll
                for (int p = 0; p < 2; ++p) { const int ci = tid + 512 * p, key = ci >> 4, ch = ci & 15;
                    kreg[p] = *(const u32x4*)(PA + (size_t)(b * SEQ + k0n + key) * 4096 + 2048 + h * 128 + 8 * ch);
                    vreg[p] = *(const u32x4*)(PA + (size_t)(b * SEQ + k0n + lane) * 4096 + 3072 + h * 128 + 8 * (wave + 8 * p)); } }
            __syncthreads();
            if (MODE == 1) { if (kt <= 2 * qb - 3) wdone = 1; }
            if (MODE == 0 && !wdone && k0 < tq0 + 15) {
                f32x4 zt[4];
#pragma unroll
                for (int f = 0; f < 4; ++f) { f32x4 acc = {0.f, 0.f, 0.f, 0.f};
#pragma unroll
                    for (int kk = 0; kk < 4; ++kk) { const bf16x8 kf = *(const LAS bf16x8*)(KL + (16 * f + c) * 272 + (32 * kk + 8 * g) * 2);
                        acc = __builtin_amdgcn_mfma_f32_16x16x32_bf16(kf, qf[kk], acc, 0, 0, 0); }
                    zt[f] = acc; }
                float lf[4][4], lz[4][4]; float tot = 0.f;
                if (k0 + 63 >= tq0) {
#pragma unroll
                    for (int f = 0; f < 4; ++f)
#pragma unroll
                        for (int i = 0; i < 4; ++i) { const int s = k0 + 16 * f + 4 * g + i; const bool valid = s < tq; const float z = zt[f][i];
                            const float sp = fmaxf(z, 0.f) + __builtin_amdgcn_logf(1.0f + __builtin_amdgcn_exp2f(-fabsf(z)));
                            const float l = valid ? -sp : 0.f; lf[f][i] = l; lz[f][i] = valid ? (l + z) : -INFINITY; tot += l; }
                } else {
#pragma unroll
                    for (int f = 0; f < 4; ++f)
#pragma unroll
                        for (int i = 0; i < 4; ++i) { const float z = zt[f][i];
                            const float l = -(fmaxf(z, 0.f) + __builtin_amdgcn_logf(1.0f + __builtin_amdgcn_exp2f(-fabsf(z)))); lf[f][i] = l; lz[f][i] = l + z; tot += l; }
                }
                tot += __shfl_xor(tot, 16); tot += __shfl_xor(tot, 32);
                bf16x8 lh[2];
#pragma unroll
                for (int fp = 0; fp < 2; ++fp) { u32x4 wh;
#pragma unroll
                    for (int q = 0; q < 2; ++q) { const int f = 2 * fp + q; wh[2 * q] = cvt_pk_bf16(lf[f][0], lf[f][1]); wh[2 * q + 1] = cvt_pk_bf16(lf[f][2], lf[f][3]); }
                    lh[fp] = __builtin_bit_cast(bf16x8, wh); }
                f32x4 sf[4];
                { f32x4 z4 = {0.f, 0.f, 0.f, 0.f};
                  sf[0] = __builtin_amdgcn_mfma_f32_16x16x32_bf16(tri[0], lh[0], z4, 0, 0, 0); sf[0] = __builtin_amdgcn_mfma_f32_16x16x32_bf16(tri[2], lh[1], sf[0], 0, 0, 0);
                  sf[1] = __builtin_amdgcn_mfma_f32_16x16x32_bf16(tri[1], lh[0], z4, 0, 0, 0); sf[1] = __builtin_amdgcn_mfma_f32_16x16x32_bf16(tri[3], lh[1], sf[1], 0, 0, 0);
                  sf[2] = __builtin_amdgcn_mfma_f32_16x16x32_bf16(tri[4], lh[1], z4, 0, 0, 0);
                  sf[3] = __builtin_amdgcn_mfma_f32_16x16x32_bf16(tri[5], lh[1], z4, 0, 0, 0); }
                bf16x8 pb[2];
#pragma unroll
                for (int fp = 0; fp < 2; ++fp) { u32x4 w;
#pragma unroll
                    for (int q = 0; q < 2; ++q) { const int f = 2 * fp + q; float p[4];
#pragma unroll
                        for (int i = 0; i < 4; ++i) p[i] = __builtin_amdgcn_exp2f(lz[f][i] + sf[f][i] + carry);
                        w[2 * q] = cvt_pk_bf16(p[0], p[1]); w[2 * q + 1] = cvt_pk_bf16(p[2], p[3]); }
                    pb[fp] = __builtin_bit_cast(bf16x8, w); }
                carry += tot;
#pragma unroll
                for (int fd = 0; fd < 8; ++fd)
#pragma unroll
                    for (int fp = 0; fp < 2; ++fp) { const LAS unsigned char* vp = VT + (16 * fd + c) * 144 + (32 * fp + 4 * g) * 2;
                        const u32x2 v0 = *(const LAS u32x2*)vp, v1 = *(const LAS u32x2*)(vp + 32);
                        u32x4 vw; vw.x = v0.x; vw.y = v0.y; vw.z = v1.x; vw.w = v1.y;
                        oacc[fd] = __builtin_amdgcn_mfma_f32_16x16x32_bf16(__builtin_bit_cast(bf16x8, vw), pb[fp], oacc[fd], 0, 0, 0); }
                wdone = (__ballot(carry >= -152.0f) == 0ull) ? 1 : 0;
            }
        }
        if (MODE == 0) { unsigned char* orow = (unsigned char*)ATT + (size_t)(b * SEQ + tq) * 1024 + h * 128 + 4 * g;
#pragma unroll
          for (int fd = 0; fd < 8; ++fd) *(unsigned*)(orow + 16 * fd) = pack4_fp8(oacc[fd][0], oacc[fd][1], oacc[fd][2], oacc[fd][3], F8_SA); }
    }
    __syncthreads();
}

__device__ __forceinline__ void ssm_lambda(const Args& a, int g, int st, float& lbr, float& lbi, float& qr, float& qi) {
    const float lr = a.in[I_LRE][g * 64 + st], li = a.in[I_LIM][g * 64 + st], dt = __expf(a.in[I_LDT][g]);
    const float mag = __expf(lr * dt);
    float rev = li * dt * 0.15915494309189535f; rev -= rintf(rev);
    lbr = mag * __builtin_amdgcn_cosf(rev); lbi = mag * __builtin_amdgcn_sinf(rev);
    const float nr = lbr - 1.0f, ni = lbi, den = 1.0f / (lr * lr + li * li);
    qr = (nr * lr + ni * li) * den; qi = (ni * lr - nr * li) * den;
}
template <bool WITH_Y>
__device__ __forceinline__ void ph_ssm_mfma(const Args& a, LAS unsigned char* lds, const bf16_t* UB, f32x2* E, bf16_t* YA, int G) {
    const int tid = opaque_tid(), lane = tid & 63, wave = __builtin_amdgcn_readfirstlane(tid >> 6), c = lane & 15, gl = lane >> 4;
    LAS f32x2* sl = (LAS f32x2*)(lds + wave * 8192);
    LAS f32x4* tab = (LAS f32x4*)(lds + 65536 + wave * 1024);
    LAS u32x4* cml = (LAS u32x4*)(lds + 73728 + wave * 5120) + lane;
    for (int item = blockIdx.x; item < 128; item += G) {
        const int b = item >> 6, cb = (item >> 3) & 7, g = (item & 7) * 8 + wave, c0 = cb * 16;
        float mur, mui;
        { float lbr, lbi, qr, qi; ssm_lambda(a, g, lane, lbr, lbi, qr, qi); tab[lane] = (f32x4){lbr, lbi, qr, qi}; mur = lbr; mui = lbi; }
        LDS_WAIT();
        bf16x8 bm[8];
        const float* brb = a.in[I_BRE] + (g * 64 + (c >> 1)) * 16 + 8 * (gl & 1); const float* bib = a.in[I_BIM] + (g * 64 + (c >> 1)) * 16 + 8 * (gl & 1);
        const LAS f32x4* tabb = tab + (c >> 1);
#pragma unroll
        for (int f = 0; f < 8; ++f) { const f32x4 tv = tabb[8 * f]; const float qr = tv[2], qi = tv[3];
            const float* br = brb + 128 * f; const float* bim = bib + 128 * f;
            const f32x4 r0 = *(const f32x4*)br, r1 = *(const f32x4*)(br + 4), i0 = *(const f32x4*)bim, i1 = *(const f32x4*)(bim + 4);
            float v[8];
#pragma unroll
            for (int e = 0; e < 4; ++e) { const float vr0 = qr * r0[e] - qi * i0[e], vi0 = qr * i0[e] + qi * r0[e], vr1 = qr * r1[e] - qi * i1[e], vi1 = qr * i1[e] + qi * r1[e];
                v[e] = (c & 1) ? vi0 : vr0; v[4 + e] = (c & 1) ? vi1 : vr1; }
            if (gl >= 2) {
#pragma unroll
                for (int e = 0; e < 8; ++e) v[e] = 0.f; }
            u32x4 w; w.x = cvt_pk_bf16(v[0], v[1]); w.y = cvt_pk_bf16(v[2], v[3]); w.z = cvt_pk_bf16(v[4], v[5]); w.w = cvt_pk_bf16(v[6], v[7]);
            bm[f] = __builtin_bit_cast(bf16x8, w); }
        float lmr[16], lmi[16];
#pragma unroll
        for (int k = 0; k < 16; ++k) { const f32x4 tv = tab[2 * gl + 8 * (k >> 1) + (k & 1)]; lmr[k] = tv[0]; lmi[k] = tv[1]; }
        if (WITH_Y) {
            const float* crb = a.in[I_CRE] + (g * 16 + c) * 64 + 2 * gl; const float* cib = a.in[I_CIM] + (g * 16 + c) * 64 + 2 * gl;
#pragma unroll
            for (int kk = 0; kk < 4; ++kk) { float v[8];
#pragma unroll
                for (int jh = 0; jh < 2; ++jh) { const f32x2 r = *(const f32x2*)(crb + 8 * (2 * kk + jh)), m = *(const f32x2*)(cib + 8 * (2 * kk + jh));
                    v[4 * jh] = r.x; v[4 * jh + 1] = -m.x; v[4 * jh + 2] = r.y; v[4 * jh + 3] = -m.y; }
                u32x4 w; w.x = cvt_pk_bf16(v[0], v[1]); w.y = cvt_pk_bf16(v[2], v[3]); w.z = cvt_pk_bf16(v[4], v[5]); w.w = cvt_pk_bf16(v[6], v[7]);
                cml[64 * kk] = w; }
            { const float dv = a.in[I_SD][g * 16 + c]; float v[8];
#pragma unroll
              for (int jj = 0; jj < 8; ++jj) v[jj] = (gl < 2 && (8 * gl + jj) == c) ? dv : 0.f;
              u32x4 w; w.x = cvt_pk_bf16(v[0], v[1]); w.y = cvt_pk_bf16(v[2], v[3]); w.z = cvt_pk_bf16(v[4], v[5]); w.w = cvt_pk_bf16(v[6], v[7]);
              cml[256] = w; }
        }
        f32x4 s[8];
#pragma unroll
        for (int f = 0; f < 8; ++f) s[f] = (f32x4){0.f, 0.f, 0.f, 0.f};
        if (WITH_Y) {
            float pr = mur, pi = mui;
#pragma unroll
            for (int q = 0; q < 6; ++q) { const float nr = pr * pr - pi * pi, ni = 2.0f * pr * pi; pr = nr; pi = ni; }
            float sr = 0.f, si = 0.f;
            const f32x2* ep = E + (size_t)((b * 64 + g) * 128) * 64 + lane;
            f32x2 ev[8], en[8];
#pragma unroll
            for (int k = 0; k < 8; ++k) ev[k] = ep[(size_t)k * 64];
            for (int cc = 0; cc < c0 + 16; cc += 8) {
                if (cc + 8 < c0 + 16) {
#pragma unroll
                    for (int k = 0; k < 8; ++k) en[k] = ep[(size_t)(cc + 8 + k) * 64]; }
#pragma unroll
                for (int k = 0; k < 8; ++k) { if (cc >= c0) sl[(cc - c0 + k) * 64 + lane] = (f32x2){sr, si};
                    const float nr = pr * sr - pi * si + ev[k][0], ni = pr * si + pi * sr + ev[k][1]; sr = nr; si = ni; }
#pragma unroll
                for (int k = 0; k < 8; ++k) ev[k] = en[k];
            }
            LDS_WAIT();
#pragma unroll
            for (int f = 0; f < 8; ++f) s[f] = *(const LAS f32x4*)(sl + c * 64 + 8 * f + 2 * gl);
            LDS_WAIT();
        }
        const bf16_t* up = UB + ((size_t)(b * 64 + g) * 8192 + (size_t)(c0 + c) * 64) * 16 + 8 * (gl & 1);
        unsigned char* yp = (unsigned char*)YA + (size_t)(b * SEQ + (c0 + c) * 64) * 1024 + g * 16 + 4 * gl;
        u32x4 u0 = *(const u32x4*)(up), u1 = *(const u32x4*)(up + 16), u2 = *(const u32x4*)(up + 32), u3 = *(const u32x4*)(up + 48);
#pragma unroll 1
        for (int tau = 0; tau < 64; ++tau) {
            const u32x4 u4 = *(const u32x4*)(up + (size_t)(tau + 4) * 16);
            const bf16x8 uf = __builtin_bit_cast(bf16x8, u0);
#pragma unroll
            for (int f = 0; f < 8; ++f) { f32x4 ci;
                ci[0] = lmr[2 * f] * s[f][0] - lmi[2 * f] * s[f][1]; ci[1] = lmr[2 * f] * s[f][1] + lmi[2 * f] * s[f][0];
                ci[2] = lmr[2 * f + 1] * s[f][2] - lmi[2 * f + 1] * s[f][3]; ci[3] = lmr[2 * f + 1] * s[f][3] + lmi[2 * f + 1] * s[f][2];
                s[f] = __builtin_amdgcn_mfma_f32_16x16x32_bf16(bm[f], uf, ci, 0, 0, 0); }
            if (WITH_Y) {
                f32x4 y = __builtin_amdgcn_mfma_f32_16x16x32_bf16(__builtin_bit_cast(bf16x8, cml[256]), uf, (f32x4){0.f, 0.f, 0.f, 0.f}, 0, 0, 0);
#pragma unroll
                for (int kk = 0; kk < 4; ++kk) { u32x4 w; w.x = cvt_pk_bf16(s[2 * kk][0], s[2 * kk][1]); w.y = cvt_pk_bf16(s[2 * kk][2], s[2 * kk][3]);
                    w.z = cvt_pk_bf16(s[2 * kk + 1][0], s[2 * kk + 1][1]); w.w = cvt_pk_bf16(s[2 * kk + 1][2], s[2 * kk + 1][3]);
                    y = __builtin_amdgcn_mfma_f32_16x16x32_bf16(__builtin_bit_cast(bf16x8, cml[64 * kk]), __builtin_bit_cast(bf16x8, w), y, 0, 0, 0); }
                *(unsigned*)(yp + (size_t)tau * 1024) = pack4_fp8(gelu_tanh(y[0]), gelu_tanh(y[1]), gelu_tanh(y[2]), gelu_tanh(y[3]), F8_SA);
            }
            u0 = u1; u1 = u2; u2 = u3; u3 = u4;
        }
        if (!WITH_Y) { f32x2* eo = E + (size_t)((b * 64 + g) * 128 + c0 + c) * 64 + 2 * gl;
#pragma unroll
            for (int f = 0; f < 8; ++f) *(f32x4*)(eo + 8 * f) = s[f]; }
    }
}

typedef float f32x16 __attribute__((ext_vector_type(16)));
typedef float f32x32 __attribute__((ext_vector_type(32)));
typedef unsigned u32x6 __attribute__((ext_vector_type(6)));
constexpr float PEER_SU = 64.0f, PEER_SV = 1.4f;
constexpr size_t PEER_SHARD_BYTES = (size_t)16384 * 192;
__device__ __forceinline__ void ph_table_cvt(const float* __restrict__ U, const float* __restrict__ V, unsigned char* UT, unsigned char* VT, int gw, int ngw, int lane) {
    for (int row = gw; row < 2 * 16384; row += ngw) {
        const bool sec = row >= 16384; const int r = sec ? row - 16384 : row; const float sc = sec ? PEER_SV : PEER_SU;
        const float* src = (sec ? V : U) + (size_t)r * 2048 + 32 * lane;
        unsigned char* dst = (sec ? VT : UT) + (size_t)(lane >> 3) * PEER_SHARD_BYTES + (size_t)r * 192;
        f32x16 a, b;
#pragma unroll
        for (int q = 0; q < 4; ++q) { const f32x4 v0 = *(const f32x4*)(src + 4 * q), v1 = *(const f32x4*)(src + 16 + 4 * q);
#pragma unroll
            for (int e = 0; e < 4; ++e) { a[4 * q + e] = v0[e] * sc; b[4 * q + e] = v1[e] * sc; } }
        const u32x6 p = __builtin_amdgcn_cvt_scalef32_2xpk16_fp6_f32(a, b, 1.0f);
        *(u32x4*)(dst + 16 * (lane & 7)) = (u32x4){p[0], p[1], p[2], p[3]};
        *(u32x2*)(dst + 128 + 8 * (lane & 7)) = (u32x2){p[4], p[5]};
    }
}

__device__ __forceinline__ void ph_peer_topk(LAS unsigned char* lds, const float* SC, int* idxG, float* gateG, int G) {
    const int tid = opaque_tid(), lane = tid & 63, wave = __builtin_amdgcn_readfirstlane(tid >> 6);
    LAS float* scr = (LAS float*)(lds + wave * 8448);
    for (int it = blockIdx.x; it < 512; it += G) {
        const int tokw = it * 32 + wave * 4;
        float tk[16];
#pragma unroll
        for (int i = 0; i < 16; ++i) tk[i] = -INFINITY;
        for (int q = 0; q < 4; ++q) {
#pragma unroll
            for (int j = 0; j < 8; ++j) { const int prob = (lane >> 3) + 8 * j, seg = lane & 7;
                const f32x4 v = *(const f32x4*)(SC + (size_t)(tokw + (prob >> 4)) * 2048 + (prob & 15) * 128 + 32 * q + 4 * seg);
                LAS float* d = scr + prob * 33 + 4 * seg; d[0] = v[0]; d[1] = v[1]; d[2] = v[2]; d[3] = v[3]; }
            LDS_WAIT();
#pragma unroll 4
            for (int vi = 0; vi < 32; ++vi) {
                float x = __uint_as_float((__float_as_uint(scr[lane * 33 + vi]) & ~127u) | (unsigned)(127 - (32 * q + vi)));
#pragma unroll
                for (int i = 0; i < 16; ++i) { const float hi = fmaxf(tk[i], x); x = fminf(tk[i], x); tk[i] = hi; }
            }
            LDS_WAIT();
        }
        float t2[16];
#pragma unroll
        for (int i = 0; i < 16; ++i) t2[i] = __shfl_xor(tk[i], 1);
        float bv[16];
#pragma unroll
        for (int i = 0; i < 16; ++i) bv[i] = -INFINITY;
#pragma unroll
        for (int aa = 0; aa < 16; ++aa)
#pragma unroll
            for (int bb = 0; bb < 16 / (aa + 1); ++bb) {
                const float sum = __uint_as_float(__float_as_uint(tk[aa]) & ~127u) + __uint_as_float(__float_as_uint(t2[bb]) & ~127u);
                float x = __uint_as_float((__float_as_uint(sum) & ~255u) | (unsigned)(255 - (16 * aa + bb)));
#pragma unroll
                for (int i = 0; i < 16; ++i) { const float hi = fmaxf(bv[i], x); x = fminf(bv[i], x); bv[i] = hi; }
            }
        unsigned p1[4], p2[4];
#pragma unroll
        for (int j = 0; j < 4; ++j) { p1[j] = 0u; p2[j] = 0u;
#pragma unroll
            for (int e = 0; e < 4; ++e) { p1[j] |= (127u - (__float_as_uint(tk[4 * j + e]) & 127u)) << (8 * e); p2[j] |= (127u - (__float_as_uint(t2[4 * j + e]) & 127u)) << (8 * e); } }
        { float e[16], sum = 0.f; unsigned ex[16];
          const float top = __uint_as_float(__float_as_uint(bv[0]) & ~255u);
#pragma unroll
          for (int i = 0; i < 16; ++i) { const unsigned bits = __float_as_uint(bv[i]); const unsigned flat = 255u - (bits & 255u), aa = flat >> 4, bb = flat & 15u;
              const unsigned w1 = (aa >> 2) == 0u ? p1[0] : (aa >> 2) == 1u ? p1[1] : (aa >> 2) == 2u ? p1[2] : p1[3];
              const unsigned w2 = (bb >> 2) == 0u ? p2[0] : (bb >> 2) == 1u ? p2[1] : (bb >> 2) == 2u ? p2[2] : p2[3];
              ex[i] = (((w1 >> (8u * (aa & 3u))) & 127u) << 7) | ((w2 >> (8u * (bb & 3u))) & 127u);
              e[i] = __expf(__uint_as_float(bits & ~255u) - top); sum += e[i]; }
          const float inv = 1.0f / sum;
          if ((lane & 1) == 0) { const int tl = lane >> 4, head = (lane & 15) >> 1; const size_t o = (size_t)(tokw + tl) * 128 + 64 * (head >> 2);
#pragma unroll
              for (int i = 0; i < 16; ++i) { const int p = 8 * (i & 7) + ((2 * head + (i >> 3)) & 7); idxG[o + p] = (int)ex[i]; gateG[o + p] = e[i] * inv; } } }
    }
}

#define PEER_ROWS(b4_, b2_, i8_) do { _Pragma("unroll") for (int gq = 0; gq < 8; ++gq) { const unsigned ro = (unsigned)(i8_)[gq] * 192u; \
        b4_[gq] = *(const u32x4*)(tab + (ro + 16u * (unsigned)c)); b2_[gq] = *(const u32x2*)(tab + (ro + 128u + 8u * (unsigned)c)); } } while (0)
#define PEER_LD8(dst_, p_) do { const u32x4 _a = *(const u32x4*)(p_), _b = *(const u32x4*)((p_) + 4); dst_[0] = (int)_a.x; dst_[1] = (int)_a.y; dst_[2] = (int)_a.z; dst_[3] = (int)_a.w; \
        dst_[4] = (int)_b.x; dst_[5] = (int)_b.y; dst_[6] = (int)_b.z; dst_[7] = (int)_b.w; } while (0)
__device__ __forceinline__ void ph_peer_u(const unsigned char* UT, const bf16_t* H2, const int* idxG, float* pdot, int G) {
    const int tid = opaque_tid(), lane = tid & 63, wave = __builtin_amdgcn_readfirstlane(tid >> 6), r = lane >> 3, c = lane & 7;
    const int shard = blockIdx.x & 7, ws = (blockIdx.x >> 3) * 8 + wave, nws = (G >> 3) * 8;
    const unsigned char* tab = UT + (size_t)shard * PEER_SHARD_BYTES;
    const bf16_t* hbase = H2 + 256 * shard + 32 * c;
    const int* ibase = idxG + 8 * r;
#define PEER_TOK(t_) (((t_) < T_TOK) ? (t_) : (T_TOK - 1))
    int ci[2][8], ni[2][8]; u32x4 cw[4], nw[4];
    { const int t0 = PEER_TOK(ws), t1 = PEER_TOK(ws + nws);
      PEER_LD8(ci[0], ibase + (size_t)t0 * 128); PEER_LD8(ci[1], ibase + (size_t)t0 * 128 + 64); PEER_LD8(ni[0], ibase + (size_t)t1 * 128); PEER_LD8(ni[1], ibase + (size_t)t1 * 128 + 64);
#pragma unroll
      for (int q = 0; q < 4; ++q) cw[q] = *(const u32x4*)(hbase + (size_t)t0 * 2048 + 8 * q); }
    u32x4 a4[8], b4[8]; u32x2 a2[8], b2[8];
    PEER_ROWS(a4, a2, ci[0]);
    for (int t = ws; t < T_TOK; t += nws) {
        PEER_ROWS(b4, b2, ci[1]);
        { const int t1 = PEER_TOK(t + nws);
#pragma unroll
          for (int q = 0; q < 4; ++q) nw[q] = *(const u32x4*)(hbase + (size_t)t1 * 2048 + 8 * q); }
        f32x2 ha[16];
        { const u32x4 w0 = cw[0], w1 = cw[1], w2 = cw[2], w3 = cw[3];
          ha[0] = (f32x2){bf_lo(w0.x), bf_lo(w2.x)}; ha[1] = (f32x2){bf_hi(w0.x), bf_hi(w2.x)}; ha[2] = (f32x2){bf_lo(w0.y), bf_lo(w2.y)}; ha[3] = (f32x2){bf_hi(w0.y), bf_hi(w2.y)};
          ha[4] = (f32x2){bf_lo(w0.z), bf_lo(w2.z)}; ha[5] = (f32x2){bf_hi(w0.z), bf_hi(w2.z)}; ha[6] = (f32x2){bf_lo(w0.w), bf_lo(w2.w)}; ha[7] = (f32x2){bf_hi(w0.w), bf_hi(w2.w)};
          ha[8] = (f32x2){bf_lo(w1.x), bf_lo(w3.x)}; ha[9] = (f32x2){bf_hi(w1.x), bf_hi(w3.x)}; ha[10] = (f32x2){bf_lo(w1.y), bf_lo(w3.y)}; ha[11] = (f32x2){bf_hi(w1.y), bf_hi(w3.y)};
          ha[12] = (f32x2){bf_lo(w1.z), bf_lo(w3.z)}; ha[13] = (f32x2){bf_hi(w1.z), bf_hi(w3.z)}; ha[14] = (f32x2){bf_lo(w1.w), bf_lo(w3.w)}; ha[15] = (f32x2){bf_hi(w1.w), bf_hi(w3.w)}; }
        float* po = pdot + ((size_t)shard * T_TOK + t) * 128 + lane;
#define PEER_UDOT(b4_, b2_, half_) do { float mine = 0.f; \
            _Pragma("unroll") for (int gq = 0; gq < 8; ++gq) { const u32x6 p6 = {b4_[gq].x, b4_[gq].y, b4_[gq].z, b4_[gq].w, b2_[gq].x, b2_[gq].y}; \
                const f32x32 uv = __builtin_amdgcn_cvt_scalef32_pk32_f32_fp6(p6, 1.0f); f32x2 s = {0.f, 0.f}; \
                _Pragma("unroll") for (int k = 0; k < 16; ++k) s = (f32x2){uv[2 * k], uv[2 * k + 1]} * ha[k] + s; \
                const float d = sum8_dpp(s.x + s.y); \
                mine = (gq == c) ? d : mine; __builtin_amdgcn_sched_barrier(0); } \
            po[64 * (half_)] = mine; } while (0)
        PEER_UDOT(a4, a2, 0);
        PEER_ROWS(a4, a2, ni[0]);
#pragma unroll
        for (int q = 0; q < 8; ++q) { ci[0][q] = ni[0][q]; ci[1][q] = ni[1][q]; }
        { const int t2 = PEER_TOK(t + 2 * nws); PEER_LD8(ni[0], ibase + (size_t)t2 * 128); PEER_LD8(ni[1], ibase + (size_t)t2 * 128 + 64); }
        PEER_UDOT(b4, b2, 1);
#pragma unroll
        for (int q = 0; q < 4; ++q) cw[q] = nw[q];
    }
#undef PEER_UDOT
}
__device__ __forceinline__ void ph_peer_act(const float* pdot, const float* gateG, float* actG, int G) {
    const size_t n = (size_t)T_TOK * 128, stride = (size_t)G * 512;
    for (size_t i = (size_t)blockIdx.x * 512 + threadIdx.x; i < n; i += stride) {
        float d = 0.f;
#pragma unroll
        for (int x = 0; x < 8; ++x) d += pdot[(size_t)x * n + i];
        actG[i] = gateG[i] * gelu_tanh(d * (1.0f / PEER_SU)) * (1.0f / PEER_SV);
    }
}
template <bool DRY>
__device__ __forceinline__ void ph_peer_v(LAS unsigned char* lds, const unsigned char* VT, const int* idxG, const float* actG, const float* mod, float* OUT, int G) {
    const int tid = opaque_tid(), lane = tid & 63, wave = __builtin_amdgcn_readfirstlane(tid >> 6), r = lane >> 3, c = lane & 7;
    const int shard = blockIdx.x & 7, ws = (blockIdx.x >> 3) * 8 + wave, nws = (G >> 3) * 8;
    const unsigned char* tab = VT + (size_t)shard * PEER_SHARD_BYTES;
    LAS float* red = (LAS float*)(lds + wave * 9216);
    const int* ibase = idxG + 8 * r; const int* abase = (const int*)actG + 8 * r;
    int ci[2][8], ni[2][8], ca[2][8], na[2][8]; f32x4 cx, nx;
    { const int t0 = PEER_TOK(ws), t1 = PEER_TOK(ws + nws);
      PEER_LD8(ci[0], ibase + (size_t)t0 * 128); PEER_LD8(ci[1], ibase + (size_t)t0 * 128 + 64); PEER_LD8(ni[0], ibase + (size_t)t1 * 128); PEER_LD8(ni[1], ibase + (size_t)t1 * 128 + 64);
      PEER_LD8(ca[0], abase + (size_t)t0 * 128); PEER_LD8(ca[1], abase + (size_t)t0 * 128 + 64);
      cx = *(const f32x4*)(OUT + (size_t)t0 * 2048 + 256 * shard + 4 * lane); }
    u32x4 a4[8], b4[8]; u32x2 a2[8], b2[8];
    PEER_ROWS(a4, a2, ci[0]);
    for (int t = ws; t < T_TOK; t += nws) {
        PEER_ROWS(b4, b2, ci[1]);
        { const int t1 = PEER_TOK(t + nws);
          PEER_LD8(na[0], abase + (size_t)t1 * 128); PEER_LD8(na[1], abase + (size_t)t1 * 128 + 64); nx = *(const f32x4*)(OUT + (size_t)t1 * 2048 + 256 * shard + 4 * lane); }
        f32x2 acc[16];
#pragma unroll
        for (int k = 0; k < 16; ++k) acc[k] = (f32x2){0.f, 0.f};
#define PEER_VACC(b4_, b2_, a8_) do { _Pragma("unroll") for (int gq = 0; gq < 8; ++gq) { const float ar = __int_as_float((a8_)[gq]); const f32x2 av2 = {ar, ar}; \
            const u32x6 p6 = {b4_[gq].x, b4_[gq].y, b4_[gq].z, b4_[gq].w, b2_[gq].x, b2_[gq].y}; const f32x32 vv = __builtin_amdgcn_cvt_scalef32_pk32_f32_fp6(p6, 1.0f); \
            _Pragma("unroll") for (int k = 0; k < 16; ++k) acc[k] = (f32x2){vv[2 * k], vv[2 * k + 1]} * av2 + acc[k]; __builtin_amdgcn_sched_barrier(0); } } while (0)
        PEER_VACC(a4, a2, ca[0]);
        PEER_ROWS(a4, a2, ni[0]);
#pragma unroll
        for (int q = 0; q < 8; ++q) { ci[0][q] = ni[0][q]; ci[1][q] = ni[1][q]; }
        { const int t2 = PEER_TOK(t + 2 * nws); PEER_LD8(ni[0], ibase + (size_t)t2 * 128); PEER_LD8(ni[1], ibase + (size_t)t2 * 128 + 64); }
        PEER_VACC(b4, b2, ca[1]);
        { LAS float* w = red + (r * 8 + c) * 36;
#pragma unroll
          for (int q = 0; q < 4; ++q) { *(LAS f32x4*)(w + 4 * q) = (f32x4){acc[4 * q].x, acc[4 * q + 1].x, acc[4 * q + 2].x, acc[4 * q + 3].x};
              *(LAS f32x4*)(w + 16 + 4 * q) = (f32x4){acc[4 * q].y, acc[4 * q + 1].y, acc[4 * q + 2].y, acc[4 * q + 3].y}; } }
        LDS_WAIT();
        { f32x4 s = {0.f, 0.f, 0.f, 0.f}; const LAS float* rd = red + (lane >> 3) * 36 + 4 * (lane & 7);
#pragma unroll
          for (int rr = 0; rr < 8; ++rr) s += *(const LAS f32x4*)(rd + rr * 288);
          const int b = t >> 13; const float* gt2 = mod + (size_t)b * 12288 + 10240 + 256 * shard + 4 * lane; float* op = OUT + (size_t)t * 2048 + 256 * shard + 4 * lane;
          const f32x4 g0 = *(const f32x4*)gt2;
          if (!DRY) *(f32x4*)op = cx + g0 * s; else asm volatile("" :: "v"(s), "v"(g0)); }
        LDS_WAIT();
#pragma unroll
        for (int q = 0; q < 8; ++q) { ca[0][q] = na[0][q]; ca[1][q] = na[1][q]; }
        cx = nx;
    }
#undef PEER_VACC
}
#undef PEER_ROWS
#undef PEER_LD8
#undef PEER_TOK

__global__ void __launch_bounds__(512, 2) mk_fwd(Args args) {
    extern __shared__ __attribute__((aligned(16))) unsigned char lds_raw[];
    LAS unsigned char* lds = (LAS unsigned char*)lds_raw;
    const int tid = threadIdx.x, lane = tid & 63, wave = __builtin_amdgcn_readfirstlane(tid >> 6);
    const int G = gridDim.x, gw = blockIdx.x * 8 + wave, ngw = G * 8;
    unsigned char* ws = args.ws;
    volatile LAS unsigned* misc = (volatile LAS unsigned*)(lds + LDS_MAIN);
    if (tid < 4) misc[tid] = 0u;
    __syncthreads();
    const int lo = args.ph_lo, hi = args.ph_hi;
    XcdBarrier bar; bar.bar = (unsigned*)(ws + WS_CTL); bar.x = 0; bar.st = misc;
    if (hi - lo > 1) bar = xcd_barrier_post((unsigned*)(ws + WS_CTL), misc);
#ifndef PHMASK
#define PHMASK 0x3fff
#endif
#define IN(k) (((PHMASK >> (k)) & 1) && lo <= (k) && (k) < hi)
#define SEAM(k) do { if (IN(k) && IN((k) + 1)) xcd_barrier(bar); } while (0)
    float* mod = (float*)(ws + WS_MOD);
    bf16_t* HB = (bf16_t*)(ws + WS_H); bf16_t* PA = (bf16_t*)(ws + WS_PA); bf16_t* PG = (bf16_t*)(ws + WS_PG);
    bf16_t* YA = (bf16_t*)(ws + WS_YA); bf16_t* ATT = (bf16_t*)(ws + WS_ATT); f32x2* EB = (f32x2*)(ws + WS_E); bf16_t* UBp = (bf16_t*)(ws + WS_UB);

#define PHS(code, ...) do { __VA_ARGS__ if (DUP == (code)) { xcd_barrier(bar); __VA_ARGS__ } } while (0)
#define PH(k, ...) do { if (IN(k)) { __VA_ARGS__ if (DUP == (k)) { xcd_barrier(bar); __VA_ARGS__ } } } while (0)
    PH(0, { ph_mod_partial(args.in[I_C], args.in[I_WADA], (float*)(ws + WS_MODP), gw, ngw, lane); ph_colmax_partial(args.in[I_WIN], (float*)(ws + WS_CMAXP), gw, ngw, lane); });
    SEAM(0);
    PH(1, { ph_prologue(args, lds, gw, ngw, lane, wave); });
    SEAM(1);
    PH(2, { ph_norm<true>(args.in[I_X], HB, (float*)(ws + WS_SA), args.in[I_N1G], mod, 0, 2048, gw, ngw, lane); });
    SEAM(2);
    PH(3, { pg8::Gemm g{HB, (const bf16_t*)(ws + WS_WIN), T_TOK, 8192, 1024}; pg8::StaticOrder S; S.init(T_TOK, 8192, G, (int)blockIdx.x);
        pg8::EpiProj E{PA, PG, UBp, (const float*)(ws + WS_SA), (const float*)(ws + WS_SB)}; pg8::gemm_phase<pg8::EpiProj, pg8::StaticOrder, true, true, 1>(lds, g, S, E); });
    SEAM(3);
    PH(4, { PHS(41, { ph_attn<0>(lds, PA, ATT, args.in[I_QNG], args.in[I_KNG], G); __syncthreads(); });
        if (DUP == 411) { xcd_barrier(bar); ph_attn<1>(lds, PA, ATT, args.in[I_QNG], args.in[I_KNG], G); __syncthreads(); } PHS(42, { ph_ssm_mfma<false>(args, lds, UBp, EB, YA, G); }); });
    SEAM(4);
    PH(5, { PHS(51, { ph_ssm_mfma<true>(args, lds, UBp, EB, YA, G); __syncthreads(); });
        PHS(52, { pg8::Gemm g{ATT, (const bf16_t*)(ws + WS_WATT), T_TOK, 2048, 512}; pg8::SplitOrder S; S.init(T_TOK, 2048, G, (int)blockIdx.x);
        pg8::EpiAttUp E{PG, HB}; pg8::gemm_phase<pg8::EpiAttUp, pg8::SplitOrder, true, true, 2>(lds, g, S, E); }); });
    SEAM(5);
    PH(6, { pg8::Gemm g{YA, (const bf16_t*)(ws + WS_WGLU), T_TOK, 4096, 512}; pg8::StaticOrder S; S.init(T_TOK, 4096, G, (int)blockIdx.x);
        pg8::EpiGlu E{PG, HB, (unsigned char*)ATT}; pg8::gemm_phase<pg8::EpiGlu, pg8::StaticOrder, true, true, 2>(lds, g, S, E); });
    SEAM(6);
    PH(7, { pg8::Gemm g{ATT, (const bf16_t*)(ws + WS_WOUT), T_TOK, 2048, 1024}; pg8::StaticOrder S; S.init(T_TOK, 2048, G, (int)blockIdx.x);
        pg8::EpiOut E{args.in[I_X], args.out, mod}; pg8::gemm_phase<pg8::EpiOut, pg8::StaticOrder, true, true, 2>(lds, g, S, E);
        ph_table_cvt(args.in[I_PU], args.in[I_PV], ws + WS_UT, ws + WS_VT, gw, ngw, lane); });
    SEAM(7);
    PH(8, { ph_norm<false>(args.out, HB, nullptr, args.in[I_N2G], mod, 6144, 8192, gw, ngw, lane); });
    SEAM(8);
    PH(9, { pg8::Gemm g{HB, (const bf16_t*)(ws + WS_WSC), T_TOK, 2048, 2048}; pg8::StaticOrder S; S.init(T_TOK, 2048, G, (int)blockIdx.x);
        pg8::EpiF32 E{(float*)(ws + WS_SC)}; pg8::gemm_phase<pg8::EpiF32, pg8::StaticOrder, true, true>(lds, g, S, E); });
    SEAM(9);
    PH(10, { ph_peer_topk(lds, (const float*)(ws + WS_SC), (int*)(ws + WS_IDX), (float*)(ws + WS_GATE), G); });
    SEAM(10);
    PH(11, { ph_peer_u(ws + WS_UT, HB, (const int*)(ws + WS_IDX), (float*)(ws + WS_PDOT), G); });
    SEAM(11);
    PH(12, { ph_peer_act((const float*)(ws + WS_PDOT), (const float*)(ws + WS_GATE), (float*)(ws + WS_ACT), G); });
    SEAM(12);
    if (IN(13)) { if (DUP == 13) { ph_peer_v<true>(lds, ws + WS_VT, (const int*)(ws + WS_IDX), (const float*)(ws + WS_ACT), mod, args.out, G); xcd_barrier(bar); }
        ph_peer_v<false>(lds, ws + WS_VT, (const int*)(ws + WS_IDX), (const float*)(ws + WS_ACT), mod, args.out, G); }
#undef IN
#undef SEAM
}

extern "C" void kernel_launch(void* const* d_in, const int* in_sizes, int n_in, void* d_out, int out_size, void* d_ws, size_t ws_size, hipStream_t stream) {
    static int grid = 0;
    if (grid == 0) {
        if (n_in != 25 || out_size != T_TOK * DM || ws_size < WS_END) { fprintf(stderr, "kernel_launch: unexpected shapes (n_in %d out %d ws %zu need %zu)\n", n_in, out_size, ws_size, (size_t)WS_END); grid = -1; return; }
        int dev = 0, cus = 0, per_cu = 0;
        if (hipGetDevice(&dev) != hipSuccess || hipDeviceGetAttribute(&cus, hipDeviceAttributeMultiprocessorCount, dev) != hipSuccess) { grid = -1; return; }
        if (hipFuncSetAttribute((const void*)mk_fwd, hipFuncAttributeMaxDynamicSharedMemorySize, LDS_BYTES) != hipSuccess) { fprintf(stderr, "kernel_launch: hipFuncSetAttribute failed\n"); grid = -1; return; }
        if (hipOccupancyMaxActiveBlocksPerMultiprocessor(&per_cu, (const void*)mk_fwd, 512, LDS_BYTES) != hipSuccess || per_cu < 1) { fprintf(stderr, "kernel_launch: occupancy query says %d blocks/CU\n", per_cu); (void)hipGetLastError(); grid = -1; return; }
        grid = cus;
    }
    if (grid < 0) return;
    (void)hipMemsetAsync((char*)d_ws + WS_CTL, 0, 16384, stream);
    Args a{};
    for (int i = 0; i < 25; ++i) a.in[i] = (const float*)d_in[i];
    a.out = (float*)d_out; a.ws = (unsigned char*)d_ws;
#if MK_PER_PHASE
    for (int ph = 0; ph < NPHASE; ++ph) { a.ph_lo = ph; a.ph_hi = ph + 1; hipLaunchKernelGGL(mk_fwd, dim3(grid), dim3(512), LDS_BYTES, stream, a); }
#else
    a.ph_lo = 0; a.ph_hi = NPHASE;
    hipLaunchKernelGGL(mk_fwd, dim3(grid), dim3(512), LDS_BYTES, stream, a);
#endif
}
```

```cpp
#include <hip/hip_runtime.h>
#include <cstdio>
#include <cstdint>

#ifndef MK_PER_PHASE
#define MK_PER_PHASE 0
#endif

#ifndef DUP
#define DUP -1
#endif
#define LAS __attribute__((address_space(3)))
typedef unsigned short bf16_t;
typedef short bf16x8 __attribute__((ext_vector_type(8)));
typedef float f32x4 __attribute__((ext_vector_type(4)));
typedef float f32x2 __attribute__((ext_vector_type(2)));
typedef unsigned u32x4 __attribute__((ext_vector_type(4)));
typedef unsigned u32x2 __attribute__((ext_vector_type(2)));
typedef int i32x4 __attribute__((ext_vector_type(4)));

constexpr int T_TOK = 16384, DM = 2048, SEQ = 8192;
constexpr int NPHASE = 14;
constexpr float EPS = 1e-6f;

constexpr size_t WS_CTL   = 0;
constexpr size_t WS_MODP  = 65536;
constexpr size_t WS_MOD   = WS_MODP + (size_t)32 * 2 * 12288 * 4;
constexpr size_t WS_WIN   = WS_MOD + (size_t)2 * 12288 * 4;
constexpr size_t WS_WGLU  = WS_WIN + (size_t)8192 * 2048 * 2;
constexpr size_t WS_WATT  = WS_WGLU + (size_t)4096 * 1024 * 2;
constexpr size_t WS_WOUT  = WS_WATT + (size_t)2048 * 1024 * 2;
constexpr size_t WS_WSC   = WS_WOUT + (size_t)2048 * 2048 * 2;
constexpr size_t WS_H     = WS_WSC + (size_t)2048 * 2048 * 2;
constexpr size_t WS_PA    = WS_H + (size_t)T_TOK * 2048 * 2;
constexpr size_t WS_PG    = WS_PA + (size_t)T_TOK * 4096 * 2;
constexpr size_t WS_E     = WS_PG + (size_t)T_TOK * 4096 * 2;
constexpr size_t WS_YA    = WS_E + (size_t)2 * 64 * 128 * 64 * 8;
constexpr size_t WS_ATT   = WS_YA + (size_t)T_TOK * 1024 * 2;
constexpr size_t WS_UB    = WS_ATT + (size_t)T_TOK * 1024 * 2;
constexpr size_t WS_SA    = WS_UB + (size_t)T_TOK * 1024 * 2;
constexpr size_t WS_SB    = WS_SA + (size_t)T_TOK * 4;
constexpr size_t WS_CMAXP = WS_SB + (size_t)8192 * 4;
constexpr size_t WS_END   = WS_CMAXP + (size_t)32 * 8192 * 4;
constexpr size_t WS_SC    = WS_PA;
constexpr size_t WS_UT    = WS_PG;
constexpr size_t WS_VT    = WS_PG + (size_t)8 * 16384 * 192;
constexpr size_t WS_PDOT  = WS_VT + (size_t)8 * 16384 * 192;
constexpr size_t WS_IDX   = WS_YA;
constexpr size_t WS_GATE  = WS_YA + (size_t)T_TOK * 128 * 4;
constexpr size_t WS_ACT   = WS_GATE + (size_t)T_TOK * 128 * 4;
static_assert(WS_PDOT + (size_t)8 * T_TOK * 128 * 4 <= WS_PG + (size_t)T_TOK * 4096 * 2, "PEER buffers must fit the dead g_ssm|g_att region");
static_assert(WS_ACT + (size_t)T_TOK * 128 * 4 <= WS_YA + (size_t)T_TOK * 1024 * 2, "PEER index buffers must fit the dead YA region");
constexpr int LDS_MAIN = 131072, LDS_BYTES = LDS_MAIN + 256;

typedef __bf16 bf16x2_t __attribute__((ext_vector_type(2)));
__device__ __forceinline__ unsigned cvt_pk_bf16(float lo, float hi) { const f32x2 v = {lo, hi}; return __builtin_bit_cast(unsigned, __builtin_convertvector(v, bf16x2_t)); }
__device__ __forceinline__ float bf_lo(unsigned w) { return __uint_as_float(w << 16); }
__device__ __forceinline__ float bf_hi(unsigned w) { return __uint_as_float(w & 0xffff0000u); }
__device__ __forceinline__ float wave_sum(float v) {
#pragma unroll
    for (int o = 1; o < 64; o <<= 1) v += __shfl_xor(v, o);
    return v;
}
__device__ __forceinline__ float sigmoidf_(float x) { return 1.0f / (1.0f + __expf(-x)); }
__device__ __forceinline__ float gelu_tanh(float x) {
    const float a = 0.7978845608028654f * (x + 0.044715f * x * x * x);
    const float t = 1.0f - 2.0f / (__expf(2.0f * a) + 1.0f);
    return 0.5f * x * (1.0f + t);
}
constexpr float F8_SA = 8.0f, F8_SW = 64.0f, F8_INV = 1.0f / 512.0f;
__device__ __forceinline__ unsigned pack4_fp8(float a, float b, float c, float d, float sc) {
    a = fminf(fmaxf(a * sc, -448.f), 448.f); b = fminf(fmaxf(b * sc, -448.f), 448.f); c = fminf(fmaxf(c * sc, -448.f), 448.f); d = fminf(fmaxf(d * sc, -448.f), 448.f);
    int p = 0; p = __builtin_amdgcn_cvt_pk_fp8_f32(a, b, p, false); p = __builtin_amdgcn_cvt_pk_fp8_f32(c, d, p, true); return (unsigned)p; }
__device__ __forceinline__ float sum8_dpp(float v) {
    v += __builtin_bit_cast(float, __builtin_amdgcn_update_dpp(0, __builtin_bit_cast(int, v), 0xB1, 0xF, 0xF, true));
    v += __builtin_bit_cast(float, __builtin_amdgcn_update_dpp(0, __builtin_bit_cast(int, v), 0x4E, 0xF, 0xF, true));
    v += __builtin_bit_cast(float, __builtin_amdgcn_update_dpp(0, __builtin_bit_cast(int, v), 0x141, 0xF, 0xF, true));
    return v; }
#define LDS_WAIT() asm volatile("s_waitcnt lgkmcnt(0)" ::: "memory")
__device__ __forceinline__ int opaque_tid() { int t = threadIdx.x; asm volatile("" : "+v"(t)); return t; }

#define XB_TMO      128
#define XB_XCNT(j)  (256  + 64 * (j))
#define XB_XSUB(j)  (1280 + 64 * (j))
#define XB_XGEN(j)  (2304 + 64 * (j))
#define XB_TOP      3328
#define XB_TOPGEN   3392
#define XCD_BAR_WORDS 3456
#define XB_SPIN_CAP (1u << 22)
__device__ __forceinline__ unsigned xb_ld(unsigned* p)              { return __hip_atomic_load(p, __ATOMIC_RELAXED, __HIP_MEMORY_SCOPE_AGENT); }
__device__ __forceinline__ unsigned xb_add(unsigned* p, unsigned v) { return __hip_atomic_fetch_add(p, v, __ATOMIC_RELAXED, __HIP_MEMORY_SCOPE_AGENT); }
__device__ __forceinline__ unsigned xb_xcc_id() { return (unsigned)__builtin_amdgcn_s_getreg((3 << 11) | 20) & 0xFu; }
#define XB_SPIN(cond, bar) do { unsigned _sp = 0; while (cond) { __builtin_amdgcn_s_sleep(1); \
    if ((++_sp & 255u) == 0u) { if (xb_ld(&(bar)[XB_TMO])) break; if (_sp > XB_SPIN_CAP) { atomicAdd(&(bar)[XB_TMO], 1u); break; } } } } while (0)
struct XcdBarrier { unsigned* bar; unsigned x; volatile LAS unsigned* st; };
__device__ __forceinline__ XcdBarrier xcd_barrier_post(unsigned* bar, volatile LAS unsigned* st) {
    XcdBarrier b; b.bar = bar; b.x = xb_xcc_id(); b.st = st;
    if (threadIdx.x == 0) (void)xb_add(&bar[XB_XCNT(b.x)], 1u);
    return b;
}
__device__ __forceinline__ void xcd_barrier_complete(unsigned* bar, unsigned x, unsigned& nloc, unsigned& nx) {
    const unsigned G = gridDim.x * gridDim.y * gridDim.z;
    unsigned sum, cnt, mine, sp = 0u;
    for (;;) {
        sum = 0u; cnt = 0u; mine = 0u;
#pragma unroll
        for (unsigned j = 0; j < 16; ++j) { const unsigned c = xb_ld(&bar[XB_XCNT(j)]); sum += c; cnt += (c > 0u) ? 1u : 0u; mine = (j == x) ? c : mine; }
        if (sum == G) break;
        __builtin_amdgcn_s_sleep(1);
        if ((++sp & 255u) == 0u) { if (xb_ld(&bar[XB_TMO])) break; if (sp > XB_SPIN_CAP) { atomicAdd(&bar[XB_TMO], 1u); break; } }
    }
    nloc = mine > 0u ? mine : 1u; nx = cnt > 0u ? cnt : 1u;
}
__device__ __forceinline__ void xcd_barrier(const XcdBarrier& b) {
    asm volatile("s_waitcnt vmcnt(0)" ::: "memory");
    __syncthreads();
    if (threadIdx.x == 0) {
        unsigned* bar = b.bar;
        __builtin_amdgcn_s_waitcnt(0);
        unsigned nloc = b.st[0], nx = b.st[1];
        if (nloc == 0u) { xcd_barrier_complete(bar, b.x, nloc, nx); b.st[0] = nloc; b.st[1] = nx; }
        const unsigned old = xb_add(&bar[XB_XSUB(b.x)], 1u);
        const unsigned gen = old / nloc;
        if (old + 1u == (gen + 1u) * nloc) {
            __builtin_amdgcn_fence(__ATOMIC_RELEASE, "agent");
            asm volatile("s_waitcnt vmcnt(0)" ::: "memory");
            const unsigned og = xb_add(&bar[XB_TOP], 1u);
            const unsigned tg = og / nx;
            if (og + 1u == (tg + 1u) * nx) xb_add(&bar[XB_TOPGEN], 1u);
            else XB_SPIN(xb_ld(&bar[XB_TOPGEN]) == tg, bar);
            __builtin_amdgcn_fence(__ATOMIC_ACQUIRE, "agent");
            xb_add(&bar[XB_XGEN(b.x)], 1u);
            asm volatile("s_waitcnt vmcnt(0)" ::: "memory");
        } else {
            XB_SPIN(xb_ld(&bar[XB_XGEN(b.x)]) == gen, bar);
            __builtin_amdgcn_fence(__ATOMIC_ACQUIRE, "agent");
            asm volatile("s_waitcnt vmcnt(0)" ::: "memory");
        }
    }
    __syncthreads();
}

namespace pg8 {
constexpr int BM = 256, BK = 64, HALF = 128, HTB = HALF * BK * 2, STAGE_BYTES = 8 * HTB, NXCD = 8, WGM = 8;
__host__ __device__ __forceinline__ int lds_byte(int r, int c) { const int st = (r >> 4) * 2 + (c >> 5), rr = r & 15, cc = c & 31, ob = rr * 64 + cc * 2; return st * 1024 + (ob ^ (((ob >> 9) & 1) << 5)); }
__host__ __device__ __forceinline__ void stage_rc(int b, int& R, int& C) { const int st = b / 1024, sb = b % 1024, swz = sb ^ (((sb >> 9) & 1) << 5); R = (st >> 1) * 16 + swz / 64; C = (st & 1) * 32 + (swz % 64) / 2; }
__host__ __device__ __forceinline__ int perm32(int rho) { const int n = rho >> 4, i = rho & 15; return 8 * (i >> 2) + 4 * n + (i & 3); }
struct Unit { int pm, pn; };
struct Gemm { const bf16_t* A; const bf16_t* Bt; int M, N, K; };
struct StaticOrder {
    int nM, nN, nwg, G, c;
    __host__ __device__ void init(int M, int N, int G_, int c_) { nM = M / BM; nN = N / BM; nwg = nM * nN; G = G_; c = c_; }
    __host__ __device__ bool next(int i, Unit& u) const { return at((long)i * G + c, u); }
    __host__ __device__ bool at(long L, Unit& u) const {
        if (L >= nwg) return false;
        int wgid = (int)L; { const int q = nwg / NXCD, r = nwg % NXCD, xcd = wgid % NXCD, off = wgid / NXCD; wgid = (xcd < r ? xcd * (q + 1) : r * (q + 1) + (xcd - r) * q) + off; }
        const int nig = WGM * nN, gid = wgid / nig, fm = gid * WGM, gsz = (nM - fm) < WGM ? (nM - fm) : WGM;
        u.pm = fm + ((wgid % nig) % gsz); u.pn = (wgid % nig) / gsz; return true;
    }
    __device__ __forceinline__ void a_ready(const Unit&) const {}
    __device__ __forceinline__ void done(const Unit&) const {}
};
struct SplitOrder {
    StaticOrder b;
    __host__ __device__ void init(int M, int N, int G_, int c_) { b.init(M, N, G_, c_); }
    __host__ __device__ bool next(int i, Unit& u) const {
        if (b.G != 256 || b.nwg != 512) return b.next(i, u);
        if (b.c < 128) return false;
        return i < 4 ? b.at((b.c - 128) * 4 + i, u) : false;
    }
    __device__ __forceinline__ void a_ready(const Unit&) const {}
    __device__ __forceinline__ void done(const Unit&) const {}
};
typedef int i32x8 __attribute__((ext_vector_type(8)));
template <class Epi, class Sched, bool ALIGN_EPI = false, bool SP2 = false, int MODE = 0>
__device__ __forceinline__ void gemm_phase(LAS unsigned char* lds, const Gemm g, const Sched& S, const Epi& E) {
    const int tid = threadIdx.x, wid = __builtin_amdgcn_readfirstlane(tid >> 6), lane = tid & 63, wr = wid >> 2, wc = wid & 3, fr = lane & 15, fq = lane >> 4;
    const int K = g.K, nt = K / BK;
    unsigned voffA[2], voffB[2];
#pragma unroll
    for (int i = 0; i < 2; ++i) { int R, C; stage_rc(tid * 16 + i * 8192, R, C); const int Rb = Epi::PERM ? ((R & ~31) + perm32(R & 31)) : R;
        voffA[i] = (unsigned)(R * K + C) * 2u; voffB[i] = (unsigned)(Rb * K + C) * 2u; }
    const size_t kstep = (size_t)(BK * 2);
    const size_t hstep = (size_t)HALF * K * 2;
    const size_t tstep = 2 * hstep;
    const unsigned ldsw = (unsigned)wid * 1024u;
    const int aoff = lds_byte(wr * 64 + fr, fq * 8), boff = lds_byte(wc * 32 + fr, fq * 8);
#define PG8_SA(b, h) (((b) * 2 + (h)) * HTB)
#define PG8_SB(b, h) ((4 + (b) * 2 + (h)) * HTB)
#define PG8_STAGE(bufoff, gbase, voff) do { _Pragma("unroll") for (int _i = 0; _i < 2; ++_i) \
        __builtin_amdgcn_global_load_lds((const unsigned*)((const char*)(gbase) + (voff)[_i]), (LAS unsigned*)(lds + (bufoff) + ldsw + _i * 8192), 16, 0, 0); } while (0)
#define PG8_LD8(p_) ({ const i32x4 _lo = *(const LAS i32x4*)(p_), _hi = *(const LAS i32x4*)((p_) + 1024); (i32x8){_lo[0], _lo[1], _lo[2], _lo[3], _hi[0], _hi[1], _hi[2], _hi[3]}; })
#define PG8_LDA(dst, b, h) do { _Pragma("unroll") for (int m = 0; m < 4; ++m) dst[m] = PG8_LD8(lds + PG8_SA(b, h) + aoff + m * 2048); } while (0)
#define PG8_LDB(dst, b, h) do { _Pragma("unroll") for (int n = 0; n < 2; ++n) dst[n] = PG8_LD8(lds + PG8_SB(b, h) + boff + n * 2048); } while (0)
#define PG8_HALF(v, k) ((k) == 0 ? __builtin_shufflevector(v, v, 0, 1, 2, 3) : __builtin_shufflevector(v, v, 4, 5, 6, 7))
#define PG8_MMA(ai, bj, At, Bt) do { __builtin_amdgcn_s_setprio(1); _Pragma("unroll") for (int m = 0; m < 4; ++m) _Pragma("unroll") for (int n = 0; n < 2; ++n) { \
        if (MODE == 2) asm volatile("v_mfma_scale_f32_16x16x128_f8f6f4 %0, %1, %2, %0, %3, %3 op_sel_hi:[0,0,0]" : "+v"(acc[ai][bj][m][n]) : "v"(Bt[n]), "v"(At[m]), "v"(scl1)); \
        else { _Pragma("unroll") for (int k = 0; k < 2; ++k) \
            acc[ai][bj][m][n] = (MODE == 1) ? __builtin_bit_cast(f32x4, __builtin_amdgcn_mfma_i32_16x16x64_i8(PG8_HALF(Bt[n], k), PG8_HALF(At[m], k), __builtin_bit_cast(i32x4, acc[ai][bj][m][n]), 0, 0, 0)) \
                                            : __builtin_amdgcn_mfma_f32_16x16x32_bf16(__builtin_bit_cast(bf16x8, PG8_HALF(Bt[n], k)), __builtin_bit_cast(bf16x8, PG8_HALF(At[m], k)), acc[ai][bj][m][n], 0, 0, 0); } } __builtin_amdgcn_s_setprio(0); } while (0)
#define PG8_WAIT_V(n) asm volatile("s_waitcnt vmcnt(" #n ")" ::: "memory")
#define PG8_WAIT_L(n) asm volatile("s_waitcnt lgkmcnt(" #n ")" ::: "memory")
#define PG8_BAR __builtin_amdgcn_s_barrier()
#define PG8_SCHED __builtin_amdgcn_sched_barrier(0)
    const int scl1 = 0x7f7f7f7f;
    Unit cur, nxt; int ui = 0;
    if (!S.next(0, cur)) return;
    f32x4 acc[2][2][4][2];
#pragma unroll
    for (int a = 0; a < 2; ++a)
#pragma unroll
        for (int b = 0; b < 2; ++b)
#pragma unroll
            for (int m = 0; m < 4; ++m)
#pragma unroll
                for (int n = 0; n < 2; ++n) acc[a][b][m][n] = (f32x4){0.f, 0.f, 0.f, 0.f};
    i32x8 At[4], B0[2], B1[2];
    const char* cA = (const char*)g.A + (size_t)cur.pm * tstep; const char* cB = (const char*)g.Bt + (size_t)cur.pn * tstep;
    S.a_ready(cur);
    if constexpr (SP2) {
        PG8_STAGE(PG8_SB(0, 0), cB, voffB); PG8_STAGE(PG8_SB(0, 1), cB + hstep, voffB); PG8_STAGE(PG8_SA(0, 0), cA, voffA); PG8_STAGE(PG8_SA(0, 1), cA + hstep, voffA);
        if (wr == 1) PG8_BAR;
        PG8_WAIT_V(2); PG8_BAR;
        PG8_STAGE(PG8_SB(1, 0), cB + kstep, voffB); PG8_STAGE(PG8_SA(1, 0), cA + kstep, voffA); PG8_STAGE(PG8_SB(1, 1), cB + hstep + kstep, voffB);
        PG8_WAIT_V(6); PG8_BAR;
    } else {
        PG8_STAGE(PG8_SB(0, 0), cB, voffB); PG8_STAGE(PG8_SA(0, 0), cA, voffA); PG8_STAGE(PG8_SB(0, 1), cB + hstep, voffB); PG8_STAGE(PG8_SA(0, 1), cA + hstep, voffA);
        if (wr == 1) PG8_BAR;
        PG8_WAIT_V(4); PG8_BAR;
        PG8_STAGE(PG8_SB(1, 0), cB + kstep, voffB); PG8_STAGE(PG8_SA(1, 0), cA + kstep, voffA); PG8_STAGE(PG8_SB(1, 1), cB + hstep + kstep, voffB);
        PG8_WAIT_V(6); PG8_BAR;
    }
    for (;;) {
        const bool has_next = S.next(ui + 1, nxt);
        const char* nA = has_next ? (const char*)g.A + (size_t)nxt.pm * tstep : cA; const char* nB = has_next ? (const char*)g.Bt + (size_t)nxt.pn * tstep : cB;
#pragma unroll 1
        for (int t = 0; t < nt; t += 2) {
            const bool last = (t == nt - 2);
            const char* a1 = cA + (size_t)(t + 1) * kstep;
            const char* a2 = last ? nA : cA + (size_t)(t + 2) * kstep; const char* b2 = last ? nB : cB + (size_t)(t + 2) * kstep;
            const char* a3 = a2 + kstep; const char* b3 = b2 + kstep;
            if (last && has_next) S.a_ready(nxt);
            if constexpr (SP2) {
            PG8_LDB(B0, 0, 0); PG8_LDB(B1, 0, 1); PG8_SCHED; PG8_LDA(At, 0, 0); PG8_STAGE(PG8_SA(1, 1), a1 + hstep, voffA);
            PG8_WAIT_V(8); PG8_WAIT_L(0); PG8_BAR; PG8_MMA(0, 0, At, B0); PG8_MMA(0, 1, At, B1); PG8_BAR; PG8_SCHED;
            PG8_LDA(At, 0, 1); PG8_STAGE(PG8_SB(0, 0), b2, voffB); PG8_STAGE(PG8_SB(0, 1), b2 + hstep, voffB); PG8_STAGE(PG8_SA(0, 0), a2, voffA);
            PG8_WAIT_V(8); PG8_WAIT_L(0); PG8_BAR; PG8_MMA(1, 0, At, B0); PG8_MMA(1, 1, At, B1); PG8_BAR; PG8_SCHED;
            PG8_LDB(B0, 1, 0); PG8_LDB(B1, 1, 1); PG8_SCHED; PG8_LDA(At, 1, 0); PG8_STAGE(PG8_SA(0, 1), a2 + hstep, voffA);
            PG8_WAIT_V(8); PG8_WAIT_L(0); PG8_BAR; PG8_MMA(0, 0, At, B0); PG8_MMA(0, 1, At, B1); PG8_BAR; PG8_SCHED;
            PG8_LDA(At, 1, 1); PG8_STAGE(PG8_SB(1, 0), b3, voffB); PG8_STAGE(PG8_SB(1, 1), b3 + hstep, voffB); PG8_STAGE(PG8_SA(1, 0), a3, voffA);
            PG8_WAIT_V(8); PG8_WAIT_L(0); PG8_BAR; PG8_MMA(1, 0, At, B0); PG8_MMA(1, 1, At, B1); PG8_BAR; PG8_SCHED;
            } else {
            PG8_LDB(B0, 0, 0); PG8_SCHED; PG8_LDA(At, 0, 0); PG8_STAGE(PG8_SA(1, 1), a1 + hstep, voffA);
            PG8_WAIT_L(8); PG8_BAR; PG8_WAIT_L(0); PG8_MMA(0, 0, At, B0); PG8_BAR; PG8_SCHED;
            PG8_LDB(B1, 0, 1); PG8_STAGE(PG8_SB(0, 0), b2, voffB);
            PG8_BAR; PG8_WAIT_L(0); PG8_MMA(0, 1, At, B1); PG8_BAR;
            PG8_LDA(At, 0, 1); PG8_STAGE(PG8_SA(0, 0), a2, voffA);
            PG8_BAR; PG8_WAIT_L(0); PG8_MMA(1, 0, At, B0); PG8_BAR; PG8_SCHED;
            PG8_STAGE(PG8_SB(0, 1), b2 + hstep, voffB);
            PG8_WAIT_V(6); PG8_BAR; PG8_MMA(1, 1, At, B1); PG8_BAR;
            PG8_LDB(B0, 1, 0); PG8_SCHED; PG8_LDA(At, 1, 0); PG8_STAGE(PG8_SA(0, 1), a2 + hstep, voffA);
            PG8_WAIT_L(8); PG8_BAR; PG8_WAIT_L(0); PG8_MMA(0, 0, At, B0); PG8_BAR; PG8_SCHED;
            PG8_LDB(B1, 1, 1); PG8_STAGE(PG8_SB(1, 0), b3, voffB);
            PG8_BAR; PG8_WAIT_L(0); PG8_MMA(0, 1, At, B1); PG8_BAR;
            PG8_LDA(At, 1, 1); PG8_STAGE(PG8_SA(1, 0), a3, voffA);
            PG8_BAR; PG8_WAIT_L(0); PG8_MMA(1, 0, At, B0); PG8_BAR; PG8_SCHED;
            PG8_STAGE(PG8_SB(1, 1), b3 + hstep, voffB);
            PG8_WAIT_V(6); PG8_BAR; PG8_MMA(1, 1, At, B1); PG8_BAR;
            }
        }
        if constexpr (ALIGN_EPI) { if (wr == 0) PG8_BAR; }
        if (MODE == 2) asm volatile("s_nop 15\n\ts_nop 15" ::: "memory");
        E(acc, cur, wr, wc, fr, fq); S.done(cur);
        if (!has_next) break;
#pragma unroll
        for (int a = 0; a < 2; ++a)
#pragma unroll
            for (int b = 0; b < 2; ++b)
#pragma unroll
                for (int m = 0; m < 4; ++m)
#pragma unroll
                    for (int n = 0; n < 2; ++n) acc[a][b][m][n] = (f32x4){0.f, 0.f, 0.f, 0.f};
        cur = nxt; cA = nA; cB = nB; ++ui;
        if constexpr (ALIGN_EPI) { if (wr == 1) PG8_BAR; }
    }
    PG8_WAIT_V(0);
    if constexpr (!ALIGN_EPI) { if (wr == 0) PG8_BAR; }
    PG8_BAR;
#undef PG8_SA
#undef PG8_SB
#undef PG8_STAGE
#undef PG8_LDA
#undef PG8_LDB
#undef PG8_MMA
#undef PG8_WAIT_V
#undef PG8_WAIT_L
#undef PG8_BAR
#undef PG8_SCHED
}

struct EpiProj {
    static constexpr bool PERM = true;
    bf16_t* PA; bf16_t* PG; bf16_t* UB; const float* SA; const float* SB;
    __device__ __forceinline__ void operator()(const f32x4 (&acc)[2][2][4][2], const Unit& u, int wr, int wc, int fr, int fq) const {
        const int row0 = u.pm * BM + wr * 64 + fr; int colt = u.pn * BM; const bool isu = colt < 1024; bf16_t* base = colt < 4096 ? PA : PG;
        const int gcol0 = colt + wc * 32 + 8 * fq; colt &= 4095;
        const int col0 = colt + wc * 32 + 8 * fq;
        f32x4 sb[2][2];
#pragma unroll
        for (int bj = 0; bj < 2; ++bj) { sb[bj][0] = *(const f32x4*)(SB + gcol0 + bj * HALF); sb[bj][1] = *(const f32x4*)(SB + gcol0 + bj * HALF + 4); }
#pragma unroll
        for (int ai = 0; ai < 2; ++ai)
#pragma unroll
            for (int m = 0; m < 4; ++m) { const int row = row0 + ai * HALF + m * 16; bf16_t* rowp = base + (size_t)row * 4096 + col0; const float sa = SA[row];
#pragma unroll
                for (int bj = 0; bj < 2; ++bj) { const i32x4 i0 = __builtin_bit_cast(i32x4, acc[ai][bj][m][0]), i1 = __builtin_bit_cast(i32x4, acc[ai][bj][m][1]);
                    f32x4 v0, v1;
#pragma unroll
                    for (int e = 0; e < 4; ++e) { v0[e] = (float)i0[e] * sa * sb[bj][0][e]; v1[e] = (float)i1[e] * sa * sb[bj][1][e]; }
                    u32x4 w; w.x = cvt_pk_bf16(v0[0], v0[1]); w.y = cvt_pk_bf16(v0[2], v0[3]); w.z = cvt_pk_bf16(v1[0], v1[1]); w.w = cvt_pk_bf16(v1[2], v1[3]);
                    if (isu) { const int cu = col0 + bj * HALF; *(u32x4*)(UB + (((size_t)((row >> 13) * 64 + (cu >> 4)) * 8192 + (row & 8191)) * 16 + (cu & 8))) = w; }
                    else *(u32x4*)(rowp + bj * HALF) = w; } }
    }
};
struct EpiAttUp {
    static constexpr bool PERM = true;
    const bf16_t* PG; bf16_t* HB;
    __device__ __forceinline__ void operator()(const f32x4 (&acc)[2][2][4][2], const Unit& u, int wr, int wc, int fr, int fq) const {
        const int row0 = u.pm * BM + wr * 64 + fr; const int col0 = u.pn * BM + wc * 32 + 8 * fq;
#pragma unroll
        for (int ai = 0; ai < 2; ++ai)
#pragma unroll
            for (int m = 0; m < 4; ++m) { const size_t row = (size_t)(row0 + ai * HALF + m * 16);
#pragma unroll
                for (int bj = 0; bj < 2; ++bj) { const int col = col0 + bj * HALF;
                    const u32x4 gw = *(const u32x4*)(PG + row * 4096 + 2048 + col);
                    const f32x4 v0 = acc[ai][bj][m][0] * F8_INV, v1 = acc[ai][bj][m][1] * F8_INV;
                    u32x4 w;
                    w.x = cvt_pk_bf16(v0[0] * sigmoidf_(bf_lo(gw.x)), v0[1] * sigmoidf_(bf_hi(gw.x)));
                    w.y = cvt_pk_bf16(v0[2] * sigmoidf_(bf_lo(gw.y)), v0[3] * sigmoidf_(bf_hi(gw.y)));
                    w.z = cvt_pk_bf16(v1[0] * sigmoidf_(bf_lo(gw.z)), v1[1] * sigmoidf_(bf_hi(gw.z)));
                    w.w = cvt_pk_bf16(v1[2] * sigmoidf_(bf_lo(gw.w)), v1[3] * sigmoidf_(bf_hi(gw.w)));
                    *(u32x4*)(HB + row * 2048 + col) = w; } asm volatile("" ::: "memory"); }
    }
};
struct EpiGlu {
    static constexpr bool PERM = true;
    const bf16_t* PG; const bf16_t* HB; unsigned char* M8;
    __device__ __forceinline__ void operator()(const f32x4 (&acc)[2][2][4][2], const Unit& u, int wr, int wc, int fr, int fq) const {
        const int row0 = u.pm * BM + wr * 64 + fr; const int col = u.pn * HALF + wc * 32 + 8 * fq;
#pragma unroll
        for (int ai = 0; ai < 2; ++ai)
#pragma unroll
            for (int m = 0; m < 4; ++m) { const size_t row = (size_t)(row0 + ai * HALF + m * 16);
                const u32x4 gw = *(const u32x4*)(PG + row * 4096 + col);
                const u32x4 aw = *(const u32x4*)(HB + row * 2048 + col);
                const f32x4 a0 = acc[ai][0][m][0] * F8_INV, a1 = acc[ai][0][m][1] * F8_INV, g0 = acc[ai][1][m][0] * F8_INV, g1 = acc[ai][1][m][1] * F8_INV;
                u32x2 w;
                w.x = pack4_fp8(sigmoidf_(bf_lo(gw.x)) * a0[0] * sigmoidf_(g0[0]) + bf_lo(aw.x), sigmoidf_(bf_hi(gw.x)) * a0[1] * sigmoidf_(g0[1]) + bf_hi(aw.x),
                                sigmoidf_(bf_lo(gw.y)) * a0[2] * sigmoidf_(g0[2]) + bf_lo(aw.y), sigmoidf_(bf_hi(gw.y)) * a0[3] * sigmoidf_(g0[3]) + bf_hi(aw.y), F8_SA);
                w.y = pack4_fp8(sigmoidf_(bf_lo(gw.z)) * a1[0] * sigmoidf_(g1[0]) + bf_lo(aw.z), sigmoidf_(bf_hi(gw.z)) * a1[1] * sigmoidf_(g1[1]) + bf_hi(aw.z),
                                sigmoidf_(bf_lo(gw.w)) * a1[2] * sigmoidf_(g1[2]) + bf_lo(aw.w), sigmoidf_(bf_hi(gw.w)) * a1[3] * sigmoidf_(g1[3]) + bf_hi(aw.w), F8_SA);
                *(u32x2*)(M8 + row * 2048 + col) = w; asm volatile("" ::: "memory"); }
    }
};
struct EpiOut {
    static constexpr bool PERM = true;
    const float* X; float* O; const float* mod;
    __device__ __forceinline__ void operator()(const f32x4 (&acc)[2][2][4][2], const Unit& u, int wr, int wc, int fr, int fq) const {
        const int row0 = u.pm * BM + wr * 64 + fr; const int col0 = u.pn * BM + wc * 32 + 8 * fq;
        const float* gt = mod + (size_t)((u.pm * BM) >> 13) * 12288 + 4096;
#pragma unroll
        for (int bj = 0; bj < 2; ++bj) { const int col = col0 + bj * HALF;
            const f32x4 g0 = *(const f32x4*)(gt + col), g1 = *(const f32x4*)(gt + col + 4);
#pragma unroll
            for (int ai = 0; ai < 2; ++ai)
#pragma unroll
                for (int m = 0; m < 4; ++m) { const size_t off = (size_t)(row0 + ai * HALF + m * 16) * 2048 + col;
                    const f32x4 x0 = *(const f32x4*)(X + off), x1 = *(const f32x4*)(X + off + 4);
                    *(f32x4*)(O + off) = x0 + g0 * (acc[ai][bj][m][0] * F8_INV); *(f32x4*)(O + off + 4) = x1 + g1 * (acc[ai][bj][m][1] * F8_INV); } }
    }
};
struct EpiF32 {
    static constexpr bool PERM = true;
    float* O;
    __device__ __forceinline__ void operator()(const f32x4 (&acc)[2][2][4][2], const Unit& u, int wr, int wc, int fr, int fq) const {
        const int row0 = u.pm * BM + wr * 64 + fr; const int col0 = u.pn * BM + wc * 32 + 8 * fq;
#pragma unroll
        for (int ai = 0; ai < 2; ++ai)
#pragma unroll
            for (int m = 0; m < 4; ++m) { float* rowp = O + (size_t)(row0 + ai * HALF + m * 16) * 2048 + col0;
#pragma unroll
                for (int bj = 0; bj < 2; ++bj) { *(f32x4*)(rowp + bj * HALF) = acc[ai][bj][m][0]; *(f32x4*)(rowp + bj * HALF + 4) = acc[ai][bj][m][1]; } }
    }
};
}

struct Args { const float* in[25]; float* out; unsigned char* ws; int ph_lo, ph_hi; };
enum { I_X = 0, I_C, I_WADA, I_BADA, I_N1G, I_WIN, I_LRE, I_LIM, I_LDT, I_BRE, I_BIM, I_CRE, I_CIM, I_SD, I_WGLU, I_QNG, I_KNG, I_WATT, I_WOUT, I_N2G, I_WQ, I_K1, I_K2, I_PU, I_PV };

__device__ __forceinline__ void ph_mod_partial(const float* __restrict__ c, const float* __restrict__ w_ada, float* modp, int gw, int ngw, int lane) {
    for (int task = gw; task < 48 * 32; task += ngw) {
        const int strip = task % 48, ks = task / 48, n0 = strip * 256 + lane * 4, k0 = ks * 64;
        f32x4 a0 = {0.f, 0.f, 0.f, 0.f}, a1 = {0.f, 0.f, 0.f, 0.f};
#pragma unroll 8
        for (int k = 0; k < 64; ++k) {
            const f32x4 w = *(const f32x4*)(w_ada + (size_t)(k0 + k) * 12288 + n0);
            float c0 = c[k0 + k], c1 = c[2048 + k0 + k];
            c0 = c0 / (1.0f + __expf(-c0)); c1 = c1 / (1.0f + __expf(-c1));
            a0 += c0 * w; a1 += c1 * w;
        }
        *(f32x4*)(modp + (size_t)(ks * 2 + 0) * 12288 + n0) = a0;
        *(f32x4*)(modp + (size_t)(ks * 2 + 1) * 12288 + n0) = a1;
    }
}

__device__ __forceinline__ void ph_colmax_partial(const float* __restrict__ w_in, float* cmaxp, int gw, int ngw, int lane) {
    for (int task = gw; task < 32 * 32; task += ngw) {
        const int strip = task & 31, ks = task >> 5, n0 = strip * 256 + lane * 4, k0 = ks * 64;
        f32x4 m = {0.f, 0.f, 0.f, 0.f};
#pragma unroll 8
        for (int k = 0; k < 64; ++k) { const f32x4 w = *(const f32x4*)(w_in + (size_t)(k0 + k) * 8192 + n0);
            m[0] = fmaxf(m[0], fabsf(w[0])); m[1] = fmaxf(m[1], fabsf(w[1])); m[2] = fmaxf(m[2], fabsf(w[2])); m[3] = fmaxf(m[3], fabsf(w[3])); }
        *(f32x4*)(cmaxp + (size_t)ks * 8192 + n0) = m;
    }
}

__device__ __forceinline__ void transpose_item_f8(const float* __restrict__ W, int K, int N, unsigned char* WT8, int drow0, int scol0, int k0, LAS float* scr, int lane) {
#pragma unroll 8
    for (int i = 0; i < 32; ++i) { const int kk = 2 * i + (lane >> 5); scr[kk * 33 + (lane & 31)] = W[(size_t)(k0 + kk) * N + scol0 + (lane & 31)]; }
    LDS_WAIT();
    const int n = lane >> 1, half = lane & 1;
    const LAS float* s = scr + (32 * half) * 33 + n;
    u32x4 o[2];
#pragma unroll
    for (int q = 0; q < 8; ++q) o[q >> 2][q & 3] = pack4_fp8(s[(4 * q) * 33], s[(4 * q + 1) * 33], s[(4 * q + 2) * 33], s[(4 * q + 3) * 33], F8_SW);
    *(u32x4*)(WT8 + (size_t)(drow0 + n) * K + k0 + 32 * half) = o[0];
    *(u32x4*)(WT8 + (size_t)(drow0 + n) * K + k0 + 32 * half + 16) = o[1];
    LDS_WAIT();
}
__device__ __forceinline__ void transpose_item_i8(const float* __restrict__ W, signed char* WT8, const float* cmaxp, float* SB, int n0, int k0, LAS float* scr, int lane) {
#pragma unroll 8
    for (int i = 0; i < 32; ++i) { const int kk = 2 * i + (lane >> 5); scr[kk * 33 + (lane & 31)] = W[(size_t)(k0 + kk) * 8192 + n0 + (lane & 31)]; }
    const int n = lane >> 1, half = lane & 1;
    float cm = 0.f;
#pragma unroll 8
    for (int ks = 0; ks < 32; ++ks) cm = fmaxf(cm, cmaxp[(size_t)ks * 8192 + n0 + n]);
    const float sb = fmaxf(cm, 1e-30f) * (1.0f / 127.0f), inv = 1.0f / sb;
    if (k0 == 0 && half == 0) SB[n0 + n] = sb;
    LDS_WAIT();
    const LAS float* s = scr + (32 * half) * 33 + n;
    u32x4 o[2];
#pragma unroll
    for (int q = 0; q < 8; ++q) { unsigned w = 0;
#pragma unroll
        for (int e = 0; e < 4; ++e) { const int v = (int)rintf(s[(4 * q + e) * 33] * inv); w |= ((unsigned)v & 0xffu) << (8 * e); }
        o[q >> 2][q & 3] = w; }
    *(u32x4*)(WT8 + (size_t)(n0 + n) * 2048 + k0 + 32 * half) = o[0];
    *(u32x4*)(WT8 + (size_t)(n0 + n) * 2048 + k0 + 32 * half + 16) = o[1];
    LDS_WAIT();
}

__device__ __forceinline__ void transpose_item(const float* __restrict__ W, int K, int N, bf16_t* WT, int drow0, int scol0, int k0, LAS float* scr, int lane) {
#pragma unroll 8
    for (int i = 0; i < 32; ++i) { const int kk = 2 * i + (lane >> 5); scr[kk * 33 + (lane & 31)] = W[(size_t)(k0 + kk) * N + scol0 + (lane & 31)]; }
    LDS_WAIT();
    const int c = lane & 7;
#pragma unroll
    for (int j = 0; j < 4; ++j) { const int n = (lane >> 3) + 8 * j; const LAS float* s = scr + (8 * c) * 33 + n;
        u32x4 o; o.x = cvt_pk_bf16(s[0 * 33], s[1 * 33]); o.y = cvt_pk_bf16(s[2 * 33], s[3 * 33]); o.z = cvt_pk_bf16(s[4 * 33], s[5 * 33]); o.w = cvt_pk_bf16(s[6 * 33], s[7 * 33]);
        *(u32x4*)(WT + (size_t)(drow0 + n) * K + k0 + 8 * c) = o; }
    LDS_WAIT();
}
__device__ __forceinline__ void wsc_item(const float* wq, const float* kk, bf16_t* out, int lane) {
    const int r = lane & 15, q = lane >> 4;
    f32x4 acc[8];
#pragma unroll
    for (int f = 0; f < 8; ++f) acc[f] = (f32x4){0.f, 0.f, 0.f, 0.f};
    const float* ap = kk + r * 128 + 4 * q; const float* bp = wq + (size_t)r * 2048 + 4 * q;
#pragma unroll 2
    for (int d0 = 0; d0 < 128; d0 += 16) {
        const f32x4 bv = *(const f32x4*)(bp + d0);
        f32x4 av[8];
#pragma unroll
        for (int f = 0; f < 8; ++f) av[f] = *(const f32x4*)(ap + f * 2048 + d0);
#pragma unroll
        for (int j = 0; j < 4; ++j)
#pragma unroll
            for (int f = 0; f < 8; ++f) acc[f] = __builtin_amdgcn_mfma_f32_16x16x4f32(av[f][j], bv[j], acc[f], 0, 0, 0);
    }
#pragma unroll
    for (int f = 0; f < 8; ++f)
#pragma unroll
        for (int i = 0; i < 4; ++i) out[(size_t)(16 * f + 4 * q + i) * 2048 + r] = (bf16_t)(cvt_pk_bf16(acc[f][i], 0.f) & 0xffffu);
}
__device__ __forceinline__ void ph_prologue(const Args& a, LAS unsigned char* lds, int gw, int ngw, int lane, int wave) {
    unsigned char* ws = a.ws;
    { const float* modp = (const float*)(ws + WS_MODP); float* mod = (float*)(ws + WS_MOD); const float* b_ada = a.in[I_BADA];
      for (int idx = gw * 64 + lane; idx < 2 * 12288; idx += ngw * 64) { const int b = idx / 12288, n = idx - b * 12288; float s = b_ada[n];
#pragma unroll 8
          for (int ks = 0; ks < 32; ++ks) s += modp[(size_t)(ks * 2 + b) * 12288 + n];
          mod[idx] = s; } }
    for (int item = gw; item < 2048; item += ngw) { const int hj = item >> 7, k0 = (item & 127) * 16;
        wsc_item(a.in[I_WQ] + (size_t)k0 * 2048 + hj * 128, (hj & 1) ? a.in[I_K2] : a.in[I_K1], (bf16_t*)(ws + WS_WSC) + (size_t)(hj * 128) * 2048 + k0, lane); }
    { LAS float* scr = (LAS float*)(lds + wave * 8448);
      constexpr int I_IN = 32 * 256, I_GLU = 16 * 128, I_ATT = 16 * 64, I_OUT = 32 * 64, NIT = I_IN + I_GLU + I_ATT + I_OUT;
      for (int it = gw; it < NIT; it += ngw) {
          int r = it;
          if (r < I_IN) { const int kb = r / 256, nb = r % 256; transpose_item_i8(a.in[I_WIN], (signed char*)(ws + WS_WIN), (const float*)(ws + WS_CMAXP), (float*)(ws + WS_SB), 32 * nb, 64 * kb, scr, lane); continue; } r -= I_IN;
          if (r < I_GLU) { const int kb = r / 128, nb = r % 128, dr = 32 * nb; const int sc = ((dr >> 7) & 1) * 2048 + (dr >> 8) * 128 + (dr & 127);
              transpose_item_f8(a.in[I_WGLU], 1024, 4096, ws + WS_WGLU, dr, sc, 64 * kb, scr, lane); continue; } r -= I_GLU;
          if (r < I_ATT) { const int kb = r / 64, nb = r % 64; transpose_item_f8(a.in[I_WATT], 1024, 2048, ws + WS_WATT, 32 * nb, 32 * nb, 64 * kb, scr, lane); continue; } r -= I_ATT;
          { const int kb = r / 64, nb = r % 64; transpose_item_f8(a.in[I_WOUT], 2048, 2048, ws + WS_WOUT, 32 * nb, 32 * nb, 64 * kb, scr, lane); }
      } }
}

template <bool I8>
__device__ __forceinline__ void ph_norm(const float* X, bf16_t* Hout, float* SA, const float* __restrict__ g, const float* mod, int sh_off, int sc_off, int gw, int ngw, int lane) {
    for (int row = gw; row < T_TOK; row += ngw) {
        const int b = row >> 13;
        const f32x4* xr = (const f32x4*)(X + (size_t)row * DM) + lane;
        f32x4 v[8]; float ss = 0.f;
#pragma unroll
        for (int j = 0; j < 8; ++j) { v[j] = xr[64 * j]; ss += (v[j][0] * v[j][0] + v[j][1] * v[j][1]) + (v[j][2] * v[j][2] + v[j][3] * v[j][3]); }
        ss = wave_sum(ss);
        const float rs = 1.0f / sqrtf(ss * (1.0f / DM) + EPS);
        const float* mb = mod + (size_t)b * 12288;
        float amax = 0.f;
#pragma unroll
        for (int j = 0; j < 8; ++j) { const int col = 4 * (lane + 64 * j);
            const f32x4 gv = *(const f32x4*)(g + col), sc = *(const f32x4*)(mb + sc_off + col), sh = *(const f32x4*)(mb + sh_off + col);
            const f32x4 o = v[j] * rs * gv * (sc + 1.0f) + sh;
            if (I8) { v[j] = o; amax = fmaxf(fmaxf(amax, fmaxf(fabsf(o[0]), fabsf(o[1]))), fmaxf(fabsf(o[2]), fabsf(o[3]))); }
            else { u32x2 w; w.x = cvt_pk_bf16(o[0], o[1]); w.y = cvt_pk_bf16(o[2], o[3]); *(u32x2*)(Hout + (size_t)row * DM + col) = w; } }
        if (I8) {
#pragma unroll
            for (int o = 1; o < 64; o <<= 1) amax = fmaxf(amax, __shfl_xor(amax, o));
            const float sa = fmaxf(amax, 1e-30f) * (1.0f / 127.0f), inv = 1.0f / sa;
            if (lane == 0) SA[row] = sa;
            unsigned* h8 = (unsigned*)((signed char*)Hout + (size_t)row * DM) + lane;
#pragma unroll
            for (int j = 0; j < 8; ++j) { unsigned w = 0;
#pragma unroll
                for (int e = 0; e < 4; ++e) { const int q = (int)rintf(v[j][e] * inv); w |= ((unsigned)q & 0xffu) << (8 * e); }
                h8[64 * j] = w; }
        }
    }
}

template <int MODE>
__device__ __forceinline__ void ph_attn(LAS unsigned char* lds, const bf16_t* PA, bf16_t* ATT, const float* __restrict__ qg, const float* __restrict__ kg, int G) {
    const int tid = opaque_tid(), lane = tid & 63, wave = __builtin_amdgcn_readfirstlane(tid >> 6), c = lane & 15, g = lane >> 4;
    LAS unsigned char* KL = lds;
    LAS unsigned char* VT = lds + 17408;
    bf16x8 tri[6];
    { const int FS[6] = {0, 1, 0, 1, 2, 3}, FP[6] = {0, 0, 1, 1, 1, 1};
#pragma unroll
      for (int q = 0; q < 6; ++q)
#pragma unroll
          for (int jj = 0; jj < 8; ++jj) { const int kap = 32 * FP[q] + 16 * (jj >> 2) + 4 * g + (jj & 3); tri[q][jj] = (kap > 16 * FS[q] + c) ? (short)0x3F80 : (short)0; } }
    for (int u = blockIdx.x; u < 1024; u += G) {
        const int b = u >> 9, h = (u >> 6) & 7, qb = u & 63, t0 = qb * 128, tq0 = t0 + 16 * wave, tq = tq0 + c;
        bf16x8 qf[4];
        { const bf16_t* qrow = PA + (size_t)(b * SEQ + tq) * 4096 + 1024 + h * 128;
          u32x4 qr[4]; float ss = 0.f;
#pragma unroll
          for (int kk = 0; kk < 4; ++kk) { qr[kk] = *(const u32x4*)(qrow + 32 * kk + 8 * g);
#pragma unroll
              for (int e = 0; e < 4; ++e) { const float lo = bf_lo(qr[kk][e]), hi = bf_hi(qr[kk][e]); ss += lo * lo + hi * hi; } }
          ss += __shfl_xor(ss, 16); ss += __shfl_xor(ss, 32);
          const float rs = (1.0f / sqrtf(ss * (1.0f / 128.0f) + EPS)) * (0.08838834764831845f * 1.4426950408889634f);
#pragma unroll
          for (int kk = 0; kk < 4; ++kk) { const f32x4 g0 = *(const f32x4*)(qg + 32 * kk + 8 * g), g1 = *(const f32x4*)(qg + 32 * kk + 8 * g + 4);
              u32x4 w;
              w.x = cvt_pk_bf16(bf_lo(qr[kk].x) * rs * g0[0], bf_hi(qr[kk].x) * rs * g0[1]);
              w.y = cvt_pk_bf16(bf_lo(qr[kk].y) * rs * g0[2], bf_hi(qr[kk].y) * rs * g0[3]);
              w.z = cvt_pk_bf16(bf_lo(qr[kk].z) * rs * g1[0], bf_hi(qr[kk].z) * rs * g1[1]);
              w.w = cvt_pk_bf16(bf_lo(qr[kk].w) * rs * g1[2], bf_hi(qr[kk].w) * rs * g1[3]);
              qf[kk] = __builtin_bit_cast(bf16x8, w); } }
        float carry = 0.f; int wdone = 0;
        f32x4 oacc[8];
#pragma unroll
        for (int fd = 0; fd < 8; ++fd) oacc[fd] = (f32x4){0.f, 0.f, 0.f, 0.f};
        u32x4 kreg[2], vreg[2];
        { const int k0n = (2 * qb + 1) * 64;
#pragma unroll
          for (int p = 0; p < 2; ++p) { const int ci = tid + 512 * p, key = ci >> 4, ch = ci & 15;
              kreg[p] = *(const u32x4*)(PA + (size_t)(b * SEQ + k0n + key) * 4096 + 2048 + h * 128 + 8 * ch);
              vreg[p] = *(const u32x4*)(PA + (size_t)(b * SEQ + k0n + lane) * 4096 + 3072 + h * 128 + 8 * (wave + 8 * p)); } }
        for (int kt = 2 * qb + 1; kt >= 0; --kt) {
            const int k0 = kt * 64;
            if (__syncthreads_and(wdone)) break;
#pragma unroll
            for (int p = 0; p < 2; ++p) {
                const int ci = tid + 512 * p, key = ci >> 4, ch = ci & 15;
                const u32x4 kr = kreg[p];
                float f[8]; f[0] = bf_lo(kr.x); f[1] = bf_hi(kr.x); f[2] = bf_lo(kr.y); f[3] = bf_hi(kr.y); f[4] = bf_lo(kr.z); f[5] = bf_hi(kr.z); f[6] = bf_lo(kr.w); f[7] = bf_hi(kr.w);
                float ss = 0.f;
#pragma unroll
                for (int e = 0; e < 8; ++e) ss += f[e] * f[e];
                ss += __shfl_xor(ss, 1); ss += __shfl_xor(ss, 2); ss += __shfl_xor(ss, 4); ss += __shfl_xor(ss, 8);
                const float rs = 1.0f / sqrtf(ss * (1.0f / 128.0f) + EPS);
                const f32x4 g0 = *(const f32x4*)(kg + 8 * ch), g1 = *(const f32x4*)(kg + 8 * ch + 4);
                u32x4 w;
                w.x = cvt_pk_bf16(f[0] * rs * g0[0], f[1] * rs * g0[1]); w.y = cvt_pk_bf16(f[2] * rs * g0[2], f[3] * rs * g0[3]);
                w.z = cvt_pk_bf16(f[4] * rs * g1[0], f[5] * rs * g1[1]); w.w = cvt_pk_bf16(f[6] * rs * g1[2], f[7] * rs * g1[3]);
                *(LAS u32x4*)(KL + key * 272 + ch * 16) = w;
            }
#pragma unroll
            for (int p = 0; p < 2; ++p) {
                const int key = lane, ch = wave + 8 * p;
                const u32x4 vr = vreg[p];
                LAS unsigned short* vt = (LAS unsigned short*)(VT + (8 * ch) * 144 + key * 2);
                vt[0 * 72] = (unsigned short)(vr.x & 0xffffu); vt[1 * 72] = (unsigned short)(vr.x >> 16);
                vt[2 * 72] = (unsigned short)(vr.y & 0xffffu); vt[3 * 72] = (unsigned short)(vr.y >> 16);
                vt[4 * 72] = (unsigned short)(vr.z & 0xffffu); vt[5 * 72] = (unsigned short)(vr.z >> 16);
                vt[6 * 72] = (unsigned short)(vr.w & 0xffffu); vt[7 * 72] = (unsigned short)(vr.w >> 16);
            }
            if (kt > 0) { const int k0n = k0 - 64;
#pragma unroll
                for (int p = 0; p < 2; ++p) { const int ci = tid + 512 * p, key = ci >> 4, ch = ci & 15;
                    kreg[p] = *(const u32x4*)(PA + (size_t)(b * SEQ + k0n + key) * 4096 + 2048 + h * 128 + 8 * ch);
                    vreg[p] = *(const u32x4*)(PA + (size_t)(b * SEQ + k0n + lane) * 4096 + 3072 + h * 128 + 8 * (wave + 8 * p)); } }
            __syncthreads();
            if (MODE == 1) { if (kt <= 2 * qb - 3) wdone = 1; }
            if (MODE == 0 && !wdone && k0 < tq0 + 15) {
                f32x4 zt[4];
#pragma unroll
                for (int f = 0; f < 4; ++f) { f32x4 acc = {0.f, 0.f, 0.f, 0.f};
#pragma unroll
                    for (int kk = 0; kk < 4; ++kk) { const bf16x8 kf = *(const LAS bf16x8*)(KL + (16 * f + c) * 272 + (32 * kk + 8 * g) * 2);
                        acc = __builtin_amdgcn_mfma_f32_16x16x32_bf16(kf, qf[kk], acc, 0, 0, 0); }
                    zt[f] = acc; }
                float lf[4][4], lz[4][4]; float tot = 0.f;
                if (k0 + 63 >= tq0) {
#pragma unroll
                    for (int f = 0; f < 4; ++f)
#pragma unroll
                        for (int i = 0; i < 4; ++i) { const int s = k0 + 16 * f + 4 * g + i; const bool valid = s < tq; const float z = zt[f][i];
                            const float sp = fmaxf(z, 0.f) + __builtin_amdgcn_logf(1.0f + __builtin_amdgcn_exp2f(-fabsf(z)));
                            const float l = valid ? -sp : 0.f; lf[f][i] = l; lz[f][i] = valid ? (l + z) : -INFINITY; tot += l; }
                } else {
#pragma unroll
                    for (int f = 0; f < 4; ++f)
#pragma unroll
                        for (int i = 0; i < 4; ++i) { const float z = zt[f][i];
                            const float l = -(fmaxf(z, 0.f) + __builtin_amdgcn_logf(1.0f + __builtin_amdgcn_exp2f(-fabsf(z)))); lf[f][i] = l; lz[f][i] = l + z; tot += l; }
                }
                tot += __shfl_xor(tot, 16); tot += __shfl_xor(tot, 32);
                bf16x8 lh[2];
#pragma unroll
                for (int fp = 0; fp < 2; ++fp) { u32x4 wh;
#pragma unroll
                    for (int q = 0; q < 2; ++q) { const int f = 2 * fp + q; wh[2 * q] = cvt_pk_bf16(lf[f][0], lf[f][1]); wh[2 * q + 1] = cvt_pk_bf16(lf[f][2], lf[f][3]); }
                    lh[fp] = __builtin_bit_cast(bf16x8, wh); }
                f32x4 sf[4];
                { f32x4 z4 = {0.f, 0.f, 0.f, 0.f};
                  sf[0] = __builtin_amdgcn_mfma_f32_16x16x32_bf16(tri[0], lh[0], z4, 0, 0, 0); sf[0] = __builtin_amdgcn_mfma_f32_16x16x32_bf16(tri[2], lh[1], sf[0], 0, 0, 0);
                  sf[1] = __builtin_amdgcn_mfma_f32_16x16x32_bf16(tri[1], lh[0], z4, 0, 0, 0); sf[1] = __builtin_amdgcn_mfma_f32_16x16x32_bf16(tri[3], lh[1], sf[1], 0, 0, 0);
                  sf[2] = __builtin_amdgcn_mfma_f32_16x16x32_bf16(tri[4], lh[1], z4, 0, 0, 0);
                  sf[3] = __builtin_amdgcn_mfma_f32_16x16x32_bf16(tri[5], lh[1], z4, 0, 0, 0); }
                bf16x8 pb[2];
#pragma unroll
                for (int fp = 0; fp < 2; ++fp) { u32x4 w;
#pragma unroll
                    for (int q = 0; q < 2; ++q) { const int f = 2 * fp + q; float p[4];
#pragma unroll
                        for (int i = 0; i < 4; ++i) p[i] = __builtin_amdgcn_exp2f(lz[f][i] + sf[f][i] + carry);
                        w[2 * q] = cvt_pk_bf16(p[0], p[1]); w[2 * q + 1] = cvt_pk_bf16(p[2], p[3]); }
                    pb[fp] = __builtin_bit_cast(bf16x8, w); }
                carry += tot;
#pragma unroll
                for (int fd = 0; fd < 8; ++fd)
#pragma unroll
                    for (int fp = 0; fp < 2; ++fp) { const LAS unsigned char* vp = VT + (16 * fd + c) * 144 + (32 * fp + 4 * g) * 2;
                        const u32x2 v0 = *(const LAS u32x2*)vp, v1 = *(const LAS u32x2*)(vp + 32);
                        u32x4 vw; vw.x = v0.x; vw.y = v0.y; vw.z = v1.x; vw.w = v1.y;
                        oacc[fd] = __builtin_amdgcn_mfma_f32_16x16x32_bf16(__builtin_bit_cast(bf16x8, vw), pb[fp], oacc[fd], 0, 0, 0); }
                wdone = (__ballot(carry >= -152.0f) == 0ull) ? 1 : 0;
            }
        }
        if (MODE == 0) { unsigned char* orow = (unsigned char*)ATT + (size_t)(b * SEQ + tq) * 1024 + h * 128 + 4 * g;
#pragma unroll
          for (int fd = 0; fd < 8; ++fd) *(unsigned*)(orow + 16 * fd) = pack4_fp8(oacc[fd][0], oacc[fd][1], oacc[fd][2], oacc[fd][3], F8_SA); }
    }
    __syncthreads();
}

__device__ __forceinline__ void ssm_lambda(const Args& a, int g, int st, float& lbr, float& lbi, float& qr, float& qi) {
    const float lr = a.in[I_LRE][g * 64 + st], li = a.in[I_LIM][g * 64 + st], dt = __expf(a.in[I_LDT][g]);
    const float mag = __expf(lr * dt);
    float rev = li * dt * 0.15915494309189535f; rev -= rintf(rev);
    lbr = mag * __builtin_amdgcn_cosf(rev); lbi = mag * __builtin_amdgcn_sinf(rev);
    const float nr = lbr - 1.0f, ni = lbi, den = 1.0f / (lr * lr + li * li);
    qr = (nr * lr + ni * li) * den; qi = (ni * lr - nr * li) * den;
}
template <bool WITH_Y>
__device__ __forceinline__ void ph_ssm_mfma(const Args& a, LAS unsigned char* lds, const bf16_t* UB, f32x2* E, bf16_t* YA, int G) {
    const int tid = opaque_tid(), lane = tid & 63, wave = __builtin_amdgcn_readfirstlane(tid >> 6), c = lane & 15, gl = lane >> 4;
    LAS f32x2* sl = (LAS f32x2*)(lds + wave * 8192);
    LAS f32x4* tab = (LAS f32x4*)(lds + 65536 + wave * 1024);
    LAS u32x4* cml = (LAS u32x4*)(lds + 73728 + wave * 5120) + lane;
    for (int item = blockIdx.x; item < 128; item += G) {
        const int b = item >> 6, cb = (item >> 3) & 7, g = (item & 7) * 8 + wave, c0 = cb * 16;
        float mur, mui;
        { float lbr, lbi, qr, qi; ssm_lambda(a, g, lane, lbr, lbi, qr, qi); tab[lane] = (f32x4){lbr, lbi, qr, qi}; mur = lbr; mui = lbi; }
        LDS_WAIT();
        bf16x8 bm[8];
        const float* brb = a.in[I_BRE] + (g * 64 + (c >> 1)) * 16 + 8 * (gl & 1); const float* bib = a.in[I_BIM] + (g * 64 + (c >> 1)) * 16 + 8 * (gl & 1);
        const LAS f32x4* tabb = tab + (c >> 1);
#pragma unroll
        for (int f = 0; f < 8; ++f) { const f32x4 tv = tabb[8 * f]; const float qr = tv[2], qi = tv[3];
            const float* br = brb + 128 * f; const float* bim = bib + 128 * f;
            const f32x4 r0 = *(const f32x4*)br, r1 = *(const f32x4*)(br + 4), i0 = *(const f32x4*)bim, i1 = *(const f32x4*)(bim + 4);
            float v[8];
#pragma unroll
            for (int e = 0; e < 4; ++e) { const float vr0 = qr * r0[e] - qi * i0[e], vi0 = qr * i0[e] + qi * r0[e], vr1 = qr * r1[e] - qi * i1[e], vi1 = qr * i1[e] + qi * r1[e];
                v[e] = (c & 1) ? vi0 : vr0; v[4 + e] = (c & 1) ? vi1 : vr1; }
            if (gl >= 2) {
#pragma unroll
                for (int e = 0; e < 8; ++e) v[e] = 0.f; }
            u32x4 w; w.x = cvt_pk_bf16(v[0], v[1]); w.y = cvt_pk_bf16(v[2], v[3]); w.z = cvt_pk_bf16(v[4], v[5]); w.w = cvt_pk_bf16(v[6], v[7]);
            bm[f] = __builtin_bit_cast(bf16x8, w); }
        float lmr[16], lmi[16];
#pragma unroll
        for (int k = 0; k < 16; ++k) { const f32x4 tv = tab[2 * gl + 8 * (k >> 1) + (k & 1)]; lmr[k] = tv[0]; lmi[k] = tv[1]; }
        if (WITH_Y) {
            const float* crb = a.in[I_CRE] + (g * 16 + c) * 64 + 2 * gl; const float* cib = a.in[I_CIM] + (g * 16 + c) * 64 + 2 * gl;
#pragma unroll
            for (int kk = 0; kk < 4; ++kk) { float v[8];
#pragma unroll
                for (int jh = 0; jh < 2; ++jh) { const f32x2 r = *(const f32x2*)(crb + 8 * (2 * kk + jh)), m = *(const f32x2*)(cib + 8 * (2 * kk + jh));
                    v[4 * jh] = r.x; v[4 * jh + 1] = -m.x; v[4 * jh + 2] = r.y; v[4 * jh + 3] = -m.y; }
                u32x4 w; w.x = cvt_pk_bf16(v[0], v[1]); w.y = cvt_pk_bf16(v[2], v[3]); w.z = cvt_pk_bf16(v[4], v[5]); w.w = cvt_pk_bf16(v[6], v[7]);
                cml[64 * kk] = w; }
            { const float dv = a.in[I_SD][g * 16 + c]; float v[8];
#pragma unroll
              for (int jj = 0; jj < 8; ++jj) v[jj] = (gl < 2 && (8 * gl + jj) == c) ? dv : 0.f;
              u32x4 w; w.x = cvt_pk_bf16(v[0], v[1]); w.y = cvt_pk_bf16(v[2], v[3]); w.z = cvt_pk_bf16(v[4], v[5]); w.w = cvt_pk_bf16(v[6], v[7]);
              cml[256] = w; }
        }
        f32x4 s[8];
#pragma unroll
        for (int f = 0; f < 8; ++f) s[f] = (f32x4){0.f, 0.f, 0.f, 0.f};
        if (WITH_Y) {
            float pr = mur, pi = mui;
#pragma unroll
            for (int q = 0; q < 6; ++q) { const float nr = pr * pr - pi * pi, ni = 2.0f * pr * pi; pr = nr; pi = ni; }
            float sr = 0.f, si = 0.f;
            const f32x2* ep = E + (size_t)((b * 64 + g) * 128) * 64 + lane;
            f32x2 ev[8], en[8];
#pragma unroll
            for (int k = 0; k < 8; ++k) ev[k] = ep[(size_t)k * 64];
            for (int cc = 0; cc < c0 + 16; cc += 8) {
                if (cc + 8 < c0 + 16) {
#pragma unroll
                    for (int k = 0; k < 8; ++k) en[k] = ep[(size_t)(cc + 8 + k) * 64]; }
#pragma unroll
                for (int k = 0; k < 8; ++k) { if (cc >= c0) sl[(cc - c0 + k) * 64 + lane] = (f32x2){sr, si};
                    const float nr = pr * sr - pi * si + ev[k][0], ni = pr * si + pi * sr + ev[k][1]; sr = nr; si = ni; }
#pragma unroll
                for (int k = 0; k < 8; ++k) ev[k] = en[k];
            }
            LDS_WAIT();
#pragma unroll
            for (int f = 0; f < 8; ++f) s[f] = *(const LAS f32x4*)(sl + c * 64 + 8 * f + 2 * gl);
            LDS_WAIT();
        }
        const bf16_t* up = UB + ((size_t)(b * 64 + g) * 8192 + (size_t)(c0 + c) * 64) * 16 + 8 * (gl & 1);
        unsigned char* yp = (unsigned char*)YA + (size_t)(b * SEQ + (c0 + c) * 64) * 1024 + g * 16 + 4 * gl;
        u32x4 u0 = *(const u32x4*)(up), u1 = *(const u32x4*)(up + 16), u2 = *(const u32x4*)(up + 32), u3 = *(const u32x4*)(up + 48);
#pragma unroll 1
        for (int tau = 0; tau < 64; ++tau) {
            const u32x4 u4 = *(const u32x4*)(up + (size_t)(tau + 4) * 16);
            const bf16x8 uf = __builtin_bit_cast(bf16x8, u0);
#pragma unroll
            for (int f = 0; f < 8; ++f) { f32x4 ci;
                ci[0] = lmr[2 * f] * s[f][0] - lmi[2 * f] * s[f][1]; ci[1] = lmr[2 * f] * s[f][1] + lmi[2 * f] * s[f][0];
                ci[2] = lmr[2 * f + 1] * s[f][2] - lmi[2 * f + 1] * s[f][3]; ci[3] = lmr[2 * f + 1] * s[f][3] + lmi[2 * f + 1] * s[f][2];
                s[f] = __builtin_amdgcn_mfma_f32_16x16x32_bf16(bm[f], uf, ci, 0, 0, 0); }
            if (WITH_Y) {
                f32x4 y = __builtin_amdgcn_mfma_f32_16x16x32_bf16(__builtin_bit_cast(bf16x8, cml[256]), uf, (f32x4){0.f, 0.f, 0.f, 0.f}, 0, 0, 0);
#pragma unroll
                for (int kk = 0; kk < 4; ++kk) { u32x4 w; w.x = cvt_pk_bf16(s[2 * kk][0], s[2 * kk][1]); w.y = cvt_pk_bf16(s[2 * kk][2], s[2 * kk][3]);
                    w.z = cvt_pk_bf16(s[2 * kk + 1][0], s[2 * kk + 1][1]); w.w = cvt_pk_bf16(s[2 * kk + 1][2], s[2 * kk + 1][3]);
                    y = __builtin_amdgcn_mfma_f32_16x16x32_bf16(__builtin_bit_cast(bf16x8, cml[64 * kk]), __builtin_bit_cast(bf16x8, w), y, 0, 0, 0); }
                *(unsigned*)(yp + (size_t)tau * 1024) = pack4_fp8(gelu_tanh(y[0]), gelu_tanh(y[1]), gelu_tanh(y[2]), gelu_tanh(y[3]), F8_SA);
            }
            u0 = u1; u1 = u2; u2 = u3; u3 = u4;
        }
        if (!WITH_Y) { f32x2* eo = E + (size_t)((b * 64 + g) * 128 + c0 + c) * 64 + 2 * gl;
#pragma unroll
            for (int f = 0; f < 8; ++f) *(f32x4*)(eo + 8 * f) = s[f]; }
    }
}

typedef float f32x16 __attribute__((ext_vector_type(16)));
typedef float f32x32 __attribute__((ext_vector_type(32)));
typedef unsigned u32x6 __attribute__((ext_vector_type(6)));
constexpr float PEER_SU = 64.0f, PEER_SV = 1.4f;
constexpr size_t PEER_SHARD_BYTES = (size_t)16384 * 192;
__device__ __forceinline__ void table_cvt_pack(const f32x4 (&v)[8], float sc, unsigned char* dst, int lane) {
    f32x16 a, b;
#pragma unroll
    for (int q = 0; q < 4; ++q) {
#pragma unroll
        for (int e = 0; e < 4; ++e) { a[4 * q + e] = v[q][e] * sc; b[4 * q + e] = v[4 + q][e] * sc; } }
    const u32x6 p = __builtin_amdgcn_cvt_scalef32_2xpk16_fp6_f32(a, b, 1.0f);
    *(u32x4*)(dst + 16 * (lane & 7)) = (u32x4){p[0], p[1], p[2], p[3]};
    *(u32x2*)(dst + 128 + 8 * (lane & 7)) = (u32x2){p[4], p[5]};
}
__device__ __forceinline__ void ph_table_cvt(const float* __restrict__ U, const float* __restrict__ V, unsigned char* UT, unsigned char* VT, int gw, int ngw, int lane) {
    for (int r = gw; r < 16384; r += ngw) {
        const float* su = U + (size_t)r * 2048 + 32 * lane; const float* sv = V + (size_t)r * 2048 + 32 * lane;
        f32x4 vu[8], vv[8];
#pragma unroll
        for (int q = 0; q < 8; ++q) vu[q] = *(const f32x4*)(su + 4 * q);
#pragma unroll
        for (int q = 0; q < 8; ++q) vv[q] = *(const f32x4*)(sv + 4 * q);
        const size_t off = (size_t)(lane >> 3) * PEER_SHARD_BYTES + (size_t)r * 192;
        table_cvt_pack(vu, PEER_SU, UT + off, lane);
        table_cvt_pack(vv, PEER_SV, VT + off, lane);
    }
}

__device__ __forceinline__ void ph_peer_topk(LAS unsigned char* lds, const float* SC, int* idxG, float* gateG, int G) {
    const int tid = opaque_tid(), lane = tid & 63, wave = __builtin_amdgcn_readfirstlane(tid >> 6);
    LAS float* scr = (LAS float*)(lds + wave * 8448);
    for (int it = blockIdx.x; it < 512; it += G) {
        const int tokw = it * 32 + wave * 4;
        float tk[16];
#pragma unroll
        for (int i = 0; i < 16; ++i) tk[i] = -INFINITY;
        for (int q = 0; q < 4; ++q) {
#pragma unroll
            for (int j = 0; j < 8; ++j) { const int prob = (lane >> 3) + 8 * j, seg = lane & 7;
                const f32x4 v = *(const f32x4*)(SC + (size_t)(tokw + (prob >> 4)) * 2048 + (prob & 15) * 128 + 32 * q + 4 * seg);
                LAS float* d = scr + prob * 33 + 4 * seg; d[0] = v[0]; d[1] = v[1]; d[2] = v[2]; d[3] = v[3]; }
            LDS_WAIT();
#pragma unroll 4
            for (int vi = 0; vi < 32; ++vi) {
                float x = __uint_as_float((__float_as_uint(scr[lane * 33 + vi]) & ~127u) | (unsigned)(127 - (32 * q + vi)));
#pragma unroll
                for (int i = 0; i < 16; ++i) { const float hi = fmaxf(tk[i], x); x = fminf(tk[i], x); tk[i] = hi; }
            }
            LDS_WAIT();
        }
        float t2[16];
#pragma unroll
        for (int i = 0; i < 16; ++i) t2[i] = __shfl_xor(tk[i], 1);
        float bv[16];
#pragma unroll
        for (int i = 0; i < 16; ++i) bv[i] = -INFINITY;
#pragma unroll
        for (int aa = 0; aa < 16; ++aa)
#pragma unroll
            for (int bb = 0; bb < 16 / (aa + 1); ++bb) {
                const float sum = __uint_as_float(__float_as_uint(tk[aa]) & ~127u) + __uint_as_float(__float_as_uint(t2[bb]) & ~127u);
                float x = __uint_as_float((__float_as_uint(sum) & ~255u) | (unsigned)(255 - (16 * aa + bb)));
#pragma unroll
                for (int i = 0; i < 16; ++i) { const float hi = fmaxf(bv[i], x); x = fminf(bv[i], x); bv[i] = hi; }
            }
        unsigned p1[4], p2[4];
#pragma unroll
        for (int j = 0; j < 4; ++j) { p1[j] = 0u; p2[j] = 0u;
#pragma unroll
            for (int e = 0; e < 4; ++e) { p1[j] |= (127u - (__float_as_uint(tk[4 * j + e]) & 127u)) << (8 * e); p2[j] |= (127u - (__float_as_uint(t2[4 * j + e]) & 127u)) << (8 * e); } }
        { float e[16], sum = 0.f; unsigned ex[16];
          const float top = __uint_as_float(__float_as_uint(bv[0]) & ~255u);
#pragma unroll
          for (int i = 0; i < 16; ++i) { const unsigned bits = __float_as_uint(bv[i]); const unsigned flat = 255u - (bits & 255u), aa = flat >> 4, bb = flat & 15u;
              const unsigned w1 = (aa >> 2) == 0u ? p1[0] : (aa >> 2) == 1u ? p1[1] : (aa >> 2) == 2u ? p1[2] : p1[3];
              const unsigned w2 = (bb >> 2) == 0u ? p2[0] : (bb >> 2) == 1u ? p2[1] : (bb >> 2) == 2u ? p2[2] : p2[3];
              ex[i] = (((w1 >> (8u * (aa & 3u))) & 127u) << 7) | ((w2 >> (8u * (bb & 3u))) & 127u);
              e[i] = __expf(__uint_as_float(bits & ~255u) - top); sum += e[i]; }
          const float inv = 1.0f / sum;
          if ((lane & 1) == 0) { const int tl = lane >> 4, head = (lane & 15) >> 1; const size_t o = (size_t)(tokw + tl) * 128 + 64 * (head >> 2);
#pragma unroll
              for (int i = 0; i < 16; ++i) { const int p = 8 * (i & 7) + ((2 * head + (i >> 3)) & 7); idxG[o + p] = (int)ex[i]; gateG[o + p] = e[i] * inv; } } }
    }
}

#define PEER_ROWS(b4_, b2_, i8_) do { _Pragma("unroll") for (int gq = 0; gq < 8; ++gq) { const unsigned ro = (unsigned)(i8_)[gq] * 192u; \
        b4_[gq] = *(const u32x4*)(tab + (ro + 16u * (unsigned)c)); b2_[gq] = *(const u32x2*)(tab + (ro + 128u + 8u * (unsigned)c)); } } while (0)
#define PEER_LD8(dst_, p_) do { const u32x4 _a = *(const u32x4*)(p_), _b = *(const u32x4*)((p_) + 4); dst_[0] = (int)_a.x; dst_[1] = (int)_a.y; dst_[2] = (int)_a.z; dst_[3] = (int)_a.w; \
        dst_[4] = (int)_b.x; dst_[5] = (int)_b.y; dst_[6] = (int)_b.z; dst_[7] = (int)_b.w; } while (0)
__device__ __forceinline__ void ph_peer_u(const unsigned char* UT, const bf16_t* H2, const int* idxG, float* pdot, int G) {
    const int tid = opaque_tid(), lane = tid & 63, wave = __builtin_amdgcn_readfirstlane(tid >> 6), r = lane >> 3, c = lane & 7;
    const int shard = blockIdx.x & 7, ws = (blockIdx.x >> 3) * 8 + wave, nws = (G >> 3) * 8;
    const unsigned char* tab = UT + (size_t)shard * PEER_SHARD_BYTES;
    const bf16_t* hbase = H2 + 256 * shard + 32 * c;
    const int* ibase = idxG + 8 * r;
#define PEER_TOK(t_) (((t_) < T_TOK) ? (t_) : (T_TOK - 1))
    int ci[2][8], ni[2][8]; u32x4 cw[4], nw[4];
    { const int t0 = PEER_TOK(ws), t1 = PEER_TOK(ws + nws);
      PEER_LD8(ci[0], ibase + (size_t)t0 * 128); PEER_LD8(ci[1], ibase + (size_t)t0 * 128 + 64); PEER_LD8(ni[0], ibase + (size_t)t1 * 128); PEER_LD8(ni[1], ibase + (size_t)t1 * 128 + 64);
#pragma unroll
      for (int q = 0; q < 4; ++q) cw[q] = *(const u32x4*)(hbase + (size_t)t0 * 2048 + 8 * q); }
    u32x4 a4[8], b4[8]; u32x2 a2[8], b2[8];
    PEER_ROWS(a4, a2, ci[0]);
    for (int t = ws; t < T_TOK; t += nws) {
        PEER_ROWS(b4, b2, ci[1]);
        { const int t1 = PEER_TOK(t + nws);
#pragma unroll
          for (int q = 0; q < 4; ++q) nw[q] = *(const u32x4*)(hbase + (size_t)t1 * 2048 + 8 * q); }
        f32x2 ha[16];
        { const u32x4 w0 = cw[0], w1 = cw[1], w2 = cw[2], w3 = cw[3];
          ha[0] = (f32x2){bf_lo(w0.x), bf_lo(w2.x)}; ha[1] = (f32x2){bf_hi(w0.x), bf_hi(w2.x)}; ha[2] = (f32x2){bf_lo(w0.y), bf_lo(w2.y)}; ha[3] = (f32x2){bf_hi(w0.y), bf_hi(w2.y)};
          ha[4] = (f32x2){bf_lo(w0.z), bf_lo(w2.z)}; ha[5] = (f32x2){bf_hi(w0.z), bf_hi(w2.z)}; ha[6] = (f32x2){bf_lo(w0.w), bf_lo(w2.w)}; ha[7] = (f32x2){bf_hi(w0.w), bf_hi(w2.w)};
          ha[8] = (f32x2){bf_lo(w1.x), bf_lo(w3.x)}; ha[9] = (f32x2){bf_hi(w1.x), bf_hi(w3.x)}; ha[10] = (f32x2){bf_lo(w1.y), bf_lo(w3.y)}; ha[11] = (f32x2){bf_hi(w1.y), bf_hi(w3.y)};
          ha[12] = (f32x2){bf_lo(w1.z), bf_lo(w3.z)}; ha[13] = (f32x2){bf_hi(w1.z), bf_hi(w3.z)}; ha[14] = (f32x2){bf_lo(w1.w), bf_lo(w3.w)}; ha[15] = (f32x2){bf_hi(w1.w), bf_hi(w3.w)}; }
        float* po = pdot + ((size_t)shard * T_TOK + t) * 128 + lane;
#define PEER_UDOT(b4_, b2_, half_) do { float mine = 0.f; \
            _Pragma("unroll") for (int gq = 0; gq < 8; ++gq) { const u32x6 p6 = {b4_[gq].x, b4_[gq].y, b4_[gq].z, b4_[gq].w, b2_[gq].x, b2_[gq].y}; \
                const f32x32 uv = __builtin_amdgcn_cvt_scalef32_pk32_f32_fp6(p6, 1.0f); f32x2 s = {0.f, 0.f}; \
                _Pragma("unroll") for (int k = 0; k < 16; ++k) s = (f32x2){uv[2 * k], uv[2 * k + 1]} * ha[k] + s; \
                const float d = sum8_dpp(s.x + s.y); \
                mine = (gq == c) ? d : mine; __builtin_amdgcn_sched_barrier(0); } \
            po[64 * (half_)] = mine; } while (0)
        PEER_UDOT(a4, a2, 0);
        PEER_ROWS(a4, a2, ni[0]);
#pragma unroll
        for (int q = 0; q < 8; ++q) { ci[0][q] = ni[0][q]; ci[1][q] = ni[1][q]; }
        { const int t2 = PEER_TOK(t + 2 * nws); PEER_LD8(ni[0], ibase + (size_t)t2 * 128); PEER_LD8(ni[1], ibase + (size_t)t2 * 128 + 64); }
        PEER_UDOT(b4, b2, 1);
#pragma unroll
        for (int q = 0; q < 4; ++q) cw[q] = nw[q];
    }
#undef PEER_UDOT
}
__device__ __forceinline__ void ph_peer_act(const float* pdot, const float* gateG, float* actG, int G) {
    const size_t n = (size_t)T_TOK * 128, stride = (size_t)G * 512;
    for (size_t i = (size_t)blockIdx.x * 512 + threadIdx.x; i < n; i += stride) {
        float d = 0.f;
#pragma unroll
        for (int x = 0; x < 8; ++x) d += pdot[(size_t)x * n + i];
        actG[i] = gateG[i] * gelu_tanh(d * (1.0f / PEER_SU)) * (1.0f / PEER_SV);
    }
}
template <bool DRY>
__device__ __forceinline__ void ph_peer_v(LAS unsigned char* lds, const unsigned char* VT, const int* idxG, const float* actG, const float* mod, float* OUT, int G) {
    const int tid = opaque_tid(), lane = tid & 63, wave = __builtin_amdgcn_readfirstlane(tid >> 6), r = lane >> 3, c = lane & 7;
    const int shard = blockIdx.x & 7, ws = (blockIdx.x >> 3) * 8 + wave, nws = (G >> 3) * 8;
    const unsigned char* tab = VT + (size_t)shard * PEER_SHARD_BYTES;
    LAS float* red = (LAS float*)(lds + wave * 9216);
    const int* ibase = idxG + 8 * r; const int* abase = (const int*)actG + 8 * r;
    int ci[2][8], ni[2][8], ca[2][8], na[2][8]; f32x4 cx, nx;
    { const int t0 = PEER_TOK(ws), t1 = PEER_TOK(ws + nws);
      PEER_LD8(ci[0], ibase + (size_t)t0 * 128); PEER_LD8(ci[1], ibase + (size_t)t0 * 128 + 64); PEER_LD8(ni[0], ibase + (size_t)t1 * 128); PEER_LD8(ni[1], ibase + (size_t)t1 * 128 + 64);
      PEER_LD8(ca[0], abase + (size_t)t0 * 128); PEER_LD8(ca[1], abase + (size_t)t0 * 128 + 64);
      cx = *(const f32x4*)(OUT + (size_t)t0 * 2048 + 256 * shard + 4 * lane); }
    u32x4 a4[8], b4[8]; u32x2 a2[8], b2[8];
    PEER_ROWS(a4, a2, ci[0]);
    for (int t = ws; t < T_TOK; t += nws) {
        PEER_ROWS(b4, b2, ci[1]);
        { const int t1 = PEER_TOK(t + nws);
          PEER_LD8(na[0], abase + (size_t)t1 * 128); PEER_LD8(na[1], abase + (size_t)t1 * 128 + 64); nx = *(const f32x4*)(OUT + (size_t)t1 * 2048 + 256 * shard + 4 * lane); }
        f32x2 acc[16];
#pragma unroll
        for (int k = 0; k < 16; ++k) acc[k] = (f32x2){0.f, 0.f};
#define PEER_VACC(b4_, b2_, a8_) do { _Pragma("unroll") for (int gq = 0; gq < 8; ++gq) { const float ar = __int_as_float((a8_)[gq]); const f32x2 av2 = {ar, ar}; \
            const u32x6 p6 = {b4_[gq].x, b4_[gq].y, b4_[gq].z, b4_[gq].w, b2_[gq].x, b2_[gq].y}; const f32x32 vv = __builtin_amdgcn_cvt_scalef32_pk32_f32_fp6(p6, 1.0f); \
            _Pragma("unroll") for (int k = 0; k < 16; ++k) acc[k] = (f32x2){vv[2 * k], vv[2 * k + 1]} * av2 + acc[k]; __builtin_amdgcn_sched_barrier(0); } } while (0)
        PEER_VACC(a4, a2, ca[0]);
        PEER_ROWS(a4, a2, ni[0]);
#pragma unroll
        for (int q = 0; q < 8; ++q) { ci[0][q] = ni[0][q]; ci[1][q] = ni[1][q]; }
        { const int t2 = PEER_TOK(t + 2 * nws); PEER_LD8(ni[0], ibase + (size_t)t2 * 128); PEER_LD8(ni[1], ibase + (size_t)t2 * 128 + 64); }
        PEER_VACC(b4, b2, ca[1]);
        { LAS float* w = red + (r * 8 + c) * 36;
#pragma unroll
          for (int q = 0; q < 4; ++q) { *(LAS f32x4*)(w + 4 * q) = (f32x4){acc[4 * q].x, acc[4 * q + 1].x, acc[4 * q + 2].x, acc[4 * q + 3].x};
              *(LAS f32x4*)(w + 16 + 4 * q) = (f32x4){acc[4 * q].y, acc[4 * q + 1].y, acc[4 * q + 2].y, acc[4 * q + 3].y}; } }
        LDS_WAIT();
        { f32x4 s = {0.f, 0.f, 0.f, 0.f}; const LAS float* rd = red + (lane >> 3) * 36 + 4 * (lane & 7);
#pragma unroll
          for (int rr = 0; rr < 8; ++rr) s += *(const LAS f32x4*)(rd + rr * 288);
          const int b = t >> 13; const float* gt2 = mod + (size_t)b * 12288 + 10240 + 256 * shard + 4 * lane; float* op = OUT + (size_t)t * 2048 + 256 * shard + 4 * lane;
          const f32x4 g0 = *(const f32x4*)gt2;
          if (!DRY) *(f32x4*)op = cx + g0 * s; else asm volatile("" :: "v"(s), "v"(g0)); }
        LDS_WAIT();
#pragma unroll
        for (int q = 0; q < 8; ++q) { ca[0][q] = na[0][q]; ca[1][q] = na[1][q]; }
        cx = nx;
    }
#undef PEER_VACC
}
#undef PEER_ROWS
#undef PEER_LD8
#undef PEER_TOK

__global__ void __launch_bounds__(512, 2) mk_fwd(Args args) {
    extern __shared__ __attribute__((aligned(16))) unsigned char lds_raw[];
    LAS unsigned char* lds = (LAS unsigned char*)lds_raw;
    const int tid = threadIdx.x, lane = tid & 63, wave = __builtin_amdgcn_readfirstlane(tid >> 6);
    const int G = gridDim.x, gw = blockIdx.x * 8 + wave, ngw = G * 8;
    unsigned char* ws = args.ws;
    volatile LAS unsigned* misc = (volatile LAS unsigned*)(lds + LDS_MAIN);
    if (tid < 4) misc[tid] = 0u;
    __syncthreads();
    const int lo = args.ph_lo, hi = args.ph_hi;
    XcdBarrier bar; bar.bar = (unsigned*)(ws + WS_CTL); bar.x = 0; bar.st = misc;
    if (hi - lo > 1) bar = xcd_barrier_post((unsigned*)(ws + WS_CTL), misc);
#ifndef PHMASK
#define PHMASK 0x3fff
#endif
#define IN(k) (((PHMASK >> (k)) & 1) && lo <= (k) && (k) < hi)
#define SEAM(k) do { if (IN(k) && IN((k) + 1)) xcd_barrier(bar); } while (0)
    float* mod = (float*)(ws + WS_MOD);
    bf16_t* HB = (bf16_t*)(ws + WS_H); bf16_t* PA = (bf16_t*)(ws + WS_PA); bf16_t* PG = (bf16_t*)(ws + WS_PG);
    bf16_t* YA = (bf16_t*)(ws + WS_YA); bf16_t* ATT = (bf16_t*)(ws + WS_ATT); f32x2* EB = (f32x2*)(ws + WS_E); bf16_t* UBp = (bf16_t*)(ws + WS_UB);

#define PHS(code, ...) do { __VA_ARGS__ if (DUP == (code)) { xcd_barrier(bar); __VA_ARGS__ } } while (0)
#define PH(k, ...) do { if (IN(k)) { __VA_ARGS__ if (DUP == (k)) { xcd_barrier(bar); __VA_ARGS__ } } } while (0)
    PH(0, { ph_mod_partial(args.in[I_C], args.in[I_WADA], (float*)(ws + WS_MODP), gw, ngw, lane); ph_colmax_partial(args.in[I_WIN], (float*)(ws + WS_CMAXP), gw, ngw, lane); });
    SEAM(0);
    PH(1, { ph_prologue(args, lds, gw, ngw, lane, wave); });
    SEAM(1);
    PH(2, { ph_norm<true>(args.in[I_X], HB, (float*)(ws + WS_SA), args.in[I_N1G], mod, 0, 2048, gw, ngw, lane); });
    SEAM(2);
    PH(3, { pg8::Gemm g{HB, (const bf16_t*)(ws + WS_WIN), T_TOK, 8192, 1024}; pg8::StaticOrder S; S.init(T_TOK, 8192, G, (int)blockIdx.x);
        pg8::EpiProj E{PA, PG, UBp, (const float*)(ws + WS_SA), (const float*)(ws + WS_SB)}; pg8::gemm_phase<pg8::EpiProj, pg8::StaticOrder, true, true, 1>(lds, g, S, E); });
    SEAM(3);
    PH(4, { PHS(41, { ph_attn<0>(lds, PA, ATT, args.in[I_QNG], args.in[I_KNG], G); __syncthreads(); });
        if (DUP == 411) { xcd_barrier(bar); ph_attn<1>(lds, PA, ATT, args.in[I_QNG], args.in[I_KNG], G); __syncthreads(); } PHS(42, { ph_ssm_mfma<false>(args, lds, UBp, EB, YA, G); }); });
    SEAM(4);
    PH(5, { PHS(51, { ph_ssm_mfma<true>(args, lds, UBp, EB, YA, G); __syncthreads(); });
        PHS(52, { pg8::Gemm g{ATT, (const bf16_t*)(ws + WS_WATT), T_TOK, 2048, 512}; pg8::SplitOrder S; S.init(T_TOK, 2048, G, (int)blockIdx.x);
        pg8::EpiAttUp E{PG, HB}; pg8::gemm_phase<pg8::EpiAttUp, pg8::SplitOrder, true, true, 2>(lds, g, S, E); }); });
    SEAM(5);
    PH(6, { pg8::Gemm g{YA, (const bf16_t*)(ws + WS_WGLU), T_TOK, 4096, 512}; pg8::StaticOrder S; S.init(T_TOK, 4096, G, (int)blockIdx.x);
        pg8::EpiGlu E{PG, HB, (unsigned char*)ATT}; pg8::gemm_phase<pg8::EpiGlu, pg8::StaticOrder, true, true, 2>(lds, g, S, E); });
    SEAM(6);
    PH(7, { pg8::Gemm g{ATT, (const bf16_t*)(ws + WS_WOUT), T_TOK, 2048, 1024}; pg8::StaticOrder S; S.init(T_TOK, 2048, G, (int)blockIdx.x);
        pg8::EpiOut E{args.in[I_X], args.out, mod}; pg8::gemm_phase<pg8::EpiOut, pg8::StaticOrder, true, true, 2>(lds, g, S, E);
        ph_table_cvt(args.in[I_PU], args.in[I_PV], ws + WS_UT, ws + WS_VT, gw, ngw, lane); });
    SEAM(7);
    PH(8, { ph_norm<false>(args.out, HB, nullptr, args.in[I_N2G], mod, 6144, 8192, gw, ngw, lane); });
    SEAM(8);
    PH(9, { pg8::Gemm g{HB, (const bf16_t*)(ws + WS_WSC), T_TOK, 2048, 2048}; pg8::StaticOrder S; S.init(T_TOK, 2048, G, (int)blockIdx.x);
        pg8::EpiF32 E{(float*)(ws + WS_SC)}; pg8::gemm_phase<pg8::EpiF32, pg8::StaticOrder, true, true>(lds, g, S, E); });
    SEAM(9);
    PH(10, { ph_peer_topk(lds, (const float*)(ws + WS_SC), (int*)(ws + WS_IDX), (float*)(ws + WS_GATE), G); });
    SEAM(10);
    PH(11, { ph_peer_u(ws + WS_UT, HB, (const int*)(ws + WS_IDX), (float*)(ws + WS_PDOT), G); });
    SEAM(11);
    PH(12, { ph_peer_act((const float*)(ws + WS_PDOT), (const float*)(ws + WS_GATE), (float*)(ws + WS_ACT), G); });
    SEAM(12);
    if (IN(13)) { if (DUP == 13) { ph_peer_v<true>(lds, ws + WS_VT, (const int*)(ws + WS_IDX), (const float*)(ws + WS_ACT), mod, args.out, G); xcd_barrier(bar); }
        ph_peer_v<false>(lds, ws + WS_VT, (const int*)(ws + WS_IDX), (const float*)(ws + WS_ACT), mod, args.out, G); }
#undef IN
#undef SEAM
}

extern "C" void kernel_launch(void* const* d_in, const int* in_sizes, int n_in, void* d_out, int out_size, void* d_ws, size_t ws_size, hipStream_t stream) {
    static int grid = 0;
    if (grid == 0) {
        if (n_in != 25 || out_size != T_TOK * DM || ws_size < WS_END) { fprintf(stderr, "kernel_launch: unexpected shapes (n_in %d out %d ws %zu need %zu)\n", n_in, out_size, ws_size, (size_t)WS_END); grid = -1; return; }
        int dev = 0, cus = 0, per_cu = 0;
        if (hipGetDevice(&dev) != hipSuccess || hipDeviceGetAttribute(&cus, hipDeviceAttributeMultiprocessorCount, dev) != hipSuccess) { grid = -1; return; }
        if (hipFuncSetAttribute((const void*)mk_fwd, hipFuncAttributeMaxDynamicSharedMemorySize, LDS_BYTES) != hipSuccess) { fprintf(stderr, "kernel_launch: hipFuncSetAttribute failed\n"); grid = -1; return; }
        if (hipOccupancyMaxActiveBlocksPerMultiprocessor(&per_cu, (const void*)mk_fwd, 512, LDS_BYTES) != hipSuccess || per_cu < 1) { fprintf(stderr, "kernel_launch: occupancy query says %d blocks/CU\n", per_cu); (void)hipGetLastError(); grid = -1; return; }
        grid = cus;
    }
    if (grid < 0) return;
    (void)hipMemsetAsync((char*)d_ws + WS_CTL, 0, 16384, stream);
    Args a{};
    for (int i = 0; i < 25; ++i) a.in[i] = (const float*)d_in[i];
    a.out = (float*)d_out; a.ws = (unsigned char*)d_ws;
#if MK_PER_PHASE
    for (int ph = 0; ph < NPHASE; ++ph) { a.ph_lo = ph; a.ph_hi = ph + 1; hipLaunchKernelGGL(mk_fwd, dim3(grid), dim3(512), LDS_BYTES, stream, a); }
#else
    a.ph_lo = 0; a.ph_hi = NPHASE;
    hipLaunchKernelGGL(mk_fwd, dim3(grid), dim3(512), LDS_BYTES, stream, a);
#endif
}
```

```cpp
#include <hip/hip_runtime.h>
#include <cstdio>
#include <cstdint>

#ifndef MK_PER_PHASE
#define MK_PER_PHASE 0
#endif

#ifndef DUP
#define DUP -1
#endif
#define LAS __attribute__((address_space(3)))
typedef unsigned short bf16_t;
typedef short bf16x8 __attribute__((ext_vector_type(8)));
typedef float f32x4 __attribute__((ext_vector_type(4)));
typedef float f32x2 __attribute__((ext_vector_type(2)));
typedef unsigned u32x4 __attribute__((ext_vector_type(4)));
typedef unsigned u32x2 __attribute__((ext_vector_type(2)));
typedef int i32x4 __attribute__((ext_vector_type(4)));

constexpr int T_TOK = 16384, DM = 2048, SEQ = 8192;
constexpr int NPHASE = 14;
constexpr float EPS = 1e-6f;

constexpr size_t WS_CTL   = 0;
constexpr size_t WS_MODP  = 65536;
constexpr size_t WS_MOD   = WS_MODP + (size_t)32 * 2 * 12288 * 4;
constexpr size_t WS_WIN   = WS_MOD + (size_t)2 * 12288 * 4;
constexpr size_t WS_WGLU  = WS_WIN + (size_t)8192 * 2048 * 2;
constexpr size_t WS_WATT  = WS_WGLU + (size_t)4096 * 1024 * 2;
constexpr size_t WS_WOUT  = WS_WATT + (size_t)2048 * 1024 * 2;
constexpr size_t WS_WSC   = WS_WOUT + (size_t)2048 * 2048 * 2;
constexpr size_t WS_H     = WS_WSC + (size_t)2048 * 2048 * 2;
constexpr size_t WS_PA    = WS_H + (size_t)T_TOK * 2048 * 2;
constexpr size_t WS_PG    = WS_PA + (size_t)T_TOK * 4096 * 2;
constexpr size_t WS_E     = WS_PG + (size_t)T_TOK * 4096 * 2;
constexpr size_t WS_YA    = WS_E + (size_t)2 * 64 * 128 * 64 * 8;
constexpr size_t WS_ATT   = WS_YA + (size_t)T_TOK * 1024 * 2;
constexpr size_t WS_UB    = WS_ATT + (size_t)T_TOK * 1024 * 2;
constexpr size_t WS_SA    = WS_UB + (size_t)T_TOK * 1024 * 2;
constexpr size_t WS_SB    = WS_SA + (size_t)T_TOK * 4;
constexpr size_t WS_CMAXP = WS_SB + (size_t)8192 * 4;
constexpr size_t WS_END   = WS_CMAXP + (size_t)32 * 8192 * 4;
constexpr size_t WS_SC    = WS_PA;
constexpr size_t WS_UT    = WS_PG;
constexpr size_t WS_VT    = WS_PG + (size_t)8 * 16384 * 192;
constexpr size_t WS_PDOT  = WS_VT + (size_t)8 * 16384 * 192;
constexpr size_t WS_IDX   = WS_YA;
constexpr size_t WS_GATE  = WS_YA + (size_t)T_TOK * 128 * 4;
constexpr size_t WS_ACT   = WS_GATE + (size_t)T_TOK * 128 * 4;
static_assert(WS_PDOT + (size_t)8 * T_TOK * 128 * 4 <= WS_PG + (size_t)T_TOK * 4096 * 2, "PEER buffers must fit the dead g_ssm|g_att region");
static_assert(WS_ACT + (size_t)T_TOK * 128 * 4 <= WS_YA + (size_t)T_TOK * 1024 * 2, "PEER index buffers must fit the dead YA region");
constexpr int LDS_MAIN = 131072, LDS_BYTES = LDS_MAIN + 256;

typedef __bf16 bf16x2_t __attribute__((ext_vector_type(2)));
__device__ __forceinline__ unsigned cvt_pk_bf16(float lo, float hi) { const f32x2 v = {lo, hi}; return __builtin_bit_cast(unsigned, __builtin_convertvector(v, bf16x2_t)); }
__device__ __forceinline__ float bf_lo(unsigned w) { return __uint_as_float(w << 16); }
__device__ __forceinline__ float bf_hi(unsigned w) { return __uint_as_float(w & 0xffff0000u); }
__device__ __forceinline__ float wave_sum(float v) {
#pragma unroll
    for (int o = 1; o < 64; o <<= 1) v += __shfl_xor(v, o);
    return v;
}
__device__ __forceinline__ float sigmoidf_(float x) { return 1.0f / (1.0f + __expf(-x)); }
__device__ __forceinline__ float gelu_tanh(float x) {
    const float a = 0.7978845608028654f * (x + 0.044715f * x * x * x);
    const float t = 1.0f - 2.0f / (__expf(2.0f * a) + 1.0f);
    return 0.5f * x * (1.0f + t);
}
constexpr float F8_SA = 8.0f, F8_SW = 64.0f, F8_INV = 1.0f / 512.0f;
__device__ __forceinline__ unsigned pack4_fp8(float a, float b, float c, float d, float sc) {
    a = fminf(fmaxf(a * sc, -448.f), 448.f); b = fminf(fmaxf(b * sc, -448.f), 448.f); c = fminf(fmaxf(c * sc, -448.f), 448.f); d = fminf(fmaxf(d * sc, -448.f), 448.f);
    int p = 0; p = __builtin_amdgcn_cvt_pk_fp8_f32(a, b, p, false); p = __builtin_amdgcn_cvt_pk_fp8_f32(c, d, p, true); return (unsigned)p; }
__device__ __forceinline__ float sum8_dpp(float v) {
    v += __builtin_bit_cast(float, __builtin_amdgcn_update_dpp(0, __builtin_bit_cast(int, v), 0xB1, 0xF, 0xF, true));
    v += __builtin_bit_cast(float, __builtin_amdgcn_update_dpp(0, __builtin_bit_cast(int, v), 0x4E, 0xF, 0xF, true));
    v += __builtin_bit_cast(float, __builtin_amdgcn_update_dpp(0, __builtin_bit_cast(int, v), 0x141, 0xF, 0xF, true));
    return v; }
#define LDS_WAIT() asm volatile("s_waitcnt lgkmcnt(0)" ::: "memory")
__device__ __forceinline__ int opaque_tid() { int t = threadIdx.x; asm volatile("" : "+v"(t)); return t; }

#define XB_TMO      128
#define XB_XCNT(j)  (256  + 64 * (j))
#define XB_XSUB(j)  (1280 + 64 * (j))
#define XB_XGEN(j)  (2304 + 64 * (j))
#define XB_TOP      3328
#define XB_TOPGEN   3392
#define XCD_BAR_WORDS 3456
#define XB_SPIN_CAP (1u << 22)
__device__ __forceinline__ unsigned xb_ld(unsigned* p)              { return __hip_atomic_load(p, __ATOMIC_RELAXED, __HIP_MEMORY_SCOPE_AGENT); }
__device__ __forceinline__ unsigned xb_add(unsigned* p, unsigned v) { return __hip_atomic_fetch_add(p, v, __ATOMIC_RELAXED, __HIP_MEMORY_SCOPE_AGENT); }
__device__ __forceinline__ unsigned xb_xcc_id() { return (unsigned)__builtin_amdgcn_s_getreg((3 << 11) | 20) & 0xFu; }
#define XB_SPIN(cond, bar) do { unsigned _sp = 0; while (cond) { __builtin_amdgcn_s_sleep(1); \
    if ((++_sp & 255u) == 0u) { if (xb_ld(&(bar)[XB_TMO])) break; if (_sp > XB_SPIN_CAP) { atomicAdd(&(bar)[XB_TMO], 1u); break; } } } } while (0)
struct XcdBarrier { unsigned* bar; unsigned x; volatile LAS unsigned* st; };
__device__ __forceinline__ XcdBarrier xcd_barrier_post(unsigned* bar, volatile LAS unsigned* st) {
    XcdBarrier b; b.bar = bar; b.x = xb_xcc_id(); b.st = st;
    if (threadIdx.x == 0) (void)xb_add(&bar[XB_XCNT(b.x)], 1u);
    return b;
}
__device__ __forceinline__ void xcd_barrier_complete(unsigned* bar, unsigned x, unsigned& nloc, unsigned& nx) {
    const unsigned G = gridDim.x * gridDim.y * gridDim.z;
    unsigned sum, cnt, mine, sp = 0u;
    for (;;) {
        sum = 0u; cnt = 0u; mine = 0u;
#pragma unroll
        for (unsigned j = 0; j < 16; ++j) { const unsigned c = xb_ld(&bar[XB_XCNT(j)]); sum += c; cnt += (c > 0u) ? 1u : 0u; mine = (j == x) ? c : mine; }
        if (sum == G) break;
        __builtin_amdgcn_s_sleep(1);
        if ((++sp & 255u) == 0u) { if (xb_ld(&bar[XB_TMO])) break; if (sp > XB_SPIN_CAP) { atomicAdd(&bar[XB_TMO], 1u); break; } }
    }
    nloc = mine > 0u ? mine : 1u; nx = cnt > 0u ? cnt : 1u;
}
__device__ __forceinline__ void xcd_barrier(const XcdBarrier& b) {
    asm volatile("s_waitcnt vmcnt(0)" ::: "memory");
    __syncthreads();
    if (threadIdx.x == 0) {
        unsigned* bar = b.bar;
        __builtin_amdgcn_s_waitcnt(0);
        unsigned nloc = b.st[0], nx = b.st[1];
        if (nloc == 0u) { xcd_barrier_complete(bar, b.x, nloc, nx); b.st[0] = nloc; b.st[1] = nx; }
        const unsigned old = xb_add(&bar[XB_XSUB(b.x)], 1u);
        const unsigned gen = old / nloc;
        if (old + 1u == (gen + 1u) * nloc) {
            __builtin_amdgcn_fence(__ATOMIC_RELEASE, "agent");
            asm volatile("s_waitcnt vmcnt(0)" ::: "memory");
            const unsigned og = xb_add(&bar[XB_TOP], 1u);
            const unsigned tg = og / nx;
            if (og + 1u == (tg + 1u) * nx) xb_add(&bar[XB_TOPGEN], 1u);
            else XB_SPIN(xb_ld(&bar[XB_TOPGEN]) == tg, bar);
            __builtin_amdgcn_fence(__ATOMIC_ACQUIRE, "agent");
            xb_add(&bar[XB_XGEN(b.x)], 1u);
            asm volatile("s_waitcnt vmcnt(0)" ::: "memory");
        } else {
            XB_SPIN(xb_ld(&bar[XB_XGEN(b.x)]) == gen, bar);
            __builtin_amdgcn_fence(__ATOMIC_ACQUIRE, "agent");
            asm volatile("s_waitcnt vmcnt(0)" ::: "memory");
        }
    }
    __syncthreads();
}

namespace pg8 {
constexpr int BM = 256, BK = 64, HALF = 128, HTB = HALF * BK * 2, STAGE_BYTES = 8 * HTB, NXCD = 8, WGM = 8;
__host__ __device__ __forceinline__ int lds_byte(int r, int c) { const int st = (r >> 4) * 2 + (c >> 5), rr = r & 15, cc = c & 31, ob = rr * 64 + cc * 2; return st * 1024 + (ob ^ (((ob >> 9) & 1) << 5)); }
__host__ __device__ __forceinline__ void stage_rc(int b, int& R, int& C) { const int st = b / 1024, sb = b % 1024, swz = sb ^ (((sb >> 9) & 1) << 5); R = (st >> 1) * 16 + swz / 64; C = (st & 1) * 32 + (swz % 64) / 2; }
__host__ __device__ __forceinline__ int perm32(int rho) { const int n = rho >> 4, i = rho & 15; return 8 * (i >> 2) + 4 * n + (i & 3); }
struct Unit { int pm, pn; };
struct Gemm { const bf16_t* A; const bf16_t* Bt; int M, N, K; };
struct StaticOrder {
    int nM, nN, nwg, G, c;
    __host__ __device__ void init(int M, int N, int G_, int c_) { nM = M / BM; nN = N / BM; nwg = nM * nN; G = G_; c = c_; }
    __host__ __device__ bool next(int i, Unit& u) const { return at((long)i * G + c, u); }
    __host__ __device__ bool at(long L, Unit& u) const {
        if (L >= nwg) return false;
        int wgid = (int)L; { const int q = nwg / NXCD, r = nwg % NXCD, xcd = wgid % NXCD, off = wgid / NXCD; wgid = (xcd < r ? xcd * (q + 1) : r * (q + 1) + (xcd - r) * q) + off; }
        const int nig = WGM * nN, gid = wgid / nig, fm = gid * WGM, gsz = (nM - fm) < WGM ? (nM - fm) : WGM;
        u.pm = fm + ((wgid % nig) % gsz); u.pn = (wgid % nig) / gsz; return true;
    }
    __device__ __forceinline__ void a_ready(const Unit&) const {}
    __device__ __forceinline__ void done(const Unit&) const {}
};
struct SplitOrder {
    StaticOrder b;
    __host__ __device__ void init(int M, int N, int G_, int c_) { b.init(M, N, G_, c_); }
    __host__ __device__ bool next(int i, Unit& u) const {
        if (b.G != 256 || b.nwg != 512) return b.next(i, u);
        if (b.c < 128) return false;
        return i < 4 ? b.at((b.c - 128) * 4 + i, u) : false;
    }
    __device__ __forceinline__ void a_ready(const Unit&) const {}
    __device__ __forceinline__ void done(const Unit&) const {}
};
typedef int i32x8 __attribute__((ext_vector_type(8)));
template <class Epi, class Sched, bool ALIGN_EPI = false, bool SP2 = false, int MODE = 0>
__device__ __forceinline__ void gemm_phase(LAS unsigned char* lds, const Gemm g, const Sched& S, const Epi& E) {
    const int tid = threadIdx.x, wid = __builtin_amdgcn_readfirstlane(tid >> 6), lane = tid & 63, wr = wid >> 2, wc = wid & 3, fr = lane & 15, fq = lane >> 4;
    const int K = g.K, nt = K / BK;
    unsigned voffA[2], voffB[2];
#pragma unroll
    for (int i = 0; i < 2; ++i) { int R, C; stage_rc(tid * 16 + i * 8192, R, C); const int Rb = Epi::PERM ? ((R & ~31) + perm32(R & 31)) : R;
        voffA[i] = (unsigned)(R * K + C) * 2u; voffB[i] = (unsigned)(Rb * K + C) * 2u; }
    const size_t kstep = (size_t)(BK * 2);
    const size_t hstep = (size_t)HALF * K * 2;
    const size_t tstep = 2 * hstep;
    const unsigned ldsw = (unsigned)wid * 1024u;
    const int aoff = lds_byte(wr * 64 + fr, fq * 8), boff = lds_byte(wc * 32 + fr, fq * 8);
#define PG8_SA(b, h) (((b) * 2 + (h)) * HTB)
#define PG8_SB(b, h) ((4 + (b) * 2 + (h)) * HTB)
#define PG8_STAGE(bufoff, gbase, voff) do { _Pragma("unroll") for (int _i = 0; _i < 2; ++_i) \
        __builtin_amdgcn_global_load_lds((const unsigned*)((const char*)(gbase) + (voff)[_i]), (LAS unsigned*)(lds + (bufoff) + ldsw + _i * 8192), 16, 0, 0); } while (0)
#define PG8_LD8(p_) ({ const i32x4 _lo = *(const LAS i32x4*)(p_), _hi = *(const LAS i32x4*)((p_) + 1024); (i32x8){_lo[0], _lo[1], _lo[2], _lo[3], _hi[0], _hi[1], _hi[2], _hi[3]}; })
#define PG8_LDA(dst, b, h) do { _Pragma("unroll") for (int m = 0; m < 4; ++m) dst[m] = PG8_LD8(lds + PG8_SA(b, h) + aoff + m * 2048); } while (0)
#define PG8_LDB(dst, b, h) do { _Pragma("unroll") for (int n = 0; n < 2; ++n) dst[n] = PG8_LD8(lds + PG8_SB(b, h) + boff + n * 2048); } while (0)
#define PG8_HALF(v, k) ((k) == 0 ? __builtin_shufflevector(v, v, 0, 1, 2, 3) : __builtin_shufflevector(v, v, 4, 5, 6, 7))
#define PG8_MMA(ai, bj, At, Bt) do { __builtin_amdgcn_s_setprio(1); _Pragma("unroll") for (int m = 0; m < 4; ++m) _Pragma("unroll") for (int n = 0; n < 2; ++n) { \
        if (MODE == 2) asm volatile("v_mfma_scale_f32_16x16x128_f8f6f4 %0, %1, %2, %0, %3, %3 op_sel_hi:[0,0,0]" : "+v"(acc[ai][bj][m][n]) : "v"(Bt[n]), "v"(At[m]), "v"(scl1)); \
        else { _Pragma("unroll") for (int k = 0; k < 2; ++k) \
            acc[ai][bj][m][n] = (MODE == 1) ? __builtin_bit_cast(f32x4, __builtin_amdgcn_mfma_i32_16x16x64_i8(PG8_HALF(Bt[n], k), PG8_HALF(At[m], k), __builtin_bit_cast(i32x4, acc[ai][bj][m][n]), 0, 0, 0)) \
                                            : __builtin_amdgcn_mfma_f32_16x16x32_bf16(__builtin_bit_cast(bf16x8, PG8_HALF(Bt[n], k)), __builtin_bit_cast(bf16x8, PG8_HALF(At[m], k)), acc[ai][bj][m][n], 0, 0, 0); } } __builtin_amdgcn_s_setprio(0); } while (0)
#define PG8_WAIT_V(n) asm volatile("s_waitcnt vmcnt(" #n ")" ::: "memory")
#define PG8_WAIT_L(n) asm volatile("s_waitcnt lgkmcnt(" #n ")" ::: "memory")
#define PG8_BAR __builtin_amdgcn_s_barrier()
#define PG8_SCHED __builtin_amdgcn_sched_barrier(0)
    const int scl1 = 0x7f7f7f7f;
    Unit cur, nxt; int ui = 0;
    if (!S.next(0, cur)) return;
    f32x4 acc[2][2][4][2];
#pragma unroll
    for (int a = 0; a < 2; ++a)
#pragma unroll
        for (int b = 0; b < 2; ++b)
#pragma unroll
            for (int m = 0; m < 4; ++m)
#pragma unroll
                for (int n = 0; n < 2; ++n) acc[a][b][m][n] = (f32x4){0.f, 0.f, 0.f, 0.f};
    i32x8 At[4], B0[2], B1[2];
    const char* cA = (const char*)g.A + (size_t)cur.pm * tstep; const char* cB = (const char*)g.Bt + (size_t)cur.pn * tstep;
    S.a_ready(cur);
    if constexpr (SP2) {
        PG8_STAGE(PG8_SB(0, 0), cB, voffB); PG8_STAGE(PG8_SB(0, 1), cB + hstep, voffB); PG8_STAGE(PG8_SA(0, 0), cA, voffA); PG8_STAGE(PG8_SA(0, 1), cA + hstep, voffA);
        if (wr == 1) PG8_BAR;
        PG8_WAIT_V(2); PG8_BAR;
        PG8_STAGE(PG8_SB(1, 0), cB + kstep, voffB); PG8_STAGE(PG8_SA(1, 0), cA + kstep, voffA); PG8_STAGE(PG8_SB(1, 1), cB + hstep + kstep, voffB);
        PG8_WAIT_V(6); PG8_BAR;
    } else {
        PG8_STAGE(PG8_SB(0, 0), cB, voffB); PG8_STAGE(PG8_SA(0, 0), cA, voffA); PG8_STAGE(PG8_SB(0, 1), cB + hstep, voffB); PG8_STAGE(PG8_SA(0, 1), cA + hstep, voffA);
        if (wr == 1) PG8_BAR;
        PG8_WAIT_V(4); PG8_BAR;
        PG8_STAGE(PG8_SB(1, 0), cB + kstep, voffB); PG8_STAGE(PG8_SA(1, 0), cA + kstep, voffA); PG8_STAGE(PG8_SB(1, 1), cB + hstep + kstep, voffB);
        PG8_WAIT_V(6); PG8_BAR;
    }
    for (;;) {
        const bool has_next = S.next(ui + 1, nxt);
        const char* nA = has_next ? (const char*)g.A + (size_t)nxt.pm * tstep : cA; const char* nB = has_next ? (const char*)g.Bt + (size_t)nxt.pn * tstep : cB;
#pragma unroll 1
        for (int t = 0; t < nt; t += 2) {
            const bool last = (t == nt - 2);
            const char* a1 = cA + (size_t)(t + 1) * kstep;
            const char* a2 = last ? nA : cA + (size_t)(t + 2) * kstep; const char* b2 = last ? nB : cB + (size_t)(t + 2) * kstep;
            const char* a3 = a2 + kstep; const char* b3 = b2 + kstep;
            if (last && has_next) S.a_ready(nxt);
            if constexpr (SP2) {
            PG8_LDB(B0, 0, 0); PG8_LDB(B1, 0, 1); PG8_SCHED; PG8_LDA(At, 0, 0); PG8_STAGE(PG8_SA(1, 1), a1 + hstep, voffA);
            PG8_WAIT_V(8); PG8_WAIT_L(0); PG8_BAR; PG8_MMA(0, 0, At, B0); PG8_MMA(0, 1, At, B1); PG8_BAR; PG8_SCHED;
            PG8_LDA(At, 0, 1); PG8_STAGE(PG8_SB(0, 0), b2, voffB); PG8_STAGE(PG8_SB(0, 1), b2 + hstep, voffB); PG8_STAGE(PG8_SA(0, 0), a2, voffA);
            PG8_WAIT_V(8); PG8_WAIT_L(0); PG8_BAR; PG8_MMA(1, 0, At, B0); PG8_MMA(1, 1, At, B1); PG8_BAR; PG8_SCHED;
            PG8_LDB(B0, 1, 0); PG8_LDB(B1, 1, 1); PG8_SCHED; PG8_LDA(At, 1, 0); PG8_STAGE(PG8_SA(0, 1), a2 + hstep, voffA);
            PG8_WAIT_V(8); PG8_WAIT_L(0); PG8_BAR; PG8_MMA(0, 0, At, B0); PG8_MMA(0, 1, At, B1); PG8_BAR; PG8_SCHED;
            PG8_LDA(At, 1, 1); PG8_STAGE(PG8_SB(1, 0), b3, voffB); PG8_STAGE(PG8_SB(1, 1), b3 + hstep, voffB); PG8_STAGE(PG8_SA(1, 0), a3, voffA);
            PG8_WAIT_V(8); PG8_WAIT_L(0); PG8_BAR; PG8_MMA(1, 0, At, B0); PG8_MMA(1, 1, At, B1); PG8_BAR; PG8_SCHED;
            } else {
            PG8_LDB(B0, 0, 0); PG8_SCHED; PG8_LDA(At, 0, 0); PG8_STAGE(PG8_SA(1, 1), a1 + hstep, voffA);
            PG8_WAIT_L(8); PG8_BAR; PG8_WAIT_L(0); PG8_MMA(0, 0, At, B0); PG8_BAR; PG8_SCHED;
            PG8_LDB(B1, 0, 1); PG8_STAGE(PG8_SB(0, 0), b2, voffB);
            PG8_BAR; PG8_WAIT_L(0); PG8_MMA(0, 1, At, B1); PG8_BAR;
            PG8_LDA(At, 0, 1); PG8_STAGE(PG8_SA(0, 0), a2, voffA);
            PG8_BAR; PG8_WAIT_L(0); PG8_MMA(1, 0, At, B0); PG8_BAR; PG8_SCHED;
            PG8_STAGE(PG8_SB(0, 1), b2 + hstep, voffB);
            PG8_WAIT_V(6); PG8_BAR; PG8_MMA(1, 1, At, B1); PG8_BAR;
            PG8_LDB(B0, 1, 0); PG8_SCHED; PG8_LDA(At, 1, 0); PG8_STAGE(PG8_SA(0, 1), a2 + hstep, voffA);
            PG8_WAIT_L(8); PG8_BAR; PG8_WAIT_L(0); PG8_MMA(0, 0, At, B0); PG8_BAR; PG8_SCHED;
            PG8_LDB(B1, 1, 1); PG8_STAGE(PG8_SB(1, 0), b3, voffB);
            PG8_BAR; PG8_WAIT_L(0); PG8_MMA(0, 1, At, B1); PG8_BAR;
            PG8_LDA(At, 1, 1); PG8_STAGE(PG8_SA(1, 0), a3, voffA);
            PG8_BAR; PG8_WAIT_L(0); PG8_MMA(1, 0, At, B0); PG8_BAR; PG8_SCHED;
            PG8_STAGE(PG8_SB(1, 1), b3 + hstep, voffB);
            PG8_WAIT_V(6); PG8_BAR; PG8_MMA(1, 1, At, B1); PG8_BAR;
            }
        }
        if constexpr (ALIGN_EPI) { if (wr == 0) PG8_BAR; }
        if (MODE == 2) asm volatile("s_nop 15\n\ts_nop 15" ::: "memory");
        E(acc, cur, wr, wc, fr, fq); S.done(cur);
        if (!has_next) break;
#pragma unroll
        for (int a = 0; a < 2; ++a)
#pragma unroll
            for (int b = 0; b < 2; ++b)
#pragma unroll
                for (int m = 0; m < 4; ++m)
#pragma unroll
                    for (int n = 0; n < 2; ++n) acc[a][b][m][n] = (f32x4){0.f, 0.f, 0.f, 0.f};
        cur = nxt; cA = nA; cB = nB; ++ui;
        if constexpr (ALIGN_EPI) { if (wr == 1) PG8_BAR; }
    }
    PG8_WAIT_V(0);
    if constexpr (!ALIGN_EPI) { if (wr == 0) PG8_BAR; }
    PG8_BAR;
#undef PG8_SA
#undef PG8_SB
#undef PG8_STAGE
#undef PG8_LDA
#undef PG8_LDB
#undef PG8_MMA
#undef PG8_WAIT_V
#undef PG8_WAIT_L
#undef PG8_BAR
#undef PG8_SCHED
}

struct EpiProj {
    static constexpr bool PERM = true;
    bf16_t* PA; bf16_t* PG; bf16_t* UB; const float* SA; const float* SB;
    __device__ __forceinline__ void operator()(const f32x4 (&acc)[2][2][4][2], const Unit& u, int wr, int wc, int fr, int fq) const {
        const int row0 = u.pm * BM + wr * 64 + fr; int colt = u.pn * BM; const bool isu = colt < 1024; bf16_t* base = colt < 4096 ? PA : PG;
        const int gcol0 = colt + wc * 32 + 8 * fq; colt &= 4095;
        const int col0 = colt + wc * 32 + 8 * fq;
        f32x4 sb[2][2];
#pragma unroll
        for (int bj = 0; bj < 2; ++bj) { sb[bj][0] = *(const f32x4*)(SB + gcol0 + bj * HALF); sb[bj][1] = *(const f32x4*)(SB + gcol0 + bj * HALF + 4); }
#pragma unroll
        for (int ai = 0; ai < 2; ++ai)
#pragma unroll
            for (int m = 0; m < 4; ++m) { const int row = row0 + ai * HALF + m * 16; bf16_t* rowp = base + (size_t)row * 4096 + col0; const float sa = SA[row];
#pragma unroll
                for (int bj = 0; bj < 2; ++bj) { const i32x4 i0 = __builtin_bit_cast(i32x4, acc[ai][bj][m][0]), i1 = __builtin_bit_cast(i32x4, acc[ai][bj][m][1]);
                    f32x4 v0, v1;
#pragma unroll
                    for (int e = 0; e < 4; ++e) { v0[e] = (float)i0[e] * sa * sb[bj][0][e]; v1[e] = (float)i1[e] * sa * sb[bj][1][e]; }
                    u32x4 w; w.x = cvt_pk_bf16(v0[0], v0[1]); w.y = cvt_pk_bf16(v0[2], v0[3]); w.z = cvt_pk_bf16(v1[0], v1[1]); w.w = cvt_pk_bf16(v1[2], v1[3]);
                    if (isu) { const int cu = col0 + bj * HALF; *(u32x4*)(UB + (((size_t)((row >> 13) * 64 + (cu >> 4)) * 8192 + (row & 8191)) * 16 + (cu & 8))) = w; }
                    else *(u32x4*)(rowp + bj * HALF) = w; } }
    }
};
struct EpiAttUp {
    static constexpr bool PERM = true;
    const bf16_t* PG; bf16_t* HB;
    __device__ __forceinline__ void operator()(const f32x4 (&acc)[2][2][4][2], const Unit& u, int wr, int wc, int fr, int fq) const {
        const int row0 = u.pm * BM + wr * 64 + fr; const int col0 = u.pn * BM + wc * 32 + 8 * fq;
#pragma unroll
        for (int ai = 0; ai < 2; ++ai)
#pragma unroll
            for (int m = 0; m < 4; ++m) { const size_t row = (size_t)(row0 + ai * HALF + m * 16);
#pragma unroll
                for (int bj = 0; bj < 2; ++bj) { const int col = col0 + bj * HALF;
                    const u32x4 gw = *(const u32x4*)(PG + row * 4096 + 2048 + col);
                    const f32x4 v0 = acc[ai][bj][m][0] * F8_INV, v1 = acc[ai][bj][m][1] * F8_INV;
                    u32x4 w;
                    w.x = cvt_pk_bf16(v0[0] * sigmoidf_(bf_lo(gw.x)), v0[1] * sigmoidf_(bf_hi(gw.x)));
                    w.y = cvt_pk_bf16(v0[2] * sigmoidf_(bf_lo(gw.y)), v0[3] * sigmoidf_(bf_hi(gw.y)));
                    w.z = cvt_pk_bf16(v1[0] * sigmoidf_(bf_lo(gw.z)), v1[1] * sigmoidf_(bf_hi(gw.z)));
                    w.w = cvt_pk_bf16(v1[2] * sigmoidf_(bf_lo(gw.w)), v1[3] * sigmoidf_(bf_hi(gw.w)));
                    *(u32x4*)(HB + row * 2048 + col) = w; } asm volatile("" ::: "memory"); }
    }
};
struct EpiGlu {
    static constexpr bool PERM = true;
    const bf16_t* PG; const bf16_t* HB; unsigned char* M8;
    __device__ __forceinline__ void operator()(const f32x4 (&acc)[2][2][4][2], const Unit& u, int wr, int wc, int fr, int fq) const {
        const int row0 = u.pm * BM + wr * 64 + fr; const int col = u.pn * HALF + wc * 32 + 8 * fq;
#pragma unroll
        for (int ai = 0; ai < 2; ++ai)
#pragma unroll
            for (int m = 0; m < 4; ++m) { const size_t row = (size_t)(row0 + ai * HALF + m * 16);
                const u32x4 gw = *(const u32x4*)(PG + row * 4096 + col);
                const u32x4 aw = *(const u32x4*)(HB + row * 2048 + col);
                const f32x4 a0 = acc[ai][0][m][0] * F8_INV, a1 = acc[ai][0][m][1] * F8_INV, g0 = acc[ai][1][m][0] * F8_INV, g1 = acc[ai][1][m][1] * F8_INV;
                u32x2 w;
                w.x = pack4_fp8(sigmoidf_(bf_lo(gw.x)) * a0[0] * sigmoidf_(g0[0]) + bf_lo(aw.x), sigmoidf_(bf_hi(gw.x)) * a0[1] * sigmoidf_(g0[1]) + bf_hi(aw.x),
                                sigmoidf_(bf_lo(gw.y)) * a0[2] * sigmoidf_(g0[2]) + bf_lo(aw.y), sigmoidf_(bf_hi(gw.y)) * a0[3] * sigmoidf_(g0[3]) + bf_hi(aw.y), F8_SA);
                w.y = pack4_fp8(sigmoidf_(bf_lo(gw.z)) * a1[0] * sigmoidf_(g1[0]) + bf_lo(aw.z), sigmoidf_(bf_hi(gw.z)) * a1[1] * sigmoidf_(g1[1]) + bf_hi(aw.z),
                                sigmoidf_(bf_lo(gw.w)) * a1[2] * sigmoidf_(g1[2]) + bf_lo(aw.w), sigmoidf_(bf_hi(gw.w)) * a1[3] * sigmoidf_(g1[3]) + bf_hi(aw.w), F8_SA);
                *(u32x2*)(M8 + row * 2048 + col) = w; asm volatile("" ::: "memory"); }
    }
};
struct EpiOut {
    static constexpr bool PERM = true;
    const float* X; float* O; const float* mod;
    __device__ __forceinline__ void operator()(const f32x4 (&acc)[2][2][4][2], const Unit& u, int wr, int wc, int fr, int fq) const {
        const int row0 = u.pm * BM + wr * 64 + fr; const int col0 = u.pn * BM + wc * 32 + 8 * fq;
        const float* gt = mod + (size_t)((u.pm * BM) >> 13) * 12288 + 4096;
#pragma unroll
        for (int bj = 0; bj < 2; ++bj) { const int col = col0 + bj * HALF;
            const f32x4 g0 = *(const f32x4*)(gt + col), g1 = *(const f32x4*)(gt + col + 4);
#pragma unroll
            for (int ai = 0; ai < 2; ++ai)
#pragma unroll
                for (int m = 0; m < 4; ++m) { const size_t off = (size_t)(row0 + ai * HALF + m * 16) * 2048 + col;
                    const f32x4 x0 = *(const f32x4*)(X + off), x1 = *(const f32x4*)(X + off + 4);
                    *(f32x4*)(O + off) = x0 + g0 * (acc[ai][bj][m][0] * F8_INV); *(f32x4*)(O + off + 4) = x1 + g1 * (acc[ai][bj][m][1] * F8_INV); } }
    }
};
struct EpiF32 {
    static constexpr bool PERM = true;
    float* O;
    __device__ __forceinline__ void operator()(const f32x4 (&acc)[2][2][4][2], const Unit& u, int wr, int wc, int fr, int fq) const {
        const int row0 = u.pm * BM + wr * 64 + fr; const int col0 = u.pn * BM + wc * 32 + 8 * fq;
#pragma unroll
        for (int ai = 0; ai < 2; ++ai)
#pragma unroll
            for (int m = 0; m < 4; ++m) { float* rowp = O + (size_t)(row0 + ai * HALF + m * 16) * 2048 + col0;
#pragma unroll
                for (int bj = 0; bj < 2; ++bj) { *(f32x4*)(rowp + bj * HALF) = acc[ai][bj][m][0]; *(f32x4*)(rowp + bj * HALF + 4) = acc[ai][bj][m][1]; } }
    }
};
}

struct Args { const float* in[25]; float* out; unsigned char* ws; int ph_lo, ph_hi; };
enum { I_X = 0, I_C, I_WADA, I_BADA, I_N1G, I_WIN, I_LRE, I_LIM, I_LDT, I_BRE, I_BIM, I_CRE, I_CIM, I_SD, I_WGLU, I_QNG, I_KNG, I_WATT, I_WOUT, I_N2G, I_WQ, I_K1, I_K2, I_PU, I_PV };

__device__ __forceinline__ void ph_mod_partial(const float* __restrict__ c, const float* __restrict__ w_ada, float* modp, int gw, int ngw, int lane) {
    for (int task = gw; task < 48 * 32; task += ngw) {
        const int strip = task % 48, ks = task / 48, n0 = strip * 256 + lane * 4, k0 = ks * 64;
        f32x4 a0 = {0.f, 0.f, 0.f, 0.f}, a1 = {0.f, 0.f, 0.f, 0.f};
#pragma unroll 8
        for (int k = 0; k < 64; ++k) {
            const f32x4 w = *(const f32x4*)(w_ada + (size_t)(k0 + k) * 12288 + n0);
            float c0 = c[k0 + k], c1 = c[2048 + k0 + k];
            c0 = c0 / (1.0f + __expf(-c0)); c1 = c1 / (1.0f + __expf(-c1));
            a0 += c0 * w; a1 += c1 * w;
        }
        *(f32x4*)(modp + (size_t)(ks * 2 + 0) * 12288 + n0) = a0;
        *(f32x4*)(modp + (size_t)(ks * 2 + 1) * 12288 + n0) = a1;
    }
}

__device__ __forceinline__ void ph_colmax_partial(const float* __restrict__ w_in, float* cmaxp, int gw, int ngw, int lane) {
    for (int task = gw; task < 32 * 32; task += ngw) {
        const int strip = task & 31, ks = task >> 5, n0 = strip * 256 + lane * 4, k0 = ks * 64;
        f32x4 m = {0.f, 0.f, 0.f, 0.f};
#pragma unroll 8
        for (int k = 0; k < 64; ++k) { const f32x4 w = *(const f32x4*)(w_in + (size_t)(k0 + k) * 8192 + n0);
            m[0] = fmaxf(m[0], fabsf(w[0])); m[1] = fmaxf(m[1], fabsf(w[1])); m[2] = fmaxf(m[2], fabsf(w[2])); m[3] = fmaxf(m[3], fabsf(w[3])); }
        *(f32x4*)(cmaxp + (size_t)ks * 8192 + n0) = m;
    }
}

__device__ __forceinline__ void transpose_item_f8(const float* __restrict__ W, int K, int N, unsigned char* WT8, int drow0, int scol0, int k0, LAS float* scr, int lane) {
#pragma unroll 8
    for (int i = 0; i < 32; ++i) { const int kk = 2 * i + (lane >> 5); scr[kk * 33 + (lane & 31)] = W[(size_t)(k0 + kk) * N + scol0 + (lane & 31)]; }
    LDS_WAIT();
    const int n = lane >> 1, half = lane & 1;
    const LAS float* s = scr + (32 * half) * 33 + n;
    u32x4 o[2];
#pragma unroll
    for (int q = 0; q < 8; ++q) o[q >> 2][q & 3] = pack4_fp8(s[(4 * q) * 33], s[(4 * q + 1) * 33], s[(4 * q + 2) * 33], s[(4 * q + 3) * 33], F8_SW);
    *(u32x4*)(WT8 + (size_t)(drow0 + n) * K + k0 + 32 * half) = o[0];
    *(u32x4*)(WT8 + (size_t)(drow0 + n) * K + k0 + 32 * half + 16) = o[1];
    LDS_WAIT();
}
__device__ __forceinline__ void transpose_item_i8(const float* __restrict__ W, signed char* WT8, const float* cmaxp, float* SB, int n0, int k0, LAS float* scr, int lane) {
#pragma unroll 8
    for (int i = 0; i < 32; ++i) { const int kk = 2 * i + (lane >> 5); scr[kk * 33 + (lane & 31)] = W[(size_t)(k0 + kk) * 8192 + n0 + (lane & 31)]; }
    const int n = lane >> 1, half = lane & 1;
    float cm = 0.f;
#pragma unroll 8
    for (int ks = 0; ks < 32; ++ks) cm = fmaxf(cm, cmaxp[(size_t)ks * 8192 + n0 + n]);
    const float sb = fmaxf(cm, 1e-30f) * (1.0f / 127.0f), inv = 1.0f / sb;
    if (k0 == 0 && half == 0) SB[n0 + n] = sb;
    LDS_WAIT();
    const LAS float* s = scr + (32 * half) * 33 + n;
    u32x4 o[2];
#pragma unroll
    for (int q = 0; q < 8; ++q) { unsigned w = 0;
#pragma unroll
        for (int e = 0; e < 4; ++e) { const int v = (int)rintf(s[(4 * q + e) * 33] * inv); w |= ((unsigned)v & 0xffu) << (8 * e); }
        o[q >> 2][q & 3] = w; }
    *(u32x4*)(WT8 + (size_t)(n0 + n) * 2048 + k0 + 32 * half) = o[0];
    *(u32x4*)(WT8 + (size_t)(n0 + n) * 2048 + k0 + 32 * half + 16) = o[1];
    LDS_WAIT();
}

__device__ __forceinline__ void transpose_item(const float* __restrict__ W, int K, int N, bf16_t* WT, int drow0, int scol0, int k0, LAS float* scr, int lane) {
#pragma unroll 8
    for (int i = 0; i < 32; ++i) { const int kk = 2 * i + (lane >> 5); scr[kk * 33 + (lane & 31)] = W[(size_t)(k0 + kk) * N + scol0 + (lane & 31)]; }
    LDS_WAIT();
    const int c = lane & 7;
#pragma unroll
    for (int j = 0; j < 4; ++j) { const int n = (lane >> 3) + 8 * j; const LAS float* s = scr + (8 * c) * 33 + n;
        u32x4 o; o.x = cvt_pk_bf16(s[0 * 33], s[1 * 33]); o.y = cvt_pk_bf16(s[2 * 33], s[3 * 33]); o.z = cvt_pk_bf16(s[4 * 33], s[5 * 33]); o.w = cvt_pk_bf16(s[6 * 33], s[7 * 33]);
        *(u32x4*)(WT + (size_t)(drow0 + n) * K + k0 + 8 * c) = o; }
    LDS_WAIT();
}
__device__ __forceinline__ void wsc_item(const float* wq, const float* kk, bf16_t* out, int lane) {
    const int r = lane & 15, q = lane >> 4;
    f32x4 acc[8];
#pragma unroll
    for (int f = 0; f < 8; ++f) acc[f] = (f32x4){0.f, 0.f, 0.f, 0.f};
    const float* ap = kk + r * 128 + 4 * q; const float* bp = wq + (size_t)r * 2048 + 4 * q;
#pragma unroll 2
    for (int d0 = 0; d0 < 128; d0 += 16) {
        const f32x4 bv = *(const f32x4*)(bp + d0);
        f32x4 av[8];
#pragma unroll
        for (int f = 0; f < 8; ++f) av[f] = *(const f32x4*)(ap + f * 2048 + d0);
#pragma unroll
        for (int j = 0; j < 4; ++j)
#pragma unroll
            for (int f = 0; f < 8; ++f) acc[f] = __builtin_amdgcn_mfma_f32_16x16x4f32(av[f][j], bv[j], acc[f], 0, 0, 0);
    }
#pragma unroll
    for (int f = 0; f < 8; ++f)
#pragma unroll
        for (int i = 0; i < 4; ++i) out[(size_t)(16 * f + 4 * q + i) * 2048 + r] = (bf16_t)(cvt_pk_bf16(acc[f][i], 0.f) & 0xffffu);
}
__device__ __forceinline__ void ph_prologue(const Args& a, LAS unsigned char* lds, int gw, int ngw, int lane, int wave) {
    unsigned char* ws = a.ws;
    { const float* modp = (const float*)(ws + WS_MODP); float* mod = (float*)(ws + WS_MOD); const float* b_ada = a.in[I_BADA];
      for (int idx = gw * 64 + lane; idx < 2 * 12288; idx += ngw * 64) { const int b = idx / 12288, n = idx - b * 12288; float s = b_ada[n];
#pragma unroll 8
          for (int ks = 0; ks < 32; ++ks) s += modp[(size_t)(ks * 2 + b) * 12288 + n];
          mod[idx] = s; } }
    for (int item = gw; item < 2048; item += ngw) { const int hj = item >> 7, k0 = (item & 127) * 16;
        wsc_item(a.in[I_WQ] + (size_t)k0 * 2048 + hj * 128, (hj & 1) ? a.in[I_K2] : a.in[I_K1], (bf16_t*)(ws + WS_WSC) + (size_t)(hj * 128) * 2048 + k0, lane); }
    { LAS float* scr = (LAS float*)(lds + wave * 8448);
      constexpr int I_IN = 32 * 256, I_GLU = 16 * 128, I_ATT = 16 * 64, I_OUT = 32 * 64, NIT = I_IN + I_GLU + I_ATT + I_OUT;
      for (int it = gw; it < NIT; it += ngw) {
          int r = it;
          if (r < I_IN) { const int kb = r / 256, nb = r % 256; transpose_item_i8(a.in[I_WIN], (signed char*)(ws + WS_WIN), (const float*)(ws + WS_CMAXP), (float*)(ws + WS_SB), 32 * nb, 64 * kb, scr, lane); continue; } r -= I_IN;
          if (r < I_GLU) { const int kb = r / 128, nb = r % 128, dr = 32 * nb; const int sc = ((dr >> 7) & 1) * 2048 + (dr >> 8) * 128 + (dr & 127);
              transpose_item_f8(a.in[I_WGLU], 1024, 4096, ws + WS_WGLU, dr, sc, 64 * kb, scr, lane); continue; } r -= I_GLU;
          if (r < I_ATT) { const int kb = r / 64, nb = r % 64; transpose_item_f8(a.in[I_WATT], 1024, 2048, ws + WS_WATT, 32 * nb, 32 * nb, 64 * kb, scr, lane); continue; } r -= I_ATT;
          { const int kb = r / 64, nb = r % 64; transpose_item_f8(a.in[I_WOUT], 2048, 2048, ws + WS_WOUT, 32 * nb, 32 * nb, 64 * kb, scr, lane); }
      } }
}

template <bool I8>
__device__ __forceinline__ void ph_norm(const float* X, bf16_t* Hout, float* SA, const float* __restrict__ g, const float* mod, int sh_off, int sc_off, int gw, int ngw, int lane) {
    for (int row = gw; row < T_TOK; row += ngw) {
        const int b = row >> 13;
        const f32x4* xr = (const f32x4*)(X + (size_t)row * DM) + lane;
        f32x4 v[8]; float ss = 0.f;
#pragma unroll
        for (int j = 0; j < 8; ++j) { v[j] = xr[64 * j]; ss += (v[j][0] * v[j][0] + v[j][1] * v[j][1]) + (v[j][2] * v[j][2] + v[j][3] * v[j][3]); }
        ss = wave_sum(ss);
        const float rs = 1.0f / sqrtf(ss * (1.0f / DM) + EPS);
        const float* mb = mod + (size_t)b * 12288;
        float amax = 0.f;
#pragma unroll
        for (int j = 0; j < 8; ++j) { const int col = 4 * (lane + 64 * j);
            const f32x4 gv = *(const f32x4*)(g + col), sc = *(const f32x4*)(mb + sc_off + col), sh = *(const f32x4*)(mb + sh_off + col);
            const f32x4 o = v[j] * rs * gv * (sc + 1.0f) + sh;
            if (I8) { v[j] = o; amax = fmaxf(fmaxf(amax, fmaxf(fabsf(o[0]), fabsf(o[1]))), fmaxf(fabsf(o[2]), fabsf(o[3]))); }
            else { u32x2 w; w.x = cvt_pk_bf16(o[0], o[1]); w.y = cvt_pk_bf16(o[2], o[3]); *(u32x2*)(Hout + (size_t)row * DM + col) = w; } }
        if (I8) {
#pragma unroll
            for (int o = 1; o < 64; o <<= 1) amax = fmaxf(amax, __shfl_xor(amax, o));
            const float sa = fmaxf(amax, 1e-30f) * (1.0f / 127.0f), inv = 1.0f / sa;
            if (lane == 0) SA[row] = sa;
            unsigned* h8 = (unsigned*)((signed char*)Hout + (size_t)row * DM) + lane;
#pragma unroll
            for (int j = 0; j < 8; ++j) { unsigned w = 0;
#pragma unroll
                for (int e = 0; e < 4; ++e) { const int q = (int)rintf(v[j][e] * inv); w |= ((unsigned)q & 0xffu) << (8 * e); }
                h8[64 * j] = w; }
        }
    }
}

template <int MODE>
__device__ __forceinline__ void ph_attn(LAS unsigned char* lds, const bf16_t* PA, bf16_t* ATT, const float* __restrict__ qg, const float* __restrict__ kg, int G) {
    const int tid = opaque_tid(), lane = tid & 63, wave = __builtin_amdgcn_readfirstlane(tid >> 6), c = lane & 15, g = lane >> 4;
    LAS unsigned char* KL = lds;
    LAS unsigned char* VT = lds + 17408;
    bf16x8 tri[6];
    { const int FS[6] = {0, 1, 0, 1, 2, 3}, FP[6] = {0, 0, 1, 1, 1, 1};
#pragma unroll
      for (int q = 0; q < 6; ++q)
#pragma unroll
          for (int jj = 0; jj < 8; ++jj) { const int kap = 32 * FP[q] + 16 * (jj >> 2) + 4 * g + (jj & 3); tri[q][jj] = (kap > 16 * FS[q] + c) ? (short)0x3F80 : (short)0; } }
    for (int u = blockIdx.x; u < 1024; u += G) {
        const int b = u >> 9, h = (u >> 6) & 7, qb = u & 63, t0 = qb * 128, tq0 = t0 + 16 * wave, tq = tq0 + c;
        bf16x8 qf[4];
        { const bf16_t* qrow = PA + (size_t)(b * SEQ + tq) * 4096 + 1024 + h * 128;
          u32x4 qr[4]; float ss = 0.f;
#pragma unroll
          for (int kk = 0; kk < 4; ++kk) { qr[kk] = *(const u32x4*)(qrow + 32 * kk + 8 * g);
#pragma unroll
              for (int e = 0; e < 4; ++e) { const float lo = bf_lo(qr[kk][e]), hi = bf_hi(qr[kk][e]); ss += lo * lo + hi * hi; } }
          ss += __shfl_xor(ss, 16); ss += __shfl_xor(ss, 32);
          const float rs = (1.0f / sqrtf(ss * (1.0f / 128.0f) + EPS)) * (0.08838834764831845f * 1.4426950408889634f);
#pragma unroll
          for (int kk = 0; kk < 4; ++kk) { const f32x4 g0 = *(const f32x4*)(qg + 32 * kk + 8 * g), g1 = *(const f32x4*)(qg + 32 * kk + 8 * g + 4);
              u32x4 w;
              w.x = cvt_pk_bf16(bf_lo(qr[kk].x) * rs * g0[0], bf_hi(qr[kk].x) * rs * g0[1]);
              w.y = cvt_pk_bf16(bf_lo(qr[kk].y) * rs * g0[2], bf_hi(qr[kk].y) * rs * g0[3]);
              w.z = cvt_pk_bf16(bf_lo(qr[kk].z) * rs * g1[0], bf_hi(qr[kk].z) * rs * g1[1]);
              w.w = cvt_pk_bf16(bf_lo(qr[kk].w) * rs * g1[2], bf_hi(qr[kk].w) * rs * g1[3]);
              qf[kk] = __builtin_bit_cast(bf16x8, w); } }
        float carry = 0.f; int wdone = 0;
        f32x4 oacc[8];
#pragma unroll
        for (int fd = 0; fd < 8; ++fd) oacc[fd] = (f32x4){0.f, 0.f, 0.f, 0.f};
        u32x4 kreg[2], vreg[2];
        { const int k0n = (2 * qb + 1) * 64;
#pragma unroll
          for (int p = 0; p < 2; ++p) { const int ci = tid + 512 * p, key = ci >> 4, ch = ci & 15;
              kreg[p] = *(const u32x4*)(PA + (size_t)(b * SEQ + k0n + key) * 4096 + 2048 + h * 128 + 8 * ch);
              vreg[p] = *(const u32x4*)(PA + (size_t)(b * SEQ + k0n + lane) * 4096 + 3072 + h * 128 + 8 * (wave + 8 * p)); } }
        for (int kt = 2 * qb + 1; kt >= 0; --kt) {
            const int k0 = kt * 64;
            if (__syncthreads_and(wdone)) break;
#pragma unroll
            for (int p = 0; p < 2; ++p) {
                const int ci = tid + 512 * p, key = ci >> 4, ch = ci & 15;
                const u32x4 kr = kreg[p];
                float f[8]; f[0] = bf_lo(kr.x); f[1] = bf_hi(kr.x); f[2] = bf_lo(kr.y); f[3] = bf_hi(kr.y); f[4] = bf_lo(kr.z); f[5] = bf_hi(kr.z); f[6] = bf_lo(kr.w); f[7] = bf_hi(kr.w);
                float ss = 0.f;
#pragma unroll
                for (int e = 0; e < 8; ++e) ss += f[e] * f[e];
                ss += __shfl_xor(ss, 1); ss += __shfl_xor(ss, 2); ss += __shfl_xor(ss, 4); ss += __shfl_xor(ss, 8);
                const float rs = 1.0f / sqrtf(ss * (1.0f / 128.0f) + EPS);
                const f32x4 g0 = *(const f32x4*)(kg + 8 * ch), g1 = *(const f32x4*)(kg + 8 * ch + 4);
                u32x4 w;
                w.x = cvt_pk_bf16(f[0] * rs * g0[0], f[1] * rs * g0[1]); w.y = cvt_pk_bf16(f[2] * rs * g0[2], f[3] * rs * g0[3]);
                w.z = cvt_pk_bf16(f[4] * rs * g1[0], f[5] * rs * g1[1]); w.w = cvt_pk_bf16(f[6] * rs * g1[2], f[7] * rs * g1[3]);
                *(LAS u32x4*)(KL + key * 272 + ch * 16) = w;
            }
#pragma unroll
            for (int p = 0; p < 2; ++p) {
                const int key = lane, ch = wave + 8 * p;
                const u32x4 vr = vreg[p];
                LAS unsigned short* vt = (LAS unsigned short*)(VT + (8 * ch) * 144 + key * 2);
                vt[0 * 72] = (unsigned short)(vr.x & 0xffffu); vt[1 * 72] = (unsigned short)(vr.x >> 16);
                vt[2 * 72] = (unsigned short)(vr.y & 0xffffu); vt[3 * 72] = (unsigned short)(vr.y >> 16);
                vt[4 * 72] = (unsigned short)(vr.z & 0xffffu); vt[5 * 72] = (unsigned short)(vr.z >> 16);
                vt[6 * 72] = (unsigned short)(vr.w & 0xffffu); vt[7 * 72] = (unsigned short)(vr.w >> 16);
            }
            if (kt > 0) { const int k0n = k0 - 64;
#pragma unroll
                for (int p = 0; p < 2; ++p) { const int ci = tid + 512 * p, key = ci >> 4, ch = ci & 15;
                    kreg[p] = *(const u32x4*)(PA + (size_t)(b * SEQ + k0n + key) * 4096 + 2048 + h * 128 + 8 * ch);
                    vreg[p] = *(const u32x4*)(PA + (size_t)(b * SEQ + k0n + lane) * 4096 + 3072 + h * 128 + 8 * (wave + 8 * p)); } }
            __syncthreads();
            if (MODE == 1) { if (kt <= 2 * qb - 3) wdone = 1; }
            if (MODE == 0 && !wdone && k0 < tq0 + 15) {
                f32x4 zt[4];
#pragma unroll
                for (int f = 0; f < 4; ++f) { f32x4 acc = {0.f, 0.f, 0.f, 0.f};
#pragma unroll
                    for (int kk = 0; kk < 4; ++kk) { const bf16x8 kf = *(const LAS bf16x8*)(KL + (16 * f + c) * 272 + (32 * kk + 8 * g) * 2);
                        acc = __builtin_amdgcn_mfma_f32_16x16x32_bf16(kf, qf[kk], acc, 0, 0, 0); }
                    zt[f] = acc; }
                float lf[4][4], lz[4][4]; float tot = 0.f;
                if (k0 + 63 >= tq0) {
#pragma unroll
                    for (int f = 0; f < 4; ++f)
#pragma unroll
                        for (int i = 0; i < 4; ++i) { const int s = k0 + 16 * f + 4 * g + i; const bool valid = s < tq; const float z = zt[f][i];
                            const float sp = fmaxf(z, 0.f) + __builtin_amdgcn_logf(1.0f + __builtin_amdgcn_exp2f(-fabsf(z)));
                            const float l = valid ? -sp : 0.f; lf[f][i] = l; lz[f][i] = valid ? (l + z) : -INFINITY; tot += l; }
                } else {
#pragma unroll
                    for (int f = 0; f < 4; ++f)
#pragma unroll
                        for (int i = 0; i < 4; ++i) { const float z = zt[f][i];
                            const float l = -(fmaxf(z, 0.f) + __builtin_amdgcn_logf(1.0f + __builtin_amdgcn_exp2f(-fabsf(z)))); lf[f][i] = l; lz[f][i] = l + z; tot += l; }
                }
                tot += __shfl_xor(tot, 16); tot += __shfl_xor(tot, 32);
                bf16x8 lh[2];
#pragma unroll
                for (int fp = 0; fp < 2; ++fp) { u32x4 wh;
#pragma unroll
                    for (int q = 0; q < 2; ++q) { const int f = 2 * fp + q; wh[2 * q] = cvt_pk_bf16(lf[f][0], lf[f][1]); wh[2 * q + 1] = cvt_pk_bf16(lf[f][2], lf[f][3]); }
                    lh[fp] = __builtin_bit_cast(bf16x8, wh); }
                f32x4 sf[4];
                { f32x4 z4 = {0.f, 0.f, 0.f, 0.f};
                  sf[0] = __builtin_amdgcn_mfma_f32_16x16x32_bf16(tri[0], lh[0], z4, 0, 0, 0); sf[0] = __builtin_amdgcn_mfma_f32_16x16x32_bf16(tri[2], lh[1], sf[0], 0, 0, 0);
                  sf[1] = __builtin_amdgcn_mfma_f32_16x16x32_bf16(tri[1], lh[0], z4, 0, 0, 0); sf[1] = __builtin_amdgcn_mfma_f32_16x16x32_bf16(tri[3], lh[1], sf[1], 0, 0, 0);
                  sf[2] = __builtin_amdgcn_mfma_f32_16x16x32_bf16(tri[4], lh[1], z4, 0, 0, 0);
                  sf[3] = __builtin_amdgcn_mfma_f32_16x16x32_bf16(tri[5], lh[1], z4, 0, 0, 0); }
                bf16x8 pb[2];
#pragma unroll
                for (int fp = 0; fp < 2; ++fp) { u32x4 w;
#pragma unroll
                    for (int q = 0; q < 2; ++q) { const int f = 2 * fp + q; float p[4];
#pragma unroll
                        for (int i = 0; i < 4; ++i) p[i] = __builtin_amdgcn_exp2f(lz[f][i] + sf[f][i] + carry);
                        w[2 * q] = cvt_pk_bf16(p[0], p[1]); w[2 * q + 1] = cvt_pk_bf16(p[2], p[3]); }
                    pb[fp] = __builtin_bit_cast(bf16x8, w); }
                carry += tot;
#pragma unroll
                for (int fd = 0; fd < 8; ++fd)
#pragma unroll
                    for (int fp = 0; fp < 2; ++fp) { const LAS unsigned char* vp = VT + (16 * fd + c) * 144 + (32 * fp + 4 * g) * 2;
                        const u32x2 v0 = *(const LAS u32x2*)vp, v1 = *(const LAS u32x2*)(vp + 32);
                        u32x4 vw; vw.x = v0.x; vw.y = v0.y; vw.z = v1.x; vw.w = v1.y;
                        oacc[fd] = __builtin_amdgcn_mfma_f32_16x16x32_bf16(__builtin_bit_cast(bf16x8, vw), pb[fp], oacc[fd], 0, 0, 0); }
                wdone = (__ballot(carry >= -152.0f) == 0ull) ? 1 : 0;
            }
        }
        if (MODE == 0) { unsigned char* orow = (unsigned char*)ATT + (size_t)(b * SEQ + tq) * 1024 + h * 128 + 4 * g;
#pragma unroll
          for (int fd = 0; fd < 8; ++fd) *(unsigned*)(orow + 16 * fd) = pack4_fp8(oacc[fd][0], oacc[fd][1], oacc[fd][2], oacc[fd][3], F8_SA); }
    }
    __syncthreads();
}

__device__ __forceinline__ void ssm_lambda(const Args& a, int g, int st, float& lbr, float& lbi, float& qr, float& qi) {
    const float lr = a.in[I_LRE][g * 64 + st], li = a.in[I_LIM][g * 64 + st], dt = __expf(a.in[I_LDT][g]);
    const float mag = __expf(lr * dt);
    float rev = li * dt * 0.15915494309189535f; rev -= rintf(rev);
    lbr = mag * __builtin_amdgcn_cosf(rev); lbi = mag * __builtin_amdgcn_sinf(rev);
    const float nr = lbr - 1.0f, ni = lbi, den = 1.0f / (lr * lr + li * li);
    qr = (nr * lr + ni * li) * den; qi = (ni * lr - nr * li) * den;
}
template <bool WITH_Y>
__device__ __forceinline__ void ph_ssm_mfma(const Args& a, LAS unsigned char* lds, const bf16_t* UB, f32x2* E, bf16_t* YA, int G) {
    const int tid = opaque_tid(), lane = tid & 63, wave = __builtin_amdgcn_readfirstlane(tid >> 6), c = lane & 15, gl = lane >> 4;
    LAS f32x2* sl = (LAS f32x2*)(lds + wave * 8192);
    LAS f32x4* tab = (LAS f32x4*)(lds + 65536 + wave * 1024);
    LAS u32x4* cml = (LAS u32x4*)(lds + 73728 + wave * 5120) + lane;
    for (int item = blockIdx.x; item < 128; item += G) {
        const int b = item >> 6, cb = (item >> 3) & 7, g = (item & 7) * 8 + wave, c0 = cb * 16;
        float mur, mui;
        { float lbr, lbi, qr, qi; ssm_lambda(a, g, lane, lbr, lbi, qr, qi); tab[lane] = (f32x4){lbr, lbi, qr, qi}; mur = lbr; mui = lbi; }
        LDS_WAIT();
        bf16x8 bm[8];
        const float* brb = a.in[I_BRE] + (g * 64 + (c >> 1)) * 16 + 8 * (gl & 1); const float* bib = a.in[I_BIM] + (g * 64 + (c >> 1)) * 16 + 8 * (gl & 1);
        const LAS f32x4* tabb = tab + (c >> 1);
#pragma unroll
        for (int f = 0; f < 8; ++f) { const f32x4 tv = tabb[8 * f]; const float qr = tv[2], qi = tv[3];
            const float* br = brb + 128 * f; const float* bim = bib + 128 * f;
            const f32x4 r0 = *(const f32x4*)br, r1 = *(const f32x4*)(br + 4), i0 = *(const f32x4*)bim, i1 = *(const f32x4*)(bim + 4);
            float v[8];
#pragma unroll
            for (int e = 0; e < 4; ++e) { const float vr0 = qr * r0[e] - qi * i0[e], vi0 = qr * i0[e] + qi * r0[e], vr1 = qr * r1[e] - qi * i1[e], vi1 = qr * i1[e] + qi * r1[e];
                v[e] = (c & 1) ? vi0 : vr0; v[4 + e] = (c & 1) ? vi1 : vr1; }
            if (gl >= 2) {
#pragma unroll
                for (int e = 0; e < 8; ++e) v[e] = 0.f; }
            u32x4 w; w.x = cvt_pk_bf16(v[0], v[1]); w.y = cvt_pk_bf16(v[2], v[3]); w.z = cvt_pk_bf16(v[4], v[5]); w.w = cvt_pk_bf16(v[6], v[7]);
            bm[f] = __builtin_bit_cast(bf16x8, w); }
        float lmr[16], lmi[16];
#pragma unroll
        for (int k = 0; k < 16; ++k) { const f32x4 tv = tab[2 * gl + 8 * (k >> 1) + (k & 1)]; lmr[k] = tv[0]; lmi[k] = tv[1]; }
        if (WITH_Y) {
            const float* crb = a.in[I_CRE] + (g * 16 + c) * 64 + 2 * gl; const float* cib = a.in[I_CIM] + (g * 16 + c) * 64 + 2 * gl;
#pragma unroll
            for (int kk = 0; kk < 4; ++kk) { float v[8];
#pragma unroll
                for (int jh = 0; jh < 2; ++jh) { const f32x2 r = *(const f32x2*)(crb + 8 * (2 * kk + jh)), m = *(const f32x2*)(cib + 8 * (2 * kk + jh));
                    v[4 * jh] = r.x; v[4 * jh + 1] = -m.x; v[4 * jh + 2] = r.y; v[4 * jh + 3] = -m.y; }
                u32x4 w; w.x = cvt_pk_bf16(v[0], v[1]); w.y = cvt_pk_bf16(v[2], v[3]); w.z = cvt_pk_bf16(v[4], v[5]); w.w = cvt_pk_bf16(v[6], v[7]);
                cml[64 * kk] = w; }
            { const float dv = a.in[I_SD][g * 16 + c]; float v[8];
#pragma unroll
              for (int jj = 0; jj < 8; ++jj) v[jj] = (gl < 2 && (8 * gl + jj) == c) ? dv : 0.f;
              u32x4 w; w.x = cvt_pk_bf16(v[0], v[1]); w.y = cvt_pk_bf16(v[2], v[3]); w.z = cvt_pk_bf16(v[4], v[5]); w.w = cvt_pk_bf16(v[6], v[7]);
              cml[256] = w; }
        }
        f32x4 s[8];
#pragma unroll
        for (int f = 0; f < 8; ++f) s[f] = (f32x4){0.f, 0.f, 0.f, 0.f};
        if (WITH_Y) {
            float pr = mur, pi = mui;
#pragma unroll
            for (int q = 0; q < 6; ++q) { const float nr = pr * pr - pi * pi, ni = 2.0f * pr * pi; pr = nr; pi = ni; }
            float sr = 0.f, si = 0.f;
            const f32x2* ep = E + (size_t)((b * 64 + g) * 128) * 64 + lane;
            f32x2 ev[8], en[8];
#pragma unroll
            for (int k = 0; k < 8; ++k) ev[k] = ep[(size_t)k * 64];
            for (int cc = 0; cc < c0 + 16; cc += 8) {
                if (cc + 8 < c0 + 16) {
#pragma unroll
                    for (int k = 0; k < 8; ++k) en[k] = ep[(size_t)(cc + 8 + k) * 64]; }
#pragma unroll
                for (int k = 0; k < 8; ++k) { if (cc >= c0) sl[(cc - c0 + k) * 64 + lane] = (f32x2){sr, si};
                    const float nr = pr * sr - pi * si + ev[k][0], ni = pr * si + pi * sr + ev[k][1]; sr = nr; si = ni; }
#pragma unroll
                for (int k = 0; k < 8; ++k) ev[k] = en[k];
            }
            LDS_WAIT();
#pragma unroll
            for (int f = 0; f < 8; ++f) s[f] = *(const LAS f32x4*)(sl + c * 64 + 8 * f + 2 * gl);
            LDS_WAIT();
        }
        const bf16_t* up = UB + ((size_t)(b * 64 + g) * 8192 + (size_t)(c0 + c) * 64) * 16 + 8 * (gl & 1);
        unsigned char* yp = (unsigned char*)YA + (size_t)(b * SEQ + (c0 + c) * 64) * 1024 + g * 16 + 4 * gl;
        u32x4 u0 = *(const u32x4*)(up), u1 = *(const u32x4*)(up + 16), u2 = *(const u32x4*)(up + 32), u3 = *(const u32x4*)(up + 48);
#pragma unroll 1
        for (int tau = 0; tau < 64; ++tau) {
            const u32x4 u4 = *(const u32x4*)(up + (size_t)(tau + 4) * 16);
            const bf16x8 uf = __builtin_bit_cast(bf16x8, u0);
#pragma unroll
            for (int f = 0; f < 8; ++f) { f32x4 ci;
                ci[0] = lmr[2 * f] * s[f][0] - lmi[2 * f] * s[f][1]; ci[1] = lmr[2 * f] * s[f][1] + lmi[2 * f] * s[f][0];
                ci[2] = lmr[2 * f + 1] * s[f][2] - lmi[2 * f + 1] * s[f][3]; ci[3] = lmr[2 * f + 1] * s[f][3] + lmi[2 * f + 1] * s[f][2];
                s[f] = __builtin_amdgcn_mfma_f32_16x16x32_bf16(bm[f], uf, ci, 0, 0, 0); }
            if (WITH_Y) {
                f32x4 y = __builtin_amdgcn_mfma_f32_16x16x32_bf16(__builtin_bit_cast(bf16x8, cml[256]), uf, (f32x4){0.f, 0.f, 0.f, 0.f}, 0, 0, 0);
#pragma unroll
                for (int kk = 0; kk < 4; ++kk) { u32x4 w; w.x = cvt_pk_bf16(s[2 * kk][0], s[2 * kk][1]); w.y = cvt_pk_bf16(s[2 * kk][2], s[2 * kk][3]);
                    w.z = cvt_pk_bf16(s[2 * kk + 1][0], s[2 * kk + 1][1]); w.w = cvt_pk_bf16(s[2 * kk + 1][2], s[2 * kk + 1][3]);
                    y = __builtin_amdgcn_mfma_f32_16x16x32_bf16(__builtin_bit_cast(bf16x8, cml[64 * kk]), __builtin_bit_cast(bf16x8, w), y, 0, 0, 0); }
                *(unsigned*)(yp + (size_t)tau * 1024) = pack4_fp8(gelu_tanh(y[0]), gelu_tanh(y[1]), gelu_tanh(y[2]), gelu_tanh(y[3]), F8_SA);
            }
            u0 = u1; u1 = u2; u2 = u3; u3 = u4;
        }
        if (!WITH_Y) { f32x2* eo = E + (size_t)((b * 64 + g) * 128 + c0 + c) * 64 + 2 * gl;
#pragma unroll
            for (int f = 0; f < 8; ++f) *(f32x4*)(eo + 8 * f) = s[f]; }
    }
}

typedef float f32x16 __attribute__((ext_vector_type(16)));
typedef float f32x32 __attribute__((ext_vector_type(32)));
typedef unsigned u32x6 __attribute__((ext_vector_type(6)));
constexpr float PEER_SU = 64.0f, PEER_SV = 1.4f;
constexpr size_t PEER_SHARD_BYTES = (size_t)16384 * 192;
__device__ __forceinline__ void table_cvt_pack(const f32x4 (&v)[8], float sc, unsigned char* dst, int lane) {
    f32x16 a, b;
#pragma unroll
    for (int q = 0; q < 4; ++q) {
#pragma unroll
        for (int e = 0; e < 4; ++e) { a[4 * q + e] = v[q][e] * sc; b[4 * q + e] = v[4 + q][e] * sc; } }
    const u32x6 p = __builtin_amdgcn_cvt_scalef32_2xpk16_fp6_f32(a, b, 1.0f);
    *(u32x4*)(dst + 16 * (lane & 7)) = (u32x4){p[0], p[1], p[2], p[3]};
    *(u32x2*)(dst + 128 + 8 * (lane & 7)) = (u32x2){p[4], p[5]};
}
__device__ __forceinline__ void ph_table_cvt(const float* __restrict__ U, const float* __restrict__ V, unsigned char* UT, unsigned char* VT, int r0, int r1, int gw, int ngw, int lane) {
    for (int r = r0 + gw; r < r1; r += ngw) {
        const float* su = U + (size_t)r * 2048 + 32 * lane; const float* sv = V + (size_t)r * 2048 + 32 * lane;
        f32x4 vu[8], vv[8];
#pragma unroll
        for (int q = 0; q < 8; ++q) vu[q] = *(const f32x4*)(su + 4 * q);
#pragma unroll
        for (int q = 0; q < 8; ++q) vv[q] = *(const f32x4*)(sv + 4 * q);
        const size_t off = (size_t)(lane >> 3) * PEER_SHARD_BYTES + (size_t)r * 192;
        table_cvt_pack(vu, PEER_SU, UT + off, lane);
        table_cvt_pack(vv, PEER_SV, VT + off, lane);
    }
}

#define TK_CE(a_, b_) do { const float _h = fmaxf(a_, b_), _l = fminf(a_, b_); a_ = _h; b_ = _l; } while (0)
__device__ __forceinline__ void tk_sort16(float (&a)[16]) {
#pragma unroll
    for (int p = 1; p < 16; p *= 2)
#pragma unroll
        for (int k = p; k >= 1; k /= 2)
#pragma unroll
            for (int j = k % p; j <= 15 - k; j += 2 * k)
#pragma unroll
                for (int i = 0; i < k; ++i)
                    if (i + j + k <= 15 && (i + j) / (2 * p) == (i + j + k) / (2 * p)) TK_CE(a[i + j], a[i + j + k]);
}
__device__ __forceinline__ void tk_merge16(float (&t)[16], const float (&g)[16]) {
#pragma unroll
    for (int i = 0; i < 16; ++i) t[i] = fmaxf(t[i], g[15 - i]);
#pragma unroll
    for (int k = 8; k >= 1; k /= 2)
#pragma unroll
        for (int i = 0; i < 16; ++i)
            if ((i & k) == 0) TK_CE(t[i], t[i + k]);
}
__device__ __forceinline__ float tk2_key(float a, float b, int flat) {
    const float sum = __uint_as_float(__float_as_uint(a) & ~127u) + __uint_as_float(__float_as_uint(b) & ~127u);
    return __uint_as_float((__float_as_uint(sum) & ~255u) | (unsigned)(255 - flat)); }
__device__ __forceinline__ void ph_peer_topk(LAS unsigned char* lds, const float* SC, int* idxG, float* gateG, int G) {
    const int tid = opaque_tid(), lane = tid & 63, wave = __builtin_amdgcn_readfirstlane(tid >> 6);
    LAS float* scr = (LAS float*)(lds + wave * 8448);
    for (int it = blockIdx.x; it < 512; it += G) {
        const int tokw = it * 32 + wave * 4;
        float tk[16];
#pragma unroll
        for (int i = 0; i < 16; ++i) tk[i] = -INFINITY;
        for (int q = 0; q < 4; ++q) {
#pragma unroll
            for (int j = 0; j < 8; ++j) { const int prob = (lane >> 3) + 8 * j, seg = lane & 7;
                const f32x4 v = *(const f32x4*)(SC + (size_t)(tokw + (prob >> 4)) * 2048 + (prob & 15) * 128 + 32 * q + 4 * seg);
                LAS float* d = scr + prob * 33 + 4 * seg; d[0] = v[0]; d[1] = v[1]; d[2] = v[2]; d[3] = v[3]; }
            LDS_WAIT();
#pragma unroll
            for (int hh = 0; hh < 2; ++hh) { float g[16];
#pragma unroll
                for (int i = 0; i < 16; ++i) g[i] = __uint_as_float((__float_as_uint(scr[lane * 33 + 16 * hh + i]) & ~127u) | (unsigned)(127 - (32 * q + 16 * hh + i)));
                tk_sort16(g); tk_merge16(tk, g); }
            LDS_WAIT();
        }
        float t2[16];
#pragma unroll
        for (int i = 0; i < 16; ++i) t2[i] = __shfl_xor(tk[i], 1);
        float bv[16];
        {
          bv[0] = tk2_key(tk[0], t2[0], 0);
          bv[1] = tk2_key(tk[0], t2[1], 1);
          bv[2] = tk2_key(tk[0], t2[2], 2);
          bv[3] = tk2_key(tk[0], t2[3], 3);
          bv[4] = tk2_key(tk[0], t2[4], 4);
          bv[5] = tk2_key(tk[0], t2[5], 5);
          bv[6] = tk2_key(tk[0], t2[6], 6);
          bv[7] = tk2_key(tk[0], t2[7], 7);
          bv[8] = tk2_key(tk[0], t2[8], 8);
          bv[9] = tk2_key(tk[0], t2[9], 9);
          bv[10] = tk2_key(tk[0], t2[10], 10);
          bv[11] = tk2_key(tk[0], t2[11], 11);
          bv[12] = tk2_key(tk[0], t2[12], 12);
          bv[13] = tk2_key(tk[0], t2[13], 13);
          bv[14] = tk2_key(tk[0], t2[14], 14);
          bv[15] = tk2_key(tk[0], t2[15], 15);
          tk_sort16(bv);
          { float g[16];
          g[0] = tk2_key(tk[1], t2[0], 16);
          g[1] = tk2_key(tk[1], t2[1], 17);
          g[2] = tk2_key(tk[1], t2[2], 18);
          g[3] = tk2_key(tk[1], t2[3], 19);
          g[4] = tk2_key(tk[1], t2[4], 20);
          g[5] = tk2_key(tk[1], t2[5], 21);
          g[6] = tk2_key(tk[1], t2[6], 22);
          g[7] = tk2_key(tk[1], t2[7], 23);
          g[8] = tk2_key(tk[2], t2[0], 32);
          g[9] = tk2_key(tk[2], t2[1], 33);
          g[10] = tk2_key(tk[2], t2[2], 34);
          g[11] = tk2_key(tk[2], t2[3], 35);
          g[12] = tk2_key(tk[2], t2[4], 36);
          g[13] = tk2_key(tk[3], t2[0], 48);
          g[14] = tk2_key(tk[3], t2[1], 49);
          g[15] = tk2_key(tk[3], t2[2], 50);
          tk_sort16(g); tk_merge16(bv, g); }
          { float g[16];
          g[0] = tk2_key(tk[3], t2[3], 51);
          g[1] = tk2_key(tk[4], t2[0], 64);
          g[2] = tk2_key(tk[4], t2[1], 65);
          g[3] = tk2_key(tk[4], t2[2], 66);
          g[4] = tk2_key(tk[5], t2[0], 80);
          g[5] = tk2_key(tk[5], t2[1], 81);
          g[6] = tk2_key(tk[6], t2[0], 96);
          g[7] = tk2_key(tk[6], t2[1], 97);
          g[8] = tk2_key(tk[7], t2[0], 112);
          g[9] = tk2_key(tk[7], t2[1], 113);
          g[10] = tk2_key(tk[8], t2[0], 128);
          g[11] = tk2_key(tk[9], t2[0], 144);
          g[12] = tk2_key(tk[10], t2[0], 160);
          g[13] = tk2_key(tk[11], t2[0], 176);
          g[14] = tk2_key(tk[12], t2[0], 192);
          g[15] = tk2_key(tk[13], t2[0], 208);
          tk_sort16(g); tk_merge16(bv, g); }
          { float x = tk2_key(tk[14], t2[0], 224);
#pragma unroll
            for (int i = 0; i < 16; ++i) { const float hi = fmaxf(bv[i], x); x = fminf(bv[i], x); bv[i] = hi; } }
          { float x = tk2_key(tk[15], t2[0], 240);
#pragma unroll
            for (int i = 0; i < 16; ++i) { const float hi = fmaxf(bv[i], x); x = fminf(bv[i], x); bv[i] = hi; } }
        }
        unsigned p1[4], p2[4];
#pragma unroll
        for (int j = 0; j < 4; ++j) { p1[j] = 0u; p2[j] = 0u;
#pragma unroll
            for (int e = 0; e < 4; ++e) { p1[j] |= (127u - (__float_as_uint(tk[4 * j + e]) & 127u)) << (8 * e); p2[j] |= (127u - (__float_as_uint(t2[4 * j + e]) & 127u)) << (8 * e); } }
        { float e[16], sum = 0.f; unsigned ex[16];
          const float top = __uint_as_float(__float_as_uint(bv[0]) & ~255u);
#pragma unroll
          for (int i = 0; i < 16; ++i) { const unsigned bits = __float_as_uint(bv[i]); const unsigned flat = 255u - (bits & 255u), aa = flat >> 4, bb = flat & 15u;
              const unsigned w1 = (aa >> 2) == 0u ? p1[0] : (aa >> 2) == 1u ? p1[1] : (aa >> 2) == 2u ? p1[2] : p1[3];
              const unsigned w2 = (bb >> 2) == 0u ? p2[0] : (bb >> 2) == 1u ? p2[1] : (bb >> 2) == 2u ? p2[2] : p2[3];
              ex[i] = (((w1 >> (8u * (aa & 3u))) & 127u) << 7) | ((w2 >> (8u * (bb & 3u))) & 127u);
              e[i] = __expf(__uint_as_float(bits & ~255u) - top); sum += e[i]; }
          const float inv = 1.0f / sum;
          if ((lane & 1) == 0) { const int tl = lane >> 4, head = (lane & 15) >> 1; const size_t o = (size_t)(tokw + tl) * 128 + 64 * (head >> 2);
#pragma unroll
              for (int i = 0; i < 16; ++i) { const int p = 8 * (i & 7) + ((2 * head + (i >> 3)) & 7); idxG[o + p] = (int)ex[i]; gateG[o + p] = e[i] * inv; } } }
    }
}

#define PEER_ROWS(b4_, b2_, i8_) do { _Pragma("unroll") for (int gq = 0; gq < 8; ++gq) { const unsigned ro = (unsigned)(i8_)[gq] * 192u; \
        b4_[gq] = *(const u32x4*)(tab + (ro + 16u * (unsigned)c)); b2_[gq] = *(const u32x2*)(tab + (ro + 128u + 8u * (unsigned)c)); } } while (0)
#define PEER_LD8(dst_, p_) do { const u32x4 _a = *(const u32x4*)(p_), _b = *(const u32x4*)((p_) + 4); dst_[0] = (int)_a.x; dst_[1] = (int)_a.y; dst_[2] = (int)_a.z; dst_[3] = (int)_a.w; \
        dst_[4] = (int)_b.x; dst_[5] = (int)_b.y; dst_[6] = (int)_b.z; dst_[7] = (int)_b.w; } while (0)
__device__ __forceinline__ void ph_peer_u(const unsigned char* UT, const bf16_t* H2, const int* idxG, float* pdot, int G) {
    const int tid = opaque_tid(), lane = tid & 63, wave = __builtin_amdgcn_readfirstlane(tid >> 6), r = lane >> 3, c = lane & 7;
    const int shard = blockIdx.x & 7, ws = (blockIdx.x >> 3) * 8 + wave, nws = (G >> 3) * 8;
    const unsigned char* tab = UT + (size_t)shard * PEER_SHARD_BYTES;
    const bf16_t* hbase = H2 + 256 * shard + 32 * c;
    const int* ibase = idxG + 8 * r;
#define PEER_TOK(t_) (((t_) < T_TOK) ? (t_) : (T_TOK - 1))
    int ci[2][8], ni[2][8]; u32x4 cw[4], nw[4];
    { const int t0 = PEER_TOK(ws), t1 = PEER_TOK(ws + nws);
      PEER_LD8(ci[0], ibase + (size_t)t0 * 128); PEER_LD8(ci[1], ibase + (size_t)t0 * 128 + 64); PEER_LD8(ni[0], ibase + (size_t)t1 * 128); PEER_LD8(ni[1], ibase + (size_t)t1 * 128 + 64);
#pragma unroll
      for (int q = 0; q < 4; ++q) cw[q] = *(const u32x4*)(hbase + (size_t)t0 * 2048 + 8 * q); }
    u32x4 a4[8], b4[8]; u32x2 a2[8], b2[8];
    PEER_ROWS(a4, a2, ci[0]);
    for (int t = ws; t < T_TOK; t += nws) {
        PEER_ROWS(b4, b2, ci[1]);
        { const int t1 = PEER_TOK(t + nws);
#pragma unroll
          for (int q = 0; q < 4; ++q) nw[q] = *(const u32x4*)(hbase + (size_t)t1 * 2048 + 8 * q); }
        f32x2 ha[16];
        { const u32x4 w0 = cw[0], w1 = cw[1], w2 = cw[2], w3 = cw[3];
          ha[0] = (f32x2){bf_lo(w0.x), bf_lo(w2.x)}; ha[1] = (f32x2){bf_hi(w0.x), bf_hi(w2.x)}; ha[2] = (f32x2){bf_lo(w0.y), bf_lo(w2.y)}; ha[3] = (f32x2){bf_hi(w0.y), bf_hi(w2.y)};
          ha[4] = (f32x2){bf_lo(w0.z), bf_lo(w2.z)}; ha[5] = (f32x2){bf_hi(w0.z), bf_hi(w2.z)}; ha[6] = (f32x2){bf_lo(w0.w), bf_lo(w2.w)}; ha[7] = (f32x2){bf_hi(w0.w), bf_hi(w2.w)};
          ha[8] = (f32x2){bf_lo(w1.x), bf_lo(w3.x)}; ha[9] = (f32x2){bf_hi(w1.x), bf_hi(w3.x)}; ha[10] = (f32x2){bf_lo(w1.y), bf_lo(w3.y)}; ha[11] = (f32x2){bf_hi(w1.y), bf_hi(w3.y)};
          ha[12] = (f32x2){bf_lo(w1.z), bf_lo(w3.z)}; ha[13] = (f32x2){bf_hi(w1.z), bf_hi(w3.z)}; ha[14] = (f32x2){bf_lo(w1.w), bf_lo(w3.w)}; ha[15] = (f32x2){bf_hi(w1.w), bf_hi(w3.w)}; }
        float* po = pdot + ((size_t)shard * T_TOK + t) * 128 + lane;
#define PEER_UDOT(b4_, b2_, half_) do { float mine = 0.f; \
            _Pragma("unroll") for (int gq = 0; gq < 8; ++gq) { const u32x6 p6 = {b4_[gq].x, b4_[gq].y, b4_[gq].z, b4_[gq].w, b2_[gq].x, b2_[gq].y}; \
                const f32x32 uv = __builtin_amdgcn_cvt_scalef32_pk32_f32_fp6(p6, 1.0f); f32x2 s = {0.f, 0.f}; \
                _Pragma("unroll") for (int k = 0; k < 16; ++k) s = (f32x2){uv[2 * k], uv[2 * k + 1]} * ha[k] + s; \
                const float d = sum8_dpp(s.x + s.y); \
                mine = (gq == c) ? d : mine; __builtin_amdgcn_sched_barrier(0); } \
            po[64 * (half_)] = mine; } while (0)
        PEER_UDOT(a4, a2, 0);
        PEER_ROWS(a4, a2, ni[0]);
#pragma unroll
        for (int q = 0; q < 8; ++q) { ci[0][q] = ni[0][q]; ci[1][q] = ni[1][q]; }
        { const int t2 = PEER_TOK(t + 2 * nws); PEER_LD8(ni[0], ibase + (size_t)t2 * 128); PEER_LD8(ni[1], ibase + (size_t)t2 * 128 + 64); }
        PEER_UDOT(b4, b2, 1);
#pragma unroll
        for (int q = 0; q < 4; ++q) cw[q] = nw[q];
    }
#undef PEER_UDOT
}
__device__ __forceinline__ void ph_peer_act(const float* pdot, const float* gateG, float* actG, int G) {
    const size_t n = (size_t)T_TOK * 128, stride = (size_t)G * 512;
    for (size_t i = (size_t)blockIdx.x * 512 + threadIdx.x; i < n; i += stride) {
        float d = 0.f;
#pragma unroll
        for (int x = 0; x < 8; ++x) d += pdot[(size_t)x * n + i];
        actG[i] = gateG[i] * gelu_tanh(d * (1.0f / PEER_SU)) * (1.0f / PEER_SV);
    }
}
template <bool DRY>
__device__ __forceinline__ void ph_peer_v(LAS unsigned char* lds, const unsigned char* VT, const int* idxG, const float* actG, const float* mod, float* OUT, int G) {
    const int tid = opaque_tid(), lane = tid & 63, wave = __builtin_amdgcn_readfirstlane(tid >> 6), r = lane >> 3, c = lane & 7;
    const int shard = blockIdx.x & 7, ws = (blockIdx.x >> 3) * 8 + wave, nws = (G >> 3) * 8;
    const unsigned char* tab = VT + (size_t)shard * PEER_SHARD_BYTES;
    LAS float* red = (LAS float*)(lds + wave * 9216);
    const int* ibase = idxG + 8 * r; const int* abase = (const int*)actG + 8 * r;
    int ci[2][8], ni[2][8], ca[2][8], na[2][8]; f32x4 cx, nx;
    { const int t0 = PEER_TOK(ws), t1 = PEER_TOK(ws + nws);
      PEER_LD8(ci[0], ibase + (size_t)t0 * 128); PEER_LD8(ci[1], ibase + (size_t)t0 * 128 + 64); PEER_LD8(ni[0], ibase + (size_t)t1 * 128); PEER_LD8(ni[1], ibase + (size_t)t1 * 128 + 64);
      PEER_LD8(ca[0], abase + (size_t)t0 * 128); PEER_LD8(ca[1], abase + (size_t)t0 * 128 + 64);
      cx = *(const f32x4*)(OUT + (size_t)t0 * 2048 + 256 * shard + 4 * lane); }
    u32x4 a4[8], b4[8]; u32x2 a2[8], b2[8];
    PEER_ROWS(a4, a2, ci[0]);
    for (int t = ws; t < T_TOK; t += nws) {
        PEER_ROWS(b4, b2, ci[1]);
        { const int t1 = PEER_TOK(t + nws);
          PEER_LD8(na[0], abase + (size_t)t1 * 128); PEER_LD8(na[1], abase + (size_t)t1 * 128 + 64); nx = *(const f32x4*)(OUT + (size_t)t1 * 2048 + 256 * shard + 4 * lane); }
        f32x2 acc[16];
#pragma unroll
        for (int k = 0; k < 16; ++k) acc[k] = (f32x2){0.f, 0.f};
#define PEER_VACC(b4_, b2_, a8_) do { _Pragma("unroll") for (int gq = 0; gq < 8; ++gq) { const float ar = __int_as_float((a8_)[gq]); const f32x2 av2 = {ar, ar}; \
            const u32x6 p6 = {b4_[gq].x, b4_[gq].y, b4_[gq].z, b4_[gq].w, b2_[gq].x, b2_[gq].y}; const f32x32 vv = __builtin_amdgcn_cvt_scalef32_pk32_f32_fp6(p6, 1.0f); \
            _Pragma("unroll") for (int k = 0; k < 16; ++k) acc[k] = (f32x2){vv[2 * k], vv[2 * k + 1]} * av2 + acc[k]; __builtin_amdgcn_sched_barrier(0); } } while (0)
        PEER_VACC(a4, a2, ca[0]);
        PEER_ROWS(a4, a2, ni[0]);
#pragma unroll
        for (int q = 0; q < 8; ++q) { ci[0][q] = ni[0][q]; ci[1][q] = ni[1][q]; }
        { const int t2 = PEER_TOK(t + 2 * nws); PEER_LD8(ni[0], ibase + (size_t)t2 * 128); PEER_LD8(ni[1], ibase + (size_t)t2 * 128 + 64); }
        PEER_VACC(b4, b2, ca[1]);
        { LAS float* w = red + (r * 8 + c) * 36;
#pragma unroll
          for (int q = 0; q < 4; ++q) { *(LAS f32x4*)(w + 4 * q) = (f32x4){acc[4 * q].x, acc[4 * q + 1].x, acc[4 * q + 2].x, acc[4 * q + 3].x};
              *(LAS f32x4*)(w + 16 + 4 * q) = (f32x4){acc[4 * q].y, acc[4 * q + 1].y, acc[4 * q + 2].y, acc[4 * q + 3].y}; } }
        LDS_WAIT();
        { f32x4 s = {0.f, 0.f, 0.f, 0.f}; const LAS float* rd = red + (lane >> 3) * 36 + 4 * (lane & 7);
#pragma unroll
          for (int rr = 0; rr < 8; ++rr) s += *(const LAS f32x4*)(rd + rr * 288);
          const int b = t >> 13; const float* gt2 = mod + (size_t)b * 12288 + 10240 + 256 * shard + 4 * lane; float* op = OUT + (size_t)t * 2048 + 256 * shard + 4 * lane;
          const f32x4 g0 = *(const f32x4*)gt2;
          if (!DRY) *(f32x4*)op = cx + g0 * s; else asm volatile("" :: "v"(s), "v"(g0)); }
        LDS_WAIT();
#pragma unroll
        for (int q = 0; q < 8; ++q) { ca[0][q] = na[0][q]; ca[1][q] = na[1][q]; }
        cx = nx;
    }
#undef PEER_VACC
}
#undef PEER_ROWS
#undef PEER_LD8
#undef PEER_TOK

__global__ void __launch_bounds__(512, 2) mk_fwd(Args args) {
    extern __shared__ __attribute__((aligned(16))) unsigned char lds_raw[];
    LAS unsigned char* lds = (LAS unsigned char*)lds_raw;
    const int tid = threadIdx.x, lane = tid & 63, wave = __builtin_amdgcn_readfirstlane(tid >> 6);
    const int G = gridDim.x, gw = blockIdx.x * 8 + wave, ngw = G * 8;
    unsigned char* ws = args.ws;
    volatile LAS unsigned* misc = (volatile LAS unsigned*)(lds + LDS_MAIN);
    if (tid < 4) misc[tid] = 0u;
    __syncthreads();
    const int lo = args.ph_lo, hi = args.ph_hi;
    XcdBarrier bar; bar.bar = (unsigned*)(ws + WS_CTL); bar.x = 0; bar.st = misc;
    if (hi - lo > 1) bar = xcd_barrier_post((unsigned*)(ws + WS_CTL), misc);
#ifndef PHMASK
#define PHMASK 0x3fff
#endif
#define IN(k) (((PHMASK >> (k)) & 1) && lo <= (k) && (k) < hi)
#define SEAM(k) do { if (IN(k) && IN((k) + 1)) xcd_barrier(bar); } while (0)
    float* mod = (float*)(ws + WS_MOD);
    bf16_t* HB = (bf16_t*)(ws + WS_H); bf16_t* PA = (bf16_t*)(ws + WS_PA); bf16_t* PG = (bf16_t*)(ws + WS_PG);
    bf16_t* YA = (bf16_t*)(ws + WS_YA); bf16_t* ATT = (bf16_t*)(ws + WS_ATT); f32x2* EB = (f32x2*)(ws + WS_E); bf16_t* UBp = (bf16_t*)(ws + WS_UB);

#define PHS(code, ...) do { __VA_ARGS__ if (DUP == (code)) { xcd_barrier(bar); __VA_ARGS__ } } while (0)
#define PH(k, ...) do { if (IN(k)) { __VA_ARGS__ if (DUP == (k)) { xcd_barrier(bar); __VA_ARGS__ } } } while (0)
    PH(0, { ph_mod_partial(args.in[I_C], args.in[I_WADA], (float*)(ws + WS_MODP), gw, ngw, lane); ph_colmax_partial(args.in[I_WIN], (float*)(ws + WS_CMAXP), gw, ngw, lane); });
    SEAM(0);
    PH(1, { ph_prologue(args, lds, gw, ngw, lane, wave); });
    SEAM(1);
    PH(2, { ph_norm<true>(args.in[I_X], HB, (float*)(ws + WS_SA), args.in[I_N1G], mod, 0, 2048, gw, ngw, lane); });
    SEAM(2);
    PH(3, { pg8::Gemm g{HB, (const bf16_t*)(ws + WS_WIN), T_TOK, 8192, 1024}; pg8::StaticOrder S; S.init(T_TOK, 8192, G, (int)blockIdx.x);
        pg8::EpiProj E{PA, PG, UBp, (const float*)(ws + WS_SA), (const float*)(ws + WS_SB)}; pg8::gemm_phase<pg8::EpiProj, pg8::StaticOrder, true, true, 1>(lds, g, S, E); });
    SEAM(3);
    PH(4, { PHS(41, { ph_attn<0>(lds, PA, ATT, args.in[I_QNG], args.in[I_KNG], G); __syncthreads(); });
        if (DUP == 411) { xcd_barrier(bar); ph_attn<1>(lds, PA, ATT, args.in[I_QNG], args.in[I_KNG], G); __syncthreads(); } PHS(42, { ph_ssm_mfma<false>(args, lds, UBp, EB, YA, G); }); });
    SEAM(4);
    PH(5, { PHS(51, { ph_ssm_mfma<true>(args, lds, UBp, EB, YA, G); __syncthreads(); });
        PHS(52, { pg8::Gemm g{ATT, (const bf16_t*)(ws + WS_WATT), T_TOK, 2048, 512}; pg8::SplitOrder S; S.init(T_TOK, 2048, G, (int)blockIdx.x);
        pg8::EpiAttUp E{PG, HB}; pg8::gemm_phase<pg8::EpiAttUp, pg8::SplitOrder, true, true, 2>(lds, g, S, E); }); });
    SEAM(5);
    PH(6, { pg8::Gemm g{YA, (const bf16_t*)(ws + WS_WGLU), T_TOK, 4096, 512}; pg8::StaticOrder S; S.init(T_TOK, 4096, G, (int)blockIdx.x);
        pg8::EpiGlu E{PG, HB, (unsigned char*)ATT}; pg8::gemm_phase<pg8::EpiGlu, pg8::StaticOrder, true, true, 2>(lds, g, S, E); });
    SEAM(6);
    PH(7, { const bool split = (G == 256); const int gg = split ? 171 : G, ra = split ? 14336 : 0;
        if ((int)blockIdx.x < gg) { pg8::Gemm g{ATT, (const bf16_t*)(ws + WS_WOUT), T_TOK, 2048, 1024}; pg8::StaticOrder S; S.init(T_TOK, 2048, gg, (int)blockIdx.x);
            pg8::EpiOut E{args.in[I_X], args.out, mod}; pg8::gemm_phase<pg8::EpiOut, pg8::StaticOrder, true, true, 2>(lds, g, S, E); }
        else ph_table_cvt(args.in[I_PU], args.in[I_PV], ws + WS_UT, ws + WS_VT, 0, ra, ((int)blockIdx.x - gg) * 8 + wave, (G - gg) * 8, lane);
        ph_table_cvt(args.in[I_PU], args.in[I_PV], ws + WS_UT, ws + WS_VT, ra, 16384, gw, ngw, lane); });
    SEAM(7);
    PH(8, { ph_norm<false>(args.out, HB, nullptr, args.in[I_N2G], mod, 6144, 8192, gw, ngw, lane); });
    SEAM(8);
    PH(9, { pg8::Gemm g{HB, (const bf16_t*)(ws + WS_WSC), T_TOK, 2048, 2048}; pg8::StaticOrder S; S.init(T_TOK, 2048, G, (int)blockIdx.x);
        pg8::EpiF32 E{(float*)(ws + WS_SC)}; pg8::gemm_phase<pg8::EpiF32, pg8::StaticOrder, true, true>(lds, g, S, E); });
    SEAM(9);
    PH(10, { ph_peer_topk(lds, (const float*)(ws + WS_SC), (int*)(ws + WS_IDX), (float*)(ws + WS_GATE), G); });
    SEAM(10);
    PH(11, { ph_peer_u(ws + WS_UT, HB, (const int*)(ws + WS_IDX), (float*)(ws + WS_PDOT), G); });
    SEAM(11);
    PH(12, { ph_peer_act((const float*)(ws + WS_PDOT), (const float*)(ws + WS_GATE), (float*)(ws + WS_ACT), G); });
    SEAM(12);
    if (IN(13)) { if (DUP == 13) { ph_peer_v<true>(lds, ws + WS_VT, (const int*)(ws + WS_IDX), (const float*)(ws + WS_ACT), mod, args.out, G); xcd_barrier(bar); }
        ph_peer_v<false>(lds, ws + WS_VT, (const int*)(ws + WS_IDX), (const float*)(ws + WS_ACT), mod, args.out, G); }
#undef IN
#undef SEAM
}

extern "C" void kernel_launch(void* const* d_in, const int* in_sizes, int n_in, void* d_out, int out_size, void* d_ws, size_t ws_size, hipStream_t stream) {
    static int grid = 0;
    if (grid == 0) {
        if (n_in != 25 || out_size != T_TOK * DM || ws_size < WS_END) { fprintf(stderr, "kernel_launch: unexpected shapes (n_in %d out %d ws %zu need %zu)\n", n_in, out_size, ws_size, (size_t)WS_END); grid = -1; return; }
        int dev = 0, cus = 0, per_cu = 0;
        if (hipGetDevice(&dev) != hipSuccess || hipDeviceGetAttribute(&cus, hipDeviceAttributeMultiprocessorCount, dev) != hipSuccess) { grid = -1; return; }
        if (hipFuncSetAttribute((const void*)mk_fwd, hipFuncAttributeMaxDynamicSharedMemorySize, LDS_BYTES) != hipSuccess) { fprintf(stderr, "kernel_launch: hipFuncSetAttribute failed\n"); grid = -1; return; }
        if (hipOccupancyMaxActiveBlocksPerMultiprocessor(&per_cu, (const void*)mk_fwd, 512, LDS_BYTES) != hipSuccess || per_cu < 1) { fprintf(stderr, "kernel_launch: occupancy query says %d blocks/CU\n", per_cu); (void)hipGetLastError(); grid = -1; return; }
        grid = cus;
    }
    if (grid < 0) return;
    (void)hipMemsetAsync((char*)d_ws + WS_CTL, 0, 16384, stream);
    Args a{};
    for (int i = 0; i < 25; ++i) a.in[i] = (const float*)d_in[i];
    a.out = (float*)d_out; a.ws = (unsigned char*)d_ws;
#if MK_PER_PHASE
    for (int ph = 0; ph < NPHASE; ++ph) { a.ph_lo = ph; a.ph_hi = ph + 1; hipLaunchKernelGGL(mk_fwd, dim3(grid), dim3(512), LDS_BYTES, stream, a); }
#else
    a.ph_lo = 0; a.ph_hi = NPHASE;
    hipLaunchKernelGGL(mk_fwd, dim3(grid), dim3(512), LDS_BYTES, stream, a);
#endif
}
```

```cpp
#include <hip/hip_runtime.h>
#include <cstdio>
#include <cstdint>

#ifndef MK_PER_PHASE
#define MK_PER_PHASE 0
#endif

#ifndef DUP
#define DUP -1
#endif
#define LAS __attribute__((address_space(3)))
typedef unsigned short bf16_t;
typedef short bf16x8 __attribute__((ext_vector_type(8)));
typedef float f32x4 __attribute__((ext_vector_type(4)));
typedef float f32x2 __attribute__((ext_vector_type(2)));
typedef unsigned u32x4 __attribute__((ext_vector_type(4)));
typedef unsigned u32x2 __attribute__((ext_vector_type(2)));
typedef int i32x4 __attribute__((ext_vector_type(4)));

constexpr int T_TOK = 16384, DM = 2048, SEQ = 8192;
constexpr int NPHASE = 14;
constexpr float EPS = 1e-6f;

constexpr size_t WS_CTL   = 0;
constexpr size_t WS_MODP  = 65536;
constexpr size_t WS_MOD   = WS_MODP + (size_t)32 * 2 * 12288 * 4;
constexpr size_t WS_WIN   = WS_MOD + (size_t)2 * 12288 * 4;
constexpr size_t WS_WGLU  = WS_WIN + (size_t)8192 * 2048 * 2;
constexpr size_t WS_WATT  = WS_WGLU + (size_t)4096 * 1024 * 2;
constexpr size_t WS_WOUT  = WS_WATT + (size_t)2048 * 1024 * 2;
constexpr size_t WS_WSC   = WS_WOUT + (size_t)2048 * 2048 * 2;
constexpr size_t WS_H     = WS_WSC + (size_t)2048 * 2048 * 2;
constexpr size_t WS_PA    = WS_H + (size_t)T_TOK * 2048 * 2;
constexpr size_t WS_PG    = WS_PA + (size_t)T_TOK * 4096 * 2;
constexpr size_t WS_E     = WS_PG + (size_t)T_TOK * 4096 * 2;
constexpr size_t WS_YA    = WS_E + (size_t)2 * 64 * 128 * 64 * 8;
constexpr size_t WS_ATT   = WS_YA + (size_t)T_TOK * 1024 * 2;
constexpr size_t WS_UB    = WS_ATT + (size_t)T_TOK * 1024 * 2;
constexpr size_t WS_SA    = WS_UB + (size_t)T_TOK * 1024 * 2;
constexpr size_t WS_SB    = WS_SA + (size_t)T_TOK * 4;
constexpr size_t WS_CMAXP = WS_SB + (size_t)8192 * 4;
constexpr size_t WS_END   = WS_CMAXP + (size_t)32 * 8192 * 4;
constexpr size_t WS_SC    = WS_PA;
constexpr size_t WS_UT    = WS_PG;
constexpr size_t WS_VT    = WS_PG + (size_t)8 * 16384 * 192;
constexpr size_t WS_PDOT  = WS_VT + (size_t)8 * 16384 * 192;
constexpr size_t WS_IDX   = WS_YA;
constexpr size_t WS_GATE  = WS_YA + (size_t)T_TOK * 128 * 4;
constexpr size_t WS_ACT   = WS_GATE + (size_t)T_TOK * 128 * 4;
static_assert(WS_PDOT + (size_t)8 * T_TOK * 128 * 4 <= WS_PG + (size_t)T_TOK * 4096 * 2, "PEER buffers must fit the dead g_ssm|g_att region");
static_assert(WS_ACT + (size_t)T_TOK * 128 * 4 <= WS_YA + (size_t)T_TOK * 1024 * 2, "PEER index buffers must fit the dead YA region");
constexpr int LDS_MAIN = 131072, LDS_BYTES = LDS_MAIN + 256;

typedef __bf16 bf16x2_t __attribute__((ext_vector_type(2)));
__device__ __forceinline__ unsigned cvt_pk_bf16(float lo, float hi) { const f32x2 v = {lo, hi}; return __builtin_bit_cast(unsigned, __builtin_convertvector(v, bf16x2_t)); }
__device__ __forceinline__ float bf_lo(unsigned w) { return __uint_as_float(w << 16); }
__device__ __forceinline__ float bf_hi(unsigned w) { return __uint_as_float(w & 0xffff0000u); }
__device__ __forceinline__ float wave_sum(float v) {
#pragma unroll
    for (int o = 1; o < 64; o <<= 1) v += __shfl_xor(v, o);
    return v;
}
__device__ __forceinline__ float sigmoidf_(float x) { return 1.0f / (1.0f + __expf(-x)); }
__device__ __forceinline__ float gelu_tanh(float x) {
    const float a = 0.7978845608028654f * (x + 0.044715f * x * x * x);
    const float t = 1.0f - 2.0f / (__expf(2.0f * a) + 1.0f);
    return 0.5f * x * (1.0f + t);
}
constexpr float F8_SA = 8.0f, F8_SW = 64.0f, F8_INV = 1.0f / 512.0f;
__device__ __forceinline__ unsigned pack4_fp8(float a, float b, float c, float d, float sc) {
    a = fminf(fmaxf(a * sc, -448.f), 448.f); b = fminf(fmaxf(b * sc, -448.f), 448.f); c = fminf(fmaxf(c * sc, -448.f), 448.f); d = fminf(fmaxf(d * sc, -448.f), 448.f);
    int p = 0; p = __builtin_amdgcn_cvt_pk_fp8_f32(a, b, p, false); p = __builtin_amdgcn_cvt_pk_fp8_f32(c, d, p, true); return (unsigned)p; }
__device__ __forceinline__ float sum8_dpp(float v) {
    v += __builtin_bit_cast(float, __builtin_amdgcn_update_dpp(0, __builtin_bit_cast(int, v), 0xB1, 0xF, 0xF, true));
    v += __builtin_bit_cast(float, __builtin_amdgcn_update_dpp(0, __builtin_bit_cast(int, v), 0x4E, 0xF, 0xF, true));
    v += __builtin_bit_cast(float, __builtin_amdgcn_update_dpp(0, __builtin_bit_cast(int, v), 0x141, 0xF, 0xF, true));
    return v; }
#define LDS_WAIT() asm volatile("s_waitcnt lgkmcnt(0)" ::: "memory")
__device__ __forceinline__ int opaque_tid() { int t = threadIdx.x; asm volatile("" : "+v"(t)); return t; }

#define XB_TMO      128
#define XB_XCNT(j)  (256  + 64 * (j))
#define XB_XSUB(j)  (1280 + 64 * (j))
#define XB_XGEN(j)  (2304 + 64 * (j))
#define XB_TOP      3328
#define XB_TOPGEN   3392
#define XCD_BAR_WORDS 3456
#define XB_SPIN_CAP (1u << 22)
__device__ __forceinline__ unsigned xb_ld(unsigned* p)              { return __hip_atomic_load(p, __ATOMIC_RELAXED, __HIP_MEMORY_SCOPE_AGENT); }
__device__ __forceinline__ unsigned xb_add(unsigned* p, unsigned v) { return __hip_atomic_fetch_add(p, v, __ATOMIC_RELAXED, __HIP_MEMORY_SCOPE_AGENT); }
__device__ __forceinline__ unsigned xb_xcc_id() { return (unsigned)__builtin_amdgcn_s_getreg((3 << 11) | 20) & 0xFu; }
#define XB_SPIN(cond, bar) do { unsigned _sp = 0; while (cond) { __builtin_amdgcn_s_sleep(1); \
    if ((++_sp & 255u) == 0u) { if (xb_ld(&(bar)[XB_TMO])) break; if (_sp > XB_SPIN_CAP) { atomicAdd(&(bar)[XB_TMO], 1u); break; } } } } while (0)
struct XcdBarrier { unsigned* bar; unsigned x; volatile LAS unsigned* st; };
__device__ __forceinline__ XcdBarrier xcd_barrier_post(unsigned* bar, volatile LAS unsigned* st) {
    XcdBarrier b; b.bar = bar; b.x = xb_xcc_id(); b.st = st;
    if (threadIdx.x == 0) (void)xb_add(&bar[XB_XCNT(b.x)], 1u);
    return b;
}
__device__ __forceinline__ void xcd_barrier_complete(unsigned* bar, unsigned x, unsigned& nloc, unsigned& nx) {
    const unsigned G = gridDim.x * gridDim.y * gridDim.z;
    unsigned sum, cnt, mine, sp = 0u;
    for (;;) {
        sum = 0u; cnt = 0u; mine = 0u;
#pragma unroll
        for (unsigned j = 0; j < 16; ++j) { const unsigned c = xb_ld(&bar[XB_XCNT(j)]); sum += c; cnt += (c > 0u) ? 1u : 0u; mine = (j == x) ? c : mine; }
        if (sum == G) break;
        __builtin_amdgcn_s_sleep(1);
        if ((++sp & 255u) == 0u) { if (xb_ld(&bar[XB_TMO])) break; if (sp > XB_SPIN_CAP) { atomicAdd(&bar[XB_TMO], 1u); break; } }
    }
    nloc = mine > 0u ? mine : 1u; nx = cnt > 0u ? cnt : 1u;
}
__device__ __forceinline__ void xcd_barrier(const XcdBarrier& b) {
    asm volatile("s_waitcnt vmcnt(0)" ::: "memory");
    __syncthreads();
    if (threadIdx.x == 0) {
        unsigned* bar = b.bar;
        __builtin_amdgcn_s_waitcnt(0);
        unsigned nloc = b.st[0], nx = b.st[1];
        if (nloc == 0u) { xcd_barrier_complete(bar, b.x, nloc, nx); b.st[0] = nloc; b.st[1] = nx; }
        const unsigned old = xb_add(&bar[XB_XSUB(b.x)], 1u);
        const unsigned gen = old / nloc;
        if (old + 1u == (gen + 1u) * nloc) {
            __builtin_amdgcn_fence(__ATOMIC_RELEASE, "agent");
            asm volatile("s_waitcnt vmcnt(0)" ::: "memory");
            const unsigned og = xb_add(&bar[XB_TOP], 1u);
            const unsigned tg = og / nx;
            if (og + 1u == (tg + 1u) * nx) xb_add(&bar[XB_TOPGEN], 1u);
            else XB_SPIN(xb_ld(&bar[XB_TOPGEN]) == tg, bar);
            __builtin_amdgcn_fence(__ATOMIC_ACQUIRE, "agent");
            xb_add(&bar[XB_XGEN(b.x)], 1u);
            asm volatile("s_waitcnt vmcnt(0)" ::: "memory");
        } else {
            XB_SPIN(xb_ld(&bar[XB_XGEN(b.x)]) == gen, bar);
            __builtin_amdgcn_fence(__ATOMIC_ACQUIRE, "agent");
            asm volatile("s_waitcnt vmcnt(0)" ::: "memory");
        }
    }
    __syncthreads();
}

namespace pg8 {
constexpr int BM = 256, BK = 64, HALF = 128, HTB = HALF * BK * 2, STAGE_BYTES = 8 * HTB, NXCD = 8, WGM = 8;
__host__ __device__ __forceinline__ int lds_byte(int r, int c) { const int st = (r >> 4) * 2 + (c >> 5), rr = r & 15, cc = c & 31, ob = rr * 64 + cc * 2; return st * 1024 + (ob ^ (((ob >> 9) & 1) << 5)); }
__host__ __device__ __forceinline__ void stage_rc(int b, int& R, int& C) { const int st = b / 1024, sb = b % 1024, swz = sb ^ (((sb >> 9) & 1) << 5); R = (st >> 1) * 16 + swz / 64; C = (st & 1) * 32 + (swz % 64) / 2; }
__host__ __device__ __forceinline__ int perm32(int rho) { const int n = rho >> 4, i = rho & 15; return 8 * (i >> 2) + 4 * n + (i & 3); }
struct Unit { int pm, pn; };
struct Gemm { const bf16_t* A; const bf16_t* Bt; int M, N, K; };
struct StaticOrder {
    int nM, nN, nwg, G, c;
    __host__ __device__ void init(int M, int N, int G_, int c_) { nM = M / BM; nN = N / BM; nwg = nM * nN; G = G_; c = c_; }
    __host__ __device__ bool next(int i, Unit& u) const { return at((long)i * G + c, u); }
    __host__ __device__ bool at(long L, Unit& u) const {
        if (L >= nwg) return false;
        int wgid = (int)L; { const int q = nwg / NXCD, r = nwg % NXCD, xcd = wgid % NXCD, off = wgid / NXCD; wgid = (xcd < r ? xcd * (q + 1) : r * (q + 1) + (xcd - r) * q) + off; }
        const int nig = WGM * nN, gid = wgid / nig, fm = gid * WGM, gsz = (nM - fm) < WGM ? (nM - fm) : WGM;
        u.pm = fm + ((wgid % nig) % gsz); u.pn = (wgid % nig) / gsz; return true;
    }
    __device__ __forceinline__ void a_ready(const Unit&) const {}
    __device__ __forceinline__ void done(const Unit&) const {}
};
struct SplitOrder {
    StaticOrder b;
    __host__ __device__ void init(int M, int N, int G_, int c_) { b.init(M, N, G_, c_); }
    __host__ __device__ bool next(int i, Unit& u) const {
        if (b.G != 256 || b.nwg != 512) return b.next(i, u);
        if (b.c < 128) return false;
        return i < 4 ? b.at((b.c - 128) * 4 + i, u) : false;
    }
    __device__ __forceinline__ void a_ready(const Unit&) const {}
    __device__ __forceinline__ void done(const Unit&) const {}
};
typedef int i32x8 __attribute__((ext_vector_type(8)));
template <class Epi, class Sched, bool ALIGN_EPI = false, bool SP2 = false, int MODE = 0>
__device__ __forceinline__ void gemm_phase(LAS unsigned char* lds, const Gemm g, const Sched& S, const Epi& E) {
    const int tid = threadIdx.x, wid = __builtin_amdgcn_readfirstlane(tid >> 6), lane = tid & 63, wr = wid >> 2, wc = wid & 3, fr = lane & 15, fq = lane >> 4;
    const int K = g.K, nt = K / BK;
    unsigned voffA[2], voffB[2];
#pragma unroll
    for (int i = 0; i < 2; ++i) { int R, C; stage_rc(tid * 16 + i * 8192, R, C); const int Rb = Epi::PERM ? ((R & ~31) + perm32(R & 31)) : R;
        voffA[i] = (unsigned)(R * K + C) * 2u; voffB[i] = (unsigned)(Rb * K + C) * 2u; }
    const size_t kstep = (size_t)(BK * 2);
    const size_t hstep = (size_t)HALF * K * 2;
    const size_t tstep = 2 * hstep;
    const unsigned ldsw = (unsigned)wid * 1024u;
    const int aoff = lds_byte(wr * 64 + fr, fq * 8), boff = lds_byte(wc * 32 + fr, fq * 8);
#define PG8_SA(b, h) (((b) * 2 + (h)) * HTB)
#define PG8_SB(b, h) ((4 + (b) * 2 + (h)) * HTB)
#define PG8_STAGE(bufoff, gbase, voff) do { _Pragma("unroll") for (int _i = 0; _i < 2; ++_i) \
        __builtin_amdgcn_global_load_lds((const unsigned*)((const char*)(gbase) + (voff)[_i]), (LAS unsigned*)(lds + (bufoff) + ldsw + _i * 8192), 16, 0, 0); } while (0)
#define PG8_LD8(p_) ({ const i32x4 _lo = *(const LAS i32x4*)(p_), _hi = *(const LAS i32x4*)((p_) + 1024); (i32x8){_lo[0], _lo[1], _lo[2], _lo[3], _hi[0], _hi[1], _hi[2], _hi[3]}; })
#define PG8_LDA(dst, b, h) do { _Pragma("unroll") for (int m = 0; m < 4; ++m) dst[m] = PG8_LD8(lds + PG8_SA(b, h) + aoff + m * 2048); } while (0)
#define PG8_LDB(dst, b, h) do { _Pragma("unroll") for (int n = 0; n < 2; ++n) dst[n] = PG8_LD8(lds + PG8_SB(b, h) + boff + n * 2048); } while (0)
#define PG8_HALF(v, k) ((k) == 0 ? __builtin_shufflevector(v, v, 0, 1, 2, 3) : __builtin_shufflevector(v, v, 4, 5, 6, 7))
#define PG8_MMA(ai, bj, At, Bt) do { __builtin_amdgcn_s_setprio(1); _Pragma("unroll") for (int m = 0; m < 4; ++m) _Pragma("unroll") for (int n = 0; n < 2; ++n) { \
        if (MODE == 2) asm volatile("v_mfma_scale_f32_16x16x128_f8f6f4 %0, %1, %2, %0, %3, %3 op_sel_hi:[0,0,0]" : "+v"(acc[ai][bj][m][n]) : "v"(Bt[n]), "v"(At[m]), "v"(scl1)); \
        else { _Pragma("unroll") for (int k = 0; k < 2; ++k) \
            acc[ai][bj][m][n] = (MODE == 1) ? __builtin_bit_cast(f32x4, __builtin_amdgcn_mfma_i32_16x16x64_i8(PG8_HALF(Bt[n], k), PG8_HALF(At[m], k), __builtin_bit_cast(i32x4, acc[ai][bj][m][n]), 0, 0, 0)) \
                                            : __builtin_amdgcn_mfma_f32_16x16x32_bf16(__builtin_bit_cast(bf16x8, PG8_HALF(Bt[n], k)), __builtin_bit_cast(bf16x8, PG8_HALF(At[m], k)), acc[ai][bj][m][n], 0, 0, 0); } } __builtin_amdgcn_s_setprio(0); } while (0)
#define PG8_WAIT_V(n) asm volatile("s_waitcnt vmcnt(" #n ")" ::: "memory")
#define PG8_WAIT_L(n) asm volatile("s_waitcnt lgkmcnt(" #n ")" ::: "memory")
#define PG8_BAR __builtin_amdgcn_s_barrier()
#define PG8_SCHED __builtin_amdgcn_sched_barrier(0)
    const int scl1 = 0x7f7f7f7f;
    Unit cur, nxt; int ui = 0;
    if (!S.next(0, cur)) return;
    f32x4 acc[2][2][4][2];
#pragma unroll
    for (int a = 0; a < 2; ++a)
#pragma unroll
        for (int b = 0; b < 2; ++b)
#pragma unroll
            for (int m = 0; m < 4; ++m)
#pragma unroll
                for (int n = 0; n < 2; ++n) acc[a][b][m][n] = (f32x4){0.f, 0.f, 0.f, 0.f};
    i32x8 At[4], B0[2], B1[2];
    const char* cA = (const char*)g.A + (size_t)cur.pm * tstep; const char* cB = (const char*)g.Bt + (size_t)cur.pn * tstep;
    S.a_ready(cur);
    if constexpr (SP2) {
        PG8_STAGE(PG8_SB(0, 0), cB, voffB); PG8_STAGE(PG8_SB(0, 1), cB + hstep, voffB); PG8_STAGE(PG8_SA(0, 0), cA, voffA); PG8_STAGE(PG8_SA(0, 1), cA + hstep, voffA);
        if (wr == 1) PG8_BAR;
        PG8_WAIT_V(2); PG8_BAR;
        PG8_STAGE(PG8_SB(1, 0), cB + kstep, voffB); PG8_STAGE(PG8_SA(1, 0), cA + kstep, voffA); PG8_STAGE(PG8_SB(1, 1), cB + hstep + kstep, voffB);
        PG8_WAIT_V(6); PG8_BAR;
    } else {
        PG8_STAGE(PG8_SB(0, 0), cB, voffB); PG8_STAGE(PG8_SA(0, 0), cA, voffA); PG8_STAGE(PG8_SB(0, 1), cB + hstep, voffB); PG8_STAGE(PG8_SA(0, 1), cA + hstep, voffA);
        if (wr == 1) PG8_BAR;
        PG8_WAIT_V(4); PG8_BAR;
        PG8_STAGE(PG8_SB(1, 0), cB + kstep, voffB); PG8_STAGE(PG8_SA(1, 0), cA + kstep, voffA); PG8_STAGE(PG8_SB(1, 1), cB + hstep + kstep, voffB);
        PG8_WAIT_V(6); PG8_BAR;
    }
    for (;;) {
        const bool has_next = S.next(ui + 1, nxt);
        const char* nA = has_next ? (const char*)g.A + (size_t)nxt.pm * tstep : cA; const char* nB = has_next ? (const char*)g.Bt + (size_t)nxt.pn * tstep : cB;
#pragma unroll 1
        for (int t = 0; t < nt; t += 2) {
            const bool last = (t == nt - 2);
            const char* a1 = cA + (size_t)(t + 1) * kstep;
            const char* a2 = last ? nA : cA + (size_t)(t + 2) * kstep; const char* b2 = last ? nB : cB + (size_t)(t + 2) * kstep;
            const char* a3 = a2 + kstep; const char* b3 = b2 + kstep;
            if (last && has_next) S.a_ready(nxt);
            if constexpr (SP2) {
            PG8_LDB(B0, 0, 0); PG8_LDB(B1, 0, 1); PG8_SCHED; PG8_LDA(At, 0, 0); PG8_STAGE(PG8_SA(1, 1), a1 + hstep, voffA);
            PG8_WAIT_V(8); PG8_WAIT_L(0); PG8_BAR; PG8_MMA(0, 0, At, B0); PG8_MMA(0, 1, At, B1); PG8_BAR; PG8_SCHED;
            PG8_LDA(At, 0, 1); PG8_STAGE(PG8_SB(0, 0), b2, voffB); PG8_STAGE(PG8_SB(0, 1), b2 + hstep, voffB); PG8_STAGE(PG8_SA(0, 0), a2, voffA);
            PG8_WAIT_V(8); PG8_WAIT_L(0); PG8_BAR; PG8_MMA(1, 0, At, B0); PG8_MMA(1, 1, At, B1); PG8_BAR; PG8_SCHED;
            PG8_LDB(B0, 1, 0); PG8_LDB(B1, 1, 1); PG8_SCHED; PG8_LDA(At, 1, 0); PG8_STAGE(PG8_SA(0, 1), a2 + hstep, voffA);
            PG8_WAIT_V(8); PG8_WAIT_L(0); PG8_BAR; PG8_MMA(0, 0, At, B0); PG8_MMA(0, 1, At, B1); PG8_BAR; PG8_SCHED;
            PG8_LDA(At, 1, 1); PG8_STAGE(PG8_SB(1, 0), b3, voffB); PG8_STAGE(PG8_SB(1, 1), b3 + hstep, voffB); PG8_STAGE(PG8_SA(1, 0), a3, voffA);
            PG8_WAIT_V(8); PG8_WAIT_L(0); PG8_BAR; PG8_MMA(1, 0, At, B0); PG8_MMA(1, 1, At, B1); PG8_BAR; PG8_SCHED;
            } else {
            PG8_LDB(B0, 0, 0); PG8_SCHED; PG8_LDA(At, 0, 0); PG8_STAGE(PG8_SA(1, 1), a1 + hstep, voffA);
            PG8_WAIT_L(8); PG8_BAR; PG8_WAIT_L(0); PG8_MMA(0, 0, At, B0); PG8_BAR; PG8_SCHED;
            PG8_LDB(B1, 0, 1); PG8_STAGE(PG8_SB(0, 0), b2, voffB);
            PG8_BAR; PG8_WAIT_L(0); PG8_MMA(0, 1, At, B1); PG8_BAR;
            PG8_LDA(At, 0, 1); PG8_STAGE(PG8_SA(0, 0), a2, voffA);
            PG8_BAR; PG8_WAIT_L(0); PG8_MMA(1, 0, At, B0); PG8_BAR; PG8_SCHED;
            PG8_STAGE(PG8_SB(0, 1), b2 + hstep, voffB);
            PG8_WAIT_V(6); PG8_BAR; PG8_MMA(1, 1, At, B1); PG8_BAR;
            PG8_LDB(B0, 1, 0); PG8_SCHED; PG8_LDA(At, 1, 0); PG8_STAGE(PG8_SA(0, 1), a2 + hstep, voffA);
            PG8_WAIT_L(8); PG8_BAR; PG8_WAIT_L(0); PG8_MMA(0, 0, At, B0); PG8_BAR; PG8_SCHED;
            PG8_LDB(B1, 1, 1); PG8_STAGE(PG8_SB(1, 0), b3, voffB);
            PG8_BAR; PG8_WAIT_L(0); PG8_MMA(0, 1, At, B1); PG8_BAR;
            PG8_LDA(At, 1, 1); PG8_STAGE(PG8_SA(1, 0), a3, voffA);
            PG8_BAR; PG8_WAIT_L(0); PG8_MMA(1, 0, At, B0); PG8_BAR; PG8_SCHED;
            PG8_STAGE(PG8_SB(1, 1), b3 + hstep, voffB);
            PG8_WAIT_V(6); PG8_BAR; PG8_MMA(1, 1, At, B1); PG8_BAR;
            }
        }
        if constexpr (ALIGN_EPI) { if (wr == 0) PG8_BAR; }
        if (MODE == 2) asm volatile("s_nop 15\n\ts_nop 15" ::: "memory");
        E(acc, cur, wr, wc, fr, fq); S.done(cur);
        if (!has_next) break;
#pragma unroll
        for (int a = 0; a < 2; ++a)
#pragma unroll
            for (int b = 0; b < 2; ++b)
#pragma unroll
                for (int m = 0; m < 4; ++m)
#pragma unroll
                    for (int n = 0; n < 2; ++n) acc[a][b][m][n] = (f32x4){0.f, 0.f, 0.f, 0.f};
        cur = nxt; cA = nA; cB = nB; ++ui;
        if constexpr (ALIGN_EPI) { if (wr == 1) PG8_BAR; }
    }
    PG8_WAIT_V(0);
    if constexpr (!ALIGN_EPI) { if (wr == 0) PG8_BAR; }
    PG8_BAR;
#undef PG8_SA
#undef PG8_SB
#undef PG8_STAGE
#undef PG8_LDA
#undef PG8_LDB
#undef PG8_MMA
#undef PG8_WAIT_V
#undef PG8_WAIT_L
#undef PG8_BAR
#undef PG8_SCHED
}

struct EpiProj {
    static constexpr bool PERM = true;
    bf16_t* PA; bf16_t* PG; bf16_t* UB; const float* SA; const float* SB;
    __device__ __forceinline__ void operator()(const f32x4 (&acc)[2][2][4][2], const Unit& u, int wr, int wc, int fr, int fq) const {
        const int row0 = u.pm * BM + wr * 64 + fr; int colt = u.pn * BM; const bool isu = colt < 1024; bf16_t* base = colt < 4096 ? PA : PG;
        const int gcol0 = colt + wc * 32 + 8 * fq; colt &= 4095;
        const int col0 = colt + wc * 32 + 8 * fq;
        f32x4 sb[2][2];
#pragma unroll
        for (int bj = 0; bj < 2; ++bj) { sb[bj][0] = *(const f32x4*)(SB + gcol0 + bj * HALF); sb[bj][1] = *(const f32x4*)(SB + gcol0 + bj * HALF + 4); }
#pragma unroll
        for (int ai = 0; ai < 2; ++ai)
#pragma unroll
            for (int m = 0; m < 4; ++m) { const int row = row0 + ai * HALF + m * 16; bf16_t* rowp = base + (size_t)row * 4096 + col0; const float sa = SA[row];
#pragma unroll
                for (int bj = 0; bj < 2; ++bj) { const i32x4 i0 = __builtin_bit_cast(i32x4, acc[ai][bj][m][0]), i1 = __builtin_bit_cast(i32x4, acc[ai][bj][m][1]);
                    f32x4 v0, v1;
#pragma unroll
                    for (int e = 0; e < 4; ++e) { v0[e] = (float)i0[e] * sa * sb[bj][0][e]; v1[e] = (float)i1[e] * sa * sb[bj][1][e]; }
                    u32x4 w; w.x = cvt_pk_bf16(v0[0], v0[1]); w.y = cvt_pk_bf16(v0[2], v0[3]); w.z = cvt_pk_bf16(v1[0], v1[1]); w.w = cvt_pk_bf16(v1[2], v1[3]);
                    if (isu) { const int cu = col0 + bj * HALF; *(u32x4*)(UB + (((size_t)((row >> 13) * 64 + (cu >> 4)) * 8192 + (row & 8191)) * 16 + (cu & 8))) = w; }
                    else *(u32x4*)(rowp + bj * HALF) = w; } }
    }
};
struct EpiAttUp {
    static constexpr bool PERM = true;
    const bf16_t* PG; bf16_t* HB;
    __device__ __forceinline__ void operator()(const f32x4 (&acc)[2][2][4][2], const Unit& u, int wr, int wc, int fr, int fq) const {
        const int row0 = u.pm * BM + wr * 64 + fr; const int col0 = u.pn * BM + wc * 32 + 8 * fq;
#pragma unroll
        for (int ai = 0; ai < 2; ++ai)
#pragma unroll
            for (int m = 0; m < 4; ++m) { const size_t row = (size_t)(row0 + ai * HALF + m * 16);
#pragma unroll
                for (int bj = 0; bj < 2; ++bj) { const int col = col0 + bj * HALF;
                    const u32x4 gw = *(const u32x4*)(PG + row * 4096 + 2048 + col);
                    const f32x4 v0 = acc[ai][bj][m][0] * F8_INV, v1 = acc[ai][bj][m][1] * F8_INV;
                    u32x4 w;
                    w.x = cvt_pk_bf16(v0[0] * sigmoidf_(bf_lo(gw.x)), v0[1] * sigmoidf_(bf_hi(gw.x)));
                    w.y = cvt_pk_bf16(v0[2] * sigmoidf_(bf_lo(gw.y)), v0[3] * sigmoidf_(bf_hi(gw.y)));
                    w.z = cvt_pk_bf16(v1[0] * sigmoidf_(bf_lo(gw.z)), v1[1] * sigmoidf_(bf_hi(gw.z)));
                    w.w = cvt_pk_bf16(v1[2] * sigmoidf_(bf_lo(gw.w)), v1[3] * sigmoidf_(bf_hi(gw.w)));
                    *(u32x4*)(HB + row * 2048 + col) = w; } asm volatile("" ::: "memory"); }
    }
};
struct EpiGlu {
    static constexpr bool PERM = true;
    const bf16_t* PG; const bf16_t* HB; unsigned char* M8;
    __device__ __forceinline__ void operator()(const f32x4 (&acc)[2][2][4][2], const Unit& u, int wr, int wc, int fr, int fq) const {
        const int row0 = u.pm * BM + wr * 64 + fr; const int col = u.pn * HALF + wc * 32 + 8 * fq;
#pragma unroll
        for (int ai = 0; ai < 2; ++ai)
#pragma unroll
            for (int m = 0; m < 4; ++m) { const size_t row = (size_t)(row0 + ai * HALF + m * 16);
                const u32x4 gw = *(const u32x4*)(PG + row * 4096 + col);
                const u32x4 aw = *(const u32x4*)(HB + row * 2048 + col);
                const f32x4 a0 = acc[ai][0][m][0] * F8_INV, a1 = acc[ai][0][m][1] * F8_INV, g0 = acc[ai][1][m][0] * F8_INV, g1 = acc[ai][1][m][1] * F8_INV;
                u32x2 w;
                w.x = pack4_fp8(sigmoidf_(bf_lo(gw.x)) * a0[0] * sigmoidf_(g0[0]) + bf_lo(aw.x), sigmoidf_(bf_hi(gw.x)) * a0[1] * sigmoidf_(g0[1]) + bf_hi(aw.x),
                                sigmoidf_(bf_lo(gw.y)) * a0[2] * sigmoidf_(g0[2]) + bf_lo(aw.y), sigmoidf_(bf_hi(gw.y)) * a0[3] * sigmoidf_(g0[3]) + bf_hi(aw.y), F8_SA);
                w.y = pack4_fp8(sigmoidf_(bf_lo(gw.z)) * a1[0] * sigmoidf_(g1[0]) + bf_lo(aw.z), sigmoidf_(bf_hi(gw.z)) * a1[1] * sigmoidf_(g1[1]) + bf_hi(aw.z),
                                sigmoidf_(bf_lo(gw.w)) * a1[2] * sigmoidf_(g1[2]) + bf_lo(aw.w), sigmoidf_(bf_hi(gw.w)) * a1[3] * sigmoidf_(g1[3]) + bf_hi(aw.w), F8_SA);
                *(u32x2*)(M8 + row * 2048 + col) = w; asm volatile("" ::: "memory"); }
    }
};
struct EpiOut {
    static constexpr bool PERM = true;
    const float* X; float* O; const float* mod;
    __device__ __forceinline__ void operator()(const f32x4 (&acc)[2][2][4][2], const Unit& u, int wr, int wc, int fr, int fq) const {
        const int row0 = u.pm * BM + wr * 64 + fr; const int col0 = u.pn * BM + wc * 32 + 8 * fq;
        const float* gt = mod + (size_t)((u.pm * BM) >> 13) * 12288 + 4096;
#pragma unroll
        for (int bj = 0; bj < 2; ++bj) { const int col = col0 + bj * HALF;
            const f32x4 g0 = *(const f32x4*)(gt + col), g1 = *(const f32x4*)(gt + col + 4);
#pragma unroll
            for (int ai = 0; ai < 2; ++ai)
#pragma unroll
                for (int m = 0; m < 4; ++m) { const size_t off = (size_t)(row0 + ai * HALF + m * 16) * 2048 + col;
                    const f32x4 x0 = *(const f32x4*)(X + off), x1 = *(const f32x4*)(X + off + 4);
                    *(f32x4*)(O + off) = x0 + g0 * (acc[ai][bj][m][0] * F8_INV); *(f32x4*)(O + off + 4) = x1 + g1 * (acc[ai][bj][m][1] * F8_INV); } }
    }
};
struct EpiF32 {
    static constexpr bool PERM = true;
    float* O;
    __device__ __forceinline__ void operator()(const f32x4 (&acc)[2][2][4][2], const Unit& u, int wr, int wc, int fr, int fq) const {
        const int row0 = u.pm * BM + wr * 64 + fr; const int col0 = u.pn * BM + wc * 32 + 8 * fq;
#pragma unroll
        for (int ai = 0; ai < 2; ++ai)
#pragma unroll
            for (int m = 0; m < 4; ++m) { float* rowp = O + (size_t)(row0 + ai * HALF + m * 16) * 2048 + col0;
#pragma unroll
                for (int bj = 0; bj < 2; ++bj) { *(f32x4*)(rowp + bj * HALF) = acc[ai][bj][m][0]; *(f32x4*)(rowp + bj * HALF + 4) = acc[ai][bj][m][1]; } }
    }
};
}

struct Args { const float* in[25]; float* out; unsigned char* ws; int ph_lo, ph_hi; };
enum { I_X = 0, I_C, I_WADA, I_BADA, I_N1G, I_WIN, I_LRE, I_LIM, I_LDT, I_BRE, I_BIM, I_CRE, I_CIM, I_SD, I_WGLU, I_QNG, I_KNG, I_WATT, I_WOUT, I_N2G, I_WQ, I_K1, I_K2, I_PU, I_PV };

__device__ __forceinline__ void ph_mod_partial(const float* __restrict__ c, const float* __restrict__ w_ada, float* modp, int gw, int ngw, int lane) {
    for (int task = gw; task < 48 * 32; task += ngw) {
        const int strip = task % 48, ks = task / 48, n0 = strip * 256 + lane * 4, k0 = ks * 64;
        f32x4 a0 = {0.f, 0.f, 0.f, 0.f}, a1 = {0.f, 0.f, 0.f, 0.f};
#pragma unroll 8
        for (int k = 0; k < 64; ++k) {
            const f32x4 w = *(const f32x4*)(w_ada + (size_t)(k0 + k) * 12288 + n0);
            float c0 = c[k0 + k], c1 = c[2048 + k0 + k];
            c0 = c0 / (1.0f + __expf(-c0)); c1 = c1 / (1.0f + __expf(-c1));
            a0 += c0 * w; a1 += c1 * w;
        }
        *(f32x4*)(modp + (size_t)(ks * 2 + 0) * 12288 + n0) = a0;
        *(f32x4*)(modp + (size_t)(ks * 2 + 1) * 12288 + n0) = a1;
    }
}

__device__ __forceinline__ void ph_colmax_partial(const float* __restrict__ w_in, float* cmaxp, int gw, int ngw, int lane) {
    for (int task = gw; task < 32 * 32; task += ngw) {
        const int strip = task & 31, ks = task >> 5, n0 = strip * 256 + lane * 4, k0 = ks * 64;
        f32x4 m = {0.f, 0.f, 0.f, 0.f};
#pragma unroll 8
        for (int k = 0; k < 64; ++k) { const f32x4 w = *(const f32x4*)(w_in + (size_t)(k0 + k) * 8192 + n0);
            m[0] = fmaxf(m[0], fabsf(w[0])); m[1] = fmaxf(m[1], fabsf(w[1])); m[2] = fmaxf(m[2], fabsf(w[2])); m[3] = fmaxf(m[3], fabsf(w[3])); }
        *(f32x4*)(cmaxp + (size_t)ks * 8192 + n0) = m;
    }
}

__device__ __forceinline__ void transpose_item_f8(const float* __restrict__ W, int K, int N, unsigned char* WT8, int drow0, int scol0, int k0, LAS float* scr, int lane) {
#pragma unroll 8
    for (int i = 0; i < 32; ++i) { const int kk = 2 * i + (lane >> 5); scr[kk * 33 + (lane & 31)] = W[(size_t)(k0 + kk) * N + scol0 + (lane & 31)]; }
    LDS_WAIT();
    const int n = lane >> 1, half = lane & 1;
    const LAS float* s = scr + (32 * half) * 33 + n;
    u32x4 o[2];
#pragma unroll
    for (int q = 0; q < 8; ++q) o[q >> 2][q & 3] = pack4_fp8(s[(4 * q) * 33], s[(4 * q + 1) * 33], s[(4 * q + 2) * 33], s[(4 * q + 3) * 33], F8_SW);
    *(u32x4*)(WT8 + (size_t)(drow0 + n) * K + k0 + 32 * half) = o[0];
    *(u32x4*)(WT8 + (size_t)(drow0 + n) * K + k0 + 32 * half + 16) = o[1];
    LDS_WAIT();
}
__device__ __forceinline__ void transpose_item_i8(const float* __restrict__ W, signed char* WT8, const float* cmaxp, float* SB, int n0, int k0, LAS float* scr, int lane) {
#pragma unroll 8
    for (int i = 0; i < 32; ++i) { const int kk = 2 * i + (lane >> 5); scr[kk * 33 + (lane & 31)] = W[(size_t)(k0 + kk) * 8192 + n0 + (lane & 31)]; }
    const int n = lane >> 1, half = lane & 1;
    float cm = 0.f;
#pragma unroll 8
    for (int ks = 0; ks < 32; ++ks) cm = fmaxf(cm, cmaxp[(size_t)ks * 8192 + n0 + n]);
    const float sb = fmaxf(cm, 1e-30f) * (1.0f / 127.0f), inv = 1.0f / sb;
    if (k0 == 0 && half == 0) SB[n0 + n] = sb;
    LDS_WAIT();
    const LAS float* s = scr + (32 * half) * 33 + n;
    u32x4 o[2];
#pragma unroll
    for (int q = 0; q < 8; ++q) { unsigned w = 0;
#pragma unroll
        for (int e = 0; e < 4; ++e) { const int v = (int)rintf(s[(4 * q + e) * 33] * inv); w |= ((unsigned)v & 0xffu) << (8 * e); }
        o[q >> 2][q & 3] = w; }
    *(u32x4*)(WT8 + (size_t)(n0 + n) * 2048 + k0 + 32 * half) = o[0];
    *(u32x4*)(WT8 + (size_t)(n0 + n) * 2048 + k0 + 32 * half + 16) = o[1];
    LDS_WAIT();
}

__device__ __forceinline__ void transpose_item(const float* __restrict__ W, int K, int N, bf16_t* WT, int drow0, int scol0, int k0, LAS float* scr, int lane) {
#pragma unroll 8
    for (int i = 0; i < 32; ++i) { const int kk = 2 * i + (lane >> 5); scr[kk * 33 + (lane & 31)] = W[(size_t)(k0 + kk) * N + scol0 + (lane & 31)]; }
    LDS_WAIT();
    const int c = lane & 7;
#pragma unroll
    for (int j = 0; j < 4; ++j) { const int n = (lane >> 3) + 8 * j; const LAS float* s = scr + (8 * c) * 33 + n;
        u32x4 o; o.x = cvt_pk_bf16(s[0 * 33], s[1 * 33]); o.y = cvt_pk_bf16(s[2 * 33], s[3 * 33]); o.z = cvt_pk_bf16(s[4 * 33], s[5 * 33]); o.w = cvt_pk_bf16(s[6 * 33], s[7 * 33]);
        *(u32x4*)(WT + (size_t)(drow0 + n) * K + k0 + 8 * c) = o; }
    LDS_WAIT();
}
__device__ __forceinline__ void wsc_item(const float* wq, const float* kk, bf16_t* out, int lane) {
    const int r = lane & 15, q = lane >> 4;
    f32x4 acc[8];
#pragma unroll
    for (int f = 0; f < 8; ++f) acc[f] = (f32x4){0.f, 0.f, 0.f, 0.f};
    const float* ap = kk + r * 128 + 4 * q; const float* bp = wq + (size_t)r * 2048 + 4 * q;
#pragma unroll 2
    for (int d0 = 0; d0 < 128; d0 += 16) {
        const f32x4 bv = *(const f32x4*)(bp + d0);
        f32x4 av[8];
#pragma unroll
        for (int f = 0; f < 8; ++f) av[f] = *(const f32x4*)(ap + f * 2048 + d0);
#pragma unroll
        for (int j = 0; j < 4; ++j)
#pragma unroll
            for (int f = 0; f < 8; ++f) acc[f] = __builtin_amdgcn_mfma_f32_16x16x4f32(av[f][j], bv[j], acc[f], 0, 0, 0);
    }
#pragma unroll
    for (int f = 0; f < 8; ++f)
#pragma unroll
        for (int i = 0; i < 4; ++i) out[(size_t)(16 * f + 4 * q + i) * 2048 + r] = (bf16_t)(cvt_pk_bf16(acc[f][i], 0.f) & 0xffffu);
}
__device__ __forceinline__ void ph_prologue(const Args& a, LAS unsigned char* lds, int gw, int ngw, int lane, int wave) {
    unsigned char* ws = a.ws;
    { const float* modp = (const float*)(ws + WS_MODP); float* mod = (float*)(ws + WS_MOD); const float* b_ada = a.in[I_BADA];
      for (int idx = gw * 64 + lane; idx < 2 * 12288; idx += ngw * 64) { const int b = idx / 12288, n = idx - b * 12288; float s = b_ada[n];
#pragma unroll 8
          for (int ks = 0; ks < 32; ++ks) s += modp[(size_t)(ks * 2 + b) * 12288 + n];
          mod[idx] = s; } }
    for (int item = gw; item < 2048; item += ngw) { const int hj = item >> 7, k0 = (item & 127) * 16;
        wsc_item(a.in[I_WQ] + (size_t)k0 * 2048 + hj * 128, (hj & 1) ? a.in[I_K2] : a.in[I_K1], (bf16_t*)(ws + WS_WSC) + (size_t)(hj * 128) * 2048 + k0, lane); }
    { LAS float* scr = (LAS float*)(lds + wave * 8448);
      constexpr int I_IN = 32 * 256, I_GLU = 16 * 128, I_ATT = 16 * 64, I_OUT = 32 * 64, NIT = I_IN + I_GLU + I_ATT + I_OUT;
      for (int it = gw; it < NIT; it += ngw) {
          int r = it;
          if (r < I_IN) { const int kb = r / 256, nb = r % 256; transpose_item_i8(a.in[I_WIN], (signed char*)(ws + WS_WIN), (const float*)(ws + WS_CMAXP), (float*)(ws + WS_SB), 32 * nb, 64 * kb, scr, lane); continue; } r -= I_IN;
          if (r < I_GLU) { const int kb = r / 128, nb = r % 128, dr = 32 * nb; const int sc = ((dr >> 7) & 1) * 2048 + (dr >> 8) * 128 + (dr & 127);
              transpose_item_f8(a.in[I_WGLU], 1024, 4096, ws + WS_WGLU, dr, sc, 64 * kb, scr, lane); continue; } r -= I_GLU;
          if (r < I_ATT) { const int kb = r / 64, nb = r % 64; transpose_item_f8(a.in[I_WATT], 1024, 2048, ws + WS_WATT, 32 * nb, 32 * nb, 64 * kb, scr, lane); continue; } r -= I_ATT;
          { const int kb = r / 64, nb = r % 64; transpose_item_f8(a.in[I_WOUT], 2048, 2048, ws + WS_WOUT, 32 * nb, 32 * nb, 64 * kb, scr, lane); }
      } }
}

template <bool I8>
__device__ __forceinline__ void ph_norm(const float* X, bf16_t* Hout, float* SA, const float* __restrict__ g, const float* mod, int sh_off, int sc_off, int gw, int ngw, int lane) {
    for (int row = gw; row < T_TOK; row += ngw) {
        const int b = row >> 13;
        const f32x4* xr = (const f32x4*)(X + (size_t)row * DM) + lane;
        f32x4 v[8]; float ss = 0.f;
#pragma unroll
        for (int j = 0; j < 8; ++j) { v[j] = xr[64 * j]; ss += (v[j][0] * v[j][0] + v[j][1] * v[j][1]) + (v[j][2] * v[j][2] + v[j][3] * v[j][3]); }
        ss = wave_sum(ss);
        const float rs = 1.0f / sqrtf(ss * (1.0f / DM) + EPS);
        const float* mb = mod + (size_t)b * 12288;
        float amax = 0.f;
#pragma unroll
        for (int j = 0; j < 8; ++j) { const int col = 4 * (lane + 64 * j);
            const f32x4 gv = *(const f32x4*)(g + col), sc = *(const f32x4*)(mb + sc_off + col), sh = *(const f32x4*)(mb + sh_off + col);
            const f32x4 o = v[j] * rs * gv * (sc + 1.0f) + sh;
            if (I8) { v[j] = o; amax = fmaxf(fmaxf(amax, fmaxf(fabsf(o[0]), fabsf(o[1]))), fmaxf(fabsf(o[2]), fabsf(o[3]))); }
            else { u32x2 w; w.x = cvt_pk_bf16(o[0], o[1]); w.y = cvt_pk_bf16(o[2], o[3]); *(u32x2*)(Hout + (size_t)row * DM + col) = w; } }
        if (I8) {
#pragma unroll
            for (int o = 1; o < 64; o <<= 1) amax = fmaxf(amax, __shfl_xor(amax, o));
            const float sa = fmaxf(amax, 1e-30f) * (1.0f / 127.0f), inv = 1.0f / sa;
            if (lane == 0) SA[row] = sa;
            unsigned* h8 = (unsigned*)((signed char*)Hout + (size_t)row * DM) + lane;
#pragma unroll
            for (int j = 0; j < 8; ++j) { unsigned w = 0;
#pragma unroll
                for (int e = 0; e < 4; ++e) { const int q = (int)rintf(v[j][e] * inv); w |= ((unsigned)q & 0xffu) << (8 * e); }
                h8[64 * j] = w; }
        }
    }
}

template <int MODE>
__device__ __forceinline__ void ph_attn(LAS unsigned char* lds, const bf16_t* PA, bf16_t* ATT, const float* __restrict__ qg, const float* __restrict__ kg, int G) {
    const int tid = opaque_tid(), lane = tid & 63, wave = __builtin_amdgcn_readfirstlane(tid >> 6), c = lane & 15, g = lane >> 4;
    LAS unsigned char* KL = lds;
    LAS unsigned char* VT = lds + 17408;
    bf16x8 tri[6];
    { const int FS[6] = {0, 1, 0, 1, 2, 3}, FP[6] = {0, 0, 1, 1, 1, 1};
#pragma unroll
      for (int q = 0; q < 6; ++q)
#pragma unroll
          for (int jj = 0; jj < 8; ++jj) { const int kap = 32 * FP[q] + 16 * (jj >> 2) + 4 * g + (jj & 3); tri[q][jj] = (kap > 16 * FS[q] + c) ? (short)0x3F80 : (short)0; } }
    for (int u = blockIdx.x; u < 1024; u += G) {
        const int b = u >> 9, h = (u >> 6) & 7, qb = u & 63, t0 = qb * 128, tq0 = t0 + 16 * wave, tq = tq0 + c;
        bf16x8 qf[4];
        { const bf16_t* qrow = PA + (size_t)(b * SEQ + tq) * 4096 + 1024 + h * 128;
          u32x4 qr[4]; float ss = 0.f;
#pragma unroll
          for (int kk = 0; kk < 4; ++kk) { qr[kk] = *(const u32x4*)(qrow + 32 * kk + 8 * g);
#pragma unroll
              for (int e = 0; e < 4; ++e) { const float lo = bf_lo(qr[kk][e]), hi = bf_hi(qr[kk][e]); ss += lo * lo + hi * hi; } }
          ss += __shfl_xor(ss, 16); ss += __shfl_xor(ss, 32);
          const float rs = (1.0f / sqrtf(ss * (1.0f / 128.0f) + EPS)) * (0.08838834764831845f * 1.4426950408889634f);
#pragma unroll
          for (int kk = 0; kk < 4; ++kk) { const f32x4 g0 = *(const f32x4*)(qg + 32 * kk + 8 * g), g1 = *(const f32x4*)(qg + 32 * kk + 8 * g + 4);
              u32x4 w;
              w.x = cvt_pk_bf16(bf_lo(qr[kk].x) * rs * g0[0], bf_hi(qr[kk].x) * rs * g0[1]);
              w.y = cvt_pk_bf16(bf_lo(qr[kk].y) * rs * g0[2], bf_hi(qr[kk].y) * rs * g0[3]);
              w.z = cvt_pk_bf16(bf_lo(qr[kk].z) * rs * g1[0], bf_hi(qr[kk].z) * rs * g1[1]);
              w.w = cvt_pk_bf16(bf_lo(qr[kk].w) * rs * g1[2], bf_hi(qr[kk].w) * rs * g1[3]);
              qf[kk] = __builtin_bit_cast(bf16x8, w); } }
        float carry = 0.f; int wdone = 0;
        f32x4 oacc[8];
#pragma unroll
        for (int fd = 0; fd < 8; ++fd) oacc[fd] = (f32x4){0.f, 0.f, 0.f, 0.f};
        u32x4 kreg[2], vreg[2];
        { const int k0n = (2 * qb + 1) * 64;
#pragma unroll
          for (int p = 0; p < 2; ++p) { const int ci = tid + 512 * p, key = ci >> 4, ch = ci & 15;
              kreg[p] = *(const u32x4*)(PA + (size_t)(b * SEQ + k0n + key) * 4096 + 2048 + h * 128 + 8 * ch);
              vreg[p] = *(const u32x4*)(PA + (size_t)(b * SEQ + k0n + lane) * 4096 + 3072 + h * 128 + 8 * (wave + 8 * p)); } }
        for (int kt = 2 * qb + 1; kt >= 0; --kt) {
            const int k0 = kt * 64;
            if (__syncthreads_and(wdone)) break;
#pragma unroll
            for (int p = 0; p < 2; ++p) {
                const int ci = tid + 512 * p, key = ci >> 4, ch = ci & 15;
                const u32x4 kr = kreg[p];
                float f[8]; f[0] = bf_lo(kr.x); f[1] = bf_hi(kr.x); f[2] = bf_lo(kr.y); f[3] = bf_hi(kr.y); f[4] = bf_lo(kr.z); f[5] = bf_hi(kr.z); f[6] = bf_lo(kr.w); f[7] = bf_hi(kr.w);
                float ss = 0.f;
#pragma unroll
                for (int e = 0; e < 8; ++e) ss += f[e] * f[e];
                ss += __shfl_xor(ss, 1); ss += __shfl_xor(ss, 2); ss += __shfl_xor(ss, 4); ss += __shfl_xor(ss, 8);
                const float rs = 1.0f / sqrtf(ss * (1.0f / 128.0f) + EPS);
                const f32x4 g0 = *(const f32x4*)(kg + 8 * ch), g1 = *(const f32x4*)(kg + 8 * ch + 4);
                u32x4 w;
                w.x = cvt_pk_bf16(f[0] * rs * g0[0], f[1] * rs * g0[1]); w.y = cvt_pk_bf16(f[2] * rs * g0[2], f[3] * rs * g0[3]);
                w.z = cvt_pk_bf16(f[4] * rs * g1[0], f[5] * rs * g1[1]); w.w = cvt_pk_bf16(f[6] * rs * g1[2], f[7] * rs * g1[3]);
                *(LAS u32x4*)(KL + key * 272 + ch * 16) = w;
            }
#pragma unroll
            for (int p = 0; p < 2; ++p) {
                const int key = lane, ch = wave + 8 * p;
                const u32x4 vr = vreg[p];
                LAS unsigned short* vt = (LAS unsigned short*)(VT + (8 * ch) * 144 + key * 2);
                vt[0 * 72] = (unsigned short)(vr.x & 0xffffu); vt[1 * 72] = (unsigned short)(vr.x >> 16);
                vt[2 * 72] = (unsigned short)(vr.y & 0xffffu); vt[3 * 72] = (unsigned short)(vr.y >> 16);
                vt[4 * 72] = (unsigned short)(vr.z & 0xffffu); vt[5 * 72] = (unsigned short)(vr.z >> 16);
                vt[6 * 72] = (unsigned short)(vr.w & 0xffffu); vt[7 * 72] = (unsigned short)(vr.w >> 16);
            }
            if (kt > 0) { const int k0n = k0 - 64;
#pragma unroll
                for (int p = 0; p < 2; ++p) { const int ci = tid + 512 * p, key = ci >> 4, ch = ci & 15;
                    kreg[p] = *(const u32x4*)(PA + (size_t)(b * SEQ + k0n + key) * 4096 + 2048 + h * 128 + 8 * ch);
                    vreg[p] = *(const u32x4*)(PA + (size_t)(b * SEQ + k0n + lane) * 4096 + 3072 + h * 128 + 8 * (wave + 8 * p)); } }
            __syncthreads();
            if (MODE == 1) { if (kt <= 2 * qb - 3) wdone = 1; }
            if (MODE == 0 && !wdone && k0 < tq0 + 15) {
                f32x4 zt[4];
#pragma unroll
                for (int f = 0; f < 4; ++f) { f32x4 acc = {0.f, 0.f, 0.f, 0.f};
#pragma unroll
                    for (int kk = 0; kk < 4; ++kk) { const bf16x8 kf = *(const LAS bf16x8*)(KL + (16 * f + c) * 272 + (32 * kk + 8 * g) * 2);
                        acc = __builtin_amdgcn_mfma_f32_16x16x32_bf16(kf, qf[kk], acc, 0, 0, 0); }
                    zt[f] = acc; }
                float lf[4][4], lz[4][4]; float tot = 0.f;
                if (k0 + 63 >= tq0) {
#pragma unroll
                    for (int f = 0; f < 4; ++f)
#pragma unroll
                        for (int i = 0; i < 4; ++i) { const int s = k0 + 16 * f + 4 * g + i; const bool valid = s < tq; const float z = zt[f][i];
                            const float sp = fmaxf(z, 0.f) + __builtin_amdgcn_logf(1.0f + __builtin_amdgcn_exp2f(-fabsf(z)));
                            const float l = valid ? -sp : 0.f; lf[f][i] = l; lz[f][i] = valid ? (l + z) : -INFINITY; tot += l; }
                } else {
#pragma unroll
                    for (int f = 0; f < 4; ++f)
#pragma unroll
                        for (int i = 0; i < 4; ++i) { const float z = zt[f][i];
                            const float l = -(fmaxf(z, 0.f) + __builtin_amdgcn_logf(1.0f + __builtin_amdgcn_exp2f(-fabsf(z)))); lf[f][i] = l; lz[f][i] = l + z; tot += l; }
                }
                tot += __shfl_xor(tot, 16); tot += __shfl_xor(tot, 32);
                bf16x8 lh[2];
#pragma unroll
                for (int fp = 0; fp < 2; ++fp) { u32x4 wh;
#pragma unroll
                    for (int q = 0; q < 2; ++q) { const int f = 2 * fp + q; wh[2 * q] = cvt_pk_bf16(lf[f][0], lf[f][1]); wh[2 * q + 1] = cvt_pk_bf16(lf[f][2], lf[f][3]); }
                    lh[fp] = __builtin_bit_cast(bf16x8, wh); }
                f32x4 sf[4];
                { f32x4 z4 = {0.f, 0.f, 0.f, 0.f};
                  sf[0] = __builtin_amdgcn_mfma_f32_16x16x32_bf16(tri[0], lh[0], z4, 0, 0, 0); sf[0] = __builtin_amdgcn_mfma_f32_16x16x32_bf16(tri[2], lh[1], sf[0], 0, 0, 0);
                  sf[1] = __builtin_amdgcn_mfma_f32_16x16x32_bf16(tri[1], lh[0], z4, 0, 0, 0); sf[1] = __builtin_amdgcn_mfma_f32_16x16x32_bf16(tri[3], lh[1], sf[1], 0, 0, 0);
                  sf[2] = __builtin_amdgcn_mfma_f32_16x16x32_bf16(tri[4], lh[1], z4, 0, 0, 0);
                  sf[3] = __builtin_amdgcn_mfma_f32_16x16x32_bf16(tri[5], lh[1], z4, 0, 0, 0); }
                bf16x8 pb[2];
#pragma unroll
                for (int fp = 0; fp < 2; ++fp) { u32x4 w;
#pragma unroll
                    for (int q = 0; q < 2; ++q) { const int f = 2 * fp + q; float p[4];
#pragma unroll
                        for (int i = 0; i < 4; ++i) p[i] = __builtin_amdgcn_exp2f(lz[f][i] + sf[f][i] + carry);
                        w[2 * q] = cvt_pk_bf16(p[0], p[1]); w[2 * q + 1] = cvt_pk_bf16(p[2], p[3]); }
                    pb[fp] = __builtin_bit_cast(bf16x8, w); }
                carry += tot;
#pragma unroll
                for (int fd = 0; fd < 8; ++fd)
#pragma unroll
                    for (int fp = 0; fp < 2; ++fp) { const LAS unsigned char* vp = VT + (16 * fd + c) * 144 + (32 * fp + 4 * g) * 2;
                        const u32x2 v0 = *(const LAS u32x2*)vp, v1 = *(const LAS u32x2*)(vp + 32);
                        u32x4 vw; vw.x = v0.x; vw.y = v0.y; vw.z = v1.x; vw.w = v1.y;
                        oacc[fd] = __builtin_amdgcn_mfma_f32_16x16x32_bf16(__builtin_bit_cast(bf16x8, vw), pb[fp], oacc[fd], 0, 0, 0); }
                wdone = (__ballot(carry >= -152.0f) == 0ull) ? 1 : 0;
            }
        }
        if (MODE == 0) { unsigned char* orow = (unsigned char*)ATT + (size_t)(b * SEQ + tq) * 1024 + h * 128 + 4 * g;
#pragma unroll
          for (int fd = 0; fd < 8; ++fd) *(unsigned*)(orow + 16 * fd) = pack4_fp8(oacc[fd][0], oacc[fd][1], oacc[fd][2], oacc[fd][3], F8_SA); }
    }
    __syncthreads();
}

__device__ __forceinline__ void ssm_lambda(const Args& a, int g, int st, float& lbr, float& lbi, float& qr, float& qi) {
    const float lr = a.in[I_LRE][g * 64 + st], li = a.in[I_LIM][g * 64 + st], dt = __expf(a.in[I_LDT][g]);
    const float mag = __expf(lr * dt);
    float rev = li * dt * 0.15915494309189535f; rev -= rintf(rev);
    lbr = mag * __builtin_amdgcn_cosf(rev); lbi = mag * __builtin_amdgcn_sinf(rev);
    const float nr = lbr - 1.0f, ni = lbi, den = 1.0f / (lr * lr + li * li);
    qr = (nr * lr + ni * li) * den; qi = (ni * lr - nr * li) * den;
}
template <bool WITH_Y>
__device__ __forceinline__ void ph_ssm_mfma(const Args& a, LAS unsigned char* lds, const bf16_t* UB, f32x2* E, bf16_t* YA, int G) {
    const int tid = opaque_tid(), lane = tid & 63, wave = __builtin_amdgcn_readfirstlane(tid >> 6), c = lane & 15, gl = lane >> 4;
    LAS f32x2* sl = (LAS f32x2*)(lds + wave * 8192);
    LAS f32x4* tab = (LAS f32x4*)(lds + 65536 + wave * 1024);
    LAS u32x4* cml = (LAS u32x4*)(lds + 73728 + wave * 5120) + lane;
    for (int item = blockIdx.x; item < 128; item += G) {
        const int b = item >> 6, cb = (item >> 3) & 7, g = (item & 7) * 8 + wave, c0 = cb * 16;
        float mur, mui;
        { float lbr, lbi, qr, qi; ssm_lambda(a, g, lane, lbr, lbi, qr, qi); tab[lane] = (f32x4){lbr, lbi, qr, qi}; mur = lbr; mui = lbi; }
        LDS_WAIT();
        bf16x8 bm[8];
        const float* brb = a.in[I_BRE] + (g * 64 + (c >> 1)) * 16 + 8 * (gl & 1); const float* bib = a.in[I_BIM] + (g * 64 + (c >> 1)) * 16 + 8 * (gl & 1);
        const LAS f32x4* tabb = tab + (c >> 1);
#pragma unroll
        for (int f = 0; f < 8; ++f) { const f32x4 tv = tabb[8 * f]; const float qr = tv[2], qi = tv[3];
            const float* br = brb + 128 * f; const float* bim = bib + 128 * f;
            const f32x4 r0 = *(const f32x4*)br, r1 = *(const f32x4*)(br + 4), i0 = *(const f32x4*)bim, i1 = *(const f32x4*)(bim + 4);
            float v[8];
#pragma unroll
            for (int e = 0; e < 4; ++e) { const float vr0 = qr * r0[e] - qi * i0[e], vi0 = qr * i0[e] + qi * r0[e], vr1 = qr * r1[e] - qi * i1[e], vi1 = qr * i1[e] + qi * r1[e];
                v[e] = (c & 1) ? vi0 : vr0; v[4 + e] = (c & 1) ? vi1 : vr1; }
            if (gl >= 2) {
#pragma unroll
                for (int e = 0; e < 8; ++e) v[e] = 0.f; }
            u32x4 w; w.x = cvt_pk_bf16(v[0], v[1]); w.y = cvt_pk_bf16(v[2], v[3]); w.z = cvt_pk_bf16(v[4], v[5]); w.w = cvt_pk_bf16(v[6], v[7]);
            bm[f] = __builtin_bit_cast(bf16x8, w); }
        float lmr[16], lmi[16];
#pragma unroll
        for (int k = 0; k < 16; ++k) { const f32x4 tv = tab[2 * gl + 8 * (k >> 1) + (k & 1)]; lmr[k] = tv[0]; lmi[k] = tv[1]; }
        if (WITH_Y) {
            const float* crb = a.in[I_CRE] + (g * 16 + c) * 64 + 2 * gl; const float* cib = a.in[I_CIM] + (g * 16 + c) * 64 + 2 * gl;
#pragma unroll
            for (int kk = 0; kk < 4; ++kk) { float v[8];
#pragma unroll
                for (int jh = 0; jh < 2; ++jh) { const f32x2 r = *(const f32x2*)(crb + 8 * (2 * kk + jh)), m = *(const f32x2*)(cib + 8 * (2 * kk + jh));
                    v[4 * jh] = r.x; v[4 * jh + 1] = -m.x; v[4 * jh + 2] = r.y; v[4 * jh + 3] = -m.y; }
                u32x4 w; w.x = cvt_pk_bf16(v[0], v[1]); w.y = cvt_pk_bf16(v[2], v[3]); w.z = cvt_pk_bf16(v[4], v[5]); w.w = cvt_pk_bf16(v[6], v[7]);
                cml[64 * kk] = w; }
            { const float dv = a.in[I_SD][g * 16 + c]; float v[8];
#pragma unroll
              for (int jj = 0; jj < 8; ++jj) v[jj] = (gl < 2 && (8 * gl + jj) == c) ? dv : 0.f;
              u32x4 w; w.x = cvt_pk_bf16(v[0], v[1]); w.y = cvt_pk_bf16(v[2], v[3]); w.z = cvt_pk_bf16(v[4], v[5]); w.w = cvt_pk_bf16(v[6], v[7]);
              cml[256] = w; }
        }
        f32x4 s[8];
#pragma unroll
        for (int f = 0; f < 8; ++f) s[f] = (f32x4){0.f, 0.f, 0.f, 0.f};
        if (WITH_Y) {
            float pr = mur, pi = mui;
#pragma unroll
            for (int q = 0; q < 6; ++q) { const float nr = pr * pr - pi * pi, ni = 2.0f * pr * pi; pr = nr; pi = ni; }
            float sr = 0.f, si = 0.f;
            const f32x2* ep = E + (size_t)((b * 64 + g) * 128) * 64 + lane;
            f32x2 ev[8], en[8];
#pragma unroll
            for (int k = 0; k < 8; ++k) ev[k] = ep[(size_t)k * 64];
            for (int cc = 0; cc < c0 + 16; cc += 8) {
                if (cc + 8 < c0 + 16) {
#pragma unroll
                    for (int k = 0; k < 8; ++k) en[k] = ep[(size_t)(cc + 8 + k) * 64]; }
#pragma unroll
                for (int k = 0; k < 8; ++k) { if (cc >= c0) sl[(cc - c0 + k) * 64 + lane] = (f32x2){sr, si};
                    const float nr = pr * sr - pi * si + ev[k][0], ni = pr * si + pi * sr + ev[k][1]; sr = nr; si = ni; }
#pragma unroll
                for (int k = 0; k < 8; ++k) ev[k] = en[k];
            }
            LDS_WAIT();
#pragma unroll
            for (int f = 0; f < 8; ++f) s[f] = *(const LAS f32x4*)(sl + c * 64 + 8 * f + 2 * gl);
            LDS_WAIT();
        }
        const bf16_t* up = UB + ((size_t)(b * 64 + g) * 8192 + (size_t)(c0 + c) * 64) * 16 + 8 * (gl & 1);
        unsigned char* yp = (unsigned char*)YA + (size_t)(b * SEQ + (c0 + c) * 64) * 1024 + g * 16 + 4 * gl;
        u32x4 u0 = *(const u32x4*)(up), u1 = *(const u32x4*)(up + 16), u2 = *(const u32x4*)(up + 32), u3 = *(const u32x4*)(up + 48);
#pragma unroll 1
        for (int tau = 0; tau < 64; ++tau) {
            const u32x4 u4 = *(const u32x4*)(up + (size_t)(tau + 4) * 16);
            const bf16x8 uf = __builtin_bit_cast(bf16x8, u0);
#pragma unroll
            for (int f = 0; f < 8; ++f) { f32x4 ci;
                ci[0] = lmr[2 * f] * s[f][0] - lmi[2 * f] * s[f][1]; ci[1] = lmr[2 * f] * s[f][1] + lmi[2 * f] * s[f][0];
                ci[2] = lmr[2 * f + 1] * s[f][2] - lmi[2 * f + 1] * s[f][3]; ci[3] = lmr[2 * f + 1] * s[f][3] + lmi[2 * f + 1] * s[f][2];
                s[f] = __builtin_amdgcn_mfma_f32_16x16x32_bf16(bm[f], uf, ci, 0, 0, 0); }
            if (WITH_Y) {
                f32x4 y = __builtin_amdgcn_mfma_f32_16x16x32_bf16(__builtin_bit_cast(bf16x8, cml[256]), uf, (f32x4){0.f, 0.f, 0.f, 0.f}, 0, 0, 0);
#pragma unroll
                for (int kk = 0; kk < 4; ++kk) { u32x4 w; w.x = cvt_pk_bf16(s[2 * kk][0], s[2 * kk][1]); w.y = cvt_pk_bf16(s[2 * kk][2], s[2 * kk][3]);
                    w.z = cvt_pk_bf16(s[2 * kk + 1][0], s[2 * kk + 1][1]); w.w = cvt_pk_bf16(s[2 * kk + 1][2], s[2 * kk + 1][3]);
                    y = __builtin_amdgcn_mfma_f32_16x16x32_bf16(__builtin_bit_cast(bf16x8, cml[64 * kk]), __builtin_bit_cast(bf16x8, w), y, 0, 0, 0); }
                *(unsigned*)(yp + (size_t)tau * 1024) = pack4_fp8(gelu_tanh(y[0]), gelu_tanh(y[1]), gelu_tanh(y[2]), gelu_tanh(y[3]), F8_SA);
            }
            u0 = u1; u1 = u2; u2 = u3; u3 = u4;
        }
        if (!WITH_Y) { f32x2* eo = E + (size_t)((b * 64 + g) * 128 + c0 + c) * 64 + 2 * gl;
#pragma unroll
            for (int f = 0; f < 8; ++f) *(f32x4*)(eo + 8 * f) = s[f]; }
    }
}

typedef float f32x16 __attribute__((ext_vector_type(16)));
typedef float f32x32 __attribute__((ext_vector_type(32)));
typedef unsigned u32x6 __attribute__((ext_vector_type(6)));
constexpr float PEER_SU = 64.0f, PEER_SV = 1.4f;
constexpr size_t PEER_SHARD_BYTES = (size_t)16384 * 192;
__device__ __forceinline__ void table_cvt_pack(const f32x4 (&v)[8], float sc, unsigned char* dst, int lane) {
    f32x16 a, b;
#pragma unroll
    for (int q = 0; q < 4; ++q) {
#pragma unroll
        for (int e = 0; e < 4; ++e) { a[4 * q + e] = v[q][e] * sc; b[4 * q + e] = v[4 + q][e] * sc; } }
    const u32x6 p = __builtin_amdgcn_cvt_scalef32_2xpk16_fp6_f32(a, b, 1.0f);
    *(u32x4*)(dst + 16 * (lane & 7)) = (u32x4){p[0], p[1], p[2], p[3]};
    *(u32x2*)(dst + 128 + 8 * (lane & 7)) = (u32x2){p[4], p[5]};
}
__device__ __forceinline__ void ph_table_cvt(const float* __restrict__ U, const float* __restrict__ V, unsigned char* UT, unsigned char* VT, int r0, int r1, int gw, int ngw, int lane) {
    for (int r = r0 + gw; r < r1; r += ngw) {
        const float* su = U + (size_t)r * 2048 + 32 * lane; const float* sv = V + (size_t)r * 2048 + 32 * lane;
        f32x4 vu[8], vv[8];
#pragma unroll
        for (int q = 0; q < 8; ++q) vu[q] = *(const f32x4*)(su + 4 * q);
#pragma unroll
        for (int q = 0; q < 8; ++q) vv[q] = *(const f32x4*)(sv + 4 * q);
        const size_t off = (size_t)(lane >> 3) * PEER_SHARD_BYTES + (size_t)r * 192;
        table_cvt_pack(vu, PEER_SU, UT + off, lane);
        table_cvt_pack(vv, PEER_SV, VT + off, lane);
    }
}

#define TK_CE(a_, b_) do { const float _h = fmaxf(a_, b_), _l = fminf(a_, b_); a_ = _h; b_ = _l; } while (0)
__device__ __forceinline__ void tk_sort16(float (&a)[16]) {
#pragma unroll
    for (int p = 1; p < 16; p *= 2)
#pragma unroll
        for (int k = p; k >= 1; k /= 2)
#pragma unroll
            for (int j = k % p; j <= 15 - k; j += 2 * k)
#pragma unroll
                for (int i = 0; i < k; ++i)
                    if (i + j + k <= 15 && (i + j) / (2 * p) == (i + j + k) / (2 * p)) TK_CE(a[i + j], a[i + j + k]);
}
__device__ __forceinline__ void tk_merge16(float (&t)[16], const float (&g)[16]) {
#pragma unroll
    for (int i = 0; i < 16; ++i) t[i] = fmaxf(t[i], g[15 - i]);
#pragma unroll
    for (int k = 8; k >= 1; k /= 2)
#pragma unroll
        for (int i = 0; i < 16; ++i)
            if ((i & k) == 0) TK_CE(t[i], t[i + k]);
}
__device__ __forceinline__ float tk2_key(float a, float b, int flat) {
    const float sum = __uint_as_float(__float_as_uint(a) & ~127u) + __uint_as_float(__float_as_uint(b) & ~127u);
    return __uint_as_float((__float_as_uint(sum) & ~255u) | (unsigned)(255 - flat)); }
__device__ __forceinline__ void ph_peer_topk(LAS unsigned char* lds, const float* SC, int* idxG, float* gateG, int G) {
    const int tid = opaque_tid(), lane = tid & 63, wave = __builtin_amdgcn_readfirstlane(tid >> 6);
    LAS float* scr = (LAS float*)(lds + wave * 8448);
    for (int it = blockIdx.x; it < 512; it += G) {
        const int tokw = it * 32 + wave * 4;
        float tk[16];
#pragma unroll
        for (int i = 0; i < 16; ++i) tk[i] = -INFINITY;
        f32x4 nv[8];
#pragma unroll
        for (int j = 0; j < 8; ++j) { const int prob = (lane >> 3) + 8 * j, seg = lane & 7; nv[j] = *(const f32x4*)(SC + (size_t)(tokw + (prob >> 4)) * 2048 + (prob & 15) * 128 + 4 * seg); }
        for (int q = 0; q < 4; ++q) {
#pragma unroll
            for (int j = 0; j < 8; ++j) { const int prob = (lane >> 3) + 8 * j, seg = lane & 7; const f32x4 v = nv[j];
                LAS float* d = scr + prob * 33 + 4 * seg; d[0] = v[0]; d[1] = v[1]; d[2] = v[2]; d[3] = v[3]; }
            { const int qn = q < 3 ? q + 1 : 3;
#pragma unroll
              for (int j = 0; j < 8; ++j) { const int prob = (lane >> 3) + 8 * j, seg = lane & 7; nv[j] = *(const f32x4*)(SC + (size_t)(tokw + (prob >> 4)) * 2048 + (prob & 15) * 128 + 32 * qn + 4 * seg); } }
            LDS_WAIT();
#pragma unroll
            for (int hh = 0; hh < 2; ++hh) { float g[16];
#pragma unroll
                for (int i = 0; i < 16; ++i) g[i] = __uint_as_float((__float_as_uint(scr[lane * 33 + 16 * hh + i]) & ~127u) | (unsigned)(127 - (32 * q + 16 * hh + i)));
                tk_sort16(g); tk_merge16(tk, g); }
            LDS_WAIT();
        }
        float t2[16];
#pragma unroll
        for (int i = 0; i < 16; ++i) t2[i] = __shfl_xor(tk[i], 1);
        float bv[16];
        {
          bv[0] = tk2_key(tk[0], t2[0], 0);
          bv[1] = tk2_key(tk[0], t2[1], 1);
          bv[2] = tk2_key(tk[0], t2[2], 2);
          bv[3] = tk2_key(tk[0], t2[3], 3);
          bv[4] = tk2_key(tk[0], t2[4], 4);
          bv[5] = tk2_key(tk[0], t2[5], 5);
          bv[6] = tk2_key(tk[0], t2[6], 6);
          bv[7] = tk2_key(tk[0], t2[7], 7);
          bv[8] = tk2_key(tk[0], t2[8], 8);
          bv[9] = tk2_key(tk[0], t2[9], 9);
          bv[10] = tk2_key(tk[0], t2[10], 10);
          bv[11] = tk2_key(tk[0], t2[11], 11);
          bv[12] = tk2_key(tk[0], t2[12], 12);
          bv[13] = tk2_key(tk[0], t2[13], 13);
          bv[14] = tk2_key(tk[0], t2[14], 14);
          bv[15] = tk2_key(tk[0], t2[15], 15);
          tk_sort16(bv);
          { float g[16];
          g[0] = tk2_key(tk[1], t2[0], 16);
          g[1] = tk2_key(tk[1], t2[1], 17);
          g[2] = tk2_key(tk[1], t2[2], 18);
          g[3] = tk2_key(tk[1], t2[3], 19);
          g[4] = tk2_key(tk[1], t2[4], 20);
          g[5] = tk2_key(tk[1], t2[5], 21);
          g[6] = tk2_key(tk[1], t2[6], 22);
          g[7] = tk2_key(tk[1], t2[7], 23);
          g[8] = tk2_key(tk[2], t2[0], 32);
          g[9] = tk2_key(tk[2], t2[1], 33);
          g[10] = tk2_key(tk[2], t2[2], 34);
          g[11] = tk2_key(tk[2], t2[3], 35);
          g[12] = tk2_key(tk[2], t2[4], 36);
          g[13] = tk2_key(tk[3], t2[0], 48);
          g[14] = tk2_key(tk[3], t2[1], 49);
          g[15] = tk2_key(tk[3], t2[2], 50);
          tk_sort16(g); tk_merge16(bv, g); }
          { float g[16];
          g[0] = tk2_key(tk[3], t2[3], 51);
          g[1] = tk2_key(tk[4], t2[0], 64);
          g[2] = tk2_key(tk[4], t2[1], 65);
          g[3] = tk2_key(tk[4], t2[2], 66);
          g[4] = tk2_key(tk[5], t2[0], 80);
          g[5] = tk2_key(tk[5], t2[1], 81);
          g[6] = tk2_key(tk[6], t2[0], 96);
          g[7] = tk2_key(tk[6], t2[1], 97);
          g[8] = tk2_key(tk[7], t2[0], 112);
          g[9] = tk2_key(tk[7], t2[1], 113);
          g[10] = tk2_key(tk[8], t2[0], 128);
          g[11] = tk2_key(tk[9], t2[0], 144);
          g[12] = tk2_key(tk[10], t2[0], 160);
          g[13] = tk2_key(tk[11], t2[0], 176);
          g[14] = tk2_key(tk[12], t2[0], 192);
          g[15] = tk2_key(tk[13], t2[0], 208);
          tk_sort16(g); tk_merge16(bv, g); }
          { float x = tk2_key(tk[14], t2[0], 224);
#pragma unroll
            for (int i = 0; i < 16; ++i) { const float hi = fmaxf(bv[i], x); x = fminf(bv[i], x); bv[i] = hi; } }
          { float x = tk2_key(tk[15], t2[0], 240);
#pragma unroll
            for (int i = 0; i < 16; ++i) { const float hi = fmaxf(bv[i], x); x = fminf(bv[i], x); bv[i] = hi; } }
        }
        unsigned p1[4], p2[4];
#pragma unroll
        for (int j = 0; j < 4; ++j) { p1[j] = 0u; p2[j] = 0u;
#pragma unroll
            for (int e = 0; e < 4; ++e) { p1[j] |= (127u - (__float_as_uint(tk[4 * j + e]) & 127u)) << (8 * e); p2[j] |= (127u - (__float_as_uint(t2[4 * j + e]) & 127u)) << (8 * e); } }
        { float e[16], sum = 0.f; unsigned ex[16];
          const float top = __uint_as_float(__float_as_uint(bv[0]) & ~255u);
#pragma unroll
          for (int i = 0; i < 16; ++i) { const unsigned bits = __float_as_uint(bv[i]); const unsigned flat = 255u - (bits & 255u), aa = flat >> 4, bb = flat & 15u;
              const unsigned w1 = (aa >> 2) == 0u ? p1[0] : (aa >> 2) == 1u ? p1[1] : (aa >> 2) == 2u ? p1[2] : p1[3];
              const unsigned w2 = (bb >> 2) == 0u ? p2[0] : (bb >> 2) == 1u ? p2[1] : (bb >> 2) == 2u ? p2[2] : p2[3];
              ex[i] = (((w1 >> (8u * (aa & 3u))) & 127u) << 7) | ((w2 >> (8u * (bb & 3u))) & 127u);
              e[i] = __expf(__uint_as_float(bits & ~255u) - top); sum += e[i]; }
          const float inv = 1.0f / sum;
          if ((lane & 1) == 0) { const int tl = lane >> 4, head = (lane & 15) >> 1; const size_t o = (size_t)(tokw + tl) * 128 + 64 * (head >> 2);
#pragma unroll
              for (int i = 0; i < 16; ++i) { const int p = 8 * (i & 7) + ((2 * head + (i >> 3)) & 7); idxG[o + p] = (int)ex[i]; gateG[o + p] = e[i] * inv; } } }
    }
}

#define PEER_ROWS(b4_, b2_, i8_) do { _Pragma("unroll") for (int gq = 0; gq < 8; ++gq) { const unsigned ro = (unsigned)(i8_)[gq] * 192u; \
        b4_[gq] = *(const u32x4*)(tab + (ro + 16u * (unsigned)c)); b2_[gq] = *(const u32x2*)(tab + (ro + 128u + 8u * (unsigned)c)); } } while (0)
#define PEER_LD8(dst_, p_) do { const u32x4 _a = *(const u32x4*)(p_), _b = *(const u32x4*)((p_) + 4); dst_[0] = (int)_a.x; dst_[1] = (int)_a.y; dst_[2] = (int)_a.z; dst_[3] = (int)_a.w; \
        dst_[4] = (int)_b.x; dst_[5] = (int)_b.y; dst_[6] = (int)_b.z; dst_[7] = (int)_b.w; } while (0)
__device__ __forceinline__ void ph_peer_u(const unsigned char* UT, const bf16_t* H2, const int* idxG, float* pdot, int G) {
    const int tid = opaque_tid(), lane = tid & 63, wave = __builtin_amdgcn_readfirstlane(tid >> 6), r = lane >> 3, c = lane & 7;
    const int shard = blockIdx.x & 7, ws = (blockIdx.x >> 3) * 8 + wave, nws = (G >> 3) * 8;
    const unsigned char* tab = UT + (size_t)shard * PEER_SHARD_BYTES;
    const bf16_t* hbase = H2 + 256 * shard + 32 * c;
    const int* ibase = idxG + 8 * r;
#define PEER_TOK(t_) (((t_) < T_TOK) ? (t_) : (T_TOK - 1))
    int ci[2][8], ni[2][8]; u32x4 cw[4], nw[4];
    { const int t0 = PEER_TOK(ws), t1 = PEER_TOK(ws + nws);
      PEER_LD8(ci[0], ibase + (size_t)t0 * 128); PEER_LD8(ci[1], ibase + (size_t)t0 * 128 + 64); PEER_LD8(ni[0], ibase + (size_t)t1 * 128); PEER_LD8(ni[1], ibase + (size_t)t1 * 128 + 64);
#pragma unroll
      for (int q = 0; q < 4; ++q) cw[q] = *(const u32x4*)(hbase + (size_t)t0 * 2048 + 8 * q); }
    u32x4 a4[8], b4[8]; u32x2 a2[8], b2[8];
    PEER_ROWS(a4, a2, ci[0]);
    for (int t = ws; t < T_TOK; t += nws) {
        PEER_ROWS(b4, b2, ci[1]);
        { const int t1 = PEER_TOK(t + nws);
#pragma unroll
          for (int q = 0; q < 4; ++q) nw[q] = *(const u32x4*)(hbase + (size_t)t1 * 2048 + 8 * q); }
        f32x2 ha[16];
        { const u32x4 w0 = cw[0], w1 = cw[1], w2 = cw[2], w3 = cw[3];
          ha[0] = (f32x2){bf_lo(w0.x), bf_lo(w2.x)}; ha[1] = (f32x2){bf_hi(w0.x), bf_hi(w2.x)}; ha[2] = (f32x2){bf_lo(w0.y), bf_lo(w2.y)}; ha[3] = (f32x2){bf_hi(w0.y), bf_hi(w2.y)};
          ha[4] = (f32x2){bf_lo(w0.z), bf_lo(w2.z)}; ha[5] = (f32x2){bf_hi(w0.z), bf_hi(w2.z)}; ha[6] = (f32x2){bf_lo(w0.w), bf_lo(w2.w)}; ha[7] = (f32x2){bf_hi(w0.w), bf_hi(w2.w)};
          ha[8] = (f32x2){bf_lo(w1.x), bf_lo(w3.x)}; ha[9] = (f32x2){bf_hi(w1.x), bf_hi(w3.x)}; ha[10] = (f32x2){bf_lo(w1.y), bf_lo(w3.y)}; ha[11] = (f32x2){bf_hi(w1.y), bf_hi(w3.y)};
          ha[12] = (f32x2){bf_lo(w1.z), bf_lo(w3.z)}; ha[13] = (f32x2){bf_hi(w1.z), bf_hi(w3.z)}; ha[14] = (f32x2){bf_lo(w1.w), bf_lo(w3.w)}; ha[15] = (f32x2){bf_hi(w1.w), bf_hi(w3.w)}; }
        float* po = pdot + ((size_t)shard * T_TOK + t) * 128 + lane;
#define PEER_UDOT(b4_, b2_, half_) do { float mine = 0.f; \
            _Pragma("unroll") for (int gq = 0; gq < 8; ++gq) { const u32x6 p6 = {b4_[gq].x, b4_[gq].y, b4_[gq].z, b4_[gq].w, b2_[gq].x, b2_[gq].y}; \
                const f32x32 uv = __builtin_amdgcn_cvt_scalef32_pk32_f32_fp6(p6, 1.0f); f32x2 s = {0.f, 0.f}; \
                _Pragma("unroll") for (int k = 0; k < 16; ++k) s = (f32x2){uv[2 * k], uv[2 * k + 1]} * ha[k] + s; \
                const float d = sum8_dpp(s.x + s.y); \
                mine = (gq == c) ? d : mine; __builtin_amdgcn_sched_barrier(0); } \
            po[64 * (half_)] = mine; } while (0)
        PEER_UDOT(a4, a2, 0);
        PEER_ROWS(a4, a2, ni[0]);
#pragma unroll
        for (int q = 0; q < 8; ++q) { ci[0][q] = ni[0][q]; ci[1][q] = ni[1][q]; }
        { const int t2 = PEER_TOK(t + 2 * nws); PEER_LD8(ni[0], ibase + (size_t)t2 * 128); PEER_LD8(ni[1], ibase + (size_t)t2 * 128 + 64); }
        PEER_UDOT(b4, b2, 1);
#pragma unroll
        for (int q = 0; q < 4; ++q) cw[q] = nw[q];
    }
#undef PEER_UDOT
}
__device__ __forceinline__ void ph_peer_act(const float* pdot, const float* gateG, float* actG, int G) {
    const size_t n = (size_t)T_TOK * 128, stride = (size_t)G * 512;
    for (size_t i = (size_t)blockIdx.x * 512 + threadIdx.x; i < n; i += stride) {
        float d = 0.f;
#pragma unroll
        for (int x = 0; x < 8; ++x) d += pdot[(size_t)x * n + i];
        actG[i] = gateG[i] * gelu_tanh(d * (1.0f / PEER_SU)) * (1.0f / PEER_SV);
    }
}
template <bool DRY>
__device__ __forceinline__ void ph_peer_v(LAS unsigned char* lds, const unsigned char* VT, const int* idxG, const float* actG, const float* mod, float* OUT, int G) {
    const int tid = opaque_tid(), lane = tid & 63, wave = __builtin_amdgcn_readfirstlane(tid >> 6), r = lane >> 3, c = lane & 7;
    const int shard = blockIdx.x & 7, ws = (blockIdx.x >> 3) * 8 + wave, nws = (G >> 3) * 8;
    const unsigned char* tab = VT + (size_t)shard * PEER_SHARD_BYTES;
    LAS float* red = (LAS float*)(lds + wave * 9216);
    const int* ibase = idxG + 8 * r; const int* abase = (const int*)actG + 8 * r;
    int ci[2][8], ni[2][8], ca[2][8], na[2][8]; f32x4 cx, nx;
    { const int t0 = PEER_TOK(ws), t1 = PEER_TOK(ws + nws);
      PEER_LD8(ci[0], ibase + (size_t)t0 * 128); PEER_LD8(ci[1], ibase + (size_t)t0 * 128 + 64); PEER_LD8(ni[0], ibase + (size_t)t1 * 128); PEER_LD8(ni[1], ibase + (size_t)t1 * 128 + 64);
      PEER_LD8(ca[0], abase + (size_t)t0 * 128); PEER_LD8(ca[1], abase + (size_t)t0 * 128 + 64);
      cx = *(const f32x4*)(OUT + (size_t)t0 * 2048 + 256 * shard + 4 * lane); }
    u32x4 a4[8], b4[8]; u32x2 a2[8], b2[8];
    PEER_ROWS(a4, a2, ci[0]);
    for (int t = ws; t < T_TOK; t += nws) {
        PEER_ROWS(b4, b2, ci[1]);
        { const int t1 = PEER_TOK(t + nws);
          PEER_LD8(na[0], abase + (size_t)t1 * 128); PEER_LD8(na[1], abase + (size_t)t1 * 128 + 64); nx = *(const f32x4*)(OUT + (size_t)t1 * 2048 + 256 * shard + 4 * lane); }
        f32x2 acc[16];
#pragma unroll
        for (int k = 0; k < 16; ++k) acc[k] = (f32x2){0.f, 0.f};
#define PEER_VACC(b4_, b2_, a8_) do { _Pragma("unroll") for (int gq = 0; gq < 8; ++gq) { const float ar = __int_as_float((a8_)[gq]); const f32x2 av2 = {ar, ar}; \
            const u32x6 p6 = {b4_[gq].x, b4_[gq].y, b4_[gq].z, b4_[gq].w, b2_[gq].x, b2_[gq].y}; const f32x32 vv = __builtin_amdgcn_cvt_scalef32_pk32_f32_fp6(p6, 1.0f); \
            _Pragma("unroll") for (int k = 0; k < 16; ++k) acc[k] = (f32x2){vv[2 * k], vv[2 * k + 1]} * av2 + acc[k]; __builtin_amdgcn_sched_barrier(0); } } while (0)
        PEER_VACC(a4, a2, ca[0]);
        PEER_ROWS(a4, a2, ni[0]);
#pragma unroll
        for (int q = 0; q < 8; ++q) { ci[0][q] = ni[0][q]; ci[1][q] = ni[1][q]; }
        { const int t2 = PEER_TOK(t + 2 * nws); PEER_LD8(ni[0], ibase + (size_t)t2 * 128); PEER_LD8(ni[1], ibase + (size_t)t2 * 128 + 64); }
        PEER_VACC(b4, b2, ca[1]);
        { LAS float* w = red + (r * 8 + c) * 36;
#pragma unroll
          for (int q = 0; q < 4; ++q) { *(LAS f32x4*)(w + 4 * q) = (f32x4){acc[4 * q].x, acc[4 * q + 1].x, acc[4 * q + 2].x, acc[4 * q + 3].x};
              *(LAS f32x4*)(w + 16 + 4 * q) = (f32x4){acc[4 * q].y, acc[4 * q + 1].y, acc[4 * q + 2].y, acc[4 * q + 3].y}; } }
        LDS_WAIT();
        { f32x4 s = {0.f, 0.f, 0.f, 0.f}; const LAS float* rd = red + (lane >> 3) * 36 + 4 * (lane & 7);
#pragma unroll
          for (int rr = 0; rr < 8; ++rr) s += *(const LAS f32x4*)(rd + rr * 288);
          const int b = t >> 13; const float* gt2 = mod + (size_t)b * 12288 + 10240 + 256 * shard + 4 * lane; float* op = OUT + (size_t)t * 2048 + 256 * shard + 4 * lane;
          const f32x4 g0 = *(const f32x4*)gt2;
          if (!DRY) *(f32x4*)op = cx + g0 * s; else asm volatile("" :: "v"(s), "v"(g0)); }
        LDS_WAIT();
#pragma unroll
        for (int q = 0; q < 8; ++q) { ca[0][q] = na[0][q]; ca[1][q] = na[1][q]; }
        cx = nx;
    }
#undef PEER_VACC
}
#undef PEER_ROWS
#undef PEER_LD8
#undef PEER_TOK

__global__ void __launch_bounds__(512, 2) mk_fwd(Args args) {
    extern __shared__ __attribute__((aligned(16))) unsigned char lds_raw[];
    LAS unsigned char* lds = (LAS unsigned char*)lds_raw;
    const int tid = threadIdx.x, lane = tid & 63, wave = __builtin_amdgcn_readfirstlane(tid >> 6);
    const int G = gridDim.x, gw = blockIdx.x * 8 + wave, ngw = G * 8;
    unsigned char* ws = args.ws;
    volatile LAS unsigned* misc = (volatile LAS unsigned*)(lds + LDS_MAIN);
    if (tid < 4) misc[tid] = 0u;
    __syncthreads();
    const int lo = args.ph_lo, hi = args.ph_hi;
    XcdBarrier bar; bar.bar = (unsigned*)(ws + WS_CTL); bar.x = 0; bar.st = misc;
    if (hi - lo > 1) bar = xcd_barrier_post((unsigned*)(ws + WS_CTL), misc);
#ifndef PHMASK
#define PHMASK 0x3fff
#endif
#define IN(k) (((PHMASK >> (k)) & 1) && lo <= (k) && (k) < hi)
#define SEAM(k) do { if (IN(k) && IN((k) + 1)) xcd_barrier(bar); } while (0)
    float* mod = (float*)(ws + WS_MOD);
    bf16_t* HB = (bf16_t*)(ws + WS_H); bf16_t* PA = (bf16_t*)(ws + WS_PA); bf16_t* PG = (bf16_t*)(ws + WS_PG);
    bf16_t* YA = (bf16_t*)(ws + WS_YA); bf16_t* ATT = (bf16_t*)(ws + WS_ATT); f32x2* EB = (f32x2*)(ws + WS_E); bf16_t* UBp = (bf16_t*)(ws + WS_UB);

#define PHS(code, ...) do { __VA_ARGS__ if (DUP == (code)) { xcd_barrier(bar); __VA_ARGS__ } } while (0)
#define PH(k, ...) do { if (IN(k)) { __VA_ARGS__ if (DUP == (k)) { xcd_barrier(bar); __VA_ARGS__ } } } while (0)
    PH(0, { ph_mod_partial(args.in[I_C], args.in[I_WADA], (float*)(ws + WS_MODP), gw, ngw, lane); ph_colmax_partial(args.in[I_WIN], (float*)(ws + WS_CMAXP), gw, ngw, lane); });
    SEAM(0);
    PH(1, { ph_prologue(args, lds, gw, ngw, lane, wave); });
    SEAM(1);
    PH(2, { ph_norm<true>(args.in[I_X], HB, (float*)(ws + WS_SA), args.in[I_N1G], mod, 0, 2048, gw, ngw, lane); });
    SEAM(2);
    PH(3, { pg8::Gemm g{HB, (const bf16_t*)(ws + WS_WIN), T_TOK, 8192, 1024}; pg8::StaticOrder S; S.init(T_TOK, 8192, G, (int)blockIdx.x);
        pg8::EpiProj E{PA, PG, UBp, (const float*)(ws + WS_SA), (const float*)(ws + WS_SB)}; pg8::gemm_phase<pg8::EpiProj, pg8::StaticOrder, true, true, 1>(lds, g, S, E); });
    SEAM(3);
    PH(4, { PHS(41, { ph_attn<0>(lds, PA, ATT, args.in[I_QNG], args.in[I_KNG], G); __syncthreads(); });
        if (DUP == 411) { xcd_barrier(bar); ph_attn<1>(lds, PA, ATT, args.in[I_QNG], args.in[I_KNG], G); __syncthreads(); } PHS(42, { ph_ssm_mfma<false>(args, lds, UBp, EB, YA, G); }); });
    SEAM(4);
    PH(5, { PHS(51, { ph_ssm_mfma<true>(args, lds, UBp, EB, YA, G); __syncthreads(); });
        PHS(52, { pg8::Gemm g{ATT, (const bf16_t*)(ws + WS_WATT), T_TOK, 2048, 512}; pg8::SplitOrder S; S.init(T_TOK, 2048, G, (int)blockIdx.x);
        pg8::EpiAttUp E{PG, HB}; pg8::gemm_phase<pg8::EpiAttUp, pg8::SplitOrder, true, true, 2>(lds, g, S, E); }); });
    SEAM(5);
    PH(6, { pg8::Gemm g{YA, (const bf16_t*)(ws + WS_WGLU), T_TOK, 4096, 512}; pg8::StaticOrder S; S.init(T_TOK, 4096, G, (int)blockIdx.x);
        pg8::EpiGlu E{PG, HB, (unsigned char*)ATT}; pg8::gemm_phase<pg8::EpiGlu, pg8::StaticOrder, true, true, 2>(lds, g, S, E); });
    SEAM(6);
    PH(7, { const bool split = (G == 256); const int gg = split ? 171 : G, ra = split ? 11264 : 0;
        if ((int)blockIdx.x < gg) { pg8::Gemm g{ATT, (const bf16_t*)(ws + WS_WOUT), T_TOK, 2048, 1024}; pg8::StaticOrder S; S.init(T_TOK, 2048, gg, (int)blockIdx.x);
            pg8::EpiOut E{args.in[I_X], args.out, mod}; pg8::gemm_phase<pg8::EpiOut, pg8::StaticOrder, true, true, 2>(lds, g, S, E); }
        else ph_table_cvt(args.in[I_PU], args.in[I_PV], ws + WS_UT, ws + WS_VT, 0, ra, ((int)blockIdx.x - gg) * 8 + wave, (G - gg) * 8, lane);
        ph_table_cvt(args.in[I_PU], args.in[I_PV], ws + WS_UT, ws + WS_VT, ra, 16384, gw, ngw, lane); });
    SEAM(7);
    PH(8, { ph_norm<false>(args.out, HB, nullptr, args.in[I_N2G], mod, 6144, 8192, gw, ngw, lane); });
    SEAM(8);
    PH(9, { pg8::Gemm g{HB, (const bf16_t*)(ws + WS_WSC), T_TOK, 2048, 2048}; pg8::StaticOrder S; S.init(T_TOK, 2048, G, (int)blockIdx.x);
        pg8::EpiF32 E{(float*)(ws + WS_SC)}; pg8::gemm_phase<pg8::EpiF32, pg8::StaticOrder, true, true>(lds, g, S, E); });
    SEAM(9);
    PH(10, { ph_peer_topk(lds, (const float*)(ws + WS_SC), (int*)(ws + WS_IDX), (float*)(ws + WS_GATE), G); });
    SEAM(10);
    PH(11, { ph_peer_u(ws + WS_UT, HB, (const int*)(ws + WS_IDX), (float*)(ws + WS_PDOT), G); });
    SEAM(11);
    PH(12, { ph_peer_act((const float*)(ws + WS_PDOT), (const float*)(ws + WS_GATE), (float*)(ws + WS_ACT), G); });
    SEAM(12);
    if (IN(13)) { if (DUP == 13) { ph_peer_v<true>(lds, ws + WS_VT, (const int*)(ws + WS_IDX), (const float*)(ws + WS_ACT), mod, args.out, G); xcd_barrier(bar); }
        ph_peer_v<false>(lds, ws + WS_VT, (const int*)(ws + WS_IDX), (const float*)(ws + WS_ACT), mod, args.out, G); }
#undef IN
#undef SEAM
}

extern "C" void kernel_launch(void* const* d_in, const int* in_sizes, int n_in, void* d_out, int out_size, void* d_ws, size_t ws_size, hipStream_t stream) {
    static int grid = 0;
    if (grid == 0) {
        if (n_in != 25 || out_size != T_TOK * DM || ws_size < WS_END) { fprintf(stderr, "kernel_launch: unexpected shapes (n_in %d out %d ws %zu need %zu)\n", n_in, out_size, ws_size, (size_t)WS_END); grid = -1; return; }
        int dev = 0, cus = 0, per_cu = 0;
        if (hipGetDevice(&dev) != hipSuccess || hipDeviceGetAttribute(&cus, hipDeviceAttributeMultiprocessorCount, dev) != hipSuccess) { grid = -1; return; }
        if (hipFuncSetAttribute((const void*)mk_fwd, hipFuncAttributeMaxDynamicSharedMemorySize, LDS_BYTES) != hipSuccess) { fprintf(stderr, "kernel_launch: hipFuncSetAttribute failed\n"); grid = -1; return; }
        if (hipOccupancyMaxActiveBlocksPerMultiprocessor(&per_cu, (const void*)mk_fwd, 512, LDS_BYTES) != hipSuccess || per_cu < 1) { fprintf(stderr, "kernel_launch: occupancy query says %d blocks/CU\n", per_cu); (void)hipGetLastError(); grid = -1; return; }
        grid = cus;
    }
    if (grid < 0) return;
    (void)hipMemsetAsync((char*)d_ws + WS_CTL, 0, 16384, stream);
    Args a{};
    for (int i = 0; i < 25; ++i) a.in[i] = (const float*)d_in[i];
    a.out = (float*)d_out; a.ws = (unsigned char*)d_ws;
#if MK_PER_PHASE
    for (int ph = 0; ph < NPHASE; ++ph) { a.ph_lo = ph; a.ph_hi = ph + 1; hipLaunchKernelGGL(mk_fwd, dim3(grid), dim3(512), LDS_BYTES, stream, a); }
#else
    a.ph_lo = 0; a.ph_hi = NPHASE;
    hipLaunchKernelGGL(mk_fwd, dim3(grid), dim3(512), LDS_BYTES, stream, a);
#endif
}
```

```cpp
#include <hip/hip_runtime.h>
#include <cstdio>
#include <cstdint>

#ifndef MK_PER_PHASE
#define MK_PER_PHASE 0
#endif

#ifndef DUP
#define DUP -1
#endif
#define LAS __attribute__((address_space(3)))
typedef unsigned short bf16_t;
typedef short bf16x8 __attribute__((ext_vector_type(8)));
typedef float f32x4 __attribute__((ext_vector_type(4)));
typedef float f32x2 __attribute__((ext_vector_type(2)));
typedef unsigned u32x4 __attribute__((ext_vector_type(4)));
typedef unsigned u32x2 __attribute__((ext_vector_type(2)));
typedef int i32x4 __attribute__((ext_vector_type(4)));

constexpr int T_TOK = 16384, DM = 2048, SEQ = 8192;
constexpr int NPHASE = 14;
constexpr float EPS = 1e-6f;

constexpr size_t WS_CTL   = 0;
constexpr size_t WS_MODP  = 65536;
constexpr size_t WS_MOD   = WS_MODP + (size_t)32 * 2 * 12288 * 4;
constexpr size_t WS_WIN   = WS_MOD + (size_t)2 * 12288 * 4;
constexpr size_t WS_WGLU  = WS_WIN + (size_t)8192 * 2048 * 2;
constexpr size_t WS_WATT  = WS_WGLU + (size_t)4096 * 1024 * 2;
constexpr size_t WS_WOUT  = WS_WATT + (size_t)2048 * 1024 * 2;
constexpr size_t WS_WSC   = WS_WOUT + (size_t)2048 * 2048 * 2;
constexpr size_t WS_H     = WS_WSC + (size_t)2048 * 2048 * 2;
constexpr size_t WS_PA    = WS_H + (size_t)T_TOK * 2048 * 2;
constexpr size_t WS_PG    = WS_PA + (size_t)T_TOK * 4096 * 2;
constexpr size_t WS_E     = WS_PG + (size_t)T_TOK * 4096 * 2;
constexpr size_t WS_YA    = WS_E + (size_t)2 * 64 * 128 * 64 * 8;
constexpr size_t WS_ATT   = WS_YA + (size_t)T_TOK * 1024 * 2;
constexpr size_t WS_UB    = WS_ATT + (size_t)T_TOK * 1024 * 2;
constexpr size_t WS_SA    = WS_UB + (size_t)T_TOK * 1024 * 2;
constexpr size_t WS_SB    = WS_SA + (size_t)T_TOK * 4;
constexpr size_t WS_CMAXP = WS_SB + (size_t)8192 * 4;
constexpr size_t WS_END   = WS_CMAXP + (size_t)32 * 8192 * 4;
constexpr size_t WS_SC    = WS_PA;
constexpr size_t WS_UT    = WS_PG;
constexpr size_t WS_VT    = WS_PG + (size_t)8 * 16384 * 192;
constexpr size_t WS_PDOT  = WS_VT + (size_t)8 * 16384 * 192;
constexpr size_t WS_IDX   = WS_YA;
constexpr size_t WS_GATE  = WS_YA + (size_t)T_TOK * 128 * 4;
constexpr size_t WS_ACT   = WS_GATE + (size_t)T_TOK * 128 * 4;
static_assert(WS_PDOT + (size_t)8 * T_TOK * 128 * 4 <= WS_PG + (size_t)T_TOK * 4096 * 2, "PEER buffers must fit the dead g_ssm|g_att region");
static_assert(WS_ACT + (size_t)T_TOK * 128 * 4 <= WS_YA + (size_t)T_TOK * 1024 * 2, "PEER index buffers must fit the dead YA region");
constexpr int LDS_MAIN = 131072, LDS_BYTES = LDS_MAIN + 256;

typedef __bf16 bf16x2_t __attribute__((ext_vector_type(2)));
__device__ __forceinline__ unsigned cvt_pk_bf16(float lo, float hi) { const f32x2 v = {lo, hi}; return __builtin_bit_cast(unsigned, __builtin_convertvector(v, bf16x2_t)); }
__device__ __forceinline__ float bf_lo(unsigned w) { return __uint_as_float(w << 16); }
__device__ __forceinline__ float bf_hi(unsigned w) { return __uint_as_float(w & 0xffff0000u); }
__device__ __forceinline__ float wave_sum(float v) {
#pragma unroll
    for (int o = 1; o < 64; o <<= 1) v += __shfl_xor(v, o);
    return v;
}
__device__ __forceinline__ float sigmoidf_(float x) { return __builtin_amdgcn_rcpf(1.0f + __builtin_amdgcn_exp2f(-1.4426950408889634f * x)); }
__device__ __forceinline__ float gelu_tanh(float x) {
    const float a2 = (-2.0f * 0.7978845608028654f * 1.4426950408889634f) * (x + 0.044715f * x * x * x);
    return x * __builtin_amdgcn_rcpf(1.0f + __builtin_amdgcn_exp2f(a2));
}
constexpr float F8_SA = 8.0f, F8_SW = 64.0f, F8_INV = 1.0f / 512.0f;
__device__ __forceinline__ unsigned pack4_fp8(float a, float b, float c, float d, float sc) {
    a = fminf(fmaxf(a * sc, -448.f), 448.f); b = fminf(fmaxf(b * sc, -448.f), 448.f); c = fminf(fmaxf(c * sc, -448.f), 448.f); d = fminf(fmaxf(d * sc, -448.f), 448.f);
    int p = 0; p = __builtin_amdgcn_cvt_pk_fp8_f32(a, b, p, false); p = __builtin_amdgcn_cvt_pk_fp8_f32(c, d, p, true); return (unsigned)p; }
__device__ __forceinline__ float sum8_dpp(float v) {
    v += __builtin_bit_cast(float, __builtin_amdgcn_update_dpp(0, __builtin_bit_cast(int, v), 0xB1, 0xF, 0xF, true));
    v += __builtin_bit_cast(float, __builtin_amdgcn_update_dpp(0, __builtin_bit_cast(int, v), 0x4E, 0xF, 0xF, true));
    v += __builtin_bit_cast(float, __builtin_amdgcn_update_dpp(0, __builtin_bit_cast(int, v), 0x141, 0xF, 0xF, true));
    return v; }
#define LDS_WAIT() asm volatile("s_waitcnt lgkmcnt(0)" ::: "memory")
__device__ __forceinline__ int opaque_tid() { int t = threadIdx.x; asm volatile("" : "+v"(t)); return t; }

#define XB_TMO      128
#define XB_XCNT(j)  (256  + 64 * (j))
#define XB_XSUB(j)  (1280 + 64 * (j))
#define XB_XGEN(j)  (2304 + 64 * (j))
#define XB_TOP      3328
#define XB_TOPGEN   3392
#define XCD_BAR_WORDS 3456
#define XB_SPIN_CAP (1u << 22)
__device__ __forceinline__ unsigned xb_ld(unsigned* p)              { return __hip_atomic_load(p, __ATOMIC_RELAXED, __HIP_MEMORY_SCOPE_AGENT); }
__device__ __forceinline__ unsigned xb_add(unsigned* p, unsigned v) { return __hip_atomic_fetch_add(p, v, __ATOMIC_RELAXED, __HIP_MEMORY_SCOPE_AGENT); }
__device__ __forceinline__ unsigned xb_xcc_id() { return (unsigned)__builtin_amdgcn_s_getreg((3 << 11) | 20) & 0xFu; }
#define XB_SPIN(cond, bar) do { unsigned _sp = 0; while (cond) { __builtin_amdgcn_s_sleep(1); \
    if ((++_sp & 255u) == 0u) { if (xb_ld(&(bar)[XB_TMO])) break; if (_sp > XB_SPIN_CAP) { atomicAdd(&(bar)[XB_TMO], 1u); break; } } } } while (0)
struct XcdBarrier { unsigned* bar; unsigned x; volatile LAS unsigned* st; };
__device__ __forceinline__ XcdBarrier xcd_barrier_post(unsigned* bar, volatile LAS unsigned* st) {
    XcdBarrier b; b.bar = bar; b.x = xb_xcc_id(); b.st = st;
    if (threadIdx.x == 0) (void)xb_add(&bar[XB_XCNT(b.x)], 1u);
    return b;
}
__device__ __forceinline__ void xcd_barrier_complete(unsigned* bar, unsigned x, unsigned& nloc, unsigned& nx) {
    const unsigned G = gridDim.x * gridDim.y * gridDim.z;
    unsigned sum, cnt, mine, sp = 0u;
    for (;;) {
        sum = 0u; cnt = 0u; mine = 0u;
#pragma unroll
        for (unsigned j = 0; j < 16; ++j) { const unsigned c = xb_ld(&bar[XB_XCNT(j)]); sum += c; cnt += (c > 0u) ? 1u : 0u; mine = (j == x) ? c : mine; }
        if (sum == G) break;
        __builtin_amdgcn_s_sleep(1);
        if ((++sp & 255u) == 0u) { if (xb_ld(&bar[XB_TMO])) break; if (sp > XB_SPIN_CAP) { atomicAdd(&bar[XB_TMO], 1u); break; } }
    }
    nloc = mine > 0u ? mine : 1u; nx = cnt > 0u ? cnt : 1u;
}
__device__ __forceinline__ void xcd_barrier(const XcdBarrier& b) {
    asm volatile("s_waitcnt vmcnt(0)" ::: "memory");
    __syncthreads();
    if (threadIdx.x == 0) {
        unsigned* bar = b.bar;
        __builtin_amdgcn_s_waitcnt(0);
        unsigned nloc = b.st[0], nx = b.st[1];
        if (nloc == 0u) { xcd_barrier_complete(bar, b.x, nloc, nx); b.st[0] = nloc; b.st[1] = nx; }
        const unsigned old = xb_add(&bar[XB_XSUB(b.x)], 1u);
        const unsigned gen = old / nloc;
        if (old + 1u == (gen + 1u) * nloc) {
            __builtin_amdgcn_fence(__ATOMIC_RELEASE, "agent");
            asm volatile("s_waitcnt vmcnt(0)" ::: "memory");
            const unsigned og = xb_add(&bar[XB_TOP], 1u);
            const unsigned tg = og / nx;
            if (og + 1u == (tg + 1u) * nx) xb_add(&bar[XB_TOPGEN], 1u);
            else XB_SPIN(xb_ld(&bar[XB_TOPGEN]) == tg, bar);
            __builtin_amdgcn_fence(__ATOMIC_ACQUIRE, "agent");
            xb_add(&bar[XB_XGEN(b.x)], 1u);
            asm volatile("s_waitcnt vmcnt(0)" ::: "memory");
        } else {
            XB_SPIN(xb_ld(&bar[XB_XGEN(b.x)]) == gen, bar);
            __builtin_amdgcn_fence(__ATOMIC_ACQUIRE, "agent");
            asm volatile("s_waitcnt vmcnt(0)" ::: "memory");
        }
    }
    __syncthreads();
}

namespace pg8 {
constexpr int BM = 256, BK = 64, HALF = 128, HTB = HALF * BK * 2, STAGE_BYTES = 8 * HTB, NXCD = 8, WGM = 8;
__host__ __device__ __forceinline__ int lds_byte(int r, int c) { const int st = (r >> 4) * 2 + (c >> 5), rr = r & 15, cc = c & 31, ob = rr * 64 + cc * 2; return st * 1024 + (ob ^ (((ob >> 9) & 1) << 5)); }
__host__ __device__ __forceinline__ void stage_rc(int b, int& R, int& C) { const int st = b / 1024, sb = b % 1024, swz = sb ^ (((sb >> 9) & 1) << 5); R = (st >> 1) * 16 + swz / 64; C = (st & 1) * 32 + (swz % 64) / 2; }
__host__ __device__ __forceinline__ int perm32(int rho) { const int n = rho >> 4, i = rho & 15; return 8 * (i >> 2) + 4 * n + (i & 3); }
struct Unit { int pm, pn; };
struct Gemm { const bf16_t* A; const bf16_t* Bt; int M, N, K; };
struct StaticOrder {
    int nM, nN, nwg, G, c;
    __host__ __device__ void init(int M, int N, int G_, int c_) { nM = M / BM; nN = N / BM; nwg = nM * nN; G = G_; c = c_; }
    __host__ __device__ bool next(int i, Unit& u) const { return at((long)i * G + c, u); }
    __host__ __device__ bool at(long L, Unit& u) const {
        if (L >= nwg) return false;
        int wgid = (int)L; { const int q = nwg / NXCD, r = nwg % NXCD, xcd = wgid % NXCD, off = wgid / NXCD; wgid = (xcd < r ? xcd * (q + 1) : r * (q + 1) + (xcd - r) * q) + off; }
        const int nig = WGM * nN, gid = wgid / nig, fm = gid * WGM, gsz = (nM - fm) < WGM ? (nM - fm) : WGM;
        u.pm = fm + ((wgid % nig) % gsz); u.pn = (wgid % nig) / gsz; return true;
    }
    __device__ __forceinline__ void a_ready(const Unit&) const {}
    __device__ __forceinline__ void done(const Unit&) const {}
};
struct SplitOrder {
    StaticOrder b;
    __host__ __device__ void init(int M, int N, int G_, int c_) { b.init(M, N, G_, c_); }
    __host__ __device__ bool next(int i, Unit& u) const {
        if (b.G != 256 || b.nwg != 512) return b.next(i, u);
        if (b.c < 128) return false;
        return i < 4 ? b.at((b.c - 128) * 4 + i, u) : false;
    }
    __device__ __forceinline__ void a_ready(const Unit&) const {}
    __device__ __forceinline__ void done(const Unit&) const {}
};
typedef int i32x8 __attribute__((ext_vector_type(8)));
template <class Epi, class Sched, bool ALIGN_EPI = false, bool SP2 = false, int MODE = 0>
__device__ __forceinline__ void gemm_phase(LAS unsigned char* lds, const Gemm g, const Sched& S, const Epi& E) {
    const int tid = threadIdx.x, wid = __builtin_amdgcn_readfirstlane(tid >> 6), lane = tid & 63, wr = wid >> 2, wc = wid & 3, fr = lane & 15, fq = lane >> 4;
    const int K = g.K, nt = K / BK;
    unsigned voffA[2], voffB[2];
#pragma unroll
    for (int i = 0; i < 2; ++i) { int R, C; stage_rc(tid * 16 + i * 8192, R, C); const int Rb = Epi::PERM ? ((R & ~31) + perm32(R & 31)) : R;
        voffA[i] = (unsigned)(R * K + C) * 2u; voffB[i] = (unsigned)(Rb * K + C) * 2u; }
    const size_t kstep = (size_t)(BK * 2);
    const size_t hstep = (size_t)HALF * K * 2;
    const size_t tstep = 2 * hstep;
    const unsigned ldsw = (unsigned)wid * 1024u;
    const int aoff = lds_byte(wr * 64 + fr, fq * 8), boff = lds_byte(wc * 32 + fr, fq * 8);
#define PG8_SA(b, h) (((b) * 2 + (h)) * HTB)
#define PG8_SB(b, h) ((4 + (b) * 2 + (h)) * HTB)
#define PG8_STAGE(bufoff, gbase, voff) do { _Pragma("unroll") for (int _i = 0; _i < 2; ++_i) \
        __builtin_amdgcn_global_load_lds((const unsigned*)((const char*)(gbase) + (voff)[_i]), (LAS unsigned*)(lds + (bufoff) + ldsw + _i * 8192), 16, 0, 0); } while (0)
#define PG8_LD8(p_) ({ const i32x4 _lo = *(const LAS i32x4*)(p_), _hi = *(const LAS i32x4*)((p_) + 1024); (i32x8){_lo[0], _lo[1], _lo[2], _lo[3], _hi[0], _hi[1], _hi[2], _hi[3]}; })
#define PG8_LDA(dst, b, h) do { _Pragma("unroll") for (int m = 0; m < 4; ++m) dst[m] = PG8_LD8(lds + PG8_SA(b, h) + aoff + m * 2048); } while (0)
#define PG8_LDB(dst, b, h) do { _Pragma("unroll") for (int n = 0; n < 2; ++n) dst[n] = PG8_LD8(lds + PG8_SB(b, h) + boff + n * 2048); } while (0)
#define PG8_HALF(v, k) ((k) == 0 ? __builtin_shufflevector(v, v, 0, 1, 2, 3) : __builtin_shufflevector(v, v, 4, 5, 6, 7))
#define PG8_MMA(ai, bj, At, Bt) do { __builtin_amdgcn_s_setprio(1); _Pragma("unroll") for (int m = 0; m < 4; ++m) _Pragma("unroll") for (int n = 0; n < 2; ++n) { \
        if (MODE == 2) asm volatile("v_mfma_scale_f32_16x16x128_f8f6f4 %0, %1, %2, %0, %3, %3 op_sel_hi:[0,0,0]" : "+v"(acc[ai][bj][m][n]) : "v"(Bt[n]), "v"(At[m]), "v"(scl1)); \
        else { _Pragma("unroll") for (int k = 0; k < 2; ++k) \
            acc[ai][bj][m][n] = (MODE == 1) ? __builtin_bit_cast(f32x4, __builtin_amdgcn_mfma_i32_16x16x64_i8(PG8_HALF(Bt[n], k), PG8_HALF(At[m], k), __builtin_bit_cast(i32x4, acc[ai][bj][m][n]), 0, 0, 0)) \
                                            : __builtin_amdgcn_mfma_f32_16x16x32_bf16(__builtin_bit_cast(bf16x8, PG8_HALF(Bt[n], k)), __builtin_bit_cast(bf16x8, PG8_HALF(At[m], k)), acc[ai][bj][m][n], 0, 0, 0); } } __builtin_amdgcn_s_setprio(0); } while (0)
#define PG8_WAIT_V(n) asm volatile("s_waitcnt vmcnt(" #n ")" ::: "memory")
#define PG8_WAIT_L(n) asm volatile("s_waitcnt lgkmcnt(" #n ")" ::: "memory")
#define PG8_BAR __builtin_amdgcn_s_barrier()
#define PG8_SCHED __builtin_amdgcn_sched_barrier(0)
    const int scl1 = 0x7f7f7f7f;
    Unit cur, nxt; int ui = 0;
    if (!S.next(0, cur)) return;
    f32x4 acc[2][2][4][2];
#pragma unroll
    for (int a = 0; a < 2; ++a)
#pragma unroll
        for (int b = 0; b < 2; ++b)
#pragma unroll
            for (int m = 0; m < 4; ++m)
#pragma unroll
                for (int n = 0; n < 2; ++n) acc[a][b][m][n] = (f32x4){0.f, 0.f, 0.f, 0.f};
    i32x8 At[4], B0[2], B1[2];
    const char* cA = (const char*)g.A + (size_t)cur.pm * tstep; const char* cB = (const char*)g.Bt + (size_t)cur.pn * tstep;
    S.a_ready(cur);
    if constexpr (SP2) {
        PG8_STAGE(PG8_SB(0, 0), cB, voffB); PG8_STAGE(PG8_SB(0, 1), cB + hstep, voffB); PG8_STAGE(PG8_SA(0, 0), cA, voffA); PG8_STAGE(PG8_SA(0, 1), cA + hstep, voffA);
        if (wr == 1) PG8_BAR;
        PG8_WAIT_V(2); PG8_BAR;
        PG8_STAGE(PG8_SB(1, 0), cB + kstep, voffB); PG8_STAGE(PG8_SA(1, 0), cA + kstep, voffA); PG8_STAGE(PG8_SB(1, 1), cB + hstep + kstep, voffB);
        PG8_WAIT_V(6); PG8_BAR;
    } else {
        PG8_STAGE(PG8_SB(0, 0), cB, voffB); PG8_STAGE(PG8_SA(0, 0), cA, voffA); PG8_STAGE(PG8_SB(0, 1), cB + hstep, voffB); PG8_STAGE(PG8_SA(0, 1), cA + hstep, voffA);
        if (wr == 1) PG8_BAR;
        PG8_WAIT_V(4); PG8_BAR;
        PG8_STAGE(PG8_SB(1, 0), cB + kstep, voffB); PG8_STAGE(PG8_SA(1, 0), cA + kstep, voffA); PG8_STAGE(PG8_SB(1, 1), cB + hstep + kstep, voffB);
        PG8_WAIT_V(6); PG8_BAR;
    }
    for (;;) {
        const bool has_next = S.next(ui + 1, nxt);
        const char* nA = has_next ? (const char*)g.A + (size_t)nxt.pm * tstep : cA; const char* nB = has_next ? (const char*)g.Bt + (size_t)nxt.pn * tstep : cB;
#pragma unroll 1
        for (int t = 0; t < nt; t += 2) {
            const bool last = (t == nt - 2);
            const char* a1 = cA + (size_t)(t + 1) * kstep;
            const char* a2 = last ? nA : cA + (size_t)(t + 2) * kstep; const char* b2 = last ? nB : cB + (size_t)(t + 2) * kstep;
            const char* a3 = a2 + kstep; const char* b3 = b2 + kstep;
            if (last && has_next) S.a_ready(nxt);
            if constexpr (SP2) {
            PG8_LDB(B0, 0, 0); PG8_LDB(B1, 0, 1); PG8_SCHED; PG8_LDA(At, 0, 0); PG8_STAGE(PG8_SA(1, 1), a1 + hstep, voffA);
            PG8_WAIT_V(8); PG8_WAIT_L(0); PG8_BAR; PG8_MMA(0, 0, At, B0); PG8_MMA(0, 1, At, B1); PG8_BAR; PG8_SCHED;
            PG8_LDA(At, 0, 1); PG8_STAGE(PG8_SB(0, 0), b2, voffB); PG8_STAGE(PG8_SB(0, 1), b2 + hstep, voffB); PG8_STAGE(PG8_SA(0, 0), a2, voffA);
            PG8_WAIT_V(8); PG8_WAIT_L(0); PG8_BAR; PG8_MMA(1, 0, At, B0); PG8_MMA(1, 1, At, B1); PG8_BAR; PG8_SCHED;
            PG8_LDB(B0, 1, 0); PG8_LDB(B1, 1, 1); PG8_SCHED; PG8_LDA(At, 1, 0); PG8_STAGE(PG8_SA(0, 1), a2 + hstep, voffA);
            PG8_WAIT_V(8); PG8_WAIT_L(0); PG8_BAR; PG8_MMA(0, 0, At, B0); PG8_MMA(0, 1, At, B1); PG8_BAR; PG8_SCHED;
            PG8_LDA(At, 1, 1); PG8_STAGE(PG8_SB(1, 0), b3, voffB); PG8_STAGE(PG8_SB(1, 1), b3 + hstep, voffB); PG8_STAGE(PG8_SA(1, 0), a3, voffA);
            PG8_WAIT_V(8); PG8_WAIT_L(0); PG8_BAR; PG8_MMA(1, 0, At, B0); PG8_MMA(1, 1, At, B1); PG8_BAR; PG8_SCHED;
            } else {
            PG8_LDB(B0, 0, 0); PG8_SCHED; PG8_LDA(At, 0, 0); PG8_STAGE(PG8_SA(1, 1), a1 + hstep, voffA);
            PG8_WAIT_L(8); PG8_BAR; PG8_WAIT_L(0); PG8_MMA(0, 0, At, B0); PG8_BAR; PG8_SCHED;
            PG8_LDB(B1, 0, 1); PG8_STAGE(PG8_SB(0, 0), b2, voffB);
            PG8_BAR; PG8_WAIT_L(0); PG8_MMA(0, 1, At, B1); PG8_BAR;
            PG8_LDA(At, 0, 1); PG8_STAGE(PG8_SA(0, 0), a2, voffA);
            PG8_BAR; PG8_WAIT_L(0); PG8_MMA(1, 0, At, B0); PG8_BAR; PG8_SCHED;
            PG8_STAGE(PG8_SB(0, 1), b2 + hstep, voffB);
            PG8_WAIT_V(6); PG8_BAR; PG8_MMA(1, 1, At, B1); PG8_BAR;
            PG8_LDB(B0, 1, 0); PG8_SCHED; PG8_LDA(At, 1, 0); PG8_STAGE(PG8_SA(0, 1), a2 + hstep, voffA);
            PG8_WAIT_L(8); PG8_BAR; PG8_WAIT_L(0); PG8_MMA(0, 0, At, B0); PG8_BAR; PG8_SCHED;
            PG8_LDB(B1, 1, 1); PG8_STAGE(PG8_SB(1, 0), b3, voffB);
            PG8_BAR; PG8_WAIT_L(0); PG8_MMA(0, 1, At, B1); PG8_BAR;
            PG8_LDA(At, 1, 1); PG8_STAGE(PG8_SA(1, 0), a3, voffA);
            PG8_BAR; PG8_WAIT_L(0); PG8_MMA(1, 0, At, B0); PG8_BAR; PG8_SCHED;
            PG8_STAGE(PG8_SB(1, 1), b3 + hstep, voffB);
            PG8_WAIT_V(6); PG8_BAR; PG8_MMA(1, 1, At, B1); PG8_BAR;
            }
        }
        if constexpr (ALIGN_EPI) { if (wr == 0) PG8_BAR; }
        if (MODE == 2) asm volatile("s_nop 15\n\ts_nop 15" ::: "memory");
        E(acc, cur, wr, wc, fr, fq); S.done(cur);
        if (!has_next) break;
#pragma unroll
        for (int a = 0; a < 2; ++a)
#pragma unroll
            for (int b = 0; b < 2; ++b)
#pragma unroll
                for (int m = 0; m < 4; ++m)
#pragma unroll
                    for (int n = 0; n < 2; ++n) acc[a][b][m][n] = (f32x4){0.f, 0.f, 0.f, 0.f};
        cur = nxt; cA = nA; cB = nB; ++ui;
        if constexpr (ALIGN_EPI) { if (wr == 1) PG8_BAR; }
    }
    PG8_WAIT_V(0);
    if constexpr (!ALIGN_EPI) { if (wr == 0) PG8_BAR; }
    PG8_BAR;
#undef PG8_SA
#undef PG8_SB
#undef PG8_STAGE
#undef PG8_LDA
#undef PG8_LDB
#undef PG8_MMA
#undef PG8_WAIT_V
#undef PG8_WAIT_L
#undef PG8_BAR
#undef PG8_SCHED
}

struct EpiProj {
    static constexpr bool PERM = true;
    bf16_t* PA; bf16_t* PG; bf16_t* UB; const float* SA; const float* SB;
    __device__ __forceinline__ void operator()(const f32x4 (&acc)[2][2][4][2], const Unit& u, int wr, int wc, int fr, int fq) const {
        const int row0 = u.pm * BM + wr * 64 + fr; int colt = u.pn * BM; const bool isu = colt < 1024; bf16_t* base = colt < 4096 ? PA : PG;
        const int gcol0 = colt + wc * 32 + 8 * fq; colt &= 4095;
        const int col0 = colt + wc * 32 + 8 * fq;
        f32x4 sb[2][2];
#pragma unroll
        for (int bj = 0; bj < 2; ++bj) { sb[bj][0] = *(const f32x4*)(SB + gcol0 + bj * HALF); sb[bj][1] = *(const f32x4*)(SB + gcol0 + bj * HALF + 4); }
#pragma unroll
        for (int ai = 0; ai < 2; ++ai)
#pragma unroll
            for (int m = 0; m < 4; ++m) { const int row = row0 + ai * HALF + m * 16; bf16_t* rowp = base + (size_t)row * 4096 + col0; const float sa = SA[row];
#pragma unroll
                for (int bj = 0; bj < 2; ++bj) { const i32x4 i0 = __builtin_bit_cast(i32x4, acc[ai][bj][m][0]), i1 = __builtin_bit_cast(i32x4, acc[ai][bj][m][1]);
                    f32x4 v0, v1;
#pragma unroll
                    for (int e = 0; e < 4; ++e) { v0[e] = (float)i0[e] * sa * sb[bj][0][e]; v1[e] = (float)i1[e] * sa * sb[bj][1][e]; }
                    u32x4 w; w.x = cvt_pk_bf16(v0[0], v0[1]); w.y = cvt_pk_bf16(v0[2], v0[3]); w.z = cvt_pk_bf16(v1[0], v1[1]); w.w = cvt_pk_bf16(v1[2], v1[3]);
                    if (isu) { const int cu = col0 + bj * HALF; *(u32x4*)(UB + (((size_t)((row >> 13) * 64 + (cu >> 4)) * 8192 + (row & 8191)) * 16 + (cu & 8))) = w; }
                    else *(u32x4*)(rowp + bj * HALF) = w; } }
    }
};
struct EpiAttUp {
    static constexpr bool PERM = true;
    const bf16_t* PG; bf16_t* HB;
    __device__ __forceinline__ void operator()(const f32x4 (&acc)[2][2][4][2], const Unit& u, int wr, int wc, int fr, int fq) const {
        const int row0 = u.pm * BM + wr * 64 + fr; const int col0 = u.pn * BM + wc * 32 + 8 * fq;
#pragma unroll
        for (int ai = 0; ai < 2; ++ai)
#pragma unroll
            for (int m = 0; m < 4; ++m) { const size_t row = (size_t)(row0 + ai * HALF + m * 16);
#pragma unroll
                for (int bj = 0; bj < 2; ++bj) { const int col = col0 + bj * HALF;
                    const u32x4 gw = *(const u32x4*)(PG + row * 4096 + 2048 + col);
                    const f32x4 v0 = acc[ai][bj][m][0] * F8_INV, v1 = acc[ai][bj][m][1] * F8_INV;
                    u32x4 w;
                    w.x = cvt_pk_bf16(v0[0] * sigmoidf_(bf_lo(gw.x)), v0[1] * sigmoidf_(bf_hi(gw.x)));
                    w.y = cvt_pk_bf16(v0[2] * sigmoidf_(bf_lo(gw.y)), v0[3] * sigmoidf_(bf_hi(gw.y)));
                    w.z = cvt_pk_bf16(v1[0] * sigmoidf_(bf_lo(gw.z)), v1[1] * sigmoidf_(bf_hi(gw.z)));
                    w.w = cvt_pk_bf16(v1[2] * sigmoidf_(bf_lo(gw.w)), v1[3] * sigmoidf_(bf_hi(gw.w)));
                    *(u32x4*)(HB + row * 2048 + col) = w; } asm volatile("" ::: "memory"); }
    }
};
struct EpiGlu {
    static constexpr bool PERM = true;
    const bf16_t* PG; const bf16_t* HB; unsigned char* M8;
    __device__ __forceinline__ void operator()(const f32x4 (&acc)[2][2][4][2], const Unit& u, int wr, int wc, int fr, int fq) const {
        const int row0 = u.pm * BM + wr * 64 + fr; const int col = u.pn * HALF + wc * 32 + 8 * fq;
#pragma unroll
        for (int ai = 0; ai < 2; ++ai)
#pragma unroll
            for (int m = 0; m < 4; ++m) { const size_t row = (size_t)(row0 + ai * HALF + m * 16);
                const u32x4 gw = *(const u32x4*)(PG + row * 4096 + col);
                const u32x4 aw = *(const u32x4*)(HB + row * 2048 + col);
                const f32x4 a0 = acc[ai][0][m][0] * F8_INV, a1 = acc[ai][0][m][1] * F8_INV, g0 = acc[ai][1][m][0] * F8_INV, g1 = acc[ai][1][m][1] * F8_INV;
                u32x2 w;
                w.x = pack4_fp8(sigmoidf_(bf_lo(gw.x)) * a0[0] * sigmoidf_(g0[0]) + bf_lo(aw.x), sigmoidf_(bf_hi(gw.x)) * a0[1] * sigmoidf_(g0[1]) + bf_hi(aw.x),
                                sigmoidf_(bf_lo(gw.y)) * a0[2] * sigmoidf_(g0[2]) + bf_lo(aw.y), sigmoidf_(bf_hi(gw.y)) * a0[3] * sigmoidf_(g0[3]) + bf_hi(aw.y), F8_SA);
                w.y = pack4_fp8(sigmoidf_(bf_lo(gw.z)) * a1[0] * sigmoidf_(g1[0]) + bf_lo(aw.z), sigmoidf_(bf_hi(gw.z)) * a1[1] * sigmoidf_(g1[1]) + bf_hi(aw.z),
                                sigmoidf_(bf_lo(gw.w)) * a1[2] * sigmoidf_(g1[2]) + bf_lo(aw.w), sigmoidf_(bf_hi(gw.w)) * a1[3] * sigmoidf_(g1[3]) + bf_hi(aw.w), F8_SA);
                *(u32x2*)(M8 + row * 2048 + col) = w; asm volatile("" ::: "memory"); }
    }
};
struct EpiOut {
    static constexpr bool PERM = true;
    const float* X; float* O; const float* mod;
    __device__ __forceinline__ void operator()(const f32x4 (&acc)[2][2][4][2], const Unit& u, int wr, int wc, int fr, int fq) const {
        const int row0 = u.pm * BM + wr * 64 + fr; const int col0 = u.pn * BM + wc * 32 + 8 * fq;
        const float* gt = mod + (size_t)((u.pm * BM) >> 13) * 12288 + 4096;
#pragma unroll
        for (int bj = 0; bj < 2; ++bj) { const int col = col0 + bj * HALF;
            const f32x4 g0 = *(const f32x4*)(gt + col), g1 = *(const f32x4*)(gt + col + 4);
#pragma unroll
            for (int ai = 0; ai < 2; ++ai)
#pragma unroll
                for (int m = 0; m < 4; ++m) { const size_t off = (size_t)(row0 + ai * HALF + m * 16) * 2048 + col;
                    const f32x4 x0 = *(const f32x4*)(X + off), x1 = *(const f32x4*)(X + off + 4);
                    *(f32x4*)(O + off) = x0 + g0 * (acc[ai][bj][m][0] * F8_INV); *(f32x4*)(O + off + 4) = x1 + g1 * (acc[ai][bj][m][1] * F8_INV); } }
    }
};
struct EpiF32 {
    static constexpr bool PERM = true;
    float* O;
    __device__ __forceinline__ void operator()(const f32x4 (&acc)[2][2][4][2], const Unit& u, int wr, int wc, int fr, int fq) const {
        const int row0 = u.pm * BM + wr * 64 + fr; const int col0 = u.pn * BM + wc * 32 + 8 * fq;
#pragma unroll
        for (int ai = 0; ai < 2; ++ai)
#pragma unroll
            for (int m = 0; m < 4; ++m) { float* rowp = O + (size_t)(row0 + ai * HALF + m * 16) * 2048 + col0;
#pragma unroll
                for (int bj = 0; bj < 2; ++bj) { *(f32x4*)(rowp + bj * HALF) = acc[ai][bj][m][0]; *(f32x4*)(rowp + bj * HALF + 4) = acc[ai][bj][m][1]; } }
    }
};
}

struct Args { const float* in[25]; float* out; unsigned char* ws; int ph_lo, ph_hi; };
enum { I_X = 0, I_C, I_WADA, I_BADA, I_N1G, I_WIN, I_LRE, I_LIM, I_LDT, I_BRE, I_BIM, I_CRE, I_CIM, I_SD, I_WGLU, I_QNG, I_KNG, I_WATT, I_WOUT, I_N2G, I_WQ, I_K1, I_K2, I_PU, I_PV };

__device__ __forceinline__ void ph_mod_partial(const float* __restrict__ c, const float* __restrict__ w_ada, float* modp, int gw, int ngw, int lane) {
    for (int task = gw; task < 48 * 32; task += ngw) {
        const int strip = task % 48, ks = task / 48, n0 = strip * 256 + lane * 4, k0 = ks * 64;
        f32x4 a0 = {0.f, 0.f, 0.f, 0.f}, a1 = {0.f, 0.f, 0.f, 0.f};
#pragma unroll 8
        for (int k = 0; k < 64; ++k) {
            const f32x4 w = *(const f32x4*)(w_ada + (size_t)(k0 + k) * 12288 + n0);
            float c0 = c[k0 + k], c1 = c[2048 + k0 + k];
            c0 = c0 / (1.0f + __expf(-c0)); c1 = c1 / (1.0f + __expf(-c1));
            a0 += c0 * w; a1 += c1 * w;
        }
        *(f32x4*)(modp + (size_t)(ks * 2 + 0) * 12288 + n0) = a0;
        *(f32x4*)(modp + (size_t)(ks * 2 + 1) * 12288 + n0) = a1;
    }
}

__device__ __forceinline__ void ph_colmax_partial(const float* __restrict__ w_in, float* cmaxp, int gw, int ngw, int lane) {
    for (int task = gw; task < 32 * 32; task += ngw) {
        const int strip = task & 31, ks = task >> 5, n0 = strip * 256 + lane * 4, k0 = ks * 64;
        f32x4 m = {0.f, 0.f, 0.f, 0.f};
#pragma unroll 8
        for (int k = 0; k < 64; ++k) { const f32x4 w = *(const f32x4*)(w_in + (size_t)(k0 + k) * 8192 + n0);
            m[0] = fmaxf(m[0], fabsf(w[0])); m[1] = fmaxf(m[1], fabsf(w[1])); m[2] = fmaxf(m[2], fabsf(w[2])); m[3] = fmaxf(m[3], fabsf(w[3])); }
        *(f32x4*)(cmaxp + (size_t)ks * 8192 + n0) = m;
    }
}

__device__ __forceinline__ void transpose_item_f8(const float* __restrict__ W, int K, int N, unsigned char* WT8, int drow0, int scol0, int k0, LAS float* scr, int lane) {
#pragma unroll 8
    for (int i = 0; i < 32; ++i) { const int kk = 2 * i + (lane >> 5); scr[kk * 33 + (lane & 31)] = W[(size_t)(k0 + kk) * N + scol0 + (lane & 31)]; }
    LDS_WAIT();
    const int n = lane >> 1, half = lane & 1;
    const LAS float* s = scr + (32 * half) * 33 + n;
    u32x4 o[2];
#pragma unroll
    for (int q = 0; q < 8; ++q) o[q >> 2][q & 3] = pack4_fp8(s[(4 * q) * 33], s[(4 * q + 1) * 33], s[(4 * q + 2) * 33], s[(4 * q + 3) * 33], F8_SW);
    *(u32x4*)(WT8 + (size_t)(drow0 + n) * K + k0 + 32 * half) = o[0];
    *(u32x4*)(WT8 + (size_t)(drow0 + n) * K + k0 + 32 * half + 16) = o[1];
    LDS_WAIT();
}
__device__ __forceinline__ void transpose_item_i8(const float* __restrict__ W, signed char* WT8, const float* cmaxp, float* SB, int n0, int k0, LAS float* scr, int lane) {
#pragma unroll 8
    for (int i = 0; i < 32; ++i) { const int kk = 2 * i + (lane >> 5); scr[kk * 33 + (lane & 31)] = W[(size_t)(k0 + kk) * 8192 + n0 + (lane & 31)]; }
    const int n = lane >> 1, half = lane & 1;
    float cm = 0.f;
#pragma unroll 8
    for (int ks = 0; ks < 32; ++ks) cm = fmaxf(cm, cmaxp[(size_t)ks * 8192 + n0 + n]);
    const float sb = fmaxf(cm, 1e-30f) * (1.0f / 127.0f), inv = 1.0f / sb;
    if (k0 == 0 && half == 0) SB[n0 + n] = sb;
    LDS_WAIT();
    const LAS float* s = scr + (32 * half) * 33 + n;
    u32x4 o[2];
#pragma unroll
    for (int q = 0; q < 8; ++q) { unsigned w = 0;
#pragma unroll
        for (int e = 0; e < 4; ++e) { const int v = (int)rintf(s[(4 * q + e) * 33] * inv); w |= ((unsigned)v & 0xffu) << (8 * e); }
        o[q >> 2][q & 3] = w; }
    *(u32x4*)(WT8 + (size_t)(n0 + n) * 2048 + k0 + 32 * half) = o[0];
    *(u32x4*)(WT8 + (size_t)(n0 + n) * 2048 + k0 + 32 * half + 16) = o[1];
    LDS_WAIT();
}

__device__ __forceinline__ void transpose_item(const float* __restrict__ W, int K, int N, bf16_t* WT, int drow0, int scol0, int k0, LAS float* scr, int lane) {
#pragma unroll 8
    for (int i = 0; i < 32; ++i) { const int kk = 2 * i + (lane >> 5); scr[kk * 33 + (lane & 31)] = W[(size_t)(k0 + kk) * N + scol0 + (lane & 31)]; }
    LDS_WAIT();
    const int c = lane & 7;
#pragma unroll
    for (int j = 0; j < 4; ++j) { const int n = (lane >> 3) + 8 * j; const LAS float* s = scr + (8 * c) * 33 + n;
        u32x4 o; o.x = cvt_pk_bf16(s[0 * 33], s[1 * 33]); o.y = cvt_pk_bf16(s[2 * 33], s[3 * 33]); o.z = cvt_pk_bf16(s[4 * 33], s[5 * 33]); o.w = cvt_pk_bf16(s[6 * 33], s[7 * 33]);
        *(u32x4*)(WT + (size_t)(drow0 + n) * K + k0 + 8 * c) = o; }
    LDS_WAIT();
}
__device__ __forceinline__ void wsc_item(const float* wq, const float* kk, bf16_t* out, int lane) {
    const int r = lane & 15, q = lane >> 4;
    f32x4 acc[8];
#pragma unroll
    for (int f = 0; f < 8; ++f) acc[f] = (f32x4){0.f, 0.f, 0.f, 0.f};
    const float* ap = kk + r * 128 + 4 * q; const float* bp = wq + (size_t)r * 2048 + 4 * q;
#pragma unroll 2
    for (int d0 = 0; d0 < 128; d0 += 16) {
        const f32x4 bv = *(const f32x4*)(bp + d0);
        f32x4 av[8];
#pragma unroll
        for (int f = 0; f < 8; ++f) av[f] = *(const f32x4*)(ap + f * 2048 + d0);
#pragma unroll
        for (int j = 0; j < 4; ++j)
#pragma unroll
            for (int f = 0; f < 8; ++f) acc[f] = __builtin_amdgcn_mfma_f32_16x16x4f32(av[f][j], bv[j], acc[f], 0, 0, 0);
    }
#pragma unroll
    for (int f = 0; f < 8; ++f)
#pragma unroll
        for (int i = 0; i < 4; ++i) out[(size_t)(16 * f + 4 * q + i) * 2048 + r] = (bf16_t)(cvt_pk_bf16(acc[f][i], 0.f) & 0xffffu);
}
__device__ __forceinline__ void ph_prologue(const Args& a, LAS unsigned char* lds, int gw, int ngw, int lane, int wave) {
    unsigned char* ws = a.ws;
    { const float* modp = (const float*)(ws + WS_MODP); float* mod = (float*)(ws + WS_MOD); const float* b_ada = a.in[I_BADA];
      for (int idx = gw * 64 + lane; idx < 2 * 12288; idx += ngw * 64) { const int b = idx / 12288, n = idx - b * 12288; float s = b_ada[n];
#pragma unroll 8
          for (int ks = 0; ks < 32; ++ks) s += modp[(size_t)(ks * 2 + b) * 12288 + n];
          mod[idx] = s; } }
    for (int item = gw; item < 2048; item += ngw) { const int hj = item >> 7, k0 = (item & 127) * 16;
        wsc_item(a.in[I_WQ] + (size_t)k0 * 2048 + hj * 128, (hj & 1) ? a.in[I_K2] : a.in[I_K1], (bf16_t*)(ws + WS_WSC) + (size_t)(hj * 128) * 2048 + k0, lane); }
    { LAS float* scr = (LAS float*)(lds + wave * 8448);
      constexpr int I_IN = 32 * 256, I_GLU = 16 * 128, I_ATT = 16 * 64, I_OUT = 32 * 64, NIT = I_IN + I_GLU + I_ATT + I_OUT;
      for (int it = gw; it < NIT; it += ngw) {
          int r = it;
          if (r < I_IN) { const int kb = r / 256, nb = r % 256; transpose_item_i8(a.in[I_WIN], (signed char*)(ws + WS_WIN), (const float*)(ws + WS_CMAXP), (float*)(ws + WS_SB), 32 * nb, 64 * kb, scr, lane); continue; } r -= I_IN;
          if (r < I_GLU) { const int kb = r / 128, nb = r % 128, dr = 32 * nb; const int sc = ((dr >> 7) & 1) * 2048 + (dr >> 8) * 128 + (dr & 127);
              transpose_item_f8(a.in[I_WGLU], 1024, 4096, ws + WS_WGLU, dr, sc, 64 * kb, scr, lane); continue; } r -= I_GLU;
          if (r < I_ATT) { const int kb = r / 64, nb = r % 64; transpose_item_f8(a.in[I_WATT], 1024, 2048, ws + WS_WATT, 32 * nb, 32 * nb, 64 * kb, scr, lane); continue; } r -= I_ATT;
          { const int kb = r / 64, nb = r % 64; transpose_item_f8(a.in[I_WOUT], 2048, 2048, ws + WS_WOUT, 32 * nb, 32 * nb, 64 * kb, scr, lane); }
      } }
}

template <bool I8>
__device__ __forceinline__ void ph_norm(const float* X, bf16_t* Hout, float* SA, const float* __restrict__ g, const float* mod, int sh_off, int sc_off, int gw, int ngw, int lane) {
    for (int row = gw; row < T_TOK; row += ngw) {
        const int b = row >> 13;
        const f32x4* xr = (const f32x4*)(X + (size_t)row * DM) + lane;
        f32x4 v[8]; float ss = 0.f;
#pragma unroll
        for (int j = 0; j < 8; ++j) { v[j] = xr[64 * j]; ss += (v[j][0] * v[j][0] + v[j][1] * v[j][1]) + (v[j][2] * v[j][2] + v[j][3] * v[j][3]); }
        ss = wave_sum(ss);
        const float rs = __builtin_amdgcn_rsqf(ss * (1.0f / DM) + EPS);
        const float* mb = mod + (size_t)b * 12288;
        float amax = 0.f;
#pragma unroll
        for (int j = 0; j < 8; ++j) { const int col = 4 * (lane + 64 * j);
            const f32x4 gv = *(const f32x4*)(g + col), sc = *(const f32x4*)(mb + sc_off + col), sh = *(const f32x4*)(mb + sh_off + col);
            const f32x4 o = v[j] * rs * gv * (sc + 1.0f) + sh;
            if (I8) { v[j] = o; amax = fmaxf(fmaxf(amax, fmaxf(fabsf(o[0]), fabsf(o[1]))), fmaxf(fabsf(o[2]), fabsf(o[3]))); }
            else { u32x2 w; w.x = cvt_pk_bf16(o[0], o[1]); w.y = cvt_pk_bf16(o[2], o[3]); *(u32x2*)(Hout + (size_t)row * DM + col) = w; } }
        if (I8) {
#pragma unroll
            for (int o = 1; o < 64; o <<= 1) amax = fmaxf(amax, __shfl_xor(amax, o));
            const float sa = fmaxf(amax, 1e-30f) * (1.0f / 127.0f), inv = 1.0f / sa;
            if (lane == 0) SA[row] = sa;
            unsigned* h8 = (unsigned*)((signed char*)Hout + (size_t)row * DM) + lane;
#pragma unroll
            for (int j = 0; j < 8; ++j) { unsigned w = 0;
#pragma unroll
                for (int e = 0; e < 4; ++e) { const int q = (int)rintf(v[j][e] * inv); w |= ((unsigned)q & 0xffu) << (8 * e); }
                h8[64 * j] = w; }
        }
    }
}

template <int MODE>
__device__ __forceinline__ void ph_attn(LAS unsigned char* lds, const bf16_t* PA, bf16_t* ATT, const float* __restrict__ qg, const float* __restrict__ kg, int G) {
    const int tid = opaque_tid(), lane = tid & 63, wave = __builtin_amdgcn_readfirstlane(tid >> 6), c = lane & 15, g = lane >> 4;
    LAS unsigned char* KL = lds;
    LAS unsigned char* VT = lds + 17408;
    bf16x8 tri[6];
    { const int FS[6] = {0, 1, 0, 1, 2, 3}, FP[6] = {0, 0, 1, 1, 1, 1};
#pragma unroll
      for (int q = 0; q < 6; ++q)
#pragma unroll
          for (int jj = 0; jj < 8; ++jj) { const int kap = 32 * FP[q] + 16 * (jj >> 2) + 4 * g + (jj & 3); tri[q][jj] = (kap > 16 * FS[q] + c) ? (short)0x3F80 : (short)0; } }
    for (int u = blockIdx.x; u < 1024; u += G) {
        const int b = u >> 9, h = (u >> 6) & 7, qb = u & 63, t0 = qb * 128, tq0 = t0 + 16 * wave, tq = tq0 + c;
        bf16x8 qf[4];
        { const bf16_t* qrow = PA + (size_t)(b * SEQ + tq) * 4096 + 1024 + h * 128;
          u32x4 qr[4]; float ss = 0.f;
#pragma unroll
          for (int kk = 0; kk < 4; ++kk) { qr[kk] = *(const u32x4*)(qrow + 32 * kk + 8 * g);
#pragma unroll
              for (int e = 0; e < 4; ++e) { const float lo = bf_lo(qr[kk][e]), hi = bf_hi(qr[kk][e]); ss += lo * lo + hi * hi; } }
          ss += __shfl_xor(ss, 16); ss += __shfl_xor(ss, 32);
          const float rs = __builtin_amdgcn_rsqf(ss * (1.0f / 128.0f) + EPS) * (0.08838834764831845f * 1.4426950408889634f);
#pragma unroll
          for (int kk = 0; kk < 4; ++kk) { const f32x4 g0 = *(const f32x4*)(qg + 32 * kk + 8 * g), g1 = *(const f32x4*)(qg + 32 * kk + 8 * g + 4);
              u32x4 w;
              w.x = cvt_pk_bf16(bf_lo(qr[kk].x) * rs * g0[0], bf_hi(qr[kk].x) * rs * g0[1]);
              w.y = cvt_pk_bf16(bf_lo(qr[kk].y) * rs * g0[2], bf_hi(qr[kk].y) * rs * g0[3]);
              w.z = cvt_pk_bf16(bf_lo(qr[kk].z) * rs * g1[0], bf_hi(qr[kk].z) * rs * g1[1]);
              w.w = cvt_pk_bf16(bf_lo(qr[kk].w) * rs * g1[2], bf_hi(qr[kk].w) * rs * g1[3]);
              qf[kk] = __builtin_bit_cast(bf16x8, w); } }
        float carry = 0.f; int wdone = 0;
        f32x4 oacc[8];
#pragma unroll
        for (int fd = 0; fd < 8; ++fd) oacc[fd] = (f32x4){0.f, 0.f, 0.f, 0.f};
        u32x4 kreg[2], vreg[2];
        { const int k0n = (2 * qb + 1) * 64;
#pragma unroll
          for (int p = 0; p < 2; ++p) { const int ci = tid + 512 * p, key = ci >> 4, ch = ci & 15;
              kreg[p] = *(const u32x4*)(PA + (size_t)(b * SEQ + k0n + key) * 4096 + 2048 + h * 128 + 8 * ch);
              vreg[p] = *(const u32x4*)(PA + (size_t)(b * SEQ + k0n + lane) * 4096 + 3072 + h * 128 + 8 * (wave + 8 * p)); } }
        for (int kt = 2 * qb + 1; kt >= 0; --kt) {
            const int k0 = kt * 64;
            if (__syncthreads_and(wdone)) break;
#pragma unroll
            for (int p = 0; p < 2; ++p) {
                const int ci = tid + 512 * p, key = ci >> 4, ch = ci & 15;
                const u32x4 kr = kreg[p];
                float f[8]; f[0] = bf_lo(kr.x); f[1] = bf_hi(kr.x); f[2] = bf_lo(kr.y); f[3] = bf_hi(kr.y); f[4] = bf_lo(kr.z); f[5] = bf_hi(kr.z); f[6] = bf_lo(kr.w); f[7] = bf_hi(kr.w);
                float ss = 0.f;
#pragma unroll
                for (int e = 0; e < 8; ++e) ss += f[e] * f[e];
                ss += __shfl_xor(ss, 1); ss += __shfl_xor(ss, 2); ss += __shfl_xor(ss, 4); ss += __shfl_xor(ss, 8);
                const float rs = __builtin_amdgcn_rsqf(ss * (1.0f / 128.0f) + EPS);
                const f32x4 g0 = *(const f32x4*)(kg + 8 * ch), g1 = *(const f32x4*)(kg + 8 * ch + 4);
                u32x4 w;
                w.x = cvt_pk_bf16(f[0] * rs * g0[0], f[1] * rs * g0[1]); w.y = cvt_pk_bf16(f[2] * rs * g0[2], f[3] * rs * g0[3]);
                w.z = cvt_pk_bf16(f[4] * rs * g1[0], f[5] * rs * g1[1]); w.w = cvt_pk_bf16(f[6] * rs * g1[2], f[7] * rs * g1[3]);
                *(LAS u32x4*)(KL + key * 272 + ch * 16) = w;
            }
#pragma unroll
            for (int p = 0; p < 2; ++p) {
                const int key = lane, ch = wave + 8 * p;
                const u32x4 vr = vreg[p];
                LAS unsigned short* vt = (LAS unsigned short*)(VT + (8 * ch) * 144 + key * 2);
                vt[0 * 72] = (unsigned short)(vr.x & 0xffffu); vt[1 * 72] = (unsigned short)(vr.x >> 16);
                vt[2 * 72] = (unsigned short)(vr.y & 0xffffu); vt[3 * 72] = (unsigned short)(vr.y >> 16);
                vt[4 * 72] = (unsigned short)(vr.z & 0xffffu); vt[5 * 72] = (unsigned short)(vr.z >> 16);
                vt[6 * 72] = (unsigned short)(vr.w & 0xffffu); vt[7 * 72] = (unsigned short)(vr.w >> 16);
            }
            if (kt > 0) { const int k0n = k0 - 64;
#pragma unroll
                for (int p = 0; p < 2; ++p) { const int ci = tid + 512 * p, key = ci >> 4, ch = ci & 15;
                    kreg[p] = *(const u32x4*)(PA + (size_t)(b * SEQ + k0n + key) * 4096 + 2048 + h * 128 + 8 * ch);
                    vreg[p] = *(const u32x4*)(PA + (size_t)(b * SEQ + k0n + lane) * 4096 + 3072 + h * 128 + 8 * (wave + 8 * p)); } }
            __syncthreads();
            if (MODE == 1) { if (kt <= 2 * qb - 3) wdone = 1; }
            if (MODE == 0 && !wdone && k0 < tq0 + 15) {
                f32x4 zt[4];
#pragma unroll
                for (int f = 0; f < 4; ++f) { f32x4 acc = {0.f, 0.f, 0.f, 0.f};
#pragma unroll
                    for (int kk = 0; kk < 4; ++kk) { const bf16x8 kf = *(const LAS bf16x8*)(KL + (16 * f + c) * 272 + (32 * kk + 8 * g) * 2);
                        acc = __builtin_amdgcn_mfma_f32_16x16x32_bf16(kf, qf[kk], acc, 0, 0, 0); }
                    zt[f] = acc; }
                float lf[4][4], lz[4][4]; float tot = 0.f;
                if (k0 + 63 >= tq0) {
#pragma unroll
                    for (int f = 0; f < 4; ++f)
#pragma unroll
                        for (int i = 0; i < 4; ++i) { const int s = k0 + 16 * f + 4 * g + i; const bool valid = s < tq; const float z = zt[f][i];
                            const float sp = fmaxf(z, 0.f) + __builtin_amdgcn_logf(1.0f + __builtin_amdgcn_exp2f(-fabsf(z)));
                            const float l = valid ? -sp : 0.f; lf[f][i] = l; lz[f][i] = valid ? (l + z) : -INFINITY; tot += l; }
                } else {
#pragma unroll
                    for (int f = 0; f < 4; ++f)
#pragma unroll
                        for (int i = 0; i < 4; ++i) { const float z = zt[f][i];
                            const float l = -(fmaxf(z, 0.f) + __builtin_amdgcn_logf(1.0f + __builtin_amdgcn_exp2f(-fabsf(z)))); lf[f][i] = l; lz[f][i] = l + z; tot += l; }
                }
                tot += __shfl_xor(tot, 16); tot += __shfl_xor(tot, 32);
                bf16x8 lh[2];
#pragma unroll
                for (int fp = 0; fp < 2; ++fp) { u32x4 wh;
#pragma unroll
                    for (int q = 0; q < 2; ++q) { const int f = 2 * fp + q; wh[2 * q] = cvt_pk_bf16(lf[f][0], lf[f][1]); wh[2 * q + 1] = cvt_pk_bf16(lf[f][2], lf[f][3]); }
                    lh[fp] = __builtin_bit_cast(bf16x8, wh); }
                f32x4 sf[4];
                { f32x4 z4 = {0.f, 0.f, 0.f, 0.f};
                  sf[0] = __builtin_amdgcn_mfma_f32_16x16x32_bf16(tri[0], lh[0], z4, 0, 0, 0); sf[0] = __builtin_amdgcn_mfma_f32_16x16x32_bf16(tri[2], lh[1], sf[0], 0, 0, 0);
                  sf[1] = __builtin_amdgcn_mfma_f32_16x16x32_bf16(tri[1], lh[0], z4, 0, 0, 0); sf[1] = __builtin_amdgcn_mfma_f32_16x16x32_bf16(tri[3], lh[1], sf[1], 0, 0, 0);
                  sf[2] = __builtin_amdgcn_mfma_f32_16x16x32_bf16(tri[4], lh[1], z4, 0, 0, 0);
                  sf[3] = __builtin_amdgcn_mfma_f32_16x16x32_bf16(tri[5], lh[1], z4, 0, 0, 0); }
                bf16x8 pb[2];
#pragma unroll
                for (int fp = 0; fp < 2; ++fp) { u32x4 w;
#pragma unroll
                    for (int q = 0; q < 2; ++q) { const int f = 2 * fp + q; float p[4];
#pragma unroll
                        for (int i = 0; i < 4; ++i) p[i] = __builtin_amdgcn_exp2f(lz[f][i] + sf[f][i] + carry);
                        w[2 * q] = cvt_pk_bf16(p[0], p[1]); w[2 * q + 1] = cvt_pk_bf16(p[2], p[3]); }
                    pb[fp] = __builtin_bit_cast(bf16x8, w); }
                carry += tot;
#pragma unroll
                for (int fd = 0; fd < 8; ++fd)
#pragma unroll
                    for (int fp = 0; fp < 2; ++fp) { const LAS unsigned char* vp = VT + (16 * fd + c) * 144 + (32 * fp + 4 * g) * 2;
                        const u32x2 v0 = *(const LAS u32x2*)vp, v1 = *(const LAS u32x2*)(vp + 32);
                        u32x4 vw; vw.x = v0.x; vw.y = v0.y; vw.z = v1.x; vw.w = v1.y;
                        oacc[fd] = __builtin_amdgcn_mfma_f32_16x16x32_bf16(__builtin_bit_cast(bf16x8, vw), pb[fp], oacc[fd], 0, 0, 0); }
                wdone = (__ballot(carry >= -152.0f) == 0ull) ? 1 : 0;
            }
        }
        if (MODE == 0) { unsigned char* orow = (unsigned char*)ATT + (size_t)(b * SEQ + tq) * 1024 + h * 128 + 4 * g;
#pragma unroll
          for (int fd = 0; fd < 8; ++fd) *(unsigned*)(orow + 16 * fd) = pack4_fp8(oacc[fd][0], oacc[fd][1], oacc[fd][2], oacc[fd][3], F8_SA); }
    }
    __syncthreads();
}

__device__ __forceinline__ void ssm_lambda(const Args& a, int g, int st, float& lbr, float& lbi, float& qr, float& qi) {
    const float lr = a.in[I_LRE][g * 64 + st], li = a.in[I_LIM][g * 64 + st], dt = __expf(a.in[I_LDT][g]);
    const float mag = __expf(lr * dt);
    float rev = li * dt * 0.15915494309189535f; rev -= rintf(rev);
    lbr = mag * __builtin_amdgcn_cosf(rev); lbi = mag * __builtin_amdgcn_sinf(rev);
    const float nr = lbr - 1.0f, ni = lbi, den = 1.0f / (lr * lr + li * li);
    qr = (nr * lr + ni * li) * den; qi = (ni * lr - nr * li) * den;
}
template <bool WITH_Y>
__device__ __forceinline__ void ph_ssm_mfma(const Args& a, LAS unsigned char* lds, const bf16_t* UB, f32x2* E, bf16_t* YA, int G) {
    const int tid = opaque_tid(), lane = tid & 63, wave = __builtin_amdgcn_readfirstlane(tid >> 6), c = lane & 15, gl = lane >> 4;
    LAS f32x2* sl = (LAS f32x2*)(lds + wave * 8192);
    LAS f32x4* tab = (LAS f32x4*)(lds + 65536 + wave * 1024);
    LAS u32x4* cml = (LAS u32x4*)(lds + 73728 + wave * 5120) + lane;
    for (int item = blockIdx.x; item < 128; item += G) {
        const int b = item >> 6, cb = (item >> 3) & 7, g = (item & 7) * 8 + wave, c0 = cb * 16;
        float mur, mui;
        { float lbr, lbi, qr, qi; ssm_lambda(a, g, lane, lbr, lbi, qr, qi); tab[lane] = (f32x4){lbr, lbi, qr, qi}; mur = lbr; mui = lbi; }
        LDS_WAIT();
        bf16x8 bm[8];
        const float* brb = a.in[I_BRE] + (g * 64 + (c >> 1)) * 16 + 8 * (gl & 1); const float* bib = a.in[I_BIM] + (g * 64 + (c >> 1)) * 16 + 8 * (gl & 1);
        const LAS f32x4* tabb = tab + (c >> 1);
#pragma unroll
        for (int f = 0; f < 8; ++f) { const f32x4 tv = tabb[8 * f]; const float qr = tv[2], qi = tv[3];
            const float* br = brb + 128 * f; const float* bim = bib + 128 * f;
            const f32x4 r0 = *(const f32x4*)br, r1 = *(const f32x4*)(br + 4), i0 = *(const f32x4*)bim, i1 = *(const f32x4*)(bim + 4);
            float v[8];
#pragma unroll
            for (int e = 0; e < 4; ++e) { const float vr0 = qr * r0[e] - qi * i0[e], vi0 = qr * i0[e] + qi * r0[e], vr1 = qr * r1[e] - qi * i1[e], vi1 = qr * i1[e] + qi * r1[e];
                v[e] = (c & 1) ? vi0 : vr0; v[4 + e] = (c & 1) ? vi1 : vr1; }
            if (gl >= 2) {
#pragma unroll
                for (int e = 0; e < 8; ++e) v[e] = 0.f; }
            u32x4 w; w.x = cvt_pk_bf16(v[0], v[1]); w.y = cvt_pk_bf16(v[2], v[3]); w.z = cvt_pk_bf16(v[4], v[5]); w.w = cvt_pk_bf16(v[6], v[7]);
            bm[f] = __builtin_bit_cast(bf16x8, w); }
        float lmr[16], lmi[16];
#pragma unroll
        for (int k = 0; k < 16; ++k) { const f32x4 tv = tab[2 * gl + 8 * (k >> 1) + (k & 1)]; lmr[k] = tv[0]; lmi[k] = tv[1]; }
        if (WITH_Y) {
            const float* crb = a.in[I_CRE] + (g * 16 + c) * 64 + 2 * gl; const float* cib = a.in[I_CIM] + (g * 16 + c) * 64 + 2 * gl;
#pragma unroll
            for (int kk = 0; kk < 4; ++kk) { float v[8];
#pragma unroll
                for (int jh = 0; jh < 2; ++jh) { const f32x2 r = *(const f32x2*)(crb + 8 * (2 * kk + jh)), m = *(const f32x2*)(cib + 8 * (2 * kk + jh));
                    v[4 * jh] = r.x; v[4 * jh + 1] = -m.x; v[4 * jh + 2] = r.y; v[4 * jh + 3] = -m.y; }
                u32x4 w; w.x = cvt_pk_bf16(v[0], v[1]); w.y = cvt_pk_bf16(v[2], v[3]); w.z = cvt_pk_bf16(v[4], v[5]); w.w = cvt_pk_bf16(v[6], v[7]);
                cml[64 * kk] = w; }
            { const float dv = a.in[I_SD][g * 16 + c]; float v[8];
#pragma unroll
              for (int jj = 0; jj < 8; ++jj) v[jj] = (gl < 2 && (8 * gl + jj) == c) ? dv : 0.f;
              u32x4 w; w.x = cvt_pk_bf16(v[0], v[1]); w.y = cvt_pk_bf16(v[2], v[3]); w.z = cvt_pk_bf16(v[4], v[5]); w.w = cvt_pk_bf16(v[6], v[7]);
              cml[256] = w; }
        }
        f32x4 s[8];
#pragma unroll
        for (int f = 0; f < 8; ++f) s[f] = (f32x4){0.f, 0.f, 0.f, 0.f};
        if (WITH_Y) {
            float pr = mur, pi = mui;
#pragma unroll
            for (int q = 0; q < 6; ++q) { const float nr = pr * pr - pi * pi, ni = 2.0f * pr * pi; pr = nr; pi = ni; }
            float sr = 0.f, si = 0.f;
            const f32x2* ep = E + (size_t)((b * 64 + g) * 128) * 64 + lane;
            f32x2 ev[8], en[8];
#pragma unroll
            for (int k = 0; k < 8; ++k) ev[k] = ep[(size_t)k * 64];
            for (int cc = 0; cc < c0 + 16; cc += 8) {
                if (cc + 8 < c0 + 16) {
#pragma unroll
                    for (int k = 0; k < 8; ++k) en[k] = ep[(size_t)(cc + 8 + k) * 64]; }
#pragma unroll
                for (int k = 0; k < 8; ++k) { if (cc >= c0) sl[(cc - c0 + k) * 64 + lane] = (f32x2){sr, si};
                    const float nr = pr * sr - pi * si + ev[k][0], ni = pr * si + pi * sr + ev[k][1]; sr = nr; si = ni; }
#pragma unroll
                for (int k = 0; k < 8; ++k) ev[k] = en[k];
            }
            LDS_WAIT();
#pragma unroll
            for (int f = 0; f < 8; ++f) s[f] = *(const LAS f32x4*)(sl + c * 64 + 8 * f + 2 * gl);
            LDS_WAIT();
        }
        const bf16_t* up = UB + ((size_t)(b * 64 + g) * 8192 + (size_t)(c0 + c) * 64) * 16 + 8 * (gl & 1);
        unsigned char* yp = (unsigned char*)YA + (size_t)(b * SEQ + (c0 + c) * 64) * 1024 + g * 16 + 4 * gl;
        u32x4 u0 = *(const u32x4*)(up), u1 = *(const u32x4*)(up + 16), u2 = *(const u32x4*)(up + 32), u3 = *(const u32x4*)(up + 48);
#pragma unroll 1
        for (int tau = 0; tau < 64; ++tau) {
            const u32x4 u4 = *(const u32x4*)(up + (size_t)(tau + 4) * 16);
            const bf16x8 uf = __builtin_bit_cast(bf16x8, u0);
#pragma unroll
            for (int f = 0; f < 8; ++f) { f32x4 ci;
                ci[0] = lmr[2 * f] * s[f][0] - lmi[2 * f] * s[f][1]; ci[1] = lmr[2 * f] * s[f][1] + lmi[2 * f] * s[f][0];
                ci[2] = lmr[2 * f + 1] * s[f][2] - lmi[2 * f + 1] * s[f][3]; ci[3] = lmr[2 * f + 1] * s[f][3] + lmi[2 * f + 1] * s[f][2];
                s[f] = __builtin_amdgcn_mfma_f32_16x16x32_bf16(bm[f], uf, ci, 0, 0, 0); }
            if (WITH_Y) {
                f32x4 y = __builtin_amdgcn_mfma_f32_16x16x32_bf16(__builtin_bit_cast(bf16x8, cml[256]), uf, (f32x4){0.f, 0.f, 0.f, 0.f}, 0, 0, 0);
#pragma unroll
                for (int kk = 0; kk < 4; ++kk) { u32x4 w; w.x = cvt_pk_bf16(s[2 * kk][0], s[2 * kk][1]); w.y = cvt_pk_bf16(s[2 * kk][2], s[2 * kk][3]);
                    w.z = cvt_pk_bf16(s[2 * kk + 1][0], s[2 * kk + 1][1]); w.w = cvt_pk_bf16(s[2 * kk + 1][2], s[2 * kk + 1][3]);
                    y = __builtin_amdgcn_mfma_f32_16x16x32_bf16(__builtin_bit_cast(bf16x8, cml[64 * kk]), __builtin_bit_cast(bf16x8, w), y, 0, 0, 0); }
                *(unsigned*)(yp + (size_t)tau * 1024) = pack4_fp8(gelu_tanh(y[0]), gelu_tanh(y[1]), gelu_tanh(y[2]), gelu_tanh(y[3]), F8_SA);
            }
            u0 = u1; u1 = u2; u2 = u3; u3 = u4;
        }
        if (!WITH_Y) { f32x2* eo = E + (size_t)((b * 64 + g) * 128 + c0 + c) * 64 + 2 * gl;
#pragma unroll
            for (int f = 0; f < 8; ++f) *(f32x4*)(eo + 8 * f) = s[f]; }
    }
}

typedef float f32x16 __attribute__((ext_vector_type(16)));
typedef float f32x32 __attribute__((ext_vector_type(32)));
typedef unsigned u32x6 __attribute__((ext_vector_type(6)));
constexpr float PEER_SU = 64.0f, PEER_SV = 1.4f;
constexpr size_t PEER_SHARD_BYTES = (size_t)16384 * 192;
__device__ __forceinline__ void table_cvt_pack(const f32x4 (&v)[8], float sc, unsigned char* dst, int lane) {
    f32x16 a, b;
#pragma unroll
    for (int q = 0; q < 4; ++q) {
#pragma unroll
        for (int e = 0; e < 4; ++e) { a[4 * q + e] = v[q][e] * sc; b[4 * q + e] = v[4 + q][e] * sc; } }
    const u32x6 p = __builtin_amdgcn_cvt_scalef32_2xpk16_fp6_f32(a, b, 1.0f);
    *(u32x4*)(dst + 16 * (lane & 7)) = (u32x4){p[0], p[1], p[2], p[3]};
    *(u32x2*)(dst + 128 + 8 * (lane & 7)) = (u32x2){p[4], p[5]};
}
__device__ __forceinline__ void ph_table_cvt(const float* __restrict__ U, const float* __restrict__ V, unsigned char* UT, unsigned char* VT, int r0, int r1, int gw, int ngw, int lane) {
    for (int r = r0 + gw; r < r1; r += ngw) {
        const float* su = U + (size_t)r * 2048 + 32 * lane; const float* sv = V + (size_t)r * 2048 + 32 * lane;
        f32x4 vu[8], vv[8];
#pragma unroll
        for (int q = 0; q < 8; ++q) vu[q] = *(const f32x4*)(su + 4 * q);
#pragma unroll
        for (int q = 0; q < 8; ++q) vv[q] = *(const f32x4*)(sv + 4 * q);
        const size_t off = (size_t)(lane >> 3) * PEER_SHARD_BYTES + (size_t)r * 192;
        table_cvt_pack(vu, PEER_SU, UT + off, lane);
        table_cvt_pack(vv, PEER_SV, VT + off, lane);
    }
}

#define TK_CE(a_, b_) do { const float _h = fmaxf(a_, b_), _l = fminf(a_, b_); a_ = _h; b_ = _l; } while (0)
__device__ __forceinline__ void tk_sort16(float (&a)[16]) {
#pragma unroll
    for (int p = 1; p < 16; p *= 2)
#pragma unroll
        for (int k = p; k >= 1; k /= 2)
#pragma unroll
            for (int j = k % p; j <= 15 - k; j += 2 * k)
#pragma unroll
                for (int i = 0; i < k; ++i)
                    if (i + j + k <= 15 && (i + j) / (2 * p) == (i + j + k) / (2 * p)) TK_CE(a[i + j], a[i + j + k]);
}
__device__ __forceinline__ void tk_merge16(float (&t)[16], const float (&g)[16]) {
#pragma unroll
    for (int i = 0; i < 16; ++i) t[i] = fmaxf(t[i], g[15 - i]);
#pragma unroll
    for (int k = 8; k >= 1; k /= 2)
#pragma unroll
        for (int i = 0; i < 16; ++i)
            if ((i & k) == 0) TK_CE(t[i], t[i + k]);
}
__device__ __forceinline__ float tk2_key(float a, float b, int flat) {
    const float sum = __uint_as_float(__float_as_uint(a) & ~127u) + __uint_as_float(__float_as_uint(b) & ~127u);
    return __uint_as_float((__float_as_uint(sum) & ~255u) | (unsigned)(255 - flat)); }
__device__ __forceinline__ void ph_peer_topk(LAS unsigned char* lds, const float* SC, int* idxG, float* gateG, int G) {
    const int tid = opaque_tid(), lane = tid & 63, wave = __builtin_amdgcn_readfirstlane(tid >> 6);
    LAS float* scr = (LAS float*)(lds + wave * 8448);
    for (int it = blockIdx.x; it < 512; it += G) {
        const int tokw = it * 32 + wave * 4;
        float tk[16];
#pragma unroll
        for (int i = 0; i < 16; ++i) tk[i] = -INFINITY;
        f32x4 nv[8];
#pragma unroll
        for (int j = 0; j < 8; ++j) { const int prob = (lane >> 3) + 8 * j, seg = lane & 7; nv[j] = *(const f32x4*)(SC + (size_t)(tokw + (prob >> 4)) * 2048 + (prob & 15) * 128 + 4 * seg); }
        for (int q = 0; q < 4; ++q) {
#pragma unroll
            for (int j = 0; j < 8; ++j) { const int prob = (lane >> 3) + 8 * j, seg = lane & 7; const f32x4 v = nv[j];
                LAS float* d = scr + prob * 33 + 4 * seg; d[0] = v[0]; d[1] = v[1]; d[2] = v[2]; d[3] = v[3]; }
            { const int qn = q < 3 ? q + 1 : 3;
#pragma unroll
              for (int j = 0; j < 8; ++j) { const int prob = (lane >> 3) + 8 * j, seg = lane & 7; nv[j] = *(const f32x4*)(SC + (size_t)(tokw + (prob >> 4)) * 2048 + (prob & 15) * 128 + 32 * qn + 4 * seg); } }
            LDS_WAIT();
#pragma unroll
            for (int hh = 0; hh < 2; ++hh) { float g[16];
#pragma unroll
                for (int i = 0; i < 16; ++i) g[i] = __uint_as_float((__float_as_uint(scr[lane * 33 + 16 * hh + i]) & ~127u) | (unsigned)(127 - (32 * q + 16 * hh + i)));
                tk_sort16(g); tk_merge16(tk, g); }
            LDS_WAIT();
        }
        float t2[16];
#pragma unroll
        for (int i = 0; i < 16; ++i) t2[i] = __shfl_xor(tk[i], 1);
        float bv[16];
        {
          bv[0] = tk2_key(tk[0], t2[0], 0);
          bv[1] = tk2_key(tk[0], t2[1], 1);
          bv[2] = tk2_key(tk[0], t2[2], 2);
          bv[3] = tk2_key(tk[0], t2[3], 3);
          bv[4] = tk2_key(tk[0], t2[4], 4);
          bv[5] = tk2_key(tk[0], t2[5], 5);
          bv[6] = tk2_key(tk[0], t2[6], 6);
          bv[7] = tk2_key(tk[0], t2[7], 7);
          bv[8] = tk2_key(tk[0], t2[8], 8);
          bv[9] = tk2_key(tk[0], t2[9], 9);
          bv[10] = tk2_key(tk[0], t2[10], 10);
          bv[11] = tk2_key(tk[0], t2[11], 11);
          bv[12] = tk2_key(tk[0], t2[12], 12);
          bv[13] = tk2_key(tk[0], t2[13], 13);
          bv[14] = tk2_key(tk[0], t2[14], 14);
          bv[15] = tk2_key(tk[0], t2[15], 15);
          tk_sort16(bv);
          { float g[16];
          g[0] = tk2_key(tk[1], t2[0], 16);
          g[1] = tk2_key(tk[1], t2[1], 17);
          g[2] = tk2_key(tk[1], t2[2], 18);
          g[3] = tk2_key(tk[1], t2[3], 19);
          g[4] = tk2_key(tk[1], t2[4], 20);
          g[5] = tk2_key(tk[1], t2[5], 21);
          g[6] = tk2_key(tk[1], t2[6], 22);
          g[7] = tk2_key(tk[1], t2[7], 23);
          g[8] = tk2_key(tk[2], t2[0], 32);
          g[9] = tk2_key(tk[2], t2[1], 33);
          g[10] = tk2_key(tk[2], t2[2], 34);
          g[11] = tk2_key(tk[2], t2[3], 35);
          g[12] = tk2_key(tk[2], t2[4], 36);
          g[13] = tk2_key(tk[3], t2[0], 48);
          g[14] = tk2_key(tk[3], t2[1], 49);
          g[15] = tk2_key(tk[3], t2[2], 50);
          tk_sort16(g); tk_merge16(bv, g); }
          { float g[16];
          g[0] = tk2_key(tk[3], t2[3], 51);
          g[1] = tk2_key(tk[4], t2[0], 64);
          g[2] = tk2_key(tk[4], t2[1], 65);
          g[3] = tk2_key(tk[4], t2[2], 66);
          g[4] = tk2_key(tk[5], t2[0], 80);
          g[5] = tk2_key(tk[5], t2[1], 81);
          g[6] = tk2_key(tk[6], t2[0], 96);
          g[7] = tk2_key(tk[6], t2[1], 97);
          g[8] = tk2_key(tk[7], t2[0], 112);
          g[9] = tk2_key(tk[7], t2[1], 113);
          g[10] = tk2_key(tk[8], t2[0], 128);
          g[11] = tk2_key(tk[9], t2[0], 144);
          g[12] = tk2_key(tk[10], t2[0], 160);
          g[13] = tk2_key(tk[11], t2[0], 176);
          g[14] = tk2_key(tk[12], t2[0], 192);
          g[15] = tk2_key(tk[13], t2[0], 208);
          tk_sort16(g); tk_merge16(bv, g); }
          { float x = tk2_key(tk[14], t2[0], 224);
#pragma unroll
            for (int i = 0; i < 16; ++i) { const float hi = fmaxf(bv[i], x); x = fminf(bv[i], x); bv[i] = hi; } }
          { float x = tk2_key(tk[15], t2[0], 240);
#pragma unroll
            for (int i = 0; i < 16; ++i) { const float hi = fmaxf(bv[i], x); x = fminf(bv[i], x); bv[i] = hi; } }
        }
        unsigned p1[4], p2[4];
#pragma unroll
        for (int j = 0; j < 4; ++j) { p1[j] = 0u; p2[j] = 0u;
#pragma unroll
            for (int e = 0; e < 4; ++e) { p1[j] |= (127u - (__float_as_uint(tk[4 * j + e]) & 127u)) << (8 * e); p2[j] |= (127u - (__float_as_uint(t2[4 * j + e]) & 127u)) << (8 * e); } }
        { float e[16], sum = 0.f; unsigned ex[16];
          const float top = __uint_as_float(__float_as_uint(bv[0]) & ~255u);
#pragma unroll
          for (int i = 0; i < 16; ++i) { const unsigned bits = __float_as_uint(bv[i]); const unsigned flat = 255u - (bits & 255u), aa = flat >> 4, bb = flat & 15u;
              const unsigned w1 = (aa >> 2) == 0u ? p1[0] : (aa >> 2) == 1u ? p1[1] : (aa >> 2) == 2u ? p1[2] : p1[3];
              const unsigned w2 = (bb >> 2) == 0u ? p2[0] : (bb >> 2) == 1u ? p2[1] : (bb >> 2) == 2u ? p2[2] : p2[3];
              ex[i] = (((w1 >> (8u * (aa & 3u))) & 127u) << 7) | ((w2 >> (8u * (bb & 3u))) & 127u);
              e[i] = __expf(__uint_as_float(bits & ~255u) - top); sum += e[i]; }
          const float inv = 1.0f / sum;
          if ((lane & 1) == 0) { const int tl = lane >> 4, head = (lane & 15) >> 1; const size_t o = (size_t)(tokw + tl) * 128 + 64 * (head >> 2);
#pragma unroll
              for (int i = 0; i < 16; ++i) { const int p = 8 * (i & 7) + ((2 * head + (i >> 3)) & 7); idxG[o + p] = (int)ex[i]; gateG[o + p] = e[i] * inv; } } }
    }
}

#define PEER_ROWS(b4_, b2_, i8_) do { _Pragma("unroll") for (int gq = 0; gq < 8; ++gq) { const unsigned ro = (unsigned)(i8_)[gq] * 192u; \
        b4_[gq] = *(const u32x4*)(tab + (ro + 16u * (unsigned)c)); b2_[gq] = *(const u32x2*)(tab + (ro + 128u + 8u * (unsigned)c)); } } while (0)
#define PEER_LD8(dst_, p_) do { const u32x4 _a = *(const u32x4*)(p_), _b = *(const u32x4*)((p_) + 4); dst_[0] = (int)_a.x; dst_[1] = (int)_a.y; dst_[2] = (int)_a.z; dst_[3] = (int)_a.w; \
        dst_[4] = (int)_b.x; dst_[5] = (int)_b.y; dst_[6] = (int)_b.z; dst_[7] = (int)_b.w; } while (0)
__device__ __forceinline__ void ph_peer_u(const unsigned char* UT, const bf16_t* H2, const int* idxG, float* pdot, int G) {
    const int tid = opaque_tid(), lane = tid & 63, wave = __builtin_amdgcn_readfirstlane(tid >> 6), r = lane >> 3, c = lane & 7;
    const int shard = blockIdx.x & 7, ws = (blockIdx.x >> 3) * 8 + wave, nws = (G >> 3) * 8;
    const unsigned char* tab = UT + (size_t)shard * PEER_SHARD_BYTES;
    const bf16_t* hbase = H2 + 256 * shard + 32 * c;
    const int* ibase = idxG + 8 * r;
#define PEER_TOK(t_) (((t_) < T_TOK) ? (t_) : (T_TOK - 1))
    int ci[2][8], ni[2][8]; u32x4 cw[4], nw[4];
    { const int t0 = PEER_TOK(ws), t1 = PEER_TOK(ws + nws);
      PEER_LD8(ci[0], ibase + (size_t)t0 * 128); PEER_LD8(ci[1], ibase + (size_t)t0 * 128 + 64); PEER_LD8(ni[0], ibase + (size_t)t1 * 128); PEER_LD8(ni[1], ibase + (size_t)t1 * 128 + 64);
#pragma unroll
      for (int q = 0; q < 4; ++q) cw[q] = *(const u32x4*)(hbase + (size_t)t0 * 2048 + 8 * q); }
    u32x4 a4[8], b4[8]; u32x2 a2[8], b2[8];
    PEER_ROWS(a4, a2, ci[0]);
    for (int t = ws; t < T_TOK; t += nws) {
        PEER_ROWS(b4, b2, ci[1]);
        { const int t1 = PEER_TOK(t + nws);
#pragma unroll
          for (int q = 0; q < 4; ++q) nw[q] = *(const u32x4*)(hbase + (size_t)t1 * 2048 + 8 * q); }
        f32x2 ha[16];
        { const u32x4 w0 = cw[0], w1 = cw[1], w2 = cw[2], w3 = cw[3];
          ha[0] = (f32x2){bf_lo(w0.x), bf_lo(w2.x)}; ha[1] = (f32x2){bf_hi(w0.x), bf_hi(w2.x)}; ha[2] = (f32x2){bf_lo(w0.y), bf_lo(w2.y)}; ha[3] = (f32x2){bf_hi(w0.y), bf_hi(w2.y)};
          ha[4] = (f32x2){bf_lo(w0.z), bf_lo(w2.z)}; ha[5] = (f32x2){bf_hi(w0.z), bf_hi(w2.z)}; ha[6] = (f32x2){bf_lo(w0.w), bf_lo(w2.w)}; ha[7] = (f32x2){bf_hi(w0.w), bf_hi(w2.w)};
          ha[8] = (f32x2){bf_lo(w1.x), bf_lo(w3.x)}; ha[9] = (f32x2){bf_hi(w1.x), bf_hi(w3.x)}; ha[10] = (f32x2){bf_lo(w1.y), bf_lo(w3.y)}; ha[11] = (f32x2){bf_hi(w1.y), bf_hi(w3.y)};
          ha[12] = (f32x2){bf_lo(w1.z), bf_lo(w3.z)}; ha[13] = (f32x2){bf_hi(w1.z), bf_hi(w3.z)}; ha[14] = (f32x2){bf_lo(w1.w), bf_lo(w3.w)}; ha[15] = (f32x2){bf_hi(w1.w), bf_hi(w3.w)}; }
        float* po = pdot + ((size_t)shard * T_TOK + t) * 128 + lane;
#define PEER_UDOT(b4_, b2_, half_) do { float mine = 0.f; \
            _Pragma("unroll") for (int gq = 0; gq < 8; ++gq) { const u32x6 p6 = {b4_[gq].x, b4_[gq].y, b4_[gq].z, b4_[gq].w, b2_[gq].x, b2_[gq].y}; \
                const f32x32 uv = __builtin_amdgcn_cvt_scalef32_pk32_f32_fp6(p6, 1.0f); f32x2 s = {0.f, 0.f}; \
                _Pragma("unroll") for (int k = 0; k < 16; ++k) s = (f32x2){uv[2 * k], uv[2 * k + 1]} * ha[k] + s; \
                const float d = sum8_dpp(s.x + s.y); \
                mine = (gq == c) ? d : mine; __builtin_amdgcn_sched_barrier(0); } \
            po[64 * (half_)] = mine; } while (0)
        PEER_UDOT(a4, a2, 0);
        PEER_ROWS(a4, a2, ni[0]);
#pragma unroll
        for (int q = 0; q < 8; ++q) { ci[0][q] = ni[0][q]; ci[1][q] = ni[1][q]; }
        { const int t2 = PEER_TOK(t + 2 * nws); PEER_LD8(ni[0], ibase + (size_t)t2 * 128); PEER_LD8(ni[1], ibase + (size_t)t2 * 128 + 64); }
        PEER_UDOT(b4, b2, 1);
#pragma unroll
        for (int q = 0; q < 4; ++q) cw[q] = nw[q];
    }
#undef PEER_UDOT
}
__device__ __forceinline__ void ph_peer_act(const float* pdot, const float* gateG, float* actG, int G) {
    const size_t n = (size_t)T_TOK * 128, stride = (size_t)G * 512;
    for (size_t i = (size_t)blockIdx.x * 512 + threadIdx.x; i < n; i += stride) {
        float d = 0.f;
#pragma unroll
        for (int x = 0; x < 8; ++x) d += pdot[(size_t)x * n + i];
        actG[i] = gateG[i] * gelu_tanh(d * (1.0f / PEER_SU)) * (1.0f / PEER_SV);
    }
}
template <bool DRY>
__device__ __forceinline__ void ph_peer_v(LAS unsigned char* lds, const unsigned char* VT, const int* idxG, const float* actG, const float* mod, float* OUT, int G) {
    const int tid = opaque_tid(), lane = tid & 63, wave = __builtin_amdgcn_readfirstlane(tid >> 6), r = lane >> 3, c = lane & 7;
    const int shard = blockIdx.x & 7, ws = (blockIdx.x >> 3) * 8 + wave, nws = (G >> 3) * 8;
    const unsigned char* tab = VT + (size_t)shard * PEER_SHARD_BYTES;
    LAS float* red = (LAS float*)(lds + wave * 9216);
    const int* ibase = idxG + 8 * r; const int* abase = (const int*)actG + 8 * r;
    int ci[2][8], ni[2][8], ca[2][8], na[2][8]; f32x4 cx, nx;
    { const int t0 = PEER_TOK(ws), t1 = PEER_TOK(ws + nws);
      PEER_LD8(ci[0], ibase + (size_t)t0 * 128); PEER_LD8(ci[1], ibase + (size_t)t0 * 128 + 64); PEER_LD8(ni[0], ibase + (size_t)t1 * 128); PEER_LD8(ni[1], ibase + (size_t)t1 * 128 + 64);
      PEER_LD8(ca[0], abase + (size_t)t0 * 128); PEER_LD8(ca[1], abase + (size_t)t0 * 128 + 64);
      cx = *(const f32x4*)(OUT + (size_t)t0 * 2048 + 256 * shard + 4 * lane); }
    u32x4 a4[8], b4[8]; u32x2 a2[8], b2[8];
    PEER_ROWS(a4, a2, ci[0]);
    for (int t = ws; t < T_TOK; t += nws) {
        PEER_ROWS(b4, b2, ci[1]);
        { const int t1 = PEER_TOK(t + nws);
          PEER_LD8(na[0], abase + (size_t)t1 * 128); PEER_LD8(na[1], abase + (size_t)t1 * 128 + 64); nx = *(const f32x4*)(OUT + (size_t)t1 * 2048 + 256 * shard + 4 * lane); }
        f32x2 acc[16];
#pragma unroll
        for (int k = 0; k < 16; ++k) acc[k] = (f32x2){0.f, 0.f};
#define PEER_VACC(b4_, b2_, a8_) do { _Pragma("unroll") for (int gq = 0; gq < 8; ++gq) { const float ar = __int_as_float((a8_)[gq]); const f32x2 av2 = {ar, ar}; \
            const u32x6 p6 = {b4_[gq].x, b4_[gq].y, b4_[gq].z, b4_[gq].w, b2_[gq].x, b2_[gq].y}; const f32x32 vv = __builtin_amdgcn_cvt_scalef32_pk32_f32_fp6(p6, 1.0f); \
            _Pragma("unroll") for (int k = 0; k < 16; ++k) acc[k] = (f32x2){vv[2 * k], vv[2 * k + 1]} * av2 + acc[k]; __builtin_amdgcn_sched_barrier(0); } } while (0)
        PEER_VACC(a4, a2, ca[0]);
        PEER_ROWS(a4, a2, ni[0]);
#pragma unroll
        for (int q = 0; q < 8; ++q) { ci[0][q] = ni[0][q]; ci[1][q] = ni[1][q]; }
        { const int t2 = PEER_TOK(t + 2 * nws); PEER_LD8(ni[0], ibase + (size_t)t2 * 128); PEER_LD8(ni[1], ibase + (size_t)t2 * 128 + 64); }
        PEER_VACC(b4, b2, ca[1]);
        { LAS float* w = red + (r * 8 + c) * 36;
#pragma unroll
          for (int q = 0; q < 4; ++q) { *(LAS f32x4*)(w + 4 * q) = (f32x4){acc[4 * q].x, acc[4 * q + 1].x, acc[4 * q + 2].x, acc[4 * q + 3].x};
              *(LAS f32x4*)(w + 16 + 4 * q) = (f32x4){acc[4 * q].y, acc[4 * q + 1].y, acc[4 * q + 2].y, acc[4 * q + 3].y}; } }
        LDS_WAIT();
        { f32x4 s = {0.f, 0.f, 0.f, 0.f}; const LAS float* rd = red + (lane >> 3) * 36 + 4 * (lane & 7);
#pragma unroll
          for (int rr = 0; rr < 8; ++rr) s += *(const LAS f32x4*)(rd + rr * 288);
          const int b = t >> 13; const float* gt2 = mod + (size_t)b * 12288 + 10240 + 256 * shard + 4 * lane; float* op = OUT + (size_t)t * 2048 + 256 * shard + 4 * lane;
          const f32x4 g0 = *(const f32x4*)gt2;
          if (!DRY) *(f32x4*)op = cx + g0 * s; else asm volatile("" :: "v"(s), "v"(g0)); }
        LDS_WAIT();
#pragma unroll
        for (int q = 0; q < 8; ++q) { ca[0][q] = na[0][q]; ca[1][q] = na[1][q]; }
        cx = nx;
    }
#undef PEER_VACC
}
#undef PEER_ROWS
#undef PEER_LD8
#undef PEER_TOK

__global__ void __launch_bounds__(512, 2) mk_fwd(Args args) {
    extern __shared__ __attribute__((aligned(16))) unsigned char lds_raw[];
    LAS unsigned char* lds = (LAS unsigned char*)lds_raw;
    const int tid = threadIdx.x, lane = tid & 63, wave = __builtin_amdgcn_readfirstlane(tid >> 6);
    const int G = gridDim.x, gw = blockIdx.x * 8 + wave, ngw = G * 8;
    unsigned char* ws = args.ws;
    volatile LAS unsigned* misc = (volatile LAS unsigned*)(lds + LDS_MAIN);
    if (tid < 4) misc[tid] = 0u;
    __syncthreads();
    const int lo = args.ph_lo, hi = args.ph_hi;
    XcdBarrier bar; bar.bar = (unsigned*)(ws + WS_CTL); bar.x = 0; bar.st = misc;
    if (hi - lo > 1) bar = xcd_barrier_post((unsigned*)(ws + WS_CTL), misc);
#ifndef PHMASK
#define PHMASK 0x3fff
#endif
#define IN(k) (((PHMASK >> (k)) & 1) && lo <= (k) && (k) < hi)
#define SEAM(k) do { if (IN(k) && IN((k) + 1)) xcd_barrier(bar); } while (0)
    float* mod = (float*)(ws + WS_MOD);
    bf16_t* HB = (bf16_t*)(ws + WS_H); bf16_t* PA = (bf16_t*)(ws + WS_PA); bf16_t* PG = (bf16_t*)(ws + WS_PG);
    bf16_t* YA = (bf16_t*)(ws + WS_YA); bf16_t* ATT = (bf16_t*)(ws + WS_ATT); f32x2* EB = (f32x2*)(ws + WS_E); bf16_t* UBp = (bf16_t*)(ws + WS_UB);

#define PHS(code, ...) do { __VA_ARGS__ if (DUP == (code)) { xcd_barrier(bar); __VA_ARGS__ } } while (0)
#define PH(k, ...) do { if (IN(k)) { __VA_ARGS__ if (DUP == (k)) { xcd_barrier(bar); __VA_ARGS__ } } } while (0)
    PH(0, { ph_mod_partial(args.in[I_C], args.in[I_WADA], (float*)(ws + WS_MODP), gw, ngw, lane); ph_colmax_partial(args.in[I_WIN], (float*)(ws + WS_CMAXP), gw, ngw, lane); });
    SEAM(0);
    PH(1, { ph_prologue(args, lds, gw, ngw, lane, wave); });
    SEAM(1);
    PH(2, { ph_norm<true>(args.in[I_X], HB, (float*)(ws + WS_SA), args.in[I_N1G], mod, 0, 2048, gw, ngw, lane); });
    SEAM(2);
    PH(3, { pg8::Gemm g{HB, (const bf16_t*)(ws + WS_WIN), T_TOK, 8192, 1024}; pg8::StaticOrder S; S.init(T_TOK, 8192, G, (int)blockIdx.x);
        pg8::EpiProj E{PA, PG, UBp, (const float*)(ws + WS_SA), (const float*)(ws + WS_SB)}; pg8::gemm_phase<pg8::EpiProj, pg8::StaticOrder, true, true, 1>(lds, g, S, E); });
    SEAM(3);
    PH(4, { PHS(41, { ph_attn<0>(lds, PA, ATT, args.in[I_QNG], args.in[I_KNG], G); __syncthreads(); });
        if (DUP == 411) { xcd_barrier(bar); ph_attn<1>(lds, PA, ATT, args.in[I_QNG], args.in[I_KNG], G); __syncthreads(); } PHS(42, { ph_ssm_mfma<false>(args, lds, UBp, EB, YA, G); }); });
    SEAM(4);
    PH(5, { PHS(51, { ph_ssm_mfma<true>(args, lds, UBp, EB, YA, G); __syncthreads(); });
        PHS(52, { pg8::Gemm g{ATT, (const bf16_t*)(ws + WS_WATT), T_TOK, 2048, 512}; pg8::SplitOrder S; S.init(T_TOK, 2048, G, (int)blockIdx.x);
        pg8::EpiAttUp E{PG, HB}; pg8::gemm_phase<pg8::EpiAttUp, pg8::SplitOrder, true, true, 2>(lds, g, S, E); }); });
    SEAM(5);
    PH(6, { pg8::Gemm g{YA, (const bf16_t*)(ws + WS_WGLU), T_TOK, 4096, 512}; pg8::StaticOrder S; S.init(T_TOK, 4096, G, (int)blockIdx.x);
        pg8::EpiGlu E{PG, HB, (unsigned char*)ATT}; pg8::gemm_phase<pg8::EpiGlu, pg8::StaticOrder, true, true, 2>(lds, g, S, E); });
    SEAM(6);
    PH(7, { const bool split = (G == 256); const int gg = split ? 171 : G, ra = split ? 11264 : 0;
        if ((int)blockIdx.x < gg) { pg8::Gemm g{ATT, (const bf16_t*)(ws + WS_WOUT), T_TOK, 2048, 1024}; pg8::StaticOrder S; S.init(T_TOK, 2048, gg, (int)blockIdx.x);
            pg8::EpiOut E{args.in[I_X], args.out, mod}; pg8::gemm_phase<pg8::EpiOut, pg8::StaticOrder, true, true, 2>(lds, g, S, E); }
        else ph_table_cvt(args.in[I_PU], args.in[I_PV], ws + WS_UT, ws + WS_VT, 0, ra, ((int)blockIdx.x - gg) * 8 + wave, (G - gg) * 8, lane);
        ph_table_cvt(args.in[I_PU], args.in[I_PV], ws + WS_UT, ws + WS_VT, ra, 16384, gw, ngw, lane); });
    SEAM(7);
    PH(8, { ph_norm<false>(args.out, HB, nullptr, args.in[I_N2G], mod, 6144, 8192, gw, ngw, lane); });
    SEAM(8);
    PH(9, { pg8::Gemm g{HB, (const bf16_t*)(ws + WS_WSC), T_TOK, 2048, 2048}; pg8::StaticOrder S; S.init(T_TOK, 2048, G, (int)blockIdx.x);
        pg8::EpiF32 E{(float*)(ws + WS_SC)}; pg8::gemm_phase<pg8::EpiF32, pg8::StaticOrder, true, true>(lds, g, S, E); });
    SEAM(9);
    PH(10, { ph_peer_topk(lds, (const float*)(ws + WS_SC), (int*)(ws + WS_IDX), (float*)(ws + WS_GATE), G); });
    SEAM(10);
    PH(11, { ph_peer_u(ws + WS_UT, HB, (const int*)(ws + WS_IDX), (float*)(ws + WS_PDOT), G); });
    SEAM(11);
    PH(12, { ph_peer_act((const float*)(ws + WS_PDOT), (const float*)(ws + WS_GATE), (float*)(ws + WS_ACT), G); });
    SEAM(12);
    if (IN(13)) { if (DUP == 13) { ph_peer_v<true>(lds, ws + WS_VT, (const int*)(ws + WS_IDX), (const float*)(ws + WS_ACT), mod, args.out, G); xcd_barrier(bar); }
        ph_peer_v<false>(lds, ws + WS_VT, (const int*)(ws + WS_IDX), (const float*)(ws + WS_ACT), mod, args.out, G); }
#undef IN
#undef SEAM
}

extern "C" void kernel_launch(void* const* d_in, const int* in_sizes, int n_in, void* d_out, int out_size, void* d_ws, size_t ws_size, hipStream_t stream) {
    static int grid = 0;
    if (grid == 0) {
        if (n_in != 25 || out_size != T_TOK * DM || ws_size < WS_END) { fprintf(stderr, "kernel_launch: unexpected shapes (n_in %d out %d ws %zu need %zu)\n", n_in, out_size, ws_size, (size_t)WS_END); grid = -1; return; }
        int dev = 0, cus = 0, per_cu = 0;
        if (hipGetDevice(&dev) != hipSuccess || hipDeviceGetAttribute(&cus, hipDeviceAttributeMultiprocessorCount, dev) != hipSuccess) { grid = -1; return; }
        if (hipFuncSetAttribute((const void*)mk_fwd, hipFuncAttributeMaxDynamicSharedMemorySize, LDS_BYTES) != hipSuccess) { fprintf(stderr, "kernel_launch: hipFuncSetAttribute failed\n"); grid = -1; return; }
        if (hipOccupancyMaxActiveBlocksPerMultiprocessor(&per_cu, (const void*)mk_fwd, 512, LDS_BYTES) != hipSuccess || per_cu < 1) { fprintf(stderr, "kernel_launch: occupancy query says %d blocks/CU\n", per_cu); (void)hipGetLastError(); grid = -1; return; }
        grid = cus;
    }
    if (grid < 0) return;
    (void)hipMemsetAsync((char*)d_ws + WS_CTL, 0, 16384, stream);
    Args a{};
    for (int i = 0; i < 25; ++i) a.in[i] = (const float*)d_in[i];
    a.out = (float*)d_out; a.ws = (unsigned char*)d_ws;
#if MK_PER_PHASE
    for (int ph = 0; ph < NPHASE; ++ph) { a.ph_lo = ph; a.ph_hi = ph + 1; hipLaunchKernelGGL(mk_fwd, dim3(grid), dim3(512), LDS_BYTES, stream, a); }
#else
    a.ph_lo = 0; a.ph_hi = NPHASE;
    hipLaunchKernelGGL(mk_fwd, dim3(grid), dim3(512), LDS_BYTES, stream, a);
#endif
}
```

```cpp
#include <hip/hip_runtime.h>
#include <cstdio>
#include <cstdint>

#ifndef MK_PER_PHASE
#define MK_PER_PHASE 0
#endif

#ifndef DUP
#define DUP -1
#endif
#define LAS __attribute__((address_space(3)))
typedef unsigned short bf16_t;
typedef short bf16x8 __attribute__((ext_vector_type(8)));
typedef float f32x4 __attribute__((ext_vector_type(4)));
typedef float f32x2 __attribute__((ext_vector_type(2)));
typedef unsigned u32x4 __attribute__((ext_vector_type(4)));
typedef unsigned u32x2 __attribute__((ext_vector_type(2)));
typedef int i32x4 __attribute__((ext_vector_type(4)));

constexpr int T_TOK = 16384, DM = 2048, SEQ = 8192;
constexpr int NPHASE = 14;
constexpr float EPS = 1e-6f;

constexpr size_t WS_CTL   = 0;
constexpr size_t WS_MODP  = 65536;
constexpr size_t WS_MOD   = WS_MODP + (size_t)32 * 2 * 12288 * 4;
constexpr size_t WS_WIN   = WS_MOD + (size_t)2 * 12288 * 4;
constexpr size_t WS_WGLU  = WS_WIN + (size_t)8192 * 2048 * 2;
constexpr size_t WS_WATT  = WS_WGLU + (size_t)4096 * 1024 * 2;
constexpr size_t WS_WOUT  = WS_WATT + (size_t)2048 * 1024 * 2;
constexpr size_t WS_WSC   = WS_WOUT + (size_t)2048 * 2048 * 2;
constexpr size_t WS_H     = WS_WSC + (size_t)2048 * 2048 * 2;
constexpr size_t WS_PA    = WS_H + (size_t)T_TOK * 2048 * 2;
constexpr size_t WS_PG    = WS_PA + (size_t)T_TOK * 4096 * 2;
constexpr size_t WS_E     = WS_PG + (size_t)T_TOK * 4096 * 2;
constexpr size_t WS_YA    = WS_E + (size_t)2 * 64 * 128 * 64 * 8;
constexpr size_t WS_ATT   = WS_YA + (size_t)T_TOK * 1024 * 2;
constexpr size_t WS_UB    = WS_ATT + (size_t)T_TOK * 1024 * 2;
constexpr size_t WS_SA    = WS_UB + (size_t)T_TOK * 1024 * 2;
constexpr size_t WS_SB    = WS_SA + (size_t)T_TOK * 4;
constexpr size_t WS_CMAXP = WS_SB + (size_t)8192 * 4;
constexpr size_t WS_END   = WS_CMAXP + (size_t)32 * 8192 * 4;
constexpr size_t WS_SC    = WS_PA;
constexpr size_t WS_UT    = WS_PG;
constexpr size_t WS_VT    = WS_PG + (size_t)8 * 16384 * 192;
constexpr size_t WS_PDOT  = WS_VT + (size_t)8 * 16384 * 192;
constexpr size_t WS_IDX   = WS_YA;
constexpr size_t WS_GATE  = WS_YA + (size_t)T_TOK * 128 * 4;
constexpr size_t WS_ACT   = WS_GATE + (size_t)T_TOK * 128 * 4;
static_assert(WS_PDOT + (size_t)8 * T_TOK * 128 * 4 <= WS_PG + (size_t)T_TOK * 4096 * 2, "PEER buffers must fit the dead g_ssm|g_att region");
static_assert(WS_ACT + (size_t)T_TOK * 128 * 4 <= WS_YA + (size_t)T_TOK * 1024 * 2, "PEER index buffers must fit the dead YA region");
constexpr int LDS_MAIN = 131072, LDS_BYTES = LDS_MAIN + 256;

typedef __bf16 bf16x2_t __attribute__((ext_vector_type(2)));
__device__ __forceinline__ unsigned cvt_pk_bf16(float lo, float hi) { const f32x2 v = {lo, hi}; return __builtin_bit_cast(unsigned, __builtin_convertvector(v, bf16x2_t)); }
__device__ __forceinline__ float bf_lo(unsigned w) { return __uint_as_float(w << 16); }
__device__ __forceinline__ float bf_hi(unsigned w) { return __uint_as_float(w & 0xffff0000u); }
__device__ __forceinline__ float wave_sum(float v) {
#pragma unroll
    for (int o = 1; o < 64; o <<= 1) v += __shfl_xor(v, o);
    return v;
}
__device__ __forceinline__ float sigmoidf_(float x) { return __builtin_amdgcn_rcpf(1.0f + __builtin_amdgcn_exp2f(-1.4426950408889634f * x)); }
__device__ __forceinline__ float gelu_tanh(float x) {
    const float a2 = (-2.0f * 0.7978845608028654f * 1.4426950408889634f) * (x + 0.044715f * x * x * x);
    return x * __builtin_amdgcn_rcpf(1.0f + __builtin_amdgcn_exp2f(a2));
}
constexpr float F8_SA = 8.0f, F8_SW = 64.0f, F8_INV = 1.0f / 512.0f;
__device__ __forceinline__ unsigned pack4_fp8(float a, float b, float c, float d, float sc) {
    a = fminf(fmaxf(a * sc, -448.f), 448.f); b = fminf(fmaxf(b * sc, -448.f), 448.f); c = fminf(fmaxf(c * sc, -448.f), 448.f); d = fminf(fmaxf(d * sc, -448.f), 448.f);
    int p = 0; p = __builtin_amdgcn_cvt_pk_fp8_f32(a, b, p, false); p = __builtin_amdgcn_cvt_pk_fp8_f32(c, d, p, true); return (unsigned)p; }
__device__ __forceinline__ float sum8_dpp(float v) {
    v += __builtin_bit_cast(float, __builtin_amdgcn_update_dpp(0, __builtin_bit_cast(int, v), 0xB1, 0xF, 0xF, true));
    v += __builtin_bit_cast(float, __builtin_amdgcn_update_dpp(0, __builtin_bit_cast(int, v), 0x4E, 0xF, 0xF, true));
    v += __builtin_bit_cast(float, __builtin_amdgcn_update_dpp(0, __builtin_bit_cast(int, v), 0x141, 0xF, 0xF, true));
    return v; }
#define LDS_WAIT() asm volatile("s_waitcnt lgkmcnt(0)" ::: "memory")
__device__ __forceinline__ int opaque_tid() { int t = threadIdx.x; asm volatile("" : "+v"(t)); return t; }

#define XB_TMO      128
#define XB_XCNT(j)  (256  + 64 * (j))
#define XB_XSUB(j)  (1280 + 64 * (j))
#define XB_XGEN(j)  (2304 + 64 * (j))
#define XB_TOP      3328
#define XB_TOPGEN   3392
#define XCD_BAR_WORDS 3456
#define XB_SPIN_CAP (1u << 22)
__device__ __forceinline__ unsigned xb_ld(unsigned* p)              { return __hip_atomic_load(p, __ATOMIC_RELAXED, __HIP_MEMORY_SCOPE_AGENT); }
__device__ __forceinline__ unsigned xb_add(unsigned* p, unsigned v) { return __hip_atomic_fetch_add(p, v, __ATOMIC_RELAXED, __HIP_MEMORY_SCOPE_AGENT); }
__device__ __forceinline__ unsigned xb_xcc_id() { return (unsigned)__builtin_amdgcn_s_getreg((3 << 11) | 20) & 0xFu; }
#define XB_SPIN(cond, bar) do { unsigned _sp = 0; while (cond) { __builtin_amdgcn_s_sleep(1); \
    if ((++_sp & 255u) == 0u) { if (xb_ld(&(bar)[XB_TMO])) break; if (_sp > XB_SPIN_CAP) { atomicAdd(&(bar)[XB_TMO], 1u); break; } } } } while (0)
struct XcdBarrier { unsigned* bar; unsigned x; volatile LAS unsigned* st; };
__device__ __forceinline__ XcdBarrier xcd_barrier_post(unsigned* bar, volatile LAS unsigned* st) {
    XcdBarrier b; b.bar = bar; b.x = xb_xcc_id(); b.st = st;
    if (threadIdx.x == 0) (void)xb_add(&bar[XB_XCNT(b.x)], 1u);
    return b;
}
__device__ __forceinline__ void xcd_barrier_complete(unsigned* bar, unsigned x, unsigned& nloc, unsigned& nx) {
    const unsigned G = gridDim.x * gridDim.y * gridDim.z;
    unsigned sum, cnt, mine, sp = 0u;
    for (;;) {
        sum = 0u; cnt = 0u; mine = 0u;
#pragma unroll
        for (unsigned j = 0; j < 16; ++j) { const unsigned c = xb_ld(&bar[XB_XCNT(j)]); sum += c; cnt += (c > 0u) ? 1u : 0u; mine = (j == x) ? c : mine; }
        if (sum == G) break;
        __builtin_amdgcn_s_sleep(1);
        if ((++sp & 255u) == 0u) { if (xb_ld(&bar[XB_TMO])) break; if (sp > XB_SPIN_CAP) { atomicAdd(&bar[XB_TMO], 1u); break; } }
    }
    nloc = mine > 0u ? mine : 1u; nx = cnt > 0u ? cnt : 1u;
}
__device__ __forceinline__ void xcd_barrier(const XcdBarrier& b) {
    asm volatile("s_waitcnt vmcnt(0)" ::: "memory");
    __syncthreads();
    if (threadIdx.x == 0) {
        unsigned* bar = b.bar;
        __builtin_amdgcn_s_waitcnt(0);
        unsigned nloc = b.st[0], nx = b.st[1];
        if (nloc == 0u) { xcd_barrier_complete(bar, b.x, nloc, nx); b.st[0] = nloc; b.st[1] = nx; }
        const unsigned old = xb_add(&bar[XB_XSUB(b.x)], 1u);
        const unsigned gen = old / nloc;
        if (old + 1u == (gen + 1u) * nloc) {
            __builtin_amdgcn_fence(__ATOMIC_RELEASE, "agent");
            asm volatile("s_waitcnt vmcnt(0)" ::: "memory");
            const unsigned og = xb_add(&bar[XB_TOP], 1u);
            const unsigned tg = og / nx;
            if (og + 1u == (tg + 1u) * nx) xb_add(&bar[XB_TOPGEN], 1u);
            else XB_SPIN(xb_ld(&bar[XB_TOPGEN]) == tg, bar);
            __builtin_amdgcn_fence(__ATOMIC_ACQUIRE, "agent");
            xb_add(&bar[XB_XGEN(b.x)], 1u);
            asm volatile("s_waitcnt vmcnt(0)" ::: "memory");
        } else {
            XB_SPIN(xb_ld(&bar[XB_XGEN(b.x)]) == gen, bar);
            __builtin_amdgcn_fence(__ATOMIC_ACQUIRE, "agent");
            asm volatile("s_waitcnt vmcnt(0)" ::: "memory");
        }
    }
    __syncthreads();
}

namespace pg8 {
constexpr int BM = 256, BK = 64, HALF = 128, HTB = HALF * BK * 2, STAGE_BYTES = 8 * HTB, NXCD = 8, WGM = 8;
__host__ __device__ __forceinline__ int lds_byte(int r, int c) { const int st = (r >> 4) * 2 + (c >> 5), rr = r & 15, cc = c & 31, ob = rr * 64 + cc * 2; return st * 1024 + (ob ^ (((ob >> 9) & 1) << 5)); }
__host__ __device__ __forceinline__ void stage_rc(int b, int& R, int& C) { const int st = b / 1024, sb = b % 1024, swz = sb ^ (((sb >> 9) & 1) << 5); R = (st >> 1) * 16 + swz / 64; C = (st & 1) * 32 + (swz % 64) / 2; }
__host__ __device__ __forceinline__ int perm32(int rho) { const int n = rho >> 4, i = rho & 15; return 8 * (i >> 2) + 4 * n + (i & 3); }
struct Unit { int pm, pn; };
struct Gemm { const bf16_t* A; const bf16_t* Bt; int M, N, K; };
struct StaticOrder {
    int nM, nN, nwg, G, c;
    __host__ __device__ void init(int M, int N, int G_, int c_) { nM = M / BM; nN = N / BM; nwg = nM * nN; G = G_; c = c_; }
    __host__ __device__ bool next(int i, Unit& u) const { return at((long)i * G + c, u); }
    __host__ __device__ bool at(long L, Unit& u) const {
        if (L >= nwg) return false;
        int wgid = (int)L; { const int q = nwg / NXCD, r = nwg % NXCD, xcd = wgid % NXCD, off = wgid / NXCD; wgid = (xcd < r ? xcd * (q + 1) : r * (q + 1) + (xcd - r) * q) + off; }
        const int nig = WGM * nN, gid = wgid / nig, fm = gid * WGM, gsz = (nM - fm) < WGM ? (nM - fm) : WGM;
        u.pm = fm + ((wgid % nig) % gsz); u.pn = (wgid % nig) / gsz; return true;
    }
    __device__ __forceinline__ void a_ready(const Unit&) const {}
    __device__ __forceinline__ void done(const Unit&) const {}
};
struct SplitOrder {
    StaticOrder b;
    __host__ __device__ void init(int M, int N, int G_, int c_) { b.init(M, N, G_, c_); }
    __host__ __device__ bool next(int i, Unit& u) const {
        if (b.G != 256 || b.nwg != 512) return b.next(i, u);
        if (b.c < 128) return false;
        return i < 4 ? b.at((b.c - 128) * 4 + i, u) : false;
    }
    __device__ __forceinline__ void a_ready(const Unit&) const {}
    __device__ __forceinline__ void done(const Unit&) const {}
};
typedef int i32x8 __attribute__((ext_vector_type(8)));
template <class Epi, class Sched, bool ALIGN_EPI = false, bool SP2 = false, int MODE = 0>
__device__ __forceinline__ void gemm_phase(LAS unsigned char* lds, const Gemm g, const Sched& S, const Epi& E) {
    const int tid = threadIdx.x, wid = __builtin_amdgcn_readfirstlane(tid >> 6), lane = tid & 63, wr = wid >> 2, wc = wid & 3, fr = lane & 15, fq = lane >> 4;
    const int K = g.K, nt = K / BK;
    unsigned voffA[2], voffB[2];
#pragma unroll
    for (int i = 0; i < 2; ++i) { int R, C; stage_rc(tid * 16 + i * 8192, R, C); const int Rb = Epi::PERM ? ((R & ~31) + perm32(R & 31)) : R;
        voffA[i] = (unsigned)(R * K + C) * 2u; voffB[i] = (unsigned)(Rb * K + C) * 2u; }
    const size_t kstep = (size_t)(BK * 2);
    const size_t hstep = (size_t)HALF * K * 2;
    const size_t tstep = 2 * hstep;
    const unsigned ldsw = (unsigned)wid * 1024u;
    const int aoff = lds_byte(wr * 64 + fr, fq * 8), boff = lds_byte(wc * 32 + fr, fq * 8);
#define PG8_SA(b, h) (((b) * 2 + (h)) * HTB)
#define PG8_SB(b, h) ((4 + (b) * 2 + (h)) * HTB)
#define PG8_STAGE(bufoff, gbase, voff) do { _Pragma("unroll") for (int _i = 0; _i < 2; ++_i) \
        __builtin_amdgcn_global_load_lds((const unsigned*)((const char*)(gbase) + (voff)[_i]), (LAS unsigned*)(lds + (bufoff) + ldsw + _i * 8192), 16, 0, 0); } while (0)
#define PG8_LD8(p_) ({ const i32x4 _lo = *(const LAS i32x4*)(p_), _hi = *(const LAS i32x4*)((p_) + 1024); (i32x8){_lo[0], _lo[1], _lo[2], _lo[3], _hi[0], _hi[1], _hi[2], _hi[3]}; })
#define PG8_LDA(dst, b, h) do { _Pragma("unroll") for (int m = 0; m < 4; ++m) dst[m] = PG8_LD8(lds + PG8_SA(b, h) + aoff + m * 2048); } while (0)
#define PG8_LDB(dst, b, h) do { _Pragma("unroll") for (int n = 0; n < 2; ++n) dst[n] = PG8_LD8(lds + PG8_SB(b, h) + boff + n * 2048); } while (0)
#define PG8_HALF(v, k) ((k) == 0 ? __builtin_shufflevector(v, v, 0, 1, 2, 3) : __builtin_shufflevector(v, v, 4, 5, 6, 7))
#define PG8_MMA(ai, bj, At, Bt) do { __builtin_amdgcn_s_setprio(1); _Pragma("unroll") for (int m = 0; m < 4; ++m) _Pragma("unroll") for (int n = 0; n < 2; ++n) { \
        if (MODE == 2) asm volatile("v_mfma_scale_f32_16x16x128_f8f6f4 %0, %1, %2, %0, %3, %3 op_sel_hi:[0,0,0]" : "+v"(acc[ai][bj][m][n]) : "v"(Bt[n]), "v"(At[m]), "v"(scl1)); \
        else { _Pragma("unroll") for (int k = 0; k < 2; ++k) \
            acc[ai][bj][m][n] = (MODE == 1) ? __builtin_bit_cast(f32x4, __builtin_amdgcn_mfma_i32_16x16x64_i8(PG8_HALF(Bt[n], k), PG8_HALF(At[m], k), __builtin_bit_cast(i32x4, acc[ai][bj][m][n]), 0, 0, 0)) \
                                            : __builtin_amdgcn_mfma_f32_16x16x32_bf16(__builtin_bit_cast(bf16x8, PG8_HALF(Bt[n], k)), __builtin_bit_cast(bf16x8, PG8_HALF(At[m], k)), acc[ai][bj][m][n], 0, 0, 0); } } __builtin_amdgcn_s_setprio(0); } while (0)
#define PG8_WAIT_V(n) asm volatile("s_waitcnt vmcnt(" #n ")" ::: "memory")
#define PG8_WAIT_L(n) asm volatile("s_waitcnt lgkmcnt(" #n ")" ::: "memory")
#define PG8_BAR __builtin_amdgcn_s_barrier()
#define PG8_SCHED __builtin_amdgcn_sched_barrier(0)
    const int scl1 = 0x7f7f7f7f;
    Unit cur, nxt; int ui = 0;
    if (!S.next(0, cur)) return;
    f32x4 acc[2][2][4][2];
#pragma unroll
    for (int a = 0; a < 2; ++a)
#pragma unroll
        for (int b = 0; b < 2; ++b)
#pragma unroll
            for (int m = 0; m < 4; ++m)
#pragma unroll
                for (int n = 0; n < 2; ++n) acc[a][b][m][n] = (f32x4){0.f, 0.f, 0.f, 0.f};
    i32x8 At[4], B0[2], B1[2];
    const char* cA = (const char*)g.A + (size_t)cur.pm * tstep; const char* cB = (const char*)g.Bt + (size_t)cur.pn * tstep;
    S.a_ready(cur);
    if constexpr (SP2) {
        PG8_STAGE(PG8_SB(0, 0), cB, voffB); PG8_STAGE(PG8_SB(0, 1), cB + hstep, voffB); PG8_STAGE(PG8_SA(0, 0), cA, voffA); PG8_STAGE(PG8_SA(0, 1), cA + hstep, voffA);
        if (wr == 1) PG8_BAR;
        PG8_WAIT_V(2); PG8_BAR;
        PG8_STAGE(PG8_SB(1, 0), cB + kstep, voffB); PG8_STAGE(PG8_SA(1, 0), cA + kstep, voffA); PG8_STAGE(PG8_SB(1, 1), cB + hstep + kstep, voffB);
        PG8_WAIT_V(6); PG8_BAR;
    } else {
        PG8_STAGE(PG8_SB(0, 0), cB, voffB); PG8_STAGE(PG8_SA(0, 0), cA, voffA); PG8_STAGE(PG8_SB(0, 1), cB + hstep, voffB); PG8_STAGE(PG8_SA(0, 1), cA + hstep, voffA);
        if (wr == 1) PG8_BAR;
        PG8_WAIT_V(4); PG8_BAR;
        PG8_STAGE(PG8_SB(1, 0), cB + kstep, voffB); PG8_STAGE(PG8_SA(1, 0), cA + kstep, voffA); PG8_STAGE(PG8_SB(1, 1), cB + hstep + kstep, voffB);
        PG8_WAIT_V(6); PG8_BAR;
    }
    for (;;) {
        const bool has_next = S.next(ui + 1, nxt);
        const char* nA = has_next ? (const char*)g.A + (size_t)nxt.pm * tstep : cA; const char* nB = has_next ? (const char*)g.Bt + (size_t)nxt.pn * tstep : cB;
#pragma unroll 1
        for (int t = 0; t < nt; t += 2) {
            const bool last = (t == nt - 2);
            const char* a1 = cA + (size_t)(t + 1) * kstep;
            const char* a2 = last ? nA : cA + (size_t)(t + 2) * kstep; const char* b2 = last ? nB : cB + (size_t)(t + 2) * kstep;
            const char* a3 = a2 + kstep; const char* b3 = b2 + kstep;
            if (last && has_next) S.a_ready(nxt);
            if constexpr (SP2) {
            PG8_LDB(B0, 0, 0); PG8_LDB(B1, 0, 1); PG8_SCHED; PG8_LDA(At, 0, 0); PG8_STAGE(PG8_SA(1, 1), a1 + hstep, voffA);
            PG8_WAIT_V(8); PG8_WAIT_L(0); PG8_BAR; PG8_MMA(0, 0, At, B0); PG8_MMA(0, 1, At, B1); PG8_BAR; PG8_SCHED;
            PG8_LDA(At, 0, 1); PG8_STAGE(PG8_SB(0, 0), b2, voffB); PG8_STAGE(PG8_SB(0, 1), b2 + hstep, voffB); PG8_STAGE(PG8_SA(0, 0), a2, voffA);
            PG8_WAIT_V(8); PG8_WAIT_L(0); PG8_BAR; PG8_MMA(1, 0, At, B0); PG8_MMA(1, 1, At, B1); PG8_BAR; PG8_SCHED;
            PG8_LDB(B0, 1, 0); PG8_LDB(B1, 1, 1); PG8_SCHED; PG8_LDA(At, 1, 0); PG8_STAGE(PG8_SA(0, 1), a2 + hstep, voffA);
            PG8_WAIT_V(8); PG8_WAIT_L(0); PG8_BAR; PG8_MMA(0, 0, At, B0); PG8_MMA(0, 1, At, B1); PG8_BAR; PG8_SCHED;
            PG8_LDA(At, 1, 1); PG8_STAGE(PG8_SB(1, 0), b3, voffB); PG8_STAGE(PG8_SB(1, 1), b3 + hstep, voffB); PG8_STAGE(PG8_SA(1, 0), a3, voffA);
            PG8_WAIT_V(8); PG8_WAIT_L(0); PG8_BAR; PG8_MMA(1, 0, At, B0); PG8_MMA(1, 1, At, B1); PG8_BAR; PG8_SCHED;
            } else {
            PG8_LDB(B0, 0, 0); PG8_SCHED; PG8_LDA(At, 0, 0); PG8_STAGE(PG8_SA(1, 1), a1 + hstep, voffA);
            PG8_WAIT_L(8); PG8_BAR; PG8_WAIT_L(0); PG8_MMA(0, 0, At, B0); PG8_BAR; PG8_SCHED;
            PG8_LDB(B1, 0, 1); PG8_STAGE(PG8_SB(0, 0), b2, voffB);
            PG8_BAR; PG8_WAIT_L(0); PG8_MMA(0, 1, At, B1); PG8_BAR;
            PG8_LDA(At, 0, 1); PG8_STAGE(PG8_SA(0, 0), a2, voffA);
            PG8_BAR; PG8_WAIT_L(0); PG8_MMA(1, 0, At, B0); PG8_BAR; PG8_SCHED;
            PG8_STAGE(PG8_SB(0, 1), b2 + hstep, voffB);
            PG8_WAIT_V(6); PG8_BAR; PG8_MMA(1, 1, At, B1); PG8_BAR;
            PG8_LDB(B0, 1, 0); PG8_SCHED; PG8_LDA(At, 1, 0); PG8_STAGE(PG8_SA(0, 1), a2 + hstep, voffA);
            PG8_WAIT_L(8); PG8_BAR; PG8_WAIT_L(0); PG8_MMA(0, 0, At, B0); PG8_BAR; PG8_SCHED;
            PG8_LDB(B1, 1, 1); PG8_STAGE(PG8_SB(1, 0), b3, voffB);
            PG8_BAR; PG8_WAIT_L(0); PG8_MMA(0, 1, At, B1); PG8_BAR;
            PG8_LDA(At, 1, 1); PG8_STAGE(PG8_SA(1, 0), a3, voffA);
            PG8_BAR; PG8_WAIT_L(0); PG8_MMA(1, 0, At, B0); PG8_BAR; PG8_SCHED;
            PG8_STAGE(PG8_SB(1, 1), b3 + hstep, voffB);
            PG8_WAIT_V(6); PG8_BAR; PG8_MMA(1, 1, At, B1); PG8_BAR;
            }
        }
        if constexpr (ALIGN_EPI) { if (wr == 0) PG8_BAR; }
        if (MODE == 2) asm volatile("s_nop 15\n\ts_nop 15" ::: "memory");
        E(acc, cur, wr, wc, fr, fq); S.done(cur);
        if (!has_next) break;
#pragma unroll
        for (int a = 0; a < 2; ++a)
#pragma unroll
            for (int b = 0; b < 2; ++b)
#pragma unroll
                for (int m = 0; m < 4; ++m)
#pragma unroll
                    for (int n = 0; n < 2; ++n) acc[a][b][m][n] = (f32x4){0.f, 0.f, 0.f, 0.f};
        cur = nxt; cA = nA; cB = nB; ++ui;
        if constexpr (ALIGN_EPI) { if (wr == 1) PG8_BAR; }
    }
    PG8_WAIT_V(0);
    if constexpr (!ALIGN_EPI) { if (wr == 0) PG8_BAR; }
    PG8_BAR;
#undef PG8_SA
#undef PG8_SB
#undef PG8_STAGE
#undef PG8_LDA
#undef PG8_LDB
#undef PG8_MMA
#undef PG8_WAIT_V
#undef PG8_WAIT_L
#undef PG8_BAR
#undef PG8_SCHED
}

struct EpiProj {
    static constexpr bool PERM = true;
    bf16_t* PA; bf16_t* PG; bf16_t* UB; const float* SA; const float* SB;
    __device__ __forceinline__ void operator()(const f32x4 (&acc)[2][2][4][2], const Unit& u, int wr, int wc, int fr, int fq) const {
        const int row0 = u.pm * BM + wr * 64 + fr; int colt = u.pn * BM; const bool isu = colt < 1024; bf16_t* base = colt < 4096 ? PA : PG;
        const int gcol0 = colt + wc * 32 + 8 * fq; colt &= 4095;
        const int col0 = colt + wc * 32 + 8 * fq;
        f32x4 sb[2][2];
#pragma unroll
        for (int bj = 0; bj < 2; ++bj) { sb[bj][0] = *(const f32x4*)(SB + gcol0 + bj * HALF); sb[bj][1] = *(const f32x4*)(SB + gcol0 + bj * HALF + 4); }
#pragma unroll
        for (int ai = 0; ai < 2; ++ai)
#pragma unroll
            for (int m = 0; m < 4; ++m) { const int row = row0 + ai * HALF + m * 16; bf16_t* rowp = base + (size_t)row * 4096 + col0; const float sa = SA[row];
#pragma unroll
                for (int bj = 0; bj < 2; ++bj) { const i32x4 i0 = __builtin_bit_cast(i32x4, acc[ai][bj][m][0]), i1 = __builtin_bit_cast(i32x4, acc[ai][bj][m][1]);
                    f32x4 v0, v1;
#pragma unroll
                    for (int e = 0; e < 4; ++e) { v0[e] = (float)i0[e] * sa * sb[bj][0][e]; v1[e] = (float)i1[e] * sa * sb[bj][1][e]; }
                    u32x4 w; w.x = cvt_pk_bf16(v0[0], v0[1]); w.y = cvt_pk_bf16(v0[2], v0[3]); w.z = cvt_pk_bf16(v1[0], v1[1]); w.w = cvt_pk_bf16(v1[2], v1[3]);
                    if (isu) { const int cu = col0 + bj * HALF; *(u32x4*)(UB + (((size_t)((row >> 13) * 64 + (cu >> 4)) * 8192 + (row & 8191)) * 16 + (cu & 8))) = w; }
                    else *(u32x4*)(rowp + bj * HALF) = w; } }
    }
};
struct EpiAttUp {
    static constexpr bool PERM = true;
    const bf16_t* PG; bf16_t* HB;
    __device__ __forceinline__ void operator()(const f32x4 (&acc)[2][2][4][2], const Unit& u, int wr, int wc, int fr, int fq) const {
        const int row0 = u.pm * BM + wr * 64 + fr; const int col0 = u.pn * BM + wc * 32 + 8 * fq;
#pragma unroll
        for (int ai = 0; ai < 2; ++ai)
#pragma unroll
            for (int m = 0; m < 4; ++m) { const size_t row = (size_t)(row0 + ai * HALF + m * 16);
#pragma unroll
                for (int bj = 0; bj < 2; ++bj) { const int col = col0 + bj * HALF;
                    const u32x4 gw = *(const u32x4*)(PG + row * 4096 + 2048 + col);
                    const f32x4 v0 = acc[ai][bj][m][0] * F8_INV, v1 = acc[ai][bj][m][1] * F8_INV;
                    u32x4 w;
                    w.x = cvt_pk_bf16(v0[0] * sigmoidf_(bf_lo(gw.x)), v0[1] * sigmoidf_(bf_hi(gw.x)));
                    w.y = cvt_pk_bf16(v0[2] * sigmoidf_(bf_lo(gw.y)), v0[3] * sigmoidf_(bf_hi(gw.y)));
                    w.z = cvt_pk_bf16(v1[0] * sigmoidf_(bf_lo(gw.z)), v1[1] * sigmoidf_(bf_hi(gw.z)));
                    w.w = cvt_pk_bf16(v1[2] * sigmoidf_(bf_lo(gw.w)), v1[3] * sigmoidf_(bf_hi(gw.w)));
                    *(u32x4*)(HB + row * 2048 + col) = w; } asm volatile("" ::: "memory"); }
    }
};
struct EpiGlu {
    static constexpr bool PERM = true;
    const bf16_t* PG; const bf16_t* HB; unsigned char* M8;
    __device__ __forceinline__ void operator()(const f32x4 (&acc)[2][2][4][2], const Unit& u, int wr, int wc, int fr, int fq) const {
        const int row0 = u.pm * BM + wr * 64 + fr; const int col = u.pn * HALF + wc * 32 + 8 * fq;
#pragma unroll
        for (int ai = 0; ai < 2; ++ai)
#pragma unroll
            for (int m = 0; m < 4; ++m) { const size_t row = (size_t)(row0 + ai * HALF + m * 16);
                const u32x4 gw = *(const u32x4*)(PG + row * 4096 + col);
                const u32x4 aw = *(const u32x4*)(HB + row * 2048 + col);
                const f32x4 a0 = acc[ai][0][m][0] * F8_INV, a1 = acc[ai][0][m][1] * F8_INV, g0 = acc[ai][1][m][0] * F8_INV, g1 = acc[ai][1][m][1] * F8_INV;
                u32x2 w;
                w.x = pack4_fp8(sigmoidf_(bf_lo(gw.x)) * a0[0] * sigmoidf_(g0[0]) + bf_lo(aw.x), sigmoidf_(bf_hi(gw.x)) * a0[1] * sigmoidf_(g0[1]) + bf_hi(aw.x),
                                sigmoidf_(bf_lo(gw.y)) * a0[2] * sigmoidf_(g0[2]) + bf_lo(aw.y), sigmoidf_(bf_hi(gw.y)) * a0[3] * sigmoidf_(g0[3]) + bf_hi(aw.y), F8_SA);
                w.y = pack4_fp8(sigmoidf_(bf_lo(gw.z)) * a1[0] * sigmoidf_(g1[0]) + bf_lo(aw.z), sigmoidf_(bf_hi(gw.z)) * a1[1] * sigmoidf_(g1[1]) + bf_hi(aw.z),
                                sigmoidf_(bf_lo(gw.w)) * a1[2] * sigmoidf_(g1[2]) + bf_lo(aw.w), sigmoidf_(bf_hi(gw.w)) * a1[3] * sigmoidf_(g1[3]) + bf_hi(aw.w), F8_SA);
                *(u32x2*)(M8 + row * 2048 + col) = w; asm volatile("" ::: "memory"); }
    }
};
struct EpiOut {
    static constexpr bool PERM = true;
    const float* X; float* O; const float* mod;
    __device__ __forceinline__ void operator()(const f32x4 (&acc)[2][2][4][2], const Unit& u, int wr, int wc, int fr, int fq) const {
        const int row0 = u.pm * BM + wr * 64 + fr; const int col0 = u.pn * BM + wc * 32 + 8 * fq;
        const float* gt = mod + (size_t)((u.pm * BM) >> 13) * 12288 + 4096;
#pragma unroll
        for (int bj = 0; bj < 2; ++bj) { const int col = col0 + bj * HALF;
            const f32x4 g0 = *(const f32x4*)(gt + col), g1 = *(const f32x4*)(gt + col + 4);
#pragma unroll
            for (int ai = 0; ai < 2; ++ai)
#pragma unroll
                for (int m = 0; m < 4; ++m) { const size_t off = (size_t)(row0 + ai * HALF + m * 16) * 2048 + col;
                    const f32x4 x0 = *(const f32x4*)(X + off), x1 = *(const f32x4*)(X + off + 4);
                    *(f32x4*)(O + off) = x0 + g0 * (acc[ai][bj][m][0] * F8_INV); *(f32x4*)(O + off + 4) = x1 + g1 * (acc[ai][bj][m][1] * F8_INV); } }
    }
};
struct EpiF32 {
    static constexpr bool PERM = true;
    float* O;
    __device__ __forceinline__ void operator()(const f32x4 (&acc)[2][2][4][2], const Unit& u, int wr, int wc, int fr, int fq) const {
        const int row0 = u.pm * BM + wr * 64 + fr; const int col0 = u.pn * BM + wc * 32 + 8 * fq;
#pragma unroll
        for (int ai = 0; ai < 2; ++ai)
#pragma unroll
            for (int m = 0; m < 4; ++m) { float* rowp = O + (size_t)(row0 + ai * HALF + m * 16) * 2048 + col0;
#pragma unroll
                for (int bj = 0; bj < 2; ++bj) { *(f32x4*)(rowp + bj * HALF) = acc[ai][bj][m][0]; *(f32x4*)(rowp + bj * HALF + 4) = acc[ai][bj][m][1]; } }
    }
};
}

struct Args { const float* in[25]; float* out; unsigned char* ws; int ph_lo, ph_hi; };
enum { I_X = 0, I_C, I_WADA, I_BADA, I_N1G, I_WIN, I_LRE, I_LIM, I_LDT, I_BRE, I_BIM, I_CRE, I_CIM, I_SD, I_WGLU, I_QNG, I_KNG, I_WATT, I_WOUT, I_N2G, I_WQ, I_K1, I_K2, I_PU, I_PV };

__device__ __forceinline__ void ph_mod_partial(const float* __restrict__ c, const float* __restrict__ w_ada, float* modp, int gw, int ngw, int lane) {
    for (int task = gw; task < 48 * 32; task += ngw) {
        const int strip = task % 48, ks = task / 48, n0 = strip * 256 + lane * 4, k0 = ks * 64;
        f32x4 a0 = {0.f, 0.f, 0.f, 0.f}, a1 = {0.f, 0.f, 0.f, 0.f};
#pragma unroll 8
        for (int k = 0; k < 64; ++k) {
            const f32x4 w = *(const f32x4*)(w_ada + (size_t)(k0 + k) * 12288 + n0);
            float c0 = c[k0 + k], c1 = c[2048 + k0 + k];
            c0 = c0 / (1.0f + __expf(-c0)); c1 = c1 / (1.0f + __expf(-c1));
            a0 += c0 * w; a1 += c1 * w;
        }
        *(f32x4*)(modp + (size_t)(ks * 2 + 0) * 12288 + n0) = a0;
        *(f32x4*)(modp + (size_t)(ks * 2 + 1) * 12288 + n0) = a1;
    }
}

__device__ __forceinline__ void ph_colmax_partial(const float* __restrict__ w_in, float* cmaxp, int gw, int ngw, int lane) {
    for (int task = gw; task < 32 * 32; task += ngw) {
        const int strip = task & 31, ks = task >> 5, n0 = strip * 256 + lane * 4, k0 = ks * 64;
        f32x4 m = {0.f, 0.f, 0.f, 0.f};
#pragma unroll 8
        for (int k = 0; k < 64; ++k) { const f32x4 w = *(const f32x4*)(w_in + (size_t)(k0 + k) * 8192 + n0);
            m[0] = fmaxf(m[0], fabsf(w[0])); m[1] = fmaxf(m[1], fabsf(w[1])); m[2] = fmaxf(m[2], fabsf(w[2])); m[3] = fmaxf(m[3], fabsf(w[3])); }
        *(f32x4*)(cmaxp + (size_t)ks * 8192 + n0) = m;
    }
}

__device__ __forceinline__ void transpose_item_f8(const float* __restrict__ W, int K, int N, unsigned char* WT8, int drow0, int scol0, int k0, LAS float* scr, int lane) {
#pragma unroll 8
    for (int i = 0; i < 32; ++i) { const int kk = 2 * i + (lane >> 5); scr[kk * 33 + (lane & 31)] = W[(size_t)(k0 + kk) * N + scol0 + (lane & 31)]; }
    LDS_WAIT();
    const int n = lane >> 1, half = lane & 1;
    const LAS float* s = scr + (32 * half) * 33 + n;
    u32x4 o[2];
#pragma unroll
    for (int q = 0; q < 8; ++q) o[q >> 2][q & 3] = pack4_fp8(s[(4 * q) * 33], s[(4 * q + 1) * 33], s[(4 * q + 2) * 33], s[(4 * q + 3) * 33], F8_SW);
    *(u32x4*)(WT8 + (size_t)(drow0 + n) * K + k0 + 32 * half) = o[0];
    *(u32x4*)(WT8 + (size_t)(drow0 + n) * K + k0 + 32 * half + 16) = o[1];
    LDS_WAIT();
}
__device__ __forceinline__ void transpose_item_i8(const float* __restrict__ W, signed char* WT8, const float* cmaxp, float* SB, int n0, int k0, LAS float* scr, int lane) {
#pragma unroll 8
    for (int i = 0; i < 32; ++i) { const int kk = 2 * i + (lane >> 5); scr[kk * 33 + (lane & 31)] = W[(size_t)(k0 + kk) * 8192 + n0 + (lane & 31)]; }
    const int n = lane >> 1, half = lane & 1;
    float cm = 0.f;
#pragma unroll 8
    for (int ks = 0; ks < 32; ++ks) cm = fmaxf(cm, cmaxp[(size_t)ks * 8192 + n0 + n]);
    const float sb = fmaxf(cm, 1e-30f) * (1.0f / 127.0f), inv = 1.0f / sb;
    if (k0 == 0 && half == 0) SB[n0 + n] = sb;
    LDS_WAIT();
    const LAS float* s = scr + (32 * half) * 33 + n;
    u32x4 o[2];
#pragma unroll
    for (int q = 0; q < 8; ++q) { unsigned w = 0;
#pragma unroll
        for (int e = 0; e < 4; ++e) { const int v = (int)rintf(s[(4 * q + e) * 33] * inv); w |= ((unsigned)v & 0xffu) << (8 * e); }
        o[q >> 2][q & 3] = w; }
    *(u32x4*)(WT8 + (size_t)(n0 + n) * 2048 + k0 + 32 * half) = o[0];
    *(u32x4*)(WT8 + (size_t)(n0 + n) * 2048 + k0 + 32 * half + 16) = o[1];
    LDS_WAIT();
}

__device__ __forceinline__ void transpose_item(const float* __restrict__ W, int K, int N, bf16_t* WT, int drow0, int scol0, int k0, LAS float* scr, int lane) {
#pragma unroll 8
    for (int i = 0; i < 32; ++i) { const int kk = 2 * i + (lane >> 5); scr[kk * 33 + (lane & 31)] = W[(size_t)(k0 + kk) * N + scol0 + (lane & 31)]; }
    LDS_WAIT();
    const int c = lane & 7;
#pragma unroll
    for (int j = 0; j < 4; ++j) { const int n = (lane >> 3) + 8 * j; const LAS float* s = scr + (8 * c) * 33 + n;
        u32x4 o; o.x = cvt_pk_bf16(s[0 * 33], s[1 * 33]); o.y = cvt_pk_bf16(s[2 * 33], s[3 * 33]); o.z = cvt_pk_bf16(s[4 * 33], s[5 * 33]); o.w = cvt_pk_bf16(s[6 * 33], s[7 * 33]);
        *(u32x4*)(WT + (size_t)(drow0 + n) * K + k0 + 8 * c) = o; }
    LDS_WAIT();
}
__device__ __forceinline__ void wsc_item(const float* wq, const float* kk, bf16_t* out, int lane) {
    const int r = lane & 15, q = lane >> 4;
    f32x4 acc[8];
#pragma unroll
    for (int f = 0; f < 8; ++f) acc[f] = (f32x4){0.f, 0.f, 0.f, 0.f};
    const float* ap = kk + r * 128 + 4 * q; const float* bp = wq + (size_t)r * 2048 + 4 * q;
#pragma unroll 2
    for (int d0 = 0; d0 < 128; d0 += 16) {
        const f32x4 bv = *(const f32x4*)(bp + d0);
        f32x4 av[8];
#pragma unroll
        for (int f = 0; f < 8; ++f) av[f] = *(const f32x4*)(ap + f * 2048 + d0);
#pragma unroll
        for (int j = 0; j < 4; ++j)
#pragma unroll
            for (int f = 0; f < 8; ++f) acc[f] = __builtin_amdgcn_mfma_f32_16x16x4f32(av[f][j], bv[j], acc[f], 0, 0, 0);
    }
#pragma unroll
    for (int f = 0; f < 8; ++f)
#pragma unroll
        for (int i = 0; i < 4; ++i) out[(size_t)(16 * f + 4 * q + i) * 2048 + r] = (bf16_t)(cvt_pk_bf16(acc[f][i], 0.f) & 0xffffu);
}
__device__ __forceinline__ void ph_prologue(const Args& a, LAS unsigned char* lds, int gw, int ngw, int lane, int wave) {
    unsigned char* ws = a.ws;
    { const float* modp = (const float*)(ws + WS_MODP); float* mod = (float*)(ws + WS_MOD); const float* b_ada = a.in[I_BADA];
      for (int idx = gw * 64 + lane; idx < 2 * 12288; idx += ngw * 64) { const int b = idx / 12288, n = idx - b * 12288; float s = b_ada[n];
#pragma unroll 8
          for (int ks = 0; ks < 32; ++ks) s += modp[(size_t)(ks * 2 + b) * 12288 + n];
          mod[idx] = s; } }
    for (int item = gw; item < 2048; item += ngw) { const int hj = item >> 7, k0 = (item & 127) * 16;
        wsc_item(a.in[I_WQ] + (size_t)k0 * 2048 + hj * 128, (hj & 1) ? a.in[I_K2] : a.in[I_K1], (bf16_t*)(ws + WS_WSC) + (size_t)(hj * 128) * 2048 + k0, lane); }
    { LAS float* scr = (LAS float*)(lds + wave * 8448);
      constexpr int I_IN = 32 * 256, I_GLU = 16 * 128, I_ATT = 16 * 64, I_OUT = 32 * 64, NIT = I_IN + I_GLU + I_ATT + I_OUT;
      for (int it = gw; it < NIT; it += ngw) {
          int r = it;
          if (r < I_IN) { const int kb = r / 256, nb = r % 256; transpose_item_i8(a.in[I_WIN], (signed char*)(ws + WS_WIN), (const float*)(ws + WS_CMAXP), (float*)(ws + WS_SB), 32 * nb, 64 * kb, scr, lane); continue; } r -= I_IN;
          if (r < I_GLU) { const int kb = r / 128, nb = r % 128, dr = 32 * nb; const int sc = ((dr >> 7) & 1) * 2048 + (dr >> 8) * 128 + (dr & 127);
              transpose_item_f8(a.in[I_WGLU], 1024, 4096, ws + WS_WGLU, dr, sc, 64 * kb, scr, lane); continue; } r -= I_GLU;
          if (r < I_ATT) { const int kb = r / 64, nb = r % 64; transpose_item_f8(a.in[I_WATT], 1024, 2048, ws + WS_WATT, 32 * nb, 32 * nb, 64 * kb, scr, lane); continue; } r -= I_ATT;
          { const int kb = r / 64, nb = r % 64; transpose_item_f8(a.in[I_WOUT], 2048, 2048, ws + WS_WOUT, 32 * nb, 32 * nb, 64 * kb, scr, lane); }
      } }
}

template <bool I8>
__device__ __forceinline__ void ph_norm(const float* X, bf16_t* Hout, float* SA, const float* __restrict__ g, const float* mod, int sh_off, int sc_off, int gw, int ngw, int lane) {
    for (int row = gw; row < T_TOK; row += ngw) {
        const int b = row >> 13;
        const f32x4* xr = (const f32x4*)(X + (size_t)row * DM) + lane;
        f32x4 v[8]; float ss = 0.f;
#pragma unroll
        for (int j = 0; j < 8; ++j) { v[j] = xr[64 * j]; ss += (v[j][0] * v[j][0] + v[j][1] * v[j][1]) + (v[j][2] * v[j][2] + v[j][3] * v[j][3]); }
        ss = wave_sum(ss);
        const float rs = __builtin_amdgcn_rsqf(ss * (1.0f / DM) + EPS);
        const float* mb = mod + (size_t)b * 12288;
        float amax = 0.f;
#pragma unroll
        for (int j = 0; j < 8; ++j) { const int col = 4 * (lane + 64 * j);
            const f32x4 gv = *(const f32x4*)(g + col), sc = *(const f32x4*)(mb + sc_off + col), sh = *(const f32x4*)(mb + sh_off + col);
            const f32x4 o = v[j] * rs * gv * (sc + 1.0f) + sh;
            if (I8) { v[j] = o; amax = fmaxf(fmaxf(amax, fmaxf(fabsf(o[0]), fabsf(o[1]))), fmaxf(fabsf(o[2]), fabsf(o[3]))); }
            else { u32x2 w; w.x = cvt_pk_bf16(o[0], o[1]); w.y = cvt_pk_bf16(o[2], o[3]); *(u32x2*)(Hout + (size_t)row * DM + col) = w; } }
        if (I8) {
#pragma unroll
            for (int o = 1; o < 64; o <<= 1) amax = fmaxf(amax, __shfl_xor(amax, o));
            const float sa = fmaxf(amax, 1e-30f) * (1.0f / 127.0f), inv = 1.0f / sa;
            if (lane == 0) SA[row] = sa;
            unsigned* h8 = (unsigned*)((signed char*)Hout + (size_t)row * DM) + lane;
#pragma unroll
            for (int j = 0; j < 8; ++j) { unsigned w = 0;
#pragma unroll
                for (int e = 0; e < 4; ++e) { const int q = (int)rintf(v[j][e] * inv); w |= ((unsigned)q & 0xffu) << (8 * e); }
                h8[64 * j] = w; }
        }
    }
}

template <int MODE>
__device__ __forceinline__ void ph_attn(LAS unsigned char* lds, const bf16_t* PA, bf16_t* ATT, const float* __restrict__ qg, const float* __restrict__ kg, int G) {
    const int tid = opaque_tid(), lane = tid & 63, wave = __builtin_amdgcn_readfirstlane(tid >> 6), c = lane & 15, g = lane >> 4;
    LAS unsigned char* KL = lds;
    LAS unsigned char* VT = lds + 17408;
    bf16x8 tri[6];
    { const int FS[6] = {0, 1, 0, 1, 2, 3}, FP[6] = {0, 0, 1, 1, 1, 1};
#pragma unroll
      for (int q = 0; q < 6; ++q)
#pragma unroll
          for (int jj = 0; jj < 8; ++jj) { const int kap = 32 * FP[q] + 16 * (jj >> 2) + 4 * g + (jj & 3); tri[q][jj] = (kap > 16 * FS[q] + c) ? (short)0x3F80 : (short)0; } }
    for (int u = blockIdx.x; u < 1024; u += G) {
        const int b = u >> 9, h = (u >> 6) & 7, qb = u & 63, t0 = qb * 128, tq0 = t0 + 16 * wave, tq = tq0 + c;
        bf16x8 qf[4];
        { const bf16_t* qrow = PA + (size_t)(b * SEQ + tq) * 4096 + 1024 + h * 128;
          u32x4 qr[4]; float ss = 0.f;
#pragma unroll
          for (int kk = 0; kk < 4; ++kk) { qr[kk] = *(const u32x4*)(qrow + 32 * kk + 8 * g);
#pragma unroll
              for (int e = 0; e < 4; ++e) { const float lo = bf_lo(qr[kk][e]), hi = bf_hi(qr[kk][e]); ss += lo * lo + hi * hi; } }
          ss += __shfl_xor(ss, 16); ss += __shfl_xor(ss, 32);
          const float rs = __builtin_amdgcn_rsqf(ss * (1.0f / 128.0f) + EPS) * (0.08838834764831845f * 1.4426950408889634f);
#pragma unroll
          for (int kk = 0; kk < 4; ++kk) { const f32x4 g0 = *(const f32x4*)(qg + 32 * kk + 8 * g), g1 = *(const f32x4*)(qg + 32 * kk + 8 * g + 4);
              u32x4 w;
              w.x = cvt_pk_bf16(bf_lo(qr[kk].x) * rs * g0[0], bf_hi(qr[kk].x) * rs * g0[1]);
              w.y = cvt_pk_bf16(bf_lo(qr[kk].y) * rs * g0[2], bf_hi(qr[kk].y) * rs * g0[3]);
              w.z = cvt_pk_bf16(bf_lo(qr[kk].z) * rs * g1[0], bf_hi(qr[kk].z) * rs * g1[1]);
              w.w = cvt_pk_bf16(bf_lo(qr[kk].w) * rs * g1[2], bf_hi(qr[kk].w) * rs * g1[3]);
              qf[kk] = __builtin_bit_cast(bf16x8, w); } }
        float carry = 0.f; int wdone = 0;
        f32x4 oacc[8];
#pragma unroll
        for (int fd = 0; fd < 8; ++fd) oacc[fd] = (f32x4){0.f, 0.f, 0.f, 0.f};
        u32x4 kreg[2], vreg[2];
        { const int k0n = (2 * qb + 1) * 64;
#pragma unroll
          for (int p = 0; p < 2; ++p) { const int ci = tid + 512 * p, key = ci >> 4, ch = ci & 15;
              kreg[p] = *(const u32x4*)(PA + (size_t)(b * SEQ + k0n + key) * 4096 + 2048 + h * 128 + 8 * ch);
              vreg[p] = *(const u32x4*)(PA + (size_t)(b * SEQ + k0n + lane) * 4096 + 3072 + h * 128 + 8 * (wave + 8 * p)); } }
        for (int kt = 2 * qb + 1; kt >= 0; --kt) {
            const int k0 = kt * 64;
            if (__syncthreads_and(wdone)) break;
#pragma unroll
            for (int p = 0; p < 2; ++p) {
                const int ci = tid + 512 * p, key = ci >> 4, ch = ci & 15;
                const u32x4 kr = kreg[p];
                float f[8]; f[0] = bf_lo(kr.x); f[1] = bf_hi(kr.x); f[2] = bf_lo(kr.y); f[3] = bf_hi(kr.y); f[4] = bf_lo(kr.z); f[5] = bf_hi(kr.z); f[6] = bf_lo(kr.w); f[7] = bf_hi(kr.w);
                float ss = 0.f;
#pragma unroll
                for (int e = 0; e < 8; ++e) ss += f[e] * f[e];
                ss += __shfl_xor(ss, 1); ss += __shfl_xor(ss, 2); ss += __shfl_xor(ss, 4); ss += __shfl_xor(ss, 8);
                const float rs = __builtin_amdgcn_rsqf(ss * (1.0f / 128.0f) + EPS);
                const f32x4 g0 = *(const f32x4*)(kg + 8 * ch), g1 = *(const f32x4*)(kg + 8 * ch + 4);
                u32x4 w;
                w.x = cvt_pk_bf16(f[0] * rs * g0[0], f[1] * rs * g0[1]); w.y = cvt_pk_bf16(f[2] * rs * g0[2], f[3] * rs * g0[3]);
                w.z = cvt_pk_bf16(f[4] * rs * g1[0], f[5] * rs * g1[1]); w.w = cvt_pk_bf16(f[6] * rs * g1[2], f[7] * rs * g1[3]);
                *(LAS u32x4*)(KL + key * 272 + ch * 16) = w;
            }
#pragma unroll
            for (int p = 0; p < 2; ++p) {
                const int key = lane, ch = wave + 8 * p;
                const u32x4 vr = vreg[p];
                LAS unsigned short* vt = (LAS unsigned short*)(VT + (8 * ch) * 144 + key * 2);
                vt[0 * 72] = (unsigned short)(vr.x & 0xffffu); vt[1 * 72] = (unsigned short)(vr.x >> 16);
                vt[2 * 72] = (unsigned short)(vr.y & 0xffffu); vt[3 * 72] = (unsigned short)(vr.y >> 16);
                vt[4 * 72] = (unsigned short)(vr.z & 0xffffu); vt[5 * 72] = (unsigned short)(vr.z >> 16);
                vt[6 * 72] = (unsigned short)(vr.w & 0xffffu); vt[7 * 72] = (unsigned short)(vr.w >> 16);
            }
            if (kt > 0) { const int k0n = k0 - 64;
#pragma unroll
                for (int p = 0; p < 2; ++p) { const int ci = tid + 512 * p, key = ci >> 4, ch = ci & 15;
                    kreg[p] = *(const u32x4*)(PA + (size_t)(b * SEQ + k0n + key) * 4096 + 2048 + h * 128 + 8 * ch);
                    vreg[p] = *(const u32x4*)(PA + (size_t)(b * SEQ + k0n + lane) * 4096 + 3072 + h * 128 + 8 * (wave + 8 * p)); } }
            __syncthreads();
            if (MODE == 1) { if (kt <= 2 * qb - 3) wdone = 1; }
            if (MODE == 0 && !wdone && k0 < tq0 + 15) {
                f32x4 zt[4];
#pragma unroll
                for (int f = 0; f < 4; ++f) { f32x4 acc = {0.f, 0.f, 0.f, 0.f};
#pragma unroll
                    for (int kk = 0; kk < 4; ++kk) { const bf16x8 kf = *(const LAS bf16x8*)(KL + (16 * f + c) * 272 + (32 * kk + 8 * g) * 2);
                        acc = __builtin_amdgcn_mfma_f32_16x16x32_bf16(kf, qf[kk], acc, 0, 0, 0); }
                    zt[f] = acc; }
                float lf[4][4], lz[4][4]; float tot = 0.f;
                if (k0 + 63 >= tq0) {
#pragma unroll
                    for (int f = 0; f < 4; ++f)
#pragma unroll
                        for (int i = 0; i < 4; ++i) { const int s = k0 + 16 * f + 4 * g + i; const bool valid = s < tq; const float z = zt[f][i];
                            const float sp = fmaxf(z, 0.f) + __builtin_amdgcn_logf(1.0f + __builtin_amdgcn_exp2f(-fabsf(z)));
                            const float l = valid ? -sp : 0.f; lf[f][i] = l; lz[f][i] = valid ? (l + z) : -INFINITY; tot += l; }
                } else {
#pragma unroll
                    for (int f = 0; f < 4; ++f)
#pragma unroll
                        for (int i = 0; i < 4; ++i) { const float z = zt[f][i];
                            const float l = -(fmaxf(z, 0.f) + __builtin_amdgcn_logf(1.0f + __builtin_amdgcn_exp2f(-fabsf(z)))); lf[f][i] = l; lz[f][i] = l + z; tot += l; }
                }
                tot += __shfl_xor(tot, 16); tot += __shfl_xor(tot, 32);
                bf16x8 lh[2];
#pragma unroll
                for (int fp = 0; fp < 2; ++fp) { u32x4 wh;
#pragma unroll
                    for (int q = 0; q < 2; ++q) { const int f = 2 * fp + q; wh[2 * q] = cvt_pk_bf16(lf[f][0], lf[f][1]); wh[2 * q + 1] = cvt_pk_bf16(lf[f][2], lf[f][3]); }
                    lh[fp] = __builtin_bit_cast(bf16x8, wh); }
                f32x4 sf[4];
                { f32x4 z4 = {0.f, 0.f, 0.f, 0.f};
                  sf[0] = __builtin_amdgcn_mfma_f32_16x16x32_bf16(tri[0], lh[0], z4, 0, 0, 0); sf[0] = __builtin_amdgcn_mfma_f32_16x16x32_bf16(tri[2], lh[1], sf[0], 0, 0, 0);
                  sf[1] = __builtin_amdgcn_mfma_f32_16x16x32_bf16(tri[1], lh[0], z4, 0, 0, 0); sf[1] = __builtin_amdgcn_mfma_f32_16x16x32_bf16(tri[3], lh[1], sf[1], 0, 0, 0);
                  sf[2] = __builtin_amdgcn_mfma_f32_16x16x32_bf16(tri[4], lh[1], z4, 0, 0, 0);
                  sf[3] = __builtin_amdgcn_mfma_f32_16x16x32_bf16(tri[5], lh[1], z4, 0, 0, 0); }
                bf16x8 pb[2];
#pragma unroll
                for (int fp = 0; fp < 2; ++fp) { u32x4 w;
#pragma unroll
                    for (int q = 0; q < 2; ++q) { const int f = 2 * fp + q; float p[4];
#pragma unroll
                        for (int i = 0; i < 4; ++i) p[i] = __builtin_amdgcn_exp2f(lz[f][i] + sf[f][i] + carry);
                        w[2 * q] = cvt_pk_bf16(p[0], p[1]); w[2 * q + 1] = cvt_pk_bf16(p[2], p[3]); }
                    pb[fp] = __builtin_bit_cast(bf16x8, w); }
                carry += tot;
#pragma unroll
                for (int fd = 0; fd < 8; ++fd)
#pragma unroll
                    for (int fp = 0; fp < 2; ++fp) { const LAS unsigned char* vp = VT + (16 * fd + c) * 144 + (32 * fp + 4 * g) * 2;
                        const u32x2 v0 = *(const LAS u32x2*)vp, v1 = *(const LAS u32x2*)(vp + 32);
                        u32x4 vw; vw.x = v0.x; vw.y = v0.y; vw.z = v1.x; vw.w = v1.y;
                        oacc[fd] = __builtin_amdgcn_mfma_f32_16x16x32_bf16(__builtin_bit_cast(bf16x8, vw), pb[fp], oacc[fd], 0, 0, 0); }
                wdone = (__ballot(carry >= -152.0f) == 0ull) ? 1 : 0;
            }
        }
        if (MODE == 0) { unsigned char* orow = (unsigned char*)ATT + (size_t)(b * SEQ + tq) * 1024 + h * 128 + 4 * g;
#pragma unroll
          for (int fd = 0; fd < 8; ++fd) *(unsigned*)(orow + 16 * fd) = pack4_fp8(oacc[fd][0], oacc[fd][1], oacc[fd][2], oacc[fd][3], F8_SA); }
    }
    __syncthreads();
}

__device__ __forceinline__ void ssm_lambda(const Args& a, int g, int st, float& lbr, float& lbi, float& qr, float& qi) {
    const float lr = a.in[I_LRE][g * 64 + st], li = a.in[I_LIM][g * 64 + st], dt = __expf(a.in[I_LDT][g]);
    const float mag = __expf(lr * dt);
    float rev = li * dt * 0.15915494309189535f; rev -= rintf(rev);
    lbr = mag * __builtin_amdgcn_cosf(rev); lbi = mag * __builtin_amdgcn_sinf(rev);
    const float nr = lbr - 1.0f, ni = lbi, den = 1.0f / (lr * lr + li * li);
    qr = (nr * lr + ni * li) * den; qi = (ni * lr - nr * li) * den;
}
template <bool WITH_Y>
__device__ __forceinline__ void ph_ssm_mfma(const Args& a, LAS unsigned char* lds, const bf16_t* UB, f32x2* E, bf16_t* YA, int G) {
    const int tid = opaque_tid(), lane = tid & 63, wave = __builtin_amdgcn_readfirstlane(tid >> 6), c = lane & 15, gl = lane >> 4;
    LAS f32x2* sl = (LAS f32x2*)(lds + wave * 8192);
    LAS f32x4* tab = (LAS f32x4*)(lds + 65536 + wave * 1024);
    LAS u32x4* cml = (LAS u32x4*)(lds + 73728 + wave * 5120) + lane;
    for (int item = blockIdx.x; item < 128; item += G) {
        const int b = item >> 6, cb = (item >> 3) & 7, g = (item & 7) * 8 + wave, c0 = cb * 16;
        float mur, mui;
        { float lbr, lbi, qr, qi; ssm_lambda(a, g, lane, lbr, lbi, qr, qi); tab[lane] = (f32x4){lbr, lbi, qr, qi}; mur = lbr; mui = lbi; }
        LDS_WAIT();
        bf16x8 bm[8];
        const float* brb = a.in[I_BRE] + (g * 64 + (c >> 1)) * 16 + 8 * (gl & 1); const float* bib = a.in[I_BIM] + (g * 64 + (c >> 1)) * 16 + 8 * (gl & 1);
        const LAS f32x4* tabb = tab + (c >> 1);
#pragma unroll
        for (int f = 0; f < 8; ++f) { const f32x4 tv = tabb[8 * f]; const float qr = tv[2], qi = tv[3];
            const float* br = brb + 128 * f; const float* bim = bib + 128 * f;
            const f32x4 r0 = *(const f32x4*)br, r1 = *(const f32x4*)(br + 4), i0 = *(const f32x4*)bim, i1 = *(const f32x4*)(bim + 4);
            float v[8];
#pragma unroll
            for (int e = 0; e < 4; ++e) { const float vr0 = qr * r0[e] - qi * i0[e], vi0 = qr * i0[e] + qi * r0[e], vr1 = qr * r1[e] - qi * i1[e], vi1 = qr * i1[e] + qi * r1[e];
                v[e] = (c & 1) ? vi0 : vr0; v[4 + e] = (c & 1) ? vi1 : vr1; }
            if (gl >= 2) {
#pragma unroll
                for (int e = 0; e < 8; ++e) v[e] = 0.f; }
            u32x4 w; w.x = cvt_pk_bf16(v[0], v[1]); w.y = cvt_pk_bf16(v[2], v[3]); w.z = cvt_pk_bf16(v[4], v[5]); w.w = cvt_pk_bf16(v[6], v[7]);
            bm[f] = __builtin_bit_cast(bf16x8, w); }
        float lmr[16], lmi[16];
#pragma unroll
        for (int k = 0; k < 16; ++k) { const f32x4 tv = tab[2 * gl + 8 * (k >> 1) + (k & 1)]; lmr[k] = tv[0]; lmi[k] = tv[1]; }
        if (WITH_Y) {
            const float* crb = a.in[I_CRE] + (g * 16 + c) * 64 + 2 * gl; const float* cib = a.in[I_CIM] + (g * 16 + c) * 64 + 2 * gl;
#pragma unroll
            for (int kk = 0; kk < 4; ++kk) { float v[8];
#pragma unroll
                for (int jh = 0; jh < 2; ++jh) { const f32x2 r = *(const f32x2*)(crb + 8 * (2 * kk + jh)), m = *(const f32x2*)(cib + 8 * (2 * kk + jh));
                    v[4 * jh] = r.x; v[4 * jh + 1] = -m.x; v[4 * jh + 2] = r.y; v[4 * jh + 3] = -m.y; }
                u32x4 w; w.x = cvt_pk_bf16(v[0], v[1]); w.y = cvt_pk_bf16(v[2], v[3]); w.z = cvt_pk_bf16(v[4], v[5]); w.w = cvt_pk_bf16(v[6], v[7]);
                cml[64 * kk] = w; }
            { const float dv = a.in[I_SD][g * 16 + c]; float v[8];
#pragma unroll
              for (int jj = 0; jj < 8; ++jj) v[jj] = (gl < 2 && (8 * gl + jj) == c) ? dv : 0.f;
              u32x4 w; w.x = cvt_pk_bf16(v[0], v[1]); w.y = cvt_pk_bf16(v[2], v[3]); w.z = cvt_pk_bf16(v[4], v[5]); w.w = cvt_pk_bf16(v[6], v[7]);
              cml[256] = w; }
        }
        f32x4 s[8];
#pragma unroll
        for (int f = 0; f < 8; ++f) s[f] = (f32x4){0.f, 0.f, 0.f, 0.f};
        if (WITH_Y) {
            float pr = mur, pi = mui;
#pragma unroll
            for (int q = 0; q < 6; ++q) { const float nr = pr * pr - pi * pi, ni = 2.0f * pr * pi; pr = nr; pi = ni; }
            float sr = 0.f, si = 0.f;
            const f32x2* ep = E + (size_t)((b * 64 + g) * 128) * 64 + lane;
            f32x2 ev[8], en[8];
#pragma unroll
            for (int k = 0; k < 8; ++k) ev[k] = ep[(size_t)k * 64];
            for (int cc = 0; cc < c0 + 16; cc += 8) {
                if (cc + 8 < c0 + 16) {
#pragma unroll
                    for (int k = 0; k < 8; ++k) en[k] = ep[(size_t)(cc + 8 + k) * 64]; }
#pragma unroll
                for (int k = 0; k < 8; ++k) { if (cc >= c0) sl[(cc - c0 + k) * 64 + lane] = (f32x2){sr, si};
                    const float nr = pr * sr - pi * si + ev[k][0], ni = pr * si + pi * sr + ev[k][1]; sr = nr; si = ni; }
#pragma unroll
                for (int k = 0; k < 8; ++k) ev[k] = en[k];
            }
            LDS_WAIT();
#pragma unroll
            for (int f = 0; f < 8; ++f) s[f] = *(const LAS f32x4*)(sl + c * 64 + 8 * f + 2 * gl);
            LDS_WAIT();
        }
        const bf16_t* up = UB + ((size_t)(b * 64 + g) * 8192 + (size_t)(c0 + c) * 64) * 16 + 8 * (gl & 1);
        unsigned char* yp = (unsigned char*)YA + (size_t)(b * SEQ + (c0 + c) * 64) * 1024 + g * 16 + 4 * gl;
        u32x4 u0 = *(const u32x4*)(up), u1 = *(const u32x4*)(up + 16), u2 = *(const u32x4*)(up + 32), u3 = *(const u32x4*)(up + 48);
#pragma unroll 1
        for (int tau = 0; tau < 64; ++tau) {
            const u32x4 u4 = *(const u32x4*)(up + (size_t)(tau + 4) * 16);
            const bf16x8 uf = __builtin_bit_cast(bf16x8, u0);
#pragma unroll
            for (int f = 0; f < 8; ++f) { f32x4 ci;
                ci[0] = lmr[2 * f] * s[f][0] - lmi[2 * f] * s[f][1]; ci[1] = lmr[2 * f] * s[f][1] + lmi[2 * f] * s[f][0];
                ci[2] = lmr[2 * f + 1] * s[f][2] - lmi[2 * f + 1] * s[f][3]; ci[3] = lmr[2 * f + 1] * s[f][3] + lmi[2 * f + 1] * s[f][2];
                s[f] = __builtin_amdgcn_mfma_f32_16x16x32_bf16(bm[f], uf, ci, 0, 0, 0); }
            if (WITH_Y) {
                f32x4 y = __builtin_amdgcn_mfma_f32_16x16x32_bf16(__builtin_bit_cast(bf16x8, cml[256]), uf, (f32x4){0.f, 0.f, 0.f, 0.f}, 0, 0, 0);
#pragma unroll
                for (int kk = 0; kk < 4; ++kk) { u32x4 w; w.x = cvt_pk_bf16(s[2 * kk][0], s[2 * kk][1]); w.y = cvt_pk_bf16(s[2 * kk][2], s[2 * kk][3]);
                    w.z = cvt_pk_bf16(s[2 * kk + 1][0], s[2 * kk + 1][1]); w.w = cvt_pk_bf16(s[2 * kk + 1][2], s[2 * kk + 1][3]);
                    y = __builtin_amdgcn_mfma_f32_16x16x32_bf16(__builtin_bit_cast(bf16x8, cml[64 * kk]), __builtin_bit_cast(bf16x8, w), y, 0, 0, 0); }
                *(unsigned*)(yp + (size_t)tau * 1024) = pack4_fp8(gelu_tanh(y[0]), gelu_tanh(y[1]), gelu_tanh(y[2]), gelu_tanh(y[3]), F8_SA);
            }
            u0 = u1; u1 = u2; u2 = u3; u3 = u4;
        }
        if (!WITH_Y) { f32x2* eo = E + (size_t)((b * 64 + g) * 128 + c0 + c) * 64 + 2 * gl;
#pragma unroll
            for (int f = 0; f < 8; ++f) *(f32x4*)(eo + 8 * f) = s[f]; }
    }
}

typedef float f32x16 __attribute__((ext_vector_type(16)));
typedef float f32x32 __attribute__((ext_vector_type(32)));
typedef unsigned u32x6 __attribute__((ext_vector_type(6)));
constexpr float PEER_SU = 64.0f, PEER_SV = 1.4f;
constexpr size_t PEER_SHARD_BYTES = (size_t)16384 * 192;
__device__ __forceinline__ void table_cvt_pack(const f32x4 (&v)[8], float sc, unsigned char* dst, int lane) {
    f32x16 a, b;
#pragma unroll
    for (int q = 0; q < 4; ++q) {
#pragma unroll
        for (int e = 0; e < 4; ++e) { a[4 * q + e] = v[q][e] * sc; b[4 * q + e] = v[4 + q][e] * sc; } }
    const u32x6 p = __builtin_amdgcn_cvt_scalef32_2xpk16_fp6_f32(a, b, 1.0f);
    *(u32x4*)(dst + 16 * (lane & 7)) = (u32x4){p[0], p[1], p[2], p[3]};
    *(u32x2*)(dst + 128 + 8 * (lane & 7)) = (u32x2){p[4], p[5]};
}
__device__ __forceinline__ void ph_table_cvt(const float* __restrict__ U, const float* __restrict__ V, unsigned char* UT, unsigned char* VT, int r0, int r1, int gw, int ngw, int lane) {
    for (int r = r0 + gw; r < r1; r += ngw) {
        const float* su = U + (size_t)r * 2048 + 32 * lane; const float* sv = V + (size_t)r * 2048 + 32 * lane;
        f32x4 vu[8], vv[8];
#pragma unroll
        for (int q = 0; q < 8; ++q) vu[q] = *(const f32x4*)(su + 4 * q);
#pragma unroll
        for (int q = 0; q < 8; ++q) vv[q] = *(const f32x4*)(sv + 4 * q);
        const size_t off = (size_t)(lane >> 3) * PEER_SHARD_BYTES + (size_t)r * 192;
        table_cvt_pack(vu, PEER_SU, UT + off, lane);
        table_cvt_pack(vv, PEER_SV, VT + off, lane);
    }
}

#define TK_CE(a_, b_) do { const float _h = fmaxf(a_, b_), _l = fminf(a_, b_); a_ = _h; b_ = _l; } while (0)
__device__ __forceinline__ void tk_sort16(float (&a)[16]) {
#pragma unroll
    for (int p = 1; p < 16; p *= 2)
#pragma unroll
        for (int k = p; k >= 1; k /= 2)
#pragma unroll
            for (int j = k % p; j <= 15 - k; j += 2 * k)
#pragma unroll
                for (int i = 0; i < k; ++i)
                    if (i + j + k <= 15 && (i + j) / (2 * p) == (i + j + k) / (2 * p)) TK_CE(a[i + j], a[i + j + k]);
}
__device__ __forceinline__ void tk_merge16(float (&t)[16], const float (&g)[16]) {
#pragma unroll
    for (int i = 0; i < 16; ++i) t[i] = fmaxf(t[i], g[15 - i]);
#pragma unroll
    for (int k = 8; k >= 1; k /= 2)
#pragma unroll
        for (int i = 0; i < 16; ++i)
            if ((i & k) == 0) TK_CE(t[i], t[i + k]);
}
__device__ __forceinline__ float tk2_key(float a, float b, int flat) {
    const float sum = __uint_as_float(__float_as_uint(a) & ~127u) + __uint_as_float(__float_as_uint(b) & ~127u);
    return __uint_as_float((__float_as_uint(sum) & ~255u) | (unsigned)(255 - flat)); }
__device__ __forceinline__ void ph_peer_topk(LAS unsigned char* lds, const float* SC, int* idxG, float* gateG, int G) {
    const int tid = opaque_tid(), lane = tid & 63, wave = __builtin_amdgcn_readfirstlane(tid >> 6);
    LAS float* scr = (LAS float*)(lds + wave * 8448);
    for (int it = blockIdx.x; it < 512; it += G) {
        const int tokw = it * 32 + wave * 4;
        float tk[16];
#pragma unroll
        for (int i = 0; i < 16; ++i) tk[i] = -INFINITY;
        f32x4 nv[8];
#pragma unroll
        for (int j = 0; j < 8; ++j) { const int prob = (lane >> 3) + 8 * j, seg = lane & 7; nv[j] = *(const f32x4*)(SC + (size_t)(tokw + (prob >> 4)) * 2048 + (prob & 15) * 128 + 4 * seg); }
        for (int q = 0; q < 4; ++q) {
#pragma unroll
            for (int j = 0; j < 8; ++j) { const int prob = (lane >> 3) + 8 * j, seg = lane & 7; const f32x4 v = nv[j];
                LAS float* d = scr + prob * 33 + 4 * seg; d[0] = v[0]; d[1] = v[1]; d[2] = v[2]; d[3] = v[3]; }
            { const int qn = q < 3 ? q + 1 : 3;
#pragma unroll
              for (int j = 0; j < 8; ++j) { const int prob = (lane >> 3) + 8 * j, seg = lane & 7; nv[j] = *(const f32x4*)(SC + (size_t)(tokw + (prob >> 4)) * 2048 + (prob & 15) * 128 + 32 * qn + 4 * seg); } }
            LDS_WAIT();
#pragma unroll
            for (int hh = 0; hh < 2; ++hh) { float g[16];
#pragma unroll
                for (int i = 0; i < 16; ++i) g[i] = __uint_as_float((__float_as_uint(scr[lane * 33 + 16 * hh + i]) & ~127u) | (unsigned)(127 - (32 * q + 16 * hh + i)));
                tk_sort16(g); tk_merge16(tk, g); }
            LDS_WAIT();
        }
        float t2[16];
#pragma unroll
        for (int i = 0; i < 16; ++i) t2[i] = __shfl_xor(tk[i], 1);
        float bv[16];
        {
          bv[0] = tk2_key(tk[0], t2[0], 0);
          bv[1] = tk2_key(tk[0], t2[1], 1);
          bv[2] = tk2_key(tk[0], t2[2], 2);
          bv[3] = tk2_key(tk[0], t2[3], 3);
          bv[4] = tk2_key(tk[0], t2[4], 4);
          bv[5] = tk2_key(tk[0], t2[5], 5);
          bv[6] = tk2_key(tk[0], t2[6], 6);
          bv[7] = tk2_key(tk[0], t2[7], 7);
          bv[8] = tk2_key(tk[0], t2[8], 8);
          bv[9] = tk2_key(tk[0], t2[9], 9);
          bv[10] = tk2_key(tk[0], t2[10], 10);
          bv[11] = tk2_key(tk[0], t2[11], 11);
          bv[12] = tk2_key(tk[0], t2[12], 12);
          bv[13] = tk2_key(tk[0], t2[13], 13);
          bv[14] = tk2_key(tk[0], t2[14], 14);
          bv[15] = tk2_key(tk[0], t2[15], 15);
          tk_sort16(bv);
          { float g[16];
          g[0] = tk2_key(tk[1], t2[0], 16);
          g[1] = tk2_key(tk[1], t2[1], 17);
          g[2] = tk2_key(tk[1], t2[2], 18);
          g[3] = tk2_key(tk[1], t2[3], 19);
          g[4] = tk2_key(tk[1], t2[4], 20);
          g[5] = tk2_key(tk[1], t2[5], 21);
          g[6] = tk2_key(tk[1], t2[6], 22);
          g[7] = tk2_key(tk[1], t2[7], 23);
          g[8] = tk2_key(tk[2], t2[0], 32);
          g[9] = tk2_key(tk[2], t2[1], 33);
          g[10] = tk2_key(tk[2], t2[2], 34);
          g[11] = tk2_key(tk[2], t2[3], 35);
          g[12] = tk2_key(tk[2], t2[4], 36);
          g[13] = tk2_key(tk[3], t2[0], 48);
          g[14] = tk2_key(tk[3], t2[1], 49);
          g[15] = tk2_key(tk[3], t2[2], 50);
          tk_sort16(g); tk_merge16(bv, g); }
          { float g[16];
          g[0] = tk2_key(tk[3], t2[3], 51);
          g[1] = tk2_key(tk[4], t2[0], 64);
          g[2] = tk2_key(tk[4], t2[1], 65);
          g[3] = tk2_key(tk[4], t2[2], 66);
          g[4] = tk2_key(tk[5], t2[0], 80);
          g[5] = tk2_key(tk[5], t2[1], 81);
          g[6] = tk2_key(tk[6], t2[0], 96);
          g[7] = tk2_key(tk[6], t2[1], 97);
          g[8] = tk2_key(tk[7], t2[0], 112);
          g[9] = tk2_key(tk[7], t2[1], 113);
          g[10] = tk2_key(tk[8], t2[0], 128);
          g[11] = tk2_key(tk[9], t2[0], 144);
          g[12] = tk2_key(tk[10], t2[0], 160);
          g[13] = tk2_key(tk[11], t2[0], 176);
          g[14] = tk2_key(tk[12], t2[0], 192);
          g[15] = tk2_key(tk[13], t2[0], 208);
          tk_sort16(g); tk_merge16(bv, g); }
          { float x = tk2_key(tk[14], t2[0], 224);
#pragma unroll
            for (int i = 0; i < 16; ++i) { const float hi = fmaxf(bv[i], x); x = fminf(bv[i], x); bv[i] = hi; } }
          { float x = tk2_key(tk[15], t2[0], 240);
#pragma unroll
            for (int i = 0; i < 16; ++i) { const float hi = fmaxf(bv[i], x); x = fminf(bv[i], x); bv[i] = hi; } }
        }
        unsigned p1[4], p2[4];
#pragma unroll
        for (int j = 0; j < 4; ++j) { p1[j] = 0u; p2[j] = 0u;
#pragma unroll
            for (int e = 0; e < 4; ++e) { p1[j] |= (127u - (__float_as_uint(tk[4 * j + e]) & 127u)) << (8 * e); p2[j] |= (127u - (__float_as_uint(t2[4 * j + e]) & 127u)) << (8 * e); } }
        { float e[16], sum = 0.f; unsigned ex[16];
          const float top = __uint_as_float(__float_as_uint(bv[0]) & ~255u);
#pragma unroll
          for (int i = 0; i < 16; ++i) { const unsigned bits = __float_as_uint(bv[i]); const unsigned flat = 255u - (bits & 255u), aa = flat >> 4, bb = flat & 15u;
              const unsigned w1 = (aa >> 2) == 0u ? p1[0] : (aa >> 2) == 1u ? p1[1] : (aa >> 2) == 2u ? p1[2] : p1[3];
              const unsigned w2 = (bb >> 2) == 0u ? p2[0] : (bb >> 2) == 1u ? p2[1] : (bb >> 2) == 2u ? p2[2] : p2[3];
              ex[i] = (((w1 >> (8u * (aa & 3u))) & 127u) << 7) | ((w2 >> (8u * (bb & 3u))) & 127u);
              e[i] = __expf(__uint_as_float(bits & ~255u) - top); sum += e[i]; }
          const float inv = 1.0f / sum;
          if ((lane & 1) == 0) { const int tl = lane >> 4, head = (lane & 15) >> 1; const size_t o = (size_t)(tokw + tl) * 128 + 64 * (head >> 2);
#pragma unroll
              for (int i = 0; i < 16; ++i) { const int p = 8 * (i & 7) + ((2 * head + (i >> 3)) & 7); idxG[o + p] = (int)ex[i] * 192; gateG[o + p] = e[i] * inv; } } }
    }
}

#define PEER_ROWS(b4_, b2_, i8_) do { _Pragma("unroll") for (int gq = 0; gq < 8; ++gq) { const unsigned ro = (unsigned)(i8_)[gq];        \
        b4_[gq] = *(const u32x4*)(tab + (ro + 16u * (unsigned)c)); b2_[gq] = *(const u32x2*)(tab + (ro + 128u + 8u * (unsigned)c)); } } while (0)
#define PEER_LD8(dst_, p_) do { const u32x4 _a = *(const u32x4*)(p_), _b = *(const u32x4*)((p_) + 4); dst_[0] = (int)_a.x; dst_[1] = (int)_a.y; dst_[2] = (int)_a.z; dst_[3] = (int)_a.w; \
        dst_[4] = (int)_b.x; dst_[5] = (int)_b.y; dst_[6] = (int)_b.z; dst_[7] = (int)_b.w; } while (0)
__device__ __forceinline__ void ph_peer_u(const unsigned char* UT, const bf16_t* H2, const int* idxG, float* pdot, int G) {
    const int tid = opaque_tid(), lane = tid & 63, wave = __builtin_amdgcn_readfirstlane(tid >> 6), r = lane >> 3, c = lane & 7;
    const int shard = blockIdx.x & 7, ws = (blockIdx.x >> 3) * 8 + wave, nws = (G >> 3) * 8;
    const unsigned char* tab = UT + (size_t)shard * PEER_SHARD_BYTES;
    const bf16_t* hbase = H2 + 256 * shard + 32 * c;
    const int* ibase = idxG + 8 * r;
#define PEER_TOK(t_) (((t_) < T_TOK) ? (t_) : (T_TOK - 1))
    int ci[2][8], ni[2][8]; u32x4 cw[4], nw[4];
    { const int t0 = PEER_TOK(ws), t1 = PEER_TOK(ws + nws);
      PEER_LD8(ci[0], ibase + (size_t)t0 * 128); PEER_LD8(ci[1], ibase + (size_t)t0 * 128 + 64); PEER_LD8(ni[0], ibase + (size_t)t1 * 128); PEER_LD8(ni[1], ibase + (size_t)t1 * 128 + 64);
#pragma unroll
      for (int q = 0; q < 4; ++q) cw[q] = *(const u32x4*)(hbase + (size_t)t0 * 2048 + 8 * q); }
    u32x4 a4[8], b4[8]; u32x2 a2[8], b2[8];
    PEER_ROWS(a4, a2, ci[0]);
    for (int t = ws; t < T_TOK; t += nws) {
        PEER_ROWS(b4, b2, ci[1]);
        { const int t1 = PEER_TOK(t + nws);
#pragma unroll
          for (int q = 0; q < 4; ++q) nw[q] = *(const u32x4*)(hbase + (size_t)t1 * 2048 + 8 * q); }
        f32x2 ha[16];
        { const u32x4 w0 = cw[0], w1 = cw[1], w2 = cw[2], w3 = cw[3];
          ha[0] = (f32x2){bf_lo(w0.x), bf_lo(w2.x)}; ha[1] = (f32x2){bf_hi(w0.x), bf_hi(w2.x)}; ha[2] = (f32x2){bf_lo(w0.y), bf_lo(w2.y)}; ha[3] = (f32x2){bf_hi(w0.y), bf_hi(w2.y)};
          ha[4] = (f32x2){bf_lo(w0.z), bf_lo(w2.z)}; ha[5] = (f32x2){bf_hi(w0.z), bf_hi(w2.z)}; ha[6] = (f32x2){bf_lo(w0.w), bf_lo(w2.w)}; ha[7] = (f32x2){bf_hi(w0.w), bf_hi(w2.w)};
          ha[8] = (f32x2){bf_lo(w1.x), bf_lo(w3.x)}; ha[9] = (f32x2){bf_hi(w1.x), bf_hi(w3.x)}; ha[10] = (f32x2){bf_lo(w1.y), bf_lo(w3.y)}; ha[11] = (f32x2){bf_hi(w1.y), bf_hi(w3.y)};
          ha[12] = (f32x2){bf_lo(w1.z), bf_lo(w3.z)}; ha[13] = (f32x2){bf_hi(w1.z), bf_hi(w3.z)}; ha[14] = (f32x2){bf_lo(w1.w), bf_lo(w3.w)}; ha[15] = (f32x2){bf_hi(w1.w), bf_hi(w3.w)}; }
        float* po = pdot + ((size_t)shard * T_TOK + t) * 128 + lane;
#define PEER_UDOT(b4_, b2_, half_) do { float mine = 0.f; \
            _Pragma("unroll") for (int gq = 0; gq < 8; ++gq) { const u32x6 p6 = {b4_[gq].x, b4_[gq].y, b4_[gq].z, b4_[gq].w, b2_[gq].x, b2_[gq].y}; \
                const f32x32 uv = __builtin_amdgcn_cvt_scalef32_pk32_f32_fp6(p6, 1.0f); f32x2 s = {0.f, 0.f}; \
                _Pragma("unroll") for (int k = 0; k < 16; ++k) s = (f32x2){uv[2 * k], uv[2 * k + 1]} * ha[k] + s; \
                const float d = sum8_dpp(s.x + s.y); \
                mine = (gq == c) ? d : mine; __builtin_amdgcn_sched_barrier(0); } \
            po[64 * (half_)] = mine; } while (0)
        PEER_UDOT(a4, a2, 0);
        PEER_ROWS(a4, a2, ni[0]);
#pragma unroll
        for (int q = 0; q < 8; ++q) { ci[0][q] = ni[0][q]; ci[1][q] = ni[1][q]; }
        { const int t2 = PEER_TOK(t + 2 * nws); PEER_LD8(ni[0], ibase + (size_t)t2 * 128); PEER_LD8(ni[1], ibase + (size_t)t2 * 128 + 64); }
        PEER_UDOT(b4, b2, 1);
#pragma unroll
        for (int q = 0; q < 4; ++q) cw[q] = nw[q];
    }
#undef PEER_UDOT
}
__device__ __forceinline__ void ph_peer_act(const float* pdot, const float* gateG, float* actG, int G) {
    const size_t n = (size_t)T_TOK * 128, stride = (size_t)G * 512;
    for (size_t i = (size_t)blockIdx.x * 512 + threadIdx.x; i < n; i += stride) {
        float d = 0.f;
#pragma unroll
        for (int x = 0; x < 8; ++x) d += pdot[(size_t)x * n + i];
        actG[i] = gateG[i] * gelu_tanh(d * (1.0f / PEER_SU)) * (1.0f / PEER_SV);
    }
}
template <bool DRY>
__device__ __forceinline__ void ph_peer_v(LAS unsigned char* lds, const unsigned char* VT, const int* idxG, const float* actG, const float* mod, float* OUT, int G) {
    const int tid = opaque_tid(), lane = tid & 63, wave = __builtin_amdgcn_readfirstlane(tid >> 6), r = lane >> 3, c = lane & 7;
    const int shard = blockIdx.x & 7, ws = (blockIdx.x >> 3) * 8 + wave, nws = (G >> 3) * 8;
    const unsigned char* tab = VT + (size_t)shard * PEER_SHARD_BYTES;
    LAS float* red = (LAS float*)(lds + wave * 9216);
    const int* ibase = idxG + 8 * r; const int* abase = (const int*)actG + 8 * r;
    int ci[2][8], ni[2][8], ca[2][8], na[2][8]; f32x4 cx, nx;
    { const int t0 = PEER_TOK(ws), t1 = PEER_TOK(ws + nws);
      PEER_LD8(ci[0], ibase + (size_t)t0 * 128); PEER_LD8(ci[1], ibase + (size_t)t0 * 128 + 64); PEER_LD8(ni[0], ibase + (size_t)t1 * 128); PEER_LD8(ni[1], ibase + (size_t)t1 * 128 + 64);
      PEER_LD8(ca[0], abase + (size_t)t0 * 128); PEER_LD8(ca[1], abase + (size_t)t0 * 128 + 64);
      cx = *(const f32x4*)(OUT + (size_t)t0 * 2048 + 256 * shard + 4 * lane); }
    u32x4 a4[8], b4[8]; u32x2 a2[8], b2[8];
    PEER_ROWS(a4, a2, ci[0]);
    for (int t = ws; t < T_TOK; t += nws) {
        PEER_ROWS(b4, b2, ci[1]);
        { const int t1 = PEER_TOK(t + nws);
          PEER_LD8(na[0], abase + (size_t)t1 * 128); PEER_LD8(na[1], abase + (size_t)t1 * 128 + 64); nx = *(const f32x4*)(OUT + (size_t)t1 * 2048 + 256 * shard + 4 * lane); }
        f32x2 acc[16];
#pragma unroll
        for (int k = 0; k < 16; ++k) acc[k] = (f32x2){0.f, 0.f};
#define PEER_VACC(b4_, b2_, a8_) do { _Pragma("unroll") for (int gq = 0; gq < 8; ++gq) { const float ar = __int_as_float((a8_)[gq]); const f32x2 av2 = {ar, ar}; \
            const u32x6 p6 = {b4_[gq].x, b4_[gq].y, b4_[gq].z, b4_[gq].w, b2_[gq].x, b2_[gq].y}; const f32x32 vv = __builtin_amdgcn_cvt_scalef32_pk32_f32_fp6(p6, 1.0f); \
            _Pragma("unroll") for (int k = 0; k < 16; ++k) acc[k] = (f32x2){vv[2 * k], vv[2 * k + 1]} * av2 + acc[k]; __builtin_amdgcn_sched_barrier(0); } } while (0)
        PEER_VACC(a4, a2, ca[0]);
        PEER_ROWS(a4, a2, ni[0]);
#pragma unroll
        for (int q = 0; q < 8; ++q) { ci[0][q] = ni[0][q]; ci[1][q] = ni[1][q]; }
        { const int t2 = PEER_TOK(t + 2 * nws); PEER_LD8(ni[0], ibase + (size_t)t2 * 128); PEER_LD8(ni[1], ibase + (size_t)t2 * 128 + 64); }
        PEER_VACC(b4, b2, ca[1]);
        { LAS float* w = red + (r * 8 + c) * 36;
#pragma unroll
          for (int q = 0; q < 4; ++q) { *(LAS f32x4*)(w + 4 * q) = (f32x4){acc[4 * q].x, acc[4 * q + 1].x, acc[4 * q + 2].x, acc[4 * q + 3].x};
              *(LAS f32x4*)(w + 16 + 4 * q) = (f32x4){acc[4 * q].y, acc[4 * q + 1].y, acc[4 * q + 2].y, acc[4 * q + 3].y}; } }
        LDS_WAIT();
        { f32x4 s = {0.f, 0.f, 0.f, 0.f}; const LAS float* rd = red + (lane >> 3) * 36 + 4 * (lane & 7);
#pragma unroll
          for (int rr = 0; rr < 8; ++rr) s += *(const LAS f32x4*)(rd + rr * 288);
          const int b = t >> 13; const float* gt2 = mod + (size_t)b * 12288 + 10240 + 256 * shard + 4 * lane; float* op = OUT + (size_t)t * 2048 + 256 * shard + 4 * lane;
          const f32x4 g0 = *(const f32x4*)gt2;
          if (!DRY) *(f32x4*)op = cx + g0 * s; else asm volatile("" :: "v"(s), "v"(g0)); }
        LDS_WAIT();
#pragma unroll
        for (int q = 0; q < 8; ++q) { ca[0][q] = na[0][q]; ca[1][q] = na[1][q]; }
        cx = nx;
    }
#undef PEER_VACC
}
#undef PEER_ROWS
#undef PEER_LD8
#undef PEER_TOK

__global__ void __launch_bounds__(512, 2) mk_fwd(Args args) {
    extern __shared__ __attribute__((aligned(16))) unsigned char lds_raw[];
    LAS unsigned char* lds = (LAS unsigned char*)lds_raw;
    const int tid = threadIdx.x, lane = tid & 63, wave = __builtin_amdgcn_readfirstlane(tid >> 6);
    const int G = gridDim.x, gw = blockIdx.x * 8 + wave, ngw = G * 8;
    unsigned char* ws = args.ws;
    volatile LAS unsigned* misc = (volatile LAS unsigned*)(lds + LDS_MAIN);
    if (tid < 4) misc[tid] = 0u;
    __syncthreads();
    const int lo = args.ph_lo, hi = args.ph_hi;
    XcdBarrier bar; bar.bar = (unsigned*)(ws + WS_CTL); bar.x = 0; bar.st = misc;
    if (hi - lo > 1) bar = xcd_barrier_post((unsigned*)(ws + WS_CTL), misc);
#ifndef PHMASK
#define PHMASK 0x3fff
#endif
#define IN(k) (((PHMASK >> (k)) & 1) && lo <= (k) && (k) < hi)
#define SEAM(k) do { if (IN(k) && IN((k) + 1)) xcd_barrier(bar); } while (0)
    float* mod = (float*)(ws + WS_MOD);
    bf16_t* HB = (bf16_t*)(ws + WS_H); bf16_t* PA = (bf16_t*)(ws + WS_PA); bf16_t* PG = (bf16_t*)(ws + WS_PG);
    bf16_t* YA = (bf16_t*)(ws + WS_YA); bf16_t* ATT = (bf16_t*)(ws + WS_ATT); f32x2* EB = (f32x2*)(ws + WS_E); bf16_t* UBp = (bf16_t*)(ws + WS_UB);

#define PHS(code, ...) do { __VA_ARGS__ if (DUP == (code)) { xcd_barrier(bar); __VA_ARGS__ } } while (0)
#define PH(k, ...) do { if (IN(k)) { __VA_ARGS__ if (DUP == (k)) { xcd_barrier(bar); __VA_ARGS__ } } } while (0)
    PH(0, { ph_mod_partial(args.in[I_C], args.in[I_WADA], (float*)(ws + WS_MODP), gw, ngw, lane); ph_colmax_partial(args.in[I_WIN], (float*)(ws + WS_CMAXP), gw, ngw, lane); });
    SEAM(0);
    PH(1, { ph_prologue(args, lds, gw, ngw, lane, wave); });
    SEAM(1);
    PH(2, { ph_norm<true>(args.in[I_X], HB, (float*)(ws + WS_SA), args.in[I_N1G], mod, 0, 2048, gw, ngw, lane); });
    SEAM(2);
    PH(3, { pg8::Gemm g{HB, (const bf16_t*)(ws + WS_WIN), T_TOK, 8192, 1024}; pg8::StaticOrder S; S.init(T_TOK, 8192, G, (int)blockIdx.x);
        pg8::EpiProj E{PA, PG, UBp, (const float*)(ws + WS_SA), (const float*)(ws + WS_SB)}; pg8::gemm_phase<pg8::EpiProj, pg8::StaticOrder, true, true, 1>(lds, g, S, E); });
    SEAM(3);
    PH(4, { PHS(41, { ph_attn<0>(lds, PA, ATT, args.in[I_QNG], args.in[I_KNG], G); __syncthreads(); });
        if (DUP == 411) { xcd_barrier(bar); ph_attn<1>(lds, PA, ATT, args.in[I_QNG], args.in[I_KNG], G); __syncthreads(); } PHS(42, { ph_ssm_mfma<false>(args, lds, UBp, EB, YA, G); }); });
    SEAM(4);
    PH(5, { PHS(51, { ph_ssm_mfma<true>(args, lds, UBp, EB, YA, G); __syncthreads(); });
        PHS(52, { pg8::Gemm g{ATT, (const bf16_t*)(ws + WS_WATT), T_TOK, 2048, 512}; pg8::SplitOrder S; S.init(T_TOK, 2048, G, (int)blockIdx.x);
        pg8::EpiAttUp E{PG, HB}; pg8::gemm_phase<pg8::EpiAttUp, pg8::SplitOrder, true, true, 2>(lds, g, S, E); }); });
    SEAM(5);
    PH(6, { pg8::Gemm g{YA, (const bf16_t*)(ws + WS_WGLU), T_TOK, 4096, 512}; pg8::StaticOrder S; S.init(T_TOK, 4096, G, (int)blockIdx.x);
        pg8::EpiGlu E{PG, HB, (unsigned char*)ATT}; pg8::gemm_phase<pg8::EpiGlu, pg8::StaticOrder, true, true, 2>(lds, g, S, E); });
    SEAM(6);
    PH(7, { const bool split = (G == 256); const int gg = split ? 171 : G, ra = split ? 11264 : 0;
        if ((int)blockIdx.x < gg) { pg8::Gemm g{ATT, (const bf16_t*)(ws + WS_WOUT), T_TOK, 2048, 1024}; pg8::StaticOrder S; S.init(T_TOK, 2048, gg, (int)blockIdx.x);
            pg8::EpiOut E{args.in[I_X], args.out, mod}; pg8::gemm_phase<pg8::EpiOut, pg8::StaticOrder, true, true, 2>(lds, g, S, E); }
        else ph_table_cvt(args.in[I_PU], args.in[I_PV], ws + WS_UT, ws + WS_VT, 0, ra, ((int)blockIdx.x - gg) * 8 + wave, (G - gg) * 8, lane);
        ph_table_cvt(args.in[I_PU], args.in[I_PV], ws + WS_UT, ws + WS_VT, ra, 16384, gw, ngw, lane); });
    SEAM(7);
    PH(8, { ph_norm<false>(args.out, HB, nullptr, args.in[I_N2G], mod, 6144, 8192, gw, ngw, lane); });
    SEAM(8);
    PH(9, { pg8::Gemm g{HB, (const bf16_t*)(ws + WS_WSC), T_TOK, 2048, 2048}; pg8::StaticOrder S; S.init(T_TOK, 2048, G, (int)blockIdx.x);
        pg8::EpiF32 E{(float*)(ws + WS_SC)}; pg8::gemm_phase<pg8::EpiF32, pg8::StaticOrder, true, true>(lds, g, S, E); });
    SEAM(9);
    PH(10, { ph_peer_topk(lds, (const float*)(ws + WS_SC), (int*)(ws + WS_IDX), (float*)(ws + WS_GATE), G); });
    SEAM(10);
    PH(11, { ph_peer_u(ws + WS_UT, HB, (const int*)(ws + WS_IDX), (float*)(ws + WS_PDOT), G); });
    SEAM(11);
    PH(12, { ph_peer_act((const float*)(ws + WS_PDOT), (const float*)(ws + WS_GATE), (float*)(ws + WS_ACT), G); });
    SEAM(12);
    if (IN(13)) { if (DUP == 13) { ph_peer_v<true>(lds, ws + WS_VT, (const int*)(ws + WS_IDX), (const float*)(ws + WS_ACT), mod, args.out, G); xcd_barrier(bar); }
        ph_peer_v<false>(lds, ws + WS_VT, (const int*)(ws + WS_IDX), (const float*)(ws + WS_ACT), mod, args.out, G); }
#undef IN
#undef SEAM
}

extern "C" void kernel_launch(void* const* d_in, const int* in_sizes, int n_in, void* d_out, int out_size, void* d_ws, size_t ws_size, hipStream_t stream) {
    static int grid = 0;
    if (grid == 0) {
        if (n_in != 25 || out_size != T_TOK * DM || ws_size < WS_END) { fprintf(stderr, "kernel_launch: unexpected shapes (n_in %d out %d ws %zu need %zu)\n", n_in, out_size, ws_size, (size_t)WS_END); grid = -1; return; }
        int dev = 0, cus = 0, per_cu = 0;
        if (hipGetDevice(&dev) != hipSuccess || hipDeviceGetAttribute(&cus, hipDeviceAttributeMultiprocessorCount, dev) != hipSuccess) { grid = -1; return; }
        if (hipFuncSetAttribute((const void*)mk_fwd, hipFuncAttributeMaxDynamicSharedMemorySize, LDS_BYTES) != hipSuccess) { fprintf(stderr, "kernel_launch: hipFuncSetAttribute failed\n"); grid = -1; return; }
        if (hipOccupancyMaxActiveBlocksPerMultiprocessor(&per_cu, (const void*)mk_fwd, 512, LDS_BYTES) != hipSuccess || per_cu < 1) { fprintf(stderr, "kernel_launch: occupancy query says %d blocks/CU\n", per_cu); (void)hipGetLastError(); grid = -1; return; }
        grid = cus;
    }
    if (grid < 0) return;
    (void)hipMemsetAsync((char*)d_ws + WS_CTL, 0, 16384, stream);
    Args a{};
    for (int i = 0; i < 25; ++i) a.in[i] = (const float*)d_in[i];
    a.out = (float*)d_out; a.ws = (unsigned char*)d_ws;
#if MK_PER_PHASE
    for (int ph = 0; ph < NPHASE; ++ph) { a.ph_lo = ph; a.ph_hi = ph + 1; hipLaunchKernelGGL(mk_fwd, dim3(grid), dim3(512), LDS_BYTES, stream, a); }
#else
    a.ph_lo = 0; a.ph_hi = NPHASE;
    hipLaunchKernelGGL(mk_fwd, dim3(grid), dim3(512), LDS_BYTES, stream, a);
#endif
}
```

```cpp
#include <hip/hip_runtime.h>
#include <cstdio>
#include <cstdint>

#ifndef MK_PER_PHASE
#define MK_PER_PHASE 0
#endif

#ifndef DUP
#define DUP -1
#endif
#define LAS __attribute__((address_space(3)))
typedef unsigned short bf16_t;
typedef short bf16x8 __attribute__((ext_vector_type(8)));
typedef float f32x4 __attribute__((ext_vector_type(4)));
typedef float f32x2 __attribute__((ext_vector_type(2)));
typedef unsigned u32x4 __attribute__((ext_vector_type(4)));
typedef unsigned u32x2 __attribute__((ext_vector_type(2)));
typedef int i32x4 __attribute__((ext_vector_type(4)));

constexpr int T_TOK = 16384, DM = 2048, SEQ = 8192;
constexpr int NPHASE = 14;
constexpr float EPS = 1e-6f;

constexpr size_t WS_CTL   = 0;
constexpr size_t WS_MODP  = 65536;
constexpr size_t WS_MOD   = WS_MODP + (size_t)32 * 2 * 12288 * 4;
constexpr size_t WS_WIN   = WS_MOD + (size_t)2 * 12288 * 4;
constexpr size_t WS_WGLU  = WS_WIN + (size_t)8192 * 2048 * 2;
constexpr size_t WS_WATT  = WS_WGLU + (size_t)4096 * 1024 * 2;
constexpr size_t WS_WOUT  = WS_WATT + (size_t)2048 * 1024 * 2;
constexpr size_t WS_WSC   = WS_WOUT + (size_t)2048 * 2048 * 2;
constexpr size_t WS_H     = WS_WSC + (size_t)2048 * 2048 * 2;
constexpr size_t WS_PA    = WS_H + (size_t)T_TOK * 2048 * 2;
constexpr size_t WS_PG    = WS_PA + (size_t)T_TOK * 4096 * 2;
constexpr size_t WS_E     = WS_PG + (size_t)T_TOK * 4096 * 2;
constexpr size_t WS_YA    = WS_E + (size_t)2 * 64 * 128 * 64 * 8;
constexpr size_t WS_ATT   = WS_YA + (size_t)T_TOK * 1024 * 2;
constexpr size_t WS_UB    = WS_ATT + (size_t)T_TOK * 1024 * 2;
constexpr size_t WS_SA    = WS_UB + (size_t)T_TOK * 1024 * 2;
constexpr size_t WS_SB    = WS_SA + (size_t)T_TOK * 4;
constexpr size_t WS_CMAXP = WS_SB + (size_t)8192 * 4;
constexpr size_t WS_END   = WS_CMAXP + (size_t)32 * 8192 * 4;
constexpr size_t WS_SC    = WS_PA;
constexpr size_t WS_UT    = WS_PG;
constexpr size_t WS_VT    = WS_PG + (size_t)8 * 16384 * 192;
constexpr size_t WS_PDOT  = WS_VT + (size_t)8 * 16384 * 192;
constexpr size_t WS_IDX   = WS_YA;
constexpr size_t WS_GATE  = WS_YA + (size_t)T_TOK * 128 * 4;
constexpr size_t WS_ACT   = WS_GATE + (size_t)T_TOK * 128 * 4;
static_assert(WS_PDOT + (size_t)8 * T_TOK * 128 * 4 <= WS_PG + (size_t)T_TOK * 4096 * 2, "PEER buffers must fit the dead g_ssm|g_att region");
static_assert(WS_ACT + (size_t)T_TOK * 128 * 4 <= WS_YA + (size_t)T_TOK * 1024 * 2, "PEER index buffers must fit the dead YA region");
constexpr int LDS_MAIN = 131072, LDS_BYTES = LDS_MAIN + 256;

typedef __bf16 bf16x2_t __attribute__((ext_vector_type(2)));
__device__ __forceinline__ unsigned cvt_pk_bf16(float lo, float hi) { const f32x2 v = {lo, hi}; return __builtin_bit_cast(unsigned, __builtin_convertvector(v, bf16x2_t)); }
__device__ __forceinline__ float bf_lo(unsigned w) { return __uint_as_float(w << 16); }
__device__ __forceinline__ float bf_hi(unsigned w) { return __uint_as_float(w & 0xffff0000u); }
__device__ __forceinline__ float wave_sum(float v) {
#pragma unroll
    for (int o = 1; o < 64; o <<= 1) v += __shfl_xor(v, o);
    return v;
}
__device__ __forceinline__ float sigmoidf_(float x) { return __builtin_amdgcn_rcpf(1.0f + __builtin_amdgcn_exp2f(-1.4426950408889634f * x)); }
__device__ __forceinline__ float gelu_tanh(float x) {
    const float a2 = (-2.0f * 0.7978845608028654f * 1.4426950408889634f) * (x + 0.044715f * x * x * x);
    return x * __builtin_amdgcn_rcpf(1.0f + __builtin_amdgcn_exp2f(a2));
}
constexpr float F8_SA = 8.0f, F8_SW = 64.0f, F8_INV = 1.0f / 512.0f;
__device__ __forceinline__ unsigned pack4_fp8(float a, float b, float c, float d, float sc) {
    a = fminf(fmaxf(a * sc, -448.f), 448.f); b = fminf(fmaxf(b * sc, -448.f), 448.f); c = fminf(fmaxf(c * sc, -448.f), 448.f); d = fminf(fmaxf(d * sc, -448.f), 448.f);
    int p = 0; p = __builtin_amdgcn_cvt_pk_fp8_f32(a, b, p, false); p = __builtin_amdgcn_cvt_pk_fp8_f32(c, d, p, true); return (unsigned)p; }
__device__ __forceinline__ float sum8_dpp(float v) {
    v += __builtin_bit_cast(float, __builtin_amdgcn_update_dpp(0, __builtin_bit_cast(int, v), 0xB1, 0xF, 0xF, true));
    v += __builtin_bit_cast(float, __builtin_amdgcn_update_dpp(0, __builtin_bit_cast(int, v), 0x4E, 0xF, 0xF, true));
    v += __builtin_bit_cast(float, __builtin_amdgcn_update_dpp(0, __builtin_bit_cast(int, v), 0x141, 0xF, 0xF, true));
    return v; }
#define LDS_WAIT() asm volatile("s_waitcnt lgkmcnt(0)" ::: "memory")
__device__ __forceinline__ int opaque_tid() { int t = threadIdx.x; asm volatile("" : "+v"(t)); return t; }

#define XB_TMO      128
#define XB_XCNT(j)  (256  + 64 * (j))
#define XB_XSUB(j)  (1280 + 64 * (j))
#define XB_XGEN(j)  (2304 + 64 * (j))
#define XB_TOP      3328
#define XB_TOPGEN   3392
#define XCD_BAR_WORDS 3456
#define XB_SPIN_CAP (1u << 22)
__device__ __forceinline__ unsigned xb_ld(unsigned* p)              { return __hip_atomic_load(p, __ATOMIC_RELAXED, __HIP_MEMORY_SCOPE_AGENT); }
__device__ __forceinline__ unsigned xb_add(unsigned* p, unsigned v) { return __hip_atomic_fetch_add(p, v, __ATOMIC_RELAXED, __HIP_MEMORY_SCOPE_AGENT); }
__device__ __forceinline__ unsigned xb_xcc_id() { return (unsigned)__builtin_amdgcn_s_getreg((3 << 11) | 20) & 0xFu; }
#define XB_SPIN(cond, bar) do { unsigned _sp = 0; while (cond) { __builtin_amdgcn_s_sleep(1); \
    if ((++_sp & 255u) == 0u) { if (xb_ld(&(bar)[XB_TMO])) break; if (_sp > XB_SPIN_CAP) { atomicAdd(&(bar)[XB_TMO], 1u); break; } } } } while (0)
struct XcdBarrier { unsigned* bar; unsigned x; volatile LAS unsigned* st; };
__device__ __forceinline__ XcdBarrier xcd_barrier_post(unsigned* bar, volatile LAS unsigned* st) {
    XcdBarrier b; b.bar = bar; b.x = xb_xcc_id(); b.st = st;
    if (threadIdx.x == 0) (void)xb_add(&bar[XB_XCNT(b.x)], 1u);
    return b;
}
__device__ __forceinline__ void xcd_barrier_complete(unsigned* bar, unsigned x, unsigned& nloc, unsigned& nx) {
    const unsigned G = gridDim.x * gridDim.y * gridDim.z;
    unsigned sum, cnt, mine, sp = 0u;
    for (;;) {
        sum = 0u; cnt = 0u; mine = 0u;
#pragma unroll
        for (unsigned j = 0; j < 16; ++j) { const unsigned c = xb_ld(&bar[XB_XCNT(j)]); sum += c; cnt += (c > 0u) ? 1u : 0u; mine = (j == x) ? c : mine; }
        if (sum == G) break;
        __builtin_amdgcn_s_sleep(1);
        if ((++sp & 255u) == 0u) { if (xb_ld(&bar[XB_TMO])) break; if (sp > XB_SPIN_CAP) { atomicAdd(&bar[XB_TMO], 1u); break; } }
    }
    nloc = mine > 0u ? mine : 1u; nx = cnt > 0u ? cnt : 1u;
}
__device__ __forceinline__ void xcd_barrier(const XcdBarrier& b) {
    asm volatile("s_waitcnt vmcnt(0)" ::: "memory");
    __syncthreads();
    if (threadIdx.x == 0) {
        unsigned* bar = b.bar;
        __builtin_amdgcn_s_waitcnt(0);
        unsigned nloc = b.st[0], nx = b.st[1];
        if (nloc == 0u) { xcd_barrier_complete(bar, b.x, nloc, nx); b.st[0] = nloc; b.st[1] = nx; }
        const unsigned old = xb_add(&bar[XB_XSUB(b.x)], 1u);
        const unsigned gen = old / nloc;
        if (old + 1u == (gen + 1u) * nloc) {
            __builtin_amdgcn_fence(__ATOMIC_RELEASE, "agent");
            asm volatile("s_waitcnt vmcnt(0)" ::: "memory");
            const unsigned og = xb_add(&bar[XB_TOP], 1u);
            const unsigned tg = og / nx;
            if (og + 1u == (tg + 1u) * nx) xb_add(&bar[XB_TOPGEN], 1u);
            else XB_SPIN(xb_ld(&bar[XB_TOPGEN]) == tg, bar);
            __builtin_amdgcn_fence(__ATOMIC_ACQUIRE, "agent");
            xb_add(&bar[XB_XGEN(b.x)], 1u);
            asm volatile("s_waitcnt vmcnt(0)" ::: "memory");
        } else {
            XB_SPIN(xb_ld(&bar[XB_XGEN(b.x)]) == gen, bar);
            __builtin_amdgcn_fence(__ATOMIC_ACQUIRE, "agent");
            asm volatile("s_waitcnt vmcnt(0)" ::: "memory");
        }
    }
    __syncthreads();
}

namespace pg8 {
constexpr int BM = 256, BK = 64, HALF = 128, HTB = HALF * BK * 2, STAGE_BYTES = 8 * HTB, NXCD = 8, WGM = 8;
__host__ __device__ __forceinline__ int lds_byte(int r, int c) { const int st = (r >> 4) * 2 + (c >> 5), rr = r & 15, cc = c & 31, ob = rr * 64 + cc * 2; return st * 1024 + (ob ^ (((ob >> 9) & 1) << 5)); }
__host__ __device__ __forceinline__ void stage_rc(int b, int& R, int& C) { const int st = b / 1024, sb = b % 1024, swz = sb ^ (((sb >> 9) & 1) << 5); R = (st >> 1) * 16 + swz / 64; C = (st & 1) * 32 + (swz % 64) / 2; }
__host__ __device__ __forceinline__ int perm32(int rho) { const int n = rho >> 4, i = rho & 15; return 8 * (i >> 2) + 4 * n + (i & 3); }
struct Unit { int pm, pn; };
struct Gemm { const bf16_t* A; const bf16_t* Bt; int M, N, K; };
struct StaticOrder {
    int nM, nN, nwg, G, c;
    __host__ __device__ void init(int M, int N, int G_, int c_) { nM = M / BM; nN = N / BM; nwg = nM * nN; G = G_; c = c_; }
    __host__ __device__ bool next(int i, Unit& u) const { return at((long)i * G + c, u); }
    __host__ __device__ bool at(long L, Unit& u) const {
        if (L >= nwg) return false;
        int wgid = (int)L; { const int q = nwg / NXCD, r = nwg % NXCD, xcd = wgid % NXCD, off = wgid / NXCD; wgid = (xcd < r ? xcd * (q + 1) : r * (q + 1) + (xcd - r) * q) + off; }
        const int nig = WGM * nN, gid = wgid / nig, fm = gid * WGM, gsz = (nM - fm) < WGM ? (nM - fm) : WGM;
        u.pm = fm + ((wgid % nig) % gsz); u.pn = (wgid % nig) / gsz; return true;
    }
    __device__ __forceinline__ void a_ready(const Unit&) const {}
    __device__ __forceinline__ void done(const Unit&) const {}
};
struct SplitOrder {
    StaticOrder b;
    __host__ __device__ void init(int M, int N, int G_, int c_) { b.init(M, N, G_, c_); }
    __host__ __device__ bool next(int i, Unit& u) const {
        if (b.G != 256 || b.nwg != 512) return b.next(i, u);
        if (b.c < 128) return false;
        return i < 4 ? b.at((b.c - 128) * 4 + i, u) : false;
    }
    __device__ __forceinline__ void a_ready(const Unit&) const {}
    __device__ __forceinline__ void done(const Unit&) const {}
};
typedef int i32x8 __attribute__((ext_vector_type(8)));
template <class Epi, class Sched, bool ALIGN_EPI = false, bool SP2 = false, int MODE = 0>
__device__ __forceinline__ void gemm_phase(LAS unsigned char* lds, const Gemm g, const Sched& S, const Epi& E) {
    const int tid = threadIdx.x, wid = __builtin_amdgcn_readfirstlane(tid >> 6), lane = tid & 63, wr = wid >> 2, wc = wid & 3, fr = lane & 15, fq = lane >> 4;
    const int K = g.K, nt = K / BK;
    unsigned voffA[2], voffB[2];
#pragma unroll
    for (int i = 0; i < 2; ++i) { int R, C; stage_rc(tid * 16 + i * 8192, R, C); const int Rb = Epi::PERM ? ((R & ~31) + perm32(R & 31)) : R;
        voffA[i] = (unsigned)(R * K + C) * 2u; voffB[i] = (unsigned)(Rb * K + C) * 2u; }
    const size_t kstep = (size_t)(BK * 2);
    const size_t hstep = (size_t)HALF * K * 2;
    const size_t tstep = 2 * hstep;
    const unsigned ldsw = (unsigned)wid * 1024u;
    const int aoff = lds_byte(wr * 64 + fr, fq * 8), boff = lds_byte(wc * 32 + fr, fq * 8);
#define PG8_SA(b, h) (((b) * 2 + (h)) * HTB)
#define PG8_SB(b, h) ((4 + (b) * 2 + (h)) * HTB)
#define PG8_STAGE(bufoff, gbase, voff) do { _Pragma("unroll") for (int _i = 0; _i < 2; ++_i) \
        __builtin_amdgcn_global_load_lds((const unsigned*)((const char*)(gbase) + (voff)[_i]), (LAS unsigned*)(lds + (bufoff) + ldsw + _i * 8192), 16, 0, 0); } while (0)
#define PG8_LD8(p_) ({ const i32x4 _lo = *(const LAS i32x4*)(p_), _hi = *(const LAS i32x4*)((p_) + 1024); (i32x8){_lo[0], _lo[1], _lo[2], _lo[3], _hi[0], _hi[1], _hi[2], _hi[3]}; })
#define PG8_LDA(dst, b, h) do { _Pragma("unroll") for (int m = 0; m < 4; ++m) dst[m] = PG8_LD8(lds + PG8_SA(b, h) + aoff + m * 2048); } while (0)
#define PG8_LDB(dst, b, h) do { _Pragma("unroll") for (int n = 0; n < 2; ++n) dst[n] = PG8_LD8(lds + PG8_SB(b, h) + boff + n * 2048); } while (0)
#define PG8_HALF(v, k) ((k) == 0 ? __builtin_shufflevector(v, v, 0, 1, 2, 3) : __builtin_shufflevector(v, v, 4, 5, 6, 7))
#define PG8_MMA(ai, bj, At, Bt) do { __builtin_amdgcn_s_setprio(1); _Pragma("unroll") for (int m = 0; m < 4; ++m) _Pragma("unroll") for (int n = 0; n < 2; ++n) { \
        if (MODE == 2) asm volatile("v_mfma_scale_f32_16x16x128_f8f6f4 %0, %1, %2, %0, %3, %3 op_sel_hi:[0,0,0]" : "+v"(acc[ai][bj][m][n]) : "v"(Bt[n]), "v"(At[m]), "v"(scl1)); \
        else { _Pragma("unroll") for (int k = 0; k < 2; ++k) \
            acc[ai][bj][m][n] = (MODE == 1) ? __builtin_bit_cast(f32x4, __builtin_amdgcn_mfma_i32_16x16x64_i8(PG8_HALF(Bt[n], k), PG8_HALF(At[m], k), __builtin_bit_cast(i32x4, acc[ai][bj][m][n]), 0, 0, 0)) \
                                            : __builtin_amdgcn_mfma_f32_16x16x32_bf16(__builtin_bit_cast(bf16x8, PG8_HALF(Bt[n], k)), __builtin_bit_cast(bf16x8, PG8_HALF(At[m], k)), acc[ai][bj][m][n], 0, 0, 0); } } __builtin_amdgcn_s_setprio(0); } while (0)
#define PG8_WAIT_V(n) asm volatile("s_waitcnt vmcnt(" #n ")" ::: "memory")
#define PG8_WAIT_L(n) asm volatile("s_waitcnt lgkmcnt(" #n ")" ::: "memory")
#define PG8_BAR __builtin_amdgcn_s_barrier()
#define PG8_SCHED __builtin_amdgcn_sched_barrier(0)
    const int scl1 = 0x7f7f7f7f;
    Unit cur, nxt; int ui = 0;
    if (!S.next(0, cur)) return;
    f32x4 acc[2][2][4][2];
#pragma unroll
    for (int a = 0; a < 2; ++a)
#pragma unroll
        for (int b = 0; b < 2; ++b)
#pragma unroll
            for (int m = 0; m < 4; ++m)
#pragma unroll
                for (int n = 0; n < 2; ++n) acc[a][b][m][n] = (f32x4){0.f, 0.f, 0.f, 0.f};
    i32x8 At[4], B0[2], B1[2];
    const char* cA = (const char*)g.A + (size_t)cur.pm * tstep; const char* cB = (const char*)g.Bt + (size_t)cur.pn * tstep;
    S.a_ready(cur);
    if constexpr (SP2) {
        PG8_STAGE(PG8_SB(0, 0), cB, voffB); PG8_STAGE(PG8_SB(0, 1), cB + hstep, voffB); PG8_STAGE(PG8_SA(0, 0), cA, voffA); PG8_STAGE(PG8_SA(0, 1), cA + hstep, voffA);
        if (wr == 1) PG8_BAR;
        PG8_WAIT_V(2); PG8_BAR;
        PG8_STAGE(PG8_SB(1, 0), cB + kstep, voffB); PG8_STAGE(PG8_SA(1, 0), cA + kstep, voffA); PG8_STAGE(PG8_SB(1, 1), cB + hstep + kstep, voffB);
        PG8_WAIT_V(6); PG8_BAR;
    } else {
        PG8_STAGE(PG8_SB(0, 0), cB, voffB); PG8_STAGE(PG8_SA(0, 0), cA, voffA); PG8_STAGE(PG8_SB(0, 1), cB + hstep, voffB); PG8_STAGE(PG8_SA(0, 1), cA + hstep, voffA);
        if (wr == 1) PG8_BAR;
        PG8_WAIT_V(4); PG8_BAR;
        PG8_STAGE(PG8_SB(1, 0), cB + kstep, voffB); PG8_STAGE(PG8_SA(1, 0), cA + kstep, voffA); PG8_STAGE(PG8_SB(1, 1), cB + hstep + kstep, voffB);
        PG8_WAIT_V(6); PG8_BAR;
    }
    for (;;) {
        const bool has_next = S.next(ui + 1, nxt);
        const char* nA = has_next ? (const char*)g.A + (size_t)nxt.pm * tstep : cA; const char* nB = has_next ? (const char*)g.Bt + (size_t)nxt.pn * tstep : cB;
#pragma unroll 1
        for (int t = 0; t < nt; t += 2) {
            const bool last = (t == nt - 2);
            const char* a1 = cA + (size_t)(t + 1) * kstep;
            const char* a2 = last ? nA : cA + (size_t)(t + 2) * kstep; const char* b2 = last ? nB : cB + (size_t)(t + 2) * kstep;
            const char* a3 = a2 + kstep; const char* b3 = b2 + kstep;
            if (last && has_next) S.a_ready(nxt);
            if constexpr (SP2) {
            PG8_LDB(B0, 0, 0); PG8_LDB(B1, 0, 1); PG8_SCHED; PG8_LDA(At, 0, 0); PG8_STAGE(PG8_SA(1, 1), a1 + hstep, voffA);
            PG8_WAIT_V(8); PG8_WAIT_L(0); PG8_BAR; PG8_MMA(0, 0, At, B0); PG8_MMA(0, 1, At, B1); PG8_BAR; PG8_SCHED;
            PG8_LDA(At, 0, 1); PG8_STAGE(PG8_SB(0, 0), b2, voffB); PG8_STAGE(PG8_SB(0, 1), b2 + hstep, voffB); PG8_STAGE(PG8_SA(0, 0), a2, voffA);
            PG8_WAIT_V(8); PG8_WAIT_L(0); PG8_BAR; PG8_MMA(1, 0, At, B0); PG8_MMA(1, 1, At, B1); PG8_BAR; PG8_SCHED;
            PG8_LDB(B0, 1, 0); PG8_LDB(B1, 1, 1); PG8_SCHED; PG8_LDA(At, 1, 0); PG8_STAGE(PG8_SA(0, 1), a2 + hstep, voffA);
            PG8_WAIT_V(8); PG8_WAIT_L(0); PG8_BAR; PG8_MMA(0, 0, At, B0); PG8_MMA(0, 1, At, B1); PG8_BAR; PG8_SCHED;
            PG8_LDA(At, 1, 1); PG8_STAGE(PG8_SB(1, 0), b3, voffB); PG8_STAGE(PG8_SB(1, 1), b3 + hstep, voffB); PG8_STAGE(PG8_SA(1, 0), a3, voffA);
            PG8_WAIT_V(8); PG8_WAIT_L(0); PG8_BAR; PG8_MMA(1, 0, At, B0); PG8_MMA(1, 1, At, B1); PG8_BAR; PG8_SCHED;
            } else {
            PG8_LDB(B0, 0, 0); PG8_SCHED; PG8_LDA(At, 0, 0); PG8_STAGE(PG8_SA(1, 1), a1 + hstep, voffA);
            PG8_WAIT_L(8); PG8_BAR; PG8_WAIT_L(0); PG8_MMA(0, 0, At, B0); PG8_BAR; PG8_SCHED;
            PG8_LDB(B1, 0, 1); PG8_STAGE(PG8_SB(0, 0), b2, voffB);
            PG8_BAR; PG8_WAIT_L(0); PG8_MMA(0, 1, At, B1); PG8_BAR;
            PG8_LDA(At, 0, 1); PG8_STAGE(PG8_SA(0, 0), a2, voffA);
            PG8_BAR; PG8_WAIT_L(0); PG8_MMA(1, 0, At, B0); PG8_BAR; PG8_SCHED;
            PG8_STAGE(PG8_SB(0, 1), b2 + hstep, voffB);
            PG8_WAIT_V(6); PG8_BAR; PG8_MMA(1, 1, At, B1); PG8_BAR;
            PG8_LDB(B0, 1, 0); PG8_SCHED; PG8_LDA(At, 1, 0); PG8_STAGE(PG8_SA(0, 1), a2 + hstep, voffA);
            PG8_WAIT_L(8); PG8_BAR; PG8_WAIT_L(0); PG8_MMA(0, 0, At, B0); PG8_BAR; PG8_SCHED;
            PG8_LDB(B1, 1, 1); PG8_STAGE(PG8_SB(1, 0), b3, voffB);
            PG8_BAR; PG8_WAIT_L(0); PG8_MMA(0, 1, At, B1); PG8_BAR;
            PG8_LDA(At, 1, 1); PG8_STAGE(PG8_SA(1, 0), a3, voffA);
            PG8_BAR; PG8_WAIT_L(0); PG8_MMA(1, 0, At, B0); PG8_BAR; PG8_SCHED;
            PG8_STAGE(PG8_SB(1, 1), b3 + hstep, voffB);
            PG8_WAIT_V(6); PG8_BAR; PG8_MMA(1, 1, At, B1); PG8_BAR;
            }
        }
        if constexpr (ALIGN_EPI) { if (wr == 0) PG8_BAR; }
        if (MODE == 2) asm volatile("s_nop 15\n\ts_nop 15" ::: "memory");
        E(acc, cur, wr, wc, fr, fq); S.done(cur);
        if (!has_next) break;
#pragma unroll
        for (int a = 0; a < 2; ++a)
#pragma unroll
            for (int b = 0; b < 2; ++b)
#pragma unroll
                for (int m = 0; m < 4; ++m)
#pragma unroll
                    for (int n = 0; n < 2; ++n) acc[a][b][m][n] = (f32x4){0.f, 0.f, 0.f, 0.f};
        cur = nxt; cA = nA; cB = nB; ++ui;
        if constexpr (ALIGN_EPI) { if (wr == 1) PG8_BAR; }
    }
    PG8_WAIT_V(0);
    if constexpr (!ALIGN_EPI) { if (wr == 0) PG8_BAR; }
    PG8_BAR;
#undef PG8_SA
#undef PG8_SB
#undef PG8_STAGE
#undef PG8_LDA
#undef PG8_LDB
#undef PG8_MMA
#undef PG8_WAIT_V
#undef PG8_WAIT_L
#undef PG8_BAR
#undef PG8_SCHED
}

struct EpiProj {
    static constexpr bool PERM = true;
    bf16_t* PA; bf16_t* PG; bf16_t* UB; const float* SA; const float* SB;
    __device__ __forceinline__ void operator()(const f32x4 (&acc)[2][2][4][2], const Unit& u, int wr, int wc, int fr, int fq) const {
        const int row0 = u.pm * BM + wr * 64 + fr; int colt = u.pn * BM; const bool isu = colt < 1024; bf16_t* base = colt < 4096 ? PA : PG;
        const int gcol0 = colt + wc * 32 + 8 * fq; colt &= 4095;
        const int col0 = colt + wc * 32 + 8 * fq;
        f32x4 sb[2][2];
#pragma unroll
        for (int bj = 0; bj < 2; ++bj) { sb[bj][0] = *(const f32x4*)(SB + gcol0 + bj * HALF); sb[bj][1] = *(const f32x4*)(SB + gcol0 + bj * HALF + 4); }
#pragma unroll
        for (int ai = 0; ai < 2; ++ai)
#pragma unroll
            for (int m = 0; m < 4; ++m) { const int row = row0 + ai * HALF + m * 16; bf16_t* rowp = base + (size_t)row * 4096 + col0; const float sa = SA[row];
#pragma unroll
                for (int bj = 0; bj < 2; ++bj) { const i32x4 i0 = __builtin_bit_cast(i32x4, acc[ai][bj][m][0]), i1 = __builtin_bit_cast(i32x4, acc[ai][bj][m][1]);
                    f32x4 v0, v1;
#pragma unroll
                    for (int e = 0; e < 4; ++e) { v0[e] = (float)i0[e] * sa * sb[bj][0][e]; v1[e] = (float)i1[e] * sa * sb[bj][1][e]; }
                    u32x4 w; w.x = cvt_pk_bf16(v0[0], v0[1]); w.y = cvt_pk_bf16(v0[2], v0[3]); w.z = cvt_pk_bf16(v1[0], v1[1]); w.w = cvt_pk_bf16(v1[2], v1[3]);
                    if (isu) { const int cu = col0 + bj * HALF; *(u32x4*)(UB + (((size_t)((row >> 13) * 64 + (cu >> 4)) * 8192 + (row & 8191)) * 16 + (cu & 8))) = w; }
                    else *(u32x4*)(rowp + bj * HALF) = w; } }
    }
};
struct EpiAttUp {
    static constexpr bool PERM = true;
    const bf16_t* PG; bf16_t* HB;
    __device__ __forceinline__ void operator()(const f32x4 (&acc)[2][2][4][2], const Unit& u, int wr, int wc, int fr, int fq) const {
        const int row0 = u.pm * BM + wr * 64 + fr; const int col0 = u.pn * BM + wc * 32 + 8 * fq;
#pragma unroll
        for (int ai = 0; ai < 2; ++ai)
#pragma unroll
            for (int m = 0; m < 4; ++m) { const size_t row = (size_t)(row0 + ai * HALF + m * 16);
#pragma unroll
                for (int bj = 0; bj < 2; ++bj) { const int col = col0 + bj * HALF;
                    const u32x4 gw = *(const u32x4*)(PG + row * 4096 + 2048 + col);
                    const f32x4 v0 = acc[ai][bj][m][0] * F8_INV, v1 = acc[ai][bj][m][1] * F8_INV;
                    u32x4 w;
                    w.x = cvt_pk_bf16(v0[0] * sigmoidf_(bf_lo(gw.x)), v0[1] * sigmoidf_(bf_hi(gw.x)));
                    w.y = cvt_pk_bf16(v0[2] * sigmoidf_(bf_lo(gw.y)), v0[3] * sigmoidf_(bf_hi(gw.y)));
                    w.z = cvt_pk_bf16(v1[0] * sigmoidf_(bf_lo(gw.z)), v1[1] * sigmoidf_(bf_hi(gw.z)));
                    w.w = cvt_pk_bf16(v1[2] * sigmoidf_(bf_lo(gw.w)), v1[3] * sigmoidf_(bf_hi(gw.w)));
                    *(u32x4*)(HB + row * 2048 + col) = w; } asm volatile("" ::: "memory"); }
    }
};
struct EpiGlu {
    static constexpr bool PERM = true;
    const bf16_t* PG; const bf16_t* HB; unsigned char* M8;
    __device__ __forceinline__ void operator()(const f32x4 (&acc)[2][2][4][2], const Unit& u, int wr, int wc, int fr, int fq) const {
        const int row0 = u.pm * BM + wr * 64 + fr; const int col = u.pn * HALF + wc * 32 + 8 * fq;
#pragma unroll
        for (int ai = 0; ai < 2; ++ai)
#pragma unroll
            for (int m = 0; m < 4; ++m) { const size_t row = (size_t)(row0 + ai * HALF + m * 16);
                const u32x4 gw = *(const u32x4*)(PG + row * 4096 + col);
                const u32x4 aw = *(const u32x4*)(HB + row * 2048 + col);
                const f32x4 a0 = acc[ai][0][m][0] * F8_INV, a1 = acc[ai][0][m][1] * F8_INV, g0 = acc[ai][1][m][0] * F8_INV, g1 = acc[ai][1][m][1] * F8_INV;
                u32x2 w;
                w.x = pack4_fp8(sigmoidf_(bf_lo(gw.x)) * a0[0] * sigmoidf_(g0[0]) + bf_lo(aw.x), sigmoidf_(bf_hi(gw.x)) * a0[1] * sigmoidf_(g0[1]) + bf_hi(aw.x),
                                sigmoidf_(bf_lo(gw.y)) * a0[2] * sigmoidf_(g0[2]) + bf_lo(aw.y), sigmoidf_(bf_hi(gw.y)) * a0[3] * sigmoidf_(g0[3]) + bf_hi(aw.y), F8_SA);
                w.y = pack4_fp8(sigmoidf_(bf_lo(gw.z)) * a1[0] * sigmoidf_(g1[0]) + bf_lo(aw.z), sigmoidf_(bf_hi(gw.z)) * a1[1] * sigmoidf_(g1[1]) + bf_hi(aw.z),
                                sigmoidf_(bf_lo(gw.w)) * a1[2] * sigmoidf_(g1[2]) + bf_lo(aw.w), sigmoidf_(bf_hi(gw.w)) * a1[3] * sigmoidf_(g1[3]) + bf_hi(aw.w), F8_SA);
                *(u32x2*)(M8 + row * 2048 + col) = w; asm volatile("" ::: "memory"); }
    }
};
struct EpiOut {
    static constexpr bool PERM = true;
    const float* X; float* O; const float* mod;
    __device__ __forceinline__ void operator()(const f32x4 (&acc)[2][2][4][2], const Unit& u, int wr, int wc, int fr, int fq) const {
        const int row0 = u.pm * BM + wr * 64 + fr; const int col0 = u.pn * BM + wc * 32 + 8 * fq;
        const float* gt = mod + (size_t)((u.pm * BM) >> 13) * 12288 + 4096;
#pragma unroll
        for (int bj = 0; bj < 2; ++bj) { const int col = col0 + bj * HALF;
            const f32x4 g0 = *(const f32x4*)(gt + col), g1 = *(const f32x4*)(gt + col + 4);
#pragma unroll
            for (int ai = 0; ai < 2; ++ai)
#pragma unroll
                for (int m = 0; m < 4; ++m) { const size_t off = (size_t)(row0 + ai * HALF + m * 16) * 2048 + col;
                    const f32x4 x0 = *(const f32x4*)(X + off), x1 = *(const f32x4*)(X + off + 4);
                    *(f32x4*)(O + off) = x0 + g0 * (acc[ai][bj][m][0] * F8_INV); *(f32x4*)(O + off + 4) = x1 + g1 * (acc[ai][bj][m][1] * F8_INV); } }
    }
};
struct EpiF32 {
    static constexpr bool PERM = true;
    float* O;
    __device__ __forceinline__ void operator()(const f32x4 (&acc)[2][2][4][2], const Unit& u, int wr, int wc, int fr, int fq) const {
        const int row0 = u.pm * BM + wr * 64 + fr; const int col0 = u.pn * BM + wc * 32 + 8 * fq;
#pragma unroll
        for (int ai = 0; ai < 2; ++ai)
#pragma unroll
            for (int m = 0; m < 4; ++m) { float* rowp = O + (size_t)(row0 + ai * HALF + m * 16) * 2048 + col0;
#pragma unroll
                for (int bj = 0; bj < 2; ++bj) { *(f32x4*)(rowp + bj * HALF) = acc[ai][bj][m][0]; *(f32x4*)(rowp + bj * HALF + 4) = acc[ai][bj][m][1]; } }
    }
};
}

struct Args { const float* in[25]; float* out; unsigned char* ws; int ph_lo, ph_hi; };
enum { I_X = 0, I_C, I_WADA, I_BADA, I_N1G, I_WIN, I_LRE, I_LIM, I_LDT, I_BRE, I_BIM, I_CRE, I_CIM, I_SD, I_WGLU, I_QNG, I_KNG, I_WATT, I_WOUT, I_N2G, I_WQ, I_K1, I_K2, I_PU, I_PV };

__device__ __forceinline__ void ph_mod_partial(const float* __restrict__ c, const float* __restrict__ w_ada, float* modp, int gw, int ngw, int lane) {
    for (int task = gw; task < 48 * 32; task += ngw) {
        const int strip = task % 48, ks = task / 48, n0 = strip * 256 + lane * 4, k0 = ks * 64;
        f32x4 a0 = {0.f, 0.f, 0.f, 0.f}, a1 = {0.f, 0.f, 0.f, 0.f};
#pragma unroll 8
        for (int k = 0; k < 64; ++k) {
            const f32x4 w = *(const f32x4*)(w_ada + (size_t)(k0 + k) * 12288 + n0);
            float c0 = c[k0 + k], c1 = c[2048 + k0 + k];
            c0 = c0 / (1.0f + __expf(-c0)); c1 = c1 / (1.0f + __expf(-c1));
            a0 += c0 * w; a1 += c1 * w;
        }
        *(f32x4*)(modp + (size_t)(ks * 2 + 0) * 12288 + n0) = a0;
        *(f32x4*)(modp + (size_t)(ks * 2 + 1) * 12288 + n0) = a1;
    }
}

__device__ __forceinline__ void ph_colmax_partial(const float* __restrict__ w_in, float* cmaxp, int gw, int ngw, int lane) {
    for (int task = gw; task < 32 * 32; task += ngw) {
        const int strip = task & 31, ks = task >> 5, n0 = strip * 256 + lane * 4, k0 = ks * 64;
        f32x4 m = {0.f, 0.f, 0.f, 0.f};
#pragma unroll 8
        for (int k = 0; k < 64; ++k) { const f32x4 w = *(const f32x4*)(w_in + (size_t)(k0 + k) * 8192 + n0);
            m[0] = fmaxf(m[0], fabsf(w[0])); m[1] = fmaxf(m[1], fabsf(w[1])); m[2] = fmaxf(m[2], fabsf(w[2])); m[3] = fmaxf(m[3], fabsf(w[3])); }
        *(f32x4*)(cmaxp + (size_t)ks * 8192 + n0) = m;
    }
}

__device__ __forceinline__ void transpose_item_f8(const float* __restrict__ W, int K, int N, unsigned char* WT8, int drow0, int scol0, int k0, LAS float* scr, int lane) {
#pragma unroll 8
    for (int i = 0; i < 32; ++i) { const int kk = 2 * i + (lane >> 5); scr[kk * 33 + (lane & 31)] = W[(size_t)(k0 + kk) * N + scol0 + (lane & 31)]; }
    LDS_WAIT();
    const int n = lane >> 1, half = lane & 1;
    const LAS float* s = scr + (32 * half) * 33 + n;
    u32x4 o[2];
#pragma unroll
    for (int q = 0; q < 8; ++q) o[q >> 2][q & 3] = pack4_fp8(s[(4 * q) * 33], s[(4 * q + 1) * 33], s[(4 * q + 2) * 33], s[(4 * q + 3) * 33], F8_SW);
    *(u32x4*)(WT8 + (size_t)(drow0 + n) * K + k0 + 32 * half) = o[0];
    *(u32x4*)(WT8 + (size_t)(drow0 + n) * K + k0 + 32 * half + 16) = o[1];
    LDS_WAIT();
}
__device__ __forceinline__ void transpose_item_i8(const float* __restrict__ W, signed char* WT8, const float* cmaxp, float* SB, int n0, int k0, LAS float* scr, int lane) {
#pragma unroll 8
    for (int i = 0; i < 32; ++i) { const int kk = 2 * i + (lane >> 5); scr[kk * 33 + (lane & 31)] = W[(size_t)(k0 + kk) * 8192 + n0 + (lane & 31)]; }
    const int n = lane >> 1, half = lane & 1;
    float cm = 0.f;
#pragma unroll 8
    for (int ks = 0; ks < 32; ++ks) cm = fmaxf(cm, cmaxp[(size_t)ks * 8192 + n0 + n]);
    const float sb = fmaxf(cm, 1e-30f) * (1.0f / 127.0f), inv = 1.0f / sb;
    if (k0 == 0 && half == 0) SB[n0 + n] = sb;
    LDS_WAIT();
    const LAS float* s = scr + (32 * half) * 33 + n;
    u32x4 o[2];
#pragma unroll
    for (int q = 0; q < 8; ++q) { unsigned w = 0;
#pragma unroll
        for (int e = 0; e < 4; ++e) { const int v = (int)rintf(s[(4 * q + e) * 33] * inv); w |= ((unsigned)v & 0xffu) << (8 * e); }
        o[q >> 2][q & 3] = w; }
    *(u32x4*)(WT8 + (size_t)(n0 + n) * 2048 + k0 + 32 * half) = o[0];
    *(u32x4*)(WT8 + (size_t)(n0 + n) * 2048 + k0 + 32 * half + 16) = o[1];
    LDS_WAIT();
}

__device__ __forceinline__ void transpose_item(const float* __restrict__ W, int K, int N, bf16_t* WT, int drow0, int scol0, int k0, LAS float* scr, int lane) {
#pragma unroll 8
    for (int i = 0; i < 32; ++i) { const int kk = 2 * i + (lane >> 5); scr[kk * 33 + (lane & 31)] = W[(size_t)(k0 + kk) * N + scol0 + (lane & 31)]; }
    LDS_WAIT();
    const int c = lane & 7;
#pragma unroll
    for (int j = 0; j < 4; ++j) { const int n = (lane >> 3) + 8 * j; const LAS float* s = scr + (8 * c) * 33 + n;
        u32x4 o; o.x = cvt_pk_bf16(s[0 * 33], s[1 * 33]); o.y = cvt_pk_bf16(s[2 * 33], s[3 * 33]); o.z = cvt_pk_bf16(s[4 * 33], s[5 * 33]); o.w = cvt_pk_bf16(s[6 * 33], s[7 * 33]);
        *(u32x4*)(WT + (size_t)(drow0 + n) * K + k0 + 8 * c) = o; }
    LDS_WAIT();
}
__device__ __forceinline__ void wsc_item(const float* wq, const float* kk, bf16_t* out, int lane) {
    const int r = lane & 15, q = lane >> 4;
    f32x4 acc[8];
#pragma unroll
    for (int f = 0; f < 8; ++f) acc[f] = (f32x4){0.f, 0.f, 0.f, 0.f};
    const float* ap = kk + r * 128 + 4 * q; const float* bp = wq + (size_t)r * 2048 + 4 * q;
#pragma unroll 2
    for (int d0 = 0; d0 < 128; d0 += 16) {
        const f32x4 bv = *(const f32x4*)(bp + d0);
        f32x4 av[8];
#pragma unroll
        for (int f = 0; f < 8; ++f) av[f] = *(const f32x4*)(ap + f * 2048 + d0);
#pragma unroll
        for (int j = 0; j < 4; ++j)
#pragma unroll
            for (int f = 0; f < 8; ++f) acc[f] = __builtin_amdgcn_mfma_f32_16x16x4f32(av[f][j], bv[j], acc[f], 0, 0, 0);
    }
#pragma unroll
    for (int f = 0; f < 8; ++f)
#pragma unroll
        for (int i = 0; i < 4; ++i) out[(size_t)(16 * f + 4 * q + i) * 2048 + r] = (bf16_t)(cvt_pk_bf16(acc[f][i], 0.f) & 0xffffu);
}
__device__ __forceinline__ void ph_prologue(const Args& a, LAS unsigned char* lds, int gw, int ngw, int lane, int wave) {
    unsigned char* ws = a.ws;
    { const float* modp = (const float*)(ws + WS_MODP); float* mod = (float*)(ws + WS_MOD); const float* b_ada = a.in[I_BADA];
      for (int idx = gw * 64 + lane; idx < 2 * 12288; idx += ngw * 64) { const int b = idx / 12288, n = idx - b * 12288; float s = b_ada[n];
#pragma unroll 8
          for (int ks = 0; ks < 32; ++ks) s += modp[(size_t)(ks * 2 + b) * 12288 + n];
          mod[idx] = s; } }
    for (int item = gw; item < 2048; item += ngw) { const int hj = item >> 7, k0 = (item & 127) * 16;
        wsc_item(a.in[I_WQ] + (size_t)k0 * 2048 + hj * 128, (hj & 1) ? a.in[I_K2] : a.in[I_K1], (bf16_t*)(ws + WS_WSC) + (size_t)(hj * 128) * 2048 + k0, lane); }
    { LAS float* scr = (LAS float*)(lds + wave * 8448);
      constexpr int I_IN = 32 * 256, I_GLU = 16 * 128, I_ATT = 16 * 64, I_OUT = 32 * 64, NIT = I_IN + I_GLU + I_ATT + I_OUT;
      for (int it = gw; it < NIT; it += ngw) {
          int r = it;
          if (r < I_IN) { const int kb = r / 256, nb = r % 256; transpose_item_i8(a.in[I_WIN], (signed char*)(ws + WS_WIN), (const float*)(ws + WS_CMAXP), (float*)(ws + WS_SB), 32 * nb, 64 * kb, scr, lane); continue; } r -= I_IN;
          if (r < I_GLU) { const int kb = r / 128, nb = r % 128, dr = 32 * nb; const int sc = ((dr >> 7) & 1) * 2048 + (dr >> 8) * 128 + (dr & 127);
              transpose_item_f8(a.in[I_WGLU], 1024, 4096, ws + WS_WGLU, dr, sc, 64 * kb, scr, lane); continue; } r -= I_GLU;
          if (r < I_ATT) { const int kb = r / 64, nb = r % 64; transpose_item_f8(a.in[I_WATT], 1024, 2048, ws + WS_WATT, 32 * nb, 32 * nb, 64 * kb, scr, lane); continue; } r -= I_ATT;
          { const int kb = r / 64, nb = r % 64; transpose_item_f8(a.in[I_WOUT], 2048, 2048, ws + WS_WOUT, 32 * nb, 32 * nb, 64 * kb, scr, lane); }
      } }
}

template <bool I8>
__device__ __forceinline__ void ph_norm(const float* X, bf16_t* Hout, float* SA, const float* __restrict__ g, const float* mod, int sh_off, int sc_off, int gw, int ngw, int lane) {
    for (int row = gw; row < T_TOK; row += ngw) {
        const int b = row >> 13;
        const f32x4* xr = (const f32x4*)(X + (size_t)row * DM) + lane;
        f32x4 v[8]; float ss = 0.f;
#pragma unroll
        for (int j = 0; j < 8; ++j) { v[j] = xr[64 * j]; ss += (v[j][0] * v[j][0] + v[j][1] * v[j][1]) + (v[j][2] * v[j][2] + v[j][3] * v[j][3]); }
        ss = wave_sum(ss);
        const float rs = __builtin_amdgcn_rsqf(ss * (1.0f / DM) + EPS);
        const float* mb = mod + (size_t)b * 12288;
        float amax = 0.f;
#pragma unroll
        for (int j = 0; j < 8; ++j) { const int col = 4 * (lane + 64 * j);
            const f32x4 gv = *(const f32x4*)(g + col), sc = *(const f32x4*)(mb + sc_off + col), sh = *(const f32x4*)(mb + sh_off + col);
            const f32x4 o = v[j] * rs * gv * (sc + 1.0f) + sh;
            if (I8) { v[j] = o; amax = fmaxf(fmaxf(amax, fmaxf(fabsf(o[0]), fabsf(o[1]))), fmaxf(fabsf(o[2]), fabsf(o[3]))); }
            else { u32x2 w; w.x = cvt_pk_bf16(o[0], o[1]); w.y = cvt_pk_bf16(o[2], o[3]); *(u32x2*)(Hout + (size_t)row * DM + col) = w; } }
        if (I8) {
#pragma unroll
            for (int o = 1; o < 64; o <<= 1) amax = fmaxf(amax, __shfl_xor(amax, o));
            const float sa = fmaxf(amax, 1e-30f) * (1.0f / 127.0f), inv = 1.0f / sa;
            if (lane == 0) SA[row] = sa;
            unsigned* h8 = (unsigned*)((signed char*)Hout + (size_t)row * DM) + lane;
#pragma unroll
            for (int j = 0; j < 8; ++j) { unsigned w = 0;
#pragma unroll
                for (int e = 0; e < 4; ++e) { const int q = (int)rintf(v[j][e] * inv); w |= ((unsigned)q & 0xffu) << (8 * e); }
                h8[64 * j] = w; }
        }
    }
}

template <int MODE>
__device__ __forceinline__ void ph_attn(LAS unsigned char* lds, const bf16_t* PA, bf16_t* ATT, const float* __restrict__ qg, const float* __restrict__ kg, int G) {
    const int tid = opaque_tid(), lane = tid & 63, wave = __builtin_amdgcn_readfirstlane(tid >> 6), c = lane & 15, g = lane >> 4;
    LAS unsigned char* KL = lds;
    LAS unsigned char* VT = lds + 17408;
    bf16x8 tri[6];
    { const int FS[6] = {0, 1, 0, 1, 2, 3}, FP[6] = {0, 0, 1, 1, 1, 1};
#pragma unroll
      for (int q = 0; q < 6; ++q)
#pragma unroll
          for (int jj = 0; jj < 8; ++jj) { const int kap = 32 * FP[q] + 16 * (jj >> 2) + 4 * g + (jj & 3); tri[q][jj] = (kap > 16 * FS[q] + c) ? (short)0x3F80 : (short)0; } }
    for (int u = blockIdx.x; u < 1024; u += G) {
        const int b = u >> 9, h = (u >> 6) & 7, qb = u & 63, t0 = qb * 128, tq0 = t0 + 16 * wave, tq = tq0 + c;
        bf16x8 qf[4];
        { const bf16_t* qrow = PA + (size_t)(b * SEQ + tq) * 4096 + 1024 + h * 128;
          u32x4 qr[4]; float ss = 0.f;
#pragma unroll
          for (int kk = 0; kk < 4; ++kk) { qr[kk] = *(const u32x4*)(qrow + 32 * kk + 8 * g);
#pragma unroll
              for (int e = 0; e < 4; ++e) { const float lo = bf_lo(qr[kk][e]), hi = bf_hi(qr[kk][e]); ss += lo * lo + hi * hi; } }
          ss += __shfl_xor(ss, 16); ss += __shfl_xor(ss, 32);
          const float rs = __builtin_amdgcn_rsqf(ss * (1.0f / 128.0f) + EPS) * (0.08838834764831845f * 1.4426950408889634f);
#pragma unroll
          for (int kk = 0; kk < 4; ++kk) { const f32x4 g0 = *(const f32x4*)(qg + 32 * kk + 8 * g), g1 = *(const f32x4*)(qg + 32 * kk + 8 * g + 4);
              u32x4 w;
              w.x = cvt_pk_bf16(bf_lo(qr[kk].x) * rs * g0[0], bf_hi(qr[kk].x) * rs * g0[1]);
              w.y = cvt_pk_bf16(bf_lo(qr[kk].y) * rs * g0[2], bf_hi(qr[kk].y) * rs * g0[3]);
              w.z = cvt_pk_bf16(bf_lo(qr[kk].z) * rs * g1[0], bf_hi(qr[kk].z) * rs * g1[1]);
              w.w = cvt_pk_bf16(bf_lo(qr[kk].w) * rs * g1[2], bf_hi(qr[kk].w) * rs * g1[3]);
              qf[kk] = __builtin_bit_cast(bf16x8, w); } }
        float carry = 0.f; int wdone = 0;
        f32x4 oacc[8];
#pragma unroll
        for (int fd = 0; fd < 8; ++fd) oacc[fd] = (f32x4){0.f, 0.f, 0.f, 0.f};
        u32x4 kreg[2], vreg[2];
        { const int k0n = (2 * qb + 1) * 64;
#pragma unroll
          for (int p = 0; p < 2; ++p) { const int ci = tid + 512 * p, key = ci >> 4, ch = ci & 15;
              kreg[p] = *(const u32x4*)(PA + (size_t)(b * SEQ + k0n + key) * 4096 + 2048 + h * 128 + 8 * ch);
              vreg[p] = *(const u32x4*)(PA + (size_t)(b * SEQ + k0n + lane) * 4096 + 3072 + h * 128 + 8 * (wave + 8 * p)); } }
        for (int kt = 2 * qb + 1; kt >= 0; --kt) {
            const int k0 = kt * 64;
            if (__syncthreads_and(wdone)) break;
#pragma unroll
            for (int p = 0; p < 2; ++p) {
                const int ci = tid + 512 * p, key = ci >> 4, ch = ci & 15;
                const u32x4 kr = kreg[p];
                float f[8]; f[0] = bf_lo(kr.x); f[1] = bf_hi(kr.x); f[2] = bf_lo(kr.y); f[3] = bf_hi(kr.y); f[4] = bf_lo(kr.z); f[5] = bf_hi(kr.z); f[6] = bf_lo(kr.w); f[7] = bf_hi(kr.w);
                float ss = 0.f;
#pragma unroll
                for (int e = 0; e < 8; ++e) ss += f[e] * f[e];
                ss += __shfl_xor(ss, 1); ss += __shfl_xor(ss, 2); ss += __shfl_xor(ss, 4); ss += __shfl_xor(ss, 8);
                const float rs = __builtin_amdgcn_rsqf(ss * (1.0f / 128.0f) + EPS);
                const f32x4 g0 = *(const f32x4*)(kg + 8 * ch), g1 = *(const f32x4*)(kg + 8 * ch + 4);
                u32x4 w;
                w.x = cvt_pk_bf16(f[0] * rs * g0[0], f[1] * rs * g0[1]); w.y = cvt_pk_bf16(f[2] * rs * g0[2], f[3] * rs * g0[3]);
                w.z = cvt_pk_bf16(f[4] * rs * g1[0], f[5] * rs * g1[1]); w.w = cvt_pk_bf16(f[6] * rs * g1[2], f[7] * rs * g1[3]);
                *(LAS u32x4*)(KL + key * 272 + ch * 16) = w;
            }
#pragma unroll
            for (int p = 0; p < 2; ++p) {
                const int key = lane, ch = wave + 8 * p;
                const u32x4 vr = vreg[p];
                LAS unsigned short* vt = (LAS unsigned short*)(VT + (8 * ch) * 144 + key * 2);
                vt[0 * 72] = (unsigned short)(vr.x & 0xffffu); vt[1 * 72] = (unsigned short)(vr.x >> 16);
                vt[2 * 72] = (unsigned short)(vr.y & 0xffffu); vt[3 * 72] = (unsigned short)(vr.y >> 16);
                vt[4 * 72] = (unsigned short)(vr.z & 0xffffu); vt[5 * 72] = (unsigned short)(vr.z >> 16);
                vt[6 * 72] = (unsigned short)(vr.w & 0xffffu); vt[7 * 72] = (unsigned short)(vr.w >> 16);
            }
            if (kt > 0) { const int k0n = k0 - 64;
#pragma unroll
                for (int p = 0; p < 2; ++p) { const int ci = tid + 512 * p, key = ci >> 4, ch = ci & 15;
                    kreg[p] = *(const u32x4*)(PA + (size_t)(b * SEQ + k0n + key) * 4096 + 2048 + h * 128 + 8 * ch);
                    vreg[p] = *(const u32x4*)(PA + (size_t)(b * SEQ + k0n + lane) * 4096 + 3072 + h * 128 + 8 * (wave + 8 * p)); } }
            __syncthreads();
            if (MODE == 1) { if (kt <= 2 * qb - 3) wdone = 1; }
            if (MODE == 0 && !wdone && k0 < tq0 + 15) {
                f32x4 zt[4];
#pragma unroll
                for (int f = 0; f < 4; ++f) { f32x4 acc = {0.f, 0.f, 0.f, 0.f};
#pragma unroll
                    for (int kk = 0; kk < 4; ++kk) { const bf16x8 kf = *(const LAS bf16x8*)(KL + (16 * f + c) * 272 + (32 * kk + 8 * g) * 2);
                        acc = __builtin_amdgcn_mfma_f32_16x16x32_bf16(kf, qf[kk], acc, 0, 0, 0); }
                    zt[f] = acc; }
                float lf[4][4], lz[4][4]; float tot = 0.f;
                if (k0 + 63 >= tq0) {
#pragma unroll
                    for (int f = 0; f < 4; ++f)
#pragma unroll
                        for (int i = 0; i < 4; ++i) { const int s = k0 + 16 * f + 4 * g + i; const bool valid = s < tq; const float z = zt[f][i];
                            const float sp = fmaxf(z, 0.f) + __builtin_amdgcn_logf(1.0f + __builtin_amdgcn_exp2f(-fabsf(z)));
                            const float l = valid ? -sp : 0.f; lf[f][i] = l; lz[f][i] = valid ? (l + z) : -INFINITY; tot += l; }
                } else {
#pragma unroll
                    for (int f = 0; f < 4; ++f)
#pragma unroll
                        for (int i = 0; i < 4; ++i) { const float z = zt[f][i];
                            const float l = -(fmaxf(z, 0.f) + __builtin_amdgcn_logf(1.0f + __builtin_amdgcn_exp2f(-fabsf(z)))); lf[f][i] = l; lz[f][i] = l + z; tot += l; }
                }
                tot += __shfl_xor(tot, 16); tot += __shfl_xor(tot, 32);
                bf16x8 lh[2];
#pragma unroll
                for (int fp = 0; fp < 2; ++fp) { u32x4 wh;
#pragma unroll
                    for (int q = 0; q < 2; ++q) { const int f = 2 * fp + q; wh[2 * q] = cvt_pk_bf16(lf[f][0], lf[f][1]); wh[2 * q + 1] = cvt_pk_bf16(lf[f][2], lf[f][3]); }
                    lh[fp] = __builtin_bit_cast(bf16x8, wh); }
                f32x4 sf[4];
                { f32x4 z4 = {0.f, 0.f, 0.f, 0.f};
                  sf[0] = __builtin_amdgcn_mfma_f32_16x16x32_bf16(tri[0], lh[0], z4, 0, 0, 0); sf[0] = __builtin_amdgcn_mfma_f32_16x16x32_bf16(tri[2], lh[1], sf[0], 0, 0, 0);
                  sf[1] = __builtin_amdgcn_mfma_f32_16x16x32_bf16(tri[1], lh[0], z4, 0, 0, 0); sf[1] = __builtin_amdgcn_mfma_f32_16x16x32_bf16(tri[3], lh[1], sf[1], 0, 0, 0);
                  sf[2] = __builtin_amdgcn_mfma_f32_16x16x32_bf16(tri[4], lh[1], z4, 0, 0, 0);
                  sf[3] = __builtin_amdgcn_mfma_f32_16x16x32_bf16(tri[5], lh[1], z4, 0, 0, 0); }
                bf16x8 pb[2];
#pragma unroll
                for (int fp = 0; fp < 2; ++fp) { u32x4 w;
#pragma unroll
                    for (int q = 0; q < 2; ++q) { const int f = 2 * fp + q; float p[4];
#pragma unroll
                        for (int i = 0; i < 4; ++i) p[i] = __builtin_amdgcn_exp2f(lz[f][i] + sf[f][i] + carry);
                        w[2 * q] = cvt_pk_bf16(p[0], p[1]); w[2 * q + 1] = cvt_pk_bf16(p[2], p[3]); }
                    pb[fp] = __builtin_bit_cast(bf16x8, w); }
                carry += tot;
#pragma unroll
                for (int fd = 0; fd < 8; ++fd)
#pragma unroll
                    for (int fp = 0; fp < 2; ++fp) { const LAS unsigned char* vp = VT + (16 * fd + c) * 144 + (32 * fp + 4 * g) * 2;
                        const u32x2 v0 = *(const LAS u32x2*)vp, v1 = *(const LAS u32x2*)(vp + 32);
                        u32x4 vw; vw.x = v0.x; vw.y = v0.y; vw.z = v1.x; vw.w = v1.y;
                        oacc[fd] = __builtin_amdgcn_mfma_f32_16x16x32_bf16(__builtin_bit_cast(bf16x8, vw), pb[fp], oacc[fd], 0, 0, 0); }
                wdone = (__ballot(carry >= -152.0f) == 0ull) ? 1 : 0;
            }
        }
        if (MODE == 0) { unsigned char* orow = (unsigned char*)ATT + (size_t)(b * SEQ + tq) * 1024 + h * 128 + 4 * g;
#pragma unroll
          for (int fd = 0; fd < 8; ++fd) *(unsigned*)(orow + 16 * fd) = pack4_fp8(oacc[fd][0], oacc[fd][1], oacc[fd][2], oacc[fd][3], F8_SA); }
    }
    __syncthreads();
}

__device__ __forceinline__ void ssm_lambda(const Args& a, int g, int st, float& lbr, float& lbi, float& qr, float& qi) {
    const float lr = a.in[I_LRE][g * 64 + st], li = a.in[I_LIM][g * 64 + st], dt = __expf(a.in[I_LDT][g]);
    const float mag = __expf(lr * dt);
    float rev = li * dt * 0.15915494309189535f; rev -= rintf(rev);
    lbr = mag * __builtin_amdgcn_cosf(rev); lbi = mag * __builtin_amdgcn_sinf(rev);
    const float nr = lbr - 1.0f, ni = lbi, den = 1.0f / (lr * lr + li * li);
    qr = (nr * lr + ni * li) * den; qi = (ni * lr - nr * li) * den;
}
template <bool WITH_Y>
__device__ __forceinline__ void ph_ssm_mfma(const Args& a, LAS unsigned char* lds, const bf16_t* UB, f32x2* E, bf16_t* YA, int G) {
    const int tid = opaque_tid(), lane = tid & 63, wave = __builtin_amdgcn_readfirstlane(tid >> 6), c = lane & 15, gl = lane >> 4;
    LAS f32x2* sl = (LAS f32x2*)(lds + wave * 8192);
    LAS f32x4* tab = (LAS f32x4*)(lds + 65536 + wave * 1024);
    LAS u32x4* cml = (LAS u32x4*)(lds + 73728 + wave * 5120) + lane;
    for (int item = blockIdx.x; item < 128; item += G) {
        const int b = item >> 6, cb = (item >> 3) & 7, g = (item & 7) * 8 + wave, c0 = cb * 16;
        float mur, mui;
        { float lbr, lbi, qr, qi; ssm_lambda(a, g, lane, lbr, lbi, qr, qi); tab[lane] = (f32x4){lbr, lbi, qr, qi}; mur = lbr; mui = lbi; }
        LDS_WAIT();
        bf16x8 bm[8];
        const float* brb = a.in[I_BRE] + (g * 64 + (c >> 1)) * 16 + 8 * (gl & 1); const float* bib = a.in[I_BIM] + (g * 64 + (c >> 1)) * 16 + 8 * (gl & 1);
        const LAS f32x4* tabb = tab + (c >> 1);
#pragma unroll
        for (int f = 0; f < 8; ++f) { const f32x4 tv = tabb[8 * f]; const float qr = tv[2], qi = tv[3];
            const float* br = brb + 128 * f; const float* bim = bib + 128 * f;
            const f32x4 r0 = *(const f32x4*)br, r1 = *(const f32x4*)(br + 4), i0 = *(const f32x4*)bim, i1 = *(const f32x4*)(bim + 4);
            float v[8];
#pragma unroll
            for (int e = 0; e < 4; ++e) { const float vr0 = qr * r0[e] - qi * i0[e], vi0 = qr * i0[e] + qi * r0[e], vr1 = qr * r1[e] - qi * i1[e], vi1 = qr * i1[e] + qi * r1[e];
                v[e] = (c & 1) ? vi0 : vr0; v[4 + e] = (c & 1) ? vi1 : vr1; }
            if (gl >= 2) {
#pragma unroll
                for (int e = 0; e < 8; ++e) v[e] = 0.f; }
            u32x4 w; w.x = cvt_pk_bf16(v[0], v[1]); w.y = cvt_pk_bf16(v[2], v[3]); w.z = cvt_pk_bf16(v[4], v[5]); w.w = cvt_pk_bf16(v[6], v[7]);
            bm[f] = __builtin_bit_cast(bf16x8, w); }
        float lmr[16], lmi[16];
#pragma unroll
        for (int k = 0; k < 16; ++k) { const f32x4 tv = tab[2 * gl + 8 * (k >> 1) + (k & 1)]; lmr[k] = tv[0]; lmi[k] = tv[1]; }
        if (WITH_Y) {
            const float* crb = a.in[I_CRE] + (g * 16 + c) * 64 + 2 * gl; const float* cib = a.in[I_CIM] + (g * 16 + c) * 64 + 2 * gl;
#pragma unroll
            for (int kk = 0; kk < 4; ++kk) { float v[8];
#pragma unroll
                for (int jh = 0; jh < 2; ++jh) { const f32x2 r = *(const f32x2*)(crb + 8 * (2 * kk + jh)), m = *(const f32x2*)(cib + 8 * (2 * kk + jh));
                    v[4 * jh] = r.x; v[4 * jh + 1] = -m.x; v[4 * jh + 2] = r.y; v[4 * jh + 3] = -m.y; }
                u32x4 w; w.x = cvt_pk_bf16(v[0], v[1]); w.y = cvt_pk_bf16(v[2], v[3]); w.z = cvt_pk_bf16(v[4], v[5]); w.w = cvt_pk_bf16(v[6], v[7]);
                cml[64 * kk] = w; }
            { const float dv = a.in[I_SD][g * 16 + c]; float v[8];
#pragma unroll
              for (int jj = 0; jj < 8; ++jj) v[jj] = (gl < 2 && (8 * gl + jj) == c) ? dv : 0.f;
              u32x4 w; w.x = cvt_pk_bf16(v[0], v[1]); w.y = cvt_pk_bf16(v[2], v[3]); w.z = cvt_pk_bf16(v[4], v[5]); w.w = cvt_pk_bf16(v[6], v[7]);
              cml[256] = w; }
        }
        f32x4 s[8];
#pragma unroll
        for (int f = 0; f < 8; ++f) s[f] = (f32x4){0.f, 0.f, 0.f, 0.f};
        if (WITH_Y) {
            float pr = mur, pi = mui;
#pragma unroll
            for (int q = 0; q < 6; ++q) { const float nr = pr * pr - pi * pi, ni = 2.0f * pr * pi; pr = nr; pi = ni; }
            float sr = 0.f, si = 0.f;
            const f32x2* ep = E + (size_t)((b * 64 + g) * 128) * 64 + lane;
            f32x2 ev[8], en[8];
#pragma unroll
            for (int k = 0; k < 8; ++k) ev[k] = ep[(size_t)k * 64];
            for (int cc = 0; cc < c0 + 16; cc += 8) {
                if (cc + 8 < c0 + 16) {
#pragma unroll
                    for (int k = 0; k < 8; ++k) en[k] = ep[(size_t)(cc + 8 + k) * 64]; }
#pragma unroll
                for (int k = 0; k < 8; ++k) { if (cc >= c0) sl[(cc - c0 + k) * 64 + lane] = (f32x2){sr, si};
                    const float nr = pr * sr - pi * si + ev[k][0], ni = pr * si + pi * sr + ev[k][1]; sr = nr; si = ni; }
#pragma unroll
                for (int k = 0; k < 8; ++k) ev[k] = en[k];
            }
            LDS_WAIT();
#pragma unroll
            for (int f = 0; f < 8; ++f) s[f] = *(const LAS f32x4*)(sl + c * 64 + 8 * f + 2 * gl);
            LDS_WAIT();
        }
        const bf16_t* up = UB + ((size_t)(b * 64 + g) * 8192 + (size_t)(c0 + c) * 64) * 16 + 8 * (gl & 1);
        unsigned char* yp = (unsigned char*)YA + (size_t)(b * SEQ + (c0 + c) * 64) * 1024 + g * 16 + 4 * gl;
        u32x4 u0 = *(const u32x4*)(up), u1 = *(const u32x4*)(up + 16), u2 = *(const u32x4*)(up + 32), u3 = *(const u32x4*)(up + 48);
#pragma unroll 1
        for (int tau = 0; tau < 64; ++tau) {
            const u32x4 u4 = *(const u32x4*)(up + (size_t)(tau + 4) * 16);
            const bf16x8 uf = __builtin_bit_cast(bf16x8, u0);
#pragma unroll
            for (int f = 0; f < 8; ++f) { f32x4 ci;
                ci[0] = lmr[2 * f] * s[f][0] - lmi[2 * f] * s[f][1]; ci[1] = lmr[2 * f] * s[f][1] + lmi[2 * f] * s[f][0];
                ci[2] = lmr[2 * f + 1] * s[f][2] - lmi[2 * f + 1] * s[f][3]; ci[3] = lmr[2 * f + 1] * s[f][3] + lmi[2 * f + 1] * s[f][2];
                s[f] = __builtin_amdgcn_mfma_f32_16x16x32_bf16(bm[f], uf, ci, 0, 0, 0); }
            if (WITH_Y) {
                f32x4 y = __builtin_amdgcn_mfma_f32_16x16x32_bf16(__builtin_bit_cast(bf16x8, cml[256]), uf, (f32x4){0.f, 0.f, 0.f, 0.f}, 0, 0, 0);
#pragma unroll
                for (int kk = 0; kk < 4; ++kk) { u32x4 w; w.x = cvt_pk_bf16(s[2 * kk][0], s[2 * kk][1]); w.y = cvt_pk_bf16(s[2 * kk][2], s[2 * kk][3]);
                    w.z = cvt_pk_bf16(s[2 * kk + 1][0], s[2 * kk + 1][1]); w.w = cvt_pk_bf16(s[2 * kk + 1][2], s[2 * kk + 1][3]);
                    y = __builtin_amdgcn_mfma_f32_16x16x32_bf16(__builtin_bit_cast(bf16x8, cml[64 * kk]), __builtin_bit_cast(bf16x8, w), y, 0, 0, 0); }
                *(unsigned*)(yp + (size_t)tau * 1024) = pack4_fp8(gelu_tanh(y[0]), gelu_tanh(y[1]), gelu_tanh(y[2]), gelu_tanh(y[3]), F8_SA);
            }
            u0 = u1; u1 = u2; u2 = u3; u3 = u4;
        }
        if (!WITH_Y) { f32x2* eo = E + (size_t)((b * 64 + g) * 128 + c0 + c) * 64 + 2 * gl;
#pragma unroll
            for (int f = 0; f < 8; ++f) *(f32x4*)(eo + 8 * f) = s[f]; }
    }
}

typedef float f32x16 __attribute__((ext_vector_type(16)));
typedef float f32x32 __attribute__((ext_vector_type(32)));
typedef _Float16 f16x2_t __attribute__((ext_vector_type(2)));
typedef _Float16 f16x32_t __attribute__((ext_vector_type(32)));
typedef unsigned u32x6 __attribute__((ext_vector_type(6)));
constexpr float PEER_SU = 64.0f, PEER_SV = 1.4f;
constexpr size_t PEER_SHARD_BYTES = (size_t)16384 * 192;
__device__ __forceinline__ void table_cvt_pack(const f32x4 (&v)[8], float sc, unsigned char* dst, int lane) {
    f32x16 a, b;
#pragma unroll
    for (int q = 0; q < 4; ++q) {
#pragma unroll
        for (int e = 0; e < 4; ++e) { a[4 * q + e] = v[q][e] * sc; b[4 * q + e] = v[4 + q][e] * sc; } }
    const u32x6 p = __builtin_amdgcn_cvt_scalef32_2xpk16_fp6_f32(a, b, 1.0f);
    *(u32x4*)(dst + 16 * (lane & 7)) = (u32x4){p[0], p[1], p[2], p[3]};
    *(u32x2*)(dst + 128 + 8 * (lane & 7)) = (u32x2){p[4], p[5]};
}
__device__ __forceinline__ void ph_table_cvt(const float* __restrict__ U, const float* __restrict__ V, unsigned char* UT, unsigned char* VT, int r0, int r1, int gw, int ngw, int lane) {
    for (int r = r0 + gw; r < r1; r += ngw) {
        const float* su = U + (size_t)r * 2048 + 32 * lane; const float* sv = V + (size_t)r * 2048 + 32 * lane;
        f32x4 vu[8], vv[8];
#pragma unroll
        for (int q = 0; q < 8; ++q) vu[q] = *(const f32x4*)(su + 4 * q);
#pragma unroll
        for (int q = 0; q < 8; ++q) vv[q] = *(const f32x4*)(sv + 4 * q);
        const size_t off = (size_t)(lane >> 3) * PEER_SHARD_BYTES + (size_t)r * 192;
        table_cvt_pack(vu, PEER_SU, UT + off, lane);
        table_cvt_pack(vv, PEER_SV, VT + off, lane);
    }
}

#define TK_CE(a_, b_) do { const float _h = fmaxf(a_, b_), _l = fminf(a_, b_); a_ = _h; b_ = _l; } while (0)
__device__ __forceinline__ void tk_sort16(float (&a)[16]) {
#pragma unroll
    for (int p = 1; p < 16; p *= 2)
#pragma unroll
        for (int k = p; k >= 1; k /= 2)
#pragma unroll
            for (int j = k % p; j <= 15 - k; j += 2 * k)
#pragma unroll
                for (int i = 0; i < k; ++i)
                    if (i + j + k <= 15 && (i + j) / (2 * p) == (i + j + k) / (2 * p)) TK_CE(a[i + j], a[i + j + k]);
}
__device__ __forceinline__ void tk_merge16(float (&t)[16], const float (&g)[16]) {
#pragma unroll
    for (int i = 0; i < 16; ++i) t[i] = fmaxf(t[i], g[15 - i]);
#pragma unroll
    for (int k = 8; k >= 1; k /= 2)
#pragma unroll
        for (int i = 0; i < 16; ++i)
            if ((i & k) == 0) TK_CE(t[i], t[i + k]);
}
__device__ __forceinline__ float tk2_key(float a, float b, int flat) {
    const float sum = __uint_as_float(__float_as_uint(a) & ~127u) + __uint_as_float(__float_as_uint(b) & ~127u);
    return __uint_as_float((__float_as_uint(sum) & ~255u) | (unsigned)(255 - flat)); }
__device__ __forceinline__ void ph_peer_topk(LAS unsigned char* lds, const float* SC, int* idxG, float* gateG, int G) {
    const int tid = opaque_tid(), lane = tid & 63, wave = __builtin_amdgcn_readfirstlane(tid >> 6);
    LAS float* scr = (LAS float*)(lds + wave * 8448);
    for (int it = blockIdx.x; it < 512; it += G) {
        const int tokw = it * 32 + wave * 4;
        float tk[16];
#pragma unroll
        for (int i = 0; i < 16; ++i) tk[i] = -INFINITY;
        f32x4 nv[8];
#pragma unroll
        for (int j = 0; j < 8; ++j) { const int prob = (lane >> 3) + 8 * j, seg = lane & 7; nv[j] = *(const f32x4*)(SC + (size_t)(tokw + (prob >> 4)) * 2048 + (prob & 15) * 128 + 4 * seg); }
        for (int q = 0; q < 4; ++q) {
#pragma unroll
            for (int j = 0; j < 8; ++j) { const int prob = (lane >> 3) + 8 * j, seg = lane & 7; const f32x4 v = nv[j];
                LAS float* d = scr + prob * 33 + 4 * seg; d[0] = v[0]; d[1] = v[1]; d[2] = v[2]; d[3] = v[3]; }
            { const int qn = q < 3 ? q + 1 : 3;
#pragma unroll
              for (int j = 0; j < 8; ++j) { const int prob = (lane >> 3) + 8 * j, seg = lane & 7; nv[j] = *(const f32x4*)(SC + (size_t)(tokw + (prob >> 4)) * 2048 + (prob & 15) * 128 + 32 * qn + 4 * seg); } }
            LDS_WAIT();
#pragma unroll
            for (int hh = 0; hh < 2; ++hh) { float g[16];
#pragma unroll
                for (int i = 0; i < 16; ++i) g[i] = __uint_as_float((__float_as_uint(scr[lane * 33 + 16 * hh + i]) & ~127u) | (unsigned)(127 - (32 * q + 16 * hh + i)));
                tk_sort16(g); tk_merge16(tk, g); }
            LDS_WAIT();
        }
        float t2[16];
#pragma unroll
        for (int i = 0; i < 16; ++i) t2[i] = __shfl_xor(tk[i], 1);
        float bv[16];
        {
          bv[0] = tk2_key(tk[0], t2[0], 0);
          bv[1] = tk2_key(tk[0], t2[1], 1);
          bv[2] = tk2_key(tk[0], t2[2], 2);
          bv[3] = tk2_key(tk[0], t2[3], 3);
          bv[4] = tk2_key(tk[0], t2[4], 4);
          bv[5] = tk2_key(tk[0], t2[5], 5);
          bv[6] = tk2_key(tk[0], t2[6], 6);
          bv[7] = tk2_key(tk[0], t2[7], 7);
          bv[8] = tk2_key(tk[0], t2[8], 8);
          bv[9] = tk2_key(tk[0], t2[9], 9);
          bv[10] = tk2_key(tk[0], t2[10], 10);
          bv[11] = tk2_key(tk[0], t2[11], 11);
          bv[12] = tk2_key(tk[0], t2[12], 12);
          bv[13] = tk2_key(tk[0], t2[13], 13);
          bv[14] = tk2_key(tk[0], t2[14], 14);
          bv[15] = tk2_key(tk[0], t2[15], 15);
          tk_sort16(bv);
          { float g[16];
          g[0] = tk2_key(tk[1], t2[0], 16);
          g[1] = tk2_key(tk[1], t2[1], 17);
          g[2] = tk2_key(tk[1], t2[2], 18);
          g[3] = tk2_key(tk[1], t2[3], 19);
          g[4] = tk2_key(tk[1], t2[4], 20);
          g[5] = tk2_key(tk[1], t2[5], 21);
          g[6] = tk2_key(tk[1], t2[6], 22);
          g[7] = tk2_key(tk[1], t2[7], 23);
          g[8] = tk2_key(tk[2], t2[0], 32);
          g[9] = tk2_key(tk[2], t2[1], 33);
          g[10] = tk2_key(tk[2], t2[2], 34);
          g[11] = tk2_key(tk[2], t2[3], 35);
          g[12] = tk2_key(tk[2], t2[4], 36);
          g[13] = tk2_key(tk[3], t2[0], 48);
          g[14] = tk2_key(tk[3], t2[1], 49);
          g[15] = tk2_key(tk[3], t2[2], 50);
          tk_sort16(g); tk_merge16(bv, g); }
          { float g[16];
          g[0] = tk2_key(tk[3], t2[3], 51);
          g[1] = tk2_key(tk[4], t2[0], 64);
          g[2] = tk2_key(tk[4], t2[1], 65);
          g[3] = tk2_key(tk[4], t2[2], 66);
          g[4] = tk2_key(tk[5], t2[0], 80);
          g[5] = tk2_key(tk[5], t2[1], 81);
          g[6] = tk2_key(tk[6], t2[0], 96);
          g[7] = tk2_key(tk[6], t2[1], 97);
          g[8] = tk2_key(tk[7], t2[0], 112);
          g[9] = tk2_key(tk[7], t2[1], 113);
          g[10] = tk2_key(tk[8], t2[0], 128);
          g[11] = tk2_key(tk[9], t2[0], 144);
          g[12] = tk2_key(tk[10], t2[0], 160);
          g[13] = tk2_key(tk[11], t2[0], 176);
          g[14] = tk2_key(tk[12], t2[0], 192);
          g[15] = tk2_key(tk[13], t2[0], 208);
          tk_sort16(g); tk_merge16(bv, g); }
          { float x = tk2_key(tk[14], t2[0], 224);
#pragma unroll
            for (int i = 0; i < 16; ++i) { const float hi = fmaxf(bv[i], x); x = fminf(bv[i], x); bv[i] = hi; } }
          { float x = tk2_key(tk[15], t2[0], 240);
#pragma unroll
            for (int i = 0; i < 16; ++i) { const float hi = fmaxf(bv[i], x); x = fminf(bv[i], x); bv[i] = hi; } }
        }
        unsigned p1[4], p2[4];
#pragma unroll
        for (int j = 0; j < 4; ++j) { p1[j] = 0u; p2[j] = 0u;
#pragma unroll
            for (int e = 0; e < 4; ++e) { p1[j] |= (127u - (__float_as_uint(tk[4 * j + e]) & 127u)) << (8 * e); p2[j] |= (127u - (__float_as_uint(t2[4 * j + e]) & 127u)) << (8 * e); } }
        { float e[16], sum = 0.f; unsigned ex[16];
          const float top = __uint_as_float(__float_as_uint(bv[0]) & ~255u);
#pragma unroll
          for (int i = 0; i < 16; ++i) { const unsigned bits = __float_as_uint(bv[i]); const unsigned flat = 255u - (bits & 255u), aa = flat >> 4, bb = flat & 15u;
              const unsigned w1 = (aa >> 2) == 0u ? p1[0] : (aa >> 2) == 1u ? p1[1] : (aa >> 2) == 2u ? p1[2] : p1[3];
              const unsigned w2 = (bb >> 2) == 0u ? p2[0] : (bb >> 2) == 1u ? p2[1] : (bb >> 2) == 2u ? p2[2] : p2[3];
              ex[i] = (((w1 >> (8u * (aa & 3u))) & 127u) << 7) | ((w2 >> (8u * (bb & 3u))) & 127u);
              e[i] = __expf(__uint_as_float(bits & ~255u) - top); sum += e[i]; }
          const float inv = 1.0f / sum;
          if ((lane & 1) == 0) { const int tl = lane >> 4, head = (lane & 15) >> 1; const size_t o = (size_t)(tokw + tl) * 128 + 64 * (head >> 2);
#pragma unroll
              for (int i = 0; i < 16; ++i) { const int p = 8 * (i & 7) + ((2 * head + (i >> 3)) & 7); idxG[o + p] = (int)ex[i] * 192; gateG[o + p] = e[i] * inv; } } }
    }
}

#define PEER_ROWS(b4_, b2_, i8_) do { _Pragma("unroll") for (int gq = 0; gq < 8; ++gq) { const unsigned ro = (unsigned)(i8_)[gq];        \
        b4_[gq] = *(const u32x4*)(tab + (ro + 16u * (unsigned)c)); b2_[gq] = *(const u32x2*)(tab + (ro + 128u + 8u * (unsigned)c)); } } while (0)
#define PEER_LD8(dst_, p_) do { const u32x4 _a = *(const u32x4*)(p_), _b = *(const u32x4*)((p_) + 4); dst_[0] = (int)_a.x; dst_[1] = (int)_a.y; dst_[2] = (int)_a.z; dst_[3] = (int)_a.w; \
        dst_[4] = (int)_b.x; dst_[5] = (int)_b.y; dst_[6] = (int)_b.z; dst_[7] = (int)_b.w; } while (0)
__device__ __forceinline__ void ph_peer_u(const unsigned char* UT, const bf16_t* H2, const int* idxG, float* pdot, int G) {
    const int tid = opaque_tid(), lane = tid & 63, wave = __builtin_amdgcn_readfirstlane(tid >> 6), r = lane >> 3, c = lane & 7;
    const int shard = blockIdx.x & 7, ws = (blockIdx.x >> 3) * 8 + wave, nws = (G >> 3) * 8;
    const unsigned char* tab = UT + (size_t)shard * PEER_SHARD_BYTES;
    const bf16_t* hbase = H2 + 256 * shard + 32 * c;
    const int* ibase = idxG + 8 * r;
#define PEER_TOK(t_) (((t_) < T_TOK) ? (t_) : (T_TOK - 1))
    int ci[2][8], ni[2][8]; u32x4 cw[4], nw[4];
    { const int t0 = PEER_TOK(ws), t1 = PEER_TOK(ws + nws);
      PEER_LD8(ci[0], ibase + (size_t)t0 * 128); PEER_LD8(ci[1], ibase + (size_t)t0 * 128 + 64); PEER_LD8(ni[0], ibase + (size_t)t1 * 128); PEER_LD8(ni[1], ibase + (size_t)t1 * 128 + 64);
#pragma unroll
      for (int q = 0; q < 4; ++q) cw[q] = *(const u32x4*)(hbase + (size_t)t0 * 2048 + 8 * q); }
    u32x4 a4[8], b4[8]; u32x2 a2[8], b2[8];
    PEER_ROWS(a4, a2, ci[0]);
    for (int t = ws; t < T_TOK; t += nws) {
        PEER_ROWS(b4, b2, ci[1]);
        { const int t1 = PEER_TOK(t + nws);
#pragma unroll
          for (int q = 0; q < 4; ++q) nw[q] = *(const u32x4*)(hbase + (size_t)t1 * 2048 + 8 * q); }
        f32x2 ha[16];
        { const u32x4 w0 = cw[0], w1 = cw[1], w2 = cw[2], w3 = cw[3];
          ha[0] = (f32x2){bf_lo(w0.x), bf_lo(w2.x)}; ha[1] = (f32x2){bf_hi(w0.x), bf_hi(w2.x)}; ha[2] = (f32x2){bf_lo(w0.y), bf_lo(w2.y)}; ha[3] = (f32x2){bf_hi(w0.y), bf_hi(w2.y)};
          ha[4] = (f32x2){bf_lo(w0.z), bf_lo(w2.z)}; ha[5] = (f32x2){bf_hi(w0.z), bf_hi(w2.z)}; ha[6] = (f32x2){bf_lo(w0.w), bf_lo(w2.w)}; ha[7] = (f32x2){bf_hi(w0.w), bf_hi(w2.w)};
          ha[8] = (f32x2){bf_lo(w1.x), bf_lo(w3.x)}; ha[9] = (f32x2){bf_hi(w1.x), bf_hi(w3.x)}; ha[10] = (f32x2){bf_lo(w1.y), bf_lo(w3.y)}; ha[11] = (f32x2){bf_hi(w1.y), bf_hi(w3.y)};
          ha[12] = (f32x2){bf_lo(w1.z), bf_lo(w3.z)}; ha[13] = (f32x2){bf_hi(w1.z), bf_hi(w3.z)}; ha[14] = (f32x2){bf_lo(w1.w), bf_lo(w3.w)}; ha[15] = (f32x2){bf_hi(w1.w), bf_hi(w3.w)}; }
        float* po = pdot + ((size_t)shard * T_TOK + t) * 128 + lane;
#define PEER_UDOT(b4_, b2_, half_) do { float mine = 0.f; \
            _Pragma("unroll") for (int gq = 0; gq < 8; ++gq) { const u32x6 p6 = {b4_[gq].x, b4_[gq].y, b4_[gq].z, b4_[gq].w, b2_[gq].x, b2_[gq].y}; \
                const f32x32 uv = __builtin_amdgcn_cvt_scalef32_pk32_f32_fp6(p6, 1.0f); f32x2 s = {0.f, 0.f}; \
                _Pragma("unroll") for (int k = 0; k < 16; ++k) s = (f32x2){uv[2 * k], uv[2 * k + 1]} * ha[k] + s; \
                const float d = sum8_dpp(s.x + s.y); \
                mine = (gq == c) ? d : mine; __builtin_amdgcn_sched_barrier(0); } \
            po[64 * (half_)] = mine; } while (0)
        PEER_UDOT(a4, a2, 0);
        PEER_ROWS(a4, a2, ni[0]);
#pragma unroll
        for (int q = 0; q < 8; ++q) { ci[0][q] = ni[0][q]; ci[1][q] = ni[1][q]; }
        { const int t2 = PEER_TOK(t + 2 * nws); PEER_LD8(ni[0], ibase + (size_t)t2 * 128); PEER_LD8(ni[1], ibase + (size_t)t2 * 128 + 64); }
        PEER_UDOT(b4, b2, 1);
#pragma unroll
        for (int q = 0; q < 4; ++q) cw[q] = nw[q];
    }
#undef PEER_UDOT
}
__device__ __forceinline__ void ph_peer_act(const float* pdot, const float* gateG, float* actG, int G) {
    const size_t n = (size_t)T_TOK * 128, stride = (size_t)G * 512;
    for (size_t i = (size_t)blockIdx.x * 512 + threadIdx.x; i < n; i += stride) {
        float d = 0.f;
#pragma unroll
        for (int x = 0; x < 8; ++x) d += pdot[(size_t)x * n + i];
        actG[i] = gateG[i] * gelu_tanh(d * (1.0f / PEER_SU)) * (1.0f / PEER_SV);
    }
}
template <bool DRY>
__device__ __forceinline__ void ph_peer_v(LAS unsigned char* lds, const unsigned char* VT, const int* idxG, const float* actG, const float* mod, float* OUT, int G) {
    const int tid = opaque_tid(), lane = tid & 63, wave = __builtin_amdgcn_readfirstlane(tid >> 6), r = lane >> 3, c = lane & 7;
    const int shard = blockIdx.x & 7, ws = (blockIdx.x >> 3) * 8 + wave, nws = (G >> 3) * 8;
    const unsigned char* tab = VT + (size_t)shard * PEER_SHARD_BYTES;
    LAS float* red = (LAS float*)(lds + wave * 9216);
    const int* ibase = idxG + 8 * r; const int* abase = (const int*)actG + 8 * r;
    int ci[2][8], ni[2][8], ca[2][8], na[2][8]; f32x4 cx, nx;
    { const int t0 = PEER_TOK(ws), t1 = PEER_TOK(ws + nws);
      PEER_LD8(ci[0], ibase + (size_t)t0 * 128); PEER_LD8(ci[1], ibase + (size_t)t0 * 128 + 64); PEER_LD8(ni[0], ibase + (size_t)t1 * 128); PEER_LD8(ni[1], ibase + (size_t)t1 * 128 + 64);
      PEER_LD8(ca[0], abase + (size_t)t0 * 128); PEER_LD8(ca[1], abase + (size_t)t0 * 128 + 64);
      cx = *(const f32x4*)(OUT + (size_t)t0 * 2048 + 256 * shard + 4 * lane); }
    u32x4 a4[8], b4[8]; u32x2 a2[8], b2[8];
    PEER_ROWS(a4, a2, ci[0]);
    for (int t = ws; t < T_TOK; t += nws) {
        PEER_ROWS(b4, b2, ci[1]);
        { const int t1 = PEER_TOK(t + nws);
          PEER_LD8(na[0], abase + (size_t)t1 * 128); PEER_LD8(na[1], abase + (size_t)t1 * 128 + 64); nx = *(const f32x4*)(OUT + (size_t)t1 * 2048 + 256 * shard + 4 * lane); }
        f16x2_t acc[16];
#pragma unroll
        for (int k = 0; k < 16; ++k) acc[k] = (f16x2_t){(_Float16)0.f, (_Float16)0.f};
#define PEER_VF(k_) acc[k_] = __builtin_shufflevector(vh, vh, 2 * (k_), 2 * (k_) + 1) * av2 + acc[k_]
#define PEER_VACC(b4_, b2_, a8_) do { _Pragma("unroll") for (int gq = 0; gq < 8; ++gq) { const _Float16 ah = (_Float16)__int_as_float((a8_)[gq]); const f16x2_t av2 = {ah, ah}; \
            const u32x6 p6 = {b4_[gq].x, b4_[gq].y, b4_[gq].z, b4_[gq].w, b2_[gq].x, b2_[gq].y}; const f16x32_t vh = __builtin_amdgcn_cvt_scalef32_pk32_f16_fp6(p6, 1.0f); \
            PEER_VF(0); PEER_VF(1); PEER_VF(2); PEER_VF(3); PEER_VF(4); PEER_VF(5); PEER_VF(6); PEER_VF(7); PEER_VF(8); PEER_VF(9); PEER_VF(10); PEER_VF(11); PEER_VF(12); PEER_VF(13); PEER_VF(14); PEER_VF(15); __builtin_amdgcn_sched_barrier(0); } } while (0)
        PEER_VACC(a4, a2, ca[0]);
        PEER_ROWS(a4, a2, ni[0]);
#pragma unroll
        for (int q = 0; q < 8; ++q) { ci[0][q] = ni[0][q]; ci[1][q] = ni[1][q]; }
        { const int t2 = PEER_TOK(t + 2 * nws); PEER_LD8(ni[0], ibase + (size_t)t2 * 128); PEER_LD8(ni[1], ibase + (size_t)t2 * 128 + 64); }
        PEER_VACC(b4, b2, ca[1]);
        { LAS float* w = red + (r * 8 + c) * 36;
#pragma unroll
          for (int q = 0; q < 4; ++q) { *(LAS f32x4*)(w + 4 * q) = (f32x4){(float)acc[4 * q].x, (float)acc[4 * q + 1].x, (float)acc[4 * q + 2].x, (float)acc[4 * q + 3].x};
              *(LAS f32x4*)(w + 16 + 4 * q) = (f32x4){(float)acc[4 * q].y, (float)acc[4 * q + 1].y, (float)acc[4 * q + 2].y, (float)acc[4 * q + 3].y}; } }
        LDS_WAIT();
        { f32x4 s = {0.f, 0.f, 0.f, 0.f}; const LAS float* rd = red + (lane >> 3) * 36 + 4 * (lane & 7);
#pragma unroll
          for (int rr = 0; rr < 8; ++rr) s += *(const LAS f32x4*)(rd + rr * 288);
          const int b = t >> 13; const float* gt2 = mod + (size_t)b * 12288 + 10240 + 256 * shard + 4 * lane; float* op = OUT + (size_t)t * 2048 + 256 * shard + 4 * lane;
          const f32x4 g0 = *(const f32x4*)gt2;
          if (!DRY) *(f32x4*)op = cx + g0 * s; else asm volatile("" :: "v"(s), "v"(g0)); }
        LDS_WAIT();
#pragma unroll
        for (int q = 0; q < 8; ++q) { ca[0][q] = na[0][q]; ca[1][q] = na[1][q]; }
        cx = nx;
    }
#undef PEER_VACC
#undef PEER_VF
}
#undef PEER_ROWS
#undef PEER_LD8
#undef PEER_TOK

__global__ void __launch_bounds__(512, 2) mk_fwd(Args args) {
    extern __shared__ __attribute__((aligned(16))) unsigned char lds_raw[];
    LAS unsigned char* lds = (LAS unsigned char*)lds_raw;
    const int tid = threadIdx.x, lane = tid & 63, wave = __builtin_amdgcn_readfirstlane(tid >> 6);
    const int G = gridDim.x, gw = blockIdx.x * 8 + wave, ngw = G * 8;
    unsigned char* ws = args.ws;
    volatile LAS unsigned* misc = (volatile LAS unsigned*)(lds + LDS_MAIN);
    if (tid < 4) misc[tid] = 0u;
    __syncthreads();
    const int lo = args.ph_lo, hi = args.ph_hi;
    XcdBarrier bar; bar.bar = (unsigned*)(ws + WS_CTL); bar.x = 0; bar.st = misc;
    if (hi - lo > 1) bar = xcd_barrier_post((unsigned*)(ws + WS_CTL), misc);
#ifndef PHMASK
#define PHMASK 0x3fff
#endif
#define IN(k) (((PHMASK >> (k)) & 1) && lo <= (k) && (k) < hi)
#define SEAM(k) do { if (IN(k) && IN((k) + 1)) xcd_barrier(bar); } while (0)
    float* mod = (float*)(ws + WS_MOD);
    bf16_t* HB = (bf16_t*)(ws + WS_H); bf16_t* PA = (bf16_t*)(ws + WS_PA); bf16_t* PG = (bf16_t*)(ws + WS_PG);
    bf16_t* YA = (bf16_t*)(ws + WS_YA); bf16_t* ATT = (bf16_t*)(ws + WS_ATT); f32x2* EB = (f32x2*)(ws + WS_E); bf16_t* UBp = (bf16_t*)(ws + WS_UB);

#define PHS(code, ...) do { __VA_ARGS__ if (DUP == (code)) { xcd_barrier(bar); __VA_ARGS__ } } while (0)
#define PH(k, ...) do { if (IN(k)) { __VA_ARGS__ if (DUP == (k)) { xcd_barrier(bar); __VA_ARGS__ } } } while (0)
    PH(0, { ph_mod_partial(args.in[I_C], args.in[I_WADA], (float*)(ws + WS_MODP), gw, ngw, lane); ph_colmax_partial(args.in[I_WIN], (float*)(ws + WS_CMAXP), gw, ngw, lane); });
    SEAM(0);
    PH(1, { ph_prologue(args, lds, gw, ngw, lane, wave); });
    SEAM(1);
    PH(2, { ph_norm<true>(args.in[I_X], HB, (float*)(ws + WS_SA), args.in[I_N1G], mod, 0, 2048, gw, ngw, lane); });
    SEAM(2);
    PH(3, { pg8::Gemm g{HB, (const bf16_t*)(ws + WS_WIN), T_TOK, 8192, 1024}; pg8::StaticOrder S; S.init(T_TOK, 8192, G, (int)blockIdx.x);
        pg8::EpiProj E{PA, PG, UBp, (const float*)(ws + WS_SA), (const float*)(ws + WS_SB)}; pg8::gemm_phase<pg8::EpiProj, pg8::StaticOrder, true, true, 1>(lds, g, S, E); });
    SEAM(3);
    PH(4, { PHS(41, { ph_attn<0>(lds, PA, ATT, args.in[I_QNG], args.in[I_KNG], G); __syncthreads(); });
        if (DUP == 411) { xcd_barrier(bar); ph_attn<1>(lds, PA, ATT, args.in[I_QNG], args.in[I_KNG], G); __syncthreads(); } PHS(42, { ph_ssm_mfma<false>(args, lds, UBp, EB, YA, G); }); });
    SEAM(4);
    PH(5, { PHS(51, { ph_ssm_mfma<true>(args, lds, UBp, EB, YA, G); __syncthreads(); });
        PHS(52, { pg8::Gemm g{ATT, (const bf16_t*)(ws + WS_WATT), T_TOK, 2048, 512}; pg8::SplitOrder S; S.init(T_TOK, 2048, G, (int)blockIdx.x);
        pg8::EpiAttUp E{PG, HB}; pg8::gemm_phase<pg8::EpiAttUp, pg8::SplitOrder, true, true, 2>(lds, g, S, E); }); });
    SEAM(5);
    PH(6, { pg8::Gemm g{YA, (const bf16_t*)(ws + WS_WGLU), T_TOK, 4096, 512}; pg8::StaticOrder S; S.init(T_TOK, 4096, G, (int)blockIdx.x);
        pg8::EpiGlu E{PG, HB, (unsigned char*)ATT}; pg8::gemm_phase<pg8::EpiGlu, pg8::StaticOrder, true, true, 2>(lds, g, S, E); });
    SEAM(6);
    PH(7, { const bool split = (G == 256); const int gg = split ? 171 : G, ra = split ? 11264 : 0;
        if ((int)blockIdx.x < gg) { pg8::Gemm g{ATT, (const bf16_t*)(ws + WS_WOUT), T_TOK, 2048, 1024}; pg8::StaticOrder S; S.init(T_TOK, 2048, gg, (int)blockIdx.x);
            pg8::EpiOut E{args.in[I_X], args.out, mod}; pg8::gemm_phase<pg8::EpiOut, pg8::StaticOrder, true, true, 2>(lds, g, S, E); }
        else ph_table_cvt(args.in[I_PU], args.in[I_PV], ws + WS_UT, ws + WS_VT, 0, ra, ((int)blockIdx.x - gg) * 8 + wave, (G - gg) * 8, lane);
        ph_table_cvt(args.in[I_PU], args.in[I_PV], ws + WS_UT, ws + WS_VT, ra, 16384, gw, ngw, lane); });
    SEAM(7);
    PH(8, { ph_norm<false>(args.out, HB, nullptr, args.in[I_N2G], mod, 6144, 8192, gw, ngw, lane); });
    SEAM(8);
    PH(9, { pg8::Gemm g{HB, (const bf16_t*)(ws + WS_WSC), T_TOK, 2048, 2048}; pg8::StaticOrder S; S.init(T_TOK, 2048, G, (int)blockIdx.x);
        pg8::EpiF32 E{(float*)(ws + WS_SC)}; pg8::gemm_phase<pg8::EpiF32, pg8::StaticOrder, true, true>(lds, g, S, E); });
    SEAM(9);
    PH(10, { ph_peer_topk(lds, (const float*)(ws + WS_SC), (int*)(ws + WS_IDX), (float*)(ws + WS_GATE), G); });
    SEAM(10);
    PH(11, { ph_peer_u(ws + WS_UT, HB, (const int*)(ws + WS_IDX), (float*)(ws + WS_PDOT), G); });
    SEAM(11);
    PH(12, { ph_peer_act((const float*)(ws + WS_PDOT), (const float*)(ws + WS_GATE), (float*)(ws + WS_ACT), G); });
    SEAM(12);
    if (IN(13)) { if (DUP == 13) { ph_peer_v<true>(lds, ws + WS_VT, (const int*)(ws + WS_IDX), (const float*)(ws + WS_ACT), mod, args.out, G); xcd_barrier(bar); }
        ph_peer_v<false>(lds, ws + WS_VT, (const int*)(ws + WS_IDX), (const float*)(ws + WS_ACT), mod, args.out, G); }
#undef IN
#undef SEAM
}

extern "C" void kernel_launch(void* const* d_in, const int* in_sizes, int n_in, void* d_out, int out_size, void* d_ws, size_t ws_size, hipStream_t stream) {
    static int grid = 0;
    if (grid == 0) {
        if (n_in != 25 || out_size != T_TOK * DM || ws_size < WS_END) { fprintf(stderr, "kernel_launch: unexpected shapes (n_in %d out %d ws %zu need %zu)\n", n_in, out_size, ws_size, (size_t)WS_END); grid = -1; return; }
        int dev = 0, cus = 0, per_cu = 0;
        if (hipGetDevice(&dev) != hipSuccess || hipDeviceGetAttribute(&cus, hipDeviceAttributeMultiprocessorCount, dev) != hipSuccess) { grid = -1; return; }
        if (hipFuncSetAttribute((const void*)mk_fwd, hipFuncAttributeMaxDynamicSharedMemorySize, LDS_BYTES) != hipSuccess) { fprintf(stderr, "kernel_launch: hipFuncSetAttribute failed\n"); grid = -1; return; }
        if (hipOccupancyMaxActiveBlocksPerMultiprocessor(&per_cu, (const void*)mk_fwd, 512, LDS_BYTES) != hipSuccess || per_cu < 1) { fprintf(stderr, "kernel_launch: occupancy query says %d blocks/CU\n", per_cu); (void)hipGetLastError(); grid = -1; return; }
        grid = cus;
    }
    if (grid < 0) return;
    (void)hipMemsetAsync((char*)d_ws + WS_CTL, 0, 16384, stream);
    Args a{};
    for (int i = 0; i < 25; ++i) a.in[i] = (const float*)d_in[i];
    a.out = (float*)d_out; a.ws = (unsigned char*)d_ws;
#if MK_PER_PHASE
    for (int ph = 0; ph < NPHASE; ++ph) { a.ph_lo = ph; a.ph_hi = ph + 1; hipLaunchKernelGGL(mk_fwd, dim3(grid), dim3(512), LDS_BYTES, stream, a); }
#else
    a.ph_lo = 0; a.ph_hi = NPHASE;
    hipLaunchKernelGGL(mk_fwd, dim3(grid), dim3(512), LDS_BYTES, stream, a);
#endif
}
```

```cpp
#include <hip/hip_runtime.h>
#include <cstdio>
#include <cstdint>

#ifndef MK_PER_PHASE
#define MK_PER_PHASE 0
#endif

#ifndef DUP
#define DUP -1
#endif
#define LAS __attribute__((address_space(3)))
typedef unsigned short bf16_t;
typedef short bf16x8 __attribute__((ext_vector_type(8)));
typedef float f32x4 __attribute__((ext_vector_type(4)));
typedef float f32x2 __attribute__((ext_vector_type(2)));
typedef unsigned u32x4 __attribute__((ext_vector_type(4)));
typedef unsigned u32x2 __attribute__((ext_vector_type(2)));
typedef int i32x4 __attribute__((ext_vector_type(4)));

constexpr int T_TOK = 16384, DM = 2048, SEQ = 8192;
constexpr int NPHASE = 14;
constexpr float EPS = 1e-6f;

constexpr size_t WS_CTL   = 0;
constexpr size_t WS_MODP  = 65536;
constexpr size_t WS_MOD   = WS_MODP + (size_t)32 * 2 * 12288 * 4;
constexpr size_t WS_WIN   = WS_MOD + (size_t)2 * 12288 * 4;
constexpr size_t WS_WGLU  = WS_WIN + (size_t)8192 * 2048 * 2;
constexpr size_t WS_WATT  = WS_WGLU + (size_t)4096 * 1024 * 2;
constexpr size_t WS_WOUT  = WS_WATT + (size_t)2048 * 1024 * 2;
constexpr size_t WS_WSC   = WS_WOUT + (size_t)2048 * 2048 * 2;
constexpr size_t WS_H     = WS_WSC + (size_t)2048 * 2048 * 2;
constexpr size_t WS_PA    = WS_H + (size_t)T_TOK * 2048 * 2;
constexpr size_t WS_PG    = WS_PA + (size_t)T_TOK * 4096 * 2;
constexpr size_t WS_E     = WS_PG + (size_t)T_TOK * 4096 * 2;
constexpr size_t WS_YA    = WS_E + (size_t)2 * 64 * 128 * 64 * 8;
constexpr size_t WS_ATT   = WS_YA + (size_t)T_TOK * 1024 * 2;
constexpr size_t WS_UB    = WS_ATT + (size_t)T_TOK * 1024 * 2;
constexpr size_t WS_SA    = WS_UB + (size_t)T_TOK * 1024 * 2;
constexpr size_t WS_SB    = WS_SA + (size_t)T_TOK * 4;
constexpr size_t WS_CMAXP = WS_SB + (size_t)8192 * 4;
constexpr size_t WS_END   = WS_CMAXP + (size_t)32 * 8192 * 4;
constexpr size_t WS_SC    = WS_PA;
constexpr size_t WS_UT    = WS_PG;
constexpr size_t WS_VT    = WS_PG + (size_t)8 * 16384 * 192;
constexpr size_t WS_PDOT  = WS_VT + (size_t)8 * 16384 * 192;
constexpr size_t WS_IDX   = WS_YA;
constexpr size_t WS_GATE  = WS_YA + (size_t)T_TOK * 128 * 4;
constexpr size_t WS_ACT   = WS_GATE + (size_t)T_TOK * 128 * 4;
static_assert(WS_PDOT + (size_t)8 * T_TOK * 128 * 4 <= WS_PG + (size_t)T_TOK * 4096 * 2, "PEER buffers must fit the dead g_ssm|g_att region");
static_assert(WS_ACT + (size_t)T_TOK * 128 * 4 <= WS_YA + (size_t)T_TOK * 1024 * 2, "PEER index buffers must fit the dead YA region");
constexpr int LDS_MAIN = 131072, LDS_BYTES = LDS_MAIN + 256;

typedef __bf16 bf16x2_t __attribute__((ext_vector_type(2)));
__device__ __forceinline__ unsigned cvt_pk_bf16(float lo, float hi) { const f32x2 v = {lo, hi}; return __builtin_bit_cast(unsigned, __builtin_convertvector(v, bf16x2_t)); }
__device__ __forceinline__ float bf_lo(unsigned w) { return __uint_as_float(w << 16); }
__device__ __forceinline__ float bf_hi(unsigned w) { return __uint_as_float(w & 0xffff0000u); }
__device__ __forceinline__ float wave_sum(float v) {
#pragma unroll
    for (int o = 1; o < 64; o <<= 1) v += __shfl_xor(v, o);
    return v;
}
__device__ __forceinline__ float sigmoidf_(float x) { return __builtin_amdgcn_rcpf(1.0f + __builtin_amdgcn_exp2f(-1.4426950408889634f * x)); }
__device__ __forceinline__ float gelu_tanh(float x) {
    const float a2 = (-2.0f * 0.7978845608028654f * 1.4426950408889634f) * (x + 0.044715f * x * x * x);
    return x * __builtin_amdgcn_rcpf(1.0f + __builtin_amdgcn_exp2f(a2));
}
constexpr float F8_SA = 8.0f, F8_SW = 64.0f, F8_INV = 1.0f / 512.0f;
__device__ __forceinline__ unsigned pack4_fp8(float a, float b, float c, float d, float sc) {
    a = fminf(fmaxf(a * sc, -448.f), 448.f); b = fminf(fmaxf(b * sc, -448.f), 448.f); c = fminf(fmaxf(c * sc, -448.f), 448.f); d = fminf(fmaxf(d * sc, -448.f), 448.f);
    int p = 0; p = __builtin_amdgcn_cvt_pk_fp8_f32(a, b, p, false); p = __builtin_amdgcn_cvt_pk_fp8_f32(c, d, p, true); return (unsigned)p; }
__device__ __forceinline__ float sum8_dpp(float v) {
    v += __builtin_bit_cast(float, __builtin_amdgcn_update_dpp(0, __builtin_bit_cast(int, v), 0xB1, 0xF, 0xF, true));
    v += __builtin_bit_cast(float, __builtin_amdgcn_update_dpp(0, __builtin_bit_cast(int, v), 0x4E, 0xF, 0xF, true));
    v += __builtin_bit_cast(float, __builtin_amdgcn_update_dpp(0, __builtin_bit_cast(int, v), 0x141, 0xF, 0xF, true));
    return v; }
#define LDS_WAIT() asm volatile("s_waitcnt lgkmcnt(0)" ::: "memory")
__device__ __forceinline__ int opaque_tid() { int t = threadIdx.x; asm volatile("" : "+v"(t)); return t; }

#define XB_TMO      128
#define XB_XCNT(j)  (256  + 64 * (j))
#define XB_XSUB(j)  (1280 + 64 * (j))
#define XB_XGEN(j)  (2304 + 64 * (j))
#define XB_TOP      3328
#define XB_TOPGEN   3392
#define XCD_BAR_WORDS 3456
#define XB_SPIN_CAP (1u << 22)
__device__ __forceinline__ unsigned xb_ld(unsigned* p)              { return __hip_atomic_load(p, __ATOMIC_RELAXED, __HIP_MEMORY_SCOPE_AGENT); }
__device__ __forceinline__ unsigned xb_add(unsigned* p, unsigned v) { return __hip_atomic_fetch_add(p, v, __ATOMIC_RELAXED, __HIP_MEMORY_SCOPE_AGENT); }
__device__ __forceinline__ unsigned xb_xcc_id() { return (unsigned)__builtin_amdgcn_s_getreg((3 << 11) | 20) & 0xFu; }
#define XB_SPIN(cond, bar) do { unsigned _sp = 0; while (cond) { __builtin_amdgcn_s_sleep(1); \
    if ((++_sp & 255u) == 0u) { if (xb_ld(&(bar)[XB_TMO])) break; if (_sp > XB_SPIN_CAP) { atomicAdd(&(bar)[XB_TMO], 1u); break; } } } } while (0)
struct XcdBarrier { unsigned* bar; unsigned x; volatile LAS unsigned* st; };
__device__ __forceinline__ XcdBarrier xcd_barrier_post(unsigned* bar, volatile LAS unsigned* st) {
    XcdBarrier b; b.bar = bar; b.x = xb_xcc_id(); b.st = st;
    if (threadIdx.x == 0) (void)xb_add(&bar[XB_XCNT(b.x)], 1u);
    return b;
}
__device__ __forceinline__ void xcd_barrier_complete(unsigned* bar, unsigned x, unsigned& nloc, unsigned& nx) {
    const unsigned G = gridDim.x * gridDim.y * gridDim.z;
    unsigned sum, cnt, mine, sp = 0u;
    for (;;) {
        sum = 0u; cnt = 0u; mine = 0u;
#pragma unroll
        for (unsigned j = 0; j < 16; ++j) { const unsigned c = xb_ld(&bar[XB_XCNT(j)]); sum += c; cnt += (c > 0u) ? 1u : 0u; mine = (j == x) ? c : mine; }
        if (sum == G) break;
        __builtin_amdgcn_s_sleep(1);
        if ((++sp & 255u) == 0u) { if (xb_ld(&bar[XB_TMO])) break; if (sp > XB_SPIN_CAP) { atomicAdd(&bar[XB_TMO], 1u); break; } }
    }
    nloc = mine > 0u ? mine : 1u; nx = cnt > 0u ? cnt : 1u;
}
__device__ __forceinline__ void xcd_barrier(const XcdBarrier& b) {
    asm volatile("s_waitcnt vmcnt(0)" ::: "memory");
    __syncthreads();
    if (threadIdx.x == 0) {
        unsigned* bar = b.bar;
        __builtin_amdgcn_s_waitcnt(0);
        unsigned nloc = b.st[0], nx = b.st[1];
        if (nloc == 0u) { xcd_barrier_complete(bar, b.x, nloc, nx); b.st[0] = nloc; b.st[1] = nx; }
        const unsigned old = xb_add(&bar[XB_XSUB(b.x)], 1u);
        const unsigned gen = old / nloc;
        if (old + 1u == (gen + 1u) * nloc) {
            __builtin_amdgcn_fence(__ATOMIC_RELEASE, "agent");
            asm volatile("s_waitcnt vmcnt(0)" ::: "memory");
            const unsigned og = xb_add(&bar[XB_TOP], 1u);
            const unsigned tg = og / nx;
            if (og + 1u == (tg + 1u) * nx) xb_add(&bar[XB_TOPGEN], 1u);
            else XB_SPIN(xb_ld(&bar[XB_TOPGEN]) == tg, bar);
            __builtin_amdgcn_fence(__ATOMIC_ACQUIRE, "agent");
            xb_add(&bar[XB_XGEN(b.x)], 1u);
            asm volatile("s_waitcnt vmcnt(0)" ::: "memory");
        } else {
            XB_SPIN(xb_ld(&bar[XB_XGEN(b.x)]) == gen, bar);
            __builtin_amdgcn_fence(__ATOMIC_ACQUIRE, "agent");
            asm volatile("s_waitcnt vmcnt(0)" ::: "memory");
        }
    }
    __syncthreads();
}

namespace pg8 {
constexpr int BM = 256, BK = 64, HALF = 128, HTB = HALF * BK * 2, STAGE_BYTES = 8 * HTB, NXCD = 8, WGM = 8;
__host__ __device__ __forceinline__ int lds_byte(int r, int c) { const int st = (r >> 4) * 2 + (c >> 5), rr = r & 15, cc = c & 31, ob = rr * 64 + cc * 2; return st * 1024 + (ob ^ (((ob >> 9) & 1) << 5)); }
__host__ __device__ __forceinline__ void stage_rc(int b, int& R, int& C) { const int st = b / 1024, sb = b % 1024, swz = sb ^ (((sb >> 9) & 1) << 5); R = (st >> 1) * 16 + swz / 64; C = (st & 1) * 32 + (swz % 64) / 2; }
__host__ __device__ __forceinline__ int perm32(int rho) { const int n = rho >> 4, i = rho & 15; return 8 * (i >> 2) + 4 * n + (i & 3); }
struct Unit { int pm, pn; };
struct Gemm { const bf16_t* A; const bf16_t* Bt; int M, N, K; };
struct StaticOrder {
    int nM, nN, nwg, G, c;
    __host__ __device__ void init(int M, int N, int G_, int c_) { nM = M / BM; nN = N / BM; nwg = nM * nN; G = G_; c = c_; }
    __host__ __device__ bool next(int i, Unit& u) const { return at((long)i * G + c, u); }
    __host__ __device__ bool at(long L, Unit& u) const {
        if (L >= nwg) return false;
        int wgid = (int)L; { const int q = nwg / NXCD, r = nwg % NXCD, xcd = wgid % NXCD, off = wgid / NXCD; wgid = (xcd < r ? xcd * (q + 1) : r * (q + 1) + (xcd - r) * q) + off; }
        const int nig = WGM * nN, gid = wgid / nig, fm = gid * WGM, gsz = (nM - fm) < WGM ? (nM - fm) : WGM;
        u.pm = fm + ((wgid % nig) % gsz); u.pn = (wgid % nig) / gsz; return true;
    }
    __device__ __forceinline__ void a_ready(const Unit&) const {}
    __device__ __forceinline__ void done(const Unit&) const {}
};
struct SplitOrder {
    StaticOrder b;
    __host__ __device__ void init(int M, int N, int G_, int c_) { b.init(M, N, G_, c_); }
    __host__ __device__ bool next(int i, Unit& u) const {
        if (b.G != 256 || b.nwg != 512) return b.next(i, u);
        if (b.c < 128) return false;
        return i < 4 ? b.at((b.c - 128) * 4 + i, u) : false;
    }
    __device__ __forceinline__ void a_ready(const Unit&) const {}
    __device__ __forceinline__ void done(const Unit&) const {}
};
typedef int i32x8 __attribute__((ext_vector_type(8)));
template <class Epi, class Sched, bool ALIGN_EPI = false, bool SP2 = false, int MODE = 0>
__device__ __forceinline__ void gemm_phase(LAS unsigned char* lds, const Gemm g, const Sched& S, const Epi& E) {
    const int tid = threadIdx.x, wid = __builtin_amdgcn_readfirstlane(tid >> 6), lane = tid & 63, wr = wid >> 2, wc = wid & 3, fr = lane & 15, fq = lane >> 4;
    const int K = g.K, nt = K / BK;
    unsigned voffA[2], voffB[2];
#pragma unroll
    for (int i = 0; i < 2; ++i) { int R, C; stage_rc(tid * 16 + i * 8192, R, C); const int Rb = Epi::PERM ? ((R & ~31) + perm32(R & 31)) : R;
        voffA[i] = (unsigned)(R * K + C) * 2u; voffB[i] = (unsigned)(Rb * K + C) * 2u; }
    const size_t kstep = (size_t)(BK * 2);
    const size_t hstep = (size_t)HALF * K * 2;
    const size_t tstep = 2 * hstep;
    const unsigned ldsw = (unsigned)wid * 1024u;
    const int aoff = lds_byte(wr * 64 + fr, fq * 8), boff = lds_byte(wc * 32 + fr, fq * 8);
#define PG8_SA(b, h) (((b) * 2 + (h)) * HTB)
#define PG8_SB(b, h) ((4 + (b) * 2 + (h)) * HTB)
#define PG8_STAGE(bufoff, gbase, voff) do { _Pragma("unroll") for (int _i = 0; _i < 2; ++_i) \
        __builtin_amdgcn_global_load_lds((const unsigned*)((const char*)(gbase) + (voff)[_i]), (LAS unsigned*)(lds + (bufoff) + ldsw + _i * 8192), 16, 0, 0); } while (0)
#define PG8_LD8(p_) ({ const i32x4 _lo = *(const LAS i32x4*)(p_), _hi = *(const LAS i32x4*)((p_) + 1024); (i32x8){_lo[0], _lo[1], _lo[2], _lo[3], _hi[0], _hi[1], _hi[2], _hi[3]}; })
#define PG8_LDA(dst, b, h) do { _Pragma("unroll") for (int m = 0; m < 4; ++m) dst[m] = PG8_LD8(lds + PG8_SA(b, h) + aoff + m * 2048); } while (0)
#define PG8_LDB(dst, b, h) do { _Pragma("unroll") for (int n = 0; n < 2; ++n) dst[n] = PG8_LD8(lds + PG8_SB(b, h) + boff + n * 2048); } while (0)
#define PG8_HALF(v, k) ((k) == 0 ? __builtin_shufflevector(v, v, 0, 1, 2, 3) : __builtin_shufflevector(v, v, 4, 5, 6, 7))
#define PG8_MMA(ai, bj, At, Bt) do { __builtin_amdgcn_s_setprio(1); _Pragma("unroll") for (int m = 0; m < 4; ++m) _Pragma("unroll") for (int n = 0; n < 2; ++n) { \
        if (MODE == 2) asm volatile("v_mfma_scale_f32_16x16x128_f8f6f4 %0, %1, %2, %0, %3, %3 op_sel_hi:[0,0,0]" : "+v"(acc[ai][bj][m][n]) : "v"(Bt[n]), "v"(At[m]), "v"(scl1)); \
        else { _Pragma("unroll") for (int k = 0; k < 2; ++k) \
            acc[ai][bj][m][n] = (MODE == 1) ? __builtin_bit_cast(f32x4, __builtin_amdgcn_mfma_i32_16x16x64_i8(PG8_HALF(Bt[n], k), PG8_HALF(At[m], k), __builtin_bit_cast(i32x4, acc[ai][bj][m][n]), 0, 0, 0)) \
                                            : __builtin_amdgcn_mfma_f32_16x16x32_bf16(__builtin_bit_cast(bf16x8, PG8_HALF(Bt[n], k)), __builtin_bit_cast(bf16x8, PG8_HALF(At[m], k)), acc[ai][bj][m][n], 0, 0, 0); } } __builtin_amdgcn_s_setprio(0); } while (0)
#define PG8_WAIT_V(n) asm volatile("s_waitcnt vmcnt(" #n ")" ::: "memory")
#define PG8_WAIT_L(n) asm volatile("s_waitcnt lgkmcnt(" #n ")" ::: "memory")
#define PG8_BAR __builtin_amdgcn_s_barrier()
#define PG8_SCHED __builtin_amdgcn_sched_barrier(0)
    const int scl1 = 0x7f7f7f7f;
    Unit cur, nxt; int ui = 0;
    if (!S.next(0, cur)) return;
    f32x4 acc[2][2][4][2];
#pragma unroll
    for (int a = 0; a < 2; ++a)
#pragma unroll
        for (int b = 0; b < 2; ++b)
#pragma unroll
            for (int m = 0; m < 4; ++m)
#pragma unroll
                for (int n = 0; n < 2; ++n) acc[a][b][m][n] = (f32x4){0.f, 0.f, 0.f, 0.f};
    i32x8 At[4], B0[2], B1[2];
    const char* cA = (const char*)g.A + (size_t)cur.pm * tstep; const char* cB = (const char*)g.Bt + (size_t)cur.pn * tstep;
    S.a_ready(cur);
    if constexpr (SP2) {
        PG8_STAGE(PG8_SB(0, 0), cB, voffB); PG8_STAGE(PG8_SB(0, 1), cB + hstep, voffB); PG8_STAGE(PG8_SA(0, 0), cA, voffA); PG8_STAGE(PG8_SA(0, 1), cA + hstep, voffA);
        if (wr == 1) PG8_BAR;
        PG8_WAIT_V(2); PG8_BAR;
        PG8_STAGE(PG8_SB(1, 0), cB + kstep, voffB); PG8_STAGE(PG8_SA(1, 0), cA + kstep, voffA); PG8_STAGE(PG8_SB(1, 1), cB + hstep + kstep, voffB);
        PG8_WAIT_V(6); PG8_BAR;
    } else {
        PG8_STAGE(PG8_SB(0, 0), cB, voffB); PG8_STAGE(PG8_SA(0, 0), cA, voffA); PG8_STAGE(PG8_SB(0, 1), cB + hstep, voffB); PG8_STAGE(PG8_SA(0, 1), cA + hstep, voffA);
        if (wr == 1) PG8_BAR;
        PG8_WAIT_V(4); PG8_BAR;
        PG8_STAGE(PG8_SB(1, 0), cB + kstep, voffB); PG8_STAGE(PG8_SA(1, 0), cA + kstep, voffA); PG8_STAGE(PG8_SB(1, 1), cB + hstep + kstep, voffB);
        PG8_WAIT_V(6); PG8_BAR;
    }
    for (;;) {
        const bool has_next = S.next(ui + 1, nxt);
        const char* nA = has_next ? (const char*)g.A + (size_t)nxt.pm * tstep : cA; const char* nB = has_next ? (const char*)g.Bt + (size_t)nxt.pn * tstep : cB;
#pragma unroll 1
        for (int t = 0; t < nt; t += 2) {
            const bool last = (t == nt - 2);
            const char* a1 = cA + (size_t)(t + 1) * kstep;
            const char* a2 = last ? nA : cA + (size_t)(t + 2) * kstep; const char* b2 = last ? nB : cB + (size_t)(t + 2) * kstep;
            const char* a3 = a2 + kstep; const char* b3 = b2 + kstep;
            if (last && has_next) S.a_ready(nxt);
            if constexpr (SP2) {
            PG8_LDB(B0, 0, 0); PG8_LDB(B1, 0, 1); PG8_SCHED; PG8_LDA(At, 0, 0); PG8_STAGE(PG8_SA(1, 1), a1 + hstep, voffA);
            PG8_WAIT_V(8); PG8_WAIT_L(0); PG8_BAR; PG8_MMA(0, 0, At, B0); PG8_MMA(0, 1, At, B1); PG8_BAR; PG8_SCHED;
            PG8_LDA(At, 0, 1); PG8_STAGE(PG8_SB(0, 0), b2, voffB); PG8_STAGE(PG8_SB(0, 1), b2 + hstep, voffB); PG8_STAGE(PG8_SA(0, 0), a2, voffA);
            PG8_WAIT_V(8); PG8_WAIT_L(0); PG8_BAR; PG8_MMA(1, 0, At, B0); PG8_MMA(1, 1, At, B1); PG8_BAR; PG8_SCHED;
            PG8_LDB(B0, 1, 0); PG8_LDB(B1, 1, 1); PG8_SCHED; PG8_LDA(At, 1, 0); PG8_STAGE(PG8_SA(0, 1), a2 + hstep, voffA);
            PG8_WAIT_V(8); PG8_WAIT_L(0); PG8_BAR; PG8_MMA(0, 0, At, B0); PG8_MMA(0, 1, At, B1); PG8_BAR; PG8_SCHED;
            PG8_LDA(At, 1, 1); PG8_STAGE(PG8_SB(1, 0), b3, voffB); PG8_STAGE(PG8_SB(1, 1), b3 + hstep, voffB); PG8_STAGE(PG8_SA(1, 0), a3, voffA);
            PG8_WAIT_V(8); PG8_WAIT_L(0); PG8_BAR; PG8_MMA(1, 0, At, B0); PG8_MMA(1, 1, At, B1); PG8_BAR; PG8_SCHED;
            } else {
            PG8_LDB(B0, 0, 0); PG8_SCHED; PG8_LDA(At, 0, 0); PG8_STAGE(PG8_SA(1, 1), a1 + hstep, voffA);
            PG8_WAIT_L(8); PG8_BAR; PG8_WAIT_L(0); PG8_MMA(0, 0, At, B0); PG8_BAR; PG8_SCHED;
            PG8_LDB(B1, 0, 1); PG8_STAGE(PG8_SB(0, 0), b2, voffB);
            PG8_BAR; PG8_WAIT_L(0); PG8_MMA(0, 1, At, B1); PG8_BAR;
            PG8_LDA(At, 0, 1); PG8_STAGE(PG8_SA(0, 0), a2, voffA);
            PG8_BAR; PG8_WAIT_L(0); PG8_MMA(1, 0, At, B0); PG8_BAR; PG8_SCHED;
            PG8_STAGE(PG8_SB(0, 1), b2 + hstep, voffB);
            PG8_WAIT_V(6); PG8_BAR; PG8_MMA(1, 1, At, B1); PG8_BAR;
            PG8_LDB(B0, 1, 0); PG8_SCHED; PG8_LDA(At, 1, 0); PG8_STAGE(PG8_SA(0, 1), a2 + hstep, voffA);
            PG8_WAIT_L(8); PG8_BAR; PG8_WAIT_L(0); PG8_MMA(0, 0, At, B0); PG8_BAR; PG8_SCHED;
            PG8_LDB(B1, 1, 1); PG8_STAGE(PG8_SB(1, 0), b3, voffB);
            PG8_BAR; PG8_WAIT_L(0); PG8_MMA(0, 1, At, B1); PG8_BAR;
            PG8_LDA(At, 1, 1); PG8_STAGE(PG8_SA(1, 0), a3, voffA);
            PG8_BAR; PG8_WAIT_L(0); PG8_MMA(1, 0, At, B0); PG8_BAR; PG8_SCHED;
            PG8_STAGE(PG8_SB(1, 1), b3 + hstep, voffB);
            PG8_WAIT_V(6); PG8_BAR; PG8_MMA(1, 1, At, B1); PG8_BAR;
            }
        }
        if constexpr (ALIGN_EPI) { if (wr == 0) PG8_BAR; }
        if (MODE == 2) asm volatile("s_nop 15\n\ts_nop 15" ::: "memory");
        E(acc, cur, wr, wc, fr, fq); S.done(cur);
        if (!has_next) break;
#pragma unroll
        for (int a = 0; a < 2; ++a)
#pragma unroll
            for (int b = 0; b < 2; ++b)
#pragma unroll
                for (int m = 0; m < 4; ++m)
#pragma unroll
                    for (int n = 0; n < 2; ++n) acc[a][b][m][n] = (f32x4){0.f, 0.f, 0.f, 0.f};
        cur = nxt; cA = nA; cB = nB; ++ui;
        if constexpr (ALIGN_EPI) { if (wr == 1) PG8_BAR; }
    }
    PG8_WAIT_V(0);
    if constexpr (!ALIGN_EPI) { if (wr == 0) PG8_BAR; }
    PG8_BAR;
#undef PG8_SA
#undef PG8_SB
#undef PG8_STAGE
#undef PG8_LDA
#undef PG8_LDB
#undef PG8_MMA
#undef PG8_WAIT_V
#undef PG8_WAIT_L
#undef PG8_BAR
#undef PG8_SCHED
}

struct EpiProj {
    static constexpr bool PERM = true;
    bf16_t* PA; bf16_t* PG; bf16_t* UB; const float* SA; const float* SB;
    __device__ __forceinline__ void operator()(const f32x4 (&acc)[2][2][4][2], const Unit& u, int wr, int wc, int fr, int fq) const {
        const int row0 = u.pm * BM + wr * 64 + fr; int colt = u.pn * BM; const bool isu = colt < 1024; bf16_t* base = colt < 4096 ? PA : PG;
        const int gcol0 = colt + wc * 32 + 8 * fq; colt &= 4095;
        const int col0 = colt + wc * 32 + 8 * fq;
        f32x4 sb[2][2];
#pragma unroll
        for (int bj = 0; bj < 2; ++bj) { sb[bj][0] = *(const f32x4*)(SB + gcol0 + bj * HALF); sb[bj][1] = *(const f32x4*)(SB + gcol0 + bj * HALF + 4); }
#pragma unroll
        for (int ai = 0; ai < 2; ++ai)
#pragma unroll
            for (int m = 0; m < 4; ++m) { const int row = row0 + ai * HALF + m * 16; bf16_t* rowp = base + (size_t)row * 4096 + col0; const float sa = SA[row];
#pragma unroll
                for (int bj = 0; bj < 2; ++bj) { const i32x4 i0 = __builtin_bit_cast(i32x4, acc[ai][bj][m][0]), i1 = __builtin_bit_cast(i32x4, acc[ai][bj][m][1]);
                    f32x4 v0, v1;
#pragma unroll
                    for (int e = 0; e < 4; ++e) { v0[e] = (float)i0[e] * sa * sb[bj][0][e]; v1[e] = (float)i1[e] * sa * sb[bj][1][e]; }
                    u32x4 w; w.x = cvt_pk_bf16(v0[0], v0[1]); w.y = cvt_pk_bf16(v0[2], v0[3]); w.z = cvt_pk_bf16(v1[0], v1[1]); w.w = cvt_pk_bf16(v1[2], v1[3]);
                    if (isu) { const int cu = col0 + bj * HALF; *(u32x4*)(UB + (((size_t)((row >> 13) * 64 + (cu >> 4)) * 8192 + (row & 8191)) * 16 + (cu & 8))) = w; }
                    else *(u32x4*)(rowp + bj * HALF) = w; } }
    }
};
struct EpiAttUp {
    static constexpr bool PERM = true;
    const bf16_t* PG; bf16_t* HB;
    __device__ __forceinline__ void operator()(const f32x4 (&acc)[2][2][4][2], const Unit& u, int wr, int wc, int fr, int fq) const {
        const int row0 = u.pm * BM + wr * 64 + fr; const int col0 = u.pn * BM + wc * 32 + 8 * fq;
#pragma unroll
        for (int ai = 0; ai < 2; ++ai)
#pragma unroll
            for (int m = 0; m < 4; ++m) { const size_t row = (size_t)(row0 + ai * HALF + m * 16);
#pragma unroll
                for (int bj = 0; bj < 2; ++bj) { const int col = col0 + bj * HALF;
                    const u32x4 gw = *(const u32x4*)(PG + row * 4096 + 2048 + col);
                    const f32x4 v0 = acc[ai][bj][m][0] * F8_INV, v1 = acc[ai][bj][m][1] * F8_INV;
                    u32x4 w;
                    w.x = cvt_pk_bf16(v0[0] * sigmoidf_(bf_lo(gw.x)), v0[1] * sigmoidf_(bf_hi(gw.x)));
                    w.y = cvt_pk_bf16(v0[2] * sigmoidf_(bf_lo(gw.y)), v0[3] * sigmoidf_(bf_hi(gw.y)));
                    w.z = cvt_pk_bf16(v1[0] * sigmoidf_(bf_lo(gw.z)), v1[1] * sigmoidf_(bf_hi(gw.z)));
                    w.w = cvt_pk_bf16(v1[2] * sigmoidf_(bf_lo(gw.w)), v1[3] * sigmoidf_(bf_hi(gw.w)));
                    *(u32x4*)(HB + row * 2048 + col) = w; } asm volatile("" ::: "memory"); }
    }
};
struct EpiGlu {
    static constexpr bool PERM = true;
    const bf16_t* PG; const bf16_t* HB; unsigned char* M8;
    __device__ __forceinline__ void operator()(const f32x4 (&acc)[2][2][4][2], const Unit& u, int wr, int wc, int fr, int fq) const {
        const int row0 = u.pm * BM + wr * 64 + fr; const int col = u.pn * HALF + wc * 32 + 8 * fq;
#pragma unroll
        for (int ai = 0; ai < 2; ++ai)
#pragma unroll
            for (int m = 0; m < 4; ++m) { const size_t row = (size_t)(row0 + ai * HALF + m * 16);
                const u32x4 gw = *(const u32x4*)(PG + row * 4096 + col);
                const u32x4 aw = *(const u32x4*)(HB + row * 2048 + col);
                const f32x4 a0 = acc[ai][0][m][0] * F8_INV, a1 = acc[ai][0][m][1] * F8_INV, g0 = acc[ai][1][m][0] * F8_INV, g1 = acc[ai][1][m][1] * F8_INV;
                u32x2 w;
                w.x = pack4_fp8(sigmoidf_(bf_lo(gw.x)) * a0[0] * sigmoidf_(g0[0]) + bf_lo(aw.x), sigmoidf_(bf_hi(gw.x)) * a0[1] * sigmoidf_(g0[1]) + bf_hi(aw.x),
                                sigmoidf_(bf_lo(gw.y)) * a0[2] * sigmoidf_(g0[2]) + bf_lo(aw.y), sigmoidf_(bf_hi(gw.y)) * a0[3] * sigmoidf_(g0[3]) + bf_hi(aw.y), F8_SA);
                w.y = pack4_fp8(sigmoidf_(bf_lo(gw.z)) * a1[0] * sigmoidf_(g1[0]) + bf_lo(aw.z), sigmoidf_(bf_hi(gw.z)) * a1[1] * sigmoidf_(g1[1]) + bf_hi(aw.z),
                                sigmoidf_(bf_lo(gw.w)) * a1[2] * sigmoidf_(g1[2]) + bf_lo(aw.w), sigmoidf_(bf_hi(gw.w)) * a1[3] * sigmoidf_(g1[3]) + bf_hi(aw.w), F8_SA);
                *(u32x2*)(M8 + row * 2048 + col) = w; asm volatile("" ::: "memory"); }
    }
};
struct EpiOut {
    static constexpr bool PERM = true;
    const float* X; float* O; const float* mod;
    __device__ __forceinline__ void operator()(const f32x4 (&acc)[2][2][4][2], const Unit& u, int wr, int wc, int fr, int fq) const {
        const int row0 = u.pm * BM + wr * 64 + fr; const int col0 = u.pn * BM + wc * 32 + 8 * fq;
        const float* gt = mod + (size_t)((u.pm * BM) >> 13) * 12288 + 4096;
#pragma unroll
        for (int bj = 0; bj < 2; ++bj) { const int col = col0 + bj * HALF;
            const f32x4 g0 = *(const f32x4*)(gt + col), g1 = *(const f32x4*)(gt + col + 4);
#pragma unroll
            for (int ai = 0; ai < 2; ++ai)
#pragma unroll
                for (int m = 0; m < 4; ++m) { const size_t off = (size_t)(row0 + ai * HALF + m * 16) * 2048 + col;
                    const f32x4 x0 = *(const f32x4*)(X + off), x1 = *(const f32x4*)(X + off + 4);
                    *(f32x4*)(O + off) = x0 + g0 * (acc[ai][bj][m][0] * F8_INV); *(f32x4*)(O + off + 4) = x1 + g1 * (acc[ai][bj][m][1] * F8_INV); } }
    }
};
struct EpiF32 {
    static constexpr bool PERM = true;
    float* O;
    __device__ __forceinline__ void operator()(const f32x4 (&acc)[2][2][4][2], const Unit& u, int wr, int wc, int fr, int fq) const {
        const int row0 = u.pm * BM + wr * 64 + fr; const int col0 = u.pn * BM + wc * 32 + 8 * fq;
#pragma unroll
        for (int ai = 0; ai < 2; ++ai)
#pragma unroll
            for (int m = 0; m < 4; ++m) { float* rowp = O + (size_t)(row0 + ai * HALF + m * 16) * 2048 + col0;
#pragma unroll
                for (int bj = 0; bj < 2; ++bj) { *(f32x4*)(rowp + bj * HALF) = acc[ai][bj][m][0]; *(f32x4*)(rowp + bj * HALF + 4) = acc[ai][bj][m][1]; } }
    }
};
}

struct Args { const float* in[25]; float* out; unsigned char* ws; int ph_lo, ph_hi; };
enum { I_X = 0, I_C, I_WADA, I_BADA, I_N1G, I_WIN, I_LRE, I_LIM, I_LDT, I_BRE, I_BIM, I_CRE, I_CIM, I_SD, I_WGLU, I_QNG, I_KNG, I_WATT, I_WOUT, I_N2G, I_WQ, I_K1, I_K2, I_PU, I_PV };

__device__ __forceinline__ void ph_mod_partial(const float* __restrict__ c, const float* __restrict__ w_ada, float* modp, int gw, int ngw, int lane) {
    for (int task = gw; task < 48 * 32; task += ngw) {
        const int strip = task % 48, ks = task / 48, n0 = strip * 256 + lane * 4, k0 = ks * 64;
        f32x4 a0 = {0.f, 0.f, 0.f, 0.f}, a1 = {0.f, 0.f, 0.f, 0.f};
#pragma unroll 8
        for (int k = 0; k < 64; ++k) {
            const f32x4 w = *(const f32x4*)(w_ada + (size_t)(k0 + k) * 12288 + n0);
            float c0 = c[k0 + k], c1 = c[2048 + k0 + k];
            c0 = c0 / (1.0f + __expf(-c0)); c1 = c1 / (1.0f + __expf(-c1));
            a0 += c0 * w; a1 += c1 * w;
        }
        *(f32x4*)(modp + (size_t)(ks * 2 + 0) * 12288 + n0) = a0;
        *(f32x4*)(modp + (size_t)(ks * 2 + 1) * 12288 + n0) = a1;
    }
}

__device__ __forceinline__ void ph_colmax_partial(const float* __restrict__ w_in, float* cmaxp, int gw, int ngw, int lane) {
    for (int task = gw; task < 32 * 32; task += ngw) {
        const int strip = task & 31, ks = task >> 5, n0 = strip * 256 + lane * 4, k0 = ks * 64;
        f32x4 m = {0.f, 0.f, 0.f, 0.f};
#pragma unroll 8
        for (int k = 0; k < 64; ++k) { const f32x4 w = *(const f32x4*)(w_in + (size_t)(k0 + k) * 8192 + n0);
            m[0] = fmaxf(m[0], fabsf(w[0])); m[1] = fmaxf(m[1], fabsf(w[1])); m[2] = fmaxf(m[2], fabsf(w[2])); m[3] = fmaxf(m[3], fabsf(w[3])); }
        *(f32x4*)(cmaxp + (size_t)ks * 8192 + n0) = m;
    }
}

__device__ __forceinline__ void transpose_item_f8(const float* __restrict__ W, int K, int N, unsigned char* WT8, int drow0, int scol0, int k0, LAS float* scr, int lane) {
#pragma unroll 8
    for (int i = 0; i < 32; ++i) { const int kk = 2 * i + (lane >> 5); scr[kk * 33 + (lane & 31)] = W[(size_t)(k0 + kk) * N + scol0 + (lane & 31)]; }
    LDS_WAIT();
    const int n = lane >> 1, half = lane & 1;
    const LAS float* s = scr + (32 * half) * 33 + n;
    u32x4 o[2];
#pragma unroll
    for (int q = 0; q < 8; ++q) o[q >> 2][q & 3] = pack4_fp8(s[(4 * q) * 33], s[(4 * q + 1) * 33], s[(4 * q + 2) * 33], s[(4 * q + 3) * 33], F8_SW);
    *(u32x4*)(WT8 + (size_t)(drow0 + n) * K + k0 + 32 * half) = o[0];
    *(u32x4*)(WT8 + (size_t)(drow0 + n) * K + k0 + 32 * half + 16) = o[1];
    LDS_WAIT();
}
__device__ __forceinline__ void transpose_item_i8(const float* __restrict__ W, signed char* WT8, const float* cmaxp, float* SB, int n0, int k0, LAS float* scr, int lane) {
#pragma unroll 8
    for (int i = 0; i < 32; ++i) { const int kk = 2 * i + (lane >> 5); scr[kk * 33 + (lane & 31)] = W[(size_t)(k0 + kk) * 8192 + n0 + (lane & 31)]; }
    const int n = lane >> 1, half = lane & 1;
    float cm = 0.f;
#pragma unroll 8
    for (int ks = 0; ks < 32; ++ks) cm = fmaxf(cm, cmaxp[(size_t)ks * 8192 + n0 + n]);
    const float sb = fmaxf(cm, 1e-30f) * (1.0f / 127.0f), inv = 1.0f / sb;
    if (k0 == 0 && half == 0) SB[n0 + n] = sb;
    LDS_WAIT();
    const LAS float* s = scr + (32 * half) * 33 + n;
    u32x4 o[2];
#pragma unroll
    for (int q = 0; q < 8; ++q) { unsigned w = 0;
#pragma unroll
        for (int e = 0; e < 4; ++e) { const int v = (int)rintf(s[(4 * q + e) * 33] * inv); w |= ((unsigned)v & 0xffu) << (8 * e); }
        o[q >> 2][q & 3] = w; }
    *(u32x4*)(WT8 + (size_t)(n0 + n) * 2048 + k0 + 32 * half) = o[0];
    *(u32x4*)(WT8 + (size_t)(n0 + n) * 2048 + k0 + 32 * half + 16) = o[1];
    LDS_WAIT();
}

__device__ __forceinline__ void transpose_item(const float* __restrict__ W, int K, int N, bf16_t* WT, int drow0, int scol0, int k0, LAS float* scr, int lane) {
#pragma unroll 8
    for (int i = 0; i < 32; ++i) { const int kk = 2 * i + (lane >> 5); scr[kk * 33 + (lane & 31)] = W[(size_t)(k0 + kk) * N + scol0 + (lane & 31)]; }
    LDS_WAIT();
    const int c = lane & 7;
#pragma unroll
    for (int j = 0; j < 4; ++j) { const int n = (lane >> 3) + 8 * j; const LAS float* s = scr + (8 * c) * 33 + n;
        u32x4 o; o.x = cvt_pk_bf16(s[0 * 33], s[1 * 33]); o.y = cvt_pk_bf16(s[2 * 33], s[3 * 33]); o.z = cvt_pk_bf16(s[4 * 33], s[5 * 33]); o.w = cvt_pk_bf16(s[6 * 33], s[7 * 33]);
        *(u32x4*)(WT + (size_t)(drow0 + n) * K + k0 + 8 * c) = o; }
    LDS_WAIT();
}
__device__ __forceinline__ void wsc_item(const float* wq, const float* kk, bf16_t* out, int lane) {
    const int r = lane & 15, q = lane >> 4;
    f32x4 acc[8];
#pragma unroll
    for (int f = 0; f < 8; ++f) acc[f] = (f32x4){0.f, 0.f, 0.f, 0.f};
    const float* ap = kk + r * 128 + 4 * q; const float* bp = wq + (size_t)r * 2048 + 4 * q;
#pragma unroll 2
    for (int d0 = 0; d0 < 128; d0 += 16) {
        const f32x4 bv = *(const f32x4*)(bp + d0);
        f32x4 av[8];
#pragma unroll
        for (int f = 0; f < 8; ++f) av[f] = *(const f32x4*)(ap + f * 2048 + d0);
#pragma unroll
        for (int j = 0; j < 4; ++j)
#pragma unroll
            for (int f = 0; f < 8; ++f) acc[f] = __builtin_amdgcn_mfma_f32_16x16x4f32(av[f][j], bv[j], acc[f], 0, 0, 0);
    }
#pragma unroll
    for (int f = 0; f < 8; ++f)
#pragma unroll
        for (int i = 0; i < 4; ++i) out[(size_t)(16 * f + 4 * q + i) * 2048 + r] = (bf16_t)(cvt_pk_bf16(acc[f][i], 0.f) & 0xffffu);
}
__device__ __forceinline__ void ph_prologue(const Args& a, LAS unsigned char* lds, int gw, int ngw, int lane, int wave) {
    unsigned char* ws = a.ws;
    { const float* modp = (const float*)(ws + WS_MODP); float* mod = (float*)(ws + WS_MOD); const float* b_ada = a.in[I_BADA];
      for (int idx = gw * 64 + lane; idx < 2 * 12288; idx += ngw * 64) { const int b = idx / 12288, n = idx - b * 12288; float s = b_ada[n];
#pragma unroll 8
          for (int ks = 0; ks < 32; ++ks) s += modp[(size_t)(ks * 2 + b) * 12288 + n];
          mod[idx] = s; } }
    for (int item = gw; item < 2048; item += ngw) { const int hj = item >> 7, k0 = (item & 127) * 16;
        wsc_item(a.in[I_WQ] + (size_t)k0 * 2048 + hj * 128, (hj & 1) ? a.in[I_K2] : a.in[I_K1], (bf16_t*)(ws + WS_WSC) + (size_t)(hj * 128) * 2048 + k0, lane); }
    { LAS float* scr = (LAS float*)(lds + wave * 8448);
      constexpr int I_IN = 32 * 256, I_GLU = 16 * 128, I_ATT = 16 * 64, I_OUT = 32 * 64, NIT = I_IN + I_GLU + I_ATT + I_OUT;
      for (int it = gw; it < NIT; it += ngw) {
          int r = it;
          if (r < I_IN) { const int kb = r / 256, nb = r % 256; transpose_item_i8(a.in[I_WIN], (signed char*)(ws + WS_WIN), (const float*)(ws + WS_CMAXP), (float*)(ws + WS_SB), 32 * nb, 64 * kb, scr, lane); continue; } r -= I_IN;
          if (r < I_GLU) { const int kb = r / 128, nb = r % 128, dr = 32 * nb; const int sc = ((dr >> 7) & 1) * 2048 + (dr >> 8) * 128 + (dr & 127);
              transpose_item_f8(a.in[I_WGLU], 1024, 4096, ws + WS_WGLU, dr, sc, 64 * kb, scr, lane); continue; } r -= I_GLU;
          if (r < I_ATT) { const int kb = r / 64, nb = r % 64; transpose_item_f8(a.in[I_WATT], 1024, 2048, ws + WS_WATT, 32 * nb, 32 * nb, 64 * kb, scr, lane); continue; } r -= I_ATT;
          { const int kb = r / 64, nb = r % 64; transpose_item_f8(a.in[I_WOUT], 2048, 2048, ws + WS_WOUT, 32 * nb, 32 * nb, 64 * kb, scr, lane); }
      } }
}

template <bool I8>
__device__ __forceinline__ void ph_norm(const float* X, bf16_t* Hout, float* SA, const float* __restrict__ g, const float* mod, int sh_off, int sc_off, int gw, int ngw, int lane) {
    for (int row = gw; row < T_TOK; row += ngw) {
        const int b = row >> 13;
        const f32x4* xr = (const f32x4*)(X + (size_t)row * DM) + lane;
        f32x4 v[8]; float ss = 0.f;
#pragma unroll
        for (int j = 0; j < 8; ++j) { v[j] = xr[64 * j]; ss += (v[j][0] * v[j][0] + v[j][1] * v[j][1]) + (v[j][2] * v[j][2] + v[j][3] * v[j][3]); }
        ss = wave_sum(ss);
        const float rs = __builtin_amdgcn_rsqf(ss * (1.0f / DM) + EPS);
        const float* mb = mod + (size_t)b * 12288;
        float amax = 0.f;
#pragma unroll
        for (int j = 0; j < 8; ++j) { const int col = 4 * (lane + 64 * j);
            const f32x4 gv = *(const f32x4*)(g + col), sc = *(const f32x4*)(mb + sc_off + col), sh = *(const f32x4*)(mb + sh_off + col);
            const f32x4 o = v[j] * rs * gv * (sc + 1.0f) + sh;
            if (I8) { v[j] = o; amax = fmaxf(fmaxf(amax, fmaxf(fabsf(o[0]), fabsf(o[1]))), fmaxf(fabsf(o[2]), fabsf(o[3]))); }
            else { u32x2 w; w.x = cvt_pk_bf16(o[0], o[1]); w.y = cvt_pk_bf16(o[2], o[3]); *(u32x2*)(Hout + (size_t)row * DM + col) = w; } }
        if (I8) {
#pragma unroll
            for (int o = 1; o < 64; o <<= 1) amax = fmaxf(amax, __shfl_xor(amax, o));
            const float sa = fmaxf(amax, 1e-30f) * (1.0f / 127.0f), inv = 1.0f / sa;
            if (lane == 0) SA[row] = sa;
            unsigned* h8 = (unsigned*)((signed char*)Hout + (size_t)row * DM) + lane;
#pragma unroll
            for (int j = 0; j < 8; ++j) { unsigned w = 0;
#pragma unroll
                for (int e = 0; e < 4; ++e) { const int q = (int)rintf(v[j][e] * inv); w |= ((unsigned)q & 0xffu) << (8 * e); }
                h8[64 * j] = w; }
        }
    }
}

template <int MODE>
__device__ __forceinline__ void ph_attn(LAS unsigned char* lds, const bf16_t* PA, bf16_t* ATT, const float* __restrict__ qg, const float* __restrict__ kg, int G) {
    const int tid = opaque_tid(), lane = tid & 63, wave = __builtin_amdgcn_readfirstlane(tid >> 6), c = lane & 15, g = lane >> 4;
    LAS unsigned char* KL = lds;
    LAS unsigned char* VT = lds + 17408;
    bf16x8 tri[6];
    { const int FS[6] = {0, 1, 0, 1, 2, 3}, FP[6] = {0, 0, 1, 1, 1, 1};
#pragma unroll
      for (int q = 0; q < 6; ++q)
#pragma unroll
          for (int jj = 0; jj < 8; ++jj) { const int kap = 32 * FP[q] + 16 * (jj >> 2) + 4 * g + (jj & 3); tri[q][jj] = (kap > 16 * FS[q] + c) ? (short)0x3F80 : (short)0; } }
    for (int u = blockIdx.x; u < 1024; u += G) {
        const int b = u >> 9, h = (u >> 6) & 7, qb = u & 63, t0 = qb * 128, tq0 = t0 + 16 * wave, tq = tq0 + c;
        bf16x8 qf[4];
        { const bf16_t* qrow = PA + (size_t)(b * SEQ + tq) * 4096 + 1024 + h * 128;
          u32x4 qr[4]; float ss = 0.f;
#pragma unroll
          for (int kk = 0; kk < 4; ++kk) { qr[kk] = *(const u32x4*)(qrow + 32 * kk + 8 * g);
#pragma unroll
              for (int e = 0; e < 4; ++e) { const float lo = bf_lo(qr[kk][e]), hi = bf_hi(qr[kk][e]); ss += lo * lo + hi * hi; } }
          ss += __shfl_xor(ss, 16); ss += __shfl_xor(ss, 32);
          const float rs = __builtin_amdgcn_rsqf(ss * (1.0f / 128.0f) + EPS) * (0.08838834764831845f * 1.4426950408889634f);
#pragma unroll
          for (int kk = 0; kk < 4; ++kk) { const f32x4 g0 = *(const f32x4*)(qg + 32 * kk + 8 * g), g1 = *(const f32x4*)(qg + 32 * kk + 8 * g + 4);
              u32x4 w;
              w.x = cvt_pk_bf16(bf_lo(qr[kk].x) * rs * g0[0], bf_hi(qr[kk].x) * rs * g0[1]);
              w.y = cvt_pk_bf16(bf_lo(qr[kk].y) * rs * g0[2], bf_hi(qr[kk].y) * rs * g0[3]);
              w.z = cvt_pk_bf16(bf_lo(qr[kk].z) * rs * g1[0], bf_hi(qr[kk].z) * rs * g1[1]);
              w.w = cvt_pk_bf16(bf_lo(qr[kk].w) * rs * g1[2], bf_hi(qr[kk].w) * rs * g1[3]);
              qf[kk] = __builtin_bit_cast(bf16x8, w); } }
        float carry = 0.f; int wdone = 0;
        f32x4 oacc[8];
#pragma unroll
        for (int fd = 0; fd < 8; ++fd) oacc[fd] = (f32x4){0.f, 0.f, 0.f, 0.f};
        u32x4 kreg[2], vreg[2];
        { const int k0n = (2 * qb + 1) * 64;
#pragma unroll
          for (int p = 0; p < 2; ++p) { const int ci = tid + 512 * p, key = ci >> 4, ch = ci & 15;
              kreg[p] = *(const u32x4*)(PA + (size_t)(b * SEQ + k0n + key) * 4096 + 2048 + h * 128 + 8 * ch);
              vreg[p] = *(const u32x4*)(PA + (size_t)(b * SEQ + k0n + lane) * 4096 + 3072 + h * 128 + 8 * (wave + 8 * p)); } }
        for (int kt = 2 * qb + 1; kt >= 0; --kt) {
            const int k0 = kt * 64;
            if (__syncthreads_and(wdone)) break;
#pragma unroll
            for (int p = 0; p < 2; ++p) {
                const int ci = tid + 512 * p, key = ci >> 4, ch = ci & 15;
                const u32x4 kr = kreg[p];
                float f[8]; f[0] = bf_lo(kr.x); f[1] = bf_hi(kr.x); f[2] = bf_lo(kr.y); f[3] = bf_hi(kr.y); f[4] = bf_lo(kr.z); f[5] = bf_hi(kr.z); f[6] = bf_lo(kr.w); f[7] = bf_hi(kr.w);
                float ss = 0.f;
#pragma unroll
                for (int e = 0; e < 8; ++e) ss += f[e] * f[e];
                ss += __shfl_xor(ss, 1); ss += __shfl_xor(ss, 2); ss += __shfl_xor(ss, 4); ss += __shfl_xor(ss, 8);
                const float rs = __builtin_amdgcn_rsqf(ss * (1.0f / 128.0f) + EPS);
                const f32x4 g0 = *(const f32x4*)(kg + 8 * ch), g1 = *(const f32x4*)(kg + 8 * ch + 4);
                u32x4 w;
                w.x = cvt_pk_bf16(f[0] * rs * g0[0], f[1] * rs * g0[1]); w.y = cvt_pk_bf16(f[2] * rs * g0[2], f[3] * rs * g0[3]);
                w.z = cvt_pk_bf16(f[4] * rs * g1[0], f[5] * rs * g1[1]); w.w = cvt_pk_bf16(f[6] * rs * g1[2], f[7] * rs * g1[3]);
                *(LAS u32x4*)(KL + key * 272 + ch * 16) = w;
            }
#pragma unroll
            for (int p = 0; p < 2; ++p) {
                const int key = lane, ch = wave + 8 * p;
                const u32x4 vr = vreg[p];
                LAS unsigned short* vt = (LAS unsigned short*)(VT + (8 * ch) * 144 + key * 2);
                vt[0 * 72] = (unsigned short)(vr.x & 0xffffu); vt[1 * 72] = (unsigned short)(vr.x >> 16);
                vt[2 * 72] = (unsigned short)(vr.y & 0xffffu); vt[3 * 72] = (unsigned short)(vr.y >> 16);
                vt[4 * 72] = (unsigned short)(vr.z & 0xffffu); vt[5 * 72] = (unsigned short)(vr.z >> 16);
                vt[6 * 72] = (unsigned short)(vr.w & 0xffffu); vt[7 * 72] = (unsigned short)(vr.w >> 16);
            }
            if (kt > 0) { const int k0n = k0 - 64;
#pragma unroll
                for (int p = 0; p < 2; ++p) { const int ci = tid + 512 * p, key = ci >> 4, ch = ci & 15;
                    kreg[p] = *(const u32x4*)(PA + (size_t)(b * SEQ + k0n + key) * 4096 + 2048 + h * 128 + 8 * ch);
                    vreg[p] = *(const u32x4*)(PA + (size_t)(b * SEQ + k0n + lane) * 4096 + 3072 + h * 128 + 8 * (wave + 8 * p)); } }
            __syncthreads();
            if (MODE == 1) { if (kt <= 2 * qb - 3) wdone = 1; }
            if (MODE == 0 && !wdone && k0 < tq0 + 15) {
                f32x4 zt[4];
#pragma unroll
                for (int f = 0; f < 4; ++f) { f32x4 acc = {0.f, 0.f, 0.f, 0.f};
#pragma unroll
                    for (int kk = 0; kk < 4; ++kk) { const bf16x8 kf = *(const LAS bf16x8*)(KL + (16 * f + c) * 272 + (32 * kk + 8 * g) * 2);
                        acc = __builtin_amdgcn_mfma_f32_16x16x32_bf16(kf, qf[kk], acc, 0, 0, 0); }
                    zt[f] = acc; }
                float lf[4][4], lz[4][4]; float tot = 0.f;
                if (k0 + 63 >= tq0) {
#pragma unroll
                    for (int f = 0; f < 4; ++f)
#pragma unroll
                        for (int i = 0; i < 4; ++i) { const int s = k0 + 16 * f + 4 * g + i; const bool valid = s < tq; const float z = zt[f][i];
                            const float sp = fmaxf(z, 0.f) + __builtin_amdgcn_logf(1.0f + __builtin_amdgcn_exp2f(-fabsf(z)));
                            const float l = valid ? -sp : 0.f; lf[f][i] = l; lz[f][i] = valid ? (l + z) : -INFINITY; tot += l; }
                } else {
#pragma unroll
                    for (int f = 0; f < 4; ++f)
#pragma unroll
                        for (int i = 0; i < 4; ++i) { const float z = zt[f][i];
                            const float l = -(fmaxf(z, 0.f) + __builtin_amdgcn_logf(1.0f + __builtin_amdgcn_exp2f(-fabsf(z)))); lf[f][i] = l; lz[f][i] = l + z; tot += l; }
                }
                tot += __shfl_xor(tot, 16); tot += __shfl_xor(tot, 32);
                bf16x8 lh[2];
#pragma unroll
                for (int fp = 0; fp < 2; ++fp) { u32x4 wh;
#pragma unroll
                    for (int q = 0; q < 2; ++q) { const int f = 2 * fp + q; wh[2 * q] = cvt_pk_bf16(lf[f][0], lf[f][1]); wh[2 * q + 1] = cvt_pk_bf16(lf[f][2], lf[f][3]); }
                    lh[fp] = __builtin_bit_cast(bf16x8, wh); }
                f32x4 sf[4];
                { f32x4 z4 = {0.f, 0.f, 0.f, 0.f};
                  sf[0] = __builtin_amdgcn_mfma_f32_16x16x32_bf16(tri[0], lh[0], z4, 0, 0, 0); sf[0] = __builtin_amdgcn_mfma_f32_16x16x32_bf16(tri[2], lh[1], sf[0], 0, 0, 0);
                  sf[1] = __builtin_amdgcn_mfma_f32_16x16x32_bf16(tri[1], lh[0], z4, 0, 0, 0); sf[1] = __builtin_amdgcn_mfma_f32_16x16x32_bf16(tri[3], lh[1], sf[1], 0, 0, 0);
                  sf[2] = __builtin_amdgcn_mfma_f32_16x16x32_bf16(tri[4], lh[1], z4, 0, 0, 0);
                  sf[3] = __builtin_amdgcn_mfma_f32_16x16x32_bf16(tri[5], lh[1], z4, 0, 0, 0); }
                bf16x8 pb[2];
#pragma unroll
                for (int fp = 0; fp < 2; ++fp) { u32x4 w;
#pragma unroll
                    for (int q = 0; q < 2; ++q) { const int f = 2 * fp + q; float p[4];
#pragma unroll
                        for (int i = 0; i < 4; ++i) p[i] = __builtin_amdgcn_exp2f(lz[f][i] + sf[f][i] + carry);
                        w[2 * q] = cvt_pk_bf16(p[0], p[1]); w[2 * q + 1] = cvt_pk_bf16(p[2], p[3]); }
                    pb[fp] = __builtin_bit_cast(bf16x8, w); }
                carry += tot;
#pragma unroll
                for (int fd = 0; fd < 8; ++fd)
#pragma unroll
                    for (int fp = 0; fp < 2; ++fp) { const LAS unsigned char* vp = VT + (16 * fd + c) * 144 + (32 * fp + 4 * g) * 2;
                        const u32x2 v0 = *(const LAS u32x2*)vp, v1 = *(const LAS u32x2*)(vp + 32);
                        u32x4 vw; vw.x = v0.x; vw.y = v0.y; vw.z = v1.x; vw.w = v1.y;
                        oacc[fd] = __builtin_amdgcn_mfma_f32_16x16x32_bf16(__builtin_bit_cast(bf16x8, vw), pb[fp], oacc[fd], 0, 0, 0); }
                wdone = (__ballot(carry >= -152.0f) == 0ull) ? 1 : 0;
            }
        }
        if (MODE == 0) { unsigned char* orow = (unsigned char*)ATT + (size_t)(b * SEQ + tq) * 1024 + h * 128 + 4 * g;
#pragma unroll
          for (int fd = 0; fd < 8; ++fd) *(unsigned*)(orow + 16 * fd) = pack4_fp8(oacc[fd][0], oacc[fd][1], oacc[fd][2], oacc[fd][3], F8_SA); }
    }
    __syncthreads();
}

__device__ __forceinline__ void ssm_lambda(const Args& a, int g, int st, float& lbr, float& lbi, float& qr, float& qi) {
    const float lr = a.in[I_LRE][g * 64 + st], li = a.in[I_LIM][g * 64 + st], dt = __expf(a.in[I_LDT][g]);
    const float mag = __expf(lr * dt);
    float rev = li * dt * 0.15915494309189535f; rev -= rintf(rev);
    lbr = mag * __builtin_amdgcn_cosf(rev); lbi = mag * __builtin_amdgcn_sinf(rev);
    const float nr = lbr - 1.0f, ni = lbi, den = 1.0f / (lr * lr + li * li);
    qr = (nr * lr + ni * li) * den; qi = (ni * lr - nr * li) * den;
}
template <bool WITH_Y>
__device__ __forceinline__ void ph_ssm_mfma(const Args& a, LAS unsigned char* lds, const bf16_t* UB, f32x2* E, bf16_t* YA, int G) {
    const int tid = opaque_tid(), lane = tid & 63, wave = __builtin_amdgcn_readfirstlane(tid >> 6), c = lane & 15, gl = lane >> 4;
    LAS f32x2* sl = (LAS f32x2*)(lds + wave * 8192);
    LAS f32x4* tab = (LAS f32x4*)(lds + 65536 + wave * 1024);
    LAS u32x4* cml = (LAS u32x4*)(lds + 73728 + wave * 5120) + lane;
    for (int item = blockIdx.x; item < 128; item += G) {
        const int b = item >> 6, cb = (item >> 3) & 7, g = (item & 7) * 8 + wave, c0 = cb * 16;
        float mur, mui;
        { float lbr, lbi, qr, qi; ssm_lambda(a, g, lane, lbr, lbi, qr, qi); tab[lane] = (f32x4){lbr, lbi, qr, qi}; mur = lbr; mui = lbi; }
        LDS_WAIT();
        bf16x8 bm[8];
        const float* brb = a.in[I_BRE] + (g * 64 + (c >> 1)) * 16 + 8 * (gl & 1); const float* bib = a.in[I_BIM] + (g * 64 + (c >> 1)) * 16 + 8 * (gl & 1);
        const LAS f32x4* tabb = tab + (c >> 1);
#pragma unroll
        for (int f = 0; f < 8; ++f) { const f32x4 tv = tabb[8 * f]; const float qr = tv[2], qi = tv[3];
            const float* br = brb + 128 * f; const float* bim = bib + 128 * f;
            const f32x4 r0 = *(const f32x4*)br, r1 = *(const f32x4*)(br + 4), i0 = *(const f32x4*)bim, i1 = *(const f32x4*)(bim + 4);
            float v[8];
#pragma unroll
            for (int e = 0; e < 4; ++e) { const float vr0 = qr * r0[e] - qi * i0[e], vi0 = qr * i0[e] + qi * r0[e], vr1 = qr * r1[e] - qi * i1[e], vi1 = qr * i1[e] + qi * r1[e];
                v[e] = (c & 1) ? vi0 : vr0; v[4 + e] = (c & 1) ? vi1 : vr1; }
            if (gl >= 2) {
#pragma unroll
                for (int e = 0; e < 8; ++e) v[e] = 0.f; }
            u32x4 w; w.x = cvt_pk_bf16(v[0], v[1]); w.y = cvt_pk_bf16(v[2], v[3]); w.z = cvt_pk_bf16(v[4], v[5]); w.w = cvt_pk_bf16(v[6], v[7]);
            bm[f] = __builtin_bit_cast(bf16x8, w); }
        float lmr[16], lmi[16];
#pragma unroll
        for (int k = 0; k < 16; ++k) { const f32x4 tv = tab[2 * gl + 8 * (k >> 1) + (k & 1)]; lmr[k] = tv[0]; lmi[k] = tv[1]; }
        if (WITH_Y) {
            const float* crb = a.in[I_CRE] + (g * 16 + c) * 64 + 2 * gl; const float* cib = a.in[I_CIM] + (g * 16 + c) * 64 + 2 * gl;
#pragma unroll
            for (int kk = 0; kk < 4; ++kk) { float v[8];
#pragma unroll
                for (int jh = 0; jh < 2; ++jh) { const f32x2 r = *(const f32x2*)(crb + 8 * (2 * kk + jh)), m = *(const f32x2*)(cib + 8 * (2 * kk + jh));
                    v[4 * jh] = r.x; v[4 * jh + 1] = -m.x; v[4 * jh + 2] = r.y; v[4 * jh + 3] = -m.y; }
                u32x4 w; w.x = cvt_pk_bf16(v[0], v[1]); w.y = cvt_pk_bf16(v[2], v[3]); w.z = cvt_pk_bf16(v[4], v[5]); w.w = cvt_pk_bf16(v[6], v[7]);
                cml[64 * kk] = w; }
            { const float dv = a.in[I_SD][g * 16 + c]; float v[8];
#pragma unroll
              for (int jj = 0; jj < 8; ++jj) v[jj] = (gl < 2 && (8 * gl + jj) == c) ? dv : 0.f;
              u32x4 w; w.x = cvt_pk_bf16(v[0], v[1]); w.y = cvt_pk_bf16(v[2], v[3]); w.z = cvt_pk_bf16(v[4], v[5]); w.w = cvt_pk_bf16(v[6], v[7]);
              cml[256] = w; }
        }
        f32x4 s[8];
#pragma unroll
        for (int f = 0; f < 8; ++f) s[f] = (f32x4){0.f, 0.f, 0.f, 0.f};
        if (WITH_Y) {
            float pr = mur, pi = mui;
#pragma unroll
            for (int q = 0; q < 6; ++q) { const float nr = pr * pr - pi * pi, ni = 2.0f * pr * pi; pr = nr; pi = ni; }
            float sr = 0.f, si = 0.f;
            const f32x2* ep = E + (size_t)((b * 64 + g) * 128) * 64 + lane;
            f32x2 ev[8], en[8];
#pragma unroll
            for (int k = 0; k < 8; ++k) ev[k] = ep[(size_t)k * 64];
            for (int cc = 0; cc < c0 + 16; cc += 8) {
                if (cc + 8 < c0 + 16) {
#pragma unroll
                    for (int k = 0; k < 8; ++k) en[k] = ep[(size_t)(cc + 8 + k) * 64]; }
#pragma unroll
                for (int k = 0; k < 8; ++k) { if (cc >= c0) sl[(cc - c0 + k) * 64 + lane] = (f32x2){sr, si};
                    const float nr = pr * sr - pi * si + ev[k][0], ni = pr * si + pi * sr + ev[k][1]; sr = nr; si = ni; }
#pragma unroll
                for (int k = 0; k < 8; ++k) ev[k] = en[k];
            }
            LDS_WAIT();
#pragma unroll
            for (int f = 0; f < 8; ++f) s[f] = *(const LAS f32x4*)(sl + c * 64 + 8 * f + 2 * gl);
            LDS_WAIT();
        }
        const bf16_t* up = UB + ((size_t)(b * 64 + g) * 8192 + (size_t)(c0 + c) * 64) * 16 + 8 * (gl & 1);
        unsigned char* yp = (unsigned char*)YA + (size_t)(b * SEQ + (c0 + c) * 64) * 1024 + g * 16 + 4 * gl;
        u32x4 u0 = *(const u32x4*)(up), u1 = *(const u32x4*)(up + 16), u2 = *(const u32x4*)(up + 32), u3 = *(const u32x4*)(up + 48);
#pragma unroll 1
        for (int tau = 0; tau < 64; ++tau) {
            const u32x4 u4 = *(const u32x4*)(up + (size_t)(tau + 4) * 16);
            const bf16x8 uf = __builtin_bit_cast(bf16x8, u0);
#pragma unroll
            for (int f = 0; f < 8; ++f) { f32x4 ci;
                ci[0] = lmr[2 * f] * s[f][0] - lmi[2 * f] * s[f][1]; ci[1] = lmr[2 * f] * s[f][1] + lmi[2 * f] * s[f][0];
                ci[2] = lmr[2 * f + 1] * s[f][2] - lmi[2 * f + 1] * s[f][3]; ci[3] = lmr[2 * f + 1] * s[f][3] + lmi[2 * f + 1] * s[f][2];
                s[f] = __builtin_amdgcn_mfma_f32_16x16x32_bf16(bm[f], uf, ci, 0, 0, 0); }
            if (WITH_Y) {
                f32x4 y = __builtin_amdgcn_mfma_f32_16x16x32_bf16(__builtin_bit_cast(bf16x8, cml[256]), uf, (f32x4){0.f, 0.f, 0.f, 0.f}, 0, 0, 0);
#pragma unroll
                for (int kk = 0; kk < 4; ++kk) { u32x4 w; w.x = cvt_pk_bf16(s[2 * kk][0], s[2 * kk][1]); w.y = cvt_pk_bf16(s[2 * kk][2], s[2 * kk][3]);
                    w.z = cvt_pk_bf16(s[2 * kk + 1][0], s[2 * kk + 1][1]); w.w = cvt_pk_bf16(s[2 * kk + 1][2], s[2 * kk + 1][3]);
                    y = __builtin_amdgcn_mfma_f32_16x16x32_bf16(__builtin_bit_cast(bf16x8, cml[64 * kk]), __builtin_bit_cast(bf16x8, w), y, 0, 0, 0); }
                *(unsigned*)(yp + (size_t)tau * 1024) = pack4_fp8(gelu_tanh(y[0]), gelu_tanh(y[1]), gelu_tanh(y[2]), gelu_tanh(y[3]), F8_SA);
            }
            u0 = u1; u1 = u2; u2 = u3; u3 = u4;
        }
        if (!WITH_Y) { f32x2* eo = E + (size_t)((b * 64 + g) * 128 + c0 + c) * 64 + 2 * gl;
#pragma unroll
            for (int f = 0; f < 8; ++f) *(f32x4*)(eo + 8 * f) = s[f]; }
    }
}

typedef float f32x16 __attribute__((ext_vector_type(16)));
typedef float f32x32 __attribute__((ext_vector_type(32)));
typedef _Float16 f16x2_t __attribute__((ext_vector_type(2)));
typedef _Float16 f16x32_t __attribute__((ext_vector_type(32)));
typedef unsigned u32x6 __attribute__((ext_vector_type(6)));
constexpr float PEER_SU = 64.0f, PEER_SV = 1.4f;
constexpr size_t PEER_SHARD_BYTES = (size_t)16384 * 192;
__device__ __forceinline__ void table_cvt_pack(const f32x4 (&v)[8], float sc, unsigned char* dst, int lane) {
    f32x16 a, b;
#pragma unroll
    for (int q = 0; q < 4; ++q) {
#pragma unroll
        for (int e = 0; e < 4; ++e) { a[4 * q + e] = v[q][e] * sc; b[4 * q + e] = v[4 + q][e] * sc; } }
    const u32x6 p = __builtin_amdgcn_cvt_scalef32_2xpk16_fp6_f32(a, b, 1.0f);
    *(u32x4*)(dst + 16 * (lane & 7)) = (u32x4){p[0], p[1], p[2], p[3]};
    *(u32x2*)(dst + 128 + 8 * (lane & 7)) = (u32x2){p[4], p[5]};
}
__device__ __forceinline__ void ph_table_cvt(const float* __restrict__ U, const float* __restrict__ V, unsigned char* UT, unsigned char* VT, int r0, int r1, int gw, int ngw, int lane) {
    for (int r = r0 + gw; r < r1; r += ngw) {
        const float* su = U + (size_t)r * 2048 + 32 * lane; const float* sv = V + (size_t)r * 2048 + 32 * lane;
        f32x4 vu[8], vv[8];
#pragma unroll
        for (int q = 0; q < 8; ++q) vu[q] = *(const f32x4*)(su + 4 * q);
#pragma unroll
        for (int q = 0; q < 8; ++q) vv[q] = *(const f32x4*)(sv + 4 * q);
        const size_t off = (size_t)(lane >> 3) * PEER_SHARD_BYTES + (size_t)r * 192;
        table_cvt_pack(vu, PEER_SU, UT + off, lane);
        table_cvt_pack(vv, PEER_SV, VT + off, lane);
    }
}

#define TK_CE(a_, b_) do { const float _h = fmaxf(a_, b_), _l = fminf(a_, b_); a_ = _h; b_ = _l; } while (0)
__device__ __forceinline__ void tk_sort16(float (&a)[16]) {
#pragma unroll
    for (int p = 1; p < 16; p *= 2)
#pragma unroll
        for (int k = p; k >= 1; k /= 2)
#pragma unroll
            for (int j = k % p; j <= 15 - k; j += 2 * k)
#pragma unroll
                for (int i = 0; i < k; ++i)
                    if (i + j + k <= 15 && (i + j) / (2 * p) == (i + j + k) / (2 * p)) TK_CE(a[i + j], a[i + j + k]);
}
__device__ __forceinline__ void tk_merge16(float (&t)[16], const float (&g)[16]) {
#pragma unroll
    for (int i = 0; i < 16; ++i) t[i] = fmaxf(t[i], g[15 - i]);
#pragma unroll
    for (int k = 8; k >= 1; k /= 2)
#pragma unroll
        for (int i = 0; i < 16; ++i)
            if ((i & k) == 0) TK_CE(t[i], t[i + k]);
}
__device__ __forceinline__ float tk2_key(float a, float b, int flat) {
    const float sum = __uint_as_float(__float_as_uint(a) & ~127u) + __uint_as_float(__float_as_uint(b) & ~127u);
    return __uint_as_float((__float_as_uint(sum) & ~255u) | (unsigned)(255 - flat)); }
__device__ __forceinline__ void ph_peer_topk(LAS unsigned char* lds, const float* SC, int* idxG, float* gateG, int G) {
    const int tid = opaque_tid(), lane = tid & 63, wave = __builtin_amdgcn_readfirstlane(tid >> 6);
    LAS float* scr = (LAS float*)(lds + wave * 8448);
    for (int it = blockIdx.x; it < 512; it += G) {
        const int tokw = it * 32 + wave * 4;
        float tk[16];
#pragma unroll
        for (int i = 0; i < 16; ++i) tk[i] = -INFINITY;
        f32x4 nv[8];
#pragma unroll
        for (int j = 0; j < 8; ++j) { const int prob = (lane >> 3) + 8 * j, seg = lane & 7; nv[j] = *(const f32x4*)(SC + (size_t)(tokw + (prob >> 4)) * 2048 + (prob & 15) * 128 + 4 * seg); }
        for (int q = 0; q < 4; ++q) {
#pragma unroll
            for (int j = 0; j < 8; ++j) { const int prob = (lane >> 3) + 8 * j, seg = lane & 7; const f32x4 v = nv[j];
                LAS float* d = scr + prob * 33 + 4 * seg; d[0] = v[0]; d[1] = v[1]; d[2] = v[2]; d[3] = v[3]; }
            { const int qn = q < 3 ? q + 1 : 3;
#pragma unroll
              for (int j = 0; j < 8; ++j) { const int prob = (lane >> 3) + 8 * j, seg = lane & 7; nv[j] = *(const f32x4*)(SC + (size_t)(tokw + (prob >> 4)) * 2048 + (prob & 15) * 128 + 32 * qn + 4 * seg); } }
            LDS_WAIT();
#pragma unroll
            for (int hh = 0; hh < 2; ++hh) { float g[16];
#pragma unroll
                for (int i = 0; i < 16; ++i) g[i] = __uint_as_float((__float_as_uint(scr[lane * 33 + 16 * hh + i]) & ~127u) | (unsigned)(127 - (32 * q + 16 * hh + i)));
                tk_sort16(g); tk_merge16(tk, g); }
            LDS_WAIT();
        }
        float t2[16];
#pragma unroll
        for (int i = 0; i < 16; ++i) t2[i] = __shfl_xor(tk[i], 1);
        float bv[16];
        {
          bv[0] = tk2_key(tk[0], t2[0], 0);
          bv[1] = tk2_key(tk[0], t2[1], 1);
          bv[2] = tk2_key(tk[0], t2[2], 2);
          bv[3] = tk2_key(tk[0], t2[3], 3);
          bv[4] = tk2_key(tk[0], t2[4], 4);
          bv[5] = tk2_key(tk[0], t2[5], 5);
          bv[6] = tk2_key(tk[0], t2[6], 6);
          bv[7] = tk2_key(tk[0], t2[7], 7);
          bv[8] = tk2_key(tk[0], t2[8], 8);
          bv[9] = tk2_key(tk[0], t2[9], 9);
          bv[10] = tk2_key(tk[0], t2[10], 10);
          bv[11] = tk2_key(tk[0], t2[11], 11);
          bv[12] = tk2_key(tk[0], t2[12], 12);
          bv[13] = tk2_key(tk[0], t2[13], 13);
          bv[14] = tk2_key(tk[0], t2[14], 14);
          bv[15] = tk2_key(tk[0], t2[15], 15);
          tk_sort16(bv);
          { float g[16];
          g[0] = tk2_key(tk[1], t2[0], 16);
          g[1] = tk2_key(tk[1], t2[1], 17);
          g[2] = tk2_key(tk[1], t2[2], 18);
          g[3] = tk2_key(tk[1], t2[3], 19);
          g[4] = tk2_key(tk[1], t2[4], 20);
          g[5] = tk2_key(tk[1], t2[5], 21);
          g[6] = tk2_key(tk[1], t2[6], 22);
          g[7] = tk2_key(tk[1], t2[7], 23);
          g[8] = tk2_key(tk[2], t2[0], 32);
          g[9] = tk2_key(tk[2], t2[1], 33);
          g[10] = tk2_key(tk[2], t2[2], 34);
          g[11] = tk2_key(tk[2], t2[3], 35);
          g[12] = tk2_key(tk[2], t2[4], 36);
          g[13] = tk2_key(tk[3], t2[0], 48);
          g[14] = tk2_key(tk[3], t2[1], 49);
          g[15] = tk2_key(tk[3], t2[2], 50);
          tk_sort16(g); tk_merge16(bv, g); }
          { float g[16];
          g[0] = tk2_key(tk[3], t2[3], 51);
          g[1] = tk2_key(tk[4], t2[0], 64);
          g[2] = tk2_key(tk[4], t2[1], 65);
          g[3] = tk2_key(tk[4], t2[2], 66);
          g[4] = tk2_key(tk[5], t2[0], 80);
          g[5] = tk2_key(tk[5], t2[1], 81);
          g[6] = tk2_key(tk[6], t2[0], 96);
          g[7] = tk2_key(tk[6], t2[1], 97);
          g[8] = tk2_key(tk[7], t2[0], 112);
          g[9] = tk2_key(tk[7], t2[1], 113);
          g[10] = tk2_key(tk[8], t2[0], 128);
          g[11] = tk2_key(tk[9], t2[0], 144);
          g[12] = tk2_key(tk[10], t2[0], 160);
          g[13] = tk2_key(tk[11], t2[0], 176);
          g[14] = tk2_key(tk[12], t2[0], 192);
          g[15] = tk2_key(tk[13], t2[0], 208);
          tk_sort16(g); tk_merge16(bv, g); }
          { float x = tk2_key(tk[14], t2[0], 224);
#pragma unroll
            for (int i = 0; i < 16; ++i) { const float hi = fmaxf(bv[i], x); x = fminf(bv[i], x); bv[i] = hi; } }
          { float x = tk2_key(tk[15], t2[0], 240);
#pragma unroll
            for (int i = 0; i < 16; ++i) { const float hi = fmaxf(bv[i], x); x = fminf(bv[i], x); bv[i] = hi; } }
        }
        unsigned p1[4], p2[4];
#pragma unroll
        for (int j = 0; j < 4; ++j) { p1[j] = 0u; p2[j] = 0u;
#pragma unroll
            for (int e = 0; e < 4; ++e) { p1[j] |= (127u - (__float_as_uint(tk[4 * j + e]) & 127u)) << (8 * e); p2[j] |= (127u - (__float_as_uint(t2[4 * j + e]) & 127u)) << (8 * e); } }
        { float e[16], sum = 0.f; unsigned ex[16];
          const float top = __uint_as_float(__float_as_uint(bv[0]) & ~255u);
#pragma unroll
          for (int i = 0; i < 16; ++i) { const unsigned bits = __float_as_uint(bv[i]); const unsigned flat = 255u - (bits & 255u), aa = flat >> 4, bb = flat & 15u;
              const unsigned w1 = (aa >> 2) == 0u ? p1[0] : (aa >> 2) == 1u ? p1[1] : (aa >> 2) == 2u ? p1[2] : p1[3];
              const unsigned w2 = (bb >> 2) == 0u ? p2[0] : (bb >> 2) == 1u ? p2[1] : (bb >> 2) == 2u ? p2[2] : p2[3];
              ex[i] = (((w1 >> (8u * (aa & 3u))) & 127u) << 7) | ((w2 >> (8u * (bb & 3u))) & 127u);
              e[i] = __expf(__uint_as_float(bits & ~255u) - top); sum += e[i]; }
          const float inv = 1.0f / sum;
          if ((lane & 1) == 0) { const int tl = lane >> 4, head = (lane & 15) >> 1; const size_t o = (size_t)(tokw + tl) * 128 + 64 * (head >> 2);
#pragma unroll
              for (int i = 0; i < 16; ++i) { const int p = 8 * (i & 7) + ((2 * head + (i >> 3)) & 7); idxG[o + p] = (int)ex[i] * 192; gateG[o + p] = e[i] * inv; } } }
    }
}

#define PEER_ROWS(b4_, b2_, i8_) do { _Pragma("unroll") for (int gq = 0; gq < 8; ++gq) { const unsigned ro = (unsigned)(i8_)[gq];        \
        b4_[gq] = *(const u32x4*)(tab + (ro + 16u * (unsigned)c)); b2_[gq] = *(const u32x2*)(tab + (ro + 128u + 8u * (unsigned)c)); } } while (0)
#define PEER_LD8(dst_, p_) do { const u32x4 _a = *(const u32x4*)(p_), _b = *(const u32x4*)((p_) + 4); dst_[0] = (int)_a.x; dst_[1] = (int)_a.y; dst_[2] = (int)_a.z; dst_[3] = (int)_a.w; \
        dst_[4] = (int)_b.x; dst_[5] = (int)_b.y; dst_[6] = (int)_b.z; dst_[7] = (int)_b.w; } while (0)
__device__ __forceinline__ void ph_peer_u(const unsigned char* UT, const bf16_t* H2, const int* idxG, float* pdot, int G) {
    const int tid = opaque_tid(), lane = tid & 63, wave = __builtin_amdgcn_readfirstlane(tid >> 6), r = lane >> 3, c = lane & 7;
    const int shard = blockIdx.x & 7, ws = (blockIdx.x >> 3) * 8 + wave, nws = (G >> 3) * 8;
    const unsigned char* tab = UT + (size_t)shard * PEER_SHARD_BYTES;
    const bf16_t* hbase = H2 + 256 * shard + 32 * c;
    const int* ibase = idxG + 8 * r;
#define PEER_TOK(t_) (((t_) < T_TOK) ? (t_) : (T_TOK - 1))
    int ci[2][8], ni[2][8]; u32x4 cw[4], nw[4];
    { const int t0 = PEER_TOK(ws), t1 = PEER_TOK(ws + nws);
      PEER_LD8(ci[0], ibase + (size_t)t0 * 128); PEER_LD8(ci[1], ibase + (size_t)t0 * 128 + 64); PEER_LD8(ni[0], ibase + (size_t)t1 * 128); PEER_LD8(ni[1], ibase + (size_t)t1 * 128 + 64);
#pragma unroll
      for (int q = 0; q < 4; ++q) cw[q] = *(const u32x4*)(hbase + (size_t)t0 * 2048 + 8 * q); }
    u32x4 a4[8], b4[8]; u32x2 a2[8], b2[8];
    PEER_ROWS(a4, a2, ci[0]);
    for (int t = ws; t < T_TOK; t += nws) {
        PEER_ROWS(b4, b2, ci[1]);
        { const int t1 = PEER_TOK(t + nws);
#pragma unroll
          for (int q = 0; q < 4; ++q) nw[q] = *(const u32x4*)(hbase + (size_t)t1 * 2048 + 8 * q); }
        f16x2_t ha[16];
        { const u32x4 w0 = cw[0], w1 = cw[1], w2 = cw[2], w3 = cw[3];
#define PEER_HP(lo_, hi_) __builtin_bit_cast(f16x2_t, __builtin_amdgcn_cvt_pkrtz(lo_, hi_))
          ha[0] = PEER_HP(bf_lo(w0.x), bf_lo(w2.x)); ha[1] = PEER_HP(bf_hi(w0.x), bf_hi(w2.x)); ha[2] = PEER_HP(bf_lo(w0.y), bf_lo(w2.y)); ha[3] = PEER_HP(bf_hi(w0.y), bf_hi(w2.y));
          ha[4] = PEER_HP(bf_lo(w0.z), bf_lo(w2.z)); ha[5] = PEER_HP(bf_hi(w0.z), bf_hi(w2.z)); ha[6] = PEER_HP(bf_lo(w0.w), bf_lo(w2.w)); ha[7] = PEER_HP(bf_hi(w0.w), bf_hi(w2.w));
          ha[8] = PEER_HP(bf_lo(w1.x), bf_lo(w3.x)); ha[9] = PEER_HP(bf_hi(w1.x), bf_hi(w3.x)); ha[10] = PEER_HP(bf_lo(w1.y), bf_lo(w3.y)); ha[11] = PEER_HP(bf_hi(w1.y), bf_hi(w3.y));
          ha[12] = PEER_HP(bf_lo(w1.z), bf_lo(w3.z)); ha[13] = PEER_HP(bf_hi(w1.z), bf_hi(w3.z)); ha[14] = PEER_HP(bf_lo(w1.w), bf_lo(w3.w)); ha[15] = PEER_HP(bf_hi(w1.w), bf_hi(w3.w));
#undef PEER_HP
        }
        float* po = pdot + ((size_t)shard * T_TOK + t) * 128 + lane;
#define PEER_UF(k_) s = __builtin_shufflevector(uv, uv, 2 * (k_), 2 * (k_) + 1) * ha[k_] + s
#define PEER_UDOT(b4_, b2_, half_) do { float mine = 0.f; \
            _Pragma("unroll") for (int gq = 0; gq < 8; ++gq) { const u32x6 p6 = {b4_[gq].x, b4_[gq].y, b4_[gq].z, b4_[gq].w, b2_[gq].x, b2_[gq].y}; \
                const f16x32_t uv = __builtin_amdgcn_cvt_scalef32_pk32_f16_fp6(p6, 1.0f); f16x2_t s = {(_Float16)0.f, (_Float16)0.f}; \
                PEER_UF(0); PEER_UF(1); PEER_UF(2); PEER_UF(3); PEER_UF(4); PEER_UF(5); PEER_UF(6); PEER_UF(7); PEER_UF(8); PEER_UF(9); PEER_UF(10); PEER_UF(11); PEER_UF(12); PEER_UF(13); PEER_UF(14); PEER_UF(15); \
                const float d = sum8_dpp((float)s.x + (float)s.y); \
                mine = (gq == c) ? d : mine; __builtin_amdgcn_sched_barrier(0); } \
            po[64 * (half_)] = mine; } while (0)
        PEER_UDOT(a4, a2, 0);
        PEER_ROWS(a4, a2, ni[0]);
#pragma unroll
        for (int q = 0; q < 8; ++q) { ci[0][q] = ni[0][q]; ci[1][q] = ni[1][q]; }
        { const int t2 = PEER_TOK(t + 2 * nws); PEER_LD8(ni[0], ibase + (size_t)t2 * 128); PEER_LD8(ni[1], ibase + (size_t)t2 * 128 + 64); }
        PEER_UDOT(b4, b2, 1);
#pragma unroll
        for (int q = 0; q < 4; ++q) cw[q] = nw[q];
    }
#undef PEER_UDOT
#undef PEER_UF
}
__device__ __forceinline__ void ph_peer_act(const float* pdot, const float* gateG, float* actG, int G) {
    const size_t n = (size_t)T_TOK * 128, stride = (size_t)G * 512;
    for (size_t i = (size_t)blockIdx.x * 512 + threadIdx.x; i < n; i += stride) {
        float d = 0.f;
#pragma unroll
        for (int x = 0; x < 8; ++x) d += pdot[(size_t)x * n + i];
        actG[i] = gateG[i] * gelu_tanh(d * (1.0f / PEER_SU)) * (1.0f / PEER_SV);
    }
}
template <bool DRY>
__device__ __forceinline__ void ph_peer_v(LAS unsigned char* lds, const unsigned char* VT, const int* idxG, const float* actG, const float* mod, float* OUT, int G) {
    const int tid = opaque_tid(), lane = tid & 63, wave = __builtin_amdgcn_readfirstlane(tid >> 6), r = lane >> 3, c = lane & 7;
    const int shard = blockIdx.x & 7, ws = (blockIdx.x >> 3) * 8 + wave, nws = (G >> 3) * 8;
    const unsigned char* tab = VT + (size_t)shard * PEER_SHARD_BYTES;
    LAS float* red = (LAS float*)(lds + wave * 9216);
    const int* ibase = idxG + 8 * r; const int* abase = (const int*)actG + 8 * r;
    int ci[2][8], ni[2][8], ca[2][8], na[2][8]; f32x4 cx, nx;
    { const int t0 = PEER_TOK(ws), t1 = PEER_TOK(ws + nws);
      PEER_LD8(ci[0], ibase + (size_t)t0 * 128); PEER_LD8(ci[1], ibase + (size_t)t0 * 128 + 64); PEER_LD8(ni[0], ibase + (size_t)t1 * 128); PEER_LD8(ni[1], ibase + (size_t)t1 * 128 + 64);
      PEER_LD8(ca[0], abase + (size_t)t0 * 128); PEER_LD8(ca[1], abase + (size_t)t0 * 128 + 64);
      cx = *(const f32x4*)(OUT + (size_t)t0 * 2048 + 256 * shard + 4 * lane); }
    u32x4 a4[8], b4[8]; u32x2 a2[8], b2[8];
    PEER_ROWS(a4, a2, ci[0]);
    for (int t = ws; t < T_TOK; t += nws) {
        PEER_ROWS(b4, b2, ci[1]);
        { const int t1 = PEER_TOK(t + nws);
          PEER_LD8(na[0], abase + (size_t)t1 * 128); PEER_LD8(na[1], abase + (size_t)t1 * 128 + 64); nx = *(const f32x4*)(OUT + (size_t)t1 * 2048 + 256 * shard + 4 * lane); }
        f16x2_t acc[16];
#pragma unroll
        for (int k = 0; k < 16; ++k) acc[k] = (f16x2_t){(_Float16)0.f, (_Float16)0.f};
#define PEER_VF(k_) acc[k_] = __builtin_shufflevector(vh, vh, 2 * (k_), 2 * (k_) + 1) * av2 + acc[k_]
#define PEER_VACC(b4_, b2_, a8_) do { _Pragma("unroll") for (int gq = 0; gq < 8; ++gq) { const _Float16 ah = (_Float16)__int_as_float((a8_)[gq]); const f16x2_t av2 = {ah, ah}; \
            const u32x6 p6 = {b4_[gq].x, b4_[gq].y, b4_[gq].z, b4_[gq].w, b2_[gq].x, b2_[gq].y}; const f16x32_t vh = __builtin_amdgcn_cvt_scalef32_pk32_f16_fp6(p6, 1.0f); \
            PEER_VF(0); PEER_VF(1); PEER_VF(2); PEER_VF(3); PEER_VF(4); PEER_VF(5); PEER_VF(6); PEER_VF(7); PEER_VF(8); PEER_VF(9); PEER_VF(10); PEER_VF(11); PEER_VF(12); PEER_VF(13); PEER_VF(14); PEER_VF(15); __builtin_amdgcn_sched_barrier(0); } } while (0)
        PEER_VACC(a4, a2, ca[0]);
        PEER_ROWS(a4, a2, ni[0]);
#pragma unroll
        for (int q = 0; q < 8; ++q) { ci[0][q] = ni[0][q]; ci[1][q] = ni[1][q]; }
        { const int t2 = PEER_TOK(t + 2 * nws); PEER_LD8(ni[0], ibase + (size_t)t2 * 128); PEER_LD8(ni[1], ibase + (size_t)t2 * 128 + 64); }
        PEER_VACC(b4, b2, ca[1]);
        { LAS float* w = red + (r * 8 + c) * 36;
#pragma unroll
          for (int q = 0; q < 4; ++q) { *(LAS f32x4*)(w + 4 * q) = (f32x4){(float)acc[4 * q].x, (float)acc[4 * q + 1].x, (float)acc[4 * q + 2].x, (float)acc[4 * q + 3].x};
              *(LAS f32x4*)(w + 16 + 4 * q) = (f32x4){(float)acc[4 * q].y, (float)acc[4 * q + 1].y, (float)acc[4 * q + 2].y, (float)acc[4 * q + 3].y}; } }
        LDS_WAIT();
        { f32x4 s = {0.f, 0.f, 0.f, 0.f}; const LAS float* rd = red + (lane >> 3) * 36 + 4 * (lane & 7);
#pragma unroll
          for (int rr = 0; rr < 8; ++rr) s += *(const LAS f32x4*)(rd + rr * 288);
          const int b = t >> 13; const float* gt2 = mod + (size_t)b * 12288 + 10240 + 256 * shard + 4 * lane; float* op = OUT + (size_t)t * 2048 + 256 * shard + 4 * lane;
          const f32x4 g0 = *(const f32x4*)gt2;
          if (!DRY) *(f32x4*)op = cx + g0 * s; else asm volatile("" :: "v"(s), "v"(g0)); }
        LDS_WAIT();
#pragma unroll
        for (int q = 0; q < 8; ++q) { ca[0][q] = na[0][q]; ca[1][q] = na[1][q]; }
        cx = nx;
    }
#undef PEER_VACC
#undef PEER_VF
}
#undef PEER_ROWS
#undef PEER_LD8
#undef PEER_TOK

__global__ void __launch_bounds__(512, 2) mk_fwd(Args args) {
    extern __shared__ __attribute__((aligned(16))) unsigned char lds_raw[];
    LAS unsigned char* lds = (LAS unsigned char*)lds_raw;
    const int tid = threadIdx.x, lane = tid & 63, wave = __builtin_amdgcn_readfirstlane(tid >> 6);
    const int G = gridDim.x, gw = blockIdx.x * 8 + wave, ngw = G * 8;
    unsigned char* ws = args.ws;
    volatile LAS unsigned* misc = (volatile LAS unsigned*)(lds + LDS_MAIN);
    if (tid < 4) misc[tid] = 0u;
    __syncthreads();
    const int lo = args.ph_lo, hi = args.ph_hi;
    XcdBarrier bar; bar.bar = (unsigned*)(ws + WS_CTL); bar.x = 0; bar.st = misc;
    if (hi - lo > 1) bar = xcd_barrier_post((unsigned*)(ws + WS_CTL), misc);
#ifndef PHMASK
#define PHMASK 0x3fff
#endif
#define IN(k) (((PHMASK >> (k)) & 1) && lo <= (k) && (k) < hi)
#define SEAM(k) do { if (IN(k) && IN((k) + 1)) xcd_barrier(bar); } while (0)
    float* mod = (float*)(ws + WS_MOD);
    bf16_t* HB = (bf16_t*)(ws + WS_H); bf16_t* PA = (bf16_t*)(ws + WS_PA); bf16_t* PG = (bf16_t*)(ws + WS_PG);
    bf16_t* YA = (bf16_t*)(ws + WS_YA); bf16_t* ATT = (bf16_t*)(ws + WS_ATT); f32x2* EB = (f32x2*)(ws + WS_E); bf16_t* UBp = (bf16_t*)(ws + WS_UB);

#define PHS(code, ...) do { __VA_ARGS__ if (DUP == (code)) { xcd_barrier(bar); __VA_ARGS__ } } while (0)
#define PH(k, ...) do { if (IN(k)) { __VA_ARGS__ if (DUP == (k)) { xcd_barrier(bar); __VA_ARGS__ } } } while (0)
    PH(0, { ph_mod_partial(args.in[I_C], args.in[I_WADA], (float*)(ws + WS_MODP), gw, ngw, lane); ph_colmax_partial(args.in[I_WIN], (float*)(ws + WS_CMAXP), gw, ngw, lane); });
    SEAM(0);
    PH(1, { ph_prologue(args, lds, gw, ngw, lane, wave); });
    SEAM(1);
    PH(2, { ph_norm<true>(args.in[I_X], HB, (float*)(ws + WS_SA), args.in[I_N1G], mod, 0, 2048, gw, ngw, lane); });
    SEAM(2);
    PH(3, { pg8::Gemm g{HB, (const bf16_t*)(ws + WS_WIN), T_TOK, 8192, 1024}; pg8::StaticOrder S; S.init(T_TOK, 8192, G, (int)blockIdx.x);
        pg8::EpiProj E{PA, PG, UBp, (const float*)(ws + WS_SA), (const float*)(ws + WS_SB)}; pg8::gemm_phase<pg8::EpiProj, pg8::StaticOrder, true, true, 1>(lds, g, S, E); });
    SEAM(3);
    PH(4, { PHS(41, { ph_attn<0>(lds, PA, ATT, args.in[I_QNG], args.in[I_KNG], G); __syncthreads(); });
        if (DUP == 411) { xcd_barrier(bar); ph_attn<1>(lds, PA, ATT, args.in[I_QNG], args.in[I_KNG], G); __syncthreads(); } PHS(42, { ph_ssm_mfma<false>(args, lds, UBp, EB, YA, G); }); });
    SEAM(4);
    PH(5, { PHS(51, { ph_ssm_mfma<true>(args, lds, UBp, EB, YA, G); __syncthreads(); });
        PHS(52, { pg8::Gemm g{ATT, (const bf16_t*)(ws + WS_WATT), T_TOK, 2048, 512}; pg8::SplitOrder S; S.init(T_TOK, 2048, G, (int)blockIdx.x);
        pg8::EpiAttUp E{PG, HB}; pg8::gemm_phase<pg8::EpiAttUp, pg8::SplitOrder, true, true, 2>(lds, g, S, E); }); });
    SEAM(5);
    PH(6, { pg8::Gemm g{YA, (const bf16_t*)(ws + WS_WGLU), T_TOK, 4096, 512}; pg8::StaticOrder S; S.init(T_TOK, 4096, G, (int)blockIdx.x);
        pg8::EpiGlu E{PG, HB, (unsigned char*)ATT}; pg8::gemm_phase<pg8::EpiGlu, pg8::StaticOrder, true, true, 2>(lds, g, S, E); });
    SEAM(6);
    PH(7, { const bool split = (G == 256); const int gg = split ? 171 : G, ra = split ? 11264 : 0;
        if ((int)blockIdx.x < gg) { pg8::Gemm g{ATT, (const bf16_t*)(ws + WS_WOUT), T_TOK, 2048, 1024}; pg8::StaticOrder S; S.init(T_TOK, 2048, gg, (int)blockIdx.x);
            pg8::EpiOut E{args.in[I_X], args.out, mod}; pg8::gemm_phase<pg8::EpiOut, pg8::StaticOrder, true, true, 2>(lds, g, S, E); }
        else ph_table_cvt(args.in[I_PU], args.in[I_PV], ws + WS_UT, ws + WS_VT, 0, ra, ((int)blockIdx.x - gg) * 8 + wave, (G - gg) * 8, lane);
        ph_table_cvt(args.in[I_PU], args.in[I_PV], ws + WS_UT, ws + WS_VT, ra, 16384, gw, ngw, lane); });
    SEAM(7);
    PH(8, { ph_norm<false>(args.out, HB, nullptr, args.in[I_N2G], mod, 6144, 8192, gw, ngw, lane); });
    SEAM(8);
    PH(9, { pg8::Gemm g{HB, (const bf16_t*)(ws + WS_WSC), T_TOK, 2048, 2048}; pg8::StaticOrder S; S.init(T_TOK, 2048, G, (int)blockIdx.x);
        pg8::EpiF32 E{(float*)(ws + WS_SC)}; pg8::gemm_phase<pg8::EpiF32, pg8::StaticOrder, true, true>(lds, g, S, E); });
    SEAM(9);
    PH(10, { ph_peer_topk(lds, (const float*)(ws + WS_SC), (int*)(ws + WS_IDX), (float*)(ws + WS_GATE), G); });
    SEAM(10);
    PH(11, { ph_peer_u(ws + WS_UT, HB, (const int*)(ws + WS_IDX), (float*)(ws + WS_PDOT), G); });
    SEAM(11);
    PH(12, { ph_peer_act((const float*)(ws + WS_PDOT), (const float*)(ws + WS_GATE), (float*)(ws + WS_ACT), G); });
    SEAM(12);
    if (IN(13)) { if (DUP == 13) { ph_peer_v<true>(lds, ws + WS_VT, (const int*)(ws + WS_IDX), (const float*)(ws + WS_ACT), mod, args.out, G); xcd_barrier(bar); }
        ph_peer_v<false>(lds, ws + WS_VT, (const int*)(ws + WS_IDX), (const float*)(ws + WS_ACT), mod, args.out, G); }
#undef IN
#undef SEAM
}

extern "C" void kernel_launch(void* const* d_in, const int* in_sizes, int n_in, void* d_out, int out_size, void* d_ws, size_t ws_size, hipStream_t stream) {
    static int grid = 0;
    if (grid == 0) {
        if (n_in != 25 || out_size != T_TOK * DM || ws_size < WS_END) { fprintf(stderr, "kernel_launch: unexpected shapes (n_in %d out %d ws %zu need %zu)\n", n_in, out_size, ws_size, (size_t)WS_END); grid = -1; return; }
        int dev = 0, cus = 0, per_cu = 0;
        if (hipGetDevice(&dev) != hipSuccess || hipDeviceGetAttribute(&cus, hipDeviceAttributeMultiprocessorCount, dev) != hipSuccess) { grid = -1; return; }
        if (hipFuncSetAttribute((const void*)mk_fwd, hipFuncAttributeMaxDynamicSharedMemorySize, LDS_BYTES) != hipSuccess) { fprintf(stderr, "kernel_launch: hipFuncSetAttribute failed\n"); grid = -1; return; }
        if (hipOccupancyMaxActiveBlocksPerMultiprocessor(&per_cu, (const void*)mk_fwd, 512, LDS_BYTES) != hipSuccess || per_cu < 1) { fprintf(stderr, "kernel_launch: occupancy query says %d blocks/CU\n", per_cu); (void)hipGetLastError(); grid = -1; return; }
        grid = cus;
    }
    if (grid < 0) return;
    (void)hipMemsetAsync((char*)d_ws + WS_CTL, 0, 16384, stream);
    Args a{};
    for (int i = 0; i < 25; ++i) a.in[i] = (const float*)d_in[i];
    a.out = (float*)d_out; a.ws = (unsigned char*)d_ws;
#if MK_PER_PHASE
    for (int ph = 0; ph < NPHASE; ++ph) { a.ph_lo = ph; a.ph_hi = ph + 1; hipLaunchKernelGGL(mk_fwd, dim3(grid), dim3(512), LDS_BYTES, stream, a); }
#else
    a.ph_lo = 0; a.ph_hi = NPHASE;
    hipLaunchKernelGGL(mk_fwd, dim3(grid), dim3(512), LDS_BYTES, stream, a);
#endif
}
```

```cpp
#include <hip/hip_runtime.h>
#include <cstdio>
#include <cstdint>

#ifndef MK_PER_PHASE
#define MK_PER_PHASE 0
#endif

#ifndef DUP
#define DUP -1
#endif
#define XCD_REMAP 0
#define WGM_P3 4
#define WGM_P5 4
#define WGM_P6 4
#define WGM_P7 4
#define WGM_P9 4
#define LAS __attribute__((address_space(3)))
typedef unsigned short bf16_t;
typedef short bf16x8 __attribute__((ext_vector_type(8)));
typedef short v4i16_t __attribute__((ext_vector_type(4)));
typedef float f32x4 __attribute__((ext_vector_type(4)));
typedef float f32x2 __attribute__((ext_vector_type(2)));
typedef unsigned u32x4 __attribute__((ext_vector_type(4)));
typedef unsigned u32x2 __attribute__((ext_vector_type(2)));
typedef int i32x4 __attribute__((ext_vector_type(4)));

constexpr int T_TOK = 16384, DM = 2048, SEQ = 8192;
constexpr int NPHASE = 14;
constexpr float EPS = 1e-6f;

constexpr size_t WS_CTL   = 0;
constexpr size_t WS_MODP  = 65536;
constexpr size_t WS_MOD   = WS_MODP + (size_t)32 * 2 * 12288 * 4;
constexpr size_t WS_WIN   = WS_MOD + (size_t)2 * 12288 * 4;
constexpr size_t WS_WGLU  = WS_WIN + (size_t)8192 * 2048 * 2;
constexpr size_t WS_WATT  = WS_WGLU + (size_t)4096 * 1024 * 2;
constexpr size_t WS_WOUT  = WS_WATT + (size_t)2048 * 1024 * 2;
constexpr size_t WS_WSC   = WS_WOUT + (size_t)2048 * 2048 * 2;
constexpr size_t WS_H     = WS_WSC + (size_t)2048 * 2048 * 2;
constexpr size_t WS_PA    = WS_H + (size_t)T_TOK * 2048 * 2;
constexpr size_t WS_PG    = WS_PA + (size_t)T_TOK * 4096 * 2;
constexpr size_t WS_E     = WS_PG + (size_t)T_TOK * 4096 * 2;
constexpr size_t WS_YA    = WS_E + (size_t)2 * 64 * 128 * 64 * 8;
constexpr size_t WS_ATT   = WS_YA + (size_t)T_TOK * 1024 * 2;
constexpr size_t WS_UB    = WS_ATT + (size_t)T_TOK * 1024 * 2;
constexpr size_t WS_SA    = WS_UB + (size_t)T_TOK * 1024 * 2;
constexpr size_t WS_SB    = WS_SA + (size_t)T_TOK * 4;
constexpr size_t WS_CMAXP = WS_SB + (size_t)8192 * 4;
constexpr size_t WS_END   = WS_CMAXP + (size_t)32 * 8192 * 4;
constexpr size_t WS_SC    = WS_PA;
constexpr size_t WS_X1    = WS_PA + (size_t)T_TOK * 2048 * 2;
constexpr size_t WS_UT    = WS_PG;
constexpr size_t WS_VT    = WS_PG + (size_t)8 * 16384 * 192;
constexpr size_t WS_PDOT  = WS_VT + (size_t)8 * 16384 * 192;
constexpr size_t WS_IDX   = WS_YA;
constexpr size_t WS_GATE  = WS_YA + (size_t)T_TOK * 128 * 4;
constexpr size_t WS_ACT   = WS_GATE + (size_t)T_TOK * 128 * 4;
static_assert(WS_PDOT + (size_t)8 * T_TOK * 128 * 4 <= WS_PG + (size_t)T_TOK * 4096 * 2, "PEER buffers must fit the dead g_ssm|g_att region");
static_assert(WS_ACT + (size_t)T_TOK * 128 * 4 <= WS_YA + (size_t)T_TOK * 1024 * 2, "PEER index buffers must fit the dead YA region");
constexpr int LDS_MAIN = 131072, LDS_BYTES = LDS_MAIN + 256;

typedef __bf16 bf16x2_t __attribute__((ext_vector_type(2)));
__device__ __forceinline__ unsigned cvt_pk_bf16(float lo, float hi) { const f32x2 v = {lo, hi}; return __builtin_bit_cast(unsigned, __builtin_convertvector(v, bf16x2_t)); }
__device__ __forceinline__ float bf_lo(unsigned w) { return __uint_as_float(w << 16); }
__device__ __forceinline__ float bf_hi(unsigned w) { return __uint_as_float(w & 0xffff0000u); }
__device__ __forceinline__ float wave_sum(float v) {
#pragma unroll
    for (int o = 1; o < 64; o <<= 1) v += __shfl_xor(v, o);
    return v;
}
__device__ __forceinline__ float sigmoidf_(float x) { return __builtin_amdgcn_rcpf(1.0f + __builtin_amdgcn_exp2f(-1.4426950408889634f * x)); }
__device__ __forceinline__ float sigmoid_g(float gs) { return __builtin_amdgcn_rcpf(1.0f + __builtin_amdgcn_exp2f((-1.4426950408889634f / 16.0f) * gs)); }
__device__ __forceinline__ float gelu_tanh(float x) {
    const float a2 = (-2.0f * 0.7978845608028654f * 1.4426950408889634f) * (x + 0.044715f * x * x * x);
    return x * __builtin_amdgcn_rcpf(1.0f + __builtin_amdgcn_exp2f(a2));
}
constexpr float F8_SA = 8.0f, F8_SW = 64.0f, F8_INV = 1.0f / 512.0f;
constexpr float F8_SG = 16.0f;
__device__ __forceinline__ unsigned pack4_fp8(float a, float b, float c, float d, float sc) {
    a = fminf(fmaxf(a * sc, -448.f), 448.f); b = fminf(fmaxf(b * sc, -448.f), 448.f); c = fminf(fmaxf(c * sc, -448.f), 448.f); d = fminf(fmaxf(d * sc, -448.f), 448.f);
    int p = 0; p = __builtin_amdgcn_cvt_pk_fp8_f32(a, b, p, false); p = __builtin_amdgcn_cvt_pk_fp8_f32(c, d, p, true); return (unsigned)p; }
__device__ __forceinline__ float sum8_dpp(float v) {
    v += __builtin_bit_cast(float, __builtin_amdgcn_update_dpp(0, __builtin_bit_cast(int, v), 0xB1, 0xF, 0xF, true));
    v += __builtin_bit_cast(float, __builtin_amdgcn_update_dpp(0, __builtin_bit_cast(int, v), 0x4E, 0xF, 0xF, true));
    v += __builtin_bit_cast(float, __builtin_amdgcn_update_dpp(0, __builtin_bit_cast(int, v), 0x141, 0xF, 0xF, true));
    return v; }
#define LDS_WAIT() asm volatile("s_waitcnt lgkmcnt(0)" ::: "memory")
__device__ __forceinline__ int opaque_tid() { int t = threadIdx.x; asm volatile("" : "+v"(t)); return t; }

#define XB_TMO      128
#define XB_XCNT(j)  (256  + 64 * (j))
#define XB_XSUB(j)  (1280 + 64 * (j))
#define XB_XGEN(j)  (2304 + 64 * (j))
#define XB_TOP      3328
#define XB_TOPGEN   3392
#define XCD_BAR_WORDS 3456
#define XB_SPIN_CAP (1u << 22)
__device__ __forceinline__ unsigned xb_ld(unsigned* p)              { return __hip_atomic_load(p, __ATOMIC_RELAXED, __HIP_MEMORY_SCOPE_AGENT); }
__device__ __forceinline__ unsigned xb_add(unsigned* p, unsigned v) { return __hip_atomic_fetch_add(p, v, __ATOMIC_RELAXED, __HIP_MEMORY_SCOPE_AGENT); }
__device__ __forceinline__ unsigned xb_xcc_id() { return (unsigned)__builtin_amdgcn_s_getreg((3 << 11) | 20) & 0xFu; }
#define XB_SPIN(cond, bar) do { unsigned _sp = 0; while (cond) { __builtin_amdgcn_s_sleep(1); \
    if ((++_sp & 255u) == 0u) { if (xb_ld(&(bar)[XB_TMO])) break; if (_sp > XB_SPIN_CAP) { atomicAdd(&(bar)[XB_TMO], 1u); break; } } } } while (0)
struct XcdBarrier { unsigned* bar; unsigned x; volatile LAS unsigned* st; };
__device__ __forceinline__ XcdBarrier xcd_barrier_post(unsigned* bar, volatile LAS unsigned* st) {
    XcdBarrier b; b.bar = bar; b.x = xb_xcc_id(); b.st = st;
    if (threadIdx.x == 0) (void)xb_add(&bar[XB_XCNT(b.x)], 1u);
    return b;
}
__device__ __forceinline__ void xcd_barrier_complete(unsigned* bar, unsigned x, unsigned& nloc, unsigned& nx) {
    const unsigned G = gridDim.x * gridDim.y * gridDim.z;
    unsigned sum, cnt, mine, sp = 0u;
    for (;;) {
        sum = 0u; cnt = 0u; mine = 0u;
#pragma unroll
        for (unsigned j = 0; j < 16; ++j) { const unsigned c = xb_ld(&bar[XB_XCNT(j)]); sum += c; cnt += (c > 0u) ? 1u : 0u; mine = (j == x) ? c : mine; }
        if (sum == G) break;
        __builtin_amdgcn_s_sleep(1);
        if ((++sp & 255u) == 0u) { if (xb_ld(&bar[XB_TMO])) break; if (sp > XB_SPIN_CAP) { atomicAdd(&bar[XB_TMO], 1u); break; } }
    }
    nloc = mine > 0u ? mine : 1u; nx = cnt > 0u ? cnt : 1u;
}
__device__ __forceinline__ void xcd_barrier(const XcdBarrier& b) {
    asm volatile("s_waitcnt vmcnt(0)" ::: "memory");
    __syncthreads();
    if (threadIdx.x == 0) {
        unsigned* bar = b.bar;
        __builtin_amdgcn_s_waitcnt(0);
        unsigned nloc = b.st[0], nx = b.st[1];
        if (nloc == 0u) { xcd_barrier_complete(bar, b.x, nloc, nx); b.st[0] = nloc; b.st[1] = nx; }
        const unsigned old = xb_add(&bar[XB_XSUB(b.x)], 1u);
        const unsigned gen = old / nloc;
        if (old + 1u == (gen + 1u) * nloc) {
            __builtin_amdgcn_fence(__ATOMIC_RELEASE, "agent");
            asm volatile("s_waitcnt vmcnt(0)" ::: "memory");
            const unsigned og = xb_add(&bar[XB_TOP], 1u);
            const unsigned tg = og / nx;
            if (og + 1u == (tg + 1u) * nx) xb_add(&bar[XB_TOPGEN], 1u);
            else XB_SPIN(xb_ld(&bar[XB_TOPGEN]) == tg, bar);
            __builtin_amdgcn_fence(__ATOMIC_ACQUIRE, "agent");
            xb_add(&bar[XB_XGEN(b.x)], 1u);
            asm volatile("s_waitcnt vmcnt(0)" ::: "memory");
        } else {
            XB_SPIN(xb_ld(&bar[XB_XGEN(b.x)]) == gen, bar);
            __builtin_amdgcn_fence(__ATOMIC_ACQUIRE, "agent");
            asm volatile("s_waitcnt vmcnt(0)" ::: "memory");
        }
    }
    __syncthreads();
}

namespace pg8 {
constexpr int BM = 256, BK = 64, HALF = 128, HTB = HALF * BK * 2, STAGE_BYTES = 8 * HTB, NXCD = 8;
__host__ __device__ __forceinline__ int lds_byte(int r, int c) { const int st = (r >> 4) * 2 + (c >> 5), rr = r & 15, cc = c & 31, ob = rr * 64 + cc * 2; return st * 1024 + (ob ^ (((ob >> 9) & 1) << 5)); }
__host__ __device__ __forceinline__ void stage_rc(int b, int& R, int& C) { const int st = b / 1024, sb = b % 1024, swz = sb ^ (((sb >> 9) & 1) << 5); R = (st >> 1) * 16 + swz / 64; C = (st & 1) * 32 + (swz % 64) / 2; }
__host__ __device__ __forceinline__ int perm32(int rho) { const int n = rho >> 4, i = rho & 15; return 8 * (i >> 2) + 4 * n + (i & 3); }
struct Unit { int pm, pn; };
struct Gemm { const bf16_t* A; const bf16_t* Bt; int M, N, K; };
struct StaticOrder {
    int nM, nN, nwg, G, c, WGM;
    __host__ __device__ void init(int M, int N, int G_, int c_, int wgm_) { nM = M / BM; nN = N / BM; nwg = nM * nN; G = G_; c = c_; WGM = wgm_; }
    __host__ __device__ bool next(int i, Unit& u) const { const int cc = (G == 256) ? ((c & 7) * 32 + (c >> 3)) : c; return at((long)i * G + cc, u); }
    __host__ __device__ bool at(long L, Unit& u) const {
        if (L >= nwg) return false;
        int wgid = (int)L; if (XCD_REMAP) { const int q = nwg / NXCD, r = nwg % NXCD, xcd = wgid % NXCD, off = wgid / NXCD; wgid = (xcd < r ? xcd * (q + 1) : r * (q + 1) + (xcd - r) * q) + off; }
        const int nig = WGM * nN, gid = wgid / nig, fm = gid * WGM, gsz = (nM - fm) < WGM ? (nM - fm) : WGM;
        u.pm = fm + ((wgid % nig) % gsz); u.pn = (wgid % nig) / gsz; return true;
    }
    __device__ __forceinline__ void a_ready(const Unit&) const {}
    __device__ __forceinline__ void done(const Unit&) const {}
};
struct SplitOrder {
    StaticOrder b;
    __host__ __device__ void init(int M, int N, int G_, int c_, int wgm_) { b.init(M, N, G_, c_, wgm_); }
    __host__ __device__ bool next(int i, Unit& u) const {
        if (b.G != 256 || b.nwg != 512) return b.next(i, u);
        if (b.c < 128) return false;
        return i < 4 ? b.at((long)i * 128 + (b.c - 128), u) : false;
    }
    __device__ __forceinline__ void a_ready(const Unit&) const {}
    __device__ __forceinline__ void done(const Unit&) const {}
};
typedef int i32x8 __attribute__((ext_vector_type(8)));
template <class Epi, class Sched, bool ALIGN_EPI = false, bool SP2 = false, int MODE = 0>
__device__ __forceinline__ void gemm_phase(LAS unsigned char* lds, const Gemm g, const Sched& S, const Epi& E) {
    const int tid = threadIdx.x, wid = __builtin_amdgcn_readfirstlane(tid >> 6), lane = tid & 63, wr = wid >> 2, wc = wid & 3, fr = lane & 15, fq = lane >> 4;
    const int K = g.K, nt = K / BK;
    unsigned voffA[2], voffB[2];
#pragma unroll
    for (int i = 0; i < 2; ++i) { int R, C; stage_rc(tid * 16 + i * 8192, R, C); const int Rb = Epi::PERM ? ((R & ~31) + perm32(R & 31)) : R;
        voffA[i] = (unsigned)(R * K + C) * 2u; voffB[i] = (unsigned)(Rb * K + C) * 2u; }
    const size_t kstep = (size_t)(BK * 2);
    const size_t hstep = (size_t)HALF * K * 2;
    const size_t tstep = 2 * hstep;
    const unsigned ldsw = (unsigned)wid * 1024u;
    const int aoff = lds_byte(wr * 64 + fr, fq * 8), boff = lds_byte(wc * 32 + fr, fq * 8);
#define PG8_SA(b, h) (((b) * 2 + (h)) * HTB)
#define PG8_SB(b, h) ((4 + (b) * 2 + (h)) * HTB)
#define PG8_STAGE(bufoff, gbase, voff) do { _Pragma("unroll") for (int _i = 0; _i < 2; ++_i) \
        __builtin_amdgcn_global_load_lds((const unsigned*)((const char*)(gbase) + (voff)[_i]), (LAS unsigned*)(lds + (bufoff) + ldsw + _i * 8192), 16, 0, 0); } while (0)
#define PG8_LD8(p_) ({ const i32x4 _lo = *(const LAS i32x4*)(p_), _hi = *(const LAS i32x4*)((p_) + 1024); (i32x8){_lo[0], _lo[1], _lo[2], _lo[3], _hi[0], _hi[1], _hi[2], _hi[3]}; })
#define PG8_LDA(dst, b, h) do { _Pragma("unroll") for (int m = 0; m < 4; ++m) dst[m] = PG8_LD8(lds + PG8_SA(b, h) + aoff + m * 2048); } while (0)
#define PG8_LDB(dst, b, h) do { _Pragma("unroll") for (int n = 0; n < 2; ++n) dst[n] = PG8_LD8(lds + PG8_SB(b, h) + boff + n * 2048); } while (0)
#define PG8_HALF(v, k) ((k) == 0 ? __builtin_shufflevector(v, v, 0, 1, 2, 3) : __builtin_shufflevector(v, v, 4, 5, 6, 7))
#define PG8_MMA(ai, bj, At, Bt) do { __builtin_amdgcn_s_setprio(1); _Pragma("unroll") for (int m = 0; m < 4; ++m) _Pragma("unroll") for (int n = 0; n < 2; ++n) { \
        if (MODE == 2) asm volatile("v_mfma_scale_f32_16x16x128_f8f6f4 %0, %1, %2, %0, %3, %3 op_sel_hi:[0,0,0]" : "+v"(acc[ai][bj][m][n]) : "v"(Bt[n]), "v"(At[m]), "v"(scl1)); \
        else { _Pragma("unroll") for (int k = 0; k < 2; ++k) \
            acc[ai][bj][m][n] = (MODE == 1) ? __builtin_bit_cast(f32x4, __builtin_amdgcn_mfma_i32_16x16x64_i8(PG8_HALF(Bt[n], k), PG8_HALF(At[m], k), __builtin_bit_cast(i32x4, acc[ai][bj][m][n]), 0, 0, 0)) \
                                            : __builtin_amdgcn_mfma_f32_16x16x32_bf16(__builtin_bit_cast(bf16x8, PG8_HALF(Bt[n], k)), __builtin_bit_cast(bf16x8, PG8_HALF(At[m], k)), acc[ai][bj][m][n], 0, 0, 0); } } __builtin_amdgcn_s_setprio(0); } while (0)
#define PG8_WAIT_V(n) asm volatile("s_waitcnt vmcnt(" #n ")" ::: "memory")
#define PG8_WAIT_L(n) asm volatile("s_waitcnt lgkmcnt(" #n ")" ::: "memory")
#define PG8_BAR __builtin_amdgcn_s_barrier()
#define PG8_SCHED __builtin_amdgcn_sched_barrier(0)
    const int scl1 = 0x7f7f7f7f;
    Unit cur, nxt; int ui = 0;
    if (!S.next(0, cur)) return;
    f32x4 acc[2][2][4][2];
#pragma unroll
    for (int a = 0; a < 2; ++a)
#pragma unroll
        for (int b = 0; b < 2; ++b)
#pragma unroll
            for (int m = 0; m < 4; ++m)
#pragma unroll
                for (int n = 0; n < 2; ++n) acc[a][b][m][n] = (f32x4){0.f, 0.f, 0.f, 0.f};
    i32x8 At[4], B0[2], B1[2];
    const char* cA = (const char*)g.A + (size_t)cur.pm * tstep; const char* cB = (const char*)g.Bt + (size_t)cur.pn * tstep;
    S.a_ready(cur);
    if constexpr (SP2) {
        PG8_STAGE(PG8_SB(0, 0), cB, voffB); PG8_STAGE(PG8_SB(0, 1), cB + hstep, voffB); PG8_STAGE(PG8_SA(0, 0), cA, voffA); PG8_STAGE(PG8_SA(0, 1), cA + hstep, voffA);
        if (wr == 1) PG8_BAR;
        PG8_WAIT_V(2); PG8_BAR;
        PG8_STAGE(PG8_SB(1, 0), cB + kstep, voffB); PG8_STAGE(PG8_SA(1, 0), cA + kstep, voffA); PG8_STAGE(PG8_SB(1, 1), cB + hstep + kstep, voffB);
        PG8_WAIT_V(6); PG8_BAR;
    } else {
        PG8_STAGE(PG8_SB(0, 0), cB, voffB); PG8_STAGE(PG8_SA(0, 0), cA, voffA); PG8_STAGE(PG8_SB(0, 1), cB + hstep, voffB); PG8_STAGE(PG8_SA(0, 1), cA + hstep, voffA);
        if (wr == 1) PG8_BAR;
        PG8_WAIT_V(4); PG8_BAR;
        PG8_STAGE(PG8_SB(1, 0), cB + kstep, voffB); PG8_STAGE(PG8_SA(1, 0), cA + kstep, voffA); PG8_STAGE(PG8_SB(1, 1), cB + hstep + kstep, voffB);
        PG8_WAIT_V(6); PG8_BAR;
    }
    for (;;) {
        const bool has_next = S.next(ui + 1, nxt);
        const char* nA = has_next ? (const char*)g.A + (size_t)nxt.pm * tstep : cA; const char* nB = has_next ? (const char*)g.Bt + (size_t)nxt.pn * tstep : cB;
#pragma unroll 1
        for (int t = 0; t < nt; t += 2) {
            const bool last = (t == nt - 2);
            const char* a1 = cA + (size_t)(t + 1) * kstep;
            const char* a2 = last ? nA : cA + (size_t)(t + 2) * kstep; const char* b2 = last ? nB : cB + (size_t)(t + 2) * kstep;
            const char* a3 = a2 + kstep; const char* b3 = b2 + kstep;
            if (last && has_next) S.a_ready(nxt);
            if constexpr (SP2) {
            PG8_LDB(B0, 0, 0); PG8_LDB(B1, 0, 1); PG8_SCHED; PG8_LDA(At, 0, 0); PG8_STAGE(PG8_SA(1, 1), a1 + hstep, voffA);
            PG8_WAIT_V(8); PG8_WAIT_L(0); PG8_BAR; PG8_MMA(0, 0, At, B0); PG8_MMA(0, 1, At, B1); PG8_BAR; PG8_SCHED;
            PG8_LDA(At, 0, 1); PG8_STAGE(PG8_SB(0, 0), b2, voffB); PG8_STAGE(PG8_SB(0, 1), b2 + hstep, voffB); PG8_STAGE(PG8_SA(0, 0), a2, voffA);
            PG8_WAIT_V(8); PG8_WAIT_L(0); PG8_BAR; PG8_MMA(1, 0, At, B0); PG8_MMA(1, 1, At, B1); PG8_BAR; PG8_SCHED;
            PG8_LDB(B0, 1, 0); PG8_LDB(B1, 1, 1); PG8_SCHED; PG8_LDA(At, 1, 0); PG8_STAGE(PG8_SA(0, 1), a2 + hstep, voffA);
            PG8_WAIT_V(8); PG8_WAIT_L(0); PG8_BAR; PG8_MMA(0, 0, At, B0); PG8_MMA(0, 1, At, B1); PG8_BAR; PG8_SCHED;
            PG8_LDA(At, 1, 1); PG8_STAGE(PG8_SB(1, 0), b3, voffB); PG8_STAGE(PG8_SB(1, 1), b3 + hstep, voffB); PG8_STAGE(PG8_SA(1, 0), a3, voffA);
            PG8_WAIT_V(8); PG8_WAIT_L(0); PG8_BAR; PG8_MMA(1, 0, At, B0); PG8_MMA(1, 1, At, B1); PG8_BAR; PG8_SCHED;
            } else {
            PG8_LDB(B0, 0, 0); PG8_SCHED; PG8_LDA(At, 0, 0); PG8_STAGE(PG8_SA(1, 1), a1 + hstep, voffA);
            PG8_WAIT_L(8); PG8_BAR; PG8_WAIT_L(0); PG8_MMA(0, 0, At, B0); PG8_BAR; PG8_SCHED;
            PG8_LDB(B1, 0, 1); PG8_STAGE(PG8_SB(0, 0), b2, voffB);
            PG8_BAR; PG8_WAIT_L(0); PG8_MMA(0, 1, At, B1); PG8_BAR;
            PG8_LDA(At, 0, 1); PG8_STAGE(PG8_SA(0, 0), a2, voffA);
            PG8_BAR; PG8_WAIT_L(0); PG8_MMA(1, 0, At, B0); PG8_BAR; PG8_SCHED;
            PG8_STAGE(PG8_SB(0, 1), b2 + hstep, voffB);
            PG8_WAIT_V(6); PG8_BAR; PG8_MMA(1, 1, At, B1); PG8_BAR;
            PG8_LDB(B0, 1, 0); PG8_SCHED; PG8_LDA(At, 1, 0); PG8_STAGE(PG8_SA(0, 1), a2 + hstep, voffA);
            PG8_WAIT_L(8); PG8_BAR; PG8_WAIT_L(0); PG8_MMA(0, 0, At, B0); PG8_BAR; PG8_SCHED;
            PG8_LDB(B1, 1, 1); PG8_STAGE(PG8_SB(1, 0), b3, voffB);
            PG8_BAR; PG8_WAIT_L(0); PG8_MMA(0, 1, At, B1); PG8_BAR;
            PG8_LDA(At, 1, 1); PG8_STAGE(PG8_SA(1, 0), a3, voffA);
            PG8_BAR; PG8_WAIT_L(0); PG8_MMA(1, 0, At, B0); PG8_BAR; PG8_SCHED;
            PG8_STAGE(PG8_SB(1, 1), b3 + hstep, voffB);
            PG8_WAIT_V(6); PG8_BAR; PG8_MMA(1, 1, At, B1); PG8_BAR;
            }
        }
        if constexpr (ALIGN_EPI) { if (wr == 0) PG8_BAR; }
        if (MODE == 2) asm volatile("s_nop 15\n\ts_nop 15" ::: "memory");
        E(acc, cur, wr, wc, fr, fq); S.done(cur);
        if (!has_next) break;
#pragma unroll
        for (int a = 0; a < 2; ++a)
#pragma unroll
            for (int b = 0; b < 2; ++b)
#pragma unroll
                for (int m = 0; m < 4; ++m)
#pragma unroll
                    for (int n = 0; n < 2; ++n) acc[a][b][m][n] = (f32x4){0.f, 0.f, 0.f, 0.f};
        cur = nxt; cA = nA; cB = nB; ++ui;
        if constexpr (ALIGN_EPI) { if (wr == 1) PG8_BAR; }
    }
    PG8_WAIT_V(0);
    if constexpr (!ALIGN_EPI) { if (wr == 0) PG8_BAR; }
    PG8_BAR;
#undef PG8_SA
#undef PG8_SB
#undef PG8_STAGE
#undef PG8_LDA
#undef PG8_LDB
#undef PG8_MMA
#undef PG8_WAIT_V
#undef PG8_WAIT_L
#undef PG8_BAR
#undef PG8_SCHED
}

struct EpiProj {
    static constexpr bool PERM = true;
    bf16_t* PA; bf16_t* PG; bf16_t* UB; const float* SA; const float* SB;
    __device__ __forceinline__ void operator()(const f32x4 (&acc)[2][2][4][2], const Unit& u, int wr, int wc, int fr, int fq) const {
        const int row0 = u.pm * BM + wr * 64 + fr; int colt = u.pn * BM; const bool isu = colt < 1024, isg = colt >= 4096; bf16_t* base = PA;
        const int gcol0 = colt + wc * 32 + 8 * fq; colt &= 4095;
        const int col0 = colt + wc * 32 + 8 * fq;
        f32x4 sb[2][2];
#pragma unroll
        for (int bj = 0; bj < 2; ++bj) { sb[bj][0] = *(const f32x4*)(SB + gcol0 + bj * HALF); sb[bj][1] = *(const f32x4*)(SB + gcol0 + bj * HALF + 4); }
        float saq[2][4];
#pragma unroll
        for (int ai = 0; ai < 2; ++ai)
#pragma unroll
            for (int m = 0; m < 4; ++m) saq[ai][m] = SA[row0 + ai * HALF + m * 16];
#pragma unroll
        for (int ai = 0; ai < 2; ++ai)
#pragma unroll
            for (int m = 0; m < 4; ++m) { const int row = row0 + ai * HALF + m * 16; bf16_t* rowp = base + (size_t)row * 4096 + col0; const float sa = saq[ai][m];
#pragma unroll
                for (int bj = 0; bj < 2; ++bj) { const i32x4 i0 = __builtin_bit_cast(i32x4, acc[ai][bj][m][0]), i1 = __builtin_bit_cast(i32x4, acc[ai][bj][m][1]);
                    f32x4 v0, v1;
#pragma unroll
                    for (int e = 0; e < 4; ++e) { v0[e] = (float)i0[e] * sa * sb[bj][0][e]; v1[e] = (float)i1[e] * sa * sb[bj][1][e]; }
                    u32x4 w; w.x = cvt_pk_bf16(v0[0], v0[1]); w.y = cvt_pk_bf16(v0[2], v0[3]); w.z = cvt_pk_bf16(v1[0], v1[1]); w.w = cvt_pk_bf16(v1[2], v1[3]);
                    if (isu) { const int cu = col0 + bj * HALF; *(u32x4*)(UB + (((size_t)((row >> 13) * 64 + (cu >> 4)) * 8192 + (row & 8191)) * 16 + (cu & 8))) = w; }
                    else if (isg) { u32x2 w8; w8.x = pack4_fp8(v0[0], v0[1], v0[2], v0[3], F8_SG); w8.y = pack4_fp8(v1[0], v1[1], v1[2], v1[3], F8_SG);
                        *(u32x2*)((unsigned char*)PG + (size_t)row * 4096 + col0 + bj * HALF) = w8; }
                    else *(u32x4*)(rowp + bj * HALF) = w; } }
    }
};
struct EpiAttUp {
    static constexpr bool PERM = true;
    const bf16_t* PG; bf16_t* HB;
    __device__ __forceinline__ void operator()(const f32x4 (&acc)[2][2][4][2], const Unit& u, int wr, int wc, int fr, int fq) const {
        const int row0 = u.pm * BM + wr * 64 + fr; const int col0 = u.pn * BM + wc * 32 + 8 * fq;
#pragma unroll
        for (int ai = 0; ai < 2; ++ai) {
            u32x2 gq[4][2];
#pragma unroll
            for (int m = 0; m < 4; ++m)
#pragma unroll
                for (int bj = 0; bj < 2; ++bj) gq[m][bj] = *(const u32x2*)((const unsigned char*)PG + (size_t)(row0 + ai * HALF + m * 16) * 4096 + 2048 + col0 + bj * HALF);
            asm volatile("" ::: "memory");
#pragma unroll
            for (int m = 0; m < 4; ++m) { const size_t row = (size_t)(row0 + ai * HALF + m * 16);
#pragma unroll
                for (int bj = 0; bj < 2; ++bj) { const int col = col0 + bj * HALF;
                    const u32x2 gw = gq[m][bj];
                    const f32x2 ga = __builtin_amdgcn_cvt_pk_f32_fp8((int)gw.x, false), gb = __builtin_amdgcn_cvt_pk_f32_fp8((int)gw.x, true), gc = __builtin_amdgcn_cvt_pk_f32_fp8((int)gw.y, false), gd = __builtin_amdgcn_cvt_pk_f32_fp8((int)gw.y, true);
                    const f32x4 v0 = acc[ai][bj][m][0] * F8_INV, v1 = acc[ai][bj][m][1] * F8_INV;
                    u32x2 w;
                    w.x = pack4_fp8(v0[0] * sigmoid_g(ga.x), v0[1] * sigmoid_g(ga.y), v0[2] * sigmoid_g(gb.x), v0[3] * sigmoid_g(gb.y), F8_SA);
                    w.y = pack4_fp8(v1[0] * sigmoid_g(gc.x), v1[1] * sigmoid_g(gc.y), v1[2] * sigmoid_g(gd.x), v1[3] * sigmoid_g(gd.y), F8_SA);
                    *(u32x2*)((unsigned char*)HB + row * 2048 + col) = w; } }
            asm volatile("" ::: "memory"); }
    }
};
struct EpiGlu {
    static constexpr bool PERM = true;
    const bf16_t* PG; const bf16_t* HB; unsigned char* M8;
    __device__ __forceinline__ void operator()(const f32x4 (&acc)[2][2][4][2], const Unit& u, int wr, int wc, int fr, int fq) const {
        const int row0 = u.pm * BM + wr * 64 + fr; const int col = u.pn * HALF + wc * 32 + 8 * fq;
#pragma unroll
        for (int ai = 0; ai < 2; ++ai) {
            u32x2 gq[4], aq[4];
#pragma unroll
            for (int m = 0; m < 4; ++m) { const size_t row = (size_t)(row0 + ai * HALF + m * 16); gq[m] = *(const u32x2*)((const unsigned char*)PG + row * 4096 + col); aq[m] = *(const u32x2*)((const unsigned char*)HB + row * 2048 + col); }
            asm volatile("" ::: "memory");
#pragma unroll
            for (int m = 0; m < 4; ++m) { const size_t row = (size_t)(row0 + ai * HALF + m * 16);
                const u32x2 gw = gq[m], aw8 = aq[m];
                const f32x2 pa = __builtin_amdgcn_cvt_pk_f32_fp8((int)aw8.x, false) * (1.0f / F8_SA), pb = __builtin_amdgcn_cvt_pk_f32_fp8((int)aw8.x, true) * (1.0f / F8_SA), pc = __builtin_amdgcn_cvt_pk_f32_fp8((int)aw8.y, false) * (1.0f / F8_SA), pd = __builtin_amdgcn_cvt_pk_f32_fp8((int)aw8.y, true) * (1.0f / F8_SA);
                const f32x2 ga = __builtin_amdgcn_cvt_pk_f32_fp8((int)gw.x, false), gb = __builtin_amdgcn_cvt_pk_f32_fp8((int)gw.x, true), gc = __builtin_amdgcn_cvt_pk_f32_fp8((int)gw.y, false), gd = __builtin_amdgcn_cvt_pk_f32_fp8((int)gw.y, true);
                const f32x4 a0 = acc[ai][0][m][0] * F8_INV, a1 = acc[ai][0][m][1] * F8_INV, g0 = acc[ai][1][m][0] * F8_INV, g1 = acc[ai][1][m][1] * F8_INV;
                u32x2 w;
                w.x = pack4_fp8(sigmoid_g(ga.x) * a0[0] * sigmoidf_(g0[0]) + pa.x, sigmoid_g(ga.y) * a0[1] * sigmoidf_(g0[1]) + pa.y,
                                sigmoid_g(gb.x) * a0[2] * sigmoidf_(g0[2]) + pb.x, sigmoid_g(gb.y) * a0[3] * sigmoidf_(g0[3]) + pb.y, F8_SA);
                w.y = pack4_fp8(sigmoid_g(gc.x) * a1[0] * sigmoidf_(g1[0]) + pc.x, sigmoid_g(gc.y) * a1[1] * sigmoidf_(g1[1]) + pc.y,
                                sigmoid_g(gd.x) * a1[2] * sigmoidf_(g1[2]) + pd.x, sigmoid_g(gd.y) * a1[3] * sigmoidf_(g1[3]) + pd.y, F8_SA);
                *(u32x2*)(M8 + row * 2048 + col) = w; }
            asm volatile("" ::: "memory"); }
    }
};
struct EpiOut {
    static constexpr bool PERM = true;
    const float* X; bf16_t* O; const float* mod;
    __device__ __forceinline__ void operator()(const f32x4 (&acc)[2][2][4][2], const Unit& u, int wr, int wc, int fr, int fq) const {
        const int row0 = u.pm * BM + wr * 64 + fr; const int col0 = u.pn * BM + wc * 32 + 8 * fq;
        const float* gt = mod + (size_t)((u.pm * BM) >> 13) * 12288 + 4096;
#pragma unroll
        for (int bj = 0; bj < 2; ++bj) { const int col = col0 + bj * HALF;
            const f32x4 g0 = *(const f32x4*)(gt + col), g1 = *(const f32x4*)(gt + col + 4);
#pragma unroll
            for (int ai = 0; ai < 2; ++ai) {
                f32x4 xq[4][2];
#pragma unroll
                for (int m = 0; m < 4; ++m) { const size_t off = (size_t)(row0 + ai * HALF + m * 16) * 2048 + col; xq[m][0] = *(const f32x4*)(X + off); xq[m][1] = *(const f32x4*)(X + off + 4); }
                asm volatile("" ::: "memory");
#pragma unroll
                for (int m = 0; m < 4; ++m) { const size_t off = (size_t)(row0 + ai * HALF + m * 16) * 2048 + col;
                    const f32x4 o0 = xq[m][0] + g0 * (acc[ai][bj][m][0] * F8_INV), o1 = xq[m][1] + g1 * (acc[ai][bj][m][1] * F8_INV);
                    u32x4 w; w.x = cvt_pk_bf16(o0[0], o0[1]); w.y = cvt_pk_bf16(o0[2], o0[3]); w.z = cvt_pk_bf16(o1[0], o1[1]); w.w = cvt_pk_bf16(o1[2], o1[3]);
                    *(u32x4*)(O + off) = w; }
                asm volatile("" ::: "memory"); } }
    }
};
struct EpiF32 {
    static constexpr bool PERM = true;
    bf16_t* O;
    __device__ __forceinline__ void operator()(const f32x4 (&acc)[2][2][4][2], const Unit& u, int wr, int wc, int fr, int fq) const {
        const int row0 = u.pm * BM + wr * 64 + fr; const int col0 = u.pn * BM + wc * 32 + 8 * fq;
#pragma unroll
        for (int ai = 0; ai < 2; ++ai)
#pragma unroll
            for (int m = 0; m < 4; ++m) { bf16_t* rowp = O + (size_t)(row0 + ai * HALF + m * 16) * 2048 + col0;
#pragma unroll
                for (int bj = 0; bj < 2; ++bj) { const f32x4 a = acc[ai][bj][m][0], b = acc[ai][bj][m][1];
                    u32x4 w; w.x = cvt_pk_bf16(a[0], a[1]); w.y = cvt_pk_bf16(a[2], a[3]); w.z = cvt_pk_bf16(b[0], b[1]); w.w = cvt_pk_bf16(b[2], b[3]);
                    *(u32x4*)(rowp + bj * HALF) = w; } }
    }
};
}

struct Args { const float* in[25]; float* out; unsigned char* ws; int ph_lo, ph_hi; };
enum { I_X = 0, I_C, I_WADA, I_BADA, I_N1G, I_WIN, I_LRE, I_LIM, I_LDT, I_BRE, I_BIM, I_CRE, I_CIM, I_SD, I_WGLU, I_QNG, I_KNG, I_WATT, I_WOUT, I_N2G, I_WQ, I_K1, I_K2, I_PU, I_PV };

__device__ __forceinline__ void ph_mod_partial(const float* __restrict__ c, const float* __restrict__ w_ada, float* modp, int gw, int ngw, int lane) {
    for (int task = gw; task < 48 * 32; task += ngw) {
        const int strip = task % 48, ks = task / 48, n0 = strip * 256 + lane * 4, k0 = ks * 64;
        f32x4 a0 = {0.f, 0.f, 0.f, 0.f}, a1 = {0.f, 0.f, 0.f, 0.f};
#pragma unroll 8
        for (int k = 0; k < 64; ++k) {
            const f32x4 w = *(const f32x4*)(w_ada + (size_t)(k0 + k) * 12288 + n0);
            float c0 = c[k0 + k], c1 = c[2048 + k0 + k];
            c0 = c0 / (1.0f + __expf(-c0)); c1 = c1 / (1.0f + __expf(-c1));
            a0 += c0 * w; a1 += c1 * w;
        }
        *(f32x4*)(modp + (size_t)(ks * 2 + 0) * 12288 + n0) = a0;
        *(f32x4*)(modp + (size_t)(ks * 2 + 1) * 12288 + n0) = a1;
    }
}

__device__ __forceinline__ void ph_colmax_partial(const float* __restrict__ w_in, float* cmaxp, int gw, int ngw, int lane) {
    for (int task = gw; task < 32 * 32; task += ngw) {
        const int strip = task & 31, ks = task >> 5, n0 = strip * 256 + lane * 4, k0 = ks * 64;
        f32x4 m = {0.f, 0.f, 0.f, 0.f};
#pragma unroll 8
        for (int k = 0; k < 64; ++k) { const f32x4 w = *(const f32x4*)(w_in + (size_t)(k0 + k) * 8192 + n0);
            m[0] = fmaxf(m[0], fabsf(w[0])); m[1] = fmaxf(m[1], fabsf(w[1])); m[2] = fmaxf(m[2], fabsf(w[2])); m[3] = fmaxf(m[3], fabsf(w[3])); }
        *(f32x4*)(cmaxp + (size_t)ks * 8192 + n0) = m;
    }
}

__device__ __forceinline__ void transpose_item_f8(const float* __restrict__ W, int K, int N, unsigned char* WT8, int drow0, int scol0, int k0, LAS float* scr, int lane) {
#pragma unroll 8
    for (int i = 0; i < 32; ++i) { const int kk = 2 * i + (lane >> 5); scr[kk * 33 + (lane & 31)] = W[(size_t)(k0 + kk) * N + scol0 + (lane & 31)]; }
    LDS_WAIT();
    const int n = lane >> 1, half = lane & 1;
    const LAS float* s = scr + (32 * half) * 33 + n;
    u32x4 o[2];
#pragma unroll
    for (int q = 0; q < 8; ++q) o[q >> 2][q & 3] = pack4_fp8(s[(4 * q) * 33], s[(4 * q + 1) * 33], s[(4 * q + 2) * 33], s[(4 * q + 3) * 33], F8_SW);
    *(u32x4*)(WT8 + (size_t)(drow0 + n) * K + k0 + 32 * half) = o[0];
    *(u32x4*)(WT8 + (size_t)(drow0 + n) * K + k0 + 32 * half + 16) = o[1];
    LDS_WAIT();
}
__device__ __forceinline__ void transpose_item_i8(const float* __restrict__ W, signed char* WT8, const float* cmaxp, float* SB, int n0, int k0, LAS float* scr, int lane) {
#pragma unroll 8
    for (int i = 0; i < 32; ++i) { const int kk = 2 * i + (lane >> 5); scr[kk * 33 + (lane & 31)] = W[(size_t)(k0 + kk) * 8192 + n0 + (lane & 31)]; }
    const int n = lane >> 1, half = lane & 1;
    float cm = 0.f;
#pragma unroll 8
    for (int ks = 0; ks < 32; ++ks) cm = fmaxf(cm, cmaxp[(size_t)ks * 8192 + n0 + n]);
    const float sb = fmaxf(cm, 1e-30f) * (1.0f / 127.0f), inv = 1.0f / sb;
    if (k0 == 0 && half == 0) SB[n0 + n] = sb;
    LDS_WAIT();
    const LAS float* s = scr + (32 * half) * 33 + n;
    u32x4 o[2];
#pragma unroll
    for (int q = 0; q < 8; ++q) { unsigned w = 0;
#pragma unroll
        for (int e = 0; e < 4; ++e) { const int v = (int)rintf(s[(4 * q + e) * 33] * inv); w |= ((unsigned)v & 0xffu) << (8 * e); }
        o[q >> 2][q & 3] = w; }
    *(u32x4*)(WT8 + (size_t)(n0 + n) * 2048 + k0 + 32 * half) = o[0];
    *(u32x4*)(WT8 + (size_t)(n0 + n) * 2048 + k0 + 32 * half + 16) = o[1];
    LDS_WAIT();
}

__device__ __forceinline__ void transpose_item(const float* __restrict__ W, int K, int N, bf16_t* WT, int drow0, int scol0, int k0, LAS float* scr, int lane) {
#pragma unroll 8
    for (int i = 0; i < 32; ++i) { const int kk = 2 * i + (lane >> 5); scr[kk * 33 + (lane & 31)] = W[(size_t)(k0 + kk) * N + scol0 + (lane & 31)]; }
    LDS_WAIT();
    const int c = lane & 7;
#pragma unroll
    for (int j = 0; j < 4; ++j) { const int n = (lane >> 3) + 8 * j; const LAS float* s = scr + (8 * c) * 33 + n;
        u32x4 o; o.x = cvt_pk_bf16(s[0 * 33], s[1 * 33]); o.y = cvt_pk_bf16(s[2 * 33], s[3 * 33]); o.z = cvt_pk_bf16(s[4 * 33], s[5 * 33]); o.w = cvt_pk_bf16(s[6 * 33], s[7 * 33]);
        *(u32x4*)(WT + (size_t)(drow0 + n) * K + k0 + 8 * c) = o; }
    LDS_WAIT();
}
__device__ __forceinline__ void wsc_item(const float* wq, const float* kk, bf16_t* out, int lane) {
    const int r = lane & 15, q = lane >> 4;
    f32x4 acc[8];
#pragma unroll
    for (int f = 0; f < 8; ++f) acc[f] = (f32x4){0.f, 0.f, 0.f, 0.f};
    const float* ap = kk + r * 128 + 4 * q; const float* bp = wq + (size_t)r * 2048 + 4 * q;
#pragma unroll 2
    for (int d0 = 0; d0 < 128; d0 += 16) {
        const f32x4 bv = *(const f32x4*)(bp + d0);
        f32x4 av[8];
#pragma unroll
        for (int f = 0; f < 8; ++f) av[f] = *(const f32x4*)(ap + f * 2048 + d0);
#pragma unroll
        for (int j = 0; j < 4; ++j)
#pragma unroll
            for (int f = 0; f < 8; ++f) acc[f] = __builtin_amdgcn_mfma_f32_16x16x4f32(av[f][j], bv[j], acc[f], 0, 0, 0);
    }
#pragma unroll
    for (int f = 0; f < 8; ++f)
#pragma unroll
        for (int i = 0; i < 4; ++i) out[(size_t)(16 * f + 4 * q + i) * 2048 + r] = (bf16_t)(cvt_pk_bf16(acc[f][i], 0.f) & 0xffffu);
}
__device__ __forceinline__ void ph_prologue(const Args& a, LAS unsigned char* lds, int gw, int ngw, int lane, int wave) {
    unsigned char* ws = a.ws;
    { const float* modp = (const float*)(ws + WS_MODP); float* mod = (float*)(ws + WS_MOD); const float* b_ada = a.in[I_BADA];
      for (int idx = gw * 64 + lane; idx < 2 * 12288; idx += ngw * 64) { const int b = idx / 12288, n = idx - b * 12288; float s = b_ada[n];
#pragma unroll 8
          for (int ks = 0; ks < 32; ++ks) s += modp[(size_t)(ks * 2 + b) * 12288 + n];
          mod[idx] = s; } }
    for (int item = gw; item < 2048; item += ngw) { const int hj = item >> 7, k0 = (item & 127) * 16;
        wsc_item(a.in[I_WQ] + (size_t)k0 * 2048 + hj * 128, (hj & 1) ? a.in[I_K2] : a.in[I_K1], (bf16_t*)(ws + WS_WSC) + (size_t)(hj * 128) * 2048 + k0, lane); }
    { LAS float* scr = (LAS float*)(lds + wave * 8448);
      constexpr int I_IN = 32 * 256, I_GLU = 16 * 128, I_ATT = 16 * 64, I_OUT = 32 * 64, NIT = I_IN + I_GLU + I_ATT + I_OUT;
      for (int it = gw; it < NIT; it += ngw) {
          int r = it;
          if (r < I_IN) { const int kb = r / 256, nb = r % 256; transpose_item_i8(a.in[I_WIN], (signed char*)(ws + WS_WIN), (const float*)(ws + WS_CMAXP), (float*)(ws + WS_SB), 32 * nb, 64 * kb, scr, lane); continue; } r -= I_IN;
          if (r < I_GLU) { const int kb = r / 128, nb = r % 128, dr = 32 * nb; const int sc = ((dr >> 7) & 1) * 2048 + (dr >> 8) * 128 + (dr & 127);
              transpose_item_f8(a.in[I_WGLU], 1024, 4096, ws + WS_WGLU, dr, sc, 64 * kb, scr, lane); continue; } r -= I_GLU;
          if (r < I_ATT) { const int kb = r / 64, nb = r % 64; transpose_item_f8(a.in[I_WATT], 1024, 2048, ws + WS_WATT, 32 * nb, 32 * nb, 64 * kb, scr, lane); continue; } r -= I_ATT;
          { const int kb = r / 64, nb = r % 64; transpose_item_f8(a.in[I_WOUT], 2048, 2048, ws + WS_WOUT, 32 * nb, 32 * nb, 64 * kb, scr, lane); }
      } }
}

template <bool I8, bool XB = false>
__device__ __forceinline__ void ph_norm(const float* X, bf16_t* Hout, float* SA, const float* __restrict__ g, const float* mod, int sh_off, int sc_off, int gw, int ngw, int lane) {
    f32x4 ga[8], sh[8], v[8], nv[8]; int cb = -1;
#define NORM_LDROW(r_) do { if (XB) { const u32x2* xr = (const u32x2*)((const bf16_t*)X + (size_t)(r_) * DM) + lane; \
            _Pragma("unroll") for (int j = 0; j < 8; ++j) { const u32x2 w = xr[64 * j]; nv[j] = (f32x4){bf_lo(w.x), bf_hi(w.x), bf_lo(w.y), bf_hi(w.y)}; } } \
        else { const f32x4* xr = (const f32x4*)(X + (size_t)(r_) * DM) + lane; _Pragma("unroll") for (int j = 0; j < 8; ++j) nv[j] = xr[64 * j]; } } while (0)
    if (gw < T_TOK) NORM_LDROW(gw);
    for (int row = gw; row < T_TOK; row += ngw) {
        const int b = row >> 13;
        if (b != cb) { cb = b; const float* mb = mod + (size_t)b * 12288;
#pragma unroll
            for (int j = 0; j < 8; ++j) { const int col = 4 * (lane + 64 * j);
                const f32x4 gv = *(const f32x4*)(g + col), sc = *(const f32x4*)(mb + sc_off + col); sh[j] = *(const f32x4*)(mb + sh_off + col); ga[j] = gv * (sc + 1.0f); } }
        float ss = 0.f;
#pragma unroll
        for (int j = 0; j < 8; ++j) { v[j] = nv[j]; ss += (v[j][0] * v[j][0] + v[j][1] * v[j][1]) + (v[j][2] * v[j][2] + v[j][3] * v[j][3]); }
        { const int rn = (row + ngw < T_TOK) ? row + ngw : row; NORM_LDROW(rn); }
        ss = wave_sum(ss);
        const float rs = __builtin_amdgcn_rsqf(ss * (1.0f / DM) + EPS);
        float amax = 0.f;
#pragma unroll
        for (int j = 0; j < 8; ++j) { const int col = 4 * (lane + 64 * j);
            const f32x4 o = v[j] * rs * ga[j] + sh[j];
            if (I8) { v[j] = o; amax = fmaxf(fmaxf(amax, fmaxf(fabsf(o[0]), fabsf(o[1]))), fmaxf(fabsf(o[2]), fabsf(o[3]))); }
            else { u32x2 w; w.x = cvt_pk_bf16(o[0], o[1]); w.y = cvt_pk_bf16(o[2], o[3]); *(u32x2*)(Hout + (size_t)row * DM + col) = w; } }
        if (I8) {
#pragma unroll
            for (int o = 1; o < 64; o <<= 1) amax = fmaxf(amax, __shfl_xor(amax, o));
            const float sa = fmaxf(amax, 1e-30f) * (1.0f / 127.0f), inv = 1.0f / sa;
            if (lane == 0) SA[row] = sa;
            unsigned* h8 = (unsigned*)((signed char*)Hout + (size_t)row * DM) + lane;
#pragma unroll
            for (int j = 0; j < 8; ++j) { unsigned w = 0;
#pragma unroll
                for (int e = 0; e < 4; ++e) { const int q = (int)rintf(v[j][e] * inv); w |= ((unsigned)q & 0xffu) << (8 * e); }
                h8[64 * j] = w; }
        }
    }
}

template <int MODE>
__device__ __forceinline__ void ph_attn(LAS unsigned char* lds, const bf16_t* PA, bf16_t* ATT, const float* __restrict__ qg, const float* __restrict__ kg, int G) {
    const int tid = opaque_tid(), lane = tid & 63, wave = __builtin_amdgcn_readfirstlane(tid >> 6), c = lane & 15, g = lane >> 4;
    LAS unsigned char* KL = lds;
    LAS unsigned char* VL = lds + 17408;
    bf16x8 tri[6];
    { const int FS[6] = {0, 1, 0, 1, 2, 3}, FP[6] = {0, 0, 1, 1, 1, 1};
#pragma unroll
      for (int q = 0; q < 6; ++q)
#pragma unroll
          for (int jj = 0; jj < 8; ++jj) { const int kap = 32 * FP[q] + 16 * (jj >> 2) + 4 * g + (jj & 3); tri[q][jj] = (kap > 16 * FS[q] + c) ? (short)0x3F80 : (short)0; } }
    for (int u = blockIdx.x; u < 1024; u += G) {
        const int b = u >> 9, h = (u >> 6) & 7, qb = u & 63, t0 = qb * 128, tq0 = t0 + 16 * wave, tq = tq0 + c;
        bf16x8 qf[4];
        { const bf16_t* qrow = PA + (size_t)(b * SEQ + tq) * 4096 + 1024 + h * 128;
          u32x4 qr[4]; float ss = 0.f;
#pragma unroll
          for (int kk = 0; kk < 4; ++kk) { qr[kk] = *(const u32x4*)(qrow + 32 * kk + 8 * g);
#pragma unroll
              for (int e = 0; e < 4; ++e) { const float lo = bf_lo(qr[kk][e]), hi = bf_hi(qr[kk][e]); ss += lo * lo + hi * hi; } }
          ss += __shfl_xor(ss, 16); ss += __shfl_xor(ss, 32);
          const float rs = __builtin_amdgcn_rsqf(ss * (1.0f / 128.0f) + EPS) * (0.08838834764831845f * 1.4426950408889634f);
#pragma unroll
          for (int kk = 0; kk < 4; ++kk) { const f32x4 g0 = *(const f32x4*)(qg + 32 * kk + 8 * g), g1 = *(const f32x4*)(qg + 32 * kk + 8 * g + 4);
              u32x4 w;
              w.x = cvt_pk_bf16(bf_lo(qr[kk].x) * rs * g0[0], bf_hi(qr[kk].x) * rs * g0[1]);
              w.y = cvt_pk_bf16(bf_lo(qr[kk].y) * rs * g0[2], bf_hi(qr[kk].y) * rs * g0[3]);
              w.z = cvt_pk_bf16(bf_lo(qr[kk].z) * rs * g1[0], bf_hi(qr[kk].z) * rs * g1[1]);
              w.w = cvt_pk_bf16(bf_lo(qr[kk].w) * rs * g1[2], bf_hi(qr[kk].w) * rs * g1[3]);
              qf[kk] = __builtin_bit_cast(bf16x8, w); } }
        float carry = 0.f; int wdone = 0;
        f32x4 oacc[8];
#pragma unroll
        for (int fd = 0; fd < 8; ++fd) oacc[fd] = (f32x4){0.f, 0.f, 0.f, 0.f};
        u32x4 kreg[2], vreg[2];
        { const int k0n = (2 * qb + 1) * 64;
#pragma unroll
          for (int p = 0; p < 2; ++p) { const int ci = tid + 512 * p, key = ci >> 4, ch = ci & 15;
              kreg[p] = *(const u32x4*)(PA + (size_t)(b * SEQ + k0n + key) * 4096 + 2048 + h * 128 + 8 * ch);
              vreg[p] = *(const u32x4*)(PA + (size_t)(b * SEQ + k0n + key) * 4096 + 3072 + h * 128 + 8 * ch); } }
        for (int kt = 2 * qb + 1; kt >= 0; --kt) {
            const int k0 = kt * 64;
            if (__syncthreads_and(wdone)) break;
#pragma unroll
            for (int p = 0; p < 2; ++p) {
                const int ci = tid + 512 * p, key = ci >> 4, ch = ci & 15;
                const u32x4 kr = kreg[p];
                float f[8]; f[0] = bf_lo(kr.x); f[1] = bf_hi(kr.x); f[2] = bf_lo(kr.y); f[3] = bf_hi(kr.y); f[4] = bf_lo(kr.z); f[5] = bf_hi(kr.z); f[6] = bf_lo(kr.w); f[7] = bf_hi(kr.w);
                float ss = 0.f;
#pragma unroll
                for (int e = 0; e < 8; ++e) ss += f[e] * f[e];
                ss += __shfl_xor(ss, 1); ss += __shfl_xor(ss, 2); ss += __shfl_xor(ss, 4); ss += __shfl_xor(ss, 8);
                const float rs = __builtin_amdgcn_rsqf(ss * (1.0f / 128.0f) + EPS);
                const f32x4 g0 = *(const f32x4*)(kg + 8 * ch), g1 = *(const f32x4*)(kg + 8 * ch + 4);
                u32x4 w;
                w.x = cvt_pk_bf16(f[0] * rs * g0[0], f[1] * rs * g0[1]); w.y = cvt_pk_bf16(f[2] * rs * g0[2], f[3] * rs * g0[3]);
                w.z = cvt_pk_bf16(f[4] * rs * g1[0], f[5] * rs * g1[1]); w.w = cvt_pk_bf16(f[6] * rs * g1[2], f[7] * rs * g1[3]);
                *(LAS u32x4*)(KL + key * 272 + ch * 16) = w;
            }
#pragma unroll
            for (int p = 0; p < 2; ++p) { const int ci = tid + 512 * p, key = ci >> 4, ch = ci & 15; *(LAS u32x4*)(VL + key * 288 + ch * 16) = vreg[p]; }
            if (kt > 0) { const int k0n = k0 - 64;
#pragma unroll
                for (int p = 0; p < 2; ++p) { const int ci = tid + 512 * p, key = ci >> 4, ch = ci & 15;
                    kreg[p] = *(const u32x4*)(PA + (size_t)(b * SEQ + k0n + key) * 4096 + 2048 + h * 128 + 8 * ch);
                    vreg[p] = *(const u32x4*)(PA + (size_t)(b * SEQ + k0n + key) * 4096 + 3072 + h * 128 + 8 * ch); } }
            __syncthreads();
            if (MODE == 1) { if (kt <= 2 * qb - 3) wdone = 1; }
            if (MODE == 0 && !wdone && k0 < tq0 + 15) {
                f32x4 zt[4];
#pragma unroll
                for (int f = 0; f < 4; ++f) { f32x4 acc = {0.f, 0.f, 0.f, 0.f};
#pragma unroll
                    for (int kk = 0; kk < 4; ++kk) { const bf16x8 kf = *(const LAS bf16x8*)(KL + (16 * f + c) * 272 + (32 * kk + 8 * g) * 2);
                        acc = __builtin_amdgcn_mfma_f32_16x16x32_bf16(kf, qf[kk], acc, 0, 0, 0); }
                    zt[f] = acc; }
                float lf[4][4], lz[4][4]; float tot = 0.f;
                if (k0 + 63 >= tq0) {
#pragma unroll
                    for (int f = 0; f < 4; ++f)
#pragma unroll
                        for (int i = 0; i < 4; ++i) { const int s = k0 + 16 * f + 4 * g + i; const bool valid = s < tq; const float z = zt[f][i];
                            const float sp = fmaxf(z, 0.f) + __builtin_amdgcn_logf(1.0f + __builtin_amdgcn_exp2f(-fabsf(z)));
                            const float l = valid ? -sp : 0.f; lf[f][i] = l; lz[f][i] = valid ? (l + z) : -INFINITY; tot += l; }
                } else {
#pragma unroll
                    for (int f = 0; f < 4; ++f)
#pragma unroll
                        for (int i = 0; i < 4; ++i) { const float z = zt[f][i];
                            const float l = -(fmaxf(z, 0.f) + __builtin_amdgcn_logf(1.0f + __builtin_amdgcn_exp2f(-fabsf(z)))); lf[f][i] = l; lz[f][i] = l + z; tot += l; }
                }
                tot += __shfl_xor(tot, 16); tot += __shfl_xor(tot, 32);
                bf16x8 lh[2];
#pragma unroll
                for (int fp = 0; fp < 2; ++fp) { u32x4 wh;
#pragma unroll
                    for (int q = 0; q < 2; ++q) { const int f = 2 * fp + q; wh[2 * q] = cvt_pk_bf16(lf[f][0], lf[f][1]); wh[2 * q + 1] = cvt_pk_bf16(lf[f][2], lf[f][3]); }
                    lh[fp] = __builtin_bit_cast(bf16x8, wh); }
                f32x4 sf[4];
                { f32x4 z4 = {0.f, 0.f, 0.f, 0.f};
                  sf[0] = __builtin_amdgcn_mfma_f32_16x16x32_bf16(tri[0], lh[0], z4, 0, 0, 0); sf[0] = __builtin_amdgcn_mfma_f32_16x16x32_bf16(tri[2], lh[1], sf[0], 0, 0, 0);
                  sf[1] = __builtin_amdgcn_mfma_f32_16x16x32_bf16(tri[1], lh[0], z4, 0, 0, 0); sf[1] = __builtin_amdgcn_mfma_f32_16x16x32_bf16(tri[3], lh[1], sf[1], 0, 0, 0);
                  sf[2] = __builtin_amdgcn_mfma_f32_16x16x32_bf16(tri[4], lh[1], z4, 0, 0, 0);
                  sf[3] = __builtin_amdgcn_mfma_f32_16x16x32_bf16(tri[5], lh[1], z4, 0, 0, 0); }
                bf16x8 pb[2];
#pragma unroll
                for (int fp = 0; fp < 2; ++fp) { u32x4 w;
#pragma unroll
                    for (int q = 0; q < 2; ++q) { const int f = 2 * fp + q; float p[4];
#pragma unroll
                        for (int i = 0; i < 4; ++i) p[i] = __builtin_amdgcn_exp2f(lz[f][i] + sf[f][i] + carry);
                        w[2 * q] = cvt_pk_bf16(p[0], p[1]); w[2 * q + 1] = cvt_pk_bf16(p[2], p[3]); }
                    pb[fp] = __builtin_bit_cast(bf16x8, w); }
                carry += tot;
#pragma unroll
                for (int fd = 0; fd < 8; ++fd)
#pragma unroll
                    for (int fp = 0; fp < 2; ++fp) { const LAS unsigned char* vp = VL + (32 * fp + 4 * g + (c >> 2)) * 288 + (16 * fd + 4 * (c & 3)) * 2;
                        const u32x2 v0 = __builtin_bit_cast(u32x2, __builtin_amdgcn_ds_read_tr16_b64_v4i16((LAS v4i16_t*)vp)), v1 = __builtin_bit_cast(u32x2, __builtin_amdgcn_ds_read_tr16_b64_v4i16((LAS v4i16_t*)(vp + 16 * 288)));
                        u32x4 vw; vw.x = v0.x; vw.y = v0.y; vw.z = v1.x; vw.w = v1.y;
                        oacc[fd] = __builtin_amdgcn_mfma_f32_16x16x32_bf16(__builtin_bit_cast(bf16x8, vw), pb[fp], oacc[fd], 0, 0, 0); }
                wdone = (__ballot(carry >= -152.0f) == 0ull) ? 1 : 0;
            }
        }
        if (MODE == 0) { unsigned char* orow = (unsigned char*)ATT + (size_t)(b * SEQ + tq) * 1024 + h * 128 + 4 * g;
#pragma unroll
          for (int fd = 0; fd < 8; ++fd) *(unsigned*)(orow + 16 * fd) = pack4_fp8(oacc[fd][0], oacc[fd][1], oacc[fd][2], oacc[fd][3], F8_SA); }
    }
    __syncthreads();
}

__device__ __forceinline__ void ssm_lambda(const Args& a, int g, int st, float& lbr, float& lbi, float& qr, float& qi) {
    const float lr = a.in[I_LRE][g * 64 + st], li = a.in[I_LIM][g * 64 + st], dt = __expf(a.in[I_LDT][g]);
    const float mag = __expf(lr * dt);
    float rev = li * dt * 0.15915494309189535f; rev -= rintf(rev);
    lbr = mag * __builtin_amdgcn_cosf(rev); lbi = mag * __builtin_amdgcn_sinf(rev);
    const float nr = lbr - 1.0f, ni = lbi, den = 1.0f / (lr * lr + li * li);
    qr = (nr * lr + ni * li) * den; qi = (ni * lr - nr * li) * den;
}
template <bool WITH_Y>
__device__ __forceinline__ void ph_ssm_mfma(const Args& a, LAS unsigned char* lds, const bf16_t* UB, f32x2* E, bf16_t* YA, int G) {
    const int tid = opaque_tid(), lane = tid & 63, wave = __builtin_amdgcn_readfirstlane(tid >> 6), c = lane & 15, gl = lane >> 4;
    LAS f32x2* sl = (LAS f32x2*)(lds + wave * 8192);
    LAS f32x4* tab = (LAS f32x4*)(lds + 65536 + wave * 1024);
    LAS u32x4* cml = (LAS u32x4*)(lds + 73728 + wave * 5120) + lane;
    const bool spread = !WITH_Y && G == 256;
    for (int it = blockIdx.x; it < (spread ? 256 : 128); it += G) {
        if (spread && wave >= 4) continue;
        const int item = spread ? (it >> 1) : it, wv = spread ? ((it & 1) * 4 + wave) : wave;
        const int b = item >> 6, cb = (item >> 3) & 7, g = (item & 7) * 8 + wv, c0 = cb * 16;
        float mur, mui;
        { float lbr, lbi, qr, qi; ssm_lambda(a, g, lane, lbr, lbi, qr, qi); tab[lane] = (f32x4){lbr, lbi, qr, qi}; mur = lbr; mui = lbi; }
        LDS_WAIT();
        bf16x8 bm[8];
        const float* brb = a.in[I_BRE] + (g * 64 + (c >> 1)) * 16 + 8 * (gl & 1); const float* bib = a.in[I_BIM] + (g * 64 + (c >> 1)) * 16 + 8 * (gl & 1);
        const LAS f32x4* tabb = tab + (c >> 1);
#pragma unroll
        for (int f = 0; f < 8; ++f) { const f32x4 tv = tabb[8 * f]; const float qr = tv[2], qi = tv[3];
            const float* br = brb + 128 * f; const float* bim = bib + 128 * f;
            const f32x4 r0 = *(const f32x4*)br, r1 = *(const f32x4*)(br + 4), i0 = *(const f32x4*)bim, i1 = *(const f32x4*)(bim + 4);
            float v[8];
#pragma unroll
            for (int e = 0; e < 4; ++e) { const float vr0 = qr * r0[e] - qi * i0[e], vi0 = qr * i0[e] + qi * r0[e], vr1 = qr * r1[e] - qi * i1[e], vi1 = qr * i1[e] + qi * r1[e];
                v[e] = (c & 1) ? vi0 : vr0; v[4 + e] = (c & 1) ? vi1 : vr1; }
            if (gl >= 2) {
#pragma unroll
                for (int e = 0; e < 8; ++e) v[e] = 0.f; }
            u32x4 w; w.x = cvt_pk_bf16(v[0], v[1]); w.y = cvt_pk_bf16(v[2], v[3]); w.z = cvt_pk_bf16(v[4], v[5]); w.w = cvt_pk_bf16(v[6], v[7]);
            bm[f] = __builtin_bit_cast(bf16x8, w); }
        float lmr[16], lmi[16];
#pragma unroll
        for (int k = 0; k < 16; ++k) { const f32x4 tv = tab[2 * gl + 8 * (k >> 1) + (k & 1)]; lmr[k] = tv[0]; lmi[k] = tv[1]; }
        if (WITH_Y) {
            const float* crb = a.in[I_CRE] + (g * 16 + c) * 64 + 2 * gl; const float* cib = a.in[I_CIM] + (g * 16 + c) * 64 + 2 * gl;
#pragma unroll
            for (int kk = 0; kk < 4; ++kk) { float v[8];
#pragma unroll
                for (int jh = 0; jh < 2; ++jh) { const f32x2 r = *(const f32x2*)(crb + 8 * (2 * kk + jh)), m = *(const f32x2*)(cib + 8 * (2 * kk + jh));
                    v[4 * jh] = r.x; v[4 * jh + 1] = -m.x; v[4 * jh + 2] = r.y; v[4 * jh + 3] = -m.y; }
                u32x4 w; w.x = cvt_pk_bf16(v[0], v[1]); w.y = cvt_pk_bf16(v[2], v[3]); w.z = cvt_pk_bf16(v[4], v[5]); w.w = cvt_pk_bf16(v[6], v[7]);
                cml[64 * kk] = w; }
            { const float dv = a.in[I_SD][g * 16 + c]; float v[8];
#pragma unroll
              for (int jj = 0; jj < 8; ++jj) v[jj] = (gl < 2 && (8 * gl + jj) == c) ? dv : 0.f;
              u32x4 w; w.x = cvt_pk_bf16(v[0], v[1]); w.y = cvt_pk_bf16(v[2], v[3]); w.z = cvt_pk_bf16(v[4], v[5]); w.w = cvt_pk_bf16(v[6], v[7]);
              cml[256] = w; }
        }
        f32x4 s[8];
#pragma unroll
        for (int f = 0; f < 8; ++f) s[f] = (f32x4){0.f, 0.f, 0.f, 0.f};
        if (WITH_Y) {
            float pr = mur, pi = mui;
#pragma unroll
            for (int q = 0; q < 6; ++q) { const float nr = pr * pr - pi * pi, ni = 2.0f * pr * pi; pr = nr; pi = ni; }
            float sr = 0.f, si = 0.f;
            const f32x2* ep = E + (size_t)((b * 64 + g) * 128) * 64 + lane;
            f32x2 ev[8], en[8];
#pragma unroll
            for (int k = 0; k < 8; ++k) ev[k] = ep[(size_t)k * 64];
            for (int cc = 0; cc < c0 + 16; cc += 8) {
                if (cc + 8 < c0 + 16) {
#pragma unroll
                    for (int k = 0; k < 8; ++k) en[k] = ep[(size_t)(cc + 8 + k) * 64]; }
#pragma unroll
                for (int k = 0; k < 8; ++k) { if (cc >= c0) sl[(cc - c0 + k) * 64 + lane] = (f32x2){sr, si};
                    const float nr = pr * sr - pi * si + ev[k][0], ni = pr * si + pi * sr + ev[k][1]; sr = nr; si = ni; }
#pragma unroll
                for (int k = 0; k < 8; ++k) ev[k] = en[k];
            }
            LDS_WAIT();
#pragma unroll
            for (int f = 0; f < 8; ++f) s[f] = *(const LAS f32x4*)(sl + c * 64 + 8 * f + 2 * gl);
            LDS_WAIT();
        }
        const bf16_t* up = UB + ((size_t)(b * 64 + g) * 8192 + (size_t)(c0 + c) * 64) * 16 + 8 * (gl & 1);
        unsigned char* yp = (unsigned char*)YA + (size_t)(b * SEQ + (c0 + c) * 64) * 1024 + g * 16 + 4 * gl;
        u32x4 cu[4], nu[4];
#pragma unroll
        for (int j = 0; j < 4; ++j) cu[j] = *(const u32x4*)(up + 16 * j);
#pragma unroll 1
        for (int tau = 0; tau < 64; tau += 4) {
#pragma unroll
            for (int j = 0; j < 4; ++j) nu[j] = *(const u32x4*)(up + (size_t)(tau + 4 + j) * 16);
#pragma unroll
            for (int j = 0; j < 4; ++j) {
                const bf16x8 uf = __builtin_bit_cast(bf16x8, cu[j]);
#pragma unroll
                for (int f = 0; f < 8; ++f) { f32x4 ci;
                    ci[0] = lmr[2 * f] * s[f][0] - lmi[2 * f] * s[f][1]; ci[1] = lmr[2 * f] * s[f][1] + lmi[2 * f] * s[f][0];
                    ci[2] = lmr[2 * f + 1] * s[f][2] - lmi[2 * f + 1] * s[f][3]; ci[3] = lmr[2 * f + 1] * s[f][3] + lmi[2 * f + 1] * s[f][2];
                    s[f] = __builtin_amdgcn_mfma_f32_16x16x32_bf16(bm[f], uf, ci, 0, 0, 0); }
                if (WITH_Y) {
                    f32x4 y = __builtin_amdgcn_mfma_f32_16x16x32_bf16(__builtin_bit_cast(bf16x8, cml[256]), uf, (f32x4){0.f, 0.f, 0.f, 0.f}, 0, 0, 0);
#pragma unroll
                    for (int kk = 0; kk < 4; ++kk) { u32x4 w; w.x = cvt_pk_bf16(s[2 * kk][0], s[2 * kk][1]); w.y = cvt_pk_bf16(s[2 * kk][2], s[2 * kk][3]);
                        w.z = cvt_pk_bf16(s[2 * kk + 1][0], s[2 * kk + 1][1]); w.w = cvt_pk_bf16(s[2 * kk + 1][2], s[2 * kk + 1][3]);
                        y = __builtin_amdgcn_mfma_f32_16x16x32_bf16(__builtin_bit_cast(bf16x8, cml[64 * kk]), __builtin_bit_cast(bf16x8, w), y, 0, 0, 0); }
                    *(unsigned*)(yp + (size_t)(tau + j) * 1024) = pack4_fp8(gelu_tanh(y[0]), gelu_tanh(y[1]), gelu_tanh(y[2]), gelu_tanh(y[3]), F8_SA);
                }
            }
#pragma unroll
            for (int j = 0; j < 4; ++j) cu[j] = nu[j];
        }
        if (!WITH_Y) { f32x2* eo = E + (size_t)((b * 64 + g) * 128 + c0 + c) * 64 + 2 * gl;
#pragma unroll
            for (int f = 0; f < 8; ++f) *(f32x4*)(eo + 8 * f) = s[f]; }
    }
}

typedef float f32x16 __attribute__((ext_vector_type(16)));
typedef float f32x32 __attribute__((ext_vector_type(32)));
typedef _Float16 f16x2_t __attribute__((ext_vector_type(2)));
typedef _Float16 f16x4_t __attribute__((ext_vector_type(4)));
typedef _Float16 f16x8_t __attribute__((ext_vector_type(8)));
typedef _Float16 f16x32_t __attribute__((ext_vector_type(32)));
typedef unsigned u32x6 __attribute__((ext_vector_type(6)));
constexpr float PEER_SU = 64.0f, PEER_SV = 1.4f;
constexpr size_t PEER_SHARD_BYTES = (size_t)16384 * 192;
__device__ __forceinline__ void table_cvt_pack(const f32x4 (&v)[8], float sc, unsigned char* dst, int lane) {
    f32x16 a, b;
#pragma unroll
    for (int q = 0; q < 4; ++q) {
#pragma unroll
        for (int e = 0; e < 4; ++e) { a[4 * q + e] = v[q][e] * sc; b[4 * q + e] = v[4 + q][e] * sc; } }
    const u32x6 p = __builtin_amdgcn_cvt_scalef32_2xpk16_fp6_f32(a, b, 1.0f);
    *(u32x4*)(dst + 16 * (lane & 7)) = (u32x4){p[0], p[1], p[2], p[3]};
    *(u32x2*)(dst + 128 + 8 * (lane & 7)) = (u32x2){p[4], p[5]};
}
__device__ __forceinline__ void ph_table_cvt(const float* __restrict__ U, const float* __restrict__ V, unsigned char* UT, unsigned char* VT, int r0, int r1, int gw, int ngw, int lane) {
    for (int r = r0 + gw; r < r1; r += ngw) {
        const float* su = U + (size_t)r * 2048 + 32 * lane; const float* sv = V + (size_t)r * 2048 + 32 * lane;
        f32x4 vu[8], vv[8];
#pragma unroll
        for (int q = 0; q < 8; ++q) vu[q] = *(const f32x4*)(su + 4 * q);
#pragma unroll
        for (int q = 0; q < 8; ++q) vv[q] = *(const f32x4*)(sv + 4 * q);
        const size_t off = (size_t)(lane >> 3) * PEER_SHARD_BYTES + (size_t)r * 192;
        table_cvt_pack(vu, PEER_SU, UT + off, lane);
        table_cvt_pack(vv, PEER_SV, VT + off, lane);
    }
}

#define TK_CE(a_, b_) do { const float _h = fmaxf(a_, b_), _l = fminf(a_, b_); a_ = _h; b_ = _l; } while (0)
__device__ __forceinline__ void tk_sort16(float (&a)[16]) {
#pragma unroll
    for (int p = 1; p < 16; p *= 2)
#pragma unroll
        for (int k = p; k >= 1; k /= 2)
#pragma unroll
            for (int j = k % p; j <= 15 - k; j += 2 * k)
#pragma unroll
                for (int i = 0; i < k; ++i)
                    if (i + j + k <= 15 && (i + j) / (2 * p) == (i + j + k) / (2 * p)) TK_CE(a[i + j], a[i + j + k]);
}
__device__ __forceinline__ void tk_merge16(float (&t)[16], const float (&g)[16]) {
#pragma unroll
    for (int i = 0; i < 16; ++i) t[i] = fmaxf(t[i], g[15 - i]);
#pragma unroll
    for (int k = 8; k >= 1; k /= 2)
#pragma unroll
        for (int i = 0; i < 16; ++i)
            if ((i & k) == 0) TK_CE(t[i], t[i + k]);
}
__device__ __forceinline__ float tk2_key(float a, float b, int flat) {
    const float sum = __uint_as_float(__float_as_uint(a) & ~127u) + __uint_as_float(__float_as_uint(b) & ~127u);
    return __uint_as_float((__float_as_uint(sum) & ~255u) | (unsigned)(255 - flat)); }
__device__ __forceinline__ void ph_peer_topk(LAS unsigned char* lds, const bf16_t* SC, int* idxG, float* gateG, int G) {
    const int tid = opaque_tid(), lane = tid & 63, wave = __builtin_amdgcn_readfirstlane(tid >> 6);
    LAS float* scr = (LAS float*)(lds + wave * 8448);
    for (int it = blockIdx.x; it < 512; it += G) {
        const int tokw = it * 32 + wave * 4;
        float tk[16];
#pragma unroll
        for (int i = 0; i < 16; ++i) tk[i] = -INFINITY;
        u32x2 nv[8];
#pragma unroll
        for (int j = 0; j < 8; ++j) { const int prob = (lane >> 3) + 8 * j, seg = lane & 7; nv[j] = *(const u32x2*)(SC + (size_t)(tokw + (prob >> 4)) * 2048 + (prob & 15) * 128 + 4 * seg); }
        for (int q = 0; q < 4; ++q) {
#pragma unroll
            for (int j = 0; j < 8; ++j) { const int prob = (lane >> 3) + 8 * j, seg = lane & 7; const u32x2 v = nv[j];
                LAS float* d = scr + prob * 33 + 4 * seg; d[0] = bf_lo(v.x); d[1] = bf_hi(v.x); d[2] = bf_lo(v.y); d[3] = bf_hi(v.y); }
            { const int qn = q < 3 ? q + 1 : 3;
#pragma unroll
              for (int j = 0; j < 8; ++j) { const int prob = (lane >> 3) + 8 * j, seg = lane & 7; nv[j] = *(const u32x2*)(SC + (size_t)(tokw + (prob >> 4)) * 2048 + (prob & 15) * 128 + 32 * qn + 4 * seg); } }
            LDS_WAIT();
#pragma unroll
            for (int hh = 0; hh < 2; ++hh) { float g[16];
#pragma unroll
                for (int i = 0; i < 16; ++i) g[i] = __uint_as_float((__float_as_uint(scr[lane * 33 + 16 * hh + i]) & ~127u) | (unsigned)(127 - (32 * q + 16 * hh + i)));
                tk_sort16(g); tk_merge16(tk, g); }
            LDS_WAIT();
        }
        float t2[16];
#pragma unroll
        for (int i = 0; i < 16; ++i) t2[i] = __shfl_xor(tk[i], 1);
        float bv[16];
        {
          bv[0] = tk2_key(tk[0], t2[0], 0);
          bv[1] = tk2_key(tk[0], t2[1], 1);
          bv[2] = tk2_key(tk[0], t2[2], 2);
          bv[3] = tk2_key(tk[0], t2[3], 3);
          bv[4] = tk2_key(tk[0], t2[4], 4);
          bv[5] = tk2_key(tk[0], t2[5], 5);
          bv[6] = tk2_key(tk[0], t2[6], 6);
          bv[7] = tk2_key(tk[0], t2[7], 7);
          bv[8] = tk2_key(tk[0], t2[8], 8);
          bv[9] = tk2_key(tk[0], t2[9], 9);
          bv[10] = tk2_key(tk[0], t2[10], 10);
          bv[11] = tk2_key(tk[0], t2[11], 11);
          bv[12] = tk2_key(tk[0], t2[12], 12);
          bv[13] = tk2_key(tk[0], t2[13], 13);
          bv[14] = tk2_key(tk[0], t2[14], 14);
          bv[15] = tk2_key(tk[0], t2[15], 15);
          tk_sort16(bv);
          { float g[16];
          g[0] = tk2_key(tk[1], t2[0], 16);
          g[1] = tk2_key(tk[1], t2[1], 17);
          g[2] = tk2_key(tk[1], t2[2], 18);
          g[3] = tk2_key(tk[1], t2[3], 19);
          g[4] = tk2_key(tk[1], t2[4], 20);
          g[5] = tk2_key(tk[1], t2[5], 21);
          g[6] = tk2_key(tk[1], t2[6], 22);
          g[7] = tk2_key(tk[1], t2[7], 23);
          g[8] = tk2_key(tk[2], t2[0], 32);
          g[9] = tk2_key(tk[2], t2[1], 33);
          g[10] = tk2_key(tk[2], t2[2], 34);
          g[11] = tk2_key(tk[2], t2[3], 35);
          g[12] = tk2_key(tk[2], t2[4], 36);
          g[13] = tk2_key(tk[3], t2[0], 48);
          g[14] = tk2_key(tk[3], t2[1], 49);
          g[15] = tk2_key(tk[3], t2[2], 50);
          tk_sort16(g); tk_merge16(bv, g); }
          { float g[16];
          g[0] = tk2_key(tk[3], t2[3], 51);
          g[1] = tk2_key(tk[4], t2[0], 64);
          g[2] = tk2_key(tk[4], t2[1], 65);
          g[3] = tk2_key(tk[4], t2[2], 66);
          g[4] = tk2_key(tk[5], t2[0], 80);
          g[5] = tk2_key(tk[5], t2[1], 81);
          g[6] = tk2_key(tk[6], t2[0], 96);
          g[7] = tk2_key(tk[6], t2[1], 97);
          g[8] = tk2_key(tk[7], t2[0], 112);
          g[9] = tk2_key(tk[7], t2[1], 113);
          g[10] = tk2_key(tk[8], t2[0], 128);
          g[11] = tk2_key(tk[9], t2[0], 144);
          g[12] = tk2_key(tk[10], t2[0], 160);
          g[13] = tk2_key(tk[11], t2[0], 176);
          g[14] = tk2_key(tk[12], t2[0], 192);
          g[15] = tk2_key(tk[13], t2[0], 208);
          tk_sort16(g); tk_merge16(bv, g); }
          { float x = tk2_key(tk[14], t2[0], 224);
#pragma unroll
            for (int i = 0; i < 16; ++i) { const float hi = fmaxf(bv[i], x); x = fminf(bv[i], x); bv[i] = hi; } }
          { float x = tk2_key(tk[15], t2[0], 240);
#pragma unroll
            for (int i = 0; i < 16; ++i) { const float hi = fmaxf(bv[i], x); x = fminf(bv[i], x); bv[i] = hi; } }
        }
        unsigned p1[4], p2[4];
#pragma unroll
        for (int j = 0; j < 4; ++j) { p1[j] = 0u; p2[j] = 0u;
#pragma unroll
            for (int e = 0; e < 4; ++e) { p1[j] |= (127u - (__float_as_uint(tk[4 * j + e]) & 127u)) << (8 * e); p2[j] |= (127u - (__float_as_uint(t2[4 * j + e]) & 127u)) << (8 * e); } }
        { float e[16], sum = 0.f; unsigned ex[16];
          const float top = __uint_as_float(__float_as_uint(bv[0]) & ~255u);
#pragma unroll
          for (int i = 0; i < 16; ++i) { const unsigned bits = __float_as_uint(bv[i]); const unsigned flat = 255u - (bits & 255u), aa = flat >> 4, bb = flat & 15u;
              const unsigned w1 = (aa >> 2) == 0u ? p1[0] : (aa >> 2) == 1u ? p1[1] : (aa >> 2) == 2u ? p1[2] : p1[3];
              const unsigned w2 = (bb >> 2) == 0u ? p2[0] : (bb >> 2) == 1u ? p2[1] : (bb >> 2) == 2u ? p2[2] : p2[3];
              ex[i] = (((w1 >> (8u * (aa & 3u))) & 127u) << 7) | ((w2 >> (8u * (bb & 3u))) & 127u);
              e[i] = __expf(__uint_as_float(bits & ~255u) - top); sum += e[i]; }
          const float inv = 1.0f / sum;
          if ((lane & 1) == 0) { const int tl = lane >> 4, head = (lane & 15) >> 1; const size_t o = (size_t)(tokw + tl) * 128 + 64 * (head >> 2);
#pragma unroll
              for (int i = 0; i < 16; ++i) { const int p = 8 * (i & 7) + ((2 * head + (i >> 3)) & 7); idxG[o + p] = (int)ex[i] * 192; gateG[o + p] = e[i] * inv; } } }
    }
}

#define PEER_ROWS(b4_, b2_, i8_) do { _Pragma("unroll") for (int gq = 0; gq < 8; ++gq) { const unsigned ro = (unsigned)(i8_)[gq];        \
        b4_[gq] = *(const u32x4*)(tab + (ro + 16u * (unsigned)c)); b2_[gq] = *(const u32x2*)(tab + (ro + 128u + 8u * (unsigned)c)); } } while (0)
#define PEER_LD8(dst_, p_) do { const u32x4 _a = *(const u32x4*)(p_), _b = *(const u32x4*)((p_) + 4); dst_[0] = (int)_a.x; dst_[1] = (int)_a.y; dst_[2] = (int)_a.z; dst_[3] = (int)_a.w; \
        dst_[4] = (int)_b.x; dst_[5] = (int)_b.y; dst_[6] = (int)_b.z; dst_[7] = (int)_b.w; } while (0)
constexpr float PEER_HS = 0.5f;
typedef int pi32x8 __attribute__((ext_vector_type(8)));
__device__ __forceinline__ void ph_peer_u(LAS unsigned char* lds, const unsigned char* UT, const bf16_t* H2, const int* idxG, bf16_t* pdot, int G) {
    const int tid = opaque_tid(), lane = tid & 63, wave = __builtin_amdgcn_readfirstlane(tid >> 6), r = lane >> 3, c = lane & 7;
    const int shard = blockIdx.x & 7, ws = (blockIdx.x >> 3) * 8 + wave, nws = (G >> 3) * 8;
    const unsigned char* tab = UT + (size_t)shard * PEER_SHARD_BYTES;
    LAS unsigned char* wl = lds + wave * 1024;
    *(LAS u32x2*)(wl + 512 + 8 * lane) = (u32x2){0u, 0u};
    const int n16 = lane & 15, kgl = lane >> 4;
    const LAS unsigned char* bsrc = wl + ((kgl == (n16 >> 2)) ? 32 * (n16 & 3) : 512);
    const bf16_t* hbase = H2 + 256 * shard + 32 * c;
    const int* ibase = idxG + 8 * r;
    const bool qodd = (kgl & 1) != 0; const int key = (lane & 3) + 4 * (kgl & 1);
    const int oslot = 8 * (2 * (n16 >> 2) + (kgl >> 1)) + key;
#define PEER_TOK(t_) (((t_) < T_TOK) ? (t_) : (T_TOK - 1))
    int ci[2][8], ni[2][8], nn[2][8]; u32x4 cw[4], nw[4];
    { const int t0 = PEER_TOK(ws), t1 = PEER_TOK(ws + nws);
      PEER_LD8(ci[0], ibase + (size_t)t0 * 128); PEER_LD8(ci[1], ibase + (size_t)t0 * 128 + 64); PEER_LD8(ni[0], ibase + (size_t)t1 * 128); PEER_LD8(ni[1], ibase + (size_t)t1 * 128 + 64);
#pragma unroll
      for (int q = 0; q < 4; ++q) cw[q] = *(const u32x4*)(hbase + (size_t)t0 * 2048 + 8 * q); }
    u32x4 a4[8], b4[8]; u32x2 a2[8], b2[8];
    PEER_ROWS(a4, a2, ci[0]);
    asm volatile("" :: "v"(a2[7]));
    for (int t = ws; t < T_TOK; t += nws) {
        pi32x8 bop[2][2];
        { f32x16 xa, xb;
#pragma unroll
          for (int e = 0; e < 4; ++e) { xa[2 * e] = bf_lo(cw[0][e]) * PEER_HS; xa[2 * e + 1] = bf_hi(cw[0][e]) * PEER_HS; xa[8 + 2 * e] = bf_lo(cw[1][e]) * PEER_HS; xa[8 + 2 * e + 1] = bf_hi(cw[1][e]) * PEER_HS;
              xb[2 * e] = bf_lo(cw[2][e]) * PEER_HS; xb[2 * e + 1] = bf_hi(cw[2][e]) * PEER_HS; xb[8 + 2 * e] = bf_lo(cw[3][e]) * PEER_HS; xb[8 + 2 * e + 1] = bf_hi(cw[3][e]) * PEER_HS; }
          const u32x6 hi6 = __builtin_amdgcn_cvt_scalef32_2xpk16_fp6_f32(xa, xb, 1.0f);
          const f32x32 bk = __builtin_amdgcn_cvt_scalef32_pk32_f32_fp6(hi6, 1.0f);
#pragma unroll
          for (int i = 0; i < 16; ++i) { xa[i] = (xa[i] - bk[2 * i]) * 16.0f; xb[i] = (xb[i] - bk[2 * i + 1]) * 16.0f; }
          const u32x6 lo6 = __builtin_amdgcn_cvt_scalef32_2xpk16_fp6_f32(xa, xb, 1.0f);
          if (r == 0) { *(LAS u32x4*)(wl + 32 * c) = (u32x4){hi6[0], hi6[1], hi6[2], hi6[3]}; *(LAS u32x2*)(wl + 32 * c + 16) = (u32x2){hi6[4], hi6[5]};
              *(LAS u32x4*)(wl + 256 + 32 * c) = (u32x4){lo6[0], lo6[1], lo6[2], lo6[3]}; *(LAS u32x2*)(wl + 256 + 32 * c + 16) = (u32x2){lo6[4], lo6[5]}; }
          LDS_WAIT();
#pragma unroll
          for (int h = 0; h < 2; ++h)
#pragma unroll
              for (int l = 0; l < 2; ++l) { const i32x4 u0 = *(const LAS i32x4*)(bsrc + 128 * h + 256 * l); const u32x2 u1 = *(const LAS u32x2*)(bsrc + 128 * h + 256 * l + 16);
                  bop[h][l] = (pi32x8){u0[0], u0[1], u0[2], u0[3], (int)u1[0], (int)u1[1], 0, 0}; }
          LDS_WAIT(); }
        PEER_ROWS(b4, b2, ci[1]);
        { const int t1 = PEER_TOK(t + nws);
#pragma unroll
          for (int q = 0; q < 4; ++q) nw[q] = *(const u32x4*)(hbase + (size_t)t1 * 2048 + 8 * q);
          const int t2 = PEER_TOK(t + 2 * nws); PEER_LD8(nn[0], ibase + (size_t)t2 * 128); PEER_LD8(nn[1], ibase + (size_t)t2 * 128 + 64); }
        bf16_t* po = pdot + ((size_t)shard * T_TOK + t) * 128 + oslot;
#define PEER_AF(b4_, b2_, gq_) (pi32x8){(int)b4_[gq_].x, (int)b4_[gq_].y, (int)b4_[gq_].z, (int)b4_[gq_].w, (int)b2_[gq_].x, (int)b2_[gq_].y, 0, 0}
#define PEER_MM(af_, b_, c_, sb_) __builtin_amdgcn_mfma_scale_f32_16x16x128_f8f6f4(af_, b_, c_, 2, 2, 0, 0x7f7f7f7f, 0, sb_)
#define PEER_UDOT(b4_, b2_, half_) do { float mine = 0.f; const f32x4 z4 = {0.f, 0.f, 0.f, 0.f}; \
            _Pragma("unroll") for (int gb = 0; gb < 2; ++gb) { f32x4 d0[4], d1[4]; \
                _Pragma("unroll") for (int g = 0; g < 4; ++g) { const pi32x8 af = PEER_AF(b4_, b2_, 4 * gb + g); d0[g] = PEER_MM(af, bop[0][0], z4, 0x7f7f7f7f); d1[g] = PEER_MM(af, bop[1][0], z4, 0x7f7f7f7f); } \
                _Pragma("unroll") for (int g = 0; g < 4; ++g) { const pi32x8 af = PEER_AF(b4_, b2_, 4 * gb + g); d0[g] = PEER_MM(af, bop[0][1], d0[g], 0x7b7b7b7b); d1[g] = PEER_MM(af, bop[1][1], d1[g], 0x7b7b7b7b); }        \
                _Pragma("unroll") for (int g = 0; g < 4; ++g) { \
                    const float e0 = qodd ? d1[g].x : d0[g].x, e1 = qodd ? d1[g].y : d0[g].y, e2 = qodd ? d1[g].z : d0[g].z, e3 = qodd ? d1[g].w : d0[g].w;     \
                    float v = __builtin_bit_cast(float, __builtin_amdgcn_update_dpp(0, __builtin_bit_cast(int, e0), 0x00, 0xF, 0xF, true)); \
                    v += __builtin_bit_cast(float, __builtin_amdgcn_update_dpp(0, __builtin_bit_cast(int, e1), 0x55, 0xF, 0xF, true)); \
                    v += __builtin_bit_cast(float, __builtin_amdgcn_update_dpp(0, __builtin_bit_cast(int, e2), 0xAA, 0xF, 0xF, true)); \
                    v += __builtin_bit_cast(float, __builtin_amdgcn_update_dpp(0, __builtin_bit_cast(int, e3), 0xFF, 0xF, 0xF, true)); \
                    { float sx = v, sy = v;        \
                      asm volatile("s_nop 1\n\tv_permlane16_swap_b32 %0, %1" : "+v"(sx), "+v"(sy)); v = sx + sy; } \
                    mine = (4 * gb + g == key) ? v : mine; } } \
            po[64 * (half_)] = (bf16_t)(cvt_pk_bf16(mine, 0.f) & 0xffffu); } while (0)
        PEER_UDOT(a4, a2, 0);
        PEER_ROWS(a4, a2, ni[0]);
#pragma unroll
        for (int q = 0; q < 8; ++q) { ci[0][q] = ni[0][q]; ci[1][q] = ni[1][q]; ni[0][q] = nn[0][q]; ni[1][q] = nn[1][q]; }
        PEER_UDOT(b4, b2, 1);
#pragma unroll
        for (int q = 0; q < 4; ++q) cw[q] = nw[q];
    }
#undef PEER_UDOT
#undef PEER_MM
#undef PEER_AF
}
__device__ __forceinline__ void ph_peer_act(const bf16_t* pdot, const float* gateG, float* actG, int G) {
    const size_t n = (size_t)T_TOK * 128, stride = (size_t)G * 512 * 8;
    for (size_t i = ((size_t)blockIdx.x * 512 + threadIdx.x) * 8; i < n; i += stride) {
        float d[8];
#pragma unroll
        for (int e = 0; e < 8; ++e) d[e] = 0.f;
#pragma unroll
        for (int x = 0; x < 8; ++x) { const u32x4 w = *(const u32x4*)(pdot + (size_t)x * n + i);
            d[0] += bf_lo(w.x); d[1] += bf_hi(w.x); d[2] += bf_lo(w.y); d[3] += bf_hi(w.y); d[4] += bf_lo(w.z); d[5] += bf_hi(w.z); d[6] += bf_lo(w.w); d[7] += bf_hi(w.w); }
        const f32x4 g0 = *(const f32x4*)(gateG + i), g1 = *(const f32x4*)(gateG + i + 4);
        f32x4 a0, a1;
#pragma unroll
        for (int e = 0; e < 4; ++e) { a0[e] = g0[e] * gelu_tanh(d[e] * (1.0f / (PEER_SU * PEER_HS))) * (1.0f / PEER_SV); a1[e] = g1[e] * gelu_tanh(d[4 + e] * (1.0f / (PEER_SU * PEER_HS))) * (1.0f / PEER_SV); }
        *(f32x4*)(actG + i) = a0; *(f32x4*)(actG + i + 4) = a1;
    }
}
template <bool DRY>
__device__ __forceinline__ void ph_peer_v(LAS unsigned char* lds, const unsigned char* VT, const int* idxG, const float* actG, const float* mod, const bf16_t* X1, float* OUT, int G) {
    const int tid = opaque_tid(), lane = tid & 63, wave = __builtin_amdgcn_readfirstlane(tid >> 6), r = lane >> 3, c = lane & 7;
    const int shard = blockIdx.x & 7, ws = (blockIdx.x >> 3) * 8 + wave, nws = (G >> 3) * 8;
    const unsigned char* tab = VT + (size_t)shard * PEER_SHARD_BYTES;
    LAS float* red = (LAS float*)(lds + wave * 9216);
    const int* ibase = idxG + 8 * r; const int* abase = (const int*)actG + 8 * r;
    int ci[2][8], ni[2][8], nn[2][8], ca[2][8], na[2][8]; u32x2 cx, nx;
    { const int t0 = PEER_TOK(ws), t1 = PEER_TOK(ws + nws);
      PEER_LD8(ci[0], ibase + (size_t)t0 * 128); PEER_LD8(ci[1], ibase + (size_t)t0 * 128 + 64); PEER_LD8(ni[0], ibase + (size_t)t1 * 128); PEER_LD8(ni[1], ibase + (size_t)t1 * 128 + 64);
      PEER_LD8(ca[0], abase + (size_t)t0 * 128); PEER_LD8(ca[1], abase + (size_t)t0 * 128 + 64);
      cx = *(const u32x2*)(X1 + (size_t)t0 * 2048 + 256 * shard + 4 * lane); }
    const f32x4 gta = *(const f32x4*)(mod + 10240 + 256 * shard + 4 * lane), gtb = *(const f32x4*)(mod + 12288 + 10240 + 256 * shard + 4 * lane);
    u32x4 a4[8], b4[8]; u32x2 a2[8], b2[8];
    PEER_ROWS(a4, a2, ci[0]);
    asm volatile("" :: "v"(a2[7]));
    for (int t = ws; t < T_TOK; t += nws) {
        PEER_ROWS(b4, b2, ci[1]);
        { const int t1 = PEER_TOK(t + nws);
          PEER_LD8(na[0], abase + (size_t)t1 * 128); PEER_LD8(na[1], abase + (size_t)t1 * 128 + 64); nx = *(const u32x2*)(X1 + (size_t)t1 * 2048 + 256 * shard + 4 * lane);
          const int t2 = PEER_TOK(t + 2 * nws); PEER_LD8(nn[0], ibase + (size_t)t2 * 128); PEER_LD8(nn[1], ibase + (size_t)t2 * 128 + 64); }
        f16x2_t acc[16];
#pragma unroll
        for (int k = 0; k < 16; ++k) acc[k] = (f16x2_t){(_Float16)0.f, (_Float16)0.f};
#define PEER_VF(k_) acc[k_] = __builtin_shufflevector(vh, vh, 2 * (k_), 2 * (k_) + 1) * av2 + acc[k_]
#define PEER_VACC(b4_, b2_, a8_) do { _Pragma("unroll") for (int gq = 0; gq < 8; ++gq) { const _Float16 ah = (_Float16)__int_as_float((a8_)[gq]); const f16x2_t av2 = {ah, ah}; \
            const u32x6 p6 = {b4_[gq].x, b4_[gq].y, b4_[gq].z, b4_[gq].w, b2_[gq].x, b2_[gq].y}; const f16x32_t vh = __builtin_amdgcn_cvt_scalef32_pk32_f16_fp6(p6, 1.0f); \
            PEER_VF(0); PEER_VF(1); PEER_VF(2); PEER_VF(3); PEER_VF(4); PEER_VF(5); PEER_VF(6); PEER_VF(7); PEER_VF(8); PEER_VF(9); PEER_VF(10); PEER_VF(11); PEER_VF(12); PEER_VF(13); PEER_VF(14); PEER_VF(15); __builtin_amdgcn_sched_barrier(0); } } while (0)
        PEER_VACC(a4, a2, ca[0]);
        PEER_ROWS(a4, a2, ni[0]);
#pragma unroll
        for (int q = 0; q < 8; ++q) { ci[0][q] = ni[0][q]; ci[1][q] = ni[1][q]; ni[0][q] = nn[0][q]; ni[1][q] = nn[1][q]; }
        PEER_VACC(b4, b2, ca[1]);
        { LAS f16x8_t* w = (LAS f16x8_t*)((LAS unsigned*)red + (r * 8 + c) * 20);
#pragma unroll
          for (int q = 0; q < 4; ++q) { const f16x4_t lo4 = __builtin_shufflevector(acc[4 * q], acc[4 * q + 1], 0, 1, 2, 3), hi4 = __builtin_shufflevector(acc[4 * q + 2], acc[4 * q + 3], 0, 1, 2, 3);
              w[q] = __builtin_shufflevector(lo4, hi4, 0, 1, 2, 3, 4, 5, 6, 7); } }
        LDS_WAIT();
        { const LAS f16x8_t* rd = (const LAS f16x8_t*)((const LAS unsigned*)red + (lane >> 3) * 20 + 4 * (lane & 3));
          f16x8_t p = rd[0];
#pragma unroll
          for (int rr = 1; rr < 8; ++rr) p += rd[rr * 40];
          const f16x4_t plo = __builtin_shufflevector(p, p, 0, 2, 4, 6), phi = __builtin_shufflevector(p, p, 1, 3, 5, 7);
          const f32x4 slo = __builtin_convertvector(plo, f32x4), shi = __builtin_convertvector(phi, f32x4);
          const float hsel = (lane & 4) ? 1.0f : 0.0f;
          const f32x4 s = slo + (shi - slo) * hsel;
          float* op = OUT + (size_t)t * 2048 + 256 * shard + 4 * lane;
          const f32x4 g0 = (t >> 13) ? gtb : gta;
          const f32x4 x1v = {bf_lo(cx.x), bf_hi(cx.x), bf_lo(cx.y), bf_hi(cx.y)};
          if (!DRY) *(f32x4*)op = x1v + g0 * s; else asm volatile("" :: "v"(s), "v"(g0)); }
        LDS_WAIT();
#pragma unroll
        for (int q = 0; q < 8; ++q) { ca[0][q] = na[0][q]; ca[1][q] = na[1][q]; }
        cx = nx;
    }
#undef PEER_VACC
#undef PEER_VF
}
#undef PEER_ROWS
#undef PEER_LD8
#undef PEER_TOK

__global__ void __launch_bounds__(512, 2) mk_fwd(Args args) {
    extern __shared__ __attribute__((aligned(16))) unsigned char lds_raw[];
    LAS unsigned char* lds = (LAS unsigned char*)lds_raw;
    const int tid = threadIdx.x, lane = tid & 63, wave = __builtin_amdgcn_readfirstlane(tid >> 6);
    const int G = gridDim.x, gw = blockIdx.x * 8 + wave, ngw = G * 8;
    unsigned char* ws = args.ws;
    volatile LAS unsigned* misc = (volatile LAS unsigned*)(lds + LDS_MAIN);
    if (tid < 4) misc[tid] = 0u;
    __syncthreads();
    const int lo = args.ph_lo, hi = args.ph_hi;
    XcdBarrier bar; bar.bar = (unsigned*)(ws + WS_CTL); bar.x = 0; bar.st = misc;
    if (hi - lo > 1) bar = xcd_barrier_post((unsigned*)(ws + WS_CTL), misc);
#ifndef PHMASK
#define PHMASK 0x3fff
#endif
#define IN(k) (((PHMASK >> (k)) & 1) && lo <= (k) && (k) < hi)
#define SEAM(k) do { if (IN(k) && IN((k) + 1)) xcd_barrier(bar); } while (0)
    float* mod = (float*)(ws + WS_MOD);
    bf16_t* HB = (bf16_t*)(ws + WS_H); bf16_t* PA = (bf16_t*)(ws + WS_PA); bf16_t* PG = (bf16_t*)(ws + WS_PG);
    bf16_t* YA = (bf16_t*)(ws + WS_YA); bf16_t* ATT = (bf16_t*)(ws + WS_ATT); f32x2* EB = (f32x2*)(ws + WS_E); bf16_t* UBp = (bf16_t*)(ws + WS_UB);

#define PHS(code, ...) do { __VA_ARGS__ if (DUP == (code)) { xcd_barrier(bar); __VA_ARGS__ } } while (0)
#define PH(k, ...) do { if (IN(k)) { __VA_ARGS__ if (DUP == (k)) { xcd_barrier(bar); __VA_ARGS__ } } } while (0)
    PH(0, { ph_mod_partial(args.in[I_C], args.in[I_WADA], (float*)(ws + WS_MODP), gw, ngw, lane); ph_colmax_partial(args.in[I_WIN], (float*)(ws + WS_CMAXP), gw, ngw, lane); });
    SEAM(0);
    PH(1, { ph_prologue(args, lds, gw, ngw, lane, wave); });
    SEAM(1);
    PH(2, { ph_norm<true>(args.in[I_X], HB, (float*)(ws + WS_SA), args.in[I_N1G], mod, 0, 2048, gw, ngw, lane); });
    SEAM(2);
    PH(3, { pg8::Gemm g{HB, (const bf16_t*)(ws + WS_WIN), T_TOK, 8192, 1024}; pg8::StaticOrder S; S.init(T_TOK, 8192, G, (int)blockIdx.x, WGM_P3);
        pg8::EpiProj E{PA, PG, UBp, (const float*)(ws + WS_SA), (const float*)(ws + WS_SB)}; pg8::gemm_phase<pg8::EpiProj, pg8::StaticOrder, true, true, 1>(lds, g, S, E); });
    SEAM(3);
    PH(4, { PHS(41, { ph_attn<0>(lds, PA, ATT, args.in[I_QNG], args.in[I_KNG], G); __syncthreads(); });
        if (DUP == 411) { xcd_barrier(bar); ph_attn<1>(lds, PA, ATT, args.in[I_QNG], args.in[I_KNG], G); __syncthreads(); } PHS(42, { ph_ssm_mfma<false>(args, lds, UBp, EB, YA, G); }); });
    SEAM(4);
    PH(5, { PHS(51, { ph_ssm_mfma<true>(args, lds, UBp, EB, YA, G); __syncthreads(); });
        PHS(52, { pg8::Gemm g{ATT, (const bf16_t*)(ws + WS_WATT), T_TOK, 2048, 512}; pg8::SplitOrder S; S.init(T_TOK, 2048, G, (int)blockIdx.x, WGM_P5);
        pg8::EpiAttUp E{PG, HB}; pg8::gemm_phase<pg8::EpiAttUp, pg8::SplitOrder, true, true, 2>(lds, g, S, E); }); });
    SEAM(5);
    PH(6, { pg8::Gemm g{YA, (const bf16_t*)(ws + WS_WGLU), T_TOK, 4096, 512}; pg8::StaticOrder S; S.init(T_TOK, 4096, G, (int)blockIdx.x, WGM_P6);
        pg8::EpiGlu E{PG, HB, (unsigned char*)ATT}; pg8::gemm_phase<pg8::EpiGlu, pg8::StaticOrder, true, true, 2>(lds, g, S, E); });
    SEAM(6);
    PH(7, { const bool split = (G == 256); const int gg = split ? 171 : G, ra = split ? 11264 : 0;
        if ((int)blockIdx.x < gg) { pg8::Gemm g{ATT, (const bf16_t*)(ws + WS_WOUT), T_TOK, 2048, 1024}; pg8::StaticOrder S; S.init(T_TOK, 2048, gg, (int)blockIdx.x, WGM_P7);
            pg8::EpiOut E{args.in[I_X], (bf16_t*)(ws + WS_X1), mod}; pg8::gemm_phase<pg8::EpiOut, pg8::StaticOrder, true, true, 2>(lds, g, S, E); }
        else ph_table_cvt(args.in[I_PU], args.in[I_PV], ws + WS_UT, ws + WS_VT, 0, ra, ((int)blockIdx.x - gg) * 8 + wave, (G - gg) * 8, lane);
        ph_table_cvt(args.in[I_PU], args.in[I_PV], ws + WS_UT, ws + WS_VT, ra, 16384, gw, ngw, lane); });
    SEAM(7);
    PH(8, { ph_norm<false, true>((const float*)(ws + WS_X1), HB, nullptr, args.in[I_N2G], mod, 6144, 8192, gw, ngw, lane); });
    SEAM(8);
    PH(9, { pg8::Gemm g{HB, (const bf16_t*)(ws + WS_WSC), T_TOK, 2048, 2048}; pg8::StaticOrder S; S.init(T_TOK, 2048, G, (int)blockIdx.x, WGM_P9);
        pg8::EpiF32 E{(bf16_t*)(ws + WS_SC)}; pg8::gemm_phase<pg8::EpiF32, pg8::StaticOrder, true, true>(lds, g, S, E); });
    SEAM(9);
    PH(10, { ph_peer_topk(lds, (const bf16_t*)(ws + WS_SC), (int*)(ws + WS_IDX), (float*)(ws + WS_GATE), G); });
    SEAM(10);
    PH(11, { ph_peer_u(lds, ws + WS_UT, HB, (const int*)(ws + WS_IDX), (bf16_t*)(ws + WS_PDOT), G); });
    SEAM(11);
    PH(12, { ph_peer_act((const bf16_t*)(ws + WS_PDOT), (const float*)(ws + WS_GATE), (float*)(ws + WS_ACT), G); });
    SEAM(12);
    if (IN(13)) { if (DUP == 13) { ph_peer_v<true>(lds, ws + WS_VT, (const int*)(ws + WS_IDX), (const float*)(ws + WS_ACT), mod, (const bf16_t*)(ws + WS_X1), args.out, G); xcd_barrier(bar); }
        ph_peer_v<false>(lds, ws + WS_VT, (const int*)(ws + WS_IDX), (const float*)(ws + WS_ACT), mod, (const bf16_t*)(ws + WS_X1), args.out, G); }
#undef IN
#undef SEAM
}

extern "C" void kernel_launch(void* const* d_in, const int* in_sizes, int n_in, void* d_out, int out_size, void* d_ws, size_t ws_size, hipStream_t stream) {
    static int grid = 0;
    if (grid == 0) {
        if (n_in != 25 || out_size != T_TOK * DM || ws_size < WS_END) { fprintf(stderr, "kernel_launch: unexpected shapes (n_in %d out %d ws %zu need %zu)\n", n_in, out_size, ws_size, (size_t)WS_END); grid = -1; return; }
        int dev = 0, cus = 0, per_cu = 0;
        if (hipGetDevice(&dev) != hipSuccess || hipDeviceGetAttribute(&cus, hipDeviceAttributeMultiprocessorCount, dev) != hipSuccess) { grid = -1; return; }
        if (hipFuncSetAttribute((const void*)mk_fwd, hipFuncAttributeMaxDynamicSharedMemorySize, LDS_BYTES) != hipSuccess) { fprintf(stderr, "kernel_launch: hipFuncSetAttribute failed\n"); grid = -1; return; }
        if (hipOccupancyMaxActiveBlocksPerMultiprocessor(&per_cu, (const void*)mk_fwd, 512, LDS_BYTES) != hipSuccess || per_cu < 1) { fprintf(stderr, "kernel_launch: occupancy query says %d blocks/CU\n", per_cu); (void)hipGetLastError(); grid = -1; return; }
        grid = cus;
    }
    if (grid < 0) return;
    (void)hipMemsetAsync((char*)d_ws + WS_CTL, 0, 16384, stream);
    Args a{};
    for (int i = 0; i < 25; ++i) a.in[i] = (const float*)d_in[i];
    a.out = (float*)d_out; a.ws = (unsigned char*)d_ws;
#if MK_PER_PHASE
    for (int ph = 0; ph < NPHASE; ++ph) { a.ph_lo = ph; a.ph_hi = ph + 1; hipLaunchKernelGGL(mk_fwd, dim3(grid), dim3(512), LDS_BYTES, stream, a); }
#else
    a.ph_lo = 0; a.ph_hi = NPHASE;
    hipLaunchKernelGGL(mk_fwd, dim3(grid), dim3(512), LDS_BYTES, stream, a);
#endif
}
```
